# Optimizing an MI355X kernel written in HIP

```python
import jax, jax.numpy as jnp
from jax import lax
import numpy as np

D_MODEL = 1024
BATCH = 4
SEQ = 4096
DEPTH = 2

N_MIXERS = 2
N_POOL_LAYERS = (DEPTH + 1) // 2
N_SGU_LAYERS = DEPTH // 2
POOL_WINDOWS = (2, 4, 8, 16)
POOL_GROUPS = 4
POOL_WIDTH = D_MODEL
POOL_GROUP_DIM = POOL_WIDTH // POOL_GROUPS
SGU_CHUNK = 128
SGU_HEADS = 4
SGU_WIDTH = 2 * D_MODEL
SGU_HEAD_DIM = SGU_WIDTH // SGU_HEADS
N_EXPERTS = 64
TOP_K = 8
N_GROUPS = 8
TOPK_GROUPS = 4
EXPERT_DIM = D_MODEL // 4
SHARED_DIM = EXPERT_DIM
ROUTED_SCALE = 2.5
EXPERT_BLOCK = 128
DEEPNORM_ALPHA = (2 * DEPTH) ** 0.25
DEEPNORM_BETA = (8 * DEPTH) ** -0.25
LN_EPS = 1e-5

kernel_name = "hybrid_pool_sgu_moe_deepnorm"


def layer_norm(x, g, b):
    xf = x.astype(jnp.float32)
    mu = jnp.mean(xf, axis=-1, keepdims=True)
    xc = xf - mu
    var = jnp.mean(jnp.square(xc), axis=-1, keepdims=True)
    y = xc * lax.rsqrt(var + LN_EPS) * g.astype(jnp.float32) + b.astype(jnp.float32)
    return y.astype(x.dtype)


def pool_mixer(x, w_in, w_grp, scale, w_out):
    bsz, s, _ = x.shape
    z = (x @ w_in).astype(jnp.float32).reshape(bsz, s, POOL_GROUPS, POOL_GROUP_DIM)
    cs = jnp.cumsum(z, axis=1)
    t = jnp.arange(1, s + 1, dtype=jnp.float32)
    pooled = []
    for g, w in enumerate(POOL_WINDOWS):
        c = cs[:, :, g]
        prev = jnp.pad(c[:, : s - w], ((0, 0), (w, 0), (0, 0)))
        mean = (c - prev) / jnp.minimum(t, float(w))[None, :, None]
        pooled.append(mean - z[:, :, g])
    pooled = jnp.stack(pooled, axis=2)
    y = jnp.einsum('bsgc,gcd->bsgd', pooled, w_grp.astype(jnp.float32))
    y = y.reshape(bsz, s, POOL_WIDTH) * scale.astype(jnp.float32)
    return y.astype(x.dtype) @ w_out


def sgu_mixer(x, w_in, b_in, ln_g, ln_b, w_s, b_s, w_out):
    bsz, s, _ = x.shape
    h = jax.nn.gelu(x @ w_in + b_in)
    u, v = h[..., :SGU_WIDTH], h[..., SGU_WIDTH:]
    v = layer_norm(v, ln_g, ln_b)
    v = v.reshape(bsz, s // SGU_CHUNK, SGU_CHUNK, SGU_HEADS, SGU_HEAD_DIM)
    causal = jnp.tril(jnp.ones((SGU_CHUNK, SGU_CHUNK), dtype=w_s.dtype))
    ws = w_s * causal[None]
    sv = jnp.einsum('hij,bnjhc->bnihc', ws, v) + b_s.T[:, :, None]
    gated = u * sv.reshape(bsz, s, SGU_WIDTH)
    return gated @ w_out


def moe(x, w_router, router_bias, w_gate, w_up, w_down, sh_gate, sh_up, sh_down):
    bsz, s, d = x.shape
    n_tok = bsz * s
    xf = x.reshape(n_tok, d)
    scores = jax.nn.sigmoid((xf @ w_router).astype(jnp.float32))
    biased = scores + router_bias.astype(jnp.float32)
    grouped = biased.reshape(n_tok, N_GROUPS, N_EXPERTS // N_GROUPS)
    group_score = lax.top_k(grouped, 2)[0].sum(-1)
    _, top_groups = lax.top_k(group_score, TOPK_GROUPS)
    group_mask = jax.nn.one_hot(top_groups, N_GROUPS, dtype=jnp.float32).sum(1) > 0
    expert_mask = jnp.repeat(group_mask, N_EXPERTS // N_GROUPS, axis=1)
    masked = jnp.where(expert_mask, biased, -jnp.inf)
    _, idx = lax.top_k(masked, TOP_K)
    gate = jnp.take_along_axis(scores, idx, axis=1)
    gate = gate / jnp.sum(gate, axis=-1, keepdims=True) * ROUTED_SCALE

    n_assign = n_tok * TOP_K
    flat_e = idx.reshape(n_assign)
    flat_tok = jnp.repeat(jnp.arange(n_tok, dtype=jnp.int32), TOP_K)
    order = jnp.argsort(flat_e)
    sorted_e = flat_e[order]
    counts = jnp.bincount(flat_e, length=N_EXPERTS)
    starts = jnp.cumsum(counts) - counts
    padded = (counts + EXPERT_BLOCK - 1) // EXPERT_BLOCK * EXPERT_BLOCK
    padded_end = jnp.cumsum(padded)
    padded_start = padded_end - padded
    dest_sorted = (padded_start[sorted_e] + jnp.arange(n_assign, dtype=jnp.int32) - starts[sorted_e]).astype(jnp.int32)
    n_rows = n_assign + N_EXPERTS * EXPERT_BLOCK
    n_blocks = n_rows // EXPERT_BLOCK
    row_tok = jnp.zeros((n_rows,), jnp.int32).at[dest_sorted].set(flat_tok[order])
    block_start = jnp.arange(n_blocks, dtype=jnp.int32) * EXPERT_BLOCK
    block_e = jnp.minimum(jnp.searchsorted(padded_end, block_start, side='right'), N_EXPERTS - 1)

    def expert_block(args):
        tok, e = args
        xb = xf[tok]
        hb = jax.nn.silu(xb @ w_gate[e]) * (xb @ w_up[e])
        return hb @ w_down[e]

    rows = lax.map(expert_block, (row_tok.reshape(n_blocks, EXPERT_BLOCK), block_e))
    rows = rows.reshape(n_rows, d)
    dest = jnp.zeros((n_assign,), jnp.int32).at[order].set(dest_sorted)
    picked = rows[dest].reshape(n_tok, TOP_K, d).astype(jnp.float32)
    routed = jnp.einsum('tkd,tk->td', picked, gate)
    shared = (jax.nn.silu(xf @ sh_gate) * (xf @ sh_up)) @ sh_down
    return (routed.astype(x.dtype) + shared).reshape(bsz, s, d)


def setup_inputs(seed: int = 0) -> dict:
    key = jax.random.key(seed)
    keys = iter(jax.random.split(key, 32))

    def nrm(shape, scale):
        return jax.random.normal(next(keys), shape, jnp.float32) * scale

    beta = DEEPNORM_BETA
    return {
        "x": nrm((BATCH, SEQ, D_MODEL), 1.0),
        "pool_w_in": nrm((N_POOL_LAYERS, D_MODEL, POOL_WIDTH), D_MODEL ** -0.5),
        "pool_w_grp": nrm((N_POOL_LAYERS, POOL_GROUPS, POOL_GROUP_DIM, POOL_GROUP_DIM), POOL_GROUP_DIM ** -0.5),
        "pool_scale": 1.0 + nrm((N_POOL_LAYERS, POOL_WIDTH), 0.1),
        "pool_w_out": nrm((N_POOL_LAYERS, POOL_WIDTH, D_MODEL), beta * POOL_WIDTH ** -0.5),
        "sgu_w_in": nrm((N_SGU_LAYERS, D_MODEL, 2 * SGU_WIDTH), D_MODEL ** -0.5),
        "sgu_b_in": nrm((N_SGU_LAYERS, 2 * SGU_WIDTH), 0.02),
        "sgu_ln_g": 1.0 + nrm((N_SGU_LAYERS, SGU_WIDTH), 0.1),
        "sgu_ln_b": nrm((N_SGU_LAYERS, SGU_WIDTH), 0.02),
        "sgu_w_s": nrm((N_SGU_LAYERS, SGU_HEADS, SGU_CHUNK, SGU_CHUNK), SGU_CHUNK ** -0.5),
        "sgu_b_s": 1.0 + nrm((N_SGU_LAYERS, SGU_HEADS, SGU_CHUNK), 0.1),
        "sgu_w_out": nrm((N_SGU_LAYERS, SGU_WIDTH, D_MODEL), beta * SGU_WIDTH ** -0.5),
        "ln_mix_g": 1.0 + nrm((DEPTH, D_MODEL), 0.1),
        "ln_mix_b": nrm((DEPTH, D_MODEL), 0.02),
        "moe_w_router": nrm((DEPTH, D_MODEL, N_EXPERTS), D_MODEL ** -0.5),
        "moe_router_bias": nrm((DEPTH, N_EXPERTS), 0.01),
        "moe_w_gate": nrm((DEPTH, N_EXPERTS, D_MODEL, EXPERT_DIM), D_MODEL ** -0.5),
        "moe_w_up": nrm((DEPTH, N_EXPERTS, D_MODEL, EXPERT_DIM), D_MODEL ** -0.5),
        "moe_w_down": nrm((DEPTH, N_EXPERTS, EXPERT_DIM, D_MODEL), beta * EXPERT_DIM ** -0.5),
        "moe_sh_gate": nrm((DEPTH, D_MODEL, SHARED_DIM), D_MODEL ** -0.5),
        "moe_sh_up": nrm((DEPTH, D_MODEL, SHARED_DIM), D_MODEL ** -0.5),
        "moe_sh_down": nrm((DEPTH, SHARED_DIM, D_MODEL), beta * SHARED_DIM ** -0.5),
        "ln_ffn_g": 1.0 + nrm((DEPTH, D_MODEL), 0.1),
        "ln_ffn_b": nrm((DEPTH, D_MODEL), 0.02),
    }


def reference(x, pool_w_in, pool_w_grp, pool_scale, pool_w_out, sgu_w_in, sgu_b_in, sgu_ln_g, sgu_ln_b, sgu_w_s, sgu_b_s, sgu_w_out, ln_mix_g, ln_mix_b, moe_w_router, moe_router_bias, moe_w_gate, moe_w_up, moe_w_down, moe_sh_gate, moe_sh_up, moe_sh_down, ln_ffn_g, ln_ffn_b):
    for i in range(DEPTH):
        j = i // N_MIXERS
        if i % N_MIXERS == 0:
            mix = pool_mixer(x, pool_w_in[j], pool_w_grp[j], pool_scale[j], pool_w_out[j])
        else:
            mix = sgu_mixer(x, sgu_w_in[j], sgu_b_in[j], sgu_ln_g[j], sgu_ln_b[j], sgu_w_s[j], sgu_b_s[j], sgu_w_out[j])
        x = layer_norm(DEEPNORM_ALPHA * x + mix, ln_mix_g[i], ln_mix_b[i])
        ffn = moe(x, moe_w_router[i], moe_router_bias[i], moe_w_gate[i], moe_w_up[i], moe_w_down[i], moe_sh_gate[i], moe_sh_up[i], moe_sh_down[i])
        x = layer_norm(DEEPNORM_ALPHA * x + ffn, ln_ffn_g[i], ln_ffn_b[i])
    return x
```

```cpp
#include <hip/hip_runtime.h>
#include <cstdio>
#include <cstdint>

#ifndef MK_PER_PHASE
#define MK_PER_PHASE 0
#endif

#define GAS __attribute__((address_space(1)))
#define LAS __attribute__((address_space(3)))
typedef unsigned short bf16;
typedef unsigned v4u __attribute__((ext_vector_type(4)));
typedef unsigned v2u __attribute__((ext_vector_type(2)));
typedef float f32x4 __attribute__((ext_vector_type(4)));
typedef float f32x2 __attribute__((ext_vector_type(2)));
typedef short bf16x8 __attribute__((ext_vector_type(8)));
#define RLX_AGENT __ATOMIC_RELAXED, __HIP_MEMORY_SCOPE_AGENT
#define LDS_WAIT() asm volatile("s_waitcnt lgkmcnt(0)" ::: "memory")
#define VM_WAIT() asm volatile("s_waitcnt vmcnt(0)" ::: "memory")

constexpr int T_TOK = 16384, DM = 1024, SEQ = 4096, NE = 64, TOPK = 8, EDIM = 256;
constexpr int SGU_W = 2048, SGU_HD = 512;
constexpr float ALPHA = 1.41421356237309515f;
constexpr float LN_EPS = 1e-5f, ROUTED_SCALE = 2.5f;
constexpr int CAP = 16384;
constexpr int NWAVES = 8, NTHR = 512;

constexpr size_t MiB = 1u << 20;
constexpr size_t WS_CTL = 0, CTL_ZERO_BYTES = 65536;
constexpr size_t WS_IDENT = 256 * 1024;
constexpr size_t WS_DEST = 1 * MiB;
constexpr size_t WS_GATE = WS_DEST + 512 * 1024;
constexpr size_t WS_ROWTOK = 2 * MiB;
constexpr size_t WS_WIN = 6 * MiB;
constexpr size_t WS_WGRP = 8 * MiB;
constexpr size_t WS_WOUT = WS_WGRP + 512 * 1024;
constexpr size_t WS_WSIN = WS_WOUT + 2 * MiB;
constexpr size_t WS_WSOUT = WS_WSIN + 8 * MiB;
constexpr size_t WS_WGU = 23 * MiB;
constexpr size_t WS_WDN = WS_WGU + 65 * MiB;
constexpr size_t WS_XB = 121 * MiB;
constexpr size_t WS_H = 153 * MiB;
constexpr size_t WS_Y = 233 * MiB;
constexpr size_t WS_END = 490 * MiB;
constexpr size_t WS_Z = 153 * MiB, WS_POOLED = 185 * MiB, WS_YP = 217 * MiB;
constexpr size_t WS_HS = 153 * MiB;
constexpr size_t WS_GATED = 281 * MiB;
static_assert(WS_WSOUT + 4 * MiB <= WS_WGU && WS_WDN + 33 * MiB <= WS_XB && WS_XB + 32 * MiB <= WS_H && WS_H + 80 * MiB <= WS_Y && WS_Y + 257 * MiB <= WS_END, "ws map");
constexpr int CW_TMO = 0, CW_BAR = 64, CW_CNT = 4096;

constexpr int RING_BYTES = 131072;
constexpr int MISC_OFF = RING_BYTES;
constexpr int LDS_BYTES = 147456;
constexpr int MI_BARW = 0, MI_CNT = 64, MI_TSTART = 320, MI_YSTART = 576, MI_NTILES = 832, MI_TILE_E = 1024;

__device__ __forceinline__ unsigned cvt_pk_bf16(float lo, float hi) { unsigned r; asm volatile("v_cvt_pk_bf16_f32 %0, %1, %2" : "=v"(r) : "v"(lo), "v"(hi)); return r; }
__device__ __forceinline__ float bf_lo(unsigned w) { return __uint_as_float(w << 16); }
__device__ __forceinline__ float bf_hi(unsigned w) { return __uint_as_float(w & 0xffff0000u); }
__device__ __forceinline__ float wave_sum(float v) {
#pragma unroll
    for (int o = 1; o < 64; o <<= 1) v += __shfl_xor(v, o);
    return v;
}
__device__ __forceinline__ float sigmoidf_(float x) { return __builtin_amdgcn_rcpf(1.0f + __builtin_amdgcn_exp2f(-1.4426950408889634f * x)); }
__device__ __forceinline__ float gelu_tanh(float v) { const float y = v + 0.044715f * v * v * v; return v * __builtin_amdgcn_rcpf(1.0f + __builtin_amdgcn_exp2f(-2.3022081983f * y)); }

#define XB_TMO      128
#define XB_XCNT(j)  (256  + 64 * (j))
#define XB_XSUB(j)  (1280 + 64 * (j))
#define XB_XGEN(j)  (2304 + 64 * (j))
#define XB_TOP      3328
#define XB_TOPGEN   3392
#define XCD_BAR_WORDS 3456
#define XB_SPIN_CAP (1u << 20)
__device__ __forceinline__ unsigned xb_ld(unsigned* p)              { return __hip_atomic_load(p, __ATOMIC_RELAXED, __HIP_MEMORY_SCOPE_AGENT); }
__device__ __forceinline__ unsigned xb_add(unsigned* p, unsigned v) { return __hip_atomic_fetch_add(p, v, __ATOMIC_RELAXED, __HIP_MEMORY_SCOPE_AGENT); }
__device__ __forceinline__ unsigned xb_xcc_id() { return (unsigned)__builtin_amdgcn_s_getreg((3 << 11) | 20) & 0xFu; }
#define XB_SPIN(cond, bar) do { unsigned _sp = 0; while (cond) { __builtin_amdgcn_s_sleep(1); \
    if ((++_sp & 255u) == 0u) { if (xb_ld(&(bar)[XB_TMO])) break; if (_sp > XB_SPIN_CAP) { atomicAdd(&(bar)[XB_TMO], 1u); break; } } } } while (0)
struct XcdBarrier { unsigned* bar; unsigned x; volatile LAS unsigned* st; };
__device__ __forceinline__ XcdBarrier xcd_barrier_post(unsigned* bar, volatile LAS unsigned* st) {
    XcdBarrier b; b.bar = bar; b.x = xb_xcc_id(); b.st = st;
    if (threadIdx.x == 0) (void)xb_add(&bar[XB_XCNT(b.x)], 1u);
    return b;
}
__device__ __forceinline__ void xcd_barrier_complete(unsigned* bar, unsigned x, unsigned& nloc, unsigned& nx) {
    const unsigned G = gridDim.x * gridDim.y * gridDim.z;
    unsigned sum, cnt, mine, sp = 0u;
    for (;;) {
        sum = 0u; cnt = 0u; mine = 0u;
#pragma unroll
        for (unsigned j = 0; j < 16; ++j) { const unsigned c = xb_ld(&bar[XB_XCNT(j)]); sum += c; cnt += (c > 0u) ? 1u : 0u; mine = (j == x) ? c : mine; }
        if (sum == G) break;
        __builtin_amdgcn_s_sleep(1);
        if ((++sp & 255u) == 0u) { if (xb_ld(&bar[XB_TMO])) break; if (sp > XB_SPIN_CAP) { atomicAdd(&bar[XB_TMO], 1u); break; } }
    }
    nloc = mine > 0u ? mine : 1u; nx = cnt > 0u ? cnt : 1u;
}
__device__ __forceinline__ void xcd_barrier(const XcdBarrier& b) {
    asm volatile("s_waitcnt vmcnt(0)" ::: "memory");
    __syncthreads();
    if (threadIdx.x == 0) {
        unsigned* bar = b.bar;
        __builtin_amdgcn_s_waitcnt(0);
        unsigned nloc = b.st[0], nx = b.st[1];
        if (nloc == 0u) { xcd_barrier_complete(bar, b.x, nloc, nx); b.st[0] = nloc; b.st[1] = nx; }
        const unsigned old = xb_add(&bar[XB_XSUB(b.x)], 1u);
        const unsigned gen = old / nloc;
        if (old + 1u == (gen + 1u) * nloc) {
            __builtin_amdgcn_fence(__ATOMIC_RELEASE, "agent");
            asm volatile("s_waitcnt vmcnt(0)" ::: "memory");
            const unsigned og = xb_add(&bar[XB_TOP], 1u);
            const unsigned tg = og / nx;
            if (og + 1u == (tg + 1u) * nx) xb_add(&bar[XB_TOPGEN], 1u);
            else XB_SPIN(xb_ld(&bar[XB_TOPGEN]) == tg, bar);
            __builtin_amdgcn_fence(__ATOMIC_ACQUIRE, "agent");
            xb_add(&bar[XB_XGEN(b.x)], 1u);
            asm volatile("s_waitcnt vmcnt(0)" ::: "memory");
        } else {
            XB_SPIN(xb_ld(&bar[XB_XGEN(b.x)]) == gen, bar);
            __builtin_amdgcn_fence(__ATOMIC_ACQUIRE, "agent");
            asm volatile("s_waitcnt vmcnt(0)" ::: "memory");
        }
    }
    __syncthreads();
}

namespace pg8 {
constexpr int BM = 256, BK = 64, HALF = 128, HTB = HALF * BK * 2, STAGE_BYTES = 8 * HTB, NXCD = 8, WGM = 8;
__host__ __device__ __forceinline__ int lds_byte(int r, int c) { const int st = (r >> 4) * 2 + (c >> 5), rr = r & 15, cc = c & 31, ob = rr * 64 + cc * 2; return st * 1024 + (ob ^ (((ob >> 9) & 1) << 5)); }
__host__ __device__ __forceinline__ void stage_rc(int b, int& R, int& C) { const int st = b / 1024, sb = b % 1024, swz = sb ^ (((sb >> 9) & 1) << 5); R = (st >> 1) * 16 + swz / 64; C = (st & 1) * 32 + (swz % 64) / 2; }
__host__ __device__ __forceinline__ int perm32(int rho) { const int n = rho >> 4, i = rho & 15; return 8 * (i >> 2) + 4 * n + (i & 3); }

struct Unit { const char* A; const char* B; const unsigned* gat; int nvalid; int i0, i1, i2; };

template <class Epi, class Sched, bool GATHER, bool ALIGN_EPI, bool SP2>
__device__ __forceinline__ void gemm_phase(LAS unsigned char* lds, const unsigned lda, const unsigned ldb, const int nt, const Sched& S, const Epi& E) {
    const int tid = threadIdx.x, wid = __builtin_amdgcn_readfirstlane(tid >> 6), lane = tid & 63, wr = wid >> 2, wc = wid & 3, fr = lane & 15, fq = lane >> 4;
    int R0, C0, R1, C1; stage_rc(tid * 16, R0, C0); stage_rc(tid * 16 + 8192, R1, C1);
    const int Rb0 = (R0 & ~31) + perm32(R0 & 31), Rb1 = (R1 & ~31) + perm32(R1 & 31);
    const unsigned voffB0 = (unsigned)Rb0 * ldb + (unsigned)C0 * 2u, voffB1 = (unsigned)Rb1 * ldb + (unsigned)C1 * 2u;
    const size_t hstepB = (size_t)HALF * ldb;
    const size_t kstep = (size_t)(BK * 2);
    const unsigned ldsw = (unsigned)wid * 1024u;
    const int aoff = lds_byte(wr * 64 + fr, fq * 8), boff = lds_byte(wc * 32 + fr, fq * 8);
#define PG8_SA(b, h) (((b) * 2 + (h)) * HTB)
#define PG8_SB(b, h) ((4 + (b) * 2 + (h)) * HTB)
#define PG8_STAGE(bufoff, gbase, v0, v1) do { unsigned _v0 = (v0), _v1 = (v1); asm volatile("" : "+v"(_v0), "+v"(_v1)); \
        __builtin_amdgcn_global_load_lds((const unsigned*)((const char*)(gbase) + _v0), (LAS unsigned*)(lds + (bufoff) + ldsw), 16, 0, 0); \
        __builtin_amdgcn_global_load_lds((const unsigned*)((const char*)(gbase) + _v1), (LAS unsigned*)(lds + (bufoff) + ldsw + 8192), 16, 0, 0); } while (0)
#define PG8_LDA(dst, b, h) do { _Pragma("unroll") for (int m = 0; m < 4; ++m) _Pragma("unroll") for (int k = 0; k < 2; ++k) dst[m][k] = *(const LAS bf16x8*)(lds + PG8_SA(b, h) + aoff + m * 2048 + k * 1024); } while (0)
#define PG8_LDB(dst, b, h) do { _Pragma("unroll") for (int n = 0; n < 2; ++n) _Pragma("unroll") for (int k = 0; k < 2; ++k) dst[n][k] = *(const LAS bf16x8*)(lds + PG8_SB(b, h) + boff + n * 2048 + k * 1024); } while (0)
#define PG8_MMA(ai, bj, At, Bt) do { __builtin_amdgcn_s_setprio(1); _Pragma("unroll") for (int m = 0; m < 4; ++m) _Pragma("unroll") for (int n = 0; n < 2; ++n) _Pragma("unroll") for (int k = 0; k < 2; ++k) \
        acc[ai][bj][m][n] = __builtin_amdgcn_mfma_f32_16x16x32_bf16(Bt[n][k], At[m][k], acc[ai][bj][m][n], 0, 0, 0); __builtin_amdgcn_s_setprio(0); } while (0)
#define PG8_WAIT_V(n) asm volatile("s_waitcnt vmcnt(" #n ")" ::: "memory")
#define PG8_WAIT_L(n) asm volatile("s_waitcnt lgkmcnt(" #n ")" ::: "memory")
#define PG8_BAR __builtin_amdgcn_s_barrier()
#define PG8_SCHED __builtin_amdgcn_sched_barrier(0)
#define PG8_SETV(v00, v01, v10, v11, u) do { \
        if (GATHER) { const unsigned ta = R0 < (u).nvalid ? (u).gat[R0] : 0u, tb = R1 < (u).nvalid ? (u).gat[R1] : 0u, \
                                     tc = (HALF + R0) < (u).nvalid ? (u).gat[HALF + R0] : 0u, td = (HALF + R1) < (u).nvalid ? (u).gat[HALF + R1] : 0u; \
            v00 = ta * lda + (unsigned)C0 * 2u; v01 = tb * lda + (unsigned)C1 * 2u; v10 = tc * lda + (unsigned)C0 * 2u; v11 = td * lda + (unsigned)C1 * 2u; } \
        else { v00 = (unsigned)R0 * lda + (unsigned)C0 * 2u; v01 = (unsigned)R1 * lda + (unsigned)C1 * 2u; v10 = (unsigned)(HALF + R0) * lda + (unsigned)C0 * 2u; v11 = (unsigned)(HALF + R1) * lda + (unsigned)C1 * 2u; } } while (0)
    Unit cur, nxt; int ui = 0;
    if (!S.next(0, cur)) return;
    f32x4 acc[2][2][4][2];
#pragma unroll
    for (int a = 0; a < 2; ++a)
#pragma unroll
        for (int b = 0; b < 2; ++b)
#pragma unroll
            for (int m = 0; m < 4; ++m)
#pragma unroll
                for (int n = 0; n < 2; ++n) acc[a][b][m][n] = (f32x4){0.f, 0.f, 0.f, 0.f};
    bf16x8 At[4][2], B0[2][2], B1[2][2];
    const char* cA = cur.A; const char* cB = cur.B;
    unsigned cv00, cv01, cv10, cv11;
    PG8_SETV(cv00, cv01, cv10, cv11, cur);
    if constexpr (SP2) {
        PG8_STAGE(PG8_SB(0, 0), cB, voffB0, voffB1); PG8_STAGE(PG8_SB(0, 1), cB + hstepB, voffB0, voffB1); PG8_STAGE(PG8_SA(0, 0), cA, cv00, cv01); PG8_STAGE(PG8_SA(0, 1), cA, cv10, cv11);
        if (wr == 1) PG8_BAR;
        PG8_WAIT_V(2); PG8_BAR;
        PG8_STAGE(PG8_SB(1, 0), cB + kstep, voffB0, voffB1); PG8_STAGE(PG8_SA(1, 0), cA + kstep, cv00, cv01); PG8_STAGE(PG8_SB(1, 1), cB + hstepB + kstep, voffB0, voffB1);
        PG8_WAIT_V(6); PG8_BAR;
    } else {
        PG8_STAGE(PG8_SB(0, 0), cB, voffB0, voffB1); PG8_STAGE(PG8_SA(0, 0), cA, cv00, cv01); PG8_STAGE(PG8_SB(0, 1), cB + hstepB, voffB0, voffB1); PG8_STAGE(PG8_SA(0, 1), cA, cv10, cv11);
        if (wr == 1) PG8_BAR;
        PG8_WAIT_V(4); PG8_BAR;
        PG8_STAGE(PG8_SB(1, 0), cB + kstep, voffB0, voffB1); PG8_STAGE(PG8_SA(1, 0), cA + kstep, cv00, cv01); PG8_STAGE(PG8_SB(1, 1), cB + hstepB + kstep, voffB0, voffB1);
        PG8_WAIT_V(6); PG8_BAR;
    }
    for (;;) {
        const bool has_next = S.next(ui + 1, nxt);
        const char* nA = has_next ? nxt.A : cA; const char* nB = has_next ? nxt.B : cB;
        for (int t = 0; t < nt; t += 2) {
            const bool last = (t == nt - 2);
            const char* a1 = cA + (size_t)(t + 1) * kstep;
            const char* a2 = last ? nA : cA + (size_t)(t + 2) * kstep; const char* b2 = last ? nB : cB + (size_t)(t + 2) * kstep;
            const char* a3 = a2 + kstep; const char* b3 = b2 + kstep;
            if constexpr (SP2) {
            PG8_LDB(B0, 0, 0); PG8_LDB(B1, 0, 1); PG8_SCHED; PG8_LDA(At, 0, 0); PG8_STAGE(PG8_SA(1, 1), a1, cv10, cv11);
            PG8_WAIT_V(8); PG8_WAIT_L(0); PG8_BAR; PG8_MMA(0, 0, At, B0); PG8_MMA(0, 1, At, B1); PG8_BAR; PG8_SCHED;
            if constexpr (GATHER) { if (last && has_next) { PG8_SETV(cv00, cv01, cv10, cv11, nxt); } }
            PG8_LDA(At, 0, 1); PG8_STAGE(PG8_SB(0, 0), b2, voffB0, voffB1); PG8_STAGE(PG8_SB(0, 1), b2 + hstepB, voffB0, voffB1); PG8_STAGE(PG8_SA(0, 0), a2, cv00, cv01);
            PG8_WAIT_V(8); PG8_WAIT_L(0); PG8_BAR; PG8_MMA(1, 0, At, B0); PG8_MMA(1, 1, At, B1); PG8_BAR; PG8_SCHED;
            PG8_LDB(B0, 1, 0); PG8_LDB(B1, 1, 1); PG8_SCHED; PG8_LDA(At, 1, 0); PG8_STAGE(PG8_SA(0, 1), a2, cv10, cv11);
            PG8_WAIT_V(8); PG8_WAIT_L(0); PG8_BAR; PG8_MMA(0, 0, At, B0); PG8_MMA(0, 1, At, B1); PG8_BAR; PG8_SCHED;
            PG8_LDA(At, 1, 1); PG8_STAGE(PG8_SB(1, 0), b3, voffB0, voffB1); PG8_STAGE(PG8_SB(1, 1), b3 + hstepB, voffB0, voffB1); PG8_STAGE(PG8_SA(1, 0), a3, cv00, cv01);
            PG8_WAIT_V(8); PG8_WAIT_L(0); PG8_BAR; PG8_MMA(1, 0, At, B0); PG8_MMA(1, 1, At, B1); PG8_BAR; PG8_SCHED;
            } else {
            PG8_LDB(B0, 0, 0); PG8_SCHED; PG8_LDA(At, 0, 0); PG8_STAGE(PG8_SA(1, 1), a1, cv10, cv11);
            PG8_WAIT_L(8); PG8_BAR; PG8_WAIT_L(0); PG8_MMA(0, 0, At, B0); PG8_BAR; PG8_SCHED;
            if constexpr (GATHER) { if (last && has_next) { PG8_SETV(cv00, cv01, cv10, cv11, nxt); } }
            PG8_LDB(B1, 0, 1); PG8_STAGE(PG8_SB(0, 0), b2, voffB0, voffB1);
            PG8_BAR; PG8_WAIT_L(0); PG8_MMA(0, 1, At, B1); PG8_BAR;
            PG8_LDA(At, 0, 1); PG8_STAGE(PG8_SA(0, 0), a2, cv00, cv01);
            PG8_BAR; PG8_WAIT_L(0); PG8_MMA(1, 0, At, B0); PG8_BAR; PG8_SCHED;
            PG8_STAGE(PG8_SB(0, 1), b2 + hstepB, voffB0, voffB1);
            PG8_WAIT_V(6); PG8_BAR; PG8_MMA(1, 1, At, B1); PG8_BAR;
            PG8_LDB(B0, 1, 0); PG8_SCHED; PG8_LDA(At, 1, 0); PG8_STAGE(PG8_SA(0, 1), a2, cv10, cv11);
            PG8_WAIT_L(8); PG8_BAR; PG8_WAIT_L(0); PG8_MMA(0, 0, At, B0); PG8_BAR; PG8_SCHED;
            PG8_LDB(B1, 1, 1); PG8_STAGE(PG8_SB(1, 0), b3, voffB0, voffB1);
            PG8_BAR; PG8_WAIT_L(0); PG8_MMA(0, 1, At, B1); PG8_BAR;
            PG8_LDA(At, 1, 1); PG8_STAGE(PG8_SA(1, 0), a3, cv00, cv01);
            PG8_BAR; PG8_WAIT_L(0); PG8_MMA(1, 0, At, B0); PG8_BAR; PG8_SCHED;
            PG8_STAGE(PG8_SB(1, 1), b3 + hstepB, voffB0, voffB1);
            PG8_WAIT_V(6); PG8_BAR; PG8_MMA(1, 1, At, B1); PG8_BAR;
            }
        }
        if constexpr (ALIGN_EPI) { if (wr == 0) PG8_BAR; }
        E(acc, cur, wr, wc, fr, fq);
        if (!has_next) break;
#pragma unroll
        for (int a = 0; a < 2; ++a)
#pragma unroll
            for (int b = 0; b < 2; ++b)
#pragma unroll
                for (int m = 0; m < 4; ++m)
#pragma unroll
                    for (int n = 0; n < 2; ++n) acc[a][b][m][n] = (f32x4){0.f, 0.f, 0.f, 0.f};
        cur = nxt; cA = nA; cB = nB; ++ui;
        if constexpr (ALIGN_EPI) { if (wr == 1) PG8_BAR; }
    }
    PG8_WAIT_V(0);
    if constexpr (!ALIGN_EPI) { if (wr == 0) PG8_BAR; }
    PG8_BAR;
#undef PG8_SA
#undef PG8_SB
#undef PG8_STAGE
#undef PG8_LDA
#undef PG8_LDB
#undef PG8_MMA
#undef PG8_WAIT_V
#undef PG8_WAIT_L
#undef PG8_BAR
#undef PG8_SCHED
#undef PG8_SETV
}

struct DenseSched {
    const char* A; const char* B; unsigned lda, ldb, a_pn; int nM, nN, nwg, G, c;
    __device__ __forceinline__ bool next(int i, Unit& u) const {
        const long L = (long)i * G + c; if (L >= nwg) return false;
        int wgid = (int)L; { const int q = nwg / NXCD, r = nwg % NXCD, xcd = wgid % NXCD, off = wgid / NXCD; wgid = (xcd < r ? xcd * (q + 1) : r * (q + 1) + (xcd - r) * q) + off; }
        const int nig = WGM * nN, gid = wgid / nig, fm = gid * WGM, gsz = (nM - fm) < WGM ? (nM - fm) : WGM;
        const int pm = fm + ((wgid % nig) % gsz), pn = (wgid % nig) / gsz;
        u.A = A + (size_t)pm * BM * lda + (size_t)pn * a_pn; u.B = B + (size_t)pn * BM * ldb; u.gat = nullptr; u.nvalid = BM; u.i0 = pm; u.i1 = pn; u.i2 = 0; return true;
    }
};
struct MoeInfo { const LAS unsigned* cnt; const LAS unsigned* tstart; const LAS unsigned* ystart; const LAS unsigned char* tile_e; int ntiles; };
struct G1Sched {
    MoeInfo mi; const char* XB; const char* Wgu; const unsigned* rowtok; const unsigned* ident; int G, vcu;
    __device__ __forceinline__ bool next(int i, Unit& u) const {
        const int L = i * G + vcu; if (L >= 2 * mi.ntiles) return false;
        const int tile = L >> 1, uu = L & 1; int e;
        if (tile < 64) { e = 64; u.gat = ident + tile * 256; u.nvalid = 256; }
        else { e = __builtin_amdgcn_readfirstlane((int)mi.tile_e[tile]); const int pos0 = (tile - __builtin_amdgcn_readfirstlane((int)mi.tstart[e])) * 256; u.gat = rowtok + (size_t)e * CAP + pos0; const int rem = __builtin_amdgcn_readfirstlane((int)mi.cnt[e]) - pos0; u.nvalid = rem < 256 ? rem : 256; }
        u.A = XB; u.B = Wgu + ((size_t)e * 512 + (size_t)uu * 256) * 2048; u.i0 = tile; u.i1 = uu; u.i2 = 0; return true;
    }
};
struct G2Sched {
    MoeInfo mi; const char* H; const char* Wd; int G, vcu;
    __device__ __forceinline__ bool next(int i, Unit& u) const {
        const int L = i * G + vcu; if (L >= 4 * mi.ntiles) return false;
        const int tile = L >> 2, pn = L & 3; int e;
        if (tile < 64) { e = 64; u.i0 = tile * 256; u.i2 = 1; u.nvalid = 256; }
        else { e = __builtin_amdgcn_readfirstlane((int)mi.tile_e[tile]); const int pos0 = (tile - __builtin_amdgcn_readfirstlane((int)mi.tstart[e])) * 256; u.i0 = __builtin_amdgcn_readfirstlane((int)mi.ystart[e]) + pos0; u.i2 = 0; const int rem = __builtin_amdgcn_readfirstlane((int)mi.cnt[e]) - pos0; u.nvalid = rem < 256 ? rem : 256; }
        u.A = H + (size_t)tile * 256 * 512; u.B = Wd + ((size_t)e * 1024 + (size_t)pn * 256) * 512; u.gat = nullptr; u.i1 = pn; return true;
    }
};

template <int ACT, bool BIAS, bool SCALE> struct EpiBf16 {
    bf16* O; int ldo; const float* bias; const float* scale;
    __device__ __forceinline__ void operator()(const f32x4 (&acc)[2][2][4][2], const Unit& u, int wr, int wc, int fr, int fq) const {
        const int row0 = u.i0 * BM + wr * 64 + fr, col0 = u.i1 * BM + wc * 32 + 8 * fq;
        f32x4 bv[2][2], sv[2][2];
#pragma unroll
        for (int bj = 0; bj < 2; ++bj)
#pragma unroll
            for (int n = 0; n < 2; ++n) { bv[bj][n] = BIAS ? *(const f32x4*)(bias + col0 + bj * HALF + 4 * n) : (f32x4){0.f, 0.f, 0.f, 0.f}; sv[bj][n] = SCALE ? *(const f32x4*)(scale + col0 + bj * HALF + 4 * n) : (f32x4){1.f, 1.f, 1.f, 1.f}; }
#pragma unroll
        for (int ai = 0; ai < 2; ++ai)
#pragma unroll
            for (int m = 0; m < 4; ++m) { bf16* rowp = O + (size_t)(row0 + ai * HALF + m * 16) * ldo + col0;
#pragma unroll
                for (int bj = 0; bj < 2; ++bj) { f32x4 v0 = acc[ai][bj][m][0] + bv[bj][0], v1 = acc[ai][bj][m][1] + bv[bj][1];
                    if (ACT == 1) {
#pragma unroll
                        for (int j = 0; j < 4; ++j) { v0[j] = gelu_tanh(v0[j]); v1[j] = gelu_tanh(v1[j]); } }
                    if (SCALE) { v0 = v0 * sv[bj][0]; v1 = v1 * sv[bj][1]; }
                    v4u w; w.x = cvt_pk_bf16(v0[0], v0[1]); w.y = cvt_pk_bf16(v0[2], v0[3]); w.z = cvt_pk_bf16(v1[0], v1[1]); w.w = cvt_pk_bf16(v1[2], v1[3]);
                    *(v4u*)(rowp + bj * HALF) = w; } }
    }
};
struct EpiResid {
    const float* base; float* out;
    __device__ __forceinline__ void operator()(const f32x4 (&acc)[2][2][4][2], const Unit& u, int wr, int wc, int fr, int fq) const {
        const int row0 = u.i0 * BM + wr * 64 + fr, col0 = u.i1 * BM + wc * 32 + 8 * fq;
#pragma unroll
        for (int ai = 0; ai < 2; ++ai)
#pragma unroll
            for (int m = 0; m < 4; ++m) { const size_t off = (size_t)(row0 + ai * HALF + m * 16) * DM + col0;
#pragma unroll
                for (int bj = 0; bj < 2; ++bj) { const f32x4 b0 = *(const f32x4*)(base + off + bj * HALF), b1 = *(const f32x4*)(base + off + bj * HALF + 4);
                    *(f32x4*)(out + off + bj * HALF) = b0 * ALPHA + acc[ai][bj][m][0]; *(f32x4*)(out + off + bj * HALF + 4) = b1 * ALPHA + acc[ai][bj][m][1]; }
                asm volatile("" ::: "memory"); }
    }
};
struct EpiSwiglu {
    bf16* H;
    __device__ __forceinline__ void operator()(const f32x4 (&acc)[2][2][4][2], const Unit& u, int wr, int wc, int fr, int fq) const {
        const int row0 = u.i0 * BM + wr * 64 + fr, col0 = u.i1 * HALF + wc * 32 + 8 * fq;
#pragma unroll
        for (int ai = 0; ai < 2; ++ai)
#pragma unroll
            for (int m = 0; m < 4; ++m) { bf16* rowp = H + (size_t)(row0 + ai * HALF + m * 16) * EDIM + col0; float h[8];
#pragma unroll
                for (int n = 0; n < 2; ++n)
#pragma unroll
                    for (int j = 0; j < 4; ++j) { const float g = acc[ai][0][m][n][j], up = acc[ai][1][m][n][j]; h[4 * n + j] = g * sigmoidf_(g) * up; }
                v4u w; w.x = cvt_pk_bf16(h[0], h[1]); w.y = cvt_pk_bf16(h[2], h[3]); w.z = cvt_pk_bf16(h[4], h[5]); w.w = cvt_pk_bf16(h[6], h[7]);
                *(v4u*)rowp = w; }
    }
};
struct EpiDown {
    bf16* Y; float* xf;
    __device__ __forceinline__ void operator()(const f32x4 (&acc)[2][2][4][2], const Unit& u, int wr, int wc, int fr, int fq) const {
        const int r0 = wr * 64 + fr, col0 = u.i1 * BM + wc * 32 + 8 * fq;
        if (u.i2) {
#pragma unroll
            for (int ai = 0; ai < 2; ++ai)
#pragma unroll
                for (int m = 0; m < 4; ++m) { const size_t off = (size_t)(u.i0 + r0 + ai * HALF + m * 16) * DM + col0;
#pragma unroll
                    for (int bj = 0; bj < 2; ++bj) { const f32x4 b0 = *(const f32x4*)(xf + off + bj * HALF), b1 = *(const f32x4*)(xf + off + bj * HALF + 4);
                        *(f32x4*)(xf + off + bj * HALF) = b0 * ALPHA + acc[ai][bj][m][0]; *(f32x4*)(xf + off + bj * HALF + 4) = b1 * ALPHA + acc[ai][bj][m][1]; }
                    asm volatile("" ::: "memory"); }
        } else {
#pragma unroll
            for (int ai = 0; ai < 2; ++ai)
#pragma unroll
                for (int m = 0; m < 4; ++m) { const int r = r0 + ai * HALF + m * 16;
                    if (r < u.nvalid) { bf16* rowp = Y + (size_t)(u.i0 + r) * DM + col0;
#pragma unroll
                        for (int bj = 0; bj < 2; ++bj) { const f32x4 v0 = acc[ai][bj][m][0], v1 = acc[ai][bj][m][1];
                            v4u w; w.x = cvt_pk_bf16(v0[0], v0[1]); w.y = cvt_pk_bf16(v0[2], v0[3]); w.z = cvt_pk_bf16(v1[0], v1[1]); w.w = cvt_pk_bf16(v1[2], v1[3]);
                            *(v4u*)(rowp + bj * HALF) = w; } } }
        }
    }
};
}

struct Args { const float* in[24]; float* out; unsigned char* ws; int ph_lo, ph_hi; };
enum { I_X = 0, I_PWIN, I_PWGRP, I_PSCALE, I_PWOUT, I_SWIN, I_SBIN, I_SLNG, I_SLNB, I_SWS, I_SBS, I_SWOUT, I_LNMG, I_LNMB, I_WR, I_RB, I_WG, I_WU, I_WD, I_SHG, I_SHU, I_SHD, I_LNFG, I_LNFB };

__device__ __forceinline__ void tr_item(const float* W, int N, int k0, int n0, bf16* dst  , int dpitch, LAS float* scr, int lane) {
#pragma unroll 8
    for (int i = 0; i < 32; ++i) { const int kk = 2 * i + (lane >> 5); scr[kk * 33 + (lane & 31)] = W[(size_t)(k0 + kk) * N + n0 + (lane & 31)]; }
    LDS_WAIT(); asm volatile("" ::: "memory");
    const int c = lane & 7;
#pragma unroll
    for (int j = 0; j < 4; ++j) { const int n = (lane >> 3) + 8 * j; const LAS float* s = scr + (8 * c) * 33 + n;
        v4u o; o.x = cvt_pk_bf16(s[0 * 33], s[1 * 33]); o.y = cvt_pk_bf16(s[2 * 33], s[3 * 33]); o.z = cvt_pk_bf16(s[4 * 33], s[5 * 33]); o.w = cvt_pk_bf16(s[6 * 33], s[7 * 33]);
        *(v4u*)(dst + (size_t)n * dpitch + 8 * c) = o; }
    LDS_WAIT(); asm volatile("" ::: "memory");
}
__device__ __forceinline__ void convert_moe_layer(const Args& a, int layer, LAS unsigned char* lds, int gw, int NGW, int wave, int lane) {
    LAS float* scr = (LAS float*)(lds + wave * 16384);
    bf16* WGU = (bf16*)(a.ws + WS_WGU); bf16* WDN = (bf16*)(a.ws + WS_WDN);
    constexpr int PER_E = 384, NIT = 65 * PER_E;
    for (int it = gw; it < NIT; it += NGW) {
        const int e = it / PER_E, r = it % PER_E;
        if (r < 256) { const int isup = r >> 7, rr = r & 127, kb = rr >> 3, nb = rr & 7, n0 = 32 * nb, k0 = 64 * kb;
            const float* src = (e < 64) ? a.in[isup ? I_WU : I_WG] + ((size_t)layer * 64 + e) * 262144 : a.in[isup ? I_SHU : I_SHG] + (size_t)layer * 262144;
            const int drow = e * 512 + (n0 >> 7) * 256 + isup * 128 + (n0 & 127);
            tr_item(src, 256, k0, n0, WGU + (size_t)drow * 1024 + k0, 1024, scr, lane);
        } else { const int rr = r - 256, kb = rr >> 5, nb = rr & 31, n0 = 32 * nb, k0 = 64 * kb;
            const float* src = (e < 64) ? a.in[I_WD] + ((size_t)layer * 64 + e) * 262144 : a.in[I_SHD] + (size_t)layer * 262144;
            tr_item(src, 1024, k0, n0, WDN + ((size_t)e * 1024 + n0) * 256 + k0, 256, scr, lane);
        }
    }
}
__device__ __forceinline__ void phase_p0(const Args& a, LAS unsigned char* lds, int vcu, int G) {
    const int tid = threadIdx.x, lane = tid & 63, wave = __builtin_amdgcn_readfirstlane(tid >> 6);
    const int gw = vcu * NWAVES + wave, NGW = G * NWAVES;
    LAS float* scr = (LAS float*)(lds + wave * 16384);
    constexpr int I_IN = 16 * 32, I_GRP = 4 * 4 * 8, I_OUT = 16 * 32, I_SIN = 16 * 128, I_SOUT = 32 * 32, NIT = I_IN + I_GRP + I_OUT + I_SIN + I_SOUT;
    for (int it = gw; it < NIT; it += NGW) {
        int r = it;
        if (r < I_IN) { const int kb = r >> 5, nb = r & 31; tr_item(a.in[I_PWIN], 1024, 64 * kb, 32 * nb, (bf16*)(a.ws + WS_WIN) + (size_t)(32 * nb) * 1024 + 64 * kb, 1024, scr, lane); continue; } r -= I_IN;
        if (r < I_GRP) { const int g = r >> 5, rr = r & 31, kb = rr >> 3, nb = rr & 7; tr_item(a.in[I_PWGRP] + (size_t)g * 65536, 256, 64 * kb, 32 * nb, (bf16*)(a.ws + WS_WGRP) + (size_t)(g * 256 + 32 * nb) * 256 + 64 * kb, 256, scr, lane); continue; } r -= I_GRP;
        if (r < I_OUT) { const int kb = r >> 5, nb = r & 31; tr_item(a.in[I_PWOUT], 1024, 64 * kb, 32 * nb, (bf16*)(a.ws + WS_WOUT) + (size_t)(32 * nb) * 1024 + 64 * kb, 1024, scr, lane); continue; } r -= I_OUT;
        if (r < I_SIN) { const int kb = r >> 7, nb = r & 127; tr_item(a.in[I_SWIN], 4096, 64 * kb, 32 * nb, (bf16*)(a.ws + WS_WSIN) + (size_t)(32 * nb) * 1024 + 64 * kb, 1024, scr, lane); continue; } r -= I_SIN;
        { const int kb = r >> 5, nb = r & 31; tr_item(a.in[I_SWOUT], 1024, 64 * kb, 32 * nb, (bf16*)(a.ws + WS_WSOUT) + (size_t)(32 * nb) * 2048 + 64 * kb, 2048, scr, lane); }
    }
    convert_moe_layer(a, 0, lds, gw, NGW, wave, lane);
    const float* x = a.in[I_X]; bf16* xb = (bf16*)(a.ws + WS_XB);
    const size_t gt = (size_t)vcu * NTHR + tid, NT = (size_t)G * NTHR;
    for (size_t i = gt; i < (size_t)T_TOK * DM / 8; i += NT) { const f32x4 p = *(const f32x4*)(x + i * 8), q = *(const f32x4*)(x + i * 8 + 4);
        v4u w; w.x = cvt_pk_bf16(p[0], p[1]); w.y = cvt_pk_bf16(p[2], p[3]); w.z = cvt_pk_bf16(q[0], q[1]); w.w = cvt_pk_bf16(q[2], q[3]); *(v4u*)(xb + i * 8) = w; }
    unsigned* ident = (unsigned*)(a.ws + WS_IDENT);
    for (size_t i = gt; i < (size_t)T_TOK; i += NT) ident[i] = (unsigned)i;
}

__device__ __forceinline__ void phase_pool(const Args& a, int vcu, int G) {
    const bf16* Z = (const bf16*)(a.ws + WS_Z); bf16* P = (bf16*)(a.ws + WS_POOLED);
    const size_t gt = (size_t)vcu * NTHR + threadIdx.x, NT = (size_t)G * NTHR;
    for (size_t idx = gt; idx < (size_t)T_TOK * 128; idx += NT) {
        const int c8 = (int)(idx & 127), t = (int)(idx >> 7), g = c8 >> 5, w = 2 << g, p = t & (SEQ - 1), nw = (p + 1) < w ? (p + 1) : w;
        const bf16* zp = Z + (size_t)t * DM + c8 * 8;
        float s[8]; v4u cur = *(const v4u*)zp;
#pragma unroll
        for (int j = 0; j < 4; ++j) { s[2 * j] = bf_lo(cur[j]); s[2 * j + 1] = bf_hi(cur[j]); }
        for (int i = 1; i < nw; ++i) { const v4u q = *(const v4u*)(zp - (size_t)i * DM);
#pragma unroll
            for (int j = 0; j < 4; ++j) { s[2 * j] += bf_lo(q[j]); s[2 * j + 1] += bf_hi(q[j]); } }
        const float inv = 1.0f / (float)nw; v4u o;
#pragma unroll
        for (int j = 0; j < 4; ++j) o[j] = cvt_pk_bf16(s[2 * j] * inv - bf_lo(cur[j]), s[2 * j + 1] * inv - bf_hi(cur[j]));
        *(v4u*)(P + (size_t)t * DM + c8 * 8) = o;
    }
}

__device__ __forceinline__ void ln_row_store(float (&v)[16], const float* g, const float* b, float* of, bf16* ob, int lane) {
    float s = 0.f;
#pragma unroll
    for (int i = 0; i < 16; ++i) s += v[i];
    const float mean = wave_sum(s) * (1.0f / DM); float s2 = 0.f;
#pragma unroll
    for (int i = 0; i < 16; ++i) { v[i] -= mean; s2 += v[i] * v[i]; }
    const float rstd = 1.0f / sqrtf(wave_sum(s2) * (1.0f / DM) + LN_EPS);
#pragma unroll
    for (int j = 0; j < 2; ++j) { const int c = 8 * lane + 512 * j;
        const f32x4 g0 = *(const f32x4*)(g + c), g1 = *(const f32x4*)(g + c + 4), b0 = *(const f32x4*)(b + c), b1 = *(const f32x4*)(b + c + 4);
        f32x4 y0, y1;
#pragma unroll
        for (int q = 0; q < 4; ++q) { y0[q] = v[8 * j + q] * rstd * g0[q] + b0[q]; y1[q] = v[8 * j + 4 + q] * rstd * g1[q] + b1[q]; }
        *(f32x4*)(of + c) = y0; *(f32x4*)(of + c + 4) = y1;
        v4u w; w.x = cvt_pk_bf16(y0[0], y0[1]); w.y = cvt_pk_bf16(y0[2], y0[3]); w.z = cvt_pk_bf16(y1[0], y1[1]); w.w = cvt_pk_bf16(y1[2], y1[3]);
        *(v4u*)(ob + c) = w; }
}

__device__ __forceinline__ void phase_lnr(const Args& a, int layer, LAS unsigned char* lds, int vcu, int G) {
    const int tid = threadIdx.x, lane = tid & 63, wave = __builtin_amdgcn_readfirstlane(tid >> 6);
    float* xf = a.out; bf16* xb = (bf16*)(a.ws + WS_XB);
    const float* lng = a.in[I_LNMG] + layer * DM; const float* lnb = a.in[I_LNMB] + layer * DM;
    const float* Wr = a.in[I_WR] + (size_t)layer * DM * NE; const float* rbias = a.in[I_RB] + layer * NE;
    unsigned* gcount = (unsigned*)(a.ws + WS_CTL) + CW_CNT + layer * 64;
    unsigned* rowtok = (unsigned*)(a.ws + WS_ROWTOK); unsigned* dest = (unsigned*)(a.ws + WS_DEST); float* gatev = (float*)(a.ws + WS_GATE);
    LAS float* part = (LAS float*)lds;
    LAS float* mb = (LAS float*)(lds + 32768);
    LAS float* gs = (LAS float*)(lds + 49152);
    LAS unsigned* hist = (LAS unsigned*)(lds + 51200);
    LAS unsigned* basep = (LAS unsigned*)(lds + 51456);
    for (int blk = vcu; blk < T_TOK / 64; blk += G) {
        const int row0 = blk * 64;
        if (tid < 64) hist[tid] = 0u;
        for (int rr = wave; rr < 64; rr += NWAVES) { float* xr = xf + (size_t)(row0 + rr) * DM; float v[16];
#pragma unroll
            for (int j = 0; j < 2; ++j) { const f32x4 p = *(const f32x4*)(xr + 8 * lane + 512 * j), q = *(const f32x4*)(xr + 8 * lane + 512 * j + 4);
#pragma unroll
                for (int i = 0; i < 4; ++i) { v[8 * j + i] = p[i]; v[8 * j + 4 + i] = q[i]; } }
            ln_row_store(v, lng, lnb, xr, xb + (size_t)(row0 + rr) * DM, lane); }
        VM_WAIT(); __syncthreads();
        { const int mt = wave & 3, kh = wave >> 2, r = lane & 15, g = lane >> 4;
          f32x4 acc[4];
#pragma unroll
          for (int n = 0; n < 4; ++n) acc[n] = (f32x4){0.f, 0.f, 0.f, 0.f};
          const float* arow = xf + (size_t)(row0 + 16 * mt + r) * DM + kh * 512 + 4 * g;
          const float* bcol = Wr + (size_t)(kh * 512 + 4 * g) * NE + r;
          for (int s = 0; s < 32; ++s) { const f32x4 av = *(const f32x4*)(arow + 16 * s);
#pragma unroll
              for (int i = 0; i < 4; ++i)
#pragma unroll
                  for (int n = 0; n < 4; ++n) { const float bvv = bcol[(size_t)(16 * s + i) * NE + 16 * n]; acc[n] = __builtin_amdgcn_mfma_f32_16x16x4f32(av[i], bvv, acc[n], 0, 0, 0); } }
#pragma unroll
          for (int n = 0; n < 4; ++n)
#pragma unroll
              for (int q = 0; q < 4; ++q) part[(kh * 64 + 16 * mt + 4 * g + q) * 64 + 16 * n + r] = acc[n][q]; }
        __syncthreads();
        { const int row = tid >> 3, grp = tid & 7; float sc[8], bsd[8];
#pragma unroll
          for (int i = 0; i < 8; ++i) { const int e = 8 * grp + i; const float lg = part[row * 64 + e] + part[(64 + row) * 64 + e]; sc[i] = 1.0f / (1.0f + __expf(-lg)); bsd[i] = sc[i] + rbias[e]; }
          float m1 = -INFINITY, m2 = -INFINITY;
#pragma unroll
          for (int i = 0; i < 8; ++i) { const float v = bsd[i]; if (v > m1) { m2 = m1; m1 = v; } else if (v > m2) m2 = v; }
          const float myg = m1 + m2; gs[row * 8 + grp] = myg;
          __syncthreads();
          int grank = 0;
#pragma unroll
          for (int g2 = 0; g2 < 8; ++g2) { const float o = gs[row * 8 + g2]; grank += (o > myg || (o == myg && g2 < grp)) ? 1 : 0; }
          const bool gsel = grank < 4;
#pragma unroll
          for (int i = 0; i < 8; ++i) mb[row * 64 + 8 * grp + i] = gsel ? bsd[i] : -INFINITY;
          __syncthreads();
          int rk[8];
#pragma unroll
          for (int i = 0; i < 8; ++i) rk[i] = 0;
#pragma unroll 4
          for (int j4 = 0; j4 < 16; ++j4) { const f32x4 q = *(const LAS f32x4*)(mb + row * 64 + 4 * j4);
#pragma unroll
              for (int jj = 0; jj < 4; ++jj) { const float vj = q[jj]; const int j = 4 * j4 + jj;
#pragma unroll
                  for (int i = 0; i < 8; ++i) rk[i] += (vj > bsd[i] || (vj == bsd[i] && j < 8 * grp + i)) ? 1 : 0; } }
          float psum = 0.f; bool sel[8];
#pragma unroll
          for (int i = 0; i < 8; ++i) { sel[i] = gsel && rk[i] < TOPK; psum += sel[i] ? sc[i] : 0.f; }
          psum += __shfl_xor(psum, 1); psum += __shfl_xor(psum, 2); psum += __shfl_xor(psum, 4);
          const float inv = ROUTED_SCALE / psum;
          unsigned loc[8];
#pragma unroll
          for (int i = 0; i < 8; ++i) { loc[i] = 0u; if (sel[i]) loc[i] = __hip_atomic_fetch_add(hist + 8 * grp + i, 1u, __ATOMIC_RELAXED, __HIP_MEMORY_SCOPE_WORKGROUP); }
          __syncthreads();
          if (tid < 64) { const unsigned h = hist[tid]; basep[tid] = h ? __hip_atomic_fetch_add(gcount + tid, h, RLX_AGENT) : 0u; }
          __syncthreads();
          const int tok = row0 + row;
#pragma unroll
          for (int i = 0; i < 8; ++i) if (sel[i]) { const int e = 8 * grp + i; const unsigned pos = basep[e] + loc[i];
              rowtok[(size_t)e * CAP + pos] = (unsigned)tok; dest[tok * 8 + rk[i]] = ((unsigned)e << 16) | pos; gatev[tok * 8 + rk[i]] = sc[i] * inv; }
        }
        __syncthreads();
    }
}

__device__ __forceinline__ pg8::MoeInfo moe_setup(const Args& a, int layer, LAS unsigned char* misc) {
    const int tid = threadIdx.x;
    unsigned* gcount = (unsigned*)(a.ws + WS_CTL) + CW_CNT + layer * 64;
    LAS unsigned* cnt = (LAS unsigned*)(misc + MI_CNT); LAS unsigned* tstart = (LAS unsigned*)(misc + MI_TSTART); LAS unsigned* ystart = (LAS unsigned*)(misc + MI_YSTART);
    LAS unsigned* ntl = (LAS unsigned*)(misc + MI_NTILES); LAS unsigned char* tile_e = (LAS unsigned char*)(misc + MI_TILE_E);
    __syncthreads();
    if (tid < 64) { unsigned c = __hip_atomic_load(gcount + tid, RLX_AGENT); if (c > (unsigned)CAP) c = CAP; cnt[tid] = c; }
    __syncthreads();
    if (tid < 64) { unsigned ts = 64u, ys = 0u; for (int e = 0; e < tid; ++e) { const unsigned c = cnt[e]; ts += (c + 255u) >> 8; ys += c; }
        tstart[tid] = ts; ystart[tid] = ys; const unsigned mynt = (cnt[tid] + 255u) >> 8;
        for (unsigned i = 0; i < mynt; ++i) if (ts + i < 640u) tile_e[ts + i] = (unsigned char)tid;
        if (tid == 63) ntl[0] = ts + mynt; }
    __syncthreads();
    pg8::MoeInfo mi; mi.cnt = cnt; mi.tstart = tstart; mi.ystart = ystart; mi.tile_e = tile_e; mi.ntiles = __builtin_amdgcn_readfirstlane((int)ntl[0]);
    if (mi.ntiles > 640) mi.ntiles = 640;
    return mi;
}

__device__ __forceinline__ void phase_combine(const Args& a, int layer, LAS unsigned char* misc, int vcu, int G) {
    const int tid = threadIdx.x, lane = tid & 63, wave = __builtin_amdgcn_readfirstlane(tid >> 6);
    const pg8::MoeInfo mi = moe_setup(a, layer, misc);
    float* xf = a.out; bf16* xb = (bf16*)(a.ws + WS_XB); const bf16* Y = (const bf16*)(a.ws + WS_Y);
    const unsigned* dest = (const unsigned*)(a.ws + WS_DEST); const float* gatev = (const float*)(a.ws + WS_GATE);
    const float* lng = a.in[I_LNFG] + layer * DM; const float* lnb = a.in[I_LNFB] + layer * DM;
    const int gw = vcu * NWAVES + wave, NGW = G * NWAVES;
    for (int row = gw; row < T_TOK; row += NGW) {
        float* xr = xf + (size_t)row * DM; float v[16];
#pragma unroll
        for (int j = 0; j < 2; ++j) { const f32x4 p = *(const f32x4*)(xr + 8 * lane + 512 * j), q = *(const f32x4*)(xr + 8 * lane + 512 * j + 4);
#pragma unroll
            for (int i = 0; i < 4; ++i) { v[8 * j + i] = p[i]; v[8 * j + 4 + i] = q[i]; } }
#pragma unroll
        for (int k = 0; k < TOPK; ++k) { const unsigned d = (unsigned)__builtin_amdgcn_readfirstlane((int)dest[row * 8 + k]); const float gk = __uint_as_float((unsigned)__builtin_amdgcn_readfirstlane((int)__float_as_uint(gatev[row * 8 + k])));
            const unsigned e = (d >> 16) & 63u, pos = d & 0xffffu; const bf16* yr = Y + (size_t)(mi.ystart[e] + pos) * DM;
#pragma unroll
            for (int j = 0; j < 2; ++j) { const v4u w = *(const v4u*)(yr + 8 * lane + 512 * j);
#pragma unroll
                for (int q = 0; q < 4; ++q) { v[8 * j + 2 * q] += gk * bf_lo(w[q]); v[8 * j + 2 * q + 1] += gk * bf_hi(w[q]); } } }
        ln_row_store(v, lng, lnb, xr, xb + (size_t)row * DM, lane);
    }
}

__device__ __forceinline__ int swz16(int row) { return (row ^ (row >> 4)) & 15; }
__device__ __forceinline__ void phase_sgu_spatial(const Args& a, LAS unsigned char* lds, int vcu, int G) {
    const int tid = threadIdx.x, lane = tid & 63, wave = __builtin_amdgcn_readfirstlane(tid >> 6), fr = lane & 15, fq = lane >> 4;
    const bf16* HS = (const bf16*)(a.ws + WS_HS); bf16* GT = (bf16*)(a.ws + WS_GATED);
    const float* lng = a.in[I_SLNG]; const float* lnb = a.in[I_SLNB]; const float* WS = a.in[I_SWS]; const float* BS = a.in[I_SBS];
    LAS unsigned char* Bs = lds;
    LAS unsigned char* As = lds + 65536;
    LAS float* stm = (LAS float*)(lds + 98304);
    LAS float* str = (LAS float*)(lds + 98304 + 512);
    for (int item = vcu; item < 512; item += G) {
        const int chunk = item >> 2, h = item & 3, t0 = chunk * 128;
        __syncthreads();
        for (int rr = 0; rr < 16; ++rr) { const int j = wave * 16 + rr; const bf16* vr = HS + (size_t)(t0 + j) * 4096 + SGU_W; float x[32]; float s = 0.f;
#pragma unroll
            for (int q = 0; q < 4; ++q) { const v4u w = *(const v4u*)(vr + 8 * lane + 512 * q);
#pragma unroll
                for (int p = 0; p < 4; ++p) { x[8 * q + 2 * p] = bf_lo(w[p]); x[8 * q + 2 * p + 1] = bf_hi(w[p]); s += x[8 * q + 2 * p] + x[8 * q + 2 * p + 1]; } }
            const float mean = wave_sum(s) * (1.0f / SGU_W); float s2 = 0.f;
#pragma unroll
            for (int i = 0; i < 32; ++i) { const float d = x[i] - mean; s2 += d * d; }
            const float rstd = 1.0f / sqrtf(wave_sum(s2) * (1.0f / SGU_W) + LN_EPS);
            if (lane == 0) { stm[j] = mean; str[j] = rstd; } }
        for (int q = tid; q < 128 * 16; q += NTHR) { const int i = q >> 4, jc = q & 15; const float* wp = WS + ((size_t)h * 128 + i) * 128 + 8 * jc;
            const f32x4 p0 = *(const f32x4*)wp, p1 = *(const f32x4*)(wp + 4); float w8[8];
#pragma unroll
            for (int z = 0; z < 4; ++z) { w8[z] = (8 * jc + z <= i) ? p0[z] : 0.f; w8[4 + z] = (8 * jc + 4 + z <= i) ? p1[z] : 0.f; }
            v4u o; o.x = cvt_pk_bf16(w8[0], w8[1]); o.y = cvt_pk_bf16(w8[2], w8[3]); o.z = cvt_pk_bf16(w8[4], w8[5]); o.w = cvt_pk_bf16(w8[6], w8[7]);
            *(LAS v4u*)(As + i * 256 + ((jc ^ swz16(i)) << 4)) = o; }
        __syncthreads();
        for (int hh = 0; hh < 2; ++hh) {
            const int cb = h * SGU_HD + hh * 256;
            for (int q = tid; q < 64 * 32; q += NTHR) { const int c8 = q & 31, jp = q >> 5, j0 = 2 * jp;
                const v4u w0 = *(const v4u*)(HS + (size_t)(t0 + j0) * 4096 + SGU_W + cb + 8 * c8), w1 = *(const v4u*)(HS + (size_t)(t0 + j0 + 1) * 4096 + SGU_W + cb + 8 * c8);
                const f32x4 g0 = *(const f32x4*)(lng + cb + 8 * c8), g1 = *(const f32x4*)(lng + cb + 8 * c8 + 4), b0 = *(const f32x4*)(lnb + cb + 8 * c8), b1 = *(const f32x4*)(lnb + cb + 8 * c8 + 4);
                const float m0 = stm[j0], r0 = str[j0], m1 = stm[j0 + 1], r1 = str[j0 + 1];
#pragma unroll
                for (int z = 0; z < 8; ++z) { const float gz = z < 4 ? g0[z & 3] : g1[z & 3], bz = z < 4 ? b0[z & 3] : b1[z & 3];
                    const float xa = (z & 1) ? bf_hi(w0[z >> 1]) : bf_lo(w0[z >> 1]), xc = (z & 1) ? bf_hi(w1[z >> 1]) : bf_lo(w1[z >> 1]);
                    const float ya = (xa - m0) * r0 * gz + bz, yc = (xc - m1) * r1 * gz + bz;
                    const int cc = 8 * c8 + z, slot = (cc & ~31) | (((cc >> 2) & 1) << 4) | (((cc >> 3) & 3) << 2) | (cc & 3);
                    *(LAS unsigned*)(Bs + slot * 256 + (((j0 >> 3) ^ swz16(slot)) << 4) + (j0 & 7) * 2) = cvt_pk_bf16(ya, yc); } }
            __syncthreads();
            f32x4 acc[8][2]; bf16x8 Bf[2][4];
#pragma unroll
            for (int n = 0; n < 2; ++n)
#pragma unroll
                for (int s = 0; s < 4; ++s) { const int slot = 32 * wave + 16 * n + fr; Bf[n][s] = *(const LAS bf16x8*)(Bs + slot * 256 + (((4 * s + fq) ^ swz16(slot)) << 4)); }
#pragma unroll
            for (int m = 0; m < 8; ++m) { acc[m][0] = (f32x4){0.f, 0.f, 0.f, 0.f}; acc[m][1] = (f32x4){0.f, 0.f, 0.f, 0.f};
#pragma unroll
                for (int s = 0; s < 4; ++s) if (s <= (m >> 1)) { const int i = 16 * m + fr; const bf16x8 af = *(const LAS bf16x8*)(As + i * 256 + (((4 * s + fq) ^ swz16(i)) << 4));
                    acc[m][0] = __builtin_amdgcn_mfma_f32_16x16x32_bf16(Bf[0][s], af, acc[m][0], 0, 0, 0); acc[m][1] = __builtin_amdgcn_mfma_f32_16x16x32_bf16(Bf[1][s], af, acc[m][1], 0, 0, 0); } }
#pragma unroll
            for (int m = 0; m < 8; ++m) { const int i = 16 * m + fr; const float bsv = BS[h * 128 + i]; const size_t t = (size_t)(t0 + i);
                const v4u uw = *(const v4u*)(HS + t * 4096 + cb + 32 * wave + 8 * fq); float o[8];
#pragma unroll
                for (int n = 0; n < 2; ++n)
#pragma unroll
                    for (int z = 0; z < 4; ++z) { const int c = 4 * n + z; const float uu = (c & 1) ? bf_hi(uw[c >> 1]) : bf_lo(uw[c >> 1]); o[c] = uu * (acc[m][n][z] + bsv); }
                v4u w; w.x = cvt_pk_bf16(o[0], o[1]); w.y = cvt_pk_bf16(o[2], o[3]); w.z = cvt_pk_bf16(o[4], o[5]); w.w = cvt_pk_bf16(o[6], o[7]);
                *(v4u*)(GT + t * SGU_W + cb + 32 * wave + 8 * fq) = w; }
            __syncthreads();
        }
    }
}

constexpr int N_PHASES = 16;
__global__ void __launch_bounds__(NTHR, 2) mk_fwd(Args args) {
    extern __shared__ __attribute__((aligned(16))) unsigned char lds_raw[];
    LAS unsigned char* lds = (LAS unsigned char*)lds_raw;
    LAS unsigned char* misc = lds + MISC_OFF;
    const int tid = threadIdx.x;
    const int G = gridDim.x; const int bx = blockIdx.x; const int vcu = (G % 8 == 0) ? (bx % 8) * (G / 8) + bx / 8 : bx;
    unsigned char* ws = args.ws;
    unsigned* ctl = (unsigned*)(ws + WS_CTL);
    if (tid < 16) ((LAS unsigned*)(misc + MI_BARW))[tid] = 0u;
    __syncthreads();
    const int lo = args.ph_lo, hi = args.ph_hi;
    XcdBarrier bar; bar.bar = ctl + CW_BAR; bar.x = 0; bar.st = nullptr;
    if (hi - lo > 1) bar = xcd_barrier_post(ctl + CW_BAR, (volatile LAS unsigned*)(misc + MI_BARW));
#ifndef PH_MASK
#define PH_MASK 0xFFFF
#endif
#define IN(k) (((PH_MASK >> (k)) & 1) && lo <= (k) && (k) < hi)
#define SEAM(k) do { if (IN(k) && IN((k) + 1)) xcd_barrier(bar); } while (0)
    using namespace pg8;
    if (IN(0)) { phase_p0(args, lds, vcu, G); } SEAM(0);
    if (IN(1)) { DenseSched S{(const char*)(ws + WS_XB), (const char*)(ws + WS_WIN), 2048u, 2048u, 0u, 64, 4, 256, G, bx};
        EpiBf16<0, false, false> E{(bf16*)(ws + WS_Z), DM, nullptr, nullptr};
        gemm_phase<EpiBf16<0, false, false>, DenseSched, false, true, true>(lds, 2048u, 2048u, 16, S, E); } SEAM(1);
    if (IN(2)) { phase_pool(args, vcu, G); } SEAM(2);
    if (IN(3)) { DenseSched S{(const char*)(ws + WS_POOLED), (const char*)(ws + WS_WGRP), 2048u, 512u, 512u, 64, 4, 256, G, bx};
        EpiBf16<0, false, true> E{(bf16*)(ws + WS_YP), DM, nullptr, args.in[I_PSCALE]};
        gemm_phase<EpiBf16<0, false, true>, DenseSched, false, true, true>(lds, 2048u, 512u, 4, S, E); } SEAM(3);
    if (IN(4)) { DenseSched S{(const char*)(ws + WS_YP), (const char*)(ws + WS_WOUT), 2048u, 2048u, 0u, 64, 4, 256, G, bx};
        EpiResid E{args.in[I_X], args.out};
        gemm_phase<EpiResid, DenseSched, false, true, true>(lds, 2048u, 2048u, 16, S, E); } SEAM(4);
#define MOE_PHASES(layer, pb) do { \
        if (IN(pb)) { phase_lnr(args, layer, lds, vcu, G); } SEAM(pb); \
        if (IN((pb) + 1)) { const MoeInfo mi = moe_setup(args, layer, misc); \
            G1Sched S{mi, (const char*)(ws + WS_XB), (const char*)(ws + WS_WGU), (const unsigned*)(ws + WS_ROWTOK), (const unsigned*)(ws + WS_IDENT), G, vcu}; \
            EpiSwiglu E{(bf16*)(ws + WS_H)}; \
            gemm_phase<EpiSwiglu, G1Sched, true, true, true>(lds, 2048u, 2048u, 16, S, E); } SEAM((pb) + 1); \
        if (IN((pb) + 2)) { const MoeInfo mi = moe_setup(args, layer, misc); \
            G2Sched S{mi, (const char*)(ws + WS_H), (const char*)(ws + WS_WDN), G, vcu}; \
            EpiDown E{(bf16*)(ws + WS_Y), args.out}; \
            gemm_phase<EpiDown, G2Sched, false, true, true>(lds, 512u, 512u, 4, S, E); } SEAM((pb) + 2); \
        if (IN((pb) + 3)) { phase_combine(args, layer, misc, vcu, G); \
            if (layer == 0) { const int wave = __builtin_amdgcn_readfirstlane(tid >> 6); __syncthreads(); convert_moe_layer(args, 1, lds, vcu * NWAVES + wave, G * NWAVES, wave, tid & 63); } } \
    } while (0)
    MOE_PHASES(0, 5); SEAM(8);
    if (IN(9)) { DenseSched S{(const char*)(ws + WS_XB), (const char*)(ws + WS_WSIN), 2048u, 2048u, 0u, 64, 16, 1024, G, bx};
        EpiBf16<1, true, false> E{(bf16*)(ws + WS_HS), 4096, args.in[I_SBIN], nullptr};
        gemm_phase<EpiBf16<1, true, false>, DenseSched, false, true, true>(lds, 2048u, 2048u, 16, S, E); } SEAM(9);
    if (IN(10)) { phase_sgu_spatial(args, lds, vcu, G); } SEAM(10);
    if (IN(11)) { DenseSched S{(const char*)(ws + WS_GATED), (const char*)(ws + WS_WSOUT), 4096u, 4096u, 0u, 64, 4, 256, G, bx};
        EpiResid E{args.out, args.out};
        gemm_phase<EpiResid, DenseSched, false, true, true>(lds, 4096u, 4096u, 32, S, E); } SEAM(11);
    MOE_PHASES(1, 12);
#undef MOE_PHASES
#undef IN
#undef SEAM
}

extern "C" void kernel_launch(void* const* d_in, const int* in_sizes, int n_in, void* d_out, int out_size, void* d_ws, size_t ws_size, hipStream_t stream) {
    static int grid = 0;
    if (grid == 0) {
        if (n_in != 24 || out_size != T_TOK * DM || ws_size < WS_END) { fprintf(stderr, "kernel_launch: unexpected shapes (n_in %d out %d ws %zu)\n", n_in, out_size, ws_size); grid = -1; return; }
        int dev = 0, cus = 0;
        if (hipGetDevice(&dev) != hipSuccess || hipDeviceGetAttribute(&cus, hipDeviceAttributeMultiprocessorCount, dev) != hipSuccess) { grid = -1; return; }
        if (hipFuncSetAttribute((const void*)mk_fwd, hipFuncAttributeMaxDynamicSharedMemorySize, LDS_BYTES) != hipSuccess) { fprintf(stderr, "kernel_launch: hipFuncSetAttribute failed\n"); grid = -1; return; }
        int per_cu = 0;
        if (hipOccupancyMaxActiveBlocksPerMultiprocessor(&per_cu, (const void*)mk_fwd, NTHR, LDS_BYTES) != hipSuccess || per_cu < 1) fprintf(stderr, "kernel_launch: occupancy query says %d\n", per_cu);
        (void)hipGetLastError();
        grid = cus;
    }
    if (grid < 0) return;
    (void)hipMemsetAsync((char*)d_ws + WS_CTL, 0, CTL_ZERO_BYTES, stream);
    Args a{};
    for (int i = 0; i < 24; ++i) a.in[i] = (const float*)d_in[i];
    a.out = (float*)d_out; a.ws = (unsigned char*)d_ws;
#if MK_PER_PHASE
    for (int p = 0; p < N_PHASES; ++p) { a.ph_lo = p; a.ph_hi = p + 1; hipLaunchKernelGGL(mk_fwd, dim3(grid), dim3(NTHR), LDS_BYTES, stream, a); }
#else
    a.ph_lo = 0; a.ph_hi = N_PHASES; hipLaunchKernelGGL(mk_fwd, dim3(grid), dim3(NTHR), LDS_BYTES, stream, a);
#endif
}
```

```cpp
#include <hip/hip_runtime.h>
#include <cstdio>
#include <cstdint>

#ifndef MK_PER_PHASE
#define MK_PER_PHASE 0
#endif

#define GAS __attribute__((address_space(1)))
#define LAS __attribute__((address_space(3)))
typedef unsigned short bf16;
typedef unsigned v4u __attribute__((ext_vector_type(4)));
typedef unsigned v2u __attribute__((ext_vector_type(2)));
typedef float f32x4 __attribute__((ext_vector_type(4)));
typedef float f32x2 __attribute__((ext_vector_type(2)));
typedef short bf16x8 __attribute__((ext_vector_type(8)));
#define RLX_AGENT __ATOMIC_RELAXED, __HIP_MEMORY_SCOPE_AGENT
#define LDS_WAIT() asm volatile("s_waitcnt lgkmcnt(0)" ::: "memory")
#define VM_WAIT() asm volatile("s_waitcnt vmcnt(0)" ::: "memory")

constexpr int T_TOK = 16384, DM = 1024, SEQ = 4096, NE = 64, TOPK = 8, EDIM = 256;
constexpr int SGU_W = 2048, SGU_HD = 512;
constexpr float ALPHA = 1.41421356237309515f;
constexpr float LN_EPS = 1e-5f, ROUTED_SCALE = 2.5f;
constexpr int CAP = 16384;
constexpr int NWAVES = 8, NTHR = 512;

constexpr size_t MiB = 1u << 20;
constexpr size_t WS_CTL = 0, CTL_ZERO_BYTES = 65536;
constexpr size_t WS_IDENT = 256 * 1024;
constexpr size_t WS_DEST = 1 * MiB;
constexpr size_t WS_GATE = WS_DEST + 512 * 1024;
constexpr size_t WS_ROWTOK = 2 * MiB;
constexpr size_t WS_WIN = 6 * MiB;
constexpr size_t WS_WGRP = 8 * MiB;
constexpr size_t WS_WOUT = WS_WGRP + 512 * 1024;
constexpr size_t WS_WSIN = WS_WOUT + 2 * MiB;
constexpr size_t WS_WSOUT = WS_WSIN + 8 * MiB;
constexpr size_t WS_WGU = 23 * MiB;
constexpr size_t WS_WDN = WS_WGU + 65 * MiB;
constexpr size_t WS_XB = 121 * MiB;
constexpr size_t WS_H = 153 * MiB;
constexpr size_t WS_Y = 233 * MiB;
constexpr size_t WS_END = 490 * MiB;
constexpr size_t WS_Z = 153 * MiB, WS_POOLED = 185 * MiB, WS_YP = 217 * MiB;
constexpr size_t WS_HS = 153 * MiB;
constexpr size_t WS_GATED = 281 * MiB;
static_assert(WS_WSOUT + 4 * MiB <= WS_WGU && WS_WDN + 33 * MiB <= WS_XB && WS_XB + 32 * MiB <= WS_H && WS_H + 80 * MiB <= WS_Y && WS_Y + 257 * MiB <= WS_END, "ws map");
constexpr int CW_TMO = 0, CW_BAR = 64, CW_CNT = 4096;

constexpr int RING_BYTES = 131072;
constexpr int MISC_OFF = RING_BYTES;
constexpr int LDS_BYTES = 147456;
constexpr int MI_BARW = 0, MI_CNT = 64, MI_TSTART = 320, MI_YSTART = 576, MI_NTILES = 832, MI_TILE_E = 1024;

__device__ __forceinline__ unsigned cvt_pk_bf16(float lo, float hi) { unsigned r; asm volatile("v_cvt_pk_bf16_f32 %0, %1, %2" : "=v"(r) : "v"(lo), "v"(hi)); return r; }
__device__ __forceinline__ float bf_lo(unsigned w) { return __uint_as_float(w << 16); }
__device__ __forceinline__ float bf_hi(unsigned w) { return __uint_as_float(w & 0xffff0000u); }
__device__ __forceinline__ float wave_sum(float v) {
#pragma unroll
    for (int o = 1; o < 64; o <<= 1) v += __shfl_xor(v, o);
    return v;
}
__device__ __forceinline__ float sigmoidf_(float x) { return __builtin_amdgcn_rcpf(1.0f + __builtin_amdgcn_exp2f(-1.4426950408889634f * x)); }
__device__ __forceinline__ float gelu_tanh(float v) { const float y = v + 0.044715f * v * v * v; return v * __builtin_amdgcn_rcpf(1.0f + __builtin_amdgcn_exp2f(-2.3022081983f * y)); }

#define XB_TMO      128
#define XB_XCNT(j)  (256  + 64 * (j))
#define XB_XSUB(j)  (1280 + 64 * (j))
#define XB_XGEN(j)  (2304 + 64 * (j))
#define XB_TOP      3328
#define XB_TOPGEN   3392
#define XCD_BAR_WORDS 3456
#define XB_SPIN_CAP (1u << 20)
__device__ __forceinline__ unsigned xb_ld(unsigned* p)              { return __hip_atomic_load(p, __ATOMIC_RELAXED, __HIP_MEMORY_SCOPE_AGENT); }
__device__ __forceinline__ unsigned xb_add(unsigned* p, unsigned v) { return __hip_atomic_fetch_add(p, v, __ATOMIC_RELAXED, __HIP_MEMORY_SCOPE_AGENT); }
__device__ __forceinline__ unsigned xb_xcc_id() { return (unsigned)__builtin_amdgcn_s_getreg((3 << 11) | 20) & 0xFu; }
#define XB_SPIN(cond, bar) do { unsigned _sp = 0; while (cond) { __builtin_amdgcn_s_sleep(1); \
    if ((++_sp & 255u) == 0u) { if (xb_ld(&(bar)[XB_TMO])) break; if (_sp > XB_SPIN_CAP) { atomicAdd(&(bar)[XB_TMO], 1u); break; } } } } while (0)
struct XcdBarrier { unsigned* bar; unsigned x; volatile LAS unsigned* st; };
__device__ __forceinline__ XcdBarrier xcd_barrier_post(unsigned* bar, volatile LAS unsigned* st) {
    XcdBarrier b; b.bar = bar; b.x = xb_xcc_id(); b.st = st;
    if (threadIdx.x == 0) (void)xb_add(&bar[XB_XCNT(b.x)], 1u);
    return b;
}
__device__ __forceinline__ void xcd_barrier_complete(unsigned* bar, unsigned x, unsigned& nloc, unsigned& nx) {
    const unsigned G = gridDim.x * gridDim.y * gridDim.z;
    unsigned sum, cnt, mine, sp = 0u;
    for (;;) {
        sum = 0u; cnt = 0u; mine = 0u;
#pragma unroll
        for (unsigned j = 0; j < 16; ++j) { const unsigned c = xb_ld(&bar[XB_XCNT(j)]); sum += c; cnt += (c > 0u) ? 1u : 0u; mine = (j == x) ? c : mine; }
        if (sum == G) break;
        __builtin_amdgcn_s_sleep(1);
        if ((++sp & 255u) == 0u) { if (xb_ld(&bar[XB_TMO])) break; if (sp > XB_SPIN_CAP) { atomicAdd(&bar[XB_TMO], 1u); break; } }
    }
    nloc = mine > 0u ? mine : 1u; nx = cnt > 0u ? cnt : 1u;
}
__device__ __forceinline__ void xcd_barrier(const XcdBarrier& b) {
    asm volatile("s_waitcnt vmcnt(0)" ::: "memory");
    __syncthreads();
    if (threadIdx.x == 0) {
        unsigned* bar = b.bar;
        __builtin_amdgcn_s_waitcnt(0);
        unsigned nloc = b.st[0], nx = b.st[1];
        if (nloc == 0u) { xcd_barrier_complete(bar, b.x, nloc, nx); b.st[0] = nloc; b.st[1] = nx; }
        const unsigned old = xb_add(&bar[XB_XSUB(b.x)], 1u);
        const unsigned gen = old / nloc;
        if (old + 1u == (gen + 1u) * nloc) {
            __builtin_amdgcn_fence(__ATOMIC_RELEASE, "agent");
            asm volatile("s_waitcnt vmcnt(0)" ::: "memory");
            const unsigned og = xb_add(&bar[XB_TOP], 1u);
            const unsigned tg = og / nx;
            if (og + 1u == (tg + 1u) * nx) xb_add(&bar[XB_TOPGEN], 1u);
            else XB_SPIN(xb_ld(&bar[XB_TOPGEN]) == tg, bar);
            __builtin_amdgcn_fence(__ATOMIC_ACQUIRE, "agent");
            xb_add(&bar[XB_XGEN(b.x)], 1u);
            asm volatile("s_waitcnt vmcnt(0)" ::: "memory");
        } else {
            XB_SPIN(xb_ld(&bar[XB_XGEN(b.x)]) == gen, bar);
            __builtin_amdgcn_fence(__ATOMIC_ACQUIRE, "agent");
            asm volatile("s_waitcnt vmcnt(0)" ::: "memory");
        }
    }
    __syncthreads();
}

namespace pg8 {
constexpr int BM = 256, BK = 64, HALF = 128, HTB = HALF * BK * 2, STAGE_BYTES = 8 * HTB, NXCD = 8, WGM = 8;
__host__ __device__ __forceinline__ int lds_byte(int r, int c) { const int st = (r >> 4) * 2 + (c >> 5), rr = r & 15, cc = c & 31, ob = rr * 64 + cc * 2; return st * 1024 + (ob ^ (((ob >> 9) & 1) << 5)); }
__host__ __device__ __forceinline__ void stage_rc(int b, int& R, int& C) { const int st = b / 1024, sb = b % 1024, swz = sb ^ (((sb >> 9) & 1) << 5); R = (st >> 1) * 16 + swz / 64; C = (st & 1) * 32 + (swz % 64) / 2; }
__host__ __device__ __forceinline__ int perm32(int rho) { const int n = rho >> 4, i = rho & 15; return 8 * (i >> 2) + 4 * n + (i & 3); }

struct Unit { const char* A; const char* B; const unsigned* gat; int nvalid; int i0, i1, i2; };

template <class Epi, class Sched, bool GATHER, bool ALIGN_EPI, bool SP2>
__device__ __forceinline__ void gemm_phase(LAS unsigned char* lds, const unsigned lda, const unsigned ldb, const int nt, const Sched& S, const Epi& E) {
    const int tid = threadIdx.x, wid = __builtin_amdgcn_readfirstlane(tid >> 6), lane = tid & 63, wr = wid >> 2, wc = wid & 3, fr = lane & 15, fq = lane >> 4;
    int R0, C0, R1, C1; stage_rc(tid * 16, R0, C0); stage_rc(tid * 16 + 8192, R1, C1);
    const int Rb0 = (R0 & ~31) + perm32(R0 & 31), Rb1 = (R1 & ~31) + perm32(R1 & 31);
    const unsigned voffB0 = (unsigned)Rb0 * ldb + (unsigned)C0 * 2u, voffB1 = (unsigned)Rb1 * ldb + (unsigned)C1 * 2u;
    const size_t hstepB = (size_t)HALF * ldb;
    const size_t kstep = (size_t)(BK * 2);
    const unsigned ldsw = (unsigned)wid * 1024u;
    const int aoff = lds_byte(wr * 64 + fr, fq * 8), boff = lds_byte(wc * 32 + fr, fq * 8);
#define PG8_SA(b, h) (((b) * 2 + (h)) * HTB)
#define PG8_SB(b, h) ((4 + (b) * 2 + (h)) * HTB)
#define PG8_STAGE(bufoff, gbase, v0, v1) do { unsigned _v0 = (v0), _v1 = (v1); asm volatile("" : "+v"(_v0), "+v"(_v1)); \
        __builtin_amdgcn_global_load_lds((const unsigned*)((const char*)(gbase) + _v0), (LAS unsigned*)(lds + (bufoff) + ldsw), 16, 0, 0); \
        __builtin_amdgcn_global_load_lds((const unsigned*)((const char*)(gbase) + _v1), (LAS unsigned*)(lds + (bufoff) + ldsw + 8192), 16, 0, 0); } while (0)
#define PG8_LDA(dst, b, h) do { _Pragma("unroll") for (int m = 0; m < 4; ++m) _Pragma("unroll") for (int k = 0; k < 2; ++k) dst[m][k] = *(const LAS bf16x8*)(lds + PG8_SA(b, h) + aoff + m * 2048 + k * 1024); } while (0)
#define PG8_LDB(dst, b, h) do { _Pragma("unroll") for (int n = 0; n < 2; ++n) _Pragma("unroll") for (int k = 0; k < 2; ++k) dst[n][k] = *(const LAS bf16x8*)(lds + PG8_SB(b, h) + boff + n * 2048 + k * 1024); } while (0)
#define PG8_MMA(ai, bj, At, Bt) do { __builtin_amdgcn_s_setprio(1); _Pragma("unroll") for (int m = 0; m < 4; ++m) _Pragma("unroll") for (int n = 0; n < 2; ++n) _Pragma("unroll") for (int k = 0; k < 2; ++k) \
        acc[ai][bj][m][n] = __builtin_amdgcn_mfma_f32_16x16x32_bf16(Bt[n][k], At[m][k], acc[ai][bj][m][n], 0, 0, 0); __builtin_amdgcn_s_setprio(0); } while (0)
#define PG8_WAIT_V(n) asm volatile("s_waitcnt vmcnt(" #n ")" ::: "memory")
#define PG8_WAIT_L(n) asm volatile("s_waitcnt lgkmcnt(" #n ")" ::: "memory")
#define PG8_BAR __builtin_amdgcn_s_barrier()
#define PG8_SCHED __builtin_amdgcn_sched_barrier(0)
#define PG8_SETV(v00, v01, v10, v11, u) do { \
        if (GATHER) { const unsigned ta = R0 < (u).nvalid ? (u).gat[R0] : 0u, tb = R1 < (u).nvalid ? (u).gat[R1] : 0u, \
                                     tc = (HALF + R0) < (u).nvalid ? (u).gat[HALF + R0] : 0u, td = (HALF + R1) < (u).nvalid ? (u).gat[HALF + R1] : 0u; \
            v00 = ta * lda + (unsigned)C0 * 2u; v01 = tb * lda + (unsigned)C1 * 2u; v10 = tc * lda + (unsigned)C0 * 2u; v11 = td * lda + (unsigned)C1 * 2u; } \
        else { v00 = (unsigned)R0 * lda + (unsigned)C0 * 2u; v01 = (unsigned)R1 * lda + (unsigned)C1 * 2u; v10 = (unsigned)(HALF + R0) * lda + (unsigned)C0 * 2u; v11 = (unsigned)(HALF + R1) * lda + (unsigned)C1 * 2u; } } while (0)
    Unit cur, nxt; int ui = 0;
    if (!S.next(0, cur)) return;
    f32x4 acc[2][2][4][2];
#pragma unroll
    for (int a = 0; a < 2; ++a)
#pragma unroll
        for (int b = 0; b < 2; ++b)
#pragma unroll
            for (int m = 0; m < 4; ++m)
#pragma unroll
                for (int n = 0; n < 2; ++n) acc[a][b][m][n] = (f32x4){0.f, 0.f, 0.f, 0.f};
    bf16x8 At[4][2], B0[2][2], B1[2][2];
    const char* cA = cur.A; const char* cB = cur.B;
    unsigned cv00, cv01, cv10, cv11;
    PG8_SETV(cv00, cv01, cv10, cv11, cur);
    if constexpr (SP2) {
        PG8_STAGE(PG8_SB(0, 0), cB, voffB0, voffB1); PG8_STAGE(PG8_SB(0, 1), cB + hstepB, voffB0, voffB1); PG8_STAGE(PG8_SA(0, 0), cA, cv00, cv01); PG8_STAGE(PG8_SA(0, 1), cA, cv10, cv11);
        if (wr == 1) PG8_BAR;
        PG8_WAIT_V(2); PG8_BAR;
        PG8_STAGE(PG8_SB(1, 0), cB + kstep, voffB0, voffB1); PG8_STAGE(PG8_SA(1, 0), cA + kstep, cv00, cv01); PG8_STAGE(PG8_SB(1, 1), cB + hstepB + kstep, voffB0, voffB1);
        PG8_WAIT_V(6); PG8_BAR;
    } else {
        PG8_STAGE(PG8_SB(0, 0), cB, voffB0, voffB1); PG8_STAGE(PG8_SA(0, 0), cA, cv00, cv01); PG8_STAGE(PG8_SB(0, 1), cB + hstepB, voffB0, voffB1); PG8_STAGE(PG8_SA(0, 1), cA, cv10, cv11);
        if (wr == 1) PG8_BAR;
        PG8_WAIT_V(4); PG8_BAR;
        PG8_STAGE(PG8_SB(1, 0), cB + kstep, voffB0, voffB1); PG8_STAGE(PG8_SA(1, 0), cA + kstep, cv00, cv01); PG8_STAGE(PG8_SB(1, 1), cB + hstepB + kstep, voffB0, voffB1);
        PG8_WAIT_V(6); PG8_BAR;
    }
    for (;;) {
        const bool has_next = S.next(ui + 1, nxt);
        const char* nA = has_next ? nxt.A : cA; const char* nB = has_next ? nxt.B : cB;
        for (int t = 0; t < nt; t += 2) {
            const bool last = (t == nt - 2);
            const char* a1 = cA + (size_t)(t + 1) * kstep;
            const char* a2 = last ? nA : cA + (size_t)(t + 2) * kstep; const char* b2 = last ? nB : cB + (size_t)(t + 2) * kstep;
            const char* a3 = a2 + kstep; const char* b3 = b2 + kstep;
            if constexpr (SP2) {
            PG8_LDB(B0, 0, 0); PG8_LDB(B1, 0, 1); PG8_SCHED; PG8_LDA(At, 0, 0); PG8_STAGE(PG8_SA(1, 1), a1, cv10, cv11);
            PG8_WAIT_V(8); PG8_WAIT_L(0); PG8_BAR; PG8_MMA(0, 0, At, B0); PG8_MMA(0, 1, At, B1); PG8_BAR; PG8_SCHED;
            if constexpr (GATHER) { if (last && has_next) { PG8_SETV(cv00, cv01, cv10, cv11, nxt); } }
            PG8_LDA(At, 0, 1); PG8_STAGE(PG8_SB(0, 0), b2, voffB0, voffB1); PG8_STAGE(PG8_SB(0, 1), b2 + hstepB, voffB0, voffB1); PG8_STAGE(PG8_SA(0, 0), a2, cv00, cv01);
            PG8_WAIT_V(8); PG8_WAIT_L(0); PG8_BAR; PG8_MMA(1, 0, At, B0); PG8_MMA(1, 1, At, B1); PG8_BAR; PG8_SCHED;
            PG8_LDB(B0, 1, 0); PG8_LDB(B1, 1, 1); PG8_SCHED; PG8_LDA(At, 1, 0); PG8_STAGE(PG8_SA(0, 1), a2, cv10, cv11);
            PG8_WAIT_V(8); PG8_WAIT_L(0); PG8_BAR; PG8_MMA(0, 0, At, B0); PG8_MMA(0, 1, At, B1); PG8_BAR; PG8_SCHED;
            PG8_LDA(At, 1, 1); PG8_STAGE(PG8_SB(1, 0), b3, voffB0, voffB1); PG8_STAGE(PG8_SB(1, 1), b3 + hstepB, voffB0, voffB1); PG8_STAGE(PG8_SA(1, 0), a3, cv00, cv01);
            PG8_WAIT_V(8); PG8_WAIT_L(0); PG8_BAR; PG8_MMA(1, 0, At, B0); PG8_MMA(1, 1, At, B1); PG8_BAR; PG8_SCHED;
            } else {
            PG8_LDB(B0, 0, 0); PG8_SCHED; PG8_LDA(At, 0, 0); PG8_STAGE(PG8_SA(1, 1), a1, cv10, cv11);
            PG8_WAIT_L(8); PG8_BAR; PG8_WAIT_L(0); PG8_MMA(0, 0, At, B0); PG8_BAR; PG8_SCHED;
            if constexpr (GATHER) { if (last && has_next) { PG8_SETV(cv00, cv01, cv10, cv11, nxt); } }
            PG8_LDB(B1, 0, 1); PG8_STAGE(PG8_SB(0, 0), b2, voffB0, voffB1);
            PG8_BAR; PG8_WAIT_L(0); PG8_MMA(0, 1, At, B1); PG8_BAR;
            PG8_LDA(At, 0, 1); PG8_STAGE(PG8_SA(0, 0), a2, cv00, cv01);
            PG8_BAR; PG8_WAIT_L(0); PG8_MMA(1, 0, At, B0); PG8_BAR; PG8_SCHED;
            PG8_STAGE(PG8_SB(0, 1), b2 + hstepB, voffB0, voffB1);
            PG8_WAIT_V(6); PG8_BAR; PG8_MMA(1, 1, At, B1); PG8_BAR;
            PG8_LDB(B0, 1, 0); PG8_SCHED; PG8_LDA(At, 1, 0); PG8_STAGE(PG8_SA(0, 1), a2, cv10, cv11);
            PG8_WAIT_L(8); PG8_BAR; PG8_WAIT_L(0); PG8_MMA(0, 0, At, B0); PG8_BAR; PG8_SCHED;
            PG8_LDB(B1, 1, 1); PG8_STAGE(PG8_SB(1, 0), b3, voffB0, voffB1);
            PG8_BAR; PG8_WAIT_L(0); PG8_MMA(0, 1, At, B1); PG8_BAR;
            PG8_LDA(At, 1, 1); PG8_STAGE(PG8_SA(1, 0), a3, cv00, cv01);
            PG8_BAR; PG8_WAIT_L(0); PG8_MMA(1, 0, At, B0); PG8_BAR; PG8_SCHED;
            PG8_STAGE(PG8_SB(1, 1), b3 + hstepB, voffB0, voffB1);
            PG8_WAIT_V(6); PG8_BAR; PG8_MMA(1, 1, At, B1); PG8_BAR;
            }
        }
        if constexpr (ALIGN_EPI) { if (wr == 0) PG8_BAR; }
        E(acc, cur, wr, wc, fr, fq);
        if (!has_next) break;
#pragma unroll
        for (int a = 0; a < 2; ++a)
#pragma unroll
            for (int b = 0; b < 2; ++b)
#pragma unroll
                for (int m = 0; m < 4; ++m)
#pragma unroll
                    for (int n = 0; n < 2; ++n) acc[a][b][m][n] = (f32x4){0.f, 0.f, 0.f, 0.f};
        cur = nxt; cA = nA; cB = nB; ++ui;
        if constexpr (ALIGN_EPI) { if (wr == 1) PG8_BAR; }
    }
    PG8_WAIT_V(0);
    if constexpr (!ALIGN_EPI) { if (wr == 0) PG8_BAR; }
    PG8_BAR;
#undef PG8_SA
#undef PG8_SB
#undef PG8_STAGE
#undef PG8_LDA
#undef PG8_LDB
#undef PG8_MMA
#undef PG8_WAIT_V
#undef PG8_WAIT_L
#undef PG8_BAR
#undef PG8_SCHED
#undef PG8_SETV
}

struct DenseSched {
    const char* A; const char* B; unsigned lda, ldb, a_pn; int nM, nN, nwg, G, c;
    __device__ __forceinline__ bool next(int i, Unit& u) const {
        const long L = (long)i * G + c; if (L >= nwg) return false;
        int wgid = (int)L; { const int q = nwg / NXCD, r = nwg % NXCD, xcd = wgid % NXCD, off = wgid / NXCD; wgid = (xcd < r ? xcd * (q + 1) : r * (q + 1) + (xcd - r) * q) + off; }
        const int nig = WGM * nN, gid = wgid / nig, fm = gid * WGM, gsz = (nM - fm) < WGM ? (nM - fm) : WGM;
        const int pm = fm + ((wgid % nig) % gsz), pn = (wgid % nig) / gsz;
        u.A = A + (size_t)pm * BM * lda + (size_t)pn * a_pn; u.B = B + (size_t)pn * BM * ldb; u.gat = nullptr; u.nvalid = BM; u.i0 = pm; u.i1 = pn; u.i2 = 0; return true;
    }
};
struct MoeInfo { const LAS unsigned* cnt; const LAS unsigned* tstart; const LAS unsigned* ystart; const LAS unsigned char* tile_e; int ntiles; };
struct G1Sched {
    MoeInfo mi; const char* XB; const char* Wgu; const unsigned* rowtok; const unsigned* ident; int G, vcu;
    __device__ __forceinline__ bool next(int i, Unit& u) const {
        const int L = i * G + vcu; if (L >= 2 * mi.ntiles) return false;
        const int tile = L >> 1, uu = L & 1; int e;
        if (tile < 64) { e = 64; u.gat = ident + tile * 256; u.nvalid = 256; }
        else { e = __builtin_amdgcn_readfirstlane((int)mi.tile_e[tile]); const int pos0 = (tile - __builtin_amdgcn_readfirstlane((int)mi.tstart[e])) * 256; u.gat = rowtok + (size_t)e * CAP + pos0; const int rem = __builtin_amdgcn_readfirstlane((int)mi.cnt[e]) - pos0; u.nvalid = rem < 256 ? rem : 256; }
        u.A = XB; u.B = Wgu + ((size_t)e * 512 + (size_t)uu * 256) * 2048; u.i0 = tile; u.i1 = uu; u.i2 = 0; return true;
    }
};
struct G2Sched {
    MoeInfo mi; const char* H; const char* Wd; int G, vcu, L0;
    __device__ __forceinline__ bool next(int i, Unit& u) const {
        const int L = i * G + vcu + L0; if (L >= 4 * mi.ntiles) return false;
        const int tile = L >> 2, pn = L & 3; int e;
        if (tile < 64) { e = 64; u.i0 = tile * 256; u.i2 = 1; u.nvalid = 256; }
        else { e = __builtin_amdgcn_readfirstlane((int)mi.tile_e[tile]); const int pos0 = (tile - __builtin_amdgcn_readfirstlane((int)mi.tstart[e])) * 256; u.i0 = __builtin_amdgcn_readfirstlane((int)mi.ystart[e]) + pos0; u.i2 = 0; const int rem = __builtin_amdgcn_readfirstlane((int)mi.cnt[e]) - pos0; u.nvalid = rem < 256 ? rem : 256; }
        u.A = H + (size_t)tile * 256 * 512; u.B = Wd + ((size_t)e * 1024 + (size_t)pn * 256) * 512; u.gat = nullptr; u.i1 = pn; return true;
    }
};

template <int ACT, bool BIAS, bool SCALE> struct EpiBf16 {
    bf16* O; int ldo; const float* bias; const float* scale;
    __device__ __forceinline__ void operator()(const f32x4 (&acc)[2][2][4][2], const Unit& u, int wr, int wc, int fr, int fq) const {
        const int row0 = u.i0 * BM + wr * 64 + fr, col0 = u.i1 * BM + wc * 32 + 8 * fq;
        f32x4 bv[2][2], sv[2][2];
#pragma unroll
        for (int bj = 0; bj < 2; ++bj)
#pragma unroll
            for (int n = 0; n < 2; ++n) { bv[bj][n] = BIAS ? *(const f32x4*)(bias + col0 + bj * HALF + 4 * n) : (f32x4){0.f, 0.f, 0.f, 0.f}; sv[bj][n] = SCALE ? *(const f32x4*)(scale + col0 + bj * HALF + 4 * n) : (f32x4){1.f, 1.f, 1.f, 1.f}; }
#pragma unroll
        for (int ai = 0; ai < 2; ++ai)
#pragma unroll
            for (int m = 0; m < 4; ++m) { bf16* rowp = O + (size_t)(row0 + ai * HALF + m * 16) * ldo + col0;
#pragma unroll
                for (int bj = 0; bj < 2; ++bj) { f32x4 v0 = acc[ai][bj][m][0] + bv[bj][0], v1 = acc[ai][bj][m][1] + bv[bj][1];
                    if (ACT == 1) {
#pragma unroll
                        for (int j = 0; j < 4; ++j) { v0[j] = gelu_tanh(v0[j]); v1[j] = gelu_tanh(v1[j]); } }
                    if (SCALE) { v0 = v0 * sv[bj][0]; v1 = v1 * sv[bj][1]; }
                    v4u w; w.x = cvt_pk_bf16(v0[0], v0[1]); w.y = cvt_pk_bf16(v0[2], v0[3]); w.z = cvt_pk_bf16(v1[0], v1[1]); w.w = cvt_pk_bf16(v1[2], v1[3]);
                    *(v4u*)(rowp + bj * HALF) = w; } }
    }
};
struct EpiResid {
    const float* base; float* out;
    __device__ __forceinline__ void operator()(const f32x4 (&acc)[2][2][4][2], const Unit& u, int wr, int wc, int fr, int fq) const {
        const int row0 = u.i0 * BM + wr * 64 + fr, col0 = u.i1 * BM + wc * 32 + 8 * fq;
#pragma unroll
        for (int ai = 0; ai < 2; ++ai)
#pragma unroll
            for (int m = 0; m < 4; ++m) { const size_t off = (size_t)(row0 + ai * HALF + m * 16) * DM + col0;
#pragma unroll
                for (int bj = 0; bj < 2; ++bj) { const f32x4 b0 = *(const f32x4*)(base + off + bj * HALF), b1 = *(const f32x4*)(base + off + bj * HALF + 4);
                    *(f32x4*)(out + off + bj * HALF) = b0 * ALPHA + acc[ai][bj][m][0]; *(f32x4*)(out + off + bj * HALF + 4) = b1 * ALPHA + acc[ai][bj][m][1]; }
                asm volatile("" ::: "memory"); }
    }
};
struct EpiSwiglu {
    bf16* H;
    __device__ __forceinline__ void operator()(const f32x4 (&acc)[2][2][4][2], const Unit& u, int wr, int wc, int fr, int fq) const {
        const int row0 = u.i0 * BM + wr * 64 + fr, col0 = u.i1 * HALF + wc * 32 + 8 * fq;
#pragma unroll
        for (int ai = 0; ai < 2; ++ai)
#pragma unroll
            for (int m = 0; m < 4; ++m) { bf16* rowp = H + (size_t)(row0 + ai * HALF + m * 16) * EDIM + col0; float h[8];
#pragma unroll
                for (int n = 0; n < 2; ++n)
#pragma unroll
                    for (int j = 0; j < 4; ++j) { const float g = acc[ai][0][m][n][j], up = acc[ai][1][m][n][j]; h[4 * n + j] = g * sigmoidf_(g) * up; }
                v4u w; w.x = cvt_pk_bf16(h[0], h[1]); w.y = cvt_pk_bf16(h[2], h[3]); w.z = cvt_pk_bf16(h[4], h[5]); w.w = cvt_pk_bf16(h[6], h[7]);
                *(v4u*)rowp = w; }
    }
};
struct EpiDown {
    bf16* Y; float* xf;
    __device__ __forceinline__ void operator()(const f32x4 (&acc)[2][2][4][2], const Unit& u, int wr, int wc, int fr, int fq) const {
        const int r0 = wr * 64 + fr, col0 = u.i1 * BM + wc * 32 + 8 * fq;
        if (u.i2) {
#pragma unroll
            for (int ai = 0; ai < 2; ++ai)
#pragma unroll
                for (int m = 0; m < 4; ++m) { const size_t off = (size_t)(u.i0 + r0 + ai * HALF + m * 16) * DM + col0;
#pragma unroll
                    for (int bj = 0; bj < 2; ++bj) { const f32x4 b0 = *(const f32x4*)(xf + off + bj * HALF), b1 = *(const f32x4*)(xf + off + bj * HALF + 4);
                        *(f32x4*)(xf + off + bj * HALF) = b0 * ALPHA + acc[ai][bj][m][0]; *(f32x4*)(xf + off + bj * HALF + 4) = b1 * ALPHA + acc[ai][bj][m][1]; }
                    asm volatile("" ::: "memory"); }
        } else {
#pragma unroll
            for (int ai = 0; ai < 2; ++ai)
#pragma unroll
                for (int m = 0; m < 4; ++m) { const int r = r0 + ai * HALF + m * 16;
                    if (r < u.nvalid) { bf16* rowp = Y + (size_t)(u.i0 + r) * DM + col0;
#pragma unroll
                        for (int bj = 0; bj < 2; ++bj) { const f32x4 v0 = acc[ai][bj][m][0], v1 = acc[ai][bj][m][1];
                            v4u w; w.x = cvt_pk_bf16(v0[0], v0[1]); w.y = cvt_pk_bf16(v0[2], v0[3]); w.z = cvt_pk_bf16(v1[0], v1[1]); w.w = cvt_pk_bf16(v1[2], v1[3]);
                            *(v4u*)(rowp + bj * HALF) = w; } } }
        }
    }
};
}

struct Args { const float* in[24]; float* out; unsigned char* ws; int ph_lo, ph_hi; };
enum { I_X = 0, I_PWIN, I_PWGRP, I_PSCALE, I_PWOUT, I_SWIN, I_SBIN, I_SLNG, I_SLNB, I_SWS, I_SBS, I_SWOUT, I_LNMG, I_LNMB, I_WR, I_RB, I_WG, I_WU, I_WD, I_SHG, I_SHU, I_SHD, I_LNFG, I_LNFB };

__device__ __forceinline__ void tr_item(const float* W, int N, int k0, int n0, bf16* dst  , int dpitch, LAS float* scr, int lane) {
#pragma unroll 8
    for (int i = 0; i < 32; ++i) { const int kk = 2 * i + (lane >> 5); scr[kk * 33 + (lane & 31)] = W[(size_t)(k0 + kk) * N + n0 + (lane & 31)]; }
    LDS_WAIT(); asm volatile("" ::: "memory");
    const int c = lane & 7;
#pragma unroll
    for (int j = 0; j < 4; ++j) { const int n = (lane >> 3) + 8 * j; const LAS float* s = scr + (8 * c) * 33 + n;
        v4u o; o.x = cvt_pk_bf16(s[0 * 33], s[1 * 33]); o.y = cvt_pk_bf16(s[2 * 33], s[3 * 33]); o.z = cvt_pk_bf16(s[4 * 33], s[5 * 33]); o.w = cvt_pk_bf16(s[6 * 33], s[7 * 33]);
        *(v4u*)(dst + (size_t)n * dpitch + 8 * c) = o; }
    LDS_WAIT(); asm volatile("" ::: "memory");
}
__device__ __forceinline__ void convert_moe_layer(const Args& a, int layer, LAS unsigned char* lds, int gw, int NGW, int wave, int lane) {
    LAS float* scr = (LAS float*)(lds + wave * 16384);
    bf16* WGU = (bf16*)(a.ws + WS_WGU); bf16* WDN = (bf16*)(a.ws + WS_WDN);
    constexpr int PER_E = 384, NIT = 65 * PER_E;
    for (int it = gw; it < NIT; it += NGW) {
        const int e = it / PER_E, r = it % PER_E;
        if (r < 256) { const int isup = r >> 7, rr = r & 127, kb = rr >> 3, nb = rr & 7, n0 = 32 * nb, k0 = 64 * kb;
            const float* src = (e < 64) ? a.in[isup ? I_WU : I_WG] + ((size_t)layer * 64 + e) * 262144 : a.in[isup ? I_SHU : I_SHG] + (size_t)layer * 262144;
            const int drow = e * 512 + (n0 >> 7) * 256 + isup * 128 + (n0 & 127);
            tr_item(src, 256, k0, n0, WGU + (size_t)drow * 1024 + k0, 1024, scr, lane);
        } else { const int rr = r - 256, kb = rr >> 5, nb = rr & 31, n0 = 32 * nb, k0 = 64 * kb;
            const float* src = (e < 64) ? a.in[I_WD] + ((size_t)layer * 64 + e) * 262144 : a.in[I_SHD] + (size_t)layer * 262144;
            tr_item(src, 1024, k0, n0, WDN + ((size_t)e * 1024 + n0) * 256 + k0, 256, scr, lane);
        }
    }
}
__device__ __forceinline__ void phase_p0(const Args& a, LAS unsigned char* lds, int vcu, int G) {
    const int tid = threadIdx.x, lane = tid & 63, wave = __builtin_amdgcn_readfirstlane(tid >> 6);
    const int gw = vcu * NWAVES + wave, NGW = G * NWAVES;
    LAS float* scr = (LAS float*)(lds + wave * 16384);
    constexpr int I_IN = 16 * 32, I_GRP = 4 * 4 * 8, I_OUT = 16 * 32, I_SIN = 16 * 128, I_SOUT = 32 * 32, NIT = I_IN + I_GRP + I_OUT + I_SIN + I_SOUT;
    for (int it = gw; it < NIT; it += NGW) {
        int r = it;
        if (r < I_IN) { const int kb = r >> 5, nb = r & 31; tr_item(a.in[I_PWIN], 1024, 64 * kb, 32 * nb, (bf16*)(a.ws + WS_WIN) + (size_t)(32 * nb) * 1024 + 64 * kb, 1024, scr, lane); continue; } r -= I_IN;
        if (r < I_GRP) { const int g = r >> 5, rr = r & 31, kb = rr >> 3, nb = rr & 7; tr_item(a.in[I_PWGRP] + (size_t)g * 65536, 256, 64 * kb, 32 * nb, (bf16*)(a.ws + WS_WGRP) + (size_t)(g * 256 + 32 * nb) * 256 + 64 * kb, 256, scr, lane); continue; } r -= I_GRP;
        if (r < I_OUT) { const int kb = r >> 5, nb = r & 31; tr_item(a.in[I_PWOUT], 1024, 64 * kb, 32 * nb, (bf16*)(a.ws + WS_WOUT) + (size_t)(32 * nb) * 1024 + 64 * kb, 1024, scr, lane); continue; } r -= I_OUT;
        if (r < I_SIN) { const int kb = r >> 7, nb = r & 127; tr_item(a.in[I_SWIN], 4096, 64 * kb, 32 * nb, (bf16*)(a.ws + WS_WSIN) + (size_t)(32 * nb) * 1024 + 64 * kb, 1024, scr, lane); continue; } r -= I_SIN;
        { const int kb = r >> 5, nb = r & 31; tr_item(a.in[I_SWOUT], 1024, 64 * kb, 32 * nb, (bf16*)(a.ws + WS_WSOUT) + (size_t)(32 * nb) * 2048 + 64 * kb, 2048, scr, lane); }
    }
    convert_moe_layer(a, 0, lds, gw, NGW, wave, lane);
    const float* x = a.in[I_X]; bf16* xb = (bf16*)(a.ws + WS_XB);
    const size_t gt = (size_t)vcu * NTHR + tid, NT = (size_t)G * NTHR;
    for (size_t i = gt; i < (size_t)T_TOK * DM / 8; i += NT) { const f32x4 p = *(const f32x4*)(x + i * 8), q = *(const f32x4*)(x + i * 8 + 4);
        v4u w; w.x = cvt_pk_bf16(p[0], p[1]); w.y = cvt_pk_bf16(p[2], p[3]); w.z = cvt_pk_bf16(q[0], q[1]); w.w = cvt_pk_bf16(q[2], q[3]); *(v4u*)(xb + i * 8) = w; }
    unsigned* ident = (unsigned*)(a.ws + WS_IDENT);
    for (size_t i = gt; i < (size_t)T_TOK; i += NT) ident[i] = (unsigned)i;
}

template <int W> __device__ __forceinline__ void pool_item(const bf16* zp, bf16* op, int p) {
    v4u q[W];
#pragma unroll
    for (int i = 0; i < W; ++i) { const int ii = i < p ? i : p; q[i] = *(const v4u*)(zp - (size_t)ii * DM); }
    float s[8];
#pragma unroll
    for (int j = 0; j < 8; ++j) s[j] = 0.f;
#pragma unroll
    for (int i = 0; i < W; ++i) { const float m = (i <= p) ? 1.0f : 0.0f;
#pragma unroll
        for (int j = 0; j < 4; ++j) { s[2 * j] += m * bf_lo(q[i][j]); s[2 * j + 1] += m * bf_hi(q[i][j]); } }
    const int nw = (p + 1) < W ? (p + 1) : W; const float inv = 1.0f / (float)nw; v4u o;
#pragma unroll
    for (int j = 0; j < 4; ++j) o[j] = cvt_pk_bf16(s[2 * j] * inv - bf_lo(q[0][j]), s[2 * j + 1] * inv - bf_hi(q[0][j]));
    *(v4u*)op = o;
}
__device__ __forceinline__ void phase_pool(const Args& a, int vcu, int G) {
    const bf16* Z = (const bf16*)(a.ws + WS_Z); bf16* P = (bf16*)(a.ws + WS_POOLED);
    const int tid = threadIdx.x, wave = tid >> 6, lane = tid & 63;
    const int gw = vcu * NWAVES + wave, NGW = G * NWAVES;
    for (int it = gw; it < T_TOK * 2; it += NGW) {
        const int t = it >> 1, c8 = (it & 1) * 64 + lane, g = c8 >> 5, p = t & (SEQ - 1);
        const bf16* zp = Z + (size_t)t * DM + c8 * 8; bf16* op = P + (size_t)t * DM + c8 * 8;
        if (g == 0) pool_item<2>(zp, op, p); else if (g == 1) pool_item<4>(zp, op, p); else if (g == 2) pool_item<8>(zp, op, p); else pool_item<16>(zp, op, p);
    }
}

template <int R> __device__ __forceinline__ void ln_rows_store(float (&v)[R][16], const float* g, const float* b, float* const (&of)[R], bf16* const (&ob)[R], int lane) {
    float s[R], s2[R];
#pragma unroll
    for (int r = 0; r < R; ++r) { s[r] = 0.f;
#pragma unroll
        for (int i = 0; i < 16; ++i) s[r] += v[r][i]; }
#pragma unroll
    for (int o = 1; o < 64; o <<= 1)
#pragma unroll
        for (int r = 0; r < R; ++r) s[r] += __shfl_xor(s[r], o);
#pragma unroll
    for (int r = 0; r < R; ++r) { const float mean = s[r] * (1.0f / DM); s2[r] = 0.f;
#pragma unroll
        for (int i = 0; i < 16; ++i) { v[r][i] -= mean; s2[r] += v[r][i] * v[r][i]; } }
#pragma unroll
    for (int o = 1; o < 64; o <<= 1)
#pragma unroll
        for (int r = 0; r < R; ++r) s2[r] += __shfl_xor(s2[r], o);
#pragma unroll
    for (int j = 0; j < 2; ++j) { const int c = 8 * lane + 512 * j;
        const f32x4 g0 = *(const f32x4*)(g + c), g1 = *(const f32x4*)(g + c + 4), b0 = *(const f32x4*)(b + c), b1 = *(const f32x4*)(b + c + 4);
#pragma unroll
        for (int r = 0; r < R; ++r) { const float rstd = 1.0f / sqrtf(s2[r] * (1.0f / DM) + LN_EPS); f32x4 y0, y1;
#pragma unroll
            for (int q = 0; q < 4; ++q) { y0[q] = v[r][8 * j + q] * rstd * g0[q] + b0[q]; y1[q] = v[r][8 * j + 4 + q] * rstd * g1[q] + b1[q]; }
            *(f32x4*)(of[r] + c) = y0; *(f32x4*)(of[r] + c + 4) = y1;
            v4u w; w.x = cvt_pk_bf16(y0[0], y0[1]); w.y = cvt_pk_bf16(y0[2], y0[3]); w.z = cvt_pk_bf16(y1[0], y1[1]); w.w = cvt_pk_bf16(y1[2], y1[3]);
            *(v4u*)(ob[r] + c) = w; } }
}

__device__ __forceinline__ void phase_lnr(const Args& a, int layer, LAS unsigned char* lds, int vcu, int G, bool dry) {
    const int tid = threadIdx.x, lane = tid & 63, wave = __builtin_amdgcn_readfirstlane(tid >> 6);
    const float* xin = a.out; float* xf = dry ? (float*)(a.ws + WS_Y) : a.out; bf16* xb = dry ? (bf16*)(a.ws + WS_Y + 72 * MiB) : (bf16*)(a.ws + WS_XB);
    const float* lng = a.in[I_LNMG] + layer * DM; const float* lnb = a.in[I_LNMB] + layer * DM;
    const float* Wr = a.in[I_WR] + (size_t)layer * DM * NE; const float* rbias = a.in[I_RB] + layer * NE;
    unsigned* gcount = (unsigned*)(a.ws + WS_CTL) + CW_CNT + layer * 64 + (dry ? 128 : 0);
    unsigned* rowtok = dry ? (unsigned*)(a.ws + WS_Y + 64 * MiB) : (unsigned*)(a.ws + WS_ROWTOK); unsigned* dest = dry ? (unsigned*)(a.ws + WS_Y + 68 * MiB) : (unsigned*)(a.ws + WS_DEST); float* gatev = dry ? (float*)(a.ws + WS_Y + 69 * MiB) : (float*)(a.ws + WS_GATE);
    LAS float* part = (LAS float*)lds;
    LAS float* mb = (LAS float*)(lds + 32768);
    LAS float* gs = (LAS float*)(lds + 49152);
    LAS unsigned* hist = (LAS unsigned*)(lds + 51200);
    LAS unsigned* basep = (LAS unsigned*)(lds + 51456);
    for (int blk = vcu; blk < T_TOK / 64; blk += G) {
        const int row0 = blk * 64;
        if (tid < 64) hist[tid] = 0u;
#pragma unroll 1
        for (int h4 = 0; h4 < 2; ++h4) { float v[4][16]; float* of[4]; bf16* ob[4];
#pragma unroll
            for (int r = 0; r < 4; ++r) { const int rr = wave * 8 + h4 * 4 + r; const float* xr = xin + (size_t)(row0 + rr) * DM; of[r] = xf + (size_t)(row0 + rr) * DM; ob[r] = xb + (size_t)(row0 + rr) * DM;
#pragma unroll
                for (int j = 0; j < 2; ++j) { const f32x4 p = *(const f32x4*)(xr + 8 * lane + 512 * j), q = *(const f32x4*)(xr + 8 * lane + 512 * j + 4);
#pragma unroll
                    for (int i = 0; i < 4; ++i) { v[r][8 * j + i] = p[i]; v[r][8 * j + 4 + i] = q[i]; } } }
            ln_rows_store<4>(v, lng, lnb, of, ob, lane); }
        VM_WAIT(); __syncthreads();
        { const int mt = wave & 3, kh = wave >> 2, r = lane & 15, g = lane >> 4;
          f32x4 acc[4];
#pragma unroll
          for (int n = 0; n < 4; ++n) acc[n] = (f32x4){0.f, 0.f, 0.f, 0.f};
          const float* arow = xf + (size_t)(row0 + 16 * mt + r) * DM + kh * 512 + 4 * g;
          const float* bcol = Wr + (size_t)(kh * 512 + 4 * g) * NE + 4 * r;
          f32x4 av = *(const f32x4*)arow, bw[4];
#pragma unroll
          for (int i = 0; i < 4; ++i) bw[i] = *(const f32x4*)(bcol + (size_t)i * NE);
          for (int s = 0; s < 32; ++s) { const int sn = s < 31 ? s + 1 : s;
              const f32x4 an = *(const f32x4*)(arow + 16 * sn); f32x4 bn[4];
#pragma unroll
              for (int i = 0; i < 4; ++i) bn[i] = *(const f32x4*)(bcol + (size_t)(16 * sn + i) * NE);
#pragma unroll
              for (int i = 0; i < 4; ++i)
#pragma unroll
                  for (int n = 0; n < 4; ++n) acc[n] = __builtin_amdgcn_mfma_f32_16x16x4f32(av[i], bw[i][n], acc[n], 0, 0, 0);
              av = an;
#pragma unroll
              for (int i = 0; i < 4; ++i) bw[i] = bn[i]; }
#pragma unroll
          for (int n = 0; n < 4; ++n)
#pragma unroll
              for (int q = 0; q < 4; ++q) part[(kh * 64 + 16 * mt + 4 * g + q) * 64 + 4 * r + n] = acc[n][q]; }
        __syncthreads();
        { const int row = tid >> 3, grp = tid & 7; float sc[8], bsd[8];
#pragma unroll
          for (int i = 0; i < 8; ++i) { const int e = 8 * grp + i; const float lg = part[row * 64 + e] + part[(64 + row) * 64 + e]; sc[i] = 1.0f / (1.0f + __expf(-lg)); bsd[i] = sc[i] + rbias[e]; }
          float m1 = -INFINITY, m2 = -INFINITY;
#pragma unroll
          for (int i = 0; i < 8; ++i) { const float v = bsd[i]; if (v > m1) { m2 = m1; m1 = v; } else if (v > m2) m2 = v; }
          const float myg = m1 + m2; gs[row * 8 + grp] = myg;
          __syncthreads();
          int grank = 0;
#pragma unroll
          for (int g2 = 0; g2 < 8; ++g2) { const float o = gs[row * 8 + g2]; grank += (o > myg || (o == myg && g2 < grp)) ? 1 : 0; }
          const bool gsel = grank < 4;
#pragma unroll
          for (int i = 0; i < 8; ++i) mb[row * 64 + 8 * grp + i] = gsel ? bsd[i] : -INFINITY;
          __syncthreads();
          int rk[8];
#pragma unroll
          for (int i = 0; i < 8; ++i) rk[i] = 0;
#pragma unroll 4
          for (int j4 = 0; j4 < 16; ++j4) { const f32x4 q = *(const LAS f32x4*)(mb + row * 64 + 4 * j4);
#pragma unroll
              for (int jj = 0; jj < 4; ++jj) { const float vj = q[jj]; const int j = 4 * j4 + jj;
#pragma unroll
                  for (int i = 0; i < 8; ++i) rk[i] += (vj > bsd[i] || (vj == bsd[i] && j < 8 * grp + i)) ? 1 : 0; } }
          float psum = 0.f; bool sel[8];
#pragma unroll
          for (int i = 0; i < 8; ++i) { sel[i] = gsel && rk[i] < TOPK; psum += sel[i] ? sc[i] : 0.f; }
          psum += __shfl_xor(psum, 1); psum += __shfl_xor(psum, 2); psum += __shfl_xor(psum, 4);
          const float inv = ROUTED_SCALE / psum;
          unsigned loc[8];
#pragma unroll
          for (int i = 0; i < 8; ++i) { loc[i] = 0u; if (sel[i]) loc[i] = __hip_atomic_fetch_add(hist + 8 * grp + i, 1u, __ATOMIC_RELAXED, __HIP_MEMORY_SCOPE_WORKGROUP); }
          __syncthreads();
          if (tid < 64) { const unsigned h = hist[tid]; basep[tid] = h ? __hip_atomic_fetch_add(gcount + tid, h, RLX_AGENT) : 0u; }
          __syncthreads();
          const int tok = row0 + row;
#pragma unroll
          for (int i = 0; i < 8; ++i) if (sel[i]) { const int e = 8 * grp + i; const unsigned pos = basep[e] + loc[i];
              rowtok[(size_t)e * CAP + pos] = (unsigned)tok; dest[tok * 8 + rk[i]] = ((unsigned)e << 16) | pos; gatev[tok * 8 + rk[i]] = sc[i] * inv; }
        }
        __syncthreads();
    }
}

__device__ __forceinline__ pg8::MoeInfo moe_setup(const Args& a, int layer, LAS unsigned char* misc) {
    const int tid = threadIdx.x;
    unsigned* gcount = (unsigned*)(a.ws + WS_CTL) + CW_CNT + layer * 64;
    LAS unsigned* cnt = (LAS unsigned*)(misc + MI_CNT); LAS unsigned* tstart = (LAS unsigned*)(misc + MI_TSTART); LAS unsigned* ystart = (LAS unsigned*)(misc + MI_YSTART);
    LAS unsigned* ntl = (LAS unsigned*)(misc + MI_NTILES); LAS unsigned char* tile_e = (LAS unsigned char*)(misc + MI_TILE_E);
    __syncthreads();
    if (tid < 64) { unsigned c = __hip_atomic_load(gcount + tid, RLX_AGENT); if (c > (unsigned)CAP) c = CAP; cnt[tid] = c; }
    __syncthreads();
    if (tid < 64) { unsigned ts = 64u, ys = 0u; for (int e = 0; e < tid; ++e) { const unsigned c = cnt[e]; ts += (c + 255u) >> 8; ys += c; }
        tstart[tid] = ts; ystart[tid] = ys; const unsigned mynt = (cnt[tid] + 255u) >> 8;
        for (unsigned i = 0; i < mynt; ++i) if (ts + i < 640u) tile_e[ts + i] = (unsigned char)tid;
        if (tid == 63) ntl[0] = ts + mynt; }
    __syncthreads();
    pg8::MoeInfo mi; mi.cnt = cnt; mi.tstart = tstart; mi.ystart = ystart; mi.tile_e = tile_e; mi.ntiles = __builtin_amdgcn_readfirstlane((int)ntl[0]);
    if (mi.ntiles > 640) mi.ntiles = 640;
    return mi;
}

__device__ __forceinline__ void phase_combine(const Args& a, int layer, LAS unsigned char* misc, int vcu, int G, bool dry) {
    const int tid = threadIdx.x, lane = tid & 63, wave = __builtin_amdgcn_readfirstlane(tid >> 6);
    const pg8::MoeInfo mi = moe_setup(a, layer, misc);
    float* xf = a.out; bf16* xb = (bf16*)(a.ws + WS_XB); const bf16* Y = (const bf16*)(a.ws + WS_Y);
    const unsigned* dest = (const unsigned*)(a.ws + WS_DEST); const float* gatev = (const float*)(a.ws + WS_GATE);
    const float* lng = a.in[I_LNFG] + layer * DM; const float* lnb = a.in[I_LNFB] + layer * DM;
    const int gw = vcu * NWAVES + wave, NGW = G * NWAVES;
#pragma unroll 1
    for (int rowa = gw; rowa < T_TOK; rowa += 2 * NGW) {
        float v[2][16]; float* of[2]; bf16* ob[2]; unsigned d[2][TOPK]; float gk[2][TOPK];
#pragma unroll
        for (int r = 0; r < 2; ++r) { const int row = rowa + r * NGW;
#pragma unroll
            for (int k = 0; k < TOPK; ++k) { d[r][k] = dest[row * 8 + k]; gk[r][k] = gatev[row * 8 + k]; } }
#pragma unroll
        for (int r = 0; r < 2; ++r) { const int row = rowa + r * NGW; float* xr = xf + (size_t)row * DM; of[r] = dry ? (float*)(a.ws + WS_H) + (size_t)row * DM : xr; ob[r] = xb + (size_t)row * DM;
#pragma unroll
            for (int j = 0; j < 2; ++j) { const f32x4 p = *(const f32x4*)(xr + 8 * lane + 512 * j), q = *(const f32x4*)(xr + 8 * lane + 512 * j + 4);
#pragma unroll
                for (int i = 0; i < 4; ++i) { v[r][8 * j + i] = p[i]; v[r][8 * j + 4 + i] = q[i]; } } }
#pragma unroll
        for (int r = 0; r < 2; ++r)
#pragma unroll
            for (int k = 0; k < TOPK; ++k) { const unsigned dd = (unsigned)__builtin_amdgcn_readfirstlane((int)d[r][k]); const float g = __uint_as_float((unsigned)__builtin_amdgcn_readfirstlane((int)__float_as_uint(gk[r][k])));
                const unsigned e = (dd >> 16) & 63u, pos = dd & 0xffffu; const bf16* yr = Y + (size_t)(mi.ystart[e] + pos) * DM;
#pragma unroll
                for (int j = 0; j < 2; ++j) { const v4u w = *(const v4u*)(yr + 8 * lane + 512 * j);
#pragma unroll
                    for (int q = 0; q < 4; ++q) { v[r][8 * j + 2 * q] += g * bf_lo(w[q]); v[r][8 * j + 2 * q + 1] += g * bf_hi(w[q]); } } }
        ln_rows_store<2>(v, lng, lnb, of, ob, lane);
    }
}

__device__ __forceinline__ int swz16(int row) { return (row ^ (row >> 4)) & 15; }
__device__ __forceinline__ void phase_sgu_spatial(const Args& a, LAS unsigned char* lds, int vcu, int G) {
    const int tid = threadIdx.x, lane = tid & 63, wave = __builtin_amdgcn_readfirstlane(tid >> 6), fr = lane & 15, fq = lane >> 4;
    const bf16* HS = (const bf16*)(a.ws + WS_HS); bf16* GT = (bf16*)(a.ws + WS_GATED);
    const float* lng = a.in[I_SLNG]; const float* lnb = a.in[I_SLNB]; const float* WS = a.in[I_SWS]; const float* BS = a.in[I_SBS];
    LAS unsigned char* Bs = lds;
    LAS unsigned char* As = lds + 65536;
    LAS float* stm = (LAS float*)(lds + 98304);
    LAS float* str = (LAS float*)(lds + 98304 + 512);
    for (int item = vcu; item < 512; item += G) {
        const int chunk = item >> 2, h = item & 3, t0 = chunk * 128;
        __syncthreads();
        for (int rr = 0; rr < 16; ++rr) { const int j = wave * 16 + rr; const bf16* vr = HS + (size_t)(t0 + j) * 4096 + SGU_W; float x[32]; float s = 0.f;
#pragma unroll
            for (int q = 0; q < 4; ++q) { const v4u w = *(const v4u*)(vr + 8 * lane + 512 * q);
#pragma unroll
                for (int p = 0; p < 4; ++p) { x[8 * q + 2 * p] = bf_lo(w[p]); x[8 * q + 2 * p + 1] = bf_hi(w[p]); s += x[8 * q + 2 * p] + x[8 * q + 2 * p + 1]; } }
            const float mean = wave_sum(s) * (1.0f / SGU_W); float s2 = 0.f;
#pragma unroll
            for (int i = 0; i < 32; ++i) { const float d = x[i] - mean; s2 += d * d; }
            const float rstd = 1.0f / sqrtf(wave_sum(s2) * (1.0f / SGU_W) + LN_EPS);
            if (lane == 0) { stm[j] = mean; str[j] = rstd; } }
        for (int q = tid; q < 128 * 16; q += NTHR) { const int i = q >> 4, jc = q & 15; const float* wp = WS + ((size_t)h * 128 + i) * 128 + 8 * jc;
            const f32x4 p0 = *(const f32x4*)wp, p1 = *(const f32x4*)(wp + 4); float w8[8];
#pragma unroll
            for (int z = 0; z < 4; ++z) { w8[z] = (8 * jc + z <= i) ? p0[z] : 0.f; w8[4 + z] = (8 * jc + 4 + z <= i) ? p1[z] : 0.f; }
            v4u o; o.x = cvt_pk_bf16(w8[0], w8[1]); o.y = cvt_pk_bf16(w8[2], w8[3]); o.z = cvt_pk_bf16(w8[4], w8[5]); o.w = cvt_pk_bf16(w8[6], w8[7]);
            *(LAS v4u*)(As + i * 256 + ((jc ^ swz16(i)) << 4)) = o; }
        __syncthreads();
        for (int hh = 0; hh < 2; ++hh) {
            const int cb = h * SGU_HD + hh * 256;
            for (int q = tid; q < 64 * 32; q += NTHR) { const int c8 = q & 31, jp = q >> 5, j0 = 2 * jp;
                const v4u w0 = *(const v4u*)(HS + (size_t)(t0 + j0) * 4096 + SGU_W + cb + 8 * c8), w1 = *(const v4u*)(HS + (size_t)(t0 + j0 + 1) * 4096 + SGU_W + cb + 8 * c8);
                const f32x4 g0 = *(const f32x4*)(lng + cb + 8 * c8), g1 = *(const f32x4*)(lng + cb + 8 * c8 + 4), b0 = *(const f32x4*)(lnb + cb + 8 * c8), b1 = *(const f32x4*)(lnb + cb + 8 * c8 + 4);
                const float m0 = stm[j0], r0 = str[j0], m1 = stm[j0 + 1], r1 = str[j0 + 1];
#pragma unroll
                for (int z = 0; z < 8; ++z) { const float gz = z < 4 ? g0[z & 3] : g1[z & 3], bz = z < 4 ? b0[z & 3] : b1[z & 3];
                    const float xa = (z & 1) ? bf_hi(w0[z >> 1]) : bf_lo(w0[z >> 1]), xc = (z & 1) ? bf_hi(w1[z >> 1]) : bf_lo(w1[z >> 1]);
                    const float ya = (xa - m0) * r0 * gz + bz, yc = (xc - m1) * r1 * gz + bz;
                    const int cc = 8 * c8 + z, slot = (cc & ~31) | (((cc >> 2) & 1) << 4) | (((cc >> 3) & 3) << 2) | (cc & 3);
                    *(LAS unsigned*)(Bs + slot * 256 + (((j0 >> 3) ^ swz16(slot)) << 4) + (j0 & 7) * 2) = cvt_pk_bf16(ya, yc); } }
            __syncthreads();
            f32x4 acc[8][2]; bf16x8 Bf[2][4];
#pragma unroll
            for (int n = 0; n < 2; ++n)
#pragma unroll
                for (int s = 0; s < 4; ++s) { const int slot = 32 * wave + 16 * n + fr; Bf[n][s] = *(const LAS bf16x8*)(Bs + slot * 256 + (((4 * s + fq) ^ swz16(slot)) << 4)); }
#pragma unroll
            for (int m = 0; m < 8; ++m) { acc[m][0] = (f32x4){0.f, 0.f, 0.f, 0.f}; acc[m][1] = (f32x4){0.f, 0.f, 0.f, 0.f};
#pragma unroll
                for (int s = 0; s < 4; ++s) if (s <= (m >> 1)) { const int i = 16 * m + fr; const bf16x8 af = *(const LAS bf16x8*)(As + i * 256 + (((4 * s + fq) ^ swz16(i)) << 4));
                    acc[m][0] = __builtin_amdgcn_mfma_f32_16x16x32_bf16(Bf[0][s], af, acc[m][0], 0, 0, 0); acc[m][1] = __builtin_amdgcn_mfma_f32_16x16x32_bf16(Bf[1][s], af, acc[m][1], 0, 0, 0); } }
#pragma unroll
            for (int m = 0; m < 8; ++m) { const int i = 16 * m + fr; const float bsv = BS[h * 128 + i]; const size_t t = (size_t)(t0 + i);
                const v4u uw = *(const v4u*)(HS + t * 4096 + cb + 32 * wave + 8 * fq); float o[8];
#pragma unroll
                for (int n = 0; n < 2; ++n)
#pragma unroll
                    for (int z = 0; z < 4; ++z) { const int c = 4 * n + z; const float uu = (c & 1) ? bf_hi(uw[c >> 1]) : bf_lo(uw[c >> 1]); o[c] = uu * (acc[m][n][z] + bsv); }
                v4u w; w.x = cvt_pk_bf16(o[0], o[1]); w.y = cvt_pk_bf16(o[2], o[3]); w.z = cvt_pk_bf16(o[4], o[5]); w.w = cvt_pk_bf16(o[6], o[7]);
                *(v4u*)(GT + t * SGU_W + cb + 32 * wave + 8 * fq) = w; }
            __syncthreads();
        }
    }
}

constexpr int N_PHASES = 16;
__global__ void __launch_bounds__(NTHR, 2) mk_fwd(Args args) {
    extern __shared__ __attribute__((aligned(16))) unsigned char lds_raw[];
    LAS unsigned char* lds = (LAS unsigned char*)lds_raw;
    LAS unsigned char* misc = lds + MISC_OFF;
    const int tid = threadIdx.x;
    const int G = gridDim.x; const int bx = blockIdx.x; const int vcu = (G % 8 == 0) ? (bx % 8) * (G / 8) + bx / 8 : bx;
    unsigned char* ws = args.ws;
    unsigned* ctl = (unsigned*)(ws + WS_CTL);
    if (tid < 16) ((LAS unsigned*)(misc + MI_BARW))[tid] = 0u;
    __syncthreads();
    const int lo = args.ph_lo, hi = args.ph_hi;
    XcdBarrier bar; bar.bar = ctl + CW_BAR; bar.x = 0; bar.st = nullptr;
    if (hi - lo > 1) bar = xcd_barrier_post(ctl + CW_BAR, (volatile LAS unsigned*)(misc + MI_BARW));
#ifndef PH_MASK
#define PH_MASK 0xFFFF
#endif
#define IN(k) (((PH_MASK >> (k)) & 1) && lo <= (k) && (k) < hi)
#ifndef REP_PH
#define REP_PH -1
#define REP_N 1
#endif
#define NREP(k) ((k) == REP_PH ? REP_N : 1)
#define RUN(k) if (IN(k)) for (int rep = 0; rep < NREP(k); ++rep)
#define DRY(k) (rep + 1 < NREP(k))
#define SEAM(k) do { if (IN(k) && IN((k) + 1)) xcd_barrier(bar); } while (0)
    using namespace pg8;
    RUN(0) { phase_p0(args, lds, vcu, G); } SEAM(0);
    RUN(1) { DenseSched S{(const char*)(ws + WS_XB), (const char*)(ws + WS_WIN), 2048u, 2048u, 0u, 64, 4, 256, G, bx};
        EpiBf16<0, false, false> E{(bf16*)(ws + WS_Z), DM, nullptr, nullptr};
        gemm_phase<EpiBf16<0, false, false>, DenseSched, false, true, true>(lds, 2048u, 2048u, 16, S, E); } SEAM(1);
    RUN(2) { phase_pool(args, vcu, G); } SEAM(2);
    if (REP_PH == 100 && hi - lo > 1) for (int i = 0; i < REP_N; ++i) xcd_barrier(bar);
    RUN(3) { DenseSched S{(const char*)(ws + WS_POOLED), (const char*)(ws + WS_WGRP), 2048u, 512u, 512u, 64, 4, 256, G, bx};
        EpiBf16<0, false, true> E{(bf16*)(ws + WS_YP), DM, nullptr, args.in[I_PSCALE]};
        gemm_phase<EpiBf16<0, false, true>, DenseSched, false, true, true>(lds, 2048u, 512u, 4, S, E); } SEAM(3);
    RUN(4) { DenseSched S{(const char*)(ws + WS_YP), (const char*)(ws + WS_WOUT), 2048u, 2048u, 0u, 64, 4, 256, G, bx};
        EpiResid E{args.in[I_X], args.out};
        gemm_phase<EpiResid, DenseSched, false, true, true>(lds, 2048u, 2048u, 16, S, E); } SEAM(4);
#define MOE_PHASES(layer, pb) do { \
        RUN(pb) { phase_lnr(args, layer, lds, vcu, G, DRY(pb)); } SEAM(pb); \
        RUN((pb) + 1) { const MoeInfo mi = moe_setup(args, layer, misc); \
            G1Sched S{mi, (const char*)(ws + WS_XB), (const char*)(ws + WS_WGU), (const unsigned*)(ws + WS_ROWTOK), (const unsigned*)(ws + WS_IDENT), G, vcu}; \
            EpiSwiglu E{(bf16*)(ws + WS_H)}; \
            gemm_phase<EpiSwiglu, G1Sched, true, true, true>(lds, 2048u, 2048u, 16, S, E); } SEAM((pb) + 1); \
        if (IN((pb) + 2) && REP_PH == (pb) + 2) { const MoeInfo mi = moe_setup(args, layer, misc); \
            G2Sched S{mi, (const char*)(ws + WS_H), (const char*)(ws + WS_WDN), G, vcu, 256}; \
            EpiDown E{(bf16*)(ws + WS_Y), args.out}; \
            gemm_phase<EpiDown, G2Sched, false, true, true>(lds, 512u, 512u, 4, S, E); } \
        if (IN((pb) + 2)) { const MoeInfo mi = moe_setup(args, layer, misc); \
            G2Sched S{mi, (const char*)(ws + WS_H), (const char*)(ws + WS_WDN), G, vcu, 0}; \
            EpiDown E{(bf16*)(ws + WS_Y), args.out}; \
            gemm_phase<EpiDown, G2Sched, false, true, true>(lds, 512u, 512u, 4, S, E); } SEAM((pb) + 2); \
        RUN((pb) + 3) { phase_combine(args, layer, misc, vcu, G, DRY((pb) + 3)); \
            if (layer == 0 && !DRY((pb) + 3)) { const int wave = __builtin_amdgcn_readfirstlane(tid >> 6); __syncthreads(); convert_moe_layer(args, 1, lds, vcu * NWAVES + wave, G * NWAVES, wave, tid & 63); } } \
    } while (0)
    MOE_PHASES(0, 5); SEAM(8);
    RUN(9) { DenseSched S{(const char*)(ws + WS_XB), (const char*)(ws + WS_WSIN), 2048u, 2048u, 0u, 64, 16, 1024, G, bx};
        EpiBf16<1, true, false> E{(bf16*)(ws + WS_HS), 4096, args.in[I_SBIN], nullptr};
        gemm_phase<EpiBf16<1, true, false>, DenseSched, false, true, true>(lds, 2048u, 2048u, 16, S, E); } SEAM(9);
    RUN(10) { phase_sgu_spatial(args, lds, vcu, G); } SEAM(10);
    RUN(11) { DenseSched S{(const char*)(ws + WS_GATED), (const char*)(ws + WS_WSOUT), 4096u, 4096u, 0u, 64, 4, 256, G, bx};
        EpiResid E{args.out, DRY(11) ? (float*)(ws + WS_HS) : args.out};
        gemm_phase<EpiResid, DenseSched, false, true, true>(lds, 4096u, 4096u, 32, S, E); } SEAM(11);
    MOE_PHASES(1, 12);
#undef MOE_PHASES
#undef IN
#undef SEAM
}

extern "C" void kernel_launch(void* const* d_in, const int* in_sizes, int n_in, void* d_out, int out_size, void* d_ws, size_t ws_size, hipStream_t stream) {
    static int grid = 0;
    if (grid == 0) {
        if (n_in != 24 || out_size != T_TOK * DM || ws_size < WS_END) { fprintf(stderr, "kernel_launch: unexpected shapes (n_in %d out %d ws %zu)\n", n_in, out_size, ws_size); grid = -1; return; }
        int dev = 0, cus = 0;
        if (hipGetDevice(&dev) != hipSuccess || hipDeviceGetAttribute(&cus, hipDeviceAttributeMultiprocessorCount, dev) != hipSuccess) { grid = -1; return; }
        if (hipFuncSetAttribute((const void*)mk_fwd, hipFuncAttributeMaxDynamicSharedMemorySize, LDS_BYTES) != hipSuccess) { fprintf(stderr, "kernel_launch: hipFuncSetAttribute failed\n"); grid = -1; return; }
        int per_cu = 0;
        if (hipOccupancyMaxActiveBlocksPerMultiprocessor(&per_cu, (const void*)mk_fwd, NTHR, LDS_BYTES) != hipSuccess || per_cu < 1) fprintf(stderr, "kernel_launch: occupancy query says %d\n", per_cu);
        (void)hipGetLastError();
        grid = cus;
    }
    if (grid < 0) return;
    (void)hipMemsetAsync((char*)d_ws + WS_CTL, 0, CTL_ZERO_BYTES, stream);
    Args a{};
    for (int i = 0; i < 24; ++i) a.in[i] = (const float*)d_in[i];
    a.out = (float*)d_out; a.ws = (unsigned char*)d_ws;
#if MK_PER_PHASE
    for (int p = 0; p < N_PHASES; ++p) { a.ph_lo = p; a.ph_hi = p + 1; hipLaunchKernelGGL(mk_fwd, dim3(grid), dim3(NTHR), LDS_BYTES, stream, a); }
#else
    a.ph_lo = 0; a.ph_hi = N_PHASES; hipLaunchKernelGGL(mk_fwd, dim3(grid), dim3(NTHR), LDS_BYTES, stream, a);
#endif
}
```

```cpp
#include <hip/hip_runtime.h>
#include <cstdio>
#include <cstdint>

#ifndef MK_PER_PHASE
#define MK_PER_PHASE 0
#endif

#define GAS __attribute__((address_space(1)))
#define LAS __attribute__((address_space(3)))
typedef unsigned short bf16;
typedef unsigned v4u __attribute__((ext_vector_type(4)));
typedef unsigned v2u __attribute__((ext_vector_type(2)));
typedef float f32x4 __attribute__((ext_vector_type(4)));
typedef float f32x2 __attribute__((ext_vector_type(2)));
typedef short bf16x8 __attribute__((ext_vector_type(8)));
#define RLX_AGENT __ATOMIC_RELAXED, __HIP_MEMORY_SCOPE_AGENT
#define LDS_WAIT() asm volatile("s_waitcnt lgkmcnt(0)" ::: "memory")
#define VM_WAIT() asm volatile("s_waitcnt vmcnt(0)" ::: "memory")

constexpr int T_TOK = 16384, DM = 1024, SEQ = 4096, NE = 64, TOPK = 8, EDIM = 256;
constexpr int SGU_W = 2048, SGU_HD = 512;
constexpr float ALPHA = 1.41421356237309515f;
constexpr float LN_EPS = 1e-5f, ROUTED_SCALE = 2.5f;
constexpr int CAP = 16384;
constexpr int NWAVES = 8, NTHR = 512;

constexpr size_t MiB = 1u << 20;
constexpr size_t WS_CTL = 0, CTL_ZERO_BYTES = 65536;
constexpr size_t WS_IDENT = 256 * 1024;
constexpr size_t WS_DEST = 1 * MiB;
constexpr size_t WS_GATE = WS_DEST + 512 * 1024;
constexpr size_t WS_ROWTOK = 2 * MiB;
constexpr size_t WS_WIN = 6 * MiB;
constexpr size_t WS_WGRP = 8 * MiB;
constexpr size_t WS_WOUT = WS_WGRP + 512 * 1024;
constexpr size_t WS_WSIN = WS_WOUT + 2 * MiB;
constexpr size_t WS_WSOUT = WS_WSIN + 8 * MiB;
constexpr size_t WS_WRT = WS_WSOUT + 4 * MiB;
constexpr size_t WS_WGU = 23 * MiB;
constexpr size_t WS_WDN = WS_WGU + 65 * MiB;
constexpr size_t WS_XB = 121 * MiB;
constexpr size_t WS_H = 153 * MiB;
constexpr size_t WS_Y = 233 * MiB;
constexpr size_t WS_END = 490 * MiB;
constexpr size_t WS_Z = 153 * MiB, WS_POOLED = 185 * MiB, WS_YP = 217 * MiB;
constexpr size_t WS_HS = 153 * MiB;
constexpr size_t WS_GATED = 281 * MiB;
static_assert(WS_WRT + 512 * 1024 <= WS_WGU && WS_WDN + 33 * MiB <= WS_XB && WS_XB + 32 * MiB <= WS_H && WS_H + 80 * MiB <= WS_Y && WS_Y + 257 * MiB <= WS_END, "ws map");
constexpr int CW_TMO = 0, CW_BAR = 64, CW_CNT = 4096;

constexpr int RING_BYTES = 131072;
constexpr int MISC_OFF = RING_BYTES;
constexpr int LDS_BYTES = 147456;
constexpr int MI_BARW = 0, MI_CNT = 64, MI_TSTART = 320, MI_YSTART = 576, MI_NTILES = 832, MI_TILE_E = 1024;

__device__ __forceinline__ unsigned cvt_pk_bf16(float lo, float hi) { unsigned r; asm volatile("v_cvt_pk_bf16_f32 %0, %1, %2" : "=v"(r) : "v"(lo), "v"(hi)); return r; }
__device__ __forceinline__ float bf_lo(unsigned w) { return __uint_as_float(w << 16); }
__device__ __forceinline__ float bf_hi(unsigned w) { return __uint_as_float(w & 0xffff0000u); }
__device__ __forceinline__ float wave_sum(float v) {
#pragma unroll
    for (int o = 1; o < 64; o <<= 1) v += __shfl_xor(v, o);
    return v;
}
__device__ __forceinline__ float sigmoidf_(float x) { return __builtin_amdgcn_rcpf(1.0f + __builtin_amdgcn_exp2f(-1.4426950408889634f * x)); }
__device__ __forceinline__ float gelu_tanh(float v) { const float y = v + 0.044715f * v * v * v; return v * __builtin_amdgcn_rcpf(1.0f + __builtin_amdgcn_exp2f(-2.3022081983f * y)); }

#define XB_TMO      128
#define XB_XCNT(j)  (256  + 64 * (j))
#define XB_XSUB(j)  (1280 + 64 * (j))
#define XB_XGEN(j)  (2304 + 64 * (j))
#define XB_TOP      3328
#define XB_TOPGEN   3392
#define XCD_BAR_WORDS 3456
#define XB_SPIN_CAP (1u << 20)
__device__ __forceinline__ unsigned xb_ld(unsigned* p)              { return __hip_atomic_load(p, __ATOMIC_RELAXED, __HIP_MEMORY_SCOPE_AGENT); }
__device__ __forceinline__ unsigned xb_add(unsigned* p, unsigned v) { return __hip_atomic_fetch_add(p, v, __ATOMIC_RELAXED, __HIP_MEMORY_SCOPE_AGENT); }
__device__ __forceinline__ unsigned xb_xcc_id() { return (unsigned)__builtin_amdgcn_s_getreg((3 << 11) | 20) & 0xFu; }
#define XB_SPIN(cond, bar) do { unsigned _sp = 0; while (cond) { __builtin_amdgcn_s_sleep(1); \
    if ((++_sp & 255u) == 0u) { if (xb_ld(&(bar)[XB_TMO])) break; if (_sp > XB_SPIN_CAP) { atomicAdd(&(bar)[XB_TMO], 1u); break; } } } } while (0)
struct XcdBarrier { unsigned* bar; unsigned x; volatile LAS unsigned* st; };
__device__ __forceinline__ XcdBarrier xcd_barrier_post(unsigned* bar, volatile LAS unsigned* st) {
    XcdBarrier b; b.bar = bar; b.x = xb_xcc_id(); b.st = st;
    if (threadIdx.x == 0) (void)xb_add(&bar[XB_XCNT(b.x)], 1u);
    return b;
}
__device__ __forceinline__ void xcd_barrier_complete(unsigned* bar, unsigned x, unsigned& nloc, unsigned& nx) {
    const unsigned G = gridDim.x * gridDim.y * gridDim.z;
    unsigned sum, cnt, mine, sp = 0u;
    for (;;) {
        sum = 0u; cnt = 0u; mine = 0u;
#pragma unroll
        for (unsigned j = 0; j < 16; ++j) { const unsigned c = xb_ld(&bar[XB_XCNT(j)]); sum += c; cnt += (c > 0u) ? 1u : 0u; mine = (j == x) ? c : mine; }
        if (sum == G) break;
        __builtin_amdgcn_s_sleep(1);
        if ((++sp & 255u) == 0u) { if (xb_ld(&bar[XB_TMO])) break; if (sp > XB_SPIN_CAP) { atomicAdd(&bar[XB_TMO], 1u); break; } }
    }
    nloc = mine > 0u ? mine : 1u; nx = cnt > 0u ? cnt : 1u;
}
__device__ __forceinline__ void xcd_barrier(const XcdBarrier& b) {
    asm volatile("s_waitcnt vmcnt(0)" ::: "memory");
    __syncthreads();
    if (threadIdx.x == 0) {
        unsigned* bar = b.bar;
        __builtin_amdgcn_s_waitcnt(0);
        unsigned nloc = b.st[0], nx = b.st[1];
        if (nloc == 0u) { xcd_barrier_complete(bar, b.x, nloc, nx); b.st[0] = nloc; b.st[1] = nx; }
        const unsigned old = xb_add(&bar[XB_XSUB(b.x)], 1u);
        const unsigned gen = old / nloc;
        if (old + 1u == (gen + 1u) * nloc) {
            __builtin_amdgcn_fence(__ATOMIC_RELEASE, "agent");
            asm volatile("s_waitcnt vmcnt(0)" ::: "memory");
            const unsigned og = xb_add(&bar[XB_TOP], 1u);
            const unsigned tg = og / nx;
            if (og + 1u == (tg + 1u) * nx) xb_add(&bar[XB_TOPGEN], 1u);
            else XB_SPIN(xb_ld(&bar[XB_TOPGEN]) == tg, bar);
            __builtin_amdgcn_fence(__ATOMIC_ACQUIRE, "agent");
            xb_add(&bar[XB_XGEN(b.x)], 1u);
            asm volatile("s_waitcnt vmcnt(0)" ::: "memory");
        } else {
            XB_SPIN(xb_ld(&bar[XB_XGEN(b.x)]) == gen, bar);
            __builtin_amdgcn_fence(__ATOMIC_ACQUIRE, "agent");
            asm volatile("s_waitcnt vmcnt(0)" ::: "memory");
        }
    }
    __syncthreads();
}

namespace pg8 {
constexpr int BM = 256, BK = 64, HALF = 128, HTB = HALF * BK * 2, STAGE_BYTES = 8 * HTB, NXCD = 8, WGM = 8;
__host__ __device__ __forceinline__ int lds_byte(int r, int c) { const int st = (r >> 4) * 2 + (c >> 5), rr = r & 15, cc = c & 31, ob = rr * 64 + cc * 2; return st * 1024 + (ob ^ (((ob >> 9) & 1) << 5)); }
__host__ __device__ __forceinline__ void stage_rc(int b, int& R, int& C) { const int st = b / 1024, sb = b % 1024, swz = sb ^ (((sb >> 9) & 1) << 5); R = (st >> 1) * 16 + swz / 64; C = (st & 1) * 32 + (swz % 64) / 2; }
__host__ __device__ __forceinline__ int perm32(int rho) { const int n = rho >> 4, i = rho & 15; return 8 * (i >> 2) + 4 * n + (i & 3); }

struct Unit { const char* A; const char* B; const unsigned* gat; int nvalid; int i0, i1, i2; };

template <class Epi, class Sched, bool GATHER, bool ALIGN_EPI, bool SP2>
__device__ __forceinline__ void gemm_phase(LAS unsigned char* lds, const unsigned lda, const unsigned ldb, const int nt, const Sched& S, const Epi& E) {
    const int tid = threadIdx.x, wid = __builtin_amdgcn_readfirstlane(tid >> 6), lane = tid & 63, wr = wid >> 2, wc = wid & 3, fr = lane & 15, fq = lane >> 4;
    int R0, C0, R1, C1; stage_rc(tid * 16, R0, C0); stage_rc(tid * 16 + 8192, R1, C1);
    const int Rb0 = (R0 & ~31) + perm32(R0 & 31), Rb1 = (R1 & ~31) + perm32(R1 & 31);
    const unsigned voffB0 = (unsigned)Rb0 * ldb + (unsigned)C0 * 2u, voffB1 = (unsigned)Rb1 * ldb + (unsigned)C1 * 2u;
    const size_t hstepB = (size_t)HALF * ldb;
    const size_t kstep = (size_t)(BK * 2);
    const unsigned ldsw = (unsigned)wid * 1024u;
    const int aoff = lds_byte(wr * 64 + fr, fq * 8), boff = lds_byte(wc * 32 + fr, fq * 8);
#define PG8_SA(b, h) (((b) * 2 + (h)) * HTB)
#define PG8_SB(b, h) ((4 + (b) * 2 + (h)) * HTB)
#define PG8_STAGE(bufoff, gbase, v0, v1) do { unsigned _v0 = (v0), _v1 = (v1); asm volatile("" : "+v"(_v0), "+v"(_v1)); \
        __builtin_amdgcn_global_load_lds((const unsigned*)((const char*)(gbase) + _v0), (LAS unsigned*)(lds + (bufoff) + ldsw), 16, 0, 0); \
        __builtin_amdgcn_global_load_lds((const unsigned*)((const char*)(gbase) + _v1), (LAS unsigned*)(lds + (bufoff) + ldsw + 8192), 16, 0, 0); } while (0)
#define PG8_LDA(dst, b, h) do { _Pragma("unroll") for (int m = 0; m < 4; ++m) _Pragma("unroll") for (int k = 0; k < 2; ++k) dst[m][k] = *(const LAS bf16x8*)(lds + PG8_SA(b, h) + aoff + m * 2048 + k * 1024); } while (0)
#define PG8_LDB(dst, b, h) do { _Pragma("unroll") for (int n = 0; n < 2; ++n) _Pragma("unroll") for (int k = 0; k < 2; ++k) dst[n][k] = *(const LAS bf16x8*)(lds + PG8_SB(b, h) + boff + n * 2048 + k * 1024); } while (0)
#define PG8_MMA(ai, bj, At, Bt) do { __builtin_amdgcn_s_setprio(1); _Pragma("unroll") for (int m = 0; m < 4; ++m) _Pragma("unroll") for (int n = 0; n < 2; ++n) _Pragma("unroll") for (int k = 0; k < 2; ++k) \
        acc[ai][bj][m][n] = __builtin_amdgcn_mfma_f32_16x16x32_bf16(Bt[n][k], At[m][k], acc[ai][bj][m][n], 0, 0, 0); __builtin_amdgcn_s_setprio(0); } while (0)
#define PG8_WAIT_V(n) asm volatile("s_waitcnt vmcnt(" #n ")" ::: "memory")
#define PG8_WAIT_L(n) asm volatile("s_waitcnt lgkmcnt(" #n ")" ::: "memory")
#define PG8_BAR __builtin_amdgcn_s_barrier()
#define PG8_SCHED __builtin_amdgcn_sched_barrier(0)
#define PG8_SETV(v00, v01, v10, v11, u) do { \
        if (GATHER) { const unsigned ta = R0 < (u).nvalid ? (u).gat[R0] : 0u, tb = R1 < (u).nvalid ? (u).gat[R1] : 0u, \
                                     tc = (HALF + R0) < (u).nvalid ? (u).gat[HALF + R0] : 0u, td = (HALF + R1) < (u).nvalid ? (u).gat[HALF + R1] : 0u; \
            v00 = ta * lda + (unsigned)C0 * 2u; v01 = tb * lda + (unsigned)C1 * 2u; v10 = tc * lda + (unsigned)C0 * 2u; v11 = td * lda + (unsigned)C1 * 2u; } \
        else { v00 = (unsigned)R0 * lda + (unsigned)C0 * 2u; v01 = (unsigned)R1 * lda + (unsigned)C1 * 2u; v10 = (unsigned)(HALF + R0) * lda + (unsigned)C0 * 2u; v11 = (unsigned)(HALF + R1) * lda + (unsigned)C1 * 2u; } } while (0)
    Unit cur, nxt; int ui = 0;
    if (!S.next(0, cur)) return;
    f32x4 acc[2][2][4][2];
#pragma unroll
    for (int a = 0; a < 2; ++a)
#pragma unroll
        for (int b = 0; b < 2; ++b)
#pragma unroll
            for (int m = 0; m < 4; ++m)
#pragma unroll
                for (int n = 0; n < 2; ++n) acc[a][b][m][n] = (f32x4){0.f, 0.f, 0.f, 0.f};
    bf16x8 At[4][2], B0[2][2], B1[2][2];
    const char* cA = cur.A; const char* cB = cur.B;
    unsigned cv00, cv01, cv10, cv11;
    PG8_SETV(cv00, cv01, cv10, cv11, cur);
    if constexpr (SP2) {
        PG8_STAGE(PG8_SB(0, 0), cB, voffB0, voffB1); PG8_STAGE(PG8_SB(0, 1), cB + hstepB, voffB0, voffB1); PG8_STAGE(PG8_SA(0, 0), cA, cv00, cv01); PG8_STAGE(PG8_SA(0, 1), cA, cv10, cv11);
        if (wr == 1) PG8_BAR;
        PG8_WAIT_V(2); PG8_BAR;
        PG8_STAGE(PG8_SB(1, 0), cB + kstep, voffB0, voffB1); PG8_STAGE(PG8_SA(1, 0), cA + kstep, cv00, cv01); PG8_STAGE(PG8_SB(1, 1), cB + hstepB + kstep, voffB0, voffB1);
        PG8_WAIT_V(6); PG8_BAR;
    } else {
        PG8_STAGE(PG8_SB(0, 0), cB, voffB0, voffB1); PG8_STAGE(PG8_SA(0, 0), cA, cv00, cv01); PG8_STAGE(PG8_SB(0, 1), cB + hstepB, voffB0, voffB1); PG8_STAGE(PG8_SA(0, 1), cA, cv10, cv11);
        if (wr == 1) PG8_BAR;
        PG8_WAIT_V(4); PG8_BAR;
        PG8_STAGE(PG8_SB(1, 0), cB + kstep, voffB0, voffB1); PG8_STAGE(PG8_SA(1, 0), cA + kstep, cv00, cv01); PG8_STAGE(PG8_SB(1, 1), cB + hstepB + kstep, voffB0, voffB1);
        PG8_WAIT_V(6); PG8_BAR;
    }
    for (;;) {
        const bool has_next = S.next(ui + 1, nxt);
        const char* nA = has_next ? nxt.A : cA; const char* nB = has_next ? nxt.B : cB;
        for (int t = 0; t < nt; t += 2) {
            const bool last = (t == nt - 2);
            const char* a1 = cA + (size_t)(t + 1) * kstep;
            const char* a2 = last ? nA : cA + (size_t)(t + 2) * kstep; const char* b2 = last ? nB : cB + (size_t)(t + 2) * kstep;
            const char* a3 = a2 + kstep; const char* b3 = b2 + kstep;
            if constexpr (SP2) {
            PG8_LDB(B0, 0, 0); PG8_LDB(B1, 0, 1); PG8_SCHED; PG8_LDA(At, 0, 0); PG8_STAGE(PG8_SA(1, 1), a1, cv10, cv11);
            PG8_WAIT_V(8); PG8_WAIT_L(0); PG8_BAR; PG8_MMA(0, 0, At, B0); PG8_MMA(0, 1, At, B1); PG8_BAR; PG8_SCHED;
            if constexpr (GATHER) { if (last && has_next) { PG8_SETV(cv00, cv01, cv10, cv11, nxt); } }
            PG8_LDA(At, 0, 1); PG8_STAGE(PG8_SB(0, 0), b2, voffB0, voffB1); PG8_STAGE(PG8_SB(0, 1), b2 + hstepB, voffB0, voffB1); PG8_STAGE(PG8_SA(0, 0), a2, cv00, cv01);
            PG8_WAIT_V(8); PG8_WAIT_L(0); PG8_BAR; PG8_MMA(1, 0, At, B0); PG8_MMA(1, 1, At, B1); PG8_BAR; PG8_SCHED;
            PG8_LDB(B0, 1, 0); PG8_LDB(B1, 1, 1); PG8_SCHED; PG8_LDA(At, 1, 0); PG8_STAGE(PG8_SA(0, 1), a2, cv10, cv11);
            PG8_WAIT_V(8); PG8_WAIT_L(0); PG8_BAR; PG8_MMA(0, 0, At, B0); PG8_MMA(0, 1, At, B1); PG8_BAR; PG8_SCHED;
            PG8_LDA(At, 1, 1); PG8_STAGE(PG8_SB(1, 0), b3, voffB0, voffB1); PG8_STAGE(PG8_SB(1, 1), b3 + hstepB, voffB0, voffB1); PG8_STAGE(PG8_SA(1, 0), a3, cv00, cv01);
            PG8_WAIT_V(8); PG8_WAIT_L(0); PG8_BAR; PG8_MMA(1, 0, At, B0); PG8_MMA(1, 1, At, B1); PG8_BAR; PG8_SCHED;
            } else {
            PG8_LDB(B0, 0, 0); PG8_SCHED; PG8_LDA(At, 0, 0); PG8_STAGE(PG8_SA(1, 1), a1, cv10, cv11);
            PG8_WAIT_L(8); PG8_BAR; PG8_WAIT_L(0); PG8_MMA(0, 0, At, B0); PG8_BAR; PG8_SCHED;
            if constexpr (GATHER) { if (last && has_next) { PG8_SETV(cv00, cv01, cv10, cv11, nxt); } }
            PG8_LDB(B1, 0, 1); PG8_STAGE(PG8_SB(0, 0), b2, voffB0, voffB1);
            PG8_BAR; PG8_WAIT_L(0); PG8_MMA(0, 1, At, B1); PG8_BAR;
            PG8_LDA(At, 0, 1); PG8_STAGE(PG8_SA(0, 0), a2, cv00, cv01);
            PG8_BAR; PG8_WAIT_L(0); PG8_MMA(1, 0, At, B0); PG8_BAR; PG8_SCHED;
            PG8_STAGE(PG8_SB(0, 1), b2 + hstepB, voffB0, voffB1);
            PG8_WAIT_V(6); PG8_BAR; PG8_MMA(1, 1, At, B1); PG8_BAR;
            PG8_LDB(B0, 1, 0); PG8_SCHED; PG8_LDA(At, 1, 0); PG8_STAGE(PG8_SA(0, 1), a2, cv10, cv11);
            PG8_WAIT_L(8); PG8_BAR; PG8_WAIT_L(0); PG8_MMA(0, 0, At, B0); PG8_BAR; PG8_SCHED;
            PG8_LDB(B1, 1, 1); PG8_STAGE(PG8_SB(1, 0), b3, voffB0, voffB1);
            PG8_BAR; PG8_WAIT_L(0); PG8_MMA(0, 1, At, B1); PG8_BAR;
            PG8_LDA(At, 1, 1); PG8_STAGE(PG8_SA(1, 0), a3, cv00, cv01);
            PG8_BAR; PG8_WAIT_L(0); PG8_MMA(1, 0, At, B0); PG8_BAR; PG8_SCHED;
            PG8_STAGE(PG8_SB(1, 1), b3 + hstepB, voffB0, voffB1);
            PG8_WAIT_V(6); PG8_BAR; PG8_MMA(1, 1, At, B1); PG8_BAR;
            }
        }
        if constexpr (ALIGN_EPI) { if (wr == 0) PG8_BAR; }
        E(acc, cur, wr, wc, fr, fq);
        if (!has_next) break;
#pragma unroll
        for (int a = 0; a < 2; ++a)
#pragma unroll
            for (int b = 0; b < 2; ++b)
#pragma unroll
                for (int m = 0; m < 4; ++m)
#pragma unroll
                    for (int n = 0; n < 2; ++n) acc[a][b][m][n] = (f32x4){0.f, 0.f, 0.f, 0.f};
        cur = nxt; cA = nA; cB = nB; ++ui;
        if constexpr (ALIGN_EPI) { if (wr == 1) PG8_BAR; }
    }
    PG8_WAIT_V(0);
    if constexpr (!ALIGN_EPI) { if (wr == 0) PG8_BAR; }
    PG8_BAR;
#undef PG8_SA
#undef PG8_SB
#undef PG8_STAGE
#undef PG8_LDA
#undef PG8_LDB
#undef PG8_MMA
#undef PG8_WAIT_V
#undef PG8_WAIT_L
#undef PG8_BAR
#undef PG8_SCHED
#undef PG8_SETV
}

struct DenseSched {
    const char* A; const char* B; unsigned lda, ldb, a_pn; int nM, nN, nwg, G, c;
    __device__ __forceinline__ bool next(int i, Unit& u) const {
        const long L = (long)i * G + c; if (L >= nwg) return false;
        int wgid = (int)L; { const int q = nwg / NXCD, r = nwg % NXCD, xcd = wgid % NXCD, off = wgid / NXCD; wgid = (xcd < r ? xcd * (q + 1) : r * (q + 1) + (xcd - r) * q) + off; }
        const int nig = WGM * nN, gid = wgid / nig, fm = gid * WGM, gsz = (nM - fm) < WGM ? (nM - fm) : WGM;
        const int pm = fm + ((wgid % nig) % gsz), pn = (wgid % nig) / gsz;
        u.A = A + (size_t)pm * BM * lda + (size_t)pn * a_pn; u.B = B + (size_t)pn * BM * ldb; u.gat = nullptr; u.nvalid = BM; u.i0 = pm; u.i1 = pn; u.i2 = 0; return true;
    }
};
struct MoeInfo { const LAS unsigned* cnt; const LAS unsigned* tstart; const LAS unsigned* ystart; const LAS unsigned char* tile_e; int ntiles; };
struct G1Sched {
    MoeInfo mi; const char* XB; const char* Wgu; const unsigned* rowtok; const unsigned* ident; int G, vcu;
    __device__ __forceinline__ bool next(int i, Unit& u) const {
        const int L = i * G + vcu; if (L >= 2 * mi.ntiles) return false;
        const int tile = L >> 1, uu = L & 1; int e;
        if (tile < 64) { e = 64; u.gat = ident + tile * 256; u.nvalid = 256; }
        else { e = __builtin_amdgcn_readfirstlane((int)mi.tile_e[tile]); const int pos0 = (tile - __builtin_amdgcn_readfirstlane((int)mi.tstart[e])) * 256; u.gat = rowtok + (size_t)e * CAP + pos0; const int rem = __builtin_amdgcn_readfirstlane((int)mi.cnt[e]) - pos0; u.nvalid = rem < 256 ? rem : 256; }
        u.A = XB; u.B = Wgu + ((size_t)e * 512 + (size_t)uu * 256) * 2048; u.i0 = tile; u.i1 = uu; u.i2 = 0; return true;
    }
};
struct G2Sched {
    MoeInfo mi; const char* H; const char* Wd; int G, vcu, L0;
    __device__ __forceinline__ bool next(int i, Unit& u) const {
        const int L = i * G + vcu + L0; if (L >= 4 * mi.ntiles) return false;
        const int tile = L >> 2, pn = L & 3; int e;
        if (tile < 64) { e = 64; u.i0 = tile * 256; u.i2 = 1; u.nvalid = 256; }
        else { e = __builtin_amdgcn_readfirstlane((int)mi.tile_e[tile]); const int pos0 = (tile - __builtin_amdgcn_readfirstlane((int)mi.tstart[e])) * 256; u.i0 = __builtin_amdgcn_readfirstlane((int)mi.ystart[e]) + pos0; u.i2 = 0; const int rem = __builtin_amdgcn_readfirstlane((int)mi.cnt[e]) - pos0; u.nvalid = rem < 256 ? rem : 256; }
        u.A = H + (size_t)tile * 256 * 512; u.B = Wd + ((size_t)e * 1024 + (size_t)pn * 256) * 512; u.gat = nullptr; u.i1 = pn; return true;
    }
};

template <int ACT, bool BIAS, bool SCALE> struct EpiBf16 {
    bf16* O; int ldo; const float* bias; const float* scale;
    __device__ __forceinline__ void operator()(const f32x4 (&acc)[2][2][4][2], const Unit& u, int wr, int wc, int fr, int fq) const {
        const int row0 = u.i0 * BM + wr * 64 + fr, col0 = u.i1 * BM + wc * 32 + 8 * fq;
        f32x4 bv[2][2], sv[2][2];
#pragma unroll
        for (int bj = 0; bj < 2; ++bj)
#pragma unroll
            for (int n = 0; n < 2; ++n) { bv[bj][n] = BIAS ? *(const f32x4*)(bias + col0 + bj * HALF + 4 * n) : (f32x4){0.f, 0.f, 0.f, 0.f}; sv[bj][n] = SCALE ? *(const f32x4*)(scale + col0 + bj * HALF + 4 * n) : (f32x4){1.f, 1.f, 1.f, 1.f}; }
#pragma unroll
        for (int ai = 0; ai < 2; ++ai)
#pragma unroll
            for (int m = 0; m < 4; ++m) { bf16* rowp = O + (size_t)(row0 + ai * HALF + m * 16) * ldo + col0;
#pragma unroll
                for (int bj = 0; bj < 2; ++bj) { f32x4 v0 = acc[ai][bj][m][0] + bv[bj][0], v1 = acc[ai][bj][m][1] + bv[bj][1];
                    if (ACT == 1) {
#pragma unroll
                        for (int j = 0; j < 4; ++j) { v0[j] = gelu_tanh(v0[j]); v1[j] = gelu_tanh(v1[j]); } }
                    if (SCALE) { v0 = v0 * sv[bj][0]; v1 = v1 * sv[bj][1]; }
                    v4u w; w.x = cvt_pk_bf16(v0[0], v0[1]); w.y = cvt_pk_bf16(v0[2], v0[3]); w.z = cvt_pk_bf16(v1[0], v1[1]); w.w = cvt_pk_bf16(v1[2], v1[3]);
                    *(v4u*)(rowp + bj * HALF) = w; } }
    }
};
struct EpiResid {
    const float* base; float* out;
    __device__ __forceinline__ void operator()(const f32x4 (&acc)[2][2][4][2], const Unit& u, int wr, int wc, int fr, int fq) const {
        const int row0 = u.i0 * BM + wr * 64 + fr, col0 = u.i1 * BM + wc * 32 + 8 * fq;
#pragma unroll
        for (int ai = 0; ai < 2; ++ai)
#pragma unroll
            for (int m = 0; m < 4; ++m) { const size_t off = (size_t)(row0 + ai * HALF + m * 16) * DM + col0;
#pragma unroll
                for (int bj = 0; bj < 2; ++bj) { const f32x4 b0 = *(const f32x4*)(base + off + bj * HALF), b1 = *(const f32x4*)(base + off + bj * HALF + 4);
                    *(f32x4*)(out + off + bj * HALF) = b0 * ALPHA + acc[ai][bj][m][0]; *(f32x4*)(out + off + bj * HALF + 4) = b1 * ALPHA + acc[ai][bj][m][1]; }
                asm volatile("" ::: "memory"); }
    }
};
struct EpiSwiglu {
    bf16* H;
    __device__ __forceinline__ void operator()(const f32x4 (&acc)[2][2][4][2], const Unit& u, int wr, int wc, int fr, int fq) const {
        const int row0 = u.i0 * BM + wr * 64 + fr, col0 = u.i1 * HALF + wc * 32 + 8 * fq;
#pragma unroll
        for (int ai = 0; ai < 2; ++ai)
#pragma unroll
            for (int m = 0; m < 4; ++m) { bf16* rowp = H + (size_t)(row0 + ai * HALF + m * 16) * EDIM + col0; float h[8];
#pragma unroll
                for (int n = 0; n < 2; ++n)
#pragma unroll
                    for (int j = 0; j < 4; ++j) { const float g = acc[ai][0][m][n][j], up = acc[ai][1][m][n][j]; h[4 * n + j] = g * sigmoidf_(g) * up; }
                v4u w; w.x = cvt_pk_bf16(h[0], h[1]); w.y = cvt_pk_bf16(h[2], h[3]); w.z = cvt_pk_bf16(h[4], h[5]); w.w = cvt_pk_bf16(h[6], h[7]);
                *(v4u*)rowp = w; }
    }
};
struct EpiDown {
    bf16* Y; float* xf;
    __device__ __forceinline__ void operator()(const f32x4 (&acc)[2][2][4][2], const Unit& u, int wr, int wc, int fr, int fq) const {
        const int r0 = wr * 64 + fr, col0 = u.i1 * BM + wc * 32 + 8 * fq;
        if (u.i2) {
#pragma unroll
            for (int ai = 0; ai < 2; ++ai)
#pragma unroll
                for (int m = 0; m < 4; ++m) { const size_t off = (size_t)(u.i0 + r0 + ai * HALF + m * 16) * DM + col0;
#pragma unroll
                    for (int bj = 0; bj < 2; ++bj) { const f32x4 b0 = *(const f32x4*)(xf + off + bj * HALF), b1 = *(const f32x4*)(xf + off + bj * HALF + 4);
                        *(f32x4*)(xf + off + bj * HALF) = b0 * ALPHA + acc[ai][bj][m][0]; *(f32x4*)(xf + off + bj * HALF + 4) = b1 * ALPHA + acc[ai][bj][m][1]; }
                    asm volatile("" ::: "memory"); }
        } else {
#pragma unroll
            for (int ai = 0; ai < 2; ++ai)
#pragma unroll
                for (int m = 0; m < 4; ++m) { const int r = r0 + ai * HALF + m * 16;
                    if (r < u.nvalid) { bf16* rowp = Y + (size_t)(u.i0 + r) * DM + col0;
#pragma unroll
                        for (int bj = 0; bj < 2; ++bj) { const f32x4 v0 = acc[ai][bj][m][0], v1 = acc[ai][bj][m][1];
                            v4u w; w.x = cvt_pk_bf16(v0[0], v0[1]); w.y = cvt_pk_bf16(v0[2], v0[3]); w.z = cvt_pk_bf16(v1[0], v1[1]); w.w = cvt_pk_bf16(v1[2], v1[3]);
                            *(v4u*)(rowp + bj * HALF) = w; } } }
        }
    }
};
}

struct Args { const float* in[24]; float* out; unsigned char* ws; int ph_lo, ph_hi; };
enum { I_X = 0, I_PWIN, I_PWGRP, I_PSCALE, I_PWOUT, I_SWIN, I_SBIN, I_SLNG, I_SLNB, I_SWS, I_SBS, I_SWOUT, I_LNMG, I_LNMB, I_WR, I_RB, I_WG, I_WU, I_WD, I_SHG, I_SHU, I_SHD, I_LNFG, I_LNFB };

__device__ __forceinline__ void tr_item(const float* W, int N, int k0, int n0, bf16* dst  , int dpitch, LAS float* scr, int lane) {
#pragma unroll 8
    for (int i = 0; i < 32; ++i) { const int kk = 2 * i + (lane >> 5); scr[kk * 33 + (lane & 31)] = W[(size_t)(k0 + kk) * N + n0 + (lane & 31)]; }
    LDS_WAIT(); asm volatile("" ::: "memory");
    const int c = lane & 7;
#pragma unroll
    for (int j = 0; j < 4; ++j) { const int n = (lane >> 3) + 8 * j; const LAS float* s = scr + (8 * c) * 33 + n;
        v4u o; o.x = cvt_pk_bf16(s[0 * 33], s[1 * 33]); o.y = cvt_pk_bf16(s[2 * 33], s[3 * 33]); o.z = cvt_pk_bf16(s[4 * 33], s[5 * 33]); o.w = cvt_pk_bf16(s[6 * 33], s[7 * 33]);
        *(v4u*)(dst + (size_t)n * dpitch + 8 * c) = o; }
    LDS_WAIT(); asm volatile("" ::: "memory");
}
__device__ __forceinline__ void tr_item_hilo(const float* W, int N, int k0, int n0, bf16* dh, bf16* dl, int dpitch, LAS float* scr, int lane) {
#pragma unroll 8
    for (int i = 0; i < 32; ++i) { const int kk = 2 * i + (lane >> 5); scr[kk * 33 + (lane & 31)] = W[(size_t)(k0 + kk) * N + n0 + (lane & 31)]; }
    LDS_WAIT(); asm volatile("" ::: "memory");
    const int c = lane & 7;
#pragma unroll
    for (int j = 0; j < 4; ++j) { const int n = (lane >> 3) + 8 * j; const LAS float* s = scr + (8 * c) * 33 + n; float w[8];
#pragma unroll
        for (int z = 0; z < 8; ++z) w[z] = s[z * 33];
        v4u o; o.x = cvt_pk_bf16(w[0], w[1]); o.y = cvt_pk_bf16(w[2], w[3]); o.z = cvt_pk_bf16(w[4], w[5]); o.w = cvt_pk_bf16(w[6], w[7]);
        v4u l; l.x = cvt_pk_bf16(w[0] - bf_lo(o.x), w[1] - bf_hi(o.x)); l.y = cvt_pk_bf16(w[2] - bf_lo(o.y), w[3] - bf_hi(o.y)); l.z = cvt_pk_bf16(w[4] - bf_lo(o.z), w[5] - bf_hi(o.z)); l.w = cvt_pk_bf16(w[6] - bf_lo(o.w), w[7] - bf_hi(o.w));
        *(v4u*)(dh + (size_t)n * dpitch + 8 * c) = o; *(v4u*)(dl + (size_t)n * dpitch + 8 * c) = l; }
    LDS_WAIT(); asm volatile("" ::: "memory");
}
__device__ __forceinline__ void convert_moe_layer(const Args& a, int layer, LAS unsigned char* lds, int gw, int NGW, int wave, int lane) {
    LAS float* scr = (LAS float*)(lds + wave * 16384);
    bf16* WGU = (bf16*)(a.ws + WS_WGU); bf16* WDN = (bf16*)(a.ws + WS_WDN);
    constexpr int PER_E = 384, NIT = 65 * PER_E;
    for (int it = gw; it < NIT; it += NGW) {
        const int e = it / PER_E, r = it % PER_E;
        if (r < 256) { const int isup = r >> 7, rr = r & 127, kb = rr >> 3, nb = rr & 7, n0 = 32 * nb, k0 = 64 * kb;
            const float* src = (e < 64) ? a.in[isup ? I_WU : I_WG] + ((size_t)layer * 64 + e) * 262144 : a.in[isup ? I_SHU : I_SHG] + (size_t)layer * 262144;
            const int drow = e * 512 + (n0 >> 7) * 256 + isup * 128 + (n0 & 127);
            tr_item(src, 256, k0, n0, WGU + (size_t)drow * 1024 + k0, 1024, scr, lane);
        } else { const int rr = r - 256, kb = rr >> 5, nb = rr & 31, n0 = 32 * nb, k0 = 64 * kb;
            const float* src = (e < 64) ? a.in[I_WD] + ((size_t)layer * 64 + e) * 262144 : a.in[I_SHD] + (size_t)layer * 262144;
            tr_item(src, 1024, k0, n0, WDN + ((size_t)e * 1024 + n0) * 256 + k0, 256, scr, lane);
        }
    }
}
__device__ __forceinline__ void phase_p0(const Args& a, LAS unsigned char* lds, int vcu, int G) {
    const int tid = threadIdx.x, lane = tid & 63, wave = __builtin_amdgcn_readfirstlane(tid >> 6);
    const int gw = vcu * NWAVES + wave, NGW = G * NWAVES;
    LAS float* scr = (LAS float*)(lds + wave * 16384);
    constexpr int I_IN = 16 * 32, I_GRP = 4 * 4 * 8, I_OUT = 16 * 32, I_SIN = 16 * 128, I_SOUT = 32 * 32, NIT = I_IN + I_GRP + I_OUT + I_SIN + I_SOUT;
    for (int it = gw; it < NIT; it += NGW) {
        int r = it;
        if (r < I_IN) { const int kb = r >> 5, nb = r & 31; tr_item(a.in[I_PWIN], 1024, 64 * kb, 32 * nb, (bf16*)(a.ws + WS_WIN) + (size_t)(32 * nb) * 1024 + 64 * kb, 1024, scr, lane); continue; } r -= I_IN;
        if (r < I_GRP) { const int g = r >> 5, rr = r & 31, kb = rr >> 3, nb = rr & 7; tr_item(a.in[I_PWGRP] + (size_t)g * 65536, 256, 64 * kb, 32 * nb, (bf16*)(a.ws + WS_WGRP) + (size_t)(g * 256 + 32 * nb) * 256 + 64 * kb, 256, scr, lane); continue; } r -= I_GRP;
        if (r < I_OUT) { const int kb = r >> 5, nb = r & 31; tr_item(a.in[I_PWOUT], 1024, 64 * kb, 32 * nb, (bf16*)(a.ws + WS_WOUT) + (size_t)(32 * nb) * 1024 + 64 * kb, 1024, scr, lane); continue; } r -= I_OUT;
        if (r < I_SIN) { const int kb = r >> 7, nb = r & 127; tr_item(a.in[I_SWIN], 4096, 64 * kb, 32 * nb, (bf16*)(a.ws + WS_WSIN) + (size_t)(32 * nb) * 1024 + 64 * kb, 1024, scr, lane); continue; } r -= I_SIN;
        { const int kb = r >> 5, nb = r & 31; tr_item(a.in[I_SWOUT], 1024, 64 * kb, 32 * nb, (bf16*)(a.ws + WS_WSOUT) + (size_t)(32 * nb) * 2048 + 64 * kb, 2048, scr, lane); }
    }
    for (int it = gw; it < 64; it += NGW) { const int layer = it >> 5, rr = it & 31, kb = rr >> 1, nb = rr & 1; bf16* base = (bf16*)(a.ws + WS_WRT) + (size_t)layer * 2 * 65536 + (size_t)(32 * nb) * 1024 + 64 * kb;
        tr_item_hilo(a.in[I_WR] + (size_t)layer * DM * NE, 64, 64 * kb, 32 * nb, base, base + 65536, 1024, scr, lane); }
    convert_moe_layer(a, 0, lds, gw, NGW, wave, lane);
    const float* x = a.in[I_X]; bf16* xb = (bf16*)(a.ws + WS_XB);
    const size_t gt = (size_t)vcu * NTHR + tid, NT = (size_t)G * NTHR;
    for (size_t i = gt; i < (size_t)T_TOK * DM / 8; i += NT) { const f32x4 p = *(const f32x4*)(x + i * 8), q = *(const f32x4*)(x + i * 8 + 4);
        v4u w; w.x = cvt_pk_bf16(p[0], p[1]); w.y = cvt_pk_bf16(p[2], p[3]); w.z = cvt_pk_bf16(q[0], q[1]); w.w = cvt_pk_bf16(q[2], q[3]); *(v4u*)(xb + i * 8) = w; }
    unsigned* ident = (unsigned*)(a.ws + WS_IDENT);
    for (size_t i = gt; i < (size_t)T_TOK; i += NT) ident[i] = (unsigned)i;
}

template <int W> __device__ __forceinline__ void pool_item(const bf16* zp  , bf16* op  , int p0  ) {
    v4u q[W + 3];
#pragma unroll
    for (int i = 0; i < W + 3; ++i) { const int ii = i < p0 + 3 ? i : p0 + 3; q[i] = *(const v4u*)(zp - (size_t)ii * DM); }
#pragma unroll
    for (int o = 0; o < 4; ++o) {
        float s[8];
#pragma unroll
        for (int j = 0; j < 8; ++j) s[j] = 0.f;
#pragma unroll
        for (int i = 3 - o; i < 3 - o + W; ++i) { const float m = (i <= p0 + 3) ? 1.0f : 0.0f;
#pragma unroll
            for (int j = 0; j < 4; ++j) { s[2 * j] += m * bf_lo(q[i][j]); s[2 * j + 1] += m * bf_hi(q[i][j]); } }
        const int p = p0 + o, nw = (p + 1) < W ? (p + 1) : W; const float inv = 1.0f / (float)nw; v4u ov;
#pragma unroll
        for (int j = 0; j < 4; ++j) ov[j] = cvt_pk_bf16(s[2 * j] * inv - bf_lo(q[3 - o][j]), s[2 * j + 1] * inv - bf_hi(q[3 - o][j]));
        *(v4u*)(op + (size_t)o * DM) = ov; }
}
__device__ __forceinline__ void phase_pool(const Args& a, int vcu, int G) {
    const bf16* Z = (const bf16*)(a.ws + WS_Z); bf16* P = (bf16*)(a.ws + WS_POOLED);
    const int tid = threadIdx.x, wave = tid >> 6, lane = tid & 63;
    const int gw = vcu * NWAVES + wave, NGW = G * NWAVES;
    for (int it = gw; it < (T_TOK / 4) * 2; it += NGW) {
        const int t0 = (it >> 1) * 4, c8 = (it & 1) * 64 + lane, g = c8 >> 5, p0 = t0 & (SEQ - 1);
        const bf16* zp = Z + (size_t)(t0 + 3) * DM + c8 * 8; bf16* op = P + (size_t)t0 * DM + c8 * 8;
        if (g == 0) pool_item<2>(zp, op, p0); else if (g == 1) pool_item<4>(zp, op, p0); else if (g == 2) pool_item<8>(zp, op, p0); else pool_item<16>(zp, op, p0);
    }
}

template <int R> __device__ __forceinline__ void ln_rows_store(float (&v)[R][16], const float* g, const float* b, float* const (&of)[R], bf16* const (&ob)[R], int lane) {
    float s[R], s2[R];
#pragma unroll
    for (int r = 0; r < R; ++r) { s[r] = 0.f;
#pragma unroll
        for (int i = 0; i < 16; ++i) s[r] += v[r][i]; }
#pragma unroll
    for (int o = 1; o < 64; o <<= 1)
#pragma unroll
        for (int r = 0; r < R; ++r) s[r] += __shfl_xor(s[r], o);
#pragma unroll
    for (int r = 0; r < R; ++r) { const float mean = s[r] * (1.0f / DM); s2[r] = 0.f;
#pragma unroll
        for (int i = 0; i < 16; ++i) { v[r][i] -= mean; s2[r] += v[r][i] * v[r][i]; } }
#pragma unroll
    for (int o = 1; o < 64; o <<= 1)
#pragma unroll
        for (int r = 0; r < R; ++r) s2[r] += __shfl_xor(s2[r], o);
#pragma unroll
    for (int j = 0; j < 2; ++j) { const int c = 8 * lane + 512 * j;
        const f32x4 g0 = *(const f32x4*)(g + c), g1 = *(const f32x4*)(g + c + 4), b0 = *(const f32x4*)(b + c), b1 = *(const f32x4*)(b + c + 4);
#pragma unroll
        for (int r = 0; r < R; ++r) { const float rstd = 1.0f / sqrtf(s2[r] * (1.0f / DM) + LN_EPS); f32x4 y0, y1;
#pragma unroll
            for (int q = 0; q < 4; ++q) { y0[q] = v[r][8 * j + q] * rstd * g0[q] + b0[q]; y1[q] = v[r][8 * j + 4 + q] * rstd * g1[q] + b1[q]; }
            *(f32x4*)(of[r] + c) = y0; *(f32x4*)(of[r] + c + 4) = y1;
            v4u w; w.x = cvt_pk_bf16(y0[0], y0[1]); w.y = cvt_pk_bf16(y0[2], y0[3]); w.z = cvt_pk_bf16(y1[0], y1[1]); w.w = cvt_pk_bf16(y1[2], y1[3]);
            *(v4u*)(ob[r] + c) = w; } }
}

__device__ __forceinline__ void phase_lnr(const Args& a, int layer, LAS unsigned char* lds, int vcu, int G, bool dry) {
    const int tid = threadIdx.x, lane = tid & 63, wave = __builtin_amdgcn_readfirstlane(tid >> 6);
    const float* xin = a.out; float* xf = dry ? (float*)(a.ws + WS_Y) : a.out; bf16* xb = dry ? (bf16*)(a.ws + WS_Y + 72 * MiB) : (bf16*)(a.ws + WS_XB);
    const float* lng = a.in[I_LNMG] + layer * DM; const float* lnb = a.in[I_LNMB] + layer * DM;
    const float* Wr = a.in[I_WR] + (size_t)layer * DM * NE; const float* rbias = a.in[I_RB] + layer * NE;
    unsigned* gcount = (unsigned*)(a.ws + WS_CTL) + CW_CNT + layer * 64 + (dry ? 128 : 0);
    unsigned* rowtok = dry ? (unsigned*)(a.ws + WS_Y + 64 * MiB) : (unsigned*)(a.ws + WS_ROWTOK); unsigned* dest = dry ? (unsigned*)(a.ws + WS_Y + 68 * MiB) : (unsigned*)(a.ws + WS_DEST); float* gatev = dry ? (float*)(a.ws + WS_Y + 69 * MiB) : (float*)(a.ws + WS_GATE);
    LAS float* part = (LAS float*)lds;
    LAS float* mb = (LAS float*)(lds + 32768);
    LAS float* gs = (LAS float*)(lds + 49152);
    LAS unsigned* hist = (LAS unsigned*)(lds + 51200);
    LAS unsigned* basep = (LAS unsigned*)(lds + 51456);
    for (int blk = vcu; blk < T_TOK / 64; blk += G) {
        const int row0 = blk * 64;
        if (tid < 64) hist[tid] = 0u;
#pragma unroll 1
        for (int h4 = 0; h4 < 2; ++h4) { float v[4][16]; float* of[4]; bf16* ob[4];
#pragma unroll
            for (int r = 0; r < 4; ++r) { const int rr = wave * 8 + h4 * 4 + r; const float* xr = xin + (size_t)(row0 + rr) * DM; of[r] = xf + (size_t)(row0 + rr) * DM; ob[r] = xb + (size_t)(row0 + rr) * DM;
#pragma unroll
                for (int j = 0; j < 2; ++j) { const f32x4 p = *(const f32x4*)(xr + 8 * lane + 512 * j), q = *(const f32x4*)(xr + 8 * lane + 512 * j + 4);
#pragma unroll
                    for (int i = 0; i < 4; ++i) { v[r][8 * j + i] = p[i]; v[r][8 * j + 4 + i] = q[i]; } } }
            ln_rows_store<4>(v, lng, lnb, of, ob, lane); }
        VM_WAIT(); __syncthreads();
#ifndef DRY_PARTS
#define DRY_PARTS 7
#endif
        if (!dry || (DRY_PARTS & 2)) { const int mt = wave & 3, kh = wave >> 2, r = lane & 15, g = lane >> 4;
          f32x4 acc[4];
#pragma unroll
          for (int n = 0; n < 4; ++n) acc[n] = (f32x4){0.f, 0.f, 0.f, 0.f};
          const float* arow = xf + (size_t)(row0 + 16 * mt + r) * DM + kh * 512 + 8 * g;
          const bf16* bh = (const bf16*)(a.ws + WS_WRT) + (size_t)layer * 2 * 65536 + (size_t)r * 1024 + kh * 512 + 8 * g; const bf16* bl = bh + 65536;
          f32x4 a0 = *(const f32x4*)arow, a1 = *(const f32x4*)(arow + 4); bf16x8 wh[4], wl[4];
#pragma unroll
          for (int n = 0; n < 4; ++n) { wh[n] = *(const bf16x8*)(bh + (size_t)n * 16384); wl[n] = *(const bf16x8*)(bl + (size_t)n * 16384); }
#pragma unroll 1
          for (int s = 0; s < 16; ++s) { const int sn = s < 15 ? s + 1 : s;
              const f32x4 n0 = *(const f32x4*)(arow + 32 * sn), n1 = *(const f32x4*)(arow + 32 * sn + 4); bf16x8 nh[4], nl[4];
#pragma unroll
              for (int n = 0; n < 4; ++n) { nh[n] = *(const bf16x8*)(bh + (size_t)n * 16384 + 32 * sn); nl[n] = *(const bf16x8*)(bl + (size_t)n * 16384 + 32 * sn); }
              v4u hi, lo; hi.x = cvt_pk_bf16(a0[0], a0[1]); hi.y = cvt_pk_bf16(a0[2], a0[3]); hi.z = cvt_pk_bf16(a1[0], a1[1]); hi.w = cvt_pk_bf16(a1[2], a1[3]);
              lo.x = cvt_pk_bf16(a0[0] - bf_lo(hi.x), a0[1] - bf_hi(hi.x)); lo.y = cvt_pk_bf16(a0[2] - bf_lo(hi.y), a0[3] - bf_hi(hi.y));
              lo.z = cvt_pk_bf16(a1[0] - bf_lo(hi.z), a1[1] - bf_hi(hi.z)); lo.w = cvt_pk_bf16(a1[2] - bf_lo(hi.w), a1[3] - bf_hi(hi.w));
              const bf16x8 ah = __builtin_bit_cast(bf16x8, hi), al = __builtin_bit_cast(bf16x8, lo);
#pragma unroll
              for (int n = 0; n < 4; ++n) { acc[n] = __builtin_amdgcn_mfma_f32_16x16x32_bf16(ah, wh[n], acc[n], 0, 0, 0); acc[n] = __builtin_amdgcn_mfma_f32_16x16x32_bf16(al, wh[n], acc[n], 0, 0, 0); acc[n] = __builtin_amdgcn_mfma_f32_16x16x32_bf16(ah, wl[n], acc[n], 0, 0, 0); }
              a0 = n0; a1 = n1;
#pragma unroll
              for (int n = 0; n < 4; ++n) { wh[n] = nh[n]; wl[n] = nl[n]; } }
#pragma unroll
          for (int n = 0; n < 4; ++n)
#pragma unroll
              for (int q = 0; q < 4; ++q) part[(kh * 64 + 16 * mt + 4 * g + q) * 64 + 16 * n + r] = acc[n][q]; }
        __syncthreads();
        if (!dry || (DRY_PARTS & 4)) { const int row = tid >> 3, grp = tid & 7; float sc[8], bsd[8];
#pragma unroll
          for (int i = 0; i < 8; ++i) { const int e = 8 * grp + i; const float lg = part[row * 64 + e] + part[(64 + row) * 64 + e]; sc[i] = 1.0f / (1.0f + __expf(-lg)); bsd[i] = sc[i] + rbias[e]; }
          float m1 = -INFINITY, m2 = -INFINITY;
#pragma unroll
          for (int i = 0; i < 8; ++i) { const float v = bsd[i]; if (v > m1) { m2 = m1; m1 = v; } else if (v > m2) m2 = v; }
          const float myg = m1 + m2;
          int grank = 0;
#pragma unroll
          for (int d = 1; d < 8; ++d) { const float o = __shfl(myg, (lane & ~7) | ((grp + d) & 7)); const int g2 = (grp + d) & 7; grank += (o > myg || (o == myg && g2 < grp)) ? 1 : 0; }
          const bool gsel = grank < 4;
          float cand[8]; int rk[8]; bool sel[8];
#pragma unroll
          for (int i = 0; i < 8; ++i) { cand[i] = gsel ? bsd[i] : -INFINITY; rk[i] = 0; sel[i] = false; }
#pragma unroll 1
          for (int k = 0; k < TOPK; ++k) {
              float best = cand[0]; int bi = 0;
#pragma unroll
              for (int i = 1; i < 8; ++i) if (cand[i] > best) { best = cand[i]; bi = i; }
              int gi = 8 * grp + bi;
#pragma unroll
              for (int off = 1; off < 8; off <<= 1) { const float ov = __shfl_xor(best, off); const int oi = __shfl_xor(gi, off); if (ov > best || (ov == best && oi < gi)) { best = ov; gi = oi; } }
#pragma unroll
              for (int i = 0; i < 8; ++i) if (gi == 8 * grp + i) { cand[i] = -INFINITY; rk[i] = k; sel[i] = true; }
          }
          float psum = 0.f;
#pragma unroll
          for (int i = 0; i < 8; ++i) psum += sel[i] ? sc[i] : 0.f;
          psum += __shfl_xor(psum, 1); psum += __shfl_xor(psum, 2); psum += __shfl_xor(psum, 4);
          const float inv = ROUTED_SCALE / psum;
          unsigned loc[8];
#pragma unroll
          for (int i = 0; i < 8; ++i) { loc[i] = 0u; if (sel[i]) loc[i] = __hip_atomic_fetch_add(hist + 8 * grp + i, 1u, __ATOMIC_RELAXED, __HIP_MEMORY_SCOPE_WORKGROUP); }
          __syncthreads();
          if (tid < 64) { const unsigned h = hist[tid]; basep[tid] = h ? __hip_atomic_fetch_add(gcount + tid, h, RLX_AGENT) : 0u; }
          __syncthreads();
          const int tok = row0 + row;
#pragma unroll
          for (int i = 0; i < 8; ++i) if (sel[i]) { const int e = 8 * grp + i; const unsigned pos = basep[e] + loc[i];
              rowtok[(size_t)e * CAP + pos] = (unsigned)tok; dest[tok * 8 + rk[i]] = ((unsigned)e << 16) | pos; gatev[tok * 8 + rk[i]] = sc[i] * inv; }
        }
        __syncthreads();
    }
}

__device__ __forceinline__ pg8::MoeInfo moe_setup(const Args& a, int layer, LAS unsigned char* misc) {
    const int tid = threadIdx.x;
    unsigned* gcount = (unsigned*)(a.ws + WS_CTL) + CW_CNT + layer * 64;
    LAS unsigned* cnt = (LAS unsigned*)(misc + MI_CNT); LAS unsigned* tstart = (LAS unsigned*)(misc + MI_TSTART); LAS unsigned* ystart = (LAS unsigned*)(misc + MI_YSTART);
    LAS unsigned* ntl = (LAS unsigned*)(misc + MI_NTILES); LAS unsigned char* tile_e = (LAS unsigned char*)(misc + MI_TILE_E);
    __syncthreads();
    if (tid < 64) { unsigned c = __hip_atomic_load(gcount + tid, RLX_AGENT); if (c > (unsigned)CAP) c = CAP; cnt[tid] = c; }
    __syncthreads();
    if (tid < 64) { unsigned ts = 64u, ys = 0u; for (int e = 0; e < tid; ++e) { const unsigned c = cnt[e]; ts += (c + 255u) >> 8; ys += c; }
        tstart[tid] = ts; ystart[tid] = ys; const unsigned mynt = (cnt[tid] + 255u) >> 8;
        for (unsigned i = 0; i < mynt; ++i) if (ts + i < 640u) tile_e[ts + i] = (unsigned char)tid;
        if (tid == 63) ntl[0] = ts + mynt; }
    __syncthreads();
    pg8::MoeInfo mi; mi.cnt = cnt; mi.tstart = tstart; mi.ystart = ystart; mi.tile_e = tile_e; mi.ntiles = __builtin_amdgcn_readfirstlane((int)ntl[0]);
    if (mi.ntiles > 640) mi.ntiles = 640;
    return mi;
}

__device__ __forceinline__ void phase_combine(const Args& a, int layer, LAS unsigned char* misc, int vcu, int G, bool dry) {
    const int tid = threadIdx.x, lane = tid & 63, wave = __builtin_amdgcn_readfirstlane(tid >> 6);
    const pg8::MoeInfo mi = moe_setup(a, layer, misc);
    float* xf = a.out; bf16* xb = (bf16*)(a.ws + WS_XB); const bf16* Y = (const bf16*)(a.ws + WS_Y);
    const unsigned* dest = (const unsigned*)(a.ws + WS_DEST); const float* gatev = (const float*)(a.ws + WS_GATE);
    const float* lng = a.in[I_LNFG] + layer * DM; const float* lnb = a.in[I_LNFB] + layer * DM;
    const int gw = vcu * NWAVES + wave, NGW = G * NWAVES;
#pragma unroll 1
    for (int rowa = gw; rowa < T_TOK; rowa += 2 * NGW) {
        float v[2][16]; float* of[2]; bf16* ob[2]; unsigned d[2][TOPK]; float gk[2][TOPK];
#pragma unroll
        for (int r = 0; r < 2; ++r) { const int row = rowa + r * NGW;
#pragma unroll
            for (int k = 0; k < TOPK; ++k) { d[r][k] = dest[row * 8 + k]; gk[r][k] = gatev[row * 8 + k]; } }
#pragma unroll
        for (int r = 0; r < 2; ++r) { const int row = rowa + r * NGW; float* xr = xf + (size_t)row * DM; of[r] = dry ? (float*)(a.ws + WS_H) + (size_t)row * DM : xr; ob[r] = xb + (size_t)row * DM;
#pragma unroll
            for (int j = 0; j < 2; ++j) { const f32x4 p = *(const f32x4*)(xr + 8 * lane + 512 * j), q = *(const f32x4*)(xr + 8 * lane + 512 * j + 4);
#pragma unroll
                for (int i = 0; i < 4; ++i) { v[r][8 * j + i] = p[i]; v[r][8 * j + 4 + i] = q[i]; } } }
#pragma unroll
        for (int r = 0; r < 2; ++r)
#pragma unroll
            for (int k = 0; k < TOPK; ++k) { const unsigned dd = (unsigned)__builtin_amdgcn_readfirstlane((int)d[r][k]); const float g = __uint_as_float((unsigned)__builtin_amdgcn_readfirstlane((int)__float_as_uint(gk[r][k])));
                const unsigned e = (dd >> 16) & 63u, pos = dd & 0xffffu; const bf16* yr = Y + (size_t)(mi.ystart[e] + pos) * DM;
#pragma unroll
                for (int j = 0; j < 2; ++j) { const v4u w = *(const v4u*)(yr + 8 * lane + 512 * j);
#pragma unroll
                    for (int q = 0; q < 4; ++q) { v[r][8 * j + 2 * q] += g * bf_lo(w[q]); v[r][8 * j + 2 * q + 1] += g * bf_hi(w[q]); } } }
        ln_rows_store<2>(v, lng, lnb, of, ob, lane);
    }
}

__device__ __forceinline__ int swz16(int row) { return (row ^ (row >> 4)) & 15; }
__device__ __forceinline__ void phase_sgu_spatial(const Args& a, LAS unsigned char* lds, int vcu, int G) {
    const int tid = threadIdx.x, lane = tid & 63, wave = __builtin_amdgcn_readfirstlane(tid >> 6), fr = lane & 15, fq = lane >> 4;
    const bf16* HS = (const bf16*)(a.ws + WS_HS); bf16* GT = (bf16*)(a.ws + WS_GATED);
    const float* lng = a.in[I_SLNG]; const float* lnb = a.in[I_SLNB]; const float* WS = a.in[I_SWS]; const float* BS = a.in[I_SBS];
    LAS unsigned char* Bs = lds;
    LAS unsigned char* As = lds + 65536;
    LAS float* stm = (LAS float*)(lds + 98304);
    LAS float* str = (LAS float*)(lds + 98304 + 512);
    for (int item = vcu; item < 512; item += G) {
        const int chunk = item >> 2, h = item & 3, t0 = chunk * 128;
        __syncthreads();
        for (int rr = 0; rr < 16; ++rr) { const int j = wave * 16 + rr; const bf16* vr = HS + (size_t)(t0 + j) * 4096 + SGU_W; float x[32]; float s = 0.f;
#pragma unroll
            for (int q = 0; q < 4; ++q) { const v4u w = *(const v4u*)(vr + 8 * lane + 512 * q);
#pragma unroll
                for (int p = 0; p < 4; ++p) { x[8 * q + 2 * p] = bf_lo(w[p]); x[8 * q + 2 * p + 1] = bf_hi(w[p]); s += x[8 * q + 2 * p] + x[8 * q + 2 * p + 1]; } }
            const float mean = wave_sum(s) * (1.0f / SGU_W); float s2 = 0.f;
#pragma unroll
            for (int i = 0; i < 32; ++i) { const float d = x[i] - mean; s2 += d * d; }
            const float rstd = 1.0f / sqrtf(wave_sum(s2) * (1.0f / SGU_W) + LN_EPS);
            if (lane == 0) { stm[j] = mean; str[j] = rstd; } }
        for (int q = tid; q < 128 * 16; q += NTHR) { const int i = q >> 4, jc = q & 15; const float* wp = WS + ((size_t)h * 128 + i) * 128 + 8 * jc;
            const f32x4 p0 = *(const f32x4*)wp, p1 = *(const f32x4*)(wp + 4); float w8[8];
#pragma unroll
            for (int z = 0; z < 4; ++z) { w8[z] = (8 * jc + z <= i) ? p0[z] : 0.f; w8[4 + z] = (8 * jc + 4 + z <= i) ? p1[z] : 0.f; }
            v4u o; o.x = cvt_pk_bf16(w8[0], w8[1]); o.y = cvt_pk_bf16(w8[2], w8[3]); o.z = cvt_pk_bf16(w8[4], w8[5]); o.w = cvt_pk_bf16(w8[6], w8[7]);
            *(LAS v4u*)(As + i * 256 + ((jc ^ swz16(i)) << 4)) = o; }
        __syncthreads();
        for (int hh = 0; hh < 2; ++hh) {
            const int cb = h * SGU_HD + hh * 256;
            for (int q = tid; q < 64 * 32; q += NTHR) { const int c8 = q & 31, jp = q >> 5, j0 = 2 * jp;
                const v4u w0 = *(const v4u*)(HS + (size_t)(t0 + j0) * 4096 + SGU_W + cb + 8 * c8), w1 = *(const v4u*)(HS + (size_t)(t0 + j0 + 1) * 4096 + SGU_W + cb + 8 * c8);
                const f32x4 g0 = *(const f32x4*)(lng + cb + 8 * c8), g1 = *(const f32x4*)(lng + cb + 8 * c8 + 4), b0 = *(const f32x4*)(lnb + cb + 8 * c8), b1 = *(const f32x4*)(lnb + cb + 8 * c8 + 4);
                const float m0 = stm[j0], r0 = str[j0], m1 = stm[j0 + 1], r1 = str[j0 + 1];
#pragma unroll
                for (int z = 0; z < 8; ++z) { const float gz = z < 4 ? g0[z & 3] : g1[z & 3], bz = z < 4 ? b0[z & 3] : b1[z & 3];
                    const float xa = (z & 1) ? bf_hi(w0[z >> 1]) : bf_lo(w0[z >> 1]), xc = (z & 1) ? bf_hi(w1[z >> 1]) : bf_lo(w1[z >> 1]);
                    const float ya = (xa - m0) * r0 * gz + bz, yc = (xc - m1) * r1 * gz + bz;
                    const int cc = 8 * c8 + z, slot = (cc & ~31) | (((cc >> 2) & 1) << 4) | (((cc >> 3) & 3) << 2) | (cc & 3);
                    *(LAS unsigned*)(Bs + slot * 256 + (((j0 >> 3) ^ swz16(slot)) << 4) + (j0 & 7) * 2) = cvt_pk_bf16(ya, yc); } }
            __syncthreads();
            f32x4 acc[8][2]; bf16x8 Bf[2][4];
#pragma unroll
            for (int n = 0; n < 2; ++n)
#pragma unroll
                for (int s = 0; s < 4; ++s) { const int slot = 32 * wave + 16 * n + fr; Bf[n][s] = *(const LAS bf16x8*)(Bs + slot * 256 + (((4 * s + fq) ^ swz16(slot)) << 4)); }
#pragma unroll
            for (int m = 0; m < 8; ++m) { acc[m][0] = (f32x4){0.f, 0.f, 0.f, 0.f}; acc[m][1] = (f32x4){0.f, 0.f, 0.f, 0.f};
#pragma unroll
                for (int s = 0; s < 4; ++s) if (s <= (m >> 1)) { const int i = 16 * m + fr; const bf16x8 af = *(const LAS bf16x8*)(As + i * 256 + (((4 * s + fq) ^ swz16(i)) << 4));
                    acc[m][0] = __builtin_amdgcn_mfma_f32_16x16x32_bf16(Bf[0][s], af, acc[m][0], 0, 0, 0); acc[m][1] = __builtin_amdgcn_mfma_f32_16x16x32_bf16(Bf[1][s], af, acc[m][1], 0, 0, 0); } }
#pragma unroll
            for (int m = 0; m < 8; ++m) { const int i = 16 * m + fr; const float bsv = BS[h * 128 + i]; const size_t t = (size_t)(t0 + i);
                const v4u uw = *(const v4u*)(HS + t * 4096 + cb + 32 * wave + 8 * fq); float o[8];
#pragma unroll
                for (int n = 0; n < 2; ++n)
#pragma unroll
                    for (int z = 0; z < 4; ++z) { const int c = 4 * n + z; const float uu = (c & 1) ? bf_hi(uw[c >> 1]) : bf_lo(uw[c >> 1]); o[c] = uu * (acc[m][n][z] + bsv); }
                v4u w; w.x = cvt_pk_bf16(o[0], o[1]); w.y = cvt_pk_bf16(o[2], o[3]); w.z = cvt_pk_bf16(o[4], o[5]); w.w = cvt_pk_bf16(o[6], o[7]);
                *(v4u*)(GT + t * SGU_W + cb + 32 * wave + 8 * fq) = w; }
            __syncthreads();
        }
    }
}

constexpr int N_PHASES = 16;
__global__ void __launch_bounds__(NTHR, 2) mk_fwd(Args args) {
    extern __shared__ __attribute__((aligned(16))) unsigned char lds_raw[];
    LAS unsigned char* lds = (LAS unsigned char*)lds_raw;
    LAS unsigned char* misc = lds + MISC_OFF;
    const int tid = threadIdx.x;
    const int G = gridDim.x; const int bx = blockIdx.x; const int vcu = (G % 8 == 0) ? (bx % 8) * (G / 8) + bx / 8 : bx;
    unsigned char* ws = args.ws;
    unsigned* ctl = (unsigned*)(ws + WS_CTL);
    if (tid < 16) ((LAS unsigned*)(misc + MI_BARW))[tid] = 0u;
    __syncthreads();
    const int lo = args.ph_lo, hi = args.ph_hi;
    XcdBarrier bar; bar.bar = ctl + CW_BAR; bar.x = 0; bar.st = nullptr;
    if (hi - lo > 1) bar = xcd_barrier_post(ctl + CW_BAR, (volatile LAS unsigned*)(misc + MI_BARW));
#ifndef PH_MASK
#define PH_MASK 0xFFFF
#endif
#define IN(k) (((PH_MASK >> (k)) & 1) && lo <= (k) && (k) < hi)
#ifndef REP_PH
#define REP_PH -1
#define REP_N 1
#endif
#define NREP(k) ((k) == REP_PH ? REP_N : 1)
#define RUN(k) if (IN(k)) for (int rep = 0; rep < NREP(k); ++rep)
#define DRY(k) (rep + 1 < NREP(k))
#define SEAM(k) do { if (IN(k) && IN((k) + 1)) xcd_barrier(bar); } while (0)
    using namespace pg8;
    RUN(0) { phase_p0(args, lds, vcu, G); } SEAM(0);
    RUN(1) { DenseSched S{(const char*)(ws + WS_XB), (const char*)(ws + WS_WIN), 2048u, 2048u, 0u, 64, 4, 256, G, bx};
        EpiBf16<0, false, false> E{(bf16*)(ws + WS_Z), DM, nullptr, nullptr};
        gemm_phase<EpiBf16<0, false, false>, DenseSched, false, true, true>(lds, 2048u, 2048u, 16, S, E); } SEAM(1);
    RUN(2) { phase_pool(args, vcu, G); } SEAM(2);
    if (REP_PH == 100 && hi - lo > 1) for (int i = 0; i < REP_N; ++i) xcd_barrier(bar);
    RUN(3) { DenseSched S{(const char*)(ws + WS_POOLED), (const char*)(ws + WS_WGRP), 2048u, 512u, 512u, 64, 4, 256, G, bx};
        EpiBf16<0, false, true> E{(bf16*)(ws + WS_YP), DM, nullptr, args.in[I_PSCALE]};
        gemm_phase<EpiBf16<0, false, true>, DenseSched, false, true, true>(lds, 2048u, 512u, 4, S, E); } SEAM(3);
    RUN(4) { DenseSched S{(const char*)(ws + WS_YP), (const char*)(ws + WS_WOUT), 2048u, 2048u, 0u, 64, 4, 256, G, bx};
        EpiResid E{args.in[I_X], args.out};
        gemm_phase<EpiResid, DenseSched, false, true, true>(lds, 2048u, 2048u, 16, S, E); } SEAM(4);
#define MOE_PHASES(layer, pb) do { \
        RUN(pb) { phase_lnr(args, layer, lds, vcu, G, DRY(pb)); } SEAM(pb); \
        RUN((pb) + 1) { const MoeInfo mi = moe_setup(args, layer, misc); \
            G1Sched S{mi, (const char*)(ws + WS_XB), (const char*)(ws + WS_WGU), (const unsigned*)(ws + WS_ROWTOK), (const unsigned*)(ws + WS_IDENT), G, vcu}; \
            EpiSwiglu E{(bf16*)(ws + WS_H)}; \
            gemm_phase<EpiSwiglu, G1Sched, true, true, true>(lds, 2048u, 2048u, 16, S, E); } SEAM((pb) + 1); \
        if (IN((pb) + 2) && REP_PH == (pb) + 2) { const MoeInfo mi = moe_setup(args, layer, misc); \
            G2Sched S{mi, (const char*)(ws + WS_H), (const char*)(ws + WS_WDN), G, vcu, 256}; \
            EpiDown E{(bf16*)(ws + WS_Y), args.out}; \
            gemm_phase<EpiDown, G2Sched, false, true, true>(lds, 512u, 512u, 4, S, E); } \
        if (IN((pb) + 2)) { const MoeInfo mi = moe_setup(args, layer, misc); \
            G2Sched S{mi, (const char*)(ws + WS_H), (const char*)(ws + WS_WDN), G, vcu, 0}; \
            EpiDown E{(bf16*)(ws + WS_Y), args.out}; \
            gemm_phase<EpiDown, G2Sched, false, true, true>(lds, 512u, 512u, 4, S, E); } SEAM((pb) + 2); \
        RUN((pb) + 3) { phase_combine(args, layer, misc, vcu, G, DRY((pb) + 3)); \
            if (layer == 0 && !DRY((pb) + 3)) { const int wave = __builtin_amdgcn_readfirstlane(tid >> 6); __syncthreads(); convert_moe_layer(args, 1, lds, vcu * NWAVES + wave, G * NWAVES, wave, tid & 63); } } \
    } while (0)
    MOE_PHASES(0, 5); SEAM(8);
    RUN(9) { DenseSched S{(const char*)(ws + WS_XB), (const char*)(ws + WS_WSIN), 2048u, 2048u, 0u, 64, 16, 1024, G, bx};
        EpiBf16<1, true, false> E{(bf16*)(ws + WS_HS), 4096, args.in[I_SBIN], nullptr};
        gemm_phase<EpiBf16<1, true, false>, DenseSched, false, true, true>(lds, 2048u, 2048u, 16, S, E); } SEAM(9);
    RUN(10) { phase_sgu_spatial(args, lds, vcu, G); } SEAM(10);
    RUN(11) { DenseSched S{(const char*)(ws + WS_GATED), (const char*)(ws + WS_WSOUT), 4096u, 4096u, 0u, 64, 4, 256, G, bx};
        EpiResid E{args.out, DRY(11) ? (float*)(ws + WS_HS) : args.out};
        gemm_phase<EpiResid, DenseSched, false, true, true>(lds, 4096u, 4096u, 32, S, E); } SEAM(11);
    MOE_PHASES(1, 12);
#undef MOE_PHASES
#undef IN
#undef SEAM
}

extern "C" void kernel_launch(void* const* d_in, const int* in_sizes, int n_in, void* d_out, int out_size, void* d_ws, size_t ws_size, hipStream_t stream) {
    static int grid = 0;
    if (grid == 0) {
        if (n_in != 24 || out_size != T_TOK * DM || ws_size < WS_END) { fprintf(stderr, "kernel_launch: unexpected shapes (n_in %d out %d ws %zu)\n", n_in, out_size, ws_size); grid = -1; return; }
        int dev = 0, cus = 0;
        if (hipGetDevice(&dev) != hipSuccess || hipDeviceGetAttribute(&cus, hipDeviceAttributeMultiprocessorCount, dev) != hipSuccess) { grid = -1; return; }
        if (hipFuncSetAttribute((const void*)mk_fwd, hipFuncAttributeMaxDynamicSharedMemorySize, LDS_BYTES) != hipSuccess) { fprintf(stderr, "kernel_launch: hipFuncSetAttribute failed\n"); grid = -1; return; }
        int per_cu = 0;
        if (hipOccupancyMaxActiveBlocksPerMultiprocessor(&per_cu, (const void*)mk_fwd, NTHR, LDS_BYTES) != hipSuccess || per_cu < 1) fprintf(stderr, "kernel_launch: occupancy query says %d\n", per_cu);
        (void)hipGetLastError();
        grid = cus;
    }
    if (grid < 0) return;
    (void)hipMemsetAsync((char*)d_ws + WS_CTL, 0, CTL_ZERO_BYTES, stream);
    Args a{};
    for (int i = 0; i < 24; ++i) a.in[i] = (const float*)d_in[i];
    a.out = (float*)d_out; a.ws = (unsigned char*)d_ws;
#if MK_PER_PHASE
    for (int p = 0; p < N_PHASES; ++p) { a.ph_lo = p; a.ph_hi = p + 1; hipLaunchKernelGGL(mk_fwd, dim3(grid), dim3(NTHR), LDS_BYTES, stream, a); }
#else
    a.ph_lo = 0; a.ph_hi = N_PHASES; hipLaunchKernelGGL(mk_fwd, dim3(grid), dim3(NTHR), LDS_BYTES, stream, a);
#endif
}
```

```cpp
#include <hip/hip_runtime.h>
#include <cstdio>
#include <cstdint>

#ifndef MK_PER_PHASE
#define MK_PER_PHASE 0
#endif

#define GAS __attribute__((address_space(1)))
#define LAS __attribute__((address_space(3)))
typedef unsigned short bf16;
typedef unsigned v4u __attribute__((ext_vector_type(4)));
typedef unsigned v2u __attribute__((ext_vector_type(2)));
typedef float f32x4 __attribute__((ext_vector_type(4)));
typedef float f32x2 __attribute__((ext_vector_type(2)));
typedef short bf16x8 __attribute__((ext_vector_type(8)));
#define RLX_AGENT __ATOMIC_RELAXED, __HIP_MEMORY_SCOPE_AGENT
#define LDS_WAIT() asm volatile("s_waitcnt lgkmcnt(0)" ::: "memory")
#define VM_WAIT() asm volatile("s_waitcnt vmcnt(0)" ::: "memory")

constexpr int T_TOK = 16384, DM = 1024, SEQ = 4096, NE = 64, TOPK = 8, EDIM = 256;
constexpr int SGU_W = 2048, SGU_HD = 512;
constexpr float ALPHA = 1.41421356237309515f;
constexpr float LN_EPS = 1e-5f, ROUTED_SCALE = 2.5f;
constexpr int CAP = 16384;
constexpr int NWAVES = 8, NTHR = 512;

constexpr size_t MiB = 1u << 20;
constexpr size_t WS_CTL = 0, CTL_ZERO_BYTES = 65536;
constexpr size_t WS_IDENT = 256 * 1024;
constexpr size_t WS_DEST = 1 * MiB;
constexpr size_t WS_GATE = WS_DEST + 512 * 1024;
constexpr size_t WS_ROWTOK = 2 * MiB;
constexpr size_t WS_WIN = 6 * MiB;
constexpr size_t WS_WGRP = 8 * MiB;
constexpr size_t WS_WOUT = WS_WGRP + 512 * 1024;
constexpr size_t WS_WSIN = WS_WOUT + 2 * MiB;
constexpr size_t WS_WSOUT = WS_WSIN + 8 * MiB;
constexpr size_t WS_WRT = WS_WSOUT + 4 * MiB;
constexpr size_t WS_WGU = 23 * MiB;
constexpr size_t WS_WDN = WS_WGU + 65 * MiB;
constexpr size_t WS_XB = 121 * MiB;
constexpr size_t WS_H = 153 * MiB;
constexpr size_t WS_Y = 233 * MiB;
constexpr size_t WS_END = 490 * MiB;
constexpr size_t WS_Z = 153 * MiB, WS_POOLED = 185 * MiB, WS_YP = 217 * MiB;
constexpr size_t WS_HS = 153 * MiB;
constexpr size_t WS_GATED = 281 * MiB;
static_assert(WS_WRT + 512 * 1024 <= WS_WGU && WS_WDN + 33 * MiB <= WS_XB && WS_XB + 32 * MiB <= WS_H && WS_H + 80 * MiB <= WS_Y && WS_Y + 257 * MiB <= WS_END, "ws map");
constexpr int CW_TMO = 0, CW_BAR = 64, CW_CNT = 4096;

constexpr int RING_BYTES = 131072;
constexpr int MISC_OFF = RING_BYTES;
constexpr int LDS_BYTES = 147456;
constexpr int MI_BARW = 0, MI_CNT = 64, MI_TSTART = 320, MI_YSTART = 576, MI_NTILES = 832, MI_TILE_E = 1024;

__device__ __forceinline__ unsigned cvt_pk_bf16(float lo, float hi) { unsigned r; asm volatile("v_cvt_pk_bf16_f32 %0, %1, %2" : "=v"(r) : "v"(lo), "v"(hi)); return r; }
__device__ __forceinline__ float bf_lo(unsigned w) { return __uint_as_float(w << 16); }
__device__ __forceinline__ float bf_hi(unsigned w) { return __uint_as_float(w & 0xffff0000u); }
__device__ __forceinline__ float wave_sum(float v) {
#pragma unroll
    for (int o = 1; o < 64; o <<= 1) v += __shfl_xor(v, o);
    return v;
}
__device__ __forceinline__ float sigmoidf_(float x) { return __builtin_amdgcn_rcpf(1.0f + __builtin_amdgcn_exp2f(-1.4426950408889634f * x)); }
__device__ __forceinline__ float gelu_tanh(float v) { const float y = v + 0.044715f * v * v * v; return v * __builtin_amdgcn_rcpf(1.0f + __builtin_amdgcn_exp2f(-2.3022081983f * y)); }

#define XB_TMO      128
#define XB_XCNT(j)  (256  + 64 * (j))
#define XB_XSUB(j)  (1280 + 64 * (j))
#define XB_XGEN(j)  (2304 + 64 * (j))
#define XB_TOP      3328
#define XB_TOPGEN   3392
#define XCD_BAR_WORDS 3456
#define XB_SPIN_CAP (1u << 20)
__device__ __forceinline__ unsigned xb_ld(unsigned* p)              { return __hip_atomic_load(p, __ATOMIC_RELAXED, __HIP_MEMORY_SCOPE_AGENT); }
__device__ __forceinline__ unsigned xb_add(unsigned* p, unsigned v) { return __hip_atomic_fetch_add(p, v, __ATOMIC_RELAXED, __HIP_MEMORY_SCOPE_AGENT); }
__device__ __forceinline__ unsigned xb_xcc_id() { return (unsigned)__builtin_amdgcn_s_getreg((3 << 11) | 20) & 0xFu; }
#define XB_SPIN(cond, bar) do { unsigned _sp = 0; while (cond) { __builtin_amdgcn_s_sleep(1); \
    if ((++_sp & 255u) == 0u) { if (xb_ld(&(bar)[XB_TMO])) break; if (_sp > XB_SPIN_CAP) { atomicAdd(&(bar)[XB_TMO], 1u); break; } } } } while (0)
struct XcdBarrier { unsigned* bar; unsigned x; volatile LAS unsigned* st; };
__device__ __forceinline__ XcdBarrier xcd_barrier_post(unsigned* bar, volatile LAS unsigned* st) {
    XcdBarrier b; b.bar = bar; b.x = xb_xcc_id(); b.st = st;
    if (threadIdx.x == 0) (void)xb_add(&bar[XB_XCNT(b.x)], 1u);
    return b;
}
__device__ __forceinline__ void xcd_barrier_complete(unsigned* bar, unsigned x, unsigned& nloc, unsigned& nx) {
    const unsigned G = gridDim.x * gridDim.y * gridDim.z;
    unsigned sum, cnt, mine, sp = 0u;
    for (;;) {
        sum = 0u; cnt = 0u; mine = 0u;
#pragma unroll
        for (unsigned j = 0; j < 16; ++j) { const unsigned c = xb_ld(&bar[XB_XCNT(j)]); sum += c; cnt += (c > 0u) ? 1u : 0u; mine = (j == x) ? c : mine; }
        if (sum == G) break;
        __builtin_amdgcn_s_sleep(1);
        if ((++sp & 255u) == 0u) { if (xb_ld(&bar[XB_TMO])) break; if (sp > XB_SPIN_CAP) { atomicAdd(&bar[XB_TMO], 1u); break; } }
    }
    nloc = mine > 0u ? mine : 1u; nx = cnt > 0u ? cnt : 1u;
}
__device__ __forceinline__ void xcd_barrier(const XcdBarrier& b) {
    asm volatile("s_waitcnt vmcnt(0)" ::: "memory");
    __syncthreads();
    if (threadIdx.x == 0) {
        unsigned* bar = b.bar;
        __builtin_amdgcn_s_waitcnt(0);
        unsigned nloc = b.st[0], nx = b.st[1];
        if (nloc == 0u) { xcd_barrier_complete(bar, b.x, nloc, nx); b.st[0] = nloc; b.st[1] = nx; }
        const unsigned old = xb_add(&bar[XB_XSUB(b.x)], 1u);
        const unsigned gen = old / nloc;
        if (old + 1u == (gen + 1u) * nloc) {
            __builtin_amdgcn_fence(__ATOMIC_RELEASE, "agent");
            asm volatile("s_waitcnt vmcnt(0)" ::: "memory");
            const unsigned og = xb_add(&bar[XB_TOP], 1u);
            const unsigned tg = og / nx;
            if (og + 1u == (tg + 1u) * nx) xb_add(&bar[XB_TOPGEN], 1u);
            else XB_SPIN(xb_ld(&bar[XB_TOPGEN]) == tg, bar);
            __builtin_amdgcn_fence(__ATOMIC_ACQUIRE, "agent");
            xb_add(&bar[XB_XGEN(b.x)], 1u);
            asm volatile("s_waitcnt vmcnt(0)" ::: "memory");
        } else {
            XB_SPIN(xb_ld(&bar[XB_XGEN(b.x)]) == gen, bar);
            __builtin_amdgcn_fence(__ATOMIC_ACQUIRE, "agent");
            asm volatile("s_waitcnt vmcnt(0)" ::: "memory");
        }
    }
    __syncthreads();
}

namespace pg8 {
constexpr int BM = 256, BK = 64, HALF = 128, HTB = HALF * BK * 2, STAGE_BYTES = 8 * HTB, NXCD = 8, WGM = 8;
__host__ __device__ __forceinline__ int lds_byte(int r, int c) { const int st = (r >> 4) * 2 + (c >> 5), rr = r & 15, cc = c & 31, ob = rr * 64 + cc * 2; return st * 1024 + (ob ^ (((ob >> 9) & 1) << 5)); }
__host__ __device__ __forceinline__ void stage_rc(int b, int& R, int& C) { const int st = b / 1024, sb = b % 1024, swz = sb ^ (((sb >> 9) & 1) << 5); R = (st >> 1) * 16 + swz / 64; C = (st & 1) * 32 + (swz % 64) / 2; }
__host__ __device__ __forceinline__ int perm32(int rho) { const int n = rho >> 4, i = rho & 15; return 8 * (i >> 2) + 4 * n + (i & 3); }

struct Unit { const char* A; const char* B; const unsigned* gat; int nvalid; int i0, i1, i2; };

template <class Epi, class Sched, bool GATHER, bool ALIGN_EPI, bool SP2, int BMODE = 0>
__device__ __forceinline__ void gemm_phase(LAS unsigned char* lds, const unsigned lda, const unsigned ldb, const int nt, const Sched& S, const Epi& E) {
    const int tid = threadIdx.x, wid = __builtin_amdgcn_readfirstlane(tid >> 6), lane = tid & 63, wr = wid >> 2, wc = wid & 3, fr = lane & 15, fq = lane >> 4;
    int R0, C0, R1, C1; stage_rc(tid * 16, R0, C0); stage_rc(tid * 16 + 8192, R1, C1);
    const int Rb0 = BMODE == 0 ? (R0 & ~31) + perm32(R0 & 31) : 64 * (R0 >> 5) + 16 * ((R0 & 15) >> 2) + 4 * ((R0 >> 4) & 1) + (R0 & 3);
    const int Rb1 = BMODE == 0 ? (R1 & ~31) + perm32(R1 & 31) : 64 * (R1 >> 5) + 16 * ((R1 & 15) >> 2) + 4 * ((R1 >> 4) & 1) + (R1 & 3);
    const unsigned voffB0 = (unsigned)Rb0 * ldb + (unsigned)C0 * 2u, voffB1 = (unsigned)Rb1 * ldb + (unsigned)C1 * 2u;
    const size_t hstepB = (size_t)(BMODE == 0 ? HALF : 8) * ldb;
    const size_t kstep = (size_t)(BK * 2);
    const unsigned ldsw = (unsigned)wid * 1024u;
    const int aoff = lds_byte(wr * 64 + fr, fq * 8), boff = lds_byte(wc * 32 + fr, fq * 8);
#define PG8_SA(b, h) (((b) * 2 + (h)) * HTB)
#define PG8_SB(b, h) ((4 + (b) * 2 + (h)) * HTB)
#define PG8_STAGE(bufoff, gbase, v0, v1) do { unsigned _v0 = (v0), _v1 = (v1); asm volatile("" : "+v"(_v0), "+v"(_v1)); \
        __builtin_amdgcn_global_load_lds((const unsigned*)((const char*)(gbase) + _v0), (LAS unsigned*)(lds + (bufoff) + ldsw), 16, 0, 0); \
        __builtin_amdgcn_global_load_lds((const unsigned*)((const char*)(gbase) + _v1), (LAS unsigned*)(lds + (bufoff) + ldsw + 8192), 16, 0, 0); } while (0)
#define PG8_LDA(dst, b, h) do { _Pragma("unroll") for (int m = 0; m < 4; ++m) _Pragma("unroll") for (int k = 0; k < 2; ++k) dst[m][k] = *(const LAS bf16x8*)(lds + PG8_SA(b, h) + aoff + m * 2048 + k * 1024); } while (0)
#define PG8_LDB(dst, b, h) do { _Pragma("unroll") for (int n = 0; n < 2; ++n) _Pragma("unroll") for (int k = 0; k < 2; ++k) dst[n][k] = *(const LAS bf16x8*)(lds + PG8_SB(b, h) + boff + n * 2048 + k * 1024); } while (0)
#define PG8_MMA(ai, bj, At, Bt) do { __builtin_amdgcn_s_setprio(1); _Pragma("unroll") for (int m = 0; m < 4; ++m) _Pragma("unroll") for (int n = 0; n < 2; ++n) _Pragma("unroll") for (int k = 0; k < 2; ++k) \
        acc[ai][bj][m][n] = __builtin_amdgcn_mfma_f32_16x16x32_bf16(Bt[n][k], At[m][k], acc[ai][bj][m][n], 0, 0, 0); __builtin_amdgcn_s_setprio(0); } while (0)
#define PG8_WAIT_V(n) asm volatile("s_waitcnt vmcnt(" #n ")" ::: "memory")
#define PG8_WAIT_L(n) asm volatile("s_waitcnt lgkmcnt(" #n ")" ::: "memory")
#define PG8_BAR __builtin_amdgcn_s_barrier()
#define PG8_SCHED __builtin_amdgcn_sched_barrier(0)
#define PG8_SETV(v00, v01, v10, v11, u) do { \
        if (GATHER) { const unsigned ta = R0 < (u).nvalid ? (u).gat[R0] : 0u, tb = R1 < (u).nvalid ? (u).gat[R1] : 0u, \
                                     tc = (HALF + R0) < (u).nvalid ? (u).gat[HALF + R0] : 0u, td = (HALF + R1) < (u).nvalid ? (u).gat[HALF + R1] : 0u; \
            v00 = ta * lda + (unsigned)C0 * 2u; v01 = tb * lda + (unsigned)C1 * 2u; v10 = tc * lda + (unsigned)C0 * 2u; v11 = td * lda + (unsigned)C1 * 2u; } \
        else { v00 = (unsigned)R0 * lda + (unsigned)C0 * 2u; v01 = (unsigned)R1 * lda + (unsigned)C1 * 2u; v10 = (unsigned)(HALF + R0) * lda + (unsigned)C0 * 2u; v11 = (unsigned)(HALF + R1) * lda + (unsigned)C1 * 2u; } } while (0)
    Unit cur, nxt; int ui = 0;
    if (!S.next(0, cur)) return;
    f32x4 acc[2][2][4][2];
#pragma unroll
    for (int a = 0; a < 2; ++a)
#pragma unroll
        for (int b = 0; b < 2; ++b)
#pragma unroll
            for (int m = 0; m < 4; ++m)
#pragma unroll
                for (int n = 0; n < 2; ++n) acc[a][b][m][n] = (f32x4){0.f, 0.f, 0.f, 0.f};
    bf16x8 At[4][2], B0[2][2], B1[2][2];
    const char* cA = cur.A; const char* cB = cur.B;
    unsigned cv00, cv01, cv10, cv11;
    PG8_SETV(cv00, cv01, cv10, cv11, cur);
    if constexpr (SP2) {
        PG8_STAGE(PG8_SB(0, 0), cB, voffB0, voffB1); PG8_STAGE(PG8_SB(0, 1), cB + hstepB, voffB0, voffB1); PG8_STAGE(PG8_SA(0, 0), cA, cv00, cv01); PG8_STAGE(PG8_SA(0, 1), cA, cv10, cv11);
        if (wr == 1) PG8_BAR;
        PG8_WAIT_V(2); PG8_BAR;
        PG8_STAGE(PG8_SB(1, 0), cB + kstep, voffB0, voffB1); PG8_STAGE(PG8_SA(1, 0), cA + kstep, cv00, cv01); PG8_STAGE(PG8_SB(1, 1), cB + hstepB + kstep, voffB0, voffB1);
        PG8_WAIT_V(6); PG8_BAR;
    } else {
        PG8_STAGE(PG8_SB(0, 0), cB, voffB0, voffB1); PG8_STAGE(PG8_SA(0, 0), cA, cv00, cv01); PG8_STAGE(PG8_SB(0, 1), cB + hstepB, voffB0, voffB1); PG8_STAGE(PG8_SA(0, 1), cA, cv10, cv11);
        if (wr == 1) PG8_BAR;
        PG8_WAIT_V(4); PG8_BAR;
        PG8_STAGE(PG8_SB(1, 0), cB + kstep, voffB0, voffB1); PG8_STAGE(PG8_SA(1, 0), cA + kstep, cv00, cv01); PG8_STAGE(PG8_SB(1, 1), cB + hstepB + kstep, voffB0, voffB1);
        PG8_WAIT_V(6); PG8_BAR;
    }
    for (;;) {
        const bool has_next = S.next(ui + 1, nxt);
        const char* nA = has_next ? nxt.A : cA; const char* nB = has_next ? nxt.B : cB;
        for (int t = 0; t < nt; t += 2) {
            const bool last = (t == nt - 2);
            const char* a1 = cA + (size_t)(t + 1) * kstep;
            const char* a2 = last ? nA : cA + (size_t)(t + 2) * kstep; const char* b2 = last ? nB : cB + (size_t)(t + 2) * kstep;
            const char* a3 = a2 + kstep; const char* b3 = b2 + kstep;
            if constexpr (SP2) {
            PG8_LDB(B0, 0, 0); PG8_LDB(B1, 0, 1); PG8_SCHED; PG8_LDA(At, 0, 0); PG8_STAGE(PG8_SA(1, 1), a1, cv10, cv11);
            PG8_WAIT_V(8); PG8_WAIT_L(0); PG8_BAR; PG8_MMA(0, 0, At, B0); PG8_MMA(0, 1, At, B1); PG8_BAR; PG8_SCHED;
            if constexpr (GATHER) { if (last && has_next) { PG8_SETV(cv00, cv01, cv10, cv11, nxt); } }
            PG8_LDA(At, 0, 1); PG8_STAGE(PG8_SB(0, 0), b2, voffB0, voffB1); PG8_STAGE(PG8_SB(0, 1), b2 + hstepB, voffB0, voffB1); PG8_STAGE(PG8_SA(0, 0), a2, cv00, cv01);
            PG8_WAIT_V(8); PG8_WAIT_L(0); PG8_BAR; PG8_MMA(1, 0, At, B0); PG8_MMA(1, 1, At, B1); PG8_BAR; PG8_SCHED;
            PG8_LDB(B0, 1, 0); PG8_LDB(B1, 1, 1); PG8_SCHED; PG8_LDA(At, 1, 0); PG8_STAGE(PG8_SA(0, 1), a2, cv10, cv11);
            PG8_WAIT_V(8); PG8_WAIT_L(0); PG8_BAR; PG8_MMA(0, 0, At, B0); PG8_MMA(0, 1, At, B1); PG8_BAR; PG8_SCHED;
            PG8_LDA(At, 1, 1); PG8_STAGE(PG8_SB(1, 0), b3, voffB0, voffB1); PG8_STAGE(PG8_SB(1, 1), b3 + hstepB, voffB0, voffB1); PG8_STAGE(PG8_SA(1, 0), a3, cv00, cv01);
            PG8_WAIT_V(8); PG8_WAIT_L(0); PG8_BAR; PG8_MMA(1, 0, At, B0); PG8_MMA(1, 1, At, B1); PG8_BAR; PG8_SCHED;
            } else {
            PG8_LDB(B0, 0, 0); PG8_SCHED; PG8_LDA(At, 0, 0); PG8_STAGE(PG8_SA(1, 1), a1, cv10, cv11);
            PG8_WAIT_L(8); PG8_BAR; PG8_WAIT_L(0); PG8_MMA(0, 0, At, B0); PG8_BAR; PG8_SCHED;
            if constexpr (GATHER) { if (last && has_next) { PG8_SETV(cv00, cv01, cv10, cv11, nxt); } }
            PG8_LDB(B1, 0, 1); PG8_STAGE(PG8_SB(0, 0), b2, voffB0, voffB1);
            PG8_BAR; PG8_WAIT_L(0); PG8_MMA(0, 1, At, B1); PG8_BAR;
            PG8_LDA(At, 0, 1); PG8_STAGE(PG8_SA(0, 0), a2, cv00, cv01);
            PG8_BAR; PG8_WAIT_L(0); PG8_MMA(1, 0, At, B0); PG8_BAR; PG8_SCHED;
            PG8_STAGE(PG8_SB(0, 1), b2 + hstepB, voffB0, voffB1);
            PG8_WAIT_V(6); PG8_BAR; PG8_MMA(1, 1, At, B1); PG8_BAR;
            PG8_LDB(B0, 1, 0); PG8_SCHED; PG8_LDA(At, 1, 0); PG8_STAGE(PG8_SA(0, 1), a2, cv10, cv11);
            PG8_WAIT_L(8); PG8_BAR; PG8_WAIT_L(0); PG8_MMA(0, 0, At, B0); PG8_BAR; PG8_SCHED;
            PG8_LDB(B1, 1, 1); PG8_STAGE(PG8_SB(1, 0), b3, voffB0, voffB1);
            PG8_BAR; PG8_WAIT_L(0); PG8_MMA(0, 1, At, B1); PG8_BAR;
            PG8_LDA(At, 1, 1); PG8_STAGE(PG8_SA(1, 0), a3, cv00, cv01);
            PG8_BAR; PG8_WAIT_L(0); PG8_MMA(1, 0, At, B0); PG8_BAR; PG8_SCHED;
            PG8_STAGE(PG8_SB(1, 1), b3 + hstepB, voffB0, voffB1);
            PG8_WAIT_V(6); PG8_BAR; PG8_MMA(1, 1, At, B1); PG8_BAR;
            }
        }
        if constexpr (ALIGN_EPI) { if (wr == 0) PG8_BAR; }
        E(acc, cur, wr, wc, fr, fq);
        if (!has_next) break;
#pragma unroll
        for (int a = 0; a < 2; ++a)
#pragma unroll
            for (int b = 0; b < 2; ++b)
#pragma unroll
                for (int m = 0; m < 4; ++m)
#pragma unroll
                    for (int n = 0; n < 2; ++n) acc[a][b][m][n] = (f32x4){0.f, 0.f, 0.f, 0.f};
        cur = nxt; cA = nA; cB = nB; ++ui;
        if constexpr (ALIGN_EPI) { if (wr == 1) PG8_BAR; }
    }
    PG8_WAIT_V(0);
    if constexpr (!ALIGN_EPI) { if (wr == 0) PG8_BAR; }
    PG8_BAR;
#undef PG8_SA
#undef PG8_SB
#undef PG8_STAGE
#undef PG8_LDA
#undef PG8_LDB
#undef PG8_MMA
#undef PG8_WAIT_V
#undef PG8_WAIT_L
#undef PG8_BAR
#undef PG8_SCHED
#undef PG8_SETV
}

struct DenseSched {
    const char* A; const char* B; unsigned lda, ldb, a_pn; int nM, nN, nwg, G, c;
    __device__ __forceinline__ bool next(int i, Unit& u) const {
        const long L = (long)i * G + c; if (L >= nwg) return false;
        int wgid = (int)L; { const int q = nwg / NXCD, r = nwg % NXCD, xcd = wgid % NXCD, off = wgid / NXCD; wgid = (xcd < r ? xcd * (q + 1) : r * (q + 1) + (xcd - r) * q) + off; }
        const int nig = WGM * nN, gid = wgid / nig, fm = gid * WGM, gsz = (nM - fm) < WGM ? (nM - fm) : WGM;
        const int pm = fm + ((wgid % nig) % gsz), pn = (wgid % nig) / gsz;
        u.A = A + (size_t)pm * BM * lda + (size_t)pn * a_pn; u.B = B + (size_t)pn * BM * ldb; u.gat = nullptr; u.nvalid = BM; u.i0 = pm; u.i1 = pn; u.i2 = 0; return true;
    }
};
struct MoeInfo { const LAS unsigned* cnt; const LAS unsigned* tstart; const LAS unsigned* ystart; const LAS unsigned char* tile_e; int ntiles; };
struct G1Sched {
    MoeInfo mi; const char* XB; const char* Wgu; const unsigned* rowtok; const unsigned* ident; int G, vcu;
    __device__ __forceinline__ bool next(int i, Unit& u) const {
        const int L = i * G + vcu; if (L >= 2 * mi.ntiles) return false;
        const int tile = L >> 1, uu = L & 1; int e;
        if (tile < 64) { e = 64; u.gat = ident + tile * 256; u.nvalid = 256; }
        else { e = __builtin_amdgcn_readfirstlane((int)mi.tile_e[tile]); const int pos0 = (tile - __builtin_amdgcn_readfirstlane((int)mi.tstart[e])) * 256; u.gat = rowtok + (size_t)e * CAP + pos0; const int rem = __builtin_amdgcn_readfirstlane((int)mi.cnt[e]) - pos0; u.nvalid = rem < 256 ? rem : 256; }
        u.A = XB; u.B = Wgu + ((size_t)e * 512 + (size_t)uu * 256) * 2048; u.i0 = tile; u.i1 = uu; u.i2 = 0; return true;
    }
};
struct G2Sched {
    MoeInfo mi; const char* H; const char* Wd; int G, vcu, L0;
    __device__ __forceinline__ bool next(int i, Unit& u) const {
        const int L = i * G + vcu + L0; if (L >= 4 * mi.ntiles) return false;
        const int tile = L >> 2, pn = L & 3; int e;
        if (tile < 64) { e = 64; u.i0 = tile * 256; u.i2 = 1; u.nvalid = 256; }
        else { e = __builtin_amdgcn_readfirstlane((int)mi.tile_e[tile]); const int pos0 = (tile - __builtin_amdgcn_readfirstlane((int)mi.tstart[e])) * 256; u.i0 = __builtin_amdgcn_readfirstlane((int)mi.ystart[e]) + pos0; u.i2 = 0; const int rem = __builtin_amdgcn_readfirstlane((int)mi.cnt[e]) - pos0; u.nvalid = rem < 256 ? rem : 256; }
        u.A = H + (size_t)tile * 256 * 512; u.B = Wd + ((size_t)e * 1024 + (size_t)pn * 256) * 512; u.gat = nullptr; u.i1 = pn; return true;
    }
};

template <int ACT, bool BIAS, bool SCALE> struct EpiBf16 {
    bf16* O; int ldo; const float* bias; const float* scale;
    __device__ __forceinline__ void operator()(const f32x4 (&acc)[2][2][4][2], const Unit& u, int wr, int wc, int fr, int fq) const {
        const int row0 = u.i0 * BM + wr * 64 + fr, col0 = u.i1 * BM + wc * 32 + 8 * fq;
        f32x4 bv[2][2], sv[2][2];
#pragma unroll
        for (int bj = 0; bj < 2; ++bj)
#pragma unroll
            for (int n = 0; n < 2; ++n) { bv[bj][n] = BIAS ? *(const f32x4*)(bias + col0 + bj * HALF + 4 * n) : (f32x4){0.f, 0.f, 0.f, 0.f}; sv[bj][n] = SCALE ? *(const f32x4*)(scale + col0 + bj * HALF + 4 * n) : (f32x4){1.f, 1.f, 1.f, 1.f}; }
#pragma unroll
        for (int ai = 0; ai < 2; ++ai)
#pragma unroll
            for (int m = 0; m < 4; ++m) { bf16* rowp = O + (size_t)(row0 + ai * HALF + m * 16) * ldo + col0;
#pragma unroll
                for (int bj = 0; bj < 2; ++bj) { f32x4 v0 = acc[ai][bj][m][0] + bv[bj][0], v1 = acc[ai][bj][m][1] + bv[bj][1];
                    if (ACT == 1) {
#pragma unroll
                        for (int j = 0; j < 4; ++j) { v0[j] = gelu_tanh(v0[j]); v1[j] = gelu_tanh(v1[j]); } }
                    if (SCALE) { v0 = v0 * sv[bj][0]; v1 = v1 * sv[bj][1]; }
                    v4u w; w.x = cvt_pk_bf16(v0[0], v0[1]); w.y = cvt_pk_bf16(v0[2], v0[3]); w.z = cvt_pk_bf16(v1[0], v1[1]); w.w = cvt_pk_bf16(v1[2], v1[3]);
                    *(v4u*)(rowp + bj * HALF) = w; } }
    }
};
struct EpiResid {
    const float* base; float* out;
    __device__ __forceinline__ void operator()(const f32x4 (&acc)[2][2][4][2], const Unit& u, int wr, int wc, int fr, int fq) const {
        const int row0 = u.i0 * BM + wr * 64 + fr, col0 = u.i1 * BM + wc * 32 + 8 * fq;
#pragma unroll
        for (int ai = 0; ai < 2; ++ai)
#pragma unroll
            for (int m = 0; m < 4; ++m) { const size_t off = (size_t)(row0 + ai * HALF + m * 16) * DM + col0;
#pragma unroll
                for (int bj = 0; bj < 2; ++bj) { const f32x4 b0 = *(const f32x4*)(base + off + bj * HALF), b1 = *(const f32x4*)(base + off + bj * HALF + 4);
                    *(f32x4*)(out + off + bj * HALF) = b0 * ALPHA + acc[ai][bj][m][0]; *(f32x4*)(out + off + bj * HALF + 4) = b1 * ALPHA + acc[ai][bj][m][1]; }
                asm volatile("" ::: "memory"); }
    }
};
struct EpiSwiglu {
    bf16* H;
    __device__ __forceinline__ void operator()(const f32x4 (&acc)[2][2][4][2], const Unit& u, int wr, int wc, int fr, int fq) const {
        const int row0 = u.i0 * BM + wr * 64 + fr, col0 = u.i1 * HALF + wc * 32 + 8 * fq;
#pragma unroll
        for (int ai = 0; ai < 2; ++ai)
#pragma unroll
            for (int m = 0; m < 4; ++m) { bf16* rowp = H + (size_t)(row0 + ai * HALF + m * 16) * EDIM + col0; float h[8];
#pragma unroll
                for (int n = 0; n < 2; ++n)
#pragma unroll
                    for (int j = 0; j < 4; ++j) { const float g = acc[ai][0][m][n][j], up = acc[ai][1][m][n][j]; h[4 * n + j] = g * sigmoidf_(g) * up; }
                v4u w; w.x = cvt_pk_bf16(h[0], h[1]); w.y = cvt_pk_bf16(h[2], h[3]); w.z = cvt_pk_bf16(h[4], h[5]); w.w = cvt_pk_bf16(h[6], h[7]);
                *(v4u*)rowp = w; }
    }
};
struct EpiDown {
    unsigned char* Y8; float* xf;
    __device__ __forceinline__ void operator()(const f32x4 (&acc)[2][2][4][2], const Unit& u, int wr, int wc, int fr, int fq) const {
        const int r0 = wr * 64 + fr, col0 = u.i1 * BM + wc * 64 + 16 * fq;
        if (u.i2) {
#pragma unroll
            for (int ai = 0; ai < 2; ++ai)
#pragma unroll
                for (int m = 0; m < 4; ++m) { float* p = xf + (size_t)(u.i0 + r0 + ai * HALF + m * 16) * DM + col0;
                    const f32x4 b0 = *(const f32x4*)p, b1 = *(const f32x4*)(p + 4), b2 = *(const f32x4*)(p + 8), b3 = *(const f32x4*)(p + 12);
                    *(f32x4*)p = b0 * ALPHA + acc[ai][0][m][0]; *(f32x4*)(p + 4) = b1 * ALPHA + acc[ai][0][m][1]; *(f32x4*)(p + 8) = b2 * ALPHA + acc[ai][1][m][0]; *(f32x4*)(p + 12) = b3 * ALPHA + acc[ai][1][m][1];
                    asm volatile("" ::: "memory"); }
        } else {
#pragma unroll
            for (int ai = 0; ai < 2; ++ai)
#pragma unroll
                for (int m = 0; m < 4; ++m) { const int r = r0 + ai * HALF + m * 16;
                    if (r < u.nvalid) { v4u w;
#pragma unroll
                        for (int q = 0; q < 4; ++q) { const f32x4 v = acc[ai][q >> 1][m][q & 1] * 16.0f; int t = 0; t = __builtin_amdgcn_cvt_pk_fp8_f32(v[0], v[1], t, false); t = __builtin_amdgcn_cvt_pk_fp8_f32(v[2], v[3], t, true); w[q] = (unsigned)t; }
                        *(v4u*)(Y8 + (size_t)(u.i0 + r) * DM + col0) = w; } }
        }
    }
};
}

struct Args { const float* in[24]; float* out; unsigned char* ws; int ph_lo, ph_hi; };
enum { I_X = 0, I_PWIN, I_PWGRP, I_PSCALE, I_PWOUT, I_SWIN, I_SBIN, I_SLNG, I_SLNB, I_SWS, I_SBS, I_SWOUT, I_LNMG, I_LNMB, I_WR, I_RB, I_WG, I_WU, I_WD, I_SHG, I_SHU, I_SHD, I_LNFG, I_LNFB };

__device__ __forceinline__ void tr_item(const float* W, int N, int k0, int n0, bf16* dst  , int dpitch, LAS float* scr, int lane) {
#pragma unroll 8
    for (int i = 0; i < 32; ++i) { const int kk = 2 * i + (lane >> 5); scr[kk * 33 + (lane & 31)] = W[(size_t)(k0 + kk) * N + n0 + (lane & 31)]; }
    LDS_WAIT(); asm volatile("" ::: "memory");
    const int c = lane & 7;
#pragma unroll
    for (int j = 0; j < 4; ++j) { const int n = (lane >> 3) + 8 * j; const LAS float* s = scr + (8 * c) * 33 + n;
        v4u o; o.x = cvt_pk_bf16(s[0 * 33], s[1 * 33]); o.y = cvt_pk_bf16(s[2 * 33], s[3 * 33]); o.z = cvt_pk_bf16(s[4 * 33], s[5 * 33]); o.w = cvt_pk_bf16(s[6 * 33], s[7 * 33]);
        *(v4u*)(dst + (size_t)n * dpitch + 8 * c) = o; }
    LDS_WAIT(); asm volatile("" ::: "memory");
}
__device__ __forceinline__ void tr_item_hilo(const float* W, int N, int k0, int n0, bf16* dh, bf16* dl, int dpitch, LAS float* scr, int lane) {
#pragma unroll 8
    for (int i = 0; i < 32; ++i) { const int kk = 2 * i + (lane >> 5); scr[kk * 33 + (lane & 31)] = W[(size_t)(k0 + kk) * N + n0 + (lane & 31)]; }
    LDS_WAIT(); asm volatile("" ::: "memory");
    const int c = lane & 7;
#pragma unroll
    for (int j = 0; j < 4; ++j) { const int n = (lane >> 3) + 8 * j; const LAS float* s = scr + (8 * c) * 33 + n; float w[8];
#pragma unroll
        for (int z = 0; z < 8; ++z) w[z] = s[z * 33];
        v4u o; o.x = cvt_pk_bf16(w[0], w[1]); o.y = cvt_pk_bf16(w[2], w[3]); o.z = cvt_pk_bf16(w[4], w[5]); o.w = cvt_pk_bf16(w[6], w[7]);
        v4u l; l.x = cvt_pk_bf16(w[0] - bf_lo(o.x), w[1] - bf_hi(o.x)); l.y = cvt_pk_bf16(w[2] - bf_lo(o.y), w[3] - bf_hi(o.y)); l.z = cvt_pk_bf16(w[4] - bf_lo(o.z), w[5] - bf_hi(o.z)); l.w = cvt_pk_bf16(w[6] - bf_lo(o.w), w[7] - bf_hi(o.w));
        *(v4u*)(dh + (size_t)n * dpitch + 8 * c) = o; *(v4u*)(dl + (size_t)n * dpitch + 8 * c) = l; }
    LDS_WAIT(); asm volatile("" ::: "memory");
}
__device__ __forceinline__ void convert_moe_layer(const Args& a, int layer, LAS unsigned char* lds, int gw, int NGW, int wave, int lane) {
    LAS float* scr = (LAS float*)(lds + wave * 16384);
    bf16* WGU = (bf16*)(a.ws + WS_WGU); bf16* WDN = (bf16*)(a.ws + WS_WDN);
    constexpr int PER_E = 384, NIT = 65 * PER_E;
    for (int it = gw; it < NIT; it += NGW) {
        const int e = it / PER_E, r = it % PER_E;
        if (r < 256) { const int isup = r >> 7, rr = r & 127, kb = rr >> 3, nb = rr & 7, n0 = 32 * nb, k0 = 64 * kb;
            const float* src = (e < 64) ? a.in[isup ? I_WU : I_WG] + ((size_t)layer * 64 + e) * 262144 : a.in[isup ? I_SHU : I_SHG] + (size_t)layer * 262144;
            const int drow = e * 512 + (n0 >> 7) * 256 + isup * 128 + (n0 & 127);
            tr_item(src, 256, k0, n0, WGU + (size_t)drow * 1024 + k0, 1024, scr, lane);
        } else { const int rr = r - 256, kb = rr >> 5, nb = rr & 31, n0 = 32 * nb, k0 = 64 * kb;
            const float* src = (e < 64) ? a.in[I_WD] + ((size_t)layer * 64 + e) * 262144 : a.in[I_SHD] + (size_t)layer * 262144;
            tr_item(src, 1024, k0, n0, WDN + ((size_t)e * 1024 + n0) * 256 + k0, 256, scr, lane);
        }
    }
}
__device__ __forceinline__ void phase_p0(const Args& a, LAS unsigned char* lds, int vcu, int G) {
    const int tid = threadIdx.x, lane = tid & 63, wave = __builtin_amdgcn_readfirstlane(tid >> 6);
    const int gw = vcu * NWAVES + wave, NGW = G * NWAVES;
    LAS float* scr = (LAS float*)(lds + wave * 16384);
    constexpr int I_IN = 16 * 32, I_GRP = 4 * 4 * 8, I_OUT = 16 * 32, I_SIN = 16 * 128, I_SOUT = 32 * 32, NIT = I_IN + I_GRP + I_OUT + I_SIN + I_SOUT;
    for (int it = gw; it < NIT; it += NGW) {
        int r = it;
        if (r < I_IN) { const int kb = r >> 5, nb = r & 31; tr_item(a.in[I_PWIN], 1024, 64 * kb, 32 * nb, (bf16*)(a.ws + WS_WIN) + (size_t)(32 * nb) * 1024 + 64 * kb, 1024, scr, lane); continue; } r -= I_IN;
        if (r < I_GRP) { const int g = r >> 5, rr = r & 31, kb = rr >> 3, nb = rr & 7; tr_item(a.in[I_PWGRP] + (size_t)g * 65536, 256, 64 * kb, 32 * nb, (bf16*)(a.ws + WS_WGRP) + (size_t)(g * 256 + 32 * nb) * 256 + 64 * kb, 256, scr, lane); continue; } r -= I_GRP;
        if (r < I_OUT) { const int kb = r >> 5, nb = r & 31; tr_item(a.in[I_PWOUT], 1024, 64 * kb, 32 * nb, (bf16*)(a.ws + WS_WOUT) + (size_t)(32 * nb) * 1024 + 64 * kb, 1024, scr, lane); continue; } r -= I_OUT;
        if (r < I_SIN) { const int kb = r >> 7, nb = r & 127; tr_item(a.in[I_SWIN], 4096, 64 * kb, 32 * nb, (bf16*)(a.ws + WS_WSIN) + (size_t)(32 * nb) * 1024 + 64 * kb, 1024, scr, lane); continue; } r -= I_SIN;
        { const int kb = r >> 5, nb = r & 31; tr_item(a.in[I_SWOUT], 1024, 64 * kb, 32 * nb, (bf16*)(a.ws + WS_WSOUT) + (size_t)(32 * nb) * 2048 + 64 * kb, 2048, scr, lane); }
    }
    for (int it = gw; it < 64; it += NGW) { const int layer = it >> 5, rr = it & 31, kb = rr >> 1, nb = rr & 1; bf16* base = (bf16*)(a.ws + WS_WRT) + (size_t)layer * 2 * 65536 + (size_t)(32 * nb) * 1024 + 64 * kb;
        tr_item_hilo(a.in[I_WR] + (size_t)layer * DM * NE, 64, 64 * kb, 32 * nb, base, base + 65536, 1024, scr, lane); }
    convert_moe_layer(a, 0, lds, gw, NGW, wave, lane);
    const float* x = a.in[I_X]; bf16* xb = (bf16*)(a.ws + WS_XB);
    const size_t gt = (size_t)vcu * NTHR + tid, NT = (size_t)G * NTHR;
    for (size_t i = gt; i < (size_t)T_TOK * DM / 8; i += NT) { const f32x4 p = *(const f32x4*)(x + i * 8), q = *(const f32x4*)(x + i * 8 + 4);
        v4u w; w.x = cvt_pk_bf16(p[0], p[1]); w.y = cvt_pk_bf16(p[2], p[3]); w.z = cvt_pk_bf16(q[0], q[1]); w.w = cvt_pk_bf16(q[2], q[3]); *(v4u*)(xb + i * 8) = w; }
    unsigned* ident = (unsigned*)(a.ws + WS_IDENT);
    for (size_t i = gt; i < (size_t)T_TOK; i += NT) ident[i] = (unsigned)i;
}

template <int W> __device__ __forceinline__ void pool_item(const bf16* zp  , bf16* op  , int p0  ) {
    v4u q[W + 3];
#pragma unroll
    for (int i = 0; i < W + 3; ++i) { const int ii = i < p0 + 3 ? i : p0 + 3; q[i] = *(const v4u*)(zp - (size_t)ii * DM); }
#pragma unroll
    for (int o = 0; o < 4; ++o) {
        float s[8];
#pragma unroll
        for (int j = 0; j < 8; ++j) s[j] = 0.f;
#pragma unroll
        for (int i = 3 - o; i < 3 - o + W; ++i) { const float m = (i <= p0 + 3) ? 1.0f : 0.0f;
#pragma unroll
            for (int j = 0; j < 4; ++j) { s[2 * j] += m * bf_lo(q[i][j]); s[2 * j + 1] += m * bf_hi(q[i][j]); } }
        const int p = p0 + o, nw = (p + 1) < W ? (p + 1) : W; const float inv = 1.0f / (float)nw; v4u ov;
#pragma unroll
        for (int j = 0; j < 4; ++j) ov[j] = cvt_pk_bf16(s[2 * j] * inv - bf_lo(q[3 - o][j]), s[2 * j + 1] * inv - bf_hi(q[3 - o][j]));
        *(v4u*)(op + (size_t)o * DM) = ov; }
}
__device__ __forceinline__ void phase_pool(const Args& a, int vcu, int G) {
    const bf16* Z = (const bf16*)(a.ws + WS_Z); bf16* P = (bf16*)(a.ws + WS_POOLED);
    const int tid = threadIdx.x, wave = tid >> 6, lane = tid & 63;
    const int gw = vcu * NWAVES + wave, NGW = G * NWAVES;
    for (int it = gw; it < (T_TOK / 4) * 2; it += NGW) {
        const int t0 = (it >> 1) * 4, c8 = (it & 1) * 64 + lane, g = c8 >> 5, p0 = t0 & (SEQ - 1);
        const bf16* zp = Z + (size_t)(t0 + 3) * DM + c8 * 8; bf16* op = P + (size_t)t0 * DM + c8 * 8;
        if (g == 0) pool_item<2>(zp, op, p0); else if (g == 1) pool_item<4>(zp, op, p0); else if (g == 2) pool_item<8>(zp, op, p0); else pool_item<16>(zp, op, p0);
    }
}

template <int R> __device__ __forceinline__ void ln_rows_store(float (&v)[R][16], const float* g, const float* b, float* const (&of)[R], bf16* const (&ob)[R], int lane) {
    float s[R], s2[R];
#pragma unroll
    for (int r = 0; r < R; ++r) { s[r] = 0.f;
#pragma unroll
        for (int i = 0; i < 16; ++i) s[r] += v[r][i]; }
#pragma unroll
    for (int o = 1; o < 64; o <<= 1)
#pragma unroll
        for (int r = 0; r < R; ++r) s[r] += __shfl_xor(s[r], o);
#pragma unroll
    for (int r = 0; r < R; ++r) { const float mean = s[r] * (1.0f / DM); s2[r] = 0.f;
#pragma unroll
        for (int i = 0; i < 16; ++i) { v[r][i] -= mean; s2[r] += v[r][i] * v[r][i]; } }
#pragma unroll
    for (int o = 1; o < 64; o <<= 1)
#pragma unroll
        for (int r = 0; r < R; ++r) s2[r] += __shfl_xor(s2[r], o);
#pragma unroll
    for (int j = 0; j < 2; ++j) { const int c = 8 * lane + 512 * j;
        const f32x4 g0 = *(const f32x4*)(g + c), g1 = *(const f32x4*)(g + c + 4), b0 = *(const f32x4*)(b + c), b1 = *(const f32x4*)(b + c + 4);
#pragma unroll
        for (int r = 0; r < R; ++r) { const float rstd = 1.0f / sqrtf(s2[r] * (1.0f / DM) + LN_EPS); f32x4 y0, y1;
#pragma unroll
            for (int q = 0; q < 4; ++q) { y0[q] = v[r][8 * j + q] * rstd * g0[q] + b0[q]; y1[q] = v[r][8 * j + 4 + q] * rstd * g1[q] + b1[q]; }
            *(f32x4*)(of[r] + c) = y0; *(f32x4*)(of[r] + c + 4) = y1;
            v4u w; w.x = cvt_pk_bf16(y0[0], y0[1]); w.y = cvt_pk_bf16(y0[2], y0[3]); w.z = cvt_pk_bf16(y1[0], y1[1]); w.w = cvt_pk_bf16(y1[2], y1[3]);
            *(v4u*)(ob[r] + c) = w; } }
}

__device__ __forceinline__ void phase_lnr(const Args& a, int layer, LAS unsigned char* lds, int vcu, int G, bool dry) {
    const int tid = threadIdx.x, lane = tid & 63, wave = __builtin_amdgcn_readfirstlane(tid >> 6);
    const float* xin = a.out; float* xf = dry ? (float*)(a.ws + WS_Y) : a.out; bf16* xb = dry ? (bf16*)(a.ws + WS_Y + 72 * MiB) : (bf16*)(a.ws + WS_XB);
    const float* lng = a.in[I_LNMG] + layer * DM; const float* lnb = a.in[I_LNMB] + layer * DM;
    const float* Wr = a.in[I_WR] + (size_t)layer * DM * NE; const float* rbias = a.in[I_RB] + layer * NE;
    unsigned* gcount = (unsigned*)(a.ws + WS_CTL) + CW_CNT + layer * 64 + (dry ? 128 : 0);
    unsigned* rowtok = dry ? (unsigned*)(a.ws + WS_Y + 64 * MiB) : (unsigned*)(a.ws + WS_ROWTOK); unsigned* dest = dry ? (unsigned*)(a.ws + WS_Y + 68 * MiB) : (unsigned*)(a.ws + WS_DEST); float* gatev = dry ? (float*)(a.ws + WS_Y + 69 * MiB) : (float*)(a.ws + WS_GATE);
    LAS float* part = (LAS float*)lds;
    LAS float* mb = (LAS float*)(lds + 32768);
    LAS float* gs = (LAS float*)(lds + 49152);
    LAS unsigned* hist = (LAS unsigned*)(lds + 51200);
    LAS unsigned* basep = (LAS unsigned*)(lds + 51456);
    for (int blk = vcu; blk < T_TOK / 64; blk += G) {
        const int row0 = blk * 64;
        if (tid < 64) hist[tid] = 0u;
#pragma unroll 1
        for (int h4 = 0; h4 < 2; ++h4) { float v[4][16]; float* of[4]; bf16* ob[4];
#pragma unroll
            for (int r = 0; r < 4; ++r) { const int rr = wave * 8 + h4 * 4 + r; const float* xr = xin + (size_t)(row0 + rr) * DM; of[r] = xf + (size_t)(row0 + rr) * DM; ob[r] = xb + (size_t)(row0 + rr) * DM;
#pragma unroll
                for (int j = 0; j < 2; ++j) { const f32x4 p = *(const f32x4*)(xr + 8 * lane + 512 * j), q = *(const f32x4*)(xr + 8 * lane + 512 * j + 4);
#pragma unroll
                    for (int i = 0; i < 4; ++i) { v[r][8 * j + i] = p[i]; v[r][8 * j + 4 + i] = q[i]; } } }
            ln_rows_store<4>(v, lng, lnb, of, ob, lane); }
        VM_WAIT(); __syncthreads();
#ifndef DRY_PARTS
#define DRY_PARTS 7
#endif
        if (!dry || (DRY_PARTS & 2)) { const int mt = wave & 3, kh = wave >> 2, r = lane & 15, g = lane >> 4;
          f32x4 acc[4];
#pragma unroll
          for (int n = 0; n < 4; ++n) acc[n] = (f32x4){0.f, 0.f, 0.f, 0.f};
          const float* arow = xf + (size_t)(row0 + 16 * mt + r) * DM + kh * 512 + 8 * g;
          const bf16* bh = (const bf16*)(a.ws + WS_WRT) + (size_t)layer * 2 * 65536 + (size_t)r * 1024 + kh * 512 + 8 * g; const bf16* bl = bh + 65536;
          f32x4 a0 = *(const f32x4*)arow, a1 = *(const f32x4*)(arow + 4); bf16x8 wh[4], wl[4];
#pragma unroll
          for (int n = 0; n < 4; ++n) { wh[n] = *(const bf16x8*)(bh + (size_t)n * 16384); wl[n] = *(const bf16x8*)(bl + (size_t)n * 16384); }
#pragma unroll 1
          for (int s = 0; s < 16; ++s) { const int sn = s < 15 ? s + 1 : s;
              const f32x4 n0 = *(const f32x4*)(arow + 32 * sn), n1 = *(const f32x4*)(arow + 32 * sn + 4); bf16x8 nh[4], nl[4];
#pragma unroll
              for (int n = 0; n < 4; ++n) { nh[n] = *(const bf16x8*)(bh + (size_t)n * 16384 + 32 * sn); nl[n] = *(const bf16x8*)(bl + (size_t)n * 16384 + 32 * sn); }
              v4u hi, lo; hi.x = cvt_pk_bf16(a0[0], a0[1]); hi.y = cvt_pk_bf16(a0[2], a0[3]); hi.z = cvt_pk_bf16(a1[0], a1[1]); hi.w = cvt_pk_bf16(a1[2], a1[3]);
              lo.x = cvt_pk_bf16(a0[0] - bf_lo(hi.x), a0[1] - bf_hi(hi.x)); lo.y = cvt_pk_bf16(a0[2] - bf_lo(hi.y), a0[3] - bf_hi(hi.y));
              lo.z = cvt_pk_bf16(a1[0] - bf_lo(hi.z), a1[1] - bf_hi(hi.z)); lo.w = cvt_pk_bf16(a1[2] - bf_lo(hi.w), a1[3] - bf_hi(hi.w));
              const bf16x8 ah = __builtin_bit_cast(bf16x8, hi), al = __builtin_bit_cast(bf16x8, lo);
#pragma unroll
              for (int n = 0; n < 4; ++n) { acc[n] = __builtin_amdgcn_mfma_f32_16x16x32_bf16(ah, wh[n], acc[n], 0, 0, 0); acc[n] = __builtin_amdgcn_mfma_f32_16x16x32_bf16(al, wh[n], acc[n], 0, 0, 0); acc[n] = __builtin_amdgcn_mfma_f32_16x16x32_bf16(ah, wl[n], acc[n], 0, 0, 0); }
              a0 = n0; a1 = n1;
#pragma unroll
              for (int n = 0; n < 4; ++n) { wh[n] = nh[n]; wl[n] = nl[n]; } }
#pragma unroll
          for (int n = 0; n < 4; ++n)
#pragma unroll
              for (int q = 0; q < 4; ++q) part[(kh * 64 + 16 * mt + 4 * g + q) * 64 + 16 * n + r] = acc[n][q]; }
        __syncthreads();
        if (!dry || (DRY_PARTS & 4)) { const int row = tid >> 3, grp = tid & 7; float sc[8], bsd[8];
#pragma unroll
          for (int i = 0; i < 8; ++i) { const int e = 8 * grp + i; const float lg = part[row * 64 + e] + part[(64 + row) * 64 + e]; sc[i] = 1.0f / (1.0f + __expf(-lg)); bsd[i] = sc[i] + rbias[e]; }
          float m1 = -INFINITY, m2 = -INFINITY;
#pragma unroll
          for (int i = 0; i < 8; ++i) { const float v = bsd[i]; if (v > m1) { m2 = m1; m1 = v; } else if (v > m2) m2 = v; }
          const float myg = m1 + m2;
          int grank = 0;
#pragma unroll
          for (int d = 1; d < 8; ++d) { const float o = __shfl(myg, (lane & ~7) | ((grp + d) & 7)); const int g2 = (grp + d) & 7; grank += (o > myg || (o == myg && g2 < grp)) ? 1 : 0; }
          const bool gsel = grank < 4;
          float cand[8]; int rk[8]; bool sel[8];
#pragma unroll
          for (int i = 0; i < 8; ++i) { cand[i] = gsel ? bsd[i] : -INFINITY; rk[i] = 0; sel[i] = false; }
#pragma unroll 1
          for (int k = 0; k < TOPK; ++k) {
              float best = cand[0]; int bi = 0;
#pragma unroll
              for (int i = 1; i < 8; ++i) if (cand[i] > best) { best = cand[i]; bi = i; }
              int gi = 8 * grp + bi;
#pragma unroll
              for (int off = 1; off < 8; off <<= 1) { const float ov = __shfl_xor(best, off); const int oi = __shfl_xor(gi, off); if (ov > best || (ov == best && oi < gi)) { best = ov; gi = oi; } }
#pragma unroll
              for (int i = 0; i < 8; ++i) if (gi == 8 * grp + i) { cand[i] = -INFINITY; rk[i] = k; sel[i] = true; }
          }
          float psum = 0.f;
#pragma unroll
          for (int i = 0; i < 8; ++i) psum += sel[i] ? sc[i] : 0.f;
          psum += __shfl_xor(psum, 1); psum += __shfl_xor(psum, 2); psum += __shfl_xor(psum, 4);
          const float inv = ROUTED_SCALE / psum;
          unsigned loc[8];
#pragma unroll
          for (int i = 0; i < 8; ++i) { loc[i] = 0u; if (sel[i]) loc[i] = __hip_atomic_fetch_add(hist + 8 * grp + i, 1u, __ATOMIC_RELAXED, __HIP_MEMORY_SCOPE_WORKGROUP); }
          __syncthreads();
          if (tid < 64) { const unsigned h = hist[tid]; basep[tid] = h ? __hip_atomic_fetch_add(gcount + tid, h, RLX_AGENT) : 0u; }
          __syncthreads();
          const int tok = row0 + row;
#pragma unroll
          for (int i = 0; i < 8; ++i) if (sel[i]) { const int e = 8 * grp + i; const unsigned pos = basep[e] + loc[i];
              rowtok[(size_t)e * CAP + pos] = (unsigned)tok; dest[tok * 8 + rk[i]] = ((unsigned)e << 16) | pos; gatev[tok * 8 + rk[i]] = sc[i] * inv; }
        }
        __syncthreads();
    }
}

__device__ __forceinline__ pg8::MoeInfo moe_setup(const Args& a, int layer, LAS unsigned char* misc) {
    const int tid = threadIdx.x;
    unsigned* gcount = (unsigned*)(a.ws + WS_CTL) + CW_CNT + layer * 64;
    LAS unsigned* cnt = (LAS unsigned*)(misc + MI_CNT); LAS unsigned* tstart = (LAS unsigned*)(misc + MI_TSTART); LAS unsigned* ystart = (LAS unsigned*)(misc + MI_YSTART);
    LAS unsigned* ntl = (LAS unsigned*)(misc + MI_NTILES); LAS unsigned char* tile_e = (LAS unsigned char*)(misc + MI_TILE_E);
    __syncthreads();
    if (tid < 64) { unsigned c = __hip_atomic_load(gcount + tid, RLX_AGENT); if (c > (unsigned)CAP) c = CAP; cnt[tid] = c; }
    __syncthreads();
    if (tid < 64) { unsigned ts = 64u, ys = 0u; for (int e = 0; e < tid; ++e) { const unsigned c = cnt[e]; ts += (c + 255u) >> 8; ys += c; }
        tstart[tid] = ts; ystart[tid] = ys; const unsigned mynt = (cnt[tid] + 255u) >> 8;
        for (unsigned i = 0; i < mynt; ++i) if (ts + i < 640u) tile_e[ts + i] = (unsigned char)tid;
        if (tid == 63) ntl[0] = ts + mynt; }
    __syncthreads();
    pg8::MoeInfo mi; mi.cnt = cnt; mi.tstart = tstart; mi.ystart = ystart; mi.tile_e = tile_e; mi.ntiles = __builtin_amdgcn_readfirstlane((int)ntl[0]);
    if (mi.ntiles > 640) mi.ntiles = 640;
    return mi;
}

__device__ __forceinline__ void phase_combine(const Args& a, int layer, LAS unsigned char* misc, int vcu, int G, bool dry) {
    const int tid = threadIdx.x, lane = tid & 63, wave = __builtin_amdgcn_readfirstlane(tid >> 6);
    const pg8::MoeInfo mi = moe_setup(a, layer, misc);
    float* xf = a.out; bf16* xb = (bf16*)(a.ws + WS_XB); const unsigned char* Y8 = (const unsigned char*)(a.ws + WS_Y);
    const unsigned* dest = (const unsigned*)(a.ws + WS_DEST); const float* gatev = (const float*)(a.ws + WS_GATE);
    const float* lng = a.in[I_LNFG] + layer * DM; const float* lnb = a.in[I_LNFB] + layer * DM;
    const int gw = vcu * NWAVES + wave, NGW = G * NWAVES;
#pragma unroll 1
    for (int rowa = gw; rowa < T_TOK; rowa += 2 * NGW) {
        float v[2][16]; float* of[2]; bf16* ob[2]; unsigned d[2][TOPK]; float gk[2][TOPK];
#pragma unroll
        for (int r = 0; r < 2; ++r) { const int row = rowa + r * NGW;
#pragma unroll
            for (int k = 0; k < TOPK; ++k) { d[r][k] = dest[row * 8 + k]; gk[r][k] = gatev[row * 8 + k]; } }
#pragma unroll
        for (int r = 0; r < 2; ++r) { const int row = rowa + r * NGW; float* xr = xf + (size_t)row * DM; of[r] = dry ? (float*)(a.ws + WS_H) + (size_t)row * DM : xr; ob[r] = xb + (size_t)row * DM;
#pragma unroll
            for (int j = 0; j < 2; ++j) { const f32x4 p = *(const f32x4*)(xr + 8 * lane + 512 * j), q = *(const f32x4*)(xr + 8 * lane + 512 * j + 4);
#pragma unroll
                for (int i = 0; i < 4; ++i) { v[r][8 * j + i] = p[i]; v[r][8 * j + 4 + i] = q[i]; } } }
#pragma unroll
        for (int r = 0; r < 2; ++r)
#pragma unroll
            for (int k = 0; k < TOPK; ++k) { const unsigned dd = (unsigned)__builtin_amdgcn_readfirstlane((int)d[r][k]); const float g = __uint_as_float((unsigned)__builtin_amdgcn_readfirstlane((int)__float_as_uint(gk[r][k])));
                const unsigned e = (dd >> 16) & 63u, pos = dd & 0xffffu; const unsigned char* yr = Y8 + (size_t)(mi.ystart[e] + pos) * DM; const float g16 = g * 0.0625f;
#pragma unroll
                for (int j = 0; j < 2; ++j) { const v2u w = *(const v2u*)(yr + 8 * lane + 512 * j);
#pragma unroll
                    for (int q = 0; q < 2; ++q) { const f32x2 lo2 = __builtin_amdgcn_cvt_pk_f32_fp8((int)w[q], false), hi2 = __builtin_amdgcn_cvt_pk_f32_fp8((int)w[q], true);
                        v[r][8 * j + 4 * q] += g16 * lo2.x; v[r][8 * j + 4 * q + 1] += g16 * lo2.y; v[r][8 * j + 4 * q + 2] += g16 * hi2.x; v[r][8 * j + 4 * q + 3] += g16 * hi2.y; } } }
        ln_rows_store<2>(v, lng, lnb, of, ob, lane);
    }
}

__device__ __forceinline__ int swz16(int row) { return (row ^ (row >> 4)) & 15; }
__device__ __forceinline__ void phase_sgu_spatial(const Args& a, LAS unsigned char* lds, int vcu, int G) {
    const int tid = threadIdx.x, lane = tid & 63, wave = __builtin_amdgcn_readfirstlane(tid >> 6), fr = lane & 15, fq = lane >> 4;
    const bf16* HS = (const bf16*)(a.ws + WS_HS); bf16* GT = (bf16*)(a.ws + WS_GATED);
    const float* lng = a.in[I_SLNG]; const float* lnb = a.in[I_SLNB]; const float* WS = a.in[I_SWS]; const float* BS = a.in[I_SBS];
    LAS unsigned char* Bs = lds;
    LAS unsigned char* As = lds + 65536;
    LAS float* stm = (LAS float*)(lds + 98304);
    LAS float* str = (LAS float*)(lds + 98304 + 512);
    for (int item = vcu; item < 512; item += G) {
        const int chunk = item >> 2, h = item & 3, t0 = chunk * 128;
        __syncthreads();
        for (int rr = 0; rr < 16; ++rr) { const int j = wave * 16 + rr; const bf16* vr = HS + (size_t)(t0 + j) * 4096 + SGU_W; float x[32]; float s = 0.f;
#pragma unroll
            for (int q = 0; q < 4; ++q) { const v4u w = *(const v4u*)(vr + 8 * lane + 512 * q);
#pragma unroll
                for (int p = 0; p < 4; ++p) { x[8 * q + 2 * p] = bf_lo(w[p]); x[8 * q + 2 * p + 1] = bf_hi(w[p]); s += x[8 * q + 2 * p] + x[8 * q + 2 * p + 1]; } }
            const float mean = wave_sum(s) * (1.0f / SGU_W); float s2 = 0.f;
#pragma unroll
            for (int i = 0; i < 32; ++i) { const float d = x[i] - mean; s2 += d * d; }
            const float rstd = 1.0f / sqrtf(wave_sum(s2) * (1.0f / SGU_W) + LN_EPS);
            if (lane == 0) { stm[j] = mean; str[j] = rstd; } }
        for (int q = tid; q < 128 * 16; q += NTHR) { const int i = q >> 4, jc = q & 15; const float* wp = WS + ((size_t)h * 128 + i) * 128 + 8 * jc;
            const f32x4 p0 = *(const f32x4*)wp, p1 = *(const f32x4*)(wp + 4); float w8[8];
#pragma unroll
            for (int z = 0; z < 4; ++z) { w8[z] = (8 * jc + z <= i) ? p0[z] : 0.f; w8[4 + z] = (8 * jc + 4 + z <= i) ? p1[z] : 0.f; }
            v4u o; o.x = cvt_pk_bf16(w8[0], w8[1]); o.y = cvt_pk_bf16(w8[2], w8[3]); o.z = cvt_pk_bf16(w8[4], w8[5]); o.w = cvt_pk_bf16(w8[6], w8[7]);
            *(LAS v4u*)(As + i * 256 + ((jc ^ swz16(i)) << 4)) = o; }
        __syncthreads();
        for (int hh = 0; hh < 2; ++hh) {
            const int cb = h * SGU_HD + hh * 256;
            for (int q = tid; q < 64 * 32; q += NTHR) { const int c8 = q & 31, jp = q >> 5, j0 = 2 * jp;
                const v4u w0 = *(const v4u*)(HS + (size_t)(t0 + j0) * 4096 + SGU_W + cb + 8 * c8), w1 = *(const v4u*)(HS + (size_t)(t0 + j0 + 1) * 4096 + SGU_W + cb + 8 * c8);
                const f32x4 g0 = *(const f32x4*)(lng + cb + 8 * c8), g1 = *(const f32x4*)(lng + cb + 8 * c8 + 4), b0 = *(const f32x4*)(lnb + cb + 8 * c8), b1 = *(const f32x4*)(lnb + cb + 8 * c8 + 4);
                const float m0 = stm[j0], r0 = str[j0], m1 = stm[j0 + 1], r1 = str[j0 + 1];
#pragma unroll
                for (int z = 0; z < 8; ++z) { const float gz = z < 4 ? g0[z & 3] : g1[z & 3], bz = z < 4 ? b0[z & 3] : b1[z & 3];
                    const float xa = (z & 1) ? bf_hi(w0[z >> 1]) : bf_lo(w0[z >> 1]), xc = (z & 1) ? bf_hi(w1[z >> 1]) : bf_lo(w1[z >> 1]);
                    const float ya = (xa - m0) * r0 * gz + bz, yc = (xc - m1) * r1 * gz + bz;
                    const int cc = 8 * c8 + z, slot = (cc & ~31) | (((cc >> 2) & 1) << 4) | (((cc >> 3) & 3) << 2) | (cc & 3);
                    *(LAS unsigned*)(Bs + slot * 256 + (((j0 >> 3) ^ swz16(slot)) << 4) + (j0 & 7) * 2) = cvt_pk_bf16(ya, yc); } }
            __syncthreads();
            f32x4 acc[8][2]; bf16x8 Bf[2][4];
#pragma unroll
            for (int n = 0; n < 2; ++n)
#pragma unroll
                for (int s = 0; s < 4; ++s) { const int slot = 32 * wave + 16 * n + fr; Bf[n][s] = *(const LAS bf16x8*)(Bs + slot * 256 + (((4 * s + fq) ^ swz16(slot)) << 4)); }
#pragma unroll
            for (int m = 0; m < 8; ++m) { acc[m][0] = (f32x4){0.f, 0.f, 0.f, 0.f}; acc[m][1] = (f32x4){0.f, 0.f, 0.f, 0.f};
#pragma unroll
                for (int s = 0; s < 4; ++s) if (s <= (m >> 1)) { const int i = 16 * m + fr; const bf16x8 af = *(const LAS bf16x8*)(As + i * 256 + (((4 * s + fq) ^ swz16(i)) << 4));
                    acc[m][0] = __builtin_amdgcn_mfma_f32_16x16x32_bf16(Bf[0][s], af, acc[m][0], 0, 0, 0); acc[m][1] = __builtin_amdgcn_mfma_f32_16x16x32_bf16(Bf[1][s], af, acc[m][1], 0, 0, 0); } }
#pragma unroll
            for (int m = 0; m < 8; ++m) { const int i = 16 * m + fr; const float bsv = BS[h * 128 + i]; const size_t t = (size_t)(t0 + i);
                const v4u uw = *(const v4u*)(HS + t * 4096 + cb + 32 * wave + 8 * fq); float o[8];
#pragma unroll
                for (int n = 0; n < 2; ++n)
#pragma unroll
                    for (int z = 0; z < 4; ++z) { const int c = 4 * n + z; const float uu = (c & 1) ? bf_hi(uw[c >> 1]) : bf_lo(uw[c >> 1]); o[c] = uu * (acc[m][n][z] + bsv); }
                v4u w; w.x = cvt_pk_bf16(o[0], o[1]); w.y = cvt_pk_bf16(o[2], o[3]); w.z = cvt_pk_bf16(o[4], o[5]); w.w = cvt_pk_bf16(o[6], o[7]);
                *(v4u*)(GT + t * SGU_W + cb + 32 * wave + 8 * fq) = w; }
            __syncthreads();
        }
    }
}

constexpr int N_PHASES = 16;
__global__ void __launch_bounds__(NTHR, 2) mk_fwd(Args args) {
    extern __shared__ __attribute__((aligned(16))) unsigned char lds_raw[];
    LAS unsigned char* lds = (LAS unsigned char*)lds_raw;
    LAS unsigned char* misc = lds + MISC_OFF;
    const int tid = threadIdx.x;
    const int G = gridDim.x; const int bx = blockIdx.x; const int vcu = (G % 8 == 0) ? (bx % 8) * (G / 8) + bx / 8 : bx;
    unsigned char* ws = args.ws;
    unsigned* ctl = (unsigned*)(ws + WS_CTL);
    if (tid < 16) ((LAS unsigned*)(misc + MI_BARW))[tid] = 0u;
    __syncthreads();
    const int lo = args.ph_lo, hi = args.ph_hi;
    XcdBarrier bar; bar.bar = ctl + CW_BAR; bar.x = 0; bar.st = nullptr;
    if (hi - lo > 1) bar = xcd_barrier_post(ctl + CW_BAR, (volatile LAS unsigned*)(misc + MI_BARW));
#ifndef PH_MASK
#define PH_MASK 0xFFFF
#endif
#define IN(k) (((PH_MASK >> (k)) & 1) && lo <= (k) && (k) < hi)
#ifndef REP_PH
#define REP_PH -1
#define REP_N 1
#endif
#define NREP(k) ((k) == REP_PH ? REP_N : 1)
#define RUN(k) if (IN(k)) for (int rep = 0; rep < NREP(k); ++rep)
#define DRY(k) (rep + 1 < NREP(k))
#define SEAM(k) do { if (IN(k) && IN((k) + 1)) xcd_barrier(bar); } while (0)
    using namespace pg8;
    RUN(0) { phase_p0(args, lds, vcu, G); } SEAM(0);
    RUN(1) { DenseSched S{(const char*)(ws + WS_XB), (const char*)(ws + WS_WIN), 2048u, 2048u, 0u, 64, 4, 256, G, bx};
        EpiBf16<0, false, false> E{(bf16*)(ws + WS_Z), DM, nullptr, nullptr};
        gemm_phase<EpiBf16<0, false, false>, DenseSched, false, true, true>(lds, 2048u, 2048u, 16, S, E); } SEAM(1);
    RUN(2) { phase_pool(args, vcu, G); } SEAM(2);
    if (REP_PH == 100 && hi - lo > 1) for (int i = 0; i < REP_N; ++i) xcd_barrier(bar);
    RUN(3) { DenseSched S{(const char*)(ws + WS_POOLED), (const char*)(ws + WS_WGRP), 2048u, 512u, 512u, 64, 4, 256, G, bx};
        EpiBf16<0, false, true> E{(bf16*)(ws + WS_YP), DM, nullptr, args.in[I_PSCALE]};
        gemm_phase<EpiBf16<0, false, true>, DenseSched, false, true, true>(lds, 2048u, 512u, 4, S, E); } SEAM(3);
    RUN(4) { DenseSched S{(const char*)(ws + WS_YP), (const char*)(ws + WS_WOUT), 2048u, 2048u, 0u, 64, 4, 256, G, bx};
        EpiResid E{args.in[I_X], args.out};
        gemm_phase<EpiResid, DenseSched, false, true, true>(lds, 2048u, 2048u, 16, S, E); } SEAM(4);
#define MOE_PHASES(layer, pb) do { \
        RUN(pb) { phase_lnr(args, layer, lds, vcu, G, DRY(pb)); } SEAM(pb); \
        RUN((pb) + 1) { const MoeInfo mi = moe_setup(args, layer, misc); \
            G1Sched S{mi, (const char*)(ws + WS_XB), (const char*)(ws + WS_WGU), (const unsigned*)(ws + WS_ROWTOK), (const unsigned*)(ws + WS_IDENT), G, vcu}; \
            EpiSwiglu E{(bf16*)(ws + WS_H)}; \
            gemm_phase<EpiSwiglu, G1Sched, true, true, true>(lds, 2048u, 2048u, 16, S, E); } SEAM((pb) + 1); \
        if (IN((pb) + 2) && REP_PH == (pb) + 2) { const MoeInfo mi = moe_setup(args, layer, misc); \
            G2Sched S{mi, (const char*)(ws + WS_H), (const char*)(ws + WS_WDN), G, vcu, 256}; \
            EpiDown E{(unsigned char*)(ws + WS_Y), args.out}; \
            gemm_phase<EpiDown, G2Sched, false, true, true, 1>(lds, 512u, 512u, 4, S, E); } \
        if (IN((pb) + 2)) { const MoeInfo mi = moe_setup(args, layer, misc); \
            G2Sched S{mi, (const char*)(ws + WS_H), (const char*)(ws + WS_WDN), G, vcu, 0}; \
            EpiDown E{(unsigned char*)(ws + WS_Y), args.out}; \
            gemm_phase<EpiDown, G2Sched, false, true, true, 1>(lds, 512u, 512u, 4, S, E); } SEAM((pb) + 2); \
        RUN((pb) + 3) { phase_combine(args, layer, misc, vcu, G, DRY((pb) + 3)); \
            if (layer == 0 && !DRY((pb) + 3)) { const int wave = __builtin_amdgcn_readfirstlane(tid >> 6); __syncthreads(); convert_moe_layer(args, 1, lds, vcu * NWAVES + wave, G * NWAVES, wave, tid & 63); } } \
    } while (0)
    MOE_PHASES(0, 5); SEAM(8);
    RUN(9) { DenseSched S{(const char*)(ws + WS_XB), (const char*)(ws + WS_WSIN), 2048u, 2048u, 0u, 64, 16, 1024, G, bx};
        EpiBf16<1, true, false> E{(bf16*)(ws + WS_HS), 4096, args.in[I_SBIN], nullptr};
        gemm_phase<EpiBf16<1, true, false>, DenseSched, false, true, true>(lds, 2048u, 2048u, 16, S, E); } SEAM(9);
    RUN(10) { phase_sgu_spatial(args, lds, vcu, G); } SEAM(10);
    RUN(11) { DenseSched S{(const char*)(ws + WS_GATED), (const char*)(ws + WS_WSOUT), 4096u, 4096u, 0u, 64, 4, 256, G, bx};
        EpiResid E{args.out, DRY(11) ? (float*)(ws + WS_HS) : args.out};
        gemm_phase<EpiResid, DenseSched, false, true, true>(lds, 4096u, 4096u, 32, S, E); } SEAM(11);
    MOE_PHASES(1, 12);
#undef MOE_PHASES
#undef IN
#undef SEAM
}

extern "C" void kernel_launch(void* const* d_in, const int* in_sizes, int n_in, void* d_out, int out_size, void* d_ws, size_t ws_size, hipStream_t stream) {
    static int grid = 0;
    if (grid == 0) {
        if (n_in != 24 || out_size != T_TOK * DM || ws_size < WS_END) { fprintf(stderr, "kernel_launch: unexpected shapes (n_in %d out %d ws %zu)\n", n_in, out_size, ws_size); grid = -1; return; }
        int dev = 0, cus = 0;
        if (hipGetDevice(&dev) != hipSuccess || hipDeviceGetAttribute(&cus, hipDeviceAttributeMultiprocessorCount, dev) != hipSuccess) { grid = -1; return; }
        if (hipFuncSetAttribute((const void*)mk_fwd, hipFuncAttributeMaxDynamicSharedMemorySize, LDS_BYTES) != hipSuccess) { fprintf(stderr, "kernel_launch: hipFuncSetAttribute failed\n"); grid = -1; return; }
        int per_cu = 0;
        if (hipOccupancyMaxActiveBlocksPerMultiprocessor(&per_cu, (const void*)mk_fwd, NTHR, LDS_BYTES) != hipSuccess || per_cu < 1) fprintf(stderr, "kernel_launch: occupancy query says %d\n", per_cu);
        (void)hipGetLastError();
        grid = cus;
    }
    if (grid < 0) return;
    (void)hipMemsetAsync((char*)d_ws + WS_CTL, 0, CTL_ZERO_BYTES, stream);
    Args a{};
    for (int i = 0; i < 24; ++i) a.in[i] = (const float*)d_in[i];
    a.out = (float*)d_out; a.ws = (unsigned char*)d_ws;
#if MK_PER_PHASE
    for (int p = 0; p < N_PHASES; ++p) { a.ph_lo = p; a.ph_hi = p + 1; hipLaunchKernelGGL(mk_fwd, dim3(grid), dim3(NTHR), LDS_BYTES, stream, a); }
#else
    a.ph_lo = 0; a.ph_hi = N_PHASES; hipLaunchKernelGGL(mk_fwd, dim3(grid), dim3(NTHR), LDS_BYTES, stream, a);
#endif
}
```

```cpp
#include <hip/hip_runtime.h>
#include <cstdio>
#include <cstdint>

#ifndef MK_PER_PHASE
#define MK_PER_PHASE 0
#endif

#define GAS __attribute__((address_space(1)))
#define LAS __attribute__((address_space(3)))
typedef unsigned short bf16;
typedef unsigned v4u __attribute__((ext_vector_type(4)));
typedef unsigned v2u __attribute__((ext_vector_type(2)));
typedef float f32x4 __attribute__((ext_vector_type(4)));
typedef float f32x2 __attribute__((ext_vector_type(2)));
typedef short bf16x8 __attribute__((ext_vector_type(8)));
#define RLX_AGENT __ATOMIC_RELAXED, __HIP_MEMORY_SCOPE_AGENT
#define LDS_WAIT() asm volatile("s_waitcnt lgkmcnt(0)" ::: "memory")
#define VM_WAIT() asm volatile("s_waitcnt vmcnt(0)" ::: "memory")

constexpr int T_TOK = 16384, DM = 1024, SEQ = 4096, NE = 64, TOPK = 8, EDIM = 256;
constexpr int SGU_W = 2048, SGU_HD = 512;
constexpr float ALPHA = 1.41421356237309515f;
constexpr float LN_EPS = 1e-5f, ROUTED_SCALE = 2.5f;
constexpr int CAP = 16384;
constexpr int NWAVES = 8, NTHR = 512;

constexpr size_t MiB = 1u << 20;
constexpr size_t WS_CTL = 0, CTL_ZERO_BYTES = 65536;
constexpr size_t WS_IDENT = 256 * 1024;
constexpr size_t WS_DEST = 1 * MiB;
constexpr size_t WS_GATE = WS_DEST + 512 * 1024;
constexpr size_t WS_ROWTOK = 2 * MiB;
constexpr size_t WS_WIN = 6 * MiB;
constexpr size_t WS_WGRP = 8 * MiB;
constexpr size_t WS_WOUT = WS_WGRP + 512 * 1024;
constexpr size_t WS_WSIN = WS_WOUT + 2 * MiB;
constexpr size_t WS_WSOUT = WS_WSIN + 8 * MiB;
constexpr size_t WS_WRT = WS_WSOUT + 4 * MiB;
constexpr size_t WS_WGU = 23 * MiB;
constexpr size_t WS_WDN = WS_WGU + 65 * MiB;
constexpr size_t WS_XB = 121 * MiB;
constexpr size_t WS_H = 153 * MiB;
constexpr size_t WS_Y = 233 * MiB;
constexpr size_t WS_WGU1 = 378 * MiB, WS_WDN1 = WS_WGU1 + 65 * MiB;
constexpr size_t WS_MOE_LSTRIDE = WS_WGU1 - WS_WGU;
constexpr size_t WS_END = 476 * MiB;
constexpr size_t WS_Z = 153 * MiB, WS_POOLED = 185 * MiB, WS_YP = 217 * MiB;
constexpr size_t WS_HS = 153 * MiB;
constexpr size_t WS_GATED = 281 * MiB;
static_assert(WS_WRT + 512 * 1024 <= WS_WGU && WS_WDN + 33 * MiB <= WS_XB && WS_XB + 32 * MiB <= WS_H && WS_H + 80 * MiB <= WS_Y && WS_Y + 145 * MiB <= WS_WGU1 && WS_WDN1 + 33 * MiB <= WS_END && WS_GATED + 64 * MiB <= WS_WGU1, "ws map");
constexpr int CW_TMO = 0, CW_BAR = 64, CW_CNT = 4096, CW_QNEXT = 4608;

constexpr int RING_BYTES = 131072;
constexpr int MISC_OFF = RING_BYTES;
constexpr int LDS_BYTES = 147456;
constexpr int MI_BARW = 0, MI_CNT = 64, MI_TSTART = 320, MI_YSTART = 576, MI_NTILES = 832, MI_TILE_E = 1024;

__device__ __forceinline__ unsigned cvt_pk_bf16(float lo, float hi) { unsigned r; asm volatile("v_cvt_pk_bf16_f32 %0, %1, %2" : "=v"(r) : "v"(lo), "v"(hi)); return r; }
__device__ __forceinline__ float bf_lo(unsigned w) { return __uint_as_float(w << 16); }
__device__ __forceinline__ float bf_hi(unsigned w) { return __uint_as_float(w & 0xffff0000u); }
__device__ __forceinline__ float wave_sum(float v) {
#pragma unroll
    for (int o = 1; o < 64; o <<= 1) v += __shfl_xor(v, o);
    return v;
}
__device__ __forceinline__ float sigmoidf_(float x) { return __builtin_amdgcn_rcpf(1.0f + __builtin_amdgcn_exp2f(-1.4426950408889634f * x)); }
__device__ __forceinline__ float gelu_tanh(float v) { const float y = v + 0.044715f * v * v * v; return v * __builtin_amdgcn_rcpf(1.0f + __builtin_amdgcn_exp2f(-2.3022081983f * y)); }

#define XB_TMO      128
#define XB_XCNT(j)  (256  + 64 * (j))
#define XB_XSUB(j)  (1280 + 64 * (j))
#define XB_XGEN(j)  (2304 + 64 * (j))
#define XB_TOP      3328
#define XB_TOPGEN   3392
#define XCD_BAR_WORDS 3456
#define XB_SPIN_CAP (1u << 20)
__device__ __forceinline__ unsigned xb_ld(unsigned* p)              { return __hip_atomic_load(p, __ATOMIC_RELAXED, __HIP_MEMORY_SCOPE_AGENT); }
__device__ __forceinline__ unsigned xb_add(unsigned* p, unsigned v) { return __hip_atomic_fetch_add(p, v, __ATOMIC_RELAXED, __HIP_MEMORY_SCOPE_AGENT); }
__device__ __forceinline__ unsigned xb_xcc_id() { return (unsigned)__builtin_amdgcn_s_getreg((3 << 11) | 20) & 0xFu; }
#define XB_SPIN(cond, bar) do { unsigned _sp = 0; while (cond) { __builtin_amdgcn_s_sleep(1); \
    if ((++_sp & 255u) == 0u) { if (xb_ld(&(bar)[XB_TMO])) break; if (_sp > XB_SPIN_CAP) { atomicAdd(&(bar)[XB_TMO], 1u); break; } } } } while (0)
struct XcdBarrier { unsigned* bar; unsigned x; volatile LAS unsigned* st; };
__device__ __forceinline__ XcdBarrier xcd_barrier_post(unsigned* bar, volatile LAS unsigned* st) {
    XcdBarrier b; b.bar = bar; b.x = xb_xcc_id(); b.st = st;
    if (threadIdx.x == 0) (void)xb_add(&bar[XB_XCNT(b.x)], 1u);
    return b;
}
__device__ __forceinline__ void xcd_barrier_complete(unsigned* bar, unsigned x, unsigned& nloc, unsigned& nx) {
    const unsigned G = gridDim.x * gridDim.y * gridDim.z;
    unsigned sum, cnt, mine, sp = 0u;
    for (;;) {
        sum = 0u; cnt = 0u; mine = 0u;
#pragma unroll
        for (unsigned j = 0; j < 16; ++j) { const unsigned c = xb_ld(&bar[XB_XCNT(j)]); sum += c; cnt += (c > 0u) ? 1u : 0u; mine = (j == x) ? c : mine; }
        if (sum == G) break;
        __builtin_amdgcn_s_sleep(1);
        if ((++sp & 255u) == 0u) { if (xb_ld(&bar[XB_TMO])) break; if (sp > XB_SPIN_CAP) { atomicAdd(&bar[XB_TMO], 1u); break; } }
    }
    nloc = mine > 0u ? mine : 1u; nx = cnt > 0u ? cnt : 1u;
}
struct Args;
__device__ __forceinline__ bool convert_steal(const Args& a, int layer, LAS unsigned char* lds, int wave, int lane);
__device__ __forceinline__ void xcd_barrier(const XcdBarrier& b, const Args* bga = nullptr, int bg_layer = -1, LAS unsigned char* lds = nullptr) {
    asm volatile("s_waitcnt vmcnt(0)" ::: "memory");
    __syncthreads();
    if (threadIdx.x == 0) {
        unsigned* bar = b.bar;
        __builtin_amdgcn_s_waitcnt(0);
        unsigned nloc = b.st[0], nx = b.st[1];
        if (nloc == 0u) { xcd_barrier_complete(bar, b.x, nloc, nx); b.st[0] = nloc; b.st[1] = nx; }
        const unsigned old = xb_add(&bar[XB_XSUB(b.x)], 1u);
        const unsigned gen = old / nloc;
        if (old + 1u == (gen + 1u) * nloc) {
            __builtin_amdgcn_fence(__ATOMIC_RELEASE, "agent");
            asm volatile("s_waitcnt vmcnt(0)" ::: "memory");
            const unsigned og = xb_add(&bar[XB_TOP], 1u);
            const unsigned tg = og / nx;
            if (og + 1u == (tg + 1u) * nx) xb_add(&bar[XB_TOPGEN], 1u);
            else XB_SPIN(xb_ld(&bar[XB_TOPGEN]) == tg, bar);
            __builtin_amdgcn_fence(__ATOMIC_ACQUIRE, "agent");
            xb_add(&bar[XB_XGEN(b.x)], 1u);
            asm volatile("s_waitcnt vmcnt(0)" ::: "memory");
            b.st[2] = 0xFFFFFFFFu;
        } else if (bg_layer < 0) {
            XB_SPIN(xb_ld(&bar[XB_XGEN(b.x)]) == gen, bar);
            __builtin_amdgcn_fence(__ATOMIC_ACQUIRE, "agent");
            asm volatile("s_waitcnt vmcnt(0)" ::: "memory");
            b.st[2] = 0xFFFFFFFFu;
        } else b.st[2] = gen;
    }
    __syncthreads();
    if (bg_layer >= 0) {
        const unsigned gen = b.st[2];
        if (gen != 0xFFFFFFFFu) {
            const int lane = threadIdx.x & 63, wave = __builtin_amdgcn_readfirstlane(threadIdx.x >> 6);
            bool more = true;
            while (more && (unsigned)__builtin_amdgcn_readfirstlane((int)xb_ld(&b.bar[XB_XGEN(b.x)])) == gen) more = convert_steal(*bga, bg_layer, lds, wave, lane);
            asm volatile("s_waitcnt vmcnt(0)" ::: "memory");
            __syncthreads();
            if (threadIdx.x == 0) { XB_SPIN(xb_ld(&b.bar[XB_XGEN(b.x)]) == gen, b.bar); __builtin_amdgcn_fence(__ATOMIC_ACQUIRE, "agent"); asm volatile("s_waitcnt vmcnt(0)" ::: "memory"); }
        } else __syncthreads();
        __syncthreads();
    }
}

namespace pg8 {
constexpr int BM = 256, BK = 64, HALF = 128, HTB = HALF * BK * 2, STAGE_BYTES = 8 * HTB, NXCD = 8, WGM = 8;
__host__ __device__ __forceinline__ int lds_byte(int r, int c) { const int st = (r >> 4) * 2 + (c >> 5), rr = r & 15, cc = c & 31, ob = rr * 64 + cc * 2; return st * 1024 + (ob ^ (((ob >> 9) & 1) << 5)); }
__host__ __device__ __forceinline__ void stage_rc(int b, int& R, int& C) { const int st = b / 1024, sb = b % 1024, swz = sb ^ (((sb >> 9) & 1) << 5); R = (st >> 1) * 16 + swz / 64; C = (st & 1) * 32 + (swz % 64) / 2; }
__host__ __device__ __forceinline__ int perm32(int rho) { const int n = rho >> 4, i = rho & 15; return 8 * (i >> 2) + 4 * n + (i & 3); }

struct Unit { const char* A; const char* B; const unsigned* gat; int nvalid; int i0, i1, i2; };

template <class Epi, class Sched, bool GATHER, bool ALIGN_EPI, bool SP2, int BMODE = 0>
__device__ __forceinline__ void gemm_phase(LAS unsigned char* lds, const unsigned lda, const unsigned ldb, const int nt, const Sched& S, const Epi& E) {
    const int tid = threadIdx.x, wid = __builtin_amdgcn_readfirstlane(tid >> 6), lane = tid & 63, wr = wid >> 2, wc = wid & 3, fr = lane & 15, fq = lane >> 4;
    int R0, C0, R1, C1; stage_rc(tid * 16, R0, C0); stage_rc(tid * 16 + 8192, R1, C1);
    const int Rb0 = BMODE == 0 ? (R0 & ~31) + perm32(R0 & 31) : 64 * (R0 >> 5) + 16 * ((R0 & 15) >> 2) + 4 * ((R0 >> 4) & 1) + (R0 & 3);
    const int Rb1 = BMODE == 0 ? (R1 & ~31) + perm32(R1 & 31) : 64 * (R1 >> 5) + 16 * ((R1 & 15) >> 2) + 4 * ((R1 >> 4) & 1) + (R1 & 3);
    const unsigned voffB0 = (unsigned)Rb0 * ldb + (unsigned)C0 * 2u, voffB1 = (unsigned)Rb1 * ldb + (unsigned)C1 * 2u;
    const size_t hstepB = (size_t)(BMODE == 0 ? HALF : 8) * ldb;
    const size_t kstep = (size_t)(BK * 2);
    const unsigned ldsw = (unsigned)wid * 1024u;
    const int aoff = lds_byte(wr * 64 + fr, fq * 8), boff = lds_byte(wc * 32 + fr, fq * 8);
#define PG8_SA(b, h) (((b) * 2 + (h)) * HTB)
#define PG8_SB(b, h) ((4 + (b) * 2 + (h)) * HTB)
#define PG8_STAGE(bufoff, gbase, v0, v1) do { unsigned _v0 = (v0), _v1 = (v1); asm volatile("" : "+v"(_v0), "+v"(_v1)); \
        __builtin_amdgcn_global_load_lds((const unsigned*)((const char*)(gbase) + _v0), (LAS unsigned*)(lds + (bufoff) + ldsw), 16, 0, 0); \
        __builtin_amdgcn_global_load_lds((const unsigned*)((const char*)(gbase) + _v1), (LAS unsigned*)(lds + (bufoff) + ldsw + 8192), 16, 0, 0); } while (0)
#define PG8_LDA(dst, b, h) do { _Pragma("unroll") for (int m = 0; m < 4; ++m) _Pragma("unroll") for (int k = 0; k < 2; ++k) dst[m][k] = *(const LAS bf16x8*)(lds + PG8_SA(b, h) + aoff + m * 2048 + k * 1024); } while (0)
#define PG8_LDB(dst, b, h) do { _Pragma("unroll") for (int n = 0; n < 2; ++n) _Pragma("unroll") for (int k = 0; k < 2; ++k) dst[n][k] = *(const LAS bf16x8*)(lds + PG8_SB(b, h) + boff + n * 2048 + k * 1024); } while (0)
#define PG8_MMA(ai, bj, At, Bt) do { __builtin_amdgcn_s_setprio(1); _Pragma("unroll") for (int m = 0; m < 4; ++m) _Pragma("unroll") for (int n = 0; n < 2; ++n) _Pragma("unroll") for (int k = 0; k < 2; ++k) \
        acc[ai][bj][m][n] = __builtin_amdgcn_mfma_f32_16x16x32_bf16(Bt[n][k], At[m][k], acc[ai][bj][m][n], 0, 0, 0); __builtin_amdgcn_s_setprio(0); } while (0)
#define PG8_WAIT_V(n) asm volatile("s_waitcnt vmcnt(" #n ")" ::: "memory")
#define PG8_WAIT_L(n) asm volatile("s_waitcnt lgkmcnt(" #n ")" ::: "memory")
#define PG8_BAR __builtin_amdgcn_s_barrier()
#define PG8_SCHED __builtin_amdgcn_sched_barrier(0)
#define PG8_SETV(v00, v01, v10, v11, u) do { \
        if (GATHER) { const unsigned ta = R0 < (u).nvalid ? (u).gat[R0] : 0u, tb = R1 < (u).nvalid ? (u).gat[R1] : 0u, \
                                     tc = (HALF + R0) < (u).nvalid ? (u).gat[HALF + R0] : 0u, td = (HALF + R1) < (u).nvalid ? (u).gat[HALF + R1] : 0u; \
            v00 = ta * lda + (unsigned)C0 * 2u; v01 = tb * lda + (unsigned)C1 * 2u; v10 = tc * lda + (unsigned)C0 * 2u; v11 = td * lda + (unsigned)C1 * 2u; } \
        else { v00 = (unsigned)R0 * lda + (unsigned)C0 * 2u; v01 = (unsigned)R1 * lda + (unsigned)C1 * 2u; v10 = (unsigned)(HALF + R0) * lda + (unsigned)C0 * 2u; v11 = (unsigned)(HALF + R1) * lda + (unsigned)C1 * 2u; } } while (0)
    Unit cur, nxt; int ui = 0;
    if (!S.next(0, cur)) return;
    f32x4 acc[2][2][4][2];
#pragma unroll
    for (int a = 0; a < 2; ++a)
#pragma unroll
        for (int b = 0; b < 2; ++b)
#pragma unroll
            for (int m = 0; m < 4; ++m)
#pragma unroll
                for (int n = 0; n < 2; ++n) acc[a][b][m][n] = (f32x4){0.f, 0.f, 0.f, 0.f};
    bf16x8 At[4][2], B0[2][2], B1[2][2];
    const char* cA = cur.A; const char* cB = cur.B;
    unsigned cv00, cv01, cv10, cv11;
    PG8_SETV(cv00, cv01, cv10, cv11, cur);
    if constexpr (SP2) {
        PG8_STAGE(PG8_SB(0, 0), cB, voffB0, voffB1); PG8_STAGE(PG8_SB(0, 1), cB + hstepB, voffB0, voffB1); PG8_STAGE(PG8_SA(0, 0), cA, cv00, cv01); PG8_STAGE(PG8_SA(0, 1), cA, cv10, cv11);
        if (wr == 1) PG8_BAR;
        PG8_WAIT_V(2); PG8_BAR;
        PG8_STAGE(PG8_SB(1, 0), cB + kstep, voffB0, voffB1); PG8_STAGE(PG8_SA(1, 0), cA + kstep, cv00, cv01); PG8_STAGE(PG8_SB(1, 1), cB + hstepB + kstep, voffB0, voffB1);
        PG8_WAIT_V(6); PG8_BAR;
    } else {
        PG8_STAGE(PG8_SB(0, 0), cB, voffB0, voffB1); PG8_STAGE(PG8_SA(0, 0), cA, cv00, cv01); PG8_STAGE(PG8_SB(0, 1), cB + hstepB, voffB0, voffB1); PG8_STAGE(PG8_SA(0, 1), cA, cv10, cv11);
        if (wr == 1) PG8_BAR;
        PG8_WAIT_V(4); PG8_BAR;
        PG8_STAGE(PG8_SB(1, 0), cB + kstep, voffB0, voffB1); PG8_STAGE(PG8_SA(1, 0), cA + kstep, cv00, cv01); PG8_STAGE(PG8_SB(1, 1), cB + hstepB + kstep, voffB0, voffB1);
        PG8_WAIT_V(6); PG8_BAR;
    }
    for (;;) {
        const bool has_next = S.next(ui + 1, nxt);
        const char* nA = has_next ? nxt.A : cA; const char* nB = has_next ? nxt.B : cB;
#pragma unroll 1
        for (int t = 0; t < nt; t += 2) {
            const bool last = (t == nt - 2);
            const char* a1 = cA + (size_t)(t + 1) * kstep;
            const char* a2 = last ? nA : cA + (size_t)(t + 2) * kstep; const char* b2 = last ? nB : cB + (size_t)(t + 2) * kstep;
            const char* a3 = a2 + kstep; const char* b3 = b2 + kstep;
            if constexpr (SP2) {
            PG8_LDB(B0, 0, 0); PG8_LDB(B1, 0, 1); PG8_SCHED; PG8_LDA(At, 0, 0); PG8_STAGE(PG8_SA(1, 1), a1, cv10, cv11);
            PG8_WAIT_V(8); PG8_WAIT_L(0); PG8_BAR; PG8_MMA(0, 0, At, B0); PG8_MMA(0, 1, At, B1); PG8_BAR; PG8_SCHED;
            if constexpr (GATHER) { if (last && has_next) { PG8_SETV(cv00, cv01, cv10, cv11, nxt); } }
            PG8_LDA(At, 0, 1); PG8_STAGE(PG8_SB(0, 0), b2, voffB0, voffB1); PG8_STAGE(PG8_SB(0, 1), b2 + hstepB, voffB0, voffB1); PG8_STAGE(PG8_SA(0, 0), a2, cv00, cv01);
            PG8_WAIT_V(8); PG8_WAIT_L(0); PG8_BAR; PG8_MMA(1, 0, At, B0); PG8_MMA(1, 1, At, B1); PG8_BAR; PG8_SCHED;
            PG8_LDB(B0, 1, 0); PG8_LDB(B1, 1, 1); PG8_SCHED; PG8_LDA(At, 1, 0); PG8_STAGE(PG8_SA(0, 1), a2, cv10, cv11);
            PG8_WAIT_V(8); PG8_WAIT_L(0); PG8_BAR; PG8_MMA(0, 0, At, B0); PG8_MMA(0, 1, At, B1); PG8_BAR; PG8_SCHED;
            PG8_LDA(At, 1, 1); PG8_STAGE(PG8_SB(1, 0), b3, voffB0, voffB1); PG8_STAGE(PG8_SB(1, 1), b3 + hstepB, voffB0, voffB1); PG8_STAGE(PG8_SA(1, 0), a3, cv00, cv01);
            PG8_WAIT_V(8); PG8_WAIT_L(0); PG8_BAR; PG8_MMA(1, 0, At, B0); PG8_MMA(1, 1, At, B1); PG8_BAR; PG8_SCHED;
            } else {
            PG8_LDB(B0, 0, 0); PG8_SCHED; PG8_LDA(At, 0, 0); PG8_STAGE(PG8_SA(1, 1), a1, cv10, cv11);
            PG8_WAIT_L(8); PG8_BAR; PG8_WAIT_L(0); PG8_MMA(0, 0, At, B0); PG8_BAR; PG8_SCHED;
            if constexpr (GATHER) { if (last && has_next) { PG8_SETV(cv00, cv01, cv10, cv11, nxt); } }
            PG8_LDB(B1, 0, 1); PG8_STAGE(PG8_SB(0, 0), b2, voffB0, voffB1);
            PG8_BAR; PG8_WAIT_L(0); PG8_MMA(0, 1, At, B1); PG8_BAR;
            PG8_LDA(At, 0, 1); PG8_STAGE(PG8_SA(0, 0), a2, cv00, cv01);
            PG8_BAR; PG8_WAIT_L(0); PG8_MMA(1, 0, At, B0); PG8_BAR; PG8_SCHED;
            PG8_STAGE(PG8_SB(0, 1), b2 + hstepB, voffB0, voffB1);
            PG8_WAIT_V(6); PG8_BAR; PG8_MMA(1, 1, At, B1); PG8_BAR;
            PG8_LDB(B0, 1, 0); PG8_SCHED; PG8_LDA(At, 1, 0); PG8_STAGE(PG8_SA(0, 1), a2, cv10, cv11);
            PG8_WAIT_L(8); PG8_BAR; PG8_WAIT_L(0); PG8_MMA(0, 0, At, B0); PG8_BAR; PG8_SCHED;
            PG8_LDB(B1, 1, 1); PG8_STAGE(PG8_SB(1, 0), b3, voffB0, voffB1);
            PG8_BAR; PG8_WAIT_L(0); PG8_MMA(0, 1, At, B1); PG8_BAR;
            PG8_LDA(At, 1, 1); PG8_STAGE(PG8_SA(1, 0), a3, cv00, cv01);
            PG8_BAR; PG8_WAIT_L(0); PG8_MMA(1, 0, At, B0); PG8_BAR; PG8_SCHED;
            PG8_STAGE(PG8_SB(1, 1), b3 + hstepB, voffB0, voffB1);
            PG8_WAIT_V(6); PG8_BAR; PG8_MMA(1, 1, At, B1); PG8_BAR;
            }
        }
        if constexpr (ALIGN_EPI) { if (wr == 0) PG8_BAR; }
        E(acc, cur, wr, wc, fr, fq);
        if (!has_next) break;
#pragma unroll
        for (int a = 0; a < 2; ++a)
#pragma unroll
            for (int b = 0; b < 2; ++b)
#pragma unroll
                for (int m = 0; m < 4; ++m)
#pragma unroll
                    for (int n = 0; n < 2; ++n) acc[a][b][m][n] = (f32x4){0.f, 0.f, 0.f, 0.f};
        cur = nxt; cA = nA; cB = nB; ++ui;
        if constexpr (ALIGN_EPI) { if (wr == 1) PG8_BAR; }
    }
    PG8_WAIT_V(0);
    if constexpr (!ALIGN_EPI) { if (wr == 0) PG8_BAR; }
    PG8_BAR;
#undef PG8_SA
#undef PG8_SB
#undef PG8_STAGE
#undef PG8_LDA
#undef PG8_LDB
#undef PG8_MMA
#undef PG8_WAIT_V
#undef PG8_WAIT_L
#undef PG8_BAR
#undef PG8_SCHED
#undef PG8_SETV
}

struct DenseSched {
    const char* A; const char* B; unsigned lda, ldb, a_pn; int nM, nN, nwg, G, c;
    __device__ __forceinline__ bool next(int i, Unit& u) const {
        const long L = (long)i * G + c; if (L >= nwg) return false;
        int wgid = (int)L; { const int q = nwg / NXCD, r = nwg % NXCD, xcd = wgid % NXCD, off = wgid / NXCD; wgid = (xcd < r ? xcd * (q + 1) : r * (q + 1) + (xcd - r) * q) + off; }
        const int nig = WGM * nN, gid = wgid / nig, fm = gid * WGM, gsz = (nM - fm) < WGM ? (nM - fm) : WGM;
        const int pm = fm + ((wgid % nig) % gsz), pn = (wgid % nig) / gsz;
        u.A = A + (size_t)pm * BM * lda + (size_t)pn * a_pn; u.B = B + (size_t)pn * BM * ldb; u.gat = nullptr; u.nvalid = BM; u.i0 = pm; u.i1 = pn; u.i2 = 0; return true;
    }
};
struct MoeInfo { const LAS unsigned* cnt; const LAS unsigned* tstart; const LAS unsigned* ystart; const LAS unsigned char* tile_e; int ntiles; };
struct G1Sched {
    MoeInfo mi; const char* XB; const char* Wgu; const unsigned* rowtok; const unsigned* ident; int G, vcu;
    __device__ __forceinline__ bool next(int i, Unit& u) const {
        const int L = i * G + vcu; if (L >= 2 * mi.ntiles) return false;
        const int tile = L >> 1, uu = L & 1; int e;
        if (tile < 64) { e = 64; u.gat = ident + tile * 256; u.nvalid = 256; }
        else { e = __builtin_amdgcn_readfirstlane((int)mi.tile_e[tile]); const int pos0 = (tile - __builtin_amdgcn_readfirstlane((int)mi.tstart[e])) * 256; u.gat = rowtok + (size_t)e * CAP + pos0; const int rem = __builtin_amdgcn_readfirstlane((int)mi.cnt[e]) - pos0; u.nvalid = rem < 256 ? rem : 256; }
        u.A = XB; u.B = Wgu + ((size_t)e * 512 + (size_t)uu * 256) * 2048; u.i0 = tile; u.i1 = uu; u.i2 = 0; return true;
    }
};
struct G2Sched {
    MoeInfo mi; const char* H; const char* Wd; int G, vcu, L0;
    __device__ __forceinline__ bool next(int i, Unit& u) const {
        const int L = i * G + vcu + L0; if (L >= 4 * mi.ntiles) return false;
        const int tile = L >> 2, pn = L & 3; int e;
        if (tile < 64) { e = 64; u.i0 = 131072 + tile * 256; u.i2 = 0; u.nvalid = 256; }
        else { e = __builtin_amdgcn_readfirstlane((int)mi.tile_e[tile]); const int pos0 = (tile - __builtin_amdgcn_readfirstlane((int)mi.tstart[e])) * 256; u.i0 = __builtin_amdgcn_readfirstlane((int)mi.ystart[e]) + pos0; u.i2 = 0; const int rem = __builtin_amdgcn_readfirstlane((int)mi.cnt[e]) - pos0; u.nvalid = rem < 256 ? rem : 256; }
        u.A = H + (size_t)tile * 256 * 512; u.B = Wd + ((size_t)e * 1024 + (size_t)pn * 256) * 512; u.gat = nullptr; u.i1 = pn; return true;
    }
};

template <int ACT, bool BIAS, bool SCALE> struct EpiBf16 {
    bf16* O; int ldo; const float* bias; const float* scale;
    __device__ __forceinline__ void operator()(const f32x4 (&acc)[2][2][4][2], const Unit& u, int wr, int wc, int fr, int fq) const {
        const int row0 = u.i0 * BM + wr * 64 + fr, col0 = u.i1 * BM + wc * 32 + 8 * fq;
        f32x4 bv[2][2], sv[2][2];
#pragma unroll
        for (int bj = 0; bj < 2; ++bj)
#pragma unroll
            for (int n = 0; n < 2; ++n) { bv[bj][n] = BIAS ? *(const f32x4*)(bias + col0 + bj * HALF + 4 * n) : (f32x4){0.f, 0.f, 0.f, 0.f}; sv[bj][n] = SCALE ? *(const f32x4*)(scale + col0 + bj * HALF + 4 * n) : (f32x4){1.f, 1.f, 1.f, 1.f}; }
#pragma unroll
        for (int ai = 0; ai < 2; ++ai)
#pragma unroll
            for (int m = 0; m < 4; ++m) { bf16* rowp = O + (size_t)(row0 + ai * HALF + m * 16) * ldo + col0;
#pragma unroll
                for (int bj = 0; bj < 2; ++bj) { f32x4 v0 = acc[ai][bj][m][0] + bv[bj][0], v1 = acc[ai][bj][m][1] + bv[bj][1];
                    if (ACT == 1) {
#pragma unroll
                        for (int j = 0; j < 4; ++j) { v0[j] = gelu_tanh(v0[j]); v1[j] = gelu_tanh(v1[j]); } }
                    if (SCALE) { v0 = v0 * sv[bj][0]; v1 = v1 * sv[bj][1]; }
                    v4u w; w.x = cvt_pk_bf16(v0[0], v0[1]); w.y = cvt_pk_bf16(v0[2], v0[3]); w.z = cvt_pk_bf16(v1[0], v1[1]); w.w = cvt_pk_bf16(v1[2], v1[3]);
                    *(v4u*)(rowp + bj * HALF) = w; } }
    }
};
struct EpiResid {
    const float* base; float* out;
    __device__ __forceinline__ void operator()(const f32x4 (&acc)[2][2][4][2], const Unit& u, int wr, int wc, int fr, int fq) const {
        const int row0 = u.i0 * BM + wr * 64 + fr, col0 = u.i1 * BM + wc * 32 + 8 * fq;
#pragma unroll
        for (int ai = 0; ai < 2; ++ai)
#pragma unroll
            for (int m = 0; m < 4; ++m) { const size_t off = (size_t)(row0 + ai * HALF + m * 16) * DM + col0;
#pragma unroll
                for (int bj = 0; bj < 2; ++bj) { const f32x4 b0 = *(const f32x4*)(base + off + bj * HALF), b1 = *(const f32x4*)(base + off + bj * HALF + 4);
                    *(f32x4*)(out + off + bj * HALF) = b0 * ALPHA + acc[ai][bj][m][0]; *(f32x4*)(out + off + bj * HALF + 4) = b1 * ALPHA + acc[ai][bj][m][1]; }
                asm volatile("" ::: "memory"); }
    }
};
struct EpiSwiglu {
    bf16* H;
    __device__ __forceinline__ void operator()(const f32x4 (&acc)[2][2][4][2], const Unit& u, int wr, int wc, int fr, int fq) const {
        const int row0 = u.i0 * BM + wr * 64 + fr, col0 = u.i1 * HALF + wc * 32 + 8 * fq;
#pragma unroll
        for (int ai = 0; ai < 2; ++ai)
#pragma unroll
            for (int m = 0; m < 4; ++m) { bf16* rowp = H + (size_t)(row0 + ai * HALF + m * 16) * EDIM + col0; float h[8];
#pragma unroll
                for (int n = 0; n < 2; ++n)
#pragma unroll
                    for (int j = 0; j < 4; ++j) { const float g = acc[ai][0][m][n][j], up = acc[ai][1][m][n][j]; h[4 * n + j] = g * sigmoidf_(g) * up; }
                v4u w; w.x = cvt_pk_bf16(h[0], h[1]); w.y = cvt_pk_bf16(h[2], h[3]); w.z = cvt_pk_bf16(h[4], h[5]); w.w = cvt_pk_bf16(h[6], h[7]);
                *(v4u*)rowp = w; }
    }
};
struct EpiDown {
    unsigned char* Y8;
    __device__ __forceinline__ void operator()(const f32x4 (&acc)[2][2][4][2], const Unit& u, int wr, int wc, int fr, int fq) const {
        const int r0 = wr * 64 + fr, col0 = u.i1 * BM + wc * 64 + 16 * fq;
#pragma unroll
        for (int ai = 0; ai < 2; ++ai)
#pragma unroll
            for (int m = 0; m < 4; ++m) { const int r = r0 + ai * HALF + m * 16;
                if (r < u.nvalid) { v4u w;
#pragma unroll
                    for (int q = 0; q < 4; ++q) { const f32x4 v = acc[ai][q >> 1][m][q & 1] * 16.0f; int t = 0; t = __builtin_amdgcn_cvt_pk_fp8_f32(v[0], v[1], t, false); t = __builtin_amdgcn_cvt_pk_fp8_f32(v[2], v[3], t, true); w[q] = (unsigned)t; }
                    *(v4u*)(Y8 + (size_t)(u.i0 + r) * DM + col0) = w; } }
    }
};
}

struct Args { const float* in[24]; float* out; unsigned char* ws; int ph_lo, ph_hi; };
enum { I_X = 0, I_PWIN, I_PWGRP, I_PSCALE, I_PWOUT, I_SWIN, I_SBIN, I_SLNG, I_SLNB, I_SWS, I_SBS, I_SWOUT, I_LNMG, I_LNMB, I_WR, I_RB, I_WG, I_WU, I_WD, I_SHG, I_SHU, I_SHD, I_LNFG, I_LNFB };

__device__ __forceinline__ void tr_item(const float* W, int N, int k0, int n0, bf16* dst  , int dpitch, LAS float* scr, int lane) {
#pragma unroll 8
    for (int i = 0; i < 32; ++i) { const int kk = 2 * i + (lane >> 5); scr[kk * 33 + (lane & 31)] = W[(size_t)(k0 + kk) * N + n0 + (lane & 31)]; }
    LDS_WAIT(); asm volatile("" ::: "memory");
    const int c = lane & 7;
#pragma unroll
    for (int j = 0; j < 4; ++j) { const int n = (lane >> 3) + 8 * j; const LAS float* s = scr + (8 * c) * 33 + n;
        v4u o; o.x = cvt_pk_bf16(s[0 * 33], s[1 * 33]); o.y = cvt_pk_bf16(s[2 * 33], s[3 * 33]); o.z = cvt_pk_bf16(s[4 * 33], s[5 * 33]); o.w = cvt_pk_bf16(s[6 * 33], s[7 * 33]);
        *(v4u*)(dst + (size_t)n * dpitch + 8 * c) = o; }
    LDS_WAIT(); asm volatile("" ::: "memory");
}
__device__ __forceinline__ void tr_item_hilo(const float* W, int N, int k0, int n0, bf16* dh, bf16* dl, int dpitch, LAS float* scr, int lane) {
#pragma unroll 8
    for (int i = 0; i < 32; ++i) { const int kk = 2 * i + (lane >> 5); scr[kk * 33 + (lane & 31)] = W[(size_t)(k0 + kk) * N + n0 + (lane & 31)]; }
    LDS_WAIT(); asm volatile("" ::: "memory");
    const int c = lane & 7;
#pragma unroll
    for (int j = 0; j < 4; ++j) { const int n = (lane >> 3) + 8 * j; const LAS float* s = scr + (8 * c) * 33 + n; float w[8];
#pragma unroll
        for (int z = 0; z < 8; ++z) w[z] = s[z * 33];
        v4u o; o.x = cvt_pk_bf16(w[0], w[1]); o.y = cvt_pk_bf16(w[2], w[3]); o.z = cvt_pk_bf16(w[4], w[5]); o.w = cvt_pk_bf16(w[6], w[7]);
        v4u l; l.x = cvt_pk_bf16(w[0] - bf_lo(o.x), w[1] - bf_hi(o.x)); l.y = cvt_pk_bf16(w[2] - bf_lo(o.y), w[3] - bf_hi(o.y)); l.z = cvt_pk_bf16(w[4] - bf_lo(o.z), w[5] - bf_hi(o.z)); l.w = cvt_pk_bf16(w[6] - bf_lo(o.w), w[7] - bf_hi(o.w));
        *(v4u*)(dh + (size_t)n * dpitch + 8 * c) = o; *(v4u*)(dl + (size_t)n * dpitch + 8 * c) = l; }
    LDS_WAIT(); asm volatile("" ::: "memory");
}
constexpr int MOE_ITEMS = 65 * 384;
__device__ __forceinline__ void convert_moe_item(const Args& a, int layer, int it, LAS float* scr, int lane) {
    bf16* WGU = (bf16*)(a.ws + WS_WGU + (size_t)layer * WS_MOE_LSTRIDE); bf16* WDN = (bf16*)(a.ws + WS_WDN + (size_t)layer * WS_MOE_LSTRIDE);
    const int e = it / 384, r = it % 384;
    if (r < 256) { const int isup = r >> 7, rr = r & 127, kb = rr >> 3, nb = rr & 7, n0 = 32 * nb, k0 = 64 * kb;
        const float* src = (e < 64) ? a.in[isup ? I_WU : I_WG] + ((size_t)layer * 64 + e) * 262144 : a.in[isup ? I_SHU : I_SHG] + (size_t)layer * 262144;
        const int drow = e * 512 + (n0 >> 7) * 256 + isup * 128 + (n0 & 127);
        tr_item(src, 256, k0, n0, WGU + (size_t)drow * 1024 + k0, 1024, scr, lane);
    } else { const int rr = r - 256, kb = rr >> 5, nb = rr & 31, n0 = 32 * nb, k0 = 64 * kb;
        const float* src = (e < 64) ? a.in[I_WD] + ((size_t)layer * 64 + e) * 262144 : a.in[I_SHD] + (size_t)layer * 262144;
        tr_item(src, 1024, k0, n0, WDN + ((size_t)e * 1024 + n0) * 256 + k0, 256, scr, lane);
    }
}
constexpr int Q_SHARDS = 8, Q_PER_SHARD = MOE_ITEMS / Q_SHARDS;
static_assert(Q_PER_SHARD * Q_SHARDS == MOE_ITEMS, "queue shards");
template <int CHUNK> __device__ __forceinline__ bool convert_steal_n(const Args& a, int layer, LAS unsigned char* lds, int wave, int lane) {
    unsigned* q = (unsigned*)(a.ws + WS_CTL) + CW_QNEXT + 512 * layer;
    const int s0 = (int)(blockIdx.x & 7);
    for (int s = 0; s < Q_SHARDS; ++s) { const int sh = (s0 + s) & 7;
        unsigned it = 0; if (lane == 0) it = __hip_atomic_fetch_add(q + 64 * sh, (unsigned)CHUNK, RLX_AGENT);
        it = (unsigned)__builtin_amdgcn_readfirstlane((int)it);
        if (it < (unsigned)Q_PER_SHARD) {
            for (int c = 0; c < CHUNK; ++c) if (it + c < (unsigned)Q_PER_SHARD) convert_moe_item(a, layer, sh * Q_PER_SHARD + (int)it + c, (LAS float*)(lds + wave * 16384), lane);
            return true; } }
    return false;
}
__device__ __forceinline__ bool convert_steal(const Args& a, int layer, LAS unsigned char* lds, int wave, int lane) { return convert_steal_n<1>(a, layer, lds, wave, lane); }
__device__ __forceinline__ void convert_static(const Args& a, int layer, LAS unsigned char* lds, int vcu, int G) {
    const int lane = threadIdx.x & 63, wave = __builtin_amdgcn_readfirstlane(threadIdx.x >> 6);
    for (int it = vcu * NWAVES + wave; it < MOE_ITEMS; it += G * NWAVES) convert_moe_item(a, layer, it, (LAS float*)(lds + wave * 16384), lane);
}
__device__ __forceinline__ void convert_drain(const Args& a, int layer, LAS unsigned char* lds) {
    const int lane = threadIdx.x & 63, wave = __builtin_amdgcn_readfirstlane(threadIdx.x >> 6);
    while (convert_steal_n<4>(a, layer, lds, wave, lane)) {}
    __syncthreads();
}
__device__ __forceinline__ void phase_p0(const Args& a, LAS unsigned char* lds, int vcu, int G) {
    const int tid = threadIdx.x, lane = tid & 63, wave = __builtin_amdgcn_readfirstlane(tid >> 6);
    const int gw = vcu * NWAVES + wave, NGW = G * NWAVES;
    LAS float* scr = (LAS float*)(lds + wave * 16384);
    constexpr int I_IN = 16 * 32, I_GRP = 4 * 4 * 8, I_OUT = 16 * 32, I_SIN = 16 * 128, I_SOUT = 32 * 32, NIT = I_IN + I_GRP + I_OUT + I_SIN + I_SOUT;
    for (int it = gw; it < NIT; it += NGW) {
        int r = it;
        if (r < I_IN) { const int kb = r >> 5, nb = r & 31; tr_item(a.in[I_PWIN], 1024, 64 * kb, 32 * nb, (bf16*)(a.ws + WS_WIN) + (size_t)(32 * nb) * 1024 + 64 * kb, 1024, scr, lane); continue; } r -= I_IN;
        if (r < I_GRP) { const int g = r >> 5, rr = r & 31, kb = rr >> 3, nb = rr & 7; tr_item(a.in[I_PWGRP] + (size_t)g * 65536, 256, 64 * kb, 32 * nb, (bf16*)(a.ws + WS_WGRP) + (size_t)(g * 256 + 32 * nb) * 256 + 64 * kb, 256, scr, lane); continue; } r -= I_GRP;
        if (r < I_OUT) { const int kb = r >> 5, nb = r & 31; tr_item(a.in[I_PWOUT], 1024, 64 * kb, 32 * nb, (bf16*)(a.ws + WS_WOUT) + (size_t)(32 * nb) * 1024 + 64 * kb, 1024, scr, lane); continue; } r -= I_OUT;
        if (r < I_SIN) { const int kb = r >> 7, nb = r & 127; tr_item(a.in[I_SWIN], 4096, 64 * kb, 32 * nb, (bf16*)(a.ws + WS_WSIN) + (size_t)(32 * nb) * 1024 + 64 * kb, 1024, scr, lane); continue; } r -= I_SIN;
        { const int kb = r >> 5, nb = r & 31; tr_item(a.in[I_SWOUT], 1024, 64 * kb, 32 * nb, (bf16*)(a.ws + WS_WSOUT) + (size_t)(32 * nb) * 2048 + 64 * kb, 2048, scr, lane); }
    }
    for (int it = gw; it < 64; it += NGW) { const int layer = it >> 5, rr = it & 31, kb = rr >> 1, nb = rr & 1; bf16* base = (bf16*)(a.ws + WS_WRT) + (size_t)layer * 2 * 65536 + (size_t)(32 * nb) * 1024 + 64 * kb;
        tr_item_hilo(a.in[I_WR] + (size_t)layer * DM * NE, 64, 64 * kb, 32 * nb, base, base + 65536, 1024, scr, lane); }
    convert_static(a, 0, lds, vcu, G);
    const float* x = a.in[I_X]; bf16* xb = (bf16*)(a.ws + WS_XB);
    const size_t gt = (size_t)vcu * NTHR + tid, NT = (size_t)G * NTHR;
    for (size_t i = gt; i < (size_t)T_TOK * DM / 8; i += NT) { const f32x4 p = *(const f32x4*)(x + i * 8), q = *(const f32x4*)(x + i * 8 + 4);
        v4u w; w.x = cvt_pk_bf16(p[0], p[1]); w.y = cvt_pk_bf16(p[2], p[3]); w.z = cvt_pk_bf16(q[0], q[1]); w.w = cvt_pk_bf16(q[2], q[3]); *(v4u*)(xb + i * 8) = w; }
    unsigned* ident = (unsigned*)(a.ws + WS_IDENT);
    for (size_t i = gt; i < (size_t)T_TOK; i += NT) ident[i] = (unsigned)i;
}

template <int W> __device__ __forceinline__ void pool_item(const bf16* zp  , bf16* op  , int p0  ) {
    v4u q[W + 3];
#pragma unroll
    for (int i = 0; i < W + 3; ++i) { const int ii = i < p0 + 3 ? i : p0 + 3; q[i] = *(const v4u*)(zp - (size_t)ii * DM); }
#pragma unroll
    for (int o = 0; o < 4; ++o) {
        float s[8];
#pragma unroll
        for (int j = 0; j < 8; ++j) s[j] = 0.f;
#pragma unroll
        for (int i = 3 - o; i < 3 - o + W; ++i) { const float m = (i <= p0 + 3) ? 1.0f : 0.0f;
#pragma unroll
            for (int j = 0; j < 4; ++j) { s[2 * j] += m * bf_lo(q[i][j]); s[2 * j + 1] += m * bf_hi(q[i][j]); } }
        const int p = p0 + o, nw = (p + 1) < W ? (p + 1) : W; const float inv = 1.0f / (float)nw; v4u ov;
#pragma unroll
        for (int j = 0; j < 4; ++j) ov[j] = cvt_pk_bf16(s[2 * j] * inv - bf_lo(q[3 - o][j]), s[2 * j + 1] * inv - bf_hi(q[3 - o][j]));
        *(v4u*)(op + (size_t)o * DM) = ov; }
}
__device__ __forceinline__ void phase_pool(const Args& a, int vcu, int G) {
    const bf16* Z = (const bf16*)(a.ws + WS_Z); bf16* P = (bf16*)(a.ws + WS_POOLED);
    const int tid = threadIdx.x, wave = tid >> 6, lane = tid & 63;
    const int gw = vcu * NWAVES + wave, NGW = G * NWAVES;
    for (int it = gw; it < (T_TOK / 4) * 2; it += NGW) {
        const int t0 = (it >> 1) * 4, c8 = (it & 1) * 64 + lane, g = c8 >> 5, p0 = t0 & (SEQ - 1);
        const bf16* zp = Z + (size_t)(t0 + 3) * DM + c8 * 8; bf16* op = P + (size_t)t0 * DM + c8 * 8;
        if (g == 0) pool_item<2>(zp, op, p0); else if (g == 1) pool_item<4>(zp, op, p0); else if (g == 2) pool_item<8>(zp, op, p0); else pool_item<16>(zp, op, p0);
    }
}

template <int R> __device__ __forceinline__ void ln_rows_store(float (&v)[R][16], const float* g, const float* b, float* const (&of)[R], bf16* const (&ob)[R], int lane) {
    float s[R], s2[R];
#pragma unroll
    for (int r = 0; r < R; ++r) { s[r] = 0.f;
#pragma unroll
        for (int i = 0; i < 16; ++i) s[r] += v[r][i]; }
#pragma unroll
    for (int o = 1; o < 64; o <<= 1)
#pragma unroll
        for (int r = 0; r < R; ++r) s[r] += __shfl_xor(s[r], o);
#pragma unroll
    for (int r = 0; r < R; ++r) { const float mean = s[r] * (1.0f / DM); s2[r] = 0.f;
#pragma unroll
        for (int i = 0; i < 16; ++i) { v[r][i] -= mean; s2[r] += v[r][i] * v[r][i]; } }
#pragma unroll
    for (int o = 1; o < 64; o <<= 1)
#pragma unroll
        for (int r = 0; r < R; ++r) s2[r] += __shfl_xor(s2[r], o);
#pragma unroll
    for (int j = 0; j < 2; ++j) { const int c = 8 * lane + 512 * j;
        const f32x4 g0 = *(const f32x4*)(g + c), g1 = *(const f32x4*)(g + c + 4), b0 = *(const f32x4*)(b + c), b1 = *(const f32x4*)(b + c + 4);
#pragma unroll
        for (int r = 0; r < R; ++r) { const float rstd = 1.0f / sqrtf(s2[r] * (1.0f / DM) + LN_EPS); f32x4 y0, y1;
#pragma unroll
            for (int q = 0; q < 4; ++q) { y0[q] = v[r][8 * j + q] * rstd * g0[q] + b0[q]; y1[q] = v[r][8 * j + 4 + q] * rstd * g1[q] + b1[q]; }
            *(f32x4*)(of[r] + c) = y0; *(f32x4*)(of[r] + c + 4) = y1;
            v4u w; w.x = cvt_pk_bf16(y0[0], y0[1]); w.y = cvt_pk_bf16(y0[2], y0[3]); w.z = cvt_pk_bf16(y1[0], y1[1]); w.w = cvt_pk_bf16(y1[2], y1[3]);
            *(v4u*)(ob[r] + c) = w; } }
}

__device__ __forceinline__ void phase_lnr(const Args& a, int layer, LAS unsigned char* lds, int vcu, int G, bool dry) {
    const int tid = threadIdx.x, lane = tid & 63, wave = __builtin_amdgcn_readfirstlane(tid >> 6);
    const float* xin = a.out; float* xf = dry ? (float*)(a.ws + WS_Y) : a.out; bf16* xb = dry ? (bf16*)(a.ws + WS_Y + 72 * MiB) : (bf16*)(a.ws + WS_XB);
    const float* lng = a.in[I_LNMG] + layer * DM; const float* lnb = a.in[I_LNMB] + layer * DM;
    const float* Wr = a.in[I_WR] + (size_t)layer * DM * NE; const float* rbias = a.in[I_RB] + layer * NE;
    unsigned* gcount = (unsigned*)(a.ws + WS_CTL) + CW_CNT + layer * 64 + (dry ? 128 : 0);
    unsigned* rowtok = dry ? (unsigned*)(a.ws + WS_Y + 64 * MiB) : (unsigned*)(a.ws + WS_ROWTOK); unsigned* dest = dry ? (unsigned*)(a.ws + WS_Y + 68 * MiB) : (unsigned*)(a.ws + WS_DEST); float* gatev = dry ? (float*)(a.ws + WS_Y + 69 * MiB) : (float*)(a.ws + WS_GATE);
    LAS float* part = (LAS float*)lds;
    LAS float* mb = (LAS float*)(lds + 32768);
    LAS float* gs = (LAS float*)(lds + 49152);
    LAS unsigned* hist = (LAS unsigned*)(lds + 51200);
    LAS unsigned* basep = (LAS unsigned*)(lds + 51456);
    { const int blk = vcu;
        const int row0 = blk * 64;
        if (tid < 64) hist[tid] = 0u;
#pragma unroll 1
        for (int h4 = 0; h4 < 2; ++h4) { float v[4][16]; float* of[4]; bf16* ob[4];
#pragma unroll
            for (int r = 0; r < 4; ++r) { const int rr = wave * 8 + h4 * 4 + r; const float* xr = xin + (size_t)(row0 + rr) * DM; of[r] = xf + (size_t)(row0 + rr) * DM; ob[r] = xb + (size_t)(row0 + rr) * DM;
#pragma unroll
                for (int j = 0; j < 2; ++j) { const f32x4 p = *(const f32x4*)(xr + 8 * lane + 512 * j), q = *(const f32x4*)(xr + 8 * lane + 512 * j + 4);
#pragma unroll
                    for (int i = 0; i < 4; ++i) { v[r][8 * j + i] = p[i]; v[r][8 * j + 4 + i] = q[i]; } } }
            ln_rows_store<4>(v, lng, lnb, of, ob, lane); }
        VM_WAIT(); __syncthreads();
#ifndef DRY_PARTS
#define DRY_PARTS 7
#endif
        if (!dry || (DRY_PARTS & 2)) { const int mt = wave & 3, kh = wave >> 2, r = lane & 15, g = lane >> 4;
          f32x4 acc[4];
#pragma unroll
          for (int n = 0; n < 4; ++n) acc[n] = (f32x4){0.f, 0.f, 0.f, 0.f};
          const float* arow = xf + (size_t)(row0 + 16 * mt + r) * DM + kh * 512 + 8 * g;
          const bf16* bh = (const bf16*)(a.ws + WS_WRT) + (size_t)layer * 2 * 65536 + (size_t)r * 1024 + kh * 512 + 8 * g; const bf16* bl = bh + 65536;
          f32x4 a0 = *(const f32x4*)arow, a1 = *(const f32x4*)(arow + 4); bf16x8 wh[4], wl[4];
#pragma unroll
          for (int n = 0; n < 4; ++n) { wh[n] = *(const bf16x8*)(bh + (size_t)n * 16384); wl[n] = *(const bf16x8*)(bl + (size_t)n * 16384); }
#pragma unroll 1
          for (int s = 0; s < 16; ++s) { const int sn = s < 15 ? s + 1 : s;
              const f32x4 n0 = *(const f32x4*)(arow + 32 * sn), n1 = *(const f32x4*)(arow + 32 * sn + 4); bf16x8 nh[4], nl[4];
#pragma unroll
              for (int n = 0; n < 4; ++n) { nh[n] = *(const bf16x8*)(bh + (size_t)n * 16384 + 32 * sn); nl[n] = *(const bf16x8*)(bl + (size_t)n * 16384 + 32 * sn); }
              v4u hi, lo; hi.x = cvt_pk_bf16(a0[0], a0[1]); hi.y = cvt_pk_bf16(a0[2], a0[3]); hi.z = cvt_pk_bf16(a1[0], a1[1]); hi.w = cvt_pk_bf16(a1[2], a1[3]);
              lo.x = cvt_pk_bf16(a0[0] - bf_lo(hi.x), a0[1] - bf_hi(hi.x)); lo.y = cvt_pk_bf16(a0[2] - bf_lo(hi.y), a0[3] - bf_hi(hi.y));
              lo.z = cvt_pk_bf16(a1[0] - bf_lo(hi.z), a1[1] - bf_hi(hi.z)); lo.w = cvt_pk_bf16(a1[2] - bf_lo(hi.w), a1[3] - bf_hi(hi.w));
              const bf16x8 ah = __builtin_bit_cast(bf16x8, hi), al = __builtin_bit_cast(bf16x8, lo);
#pragma unroll
              for (int n = 0; n < 4; ++n) { acc[n] = __builtin_amdgcn_mfma_f32_16x16x32_bf16(ah, wh[n], acc[n], 0, 0, 0); acc[n] = __builtin_amdgcn_mfma_f32_16x16x32_bf16(al, wh[n], acc[n], 0, 0, 0); acc[n] = __builtin_amdgcn_mfma_f32_16x16x32_bf16(ah, wl[n], acc[n], 0, 0, 0); }
              a0 = n0; a1 = n1;
#pragma unroll
              for (int n = 0; n < 4; ++n) { wh[n] = nh[n]; wl[n] = nl[n]; } }
#pragma unroll
          for (int n = 0; n < 4; ++n)
#pragma unroll
              for (int q = 0; q < 4; ++q) part[(kh * 64 + 16 * mt + 4 * g + q) * 64 + 16 * n + r] = acc[n][q]; }
        __syncthreads();
        if (!dry || (DRY_PARTS & 4)) { const int row = tid >> 3, grp = tid & 7; float sc[8], bsd[8];
#pragma unroll
          for (int i = 0; i < 8; ++i) { const int e = 8 * grp + i; const float lg = part[row * 64 + e] + part[(64 + row) * 64 + e]; sc[i] = 1.0f / (1.0f + __expf(-lg)); bsd[i] = sc[i] + rbias[e]; }
          float m1 = -INFINITY, m2 = -INFINITY;
#pragma unroll
          for (int i = 0; i < 8; ++i) { const float v = bsd[i]; if (v > m1) { m2 = m1; m1 = v; } else if (v > m2) m2 = v; }
          const float myg = m1 + m2;
          int grank = 0;
#pragma unroll
          for (int d = 1; d < 8; ++d) { const float o = __shfl(myg, (lane & ~7) | ((grp + d) & 7)); const int g2 = (grp + d) & 7; grank += (o > myg || (o == myg && g2 < grp)) ? 1 : 0; }
          const bool gsel = grank < 4;
          float cand[8]; int rk[8]; bool sel[8];
#pragma unroll
          for (int i = 0; i < 8; ++i) { cand[i] = gsel ? bsd[i] : -INFINITY; rk[i] = 0; sel[i] = false; }
#pragma unroll 1
          for (int k = 0; k < TOPK; ++k) {
              float best = cand[0]; int bi = 0;
#pragma unroll
              for (int i = 1; i < 8; ++i) if (cand[i] > best) { best = cand[i]; bi = i; }
              int gi = 8 * grp + bi;
#pragma unroll
              for (int off = 1; off < 8; off <<= 1) { const float ov = __shfl_xor(best, off); const int oi = __shfl_xor(gi, off); if (ov > best || (ov == best && oi < gi)) { best = ov; gi = oi; } }
#pragma unroll
              for (int i = 0; i < 8; ++i) if (gi == 8 * grp + i) { cand[i] = -INFINITY; rk[i] = k; sel[i] = true; }
          }
          float psum = 0.f;
#pragma unroll
          for (int i = 0; i < 8; ++i) psum += sel[i] ? sc[i] : 0.f;
          psum += __shfl_xor(psum, 1); psum += __shfl_xor(psum, 2); psum += __shfl_xor(psum, 4);
          const float inv = ROUTED_SCALE / psum;
          unsigned loc[8];
#pragma unroll
          for (int i = 0; i < 8; ++i) { loc[i] = 0u; if (sel[i]) loc[i] = __hip_atomic_fetch_add(hist + 8 * grp + i, 1u, __ATOMIC_RELAXED, __HIP_MEMORY_SCOPE_WORKGROUP); }
          __syncthreads();
          if (tid < 64) { const unsigned h = hist[tid]; basep[tid] = h ? __hip_atomic_fetch_add(gcount + tid, h, RLX_AGENT) : 0u; }
          __syncthreads();
          const int tok = row0 + row;
#pragma unroll
          for (int i = 0; i < 8; ++i) if (sel[i]) { const int e = 8 * grp + i; const unsigned pos = basep[e] + loc[i];
              rowtok[(size_t)e * CAP + pos] = (unsigned)tok; dest[tok * 8 + rk[i]] = ((unsigned)e << 16) | pos; gatev[tok * 8 + rk[i]] = sc[i] * inv; }
        }
        __syncthreads();
    }
}

__device__ __forceinline__ pg8::MoeInfo moe_setup(const Args& a, int layer, LAS unsigned char* misc) {
    const int tid = threadIdx.x;
    unsigned* gcount = (unsigned*)(a.ws + WS_CTL) + CW_CNT + layer * 64;
    LAS unsigned* cnt = (LAS unsigned*)(misc + MI_CNT); LAS unsigned* tstart = (LAS unsigned*)(misc + MI_TSTART); LAS unsigned* ystart = (LAS unsigned*)(misc + MI_YSTART);
    LAS unsigned* ntl = (LAS unsigned*)(misc + MI_NTILES); LAS unsigned char* tile_e = (LAS unsigned char*)(misc + MI_TILE_E);
    __syncthreads();
    if (tid < 64) { unsigned c = __hip_atomic_load(gcount + tid, RLX_AGENT); if (c > (unsigned)CAP) c = CAP; cnt[tid] = c; }
    __syncthreads();
    if (tid < 64) { unsigned ts = 64u, ys = 0u; for (int e = 0; e < tid; ++e) { const unsigned c = cnt[e]; ts += (c + 255u) >> 8; ys += c; }
        tstart[tid] = ts; ystart[tid] = ys; const unsigned mynt = (cnt[tid] + 255u) >> 8;
        for (unsigned i = 0; i < mynt; ++i) if (ts + i < 640u) tile_e[ts + i] = (unsigned char)tid;
        if (tid == 63) ntl[0] = ts + mynt; }
    __syncthreads();
    pg8::MoeInfo mi; mi.cnt = cnt; mi.tstart = tstart; mi.ystart = ystart; mi.tile_e = tile_e; mi.ntiles = __builtin_amdgcn_readfirstlane((int)ntl[0]);
    if (mi.ntiles > 640) mi.ntiles = 640;
    return mi;
}

__device__ __forceinline__ void phase_combine(const Args& a, int layer, LAS unsigned char* misc, int vcu, int G, bool dry) {
    const int tid = threadIdx.x, lane = tid & 63, wave = __builtin_amdgcn_readfirstlane(tid >> 6);
    const pg8::MoeInfo mi = moe_setup(a, layer, misc);
    float* xf = a.out; bf16* xb = (bf16*)(a.ws + WS_XB); const unsigned char* Y8 = (const unsigned char*)(a.ws + WS_Y);
    const unsigned* dest = (const unsigned*)(a.ws + WS_DEST); const float* gatev = (const float*)(a.ws + WS_GATE);
    const float* lng = a.in[I_LNFG] + layer * DM; const float* lnb = a.in[I_LNFB] + layer * DM;
    const int gw = vcu * NWAVES + wave, NGW = G * NWAVES;
#pragma unroll 1
    for (int rowa = gw; rowa < T_TOK; rowa += 2 * NGW) {
        float v[2][16]; float* of[2]; bf16* ob[2]; unsigned d[2][TOPK]; float gk[2][TOPK];
#pragma unroll
        for (int r = 0; r < 2; ++r) { const int row = rowa + r * NGW;
#pragma unroll
            for (int k = 0; k < TOPK; ++k) { d[r][k] = dest[row * 8 + k]; gk[r][k] = gatev[row * 8 + k]; } }
#pragma unroll
        for (int r = 0; r < 2; ++r) { const int row = rowa + r * NGW; float* xr = xf + (size_t)row * DM; of[r] = dry ? (float*)(a.ws + WS_H) + (size_t)row * DM : xr; ob[r] = xb + (size_t)row * DM;
#pragma unroll
            for (int j = 0; j < 2; ++j) { const f32x4 p = *(const f32x4*)(xr + 8 * lane + 512 * j), q = *(const f32x4*)(xr + 8 * lane + 512 * j + 4);
#pragma unroll
                for (int i = 0; i < 4; ++i) { v[r][8 * j + i] = p[i] * ALPHA; v[r][8 * j + 4 + i] = q[i] * ALPHA; } } }
#pragma unroll
        for (int r = 0; r < 2; ++r) { const unsigned char* yr = Y8 + (size_t)(131072 + rowa + r * NGW) * DM;
#pragma unroll
            for (int j = 0; j < 2; ++j) { const v2u w = *(const v2u*)(yr + 8 * lane + 512 * j);
#pragma unroll
                for (int q = 0; q < 2; ++q) { const f32x2 lo2 = __builtin_amdgcn_cvt_pk_f32_fp8((int)w[q], false), hi2 = __builtin_amdgcn_cvt_pk_f32_fp8((int)w[q], true);
                    v[r][8 * j + 4 * q] += 0.0625f * lo2.x; v[r][8 * j + 4 * q + 1] += 0.0625f * lo2.y; v[r][8 * j + 4 * q + 2] += 0.0625f * hi2.x; v[r][8 * j + 4 * q + 3] += 0.0625f * hi2.y; } } }
#pragma unroll
        for (int r = 0; r < 2; ++r)
#pragma unroll
            for (int k = 0; k < TOPK; ++k) { const unsigned dd = (unsigned)__builtin_amdgcn_readfirstlane((int)d[r][k]); const float g = __uint_as_float((unsigned)__builtin_amdgcn_readfirstlane((int)__float_as_uint(gk[r][k])));
                const unsigned e = (dd >> 16) & 63u, pos = dd & 0xffffu; const unsigned char* yr = Y8 + (size_t)(mi.ystart[e] + pos) * DM; const float g16 = g * 0.0625f;
#pragma unroll
                for (int j = 0; j < 2; ++j) { const v2u w = *(const v2u*)(yr + 8 * lane + 512 * j);
#pragma unroll
                    for (int q = 0; q < 2; ++q) { const f32x2 lo2 = __builtin_amdgcn_cvt_pk_f32_fp8((int)w[q], false), hi2 = __builtin_amdgcn_cvt_pk_f32_fp8((int)w[q], true);
                        v[r][8 * j + 4 * q] += g16 * lo2.x; v[r][8 * j + 4 * q + 1] += g16 * lo2.y; v[r][8 * j + 4 * q + 2] += g16 * hi2.x; v[r][8 * j + 4 * q + 3] += g16 * hi2.y; } } }
        ln_rows_store<2>(v, lng, lnb, of, ob, lane);
    }
}

__device__ __forceinline__ int swz16(int row) { return (row ^ (row >> 4)) & 15; }
__device__ __forceinline__ void phase_sgu_spatial(const Args& a, LAS unsigned char* lds, int vcu, int G) {
    const int tid = threadIdx.x, lane = tid & 63, wave = __builtin_amdgcn_readfirstlane(tid >> 6), fr = lane & 15, fq = lane >> 4;
    const bf16* HS = (const bf16*)(a.ws + WS_HS); bf16* GT = (bf16*)(a.ws + WS_GATED);
    const float* lng = a.in[I_SLNG]; const float* lnb = a.in[I_SLNB]; const float* WS = a.in[I_SWS]; const float* BS = a.in[I_SBS];
    LAS unsigned char* Bs = lds;
    LAS unsigned char* As = lds + 65536;
    LAS float* stm = (LAS float*)(lds + 98304);
    LAS float* str = (LAS float*)(lds + 98304 + 512);
    for (int item = vcu; item < 512; item += G) {
        const int chunk = item >> 2, h = item & 3, t0 = chunk * 128;
        __syncthreads();
#pragma unroll 1
        for (int r4 = 0; r4 < 4; ++r4) { v4u w[4][4];
#pragma unroll
            for (int rr = 0; rr < 4; ++rr) { const bf16* vr = HS + (size_t)(t0 + wave * 16 + r4 * 4 + rr) * 4096 + SGU_W;
#pragma unroll
                for (int q = 0; q < 4; ++q) w[rr][q] = *(const v4u*)(vr + 8 * lane + 512 * q); }
            float sm[4], sq[4];
#pragma unroll
            for (int rr = 0; rr < 4; ++rr) { float s1 = 0.f;
#pragma unroll
                for (int q = 0; q < 4; ++q)
#pragma unroll
                    for (int p = 0; p < 4; ++p) s1 += bf_lo(w[rr][q][p]) + bf_hi(w[rr][q][p]);
                sm[rr] = s1; }
#pragma unroll
            for (int o = 1; o < 64; o <<= 1)
#pragma unroll
                for (int rr = 0; rr < 4; ++rr) sm[rr] += __shfl_xor(sm[rr], o);
#pragma unroll
            for (int rr = 0; rr < 4; ++rr) { const float mean = sm[rr] * (1.0f / SGU_W); float s2 = 0.f;
#pragma unroll
                for (int q = 0; q < 4; ++q)
#pragma unroll
                    for (int p = 0; p < 4; ++p) { const float d0 = bf_lo(w[rr][q][p]) - mean, d1 = bf_hi(w[rr][q][p]) - mean; s2 += d0 * d0 + d1 * d1; }
                sm[rr] = mean; sq[rr] = s2; }
#pragma unroll
            for (int o = 1; o < 64; o <<= 1)
#pragma unroll
                for (int rr = 0; rr < 4; ++rr) sq[rr] += __shfl_xor(sq[rr], o);
            if (lane == 0) {
#pragma unroll
                for (int rr = 0; rr < 4; ++rr) { const int j = wave * 16 + r4 * 4 + rr; stm[j] = sm[rr]; str[j] = 1.0f / sqrtf(sq[rr] * (1.0f / SGU_W) + LN_EPS); } } }
        for (int q = tid; q < 128 * 16; q += NTHR) { const int i = q >> 4, jc = q & 15; const float* wp = WS + ((size_t)h * 128 + i) * 128 + 8 * jc;
            const f32x4 p0 = *(const f32x4*)wp, p1 = *(const f32x4*)(wp + 4); float w8[8];
#pragma unroll
            for (int z = 0; z < 4; ++z) { w8[z] = (8 * jc + z <= i) ? p0[z] : 0.f; w8[4 + z] = (8 * jc + 4 + z <= i) ? p1[z] : 0.f; }
            v4u o; o.x = cvt_pk_bf16(w8[0], w8[1]); o.y = cvt_pk_bf16(w8[2], w8[3]); o.z = cvt_pk_bf16(w8[4], w8[5]); o.w = cvt_pk_bf16(w8[6], w8[7]);
            *(LAS v4u*)(As + i * 256 + ((jc ^ swz16(i)) << 4)) = o; }
        __syncthreads();
        for (int hh = 0; hh < 2; ++hh) {
            const int cb = h * SGU_HD + hh * 256;
#pragma unroll 2
            for (int q = tid; q < 64 * 32; q += NTHR) { const int c8 = q & 31, jp = q >> 5, j0 = 2 * jp;
                const v4u w0 = *(const v4u*)(HS + (size_t)(t0 + j0) * 4096 + SGU_W + cb + 8 * c8), w1 = *(const v4u*)(HS + (size_t)(t0 + j0 + 1) * 4096 + SGU_W + cb + 8 * c8);
                const f32x4 g0 = *(const f32x4*)(lng + cb + 8 * c8), g1 = *(const f32x4*)(lng + cb + 8 * c8 + 4), b0 = *(const f32x4*)(lnb + cb + 8 * c8), b1 = *(const f32x4*)(lnb + cb + 8 * c8 + 4);
                const float m0 = stm[j0], r0 = str[j0], m1 = stm[j0 + 1], r1 = str[j0 + 1];
#pragma unroll
                for (int z = 0; z < 8; ++z) { const float gz = z < 4 ? g0[z & 3] : g1[z & 3], bz = z < 4 ? b0[z & 3] : b1[z & 3];
                    const float xa = (z & 1) ? bf_hi(w0[z >> 1]) : bf_lo(w0[z >> 1]), xc = (z & 1) ? bf_hi(w1[z >> 1]) : bf_lo(w1[z >> 1]);
                    const float ya = (xa - m0) * r0 * gz + bz, yc = (xc - m1) * r1 * gz + bz;
                    const int cc = 8 * c8 + z, slot = (cc & ~31) | (((cc >> 2) & 1) << 4) | (((cc >> 3) & 3) << 2) | (cc & 3);
                    *(LAS unsigned*)(Bs + slot * 256 + (((j0 >> 3) ^ swz16(slot)) << 4) + (j0 & 7) * 2) = cvt_pk_bf16(ya, yc); } }
            __syncthreads();
            f32x4 acc[8][2]; bf16x8 Bf[2][4];
#pragma unroll
            for (int n = 0; n < 2; ++n)
#pragma unroll
                for (int s = 0; s < 4; ++s) { const int slot = 32 * wave + 16 * n + fr; Bf[n][s] = *(const LAS bf16x8*)(Bs + slot * 256 + (((4 * s + fq) ^ swz16(slot)) << 4)); }
#pragma unroll
            for (int m = 0; m < 8; ++m) { acc[m][0] = (f32x4){0.f, 0.f, 0.f, 0.f}; acc[m][1] = (f32x4){0.f, 0.f, 0.f, 0.f};
#pragma unroll
                for (int s = 0; s < 4; ++s) if (s <= (m >> 1)) { const int i = 16 * m + fr; const bf16x8 af = *(const LAS bf16x8*)(As + i * 256 + (((4 * s + fq) ^ swz16(i)) << 4));
                    acc[m][0] = __builtin_amdgcn_mfma_f32_16x16x32_bf16(Bf[0][s], af, acc[m][0], 0, 0, 0); acc[m][1] = __builtin_amdgcn_mfma_f32_16x16x32_bf16(Bf[1][s], af, acc[m][1], 0, 0, 0); } }
#pragma unroll
            for (int m = 0; m < 8; ++m) { const int i = 16 * m + fr; const float bsv = BS[h * 128 + i]; const size_t t = (size_t)(t0 + i);
                const v4u uw = *(const v4u*)(HS + t * 4096 + cb + 32 * wave + 8 * fq); float o[8];
#pragma unroll
                for (int n = 0; n < 2; ++n)
#pragma unroll
                    for (int z = 0; z < 4; ++z) { const int c = 4 * n + z; const float uu = (c & 1) ? bf_hi(uw[c >> 1]) : bf_lo(uw[c >> 1]); o[c] = uu * (acc[m][n][z] + bsv); }
                v4u w; w.x = cvt_pk_bf16(o[0], o[1]); w.y = cvt_pk_bf16(o[2], o[3]); w.z = cvt_pk_bf16(o[4], o[5]); w.w = cvt_pk_bf16(o[6], o[7]);
                *(v4u*)(GT + t * SGU_W + cb + 32 * wave + 8 * fq) = w; }
            __syncthreads();
        }
    }
}

__device__ __forceinline__ void phase_flush(const Args& a, int vcu, int G) {
    const size_t gt = (size_t)vcu * NTHR + threadIdx.x, NT = (size_t)G * NTHR; f32x4 acc = (f32x4){0.f, 0.f, 0.f, 0.f};
    const f32x4* p0 = (const f32x4*)a.in[I_WG]; const f32x4* p1 = (const f32x4*)a.in[I_WU];
    for (size_t i = gt; i < (size_t)33554432 / 4; i += 4 * NT) { const f32x4 x0 = p0[i], x1 = p0[i + NT], x2 = p0[i + 2 * NT], x3 = p0[i + 3 * NT], y0 = p1[i], y1 = p1[i + NT], y2 = p1[i + 2 * NT], y3 = p1[i + 3 * NT]; acc += x0 + x1 + x2 + x3 + y0 + y1 + y2 + y3; }
    if (acc[0] + acc[1] + acc[2] + acc[3] == 1.2345e-30f) ((float*)(a.ws + WS_CTL))[16000] = acc[0];
}
constexpr int N_PHASES = 16;
__global__ void __launch_bounds__(NTHR, 2) mk_fwd(Args args) {
    extern __shared__ __attribute__((aligned(16))) unsigned char lds_raw[];
    LAS unsigned char* lds = (LAS unsigned char*)lds_raw;
    LAS unsigned char* misc = lds + MISC_OFF;
    const int tid = threadIdx.x;
    const int G = gridDim.x; const int bx = blockIdx.x; const int vcu = (G % 8 == 0) ? (bx % 8) * (G / 8) + bx / 8 : bx;
    unsigned char* ws = args.ws;
    unsigned* ctl = (unsigned*)(ws + WS_CTL);
    if (tid < 16) ((LAS unsigned*)(misc + MI_BARW))[tid] = 0u;
    __syncthreads();
    const int lo = args.ph_lo, hi = args.ph_hi;
    XcdBarrier bar; bar.bar = ctl + CW_BAR; bar.x = 0; bar.st = nullptr;
    if (hi - lo > 1) bar = xcd_barrier_post(ctl + CW_BAR, (volatile LAS unsigned*)(misc + MI_BARW));
#ifndef PH_MASK
#define PH_MASK 0xFFFF
#endif
#define IN(k) (((PH_MASK >> (k)) & 1) && lo <= (k) && (k) < hi)
#ifndef TS_A0
#define TS_A0 -1
#define TS_A1 -1
#define TS_M 1
#endif
    unsigned long long* tsbuf = (unsigned long long*)(ws + 32768);
#define TS_REC(k) do { if (TS_A0 >= 0 && bx == 0 && tid == 0) __hip_atomic_store(tsbuf + (k), (unsigned long long)__builtin_amdgcn_s_memrealtime(), RLX_AGENT); } while (0)
    TS_REC(0);
#ifndef REP_PH
#define REP_PH -1
#define REP_N 1
#endif
#define NREP(k) ((k) == REP_PH ? REP_N : 1)
#ifndef FLUSH_PH
#define FLUSH_PH -2
#endif
#define RUN(k) if (IN(k)) for (int rep = 0; rep < NREP(k); ++rep) if ((((k) == FLUSH_PH && rep == NREP(k) - 1) ? (xcd_barrier(bar), phase_flush(args, vcu, G), xcd_barrier(bar), true) : true))
#define DRY(k) (rep + 1 < NREP(k))
#define BG_LAYER(k) (-1)
#define SEAM(k) do { if (IN(k) && IN((k) + 1)) xcd_barrier(bar, &args, BG_LAYER(k), lds); TS_REC((k) + 1); } while (0)
    using namespace pg8;
    RUN(0) { phase_p0(args, lds, vcu, G); } SEAM(0);
    RUN(1) { DenseSched S{(const char*)(ws + WS_XB), (const char*)(ws + WS_WIN), 2048u, 2048u, 0u, 64, 4, 256, G, bx};
        EpiBf16<0, false, false> E{(bf16*)(ws + WS_Z), DM, nullptr, nullptr};
        gemm_phase<EpiBf16<0, false, false>, DenseSched, false, true, true>(lds, 2048u, 2048u, 16, S, E); } SEAM(1);
    RUN(2) { phase_pool(args, vcu, G); } SEAM(2);
    if (REP_PH == 100 && hi - lo > 1) for (int i = 0; i < REP_N; ++i) xcd_barrier(bar);
    RUN(3) { DenseSched S{(const char*)(ws + WS_POOLED), (const char*)(ws + WS_WGRP), 2048u, 512u, 512u, 64, 4, 256, G, bx};
        EpiBf16<0, false, true> E{(bf16*)(ws + WS_YP), DM, nullptr, args.in[I_PSCALE]};
        gemm_phase<EpiBf16<0, false, true>, DenseSched, false, true, true>(lds, 2048u, 512u, 4, S, E); } SEAM(3);
    RUN(4) { DenseSched S{(const char*)(ws + WS_YP), (const char*)(ws + WS_WOUT), 2048u, 2048u, 0u, 64, 4, 256, G, bx};
        EpiResid E{args.in[I_X], args.out};
        gemm_phase<EpiResid, DenseSched, false, true, true>(lds, 2048u, 2048u, 16, S, E); } SEAM(4);
#define MOE_PHASES(layer, pb) do { \
        RUN(pb) { phase_lnr(args, layer, lds, vcu, G, DRY(pb)); } SEAM(pb); \
        RUN((pb) + 1) { const MoeInfo mi = moe_setup(args, layer, misc); \
            G1Sched S{mi, (const char*)(ws + WS_XB), (const char*)(ws + WS_WGU + (size_t)layer * WS_MOE_LSTRIDE), (const unsigned*)(ws + WS_ROWTOK), (const unsigned*)(ws + WS_IDENT), G, vcu}; \
            EpiSwiglu E{(bf16*)(ws + WS_H)}; \
            gemm_phase<EpiSwiglu, G1Sched, true, true, true>(lds, 2048u, 2048u, 16, S, E); } SEAM((pb) + 1); \
        if (IN((pb) + 2) && REP_PH == (pb) + 2) { const MoeInfo mi = moe_setup(args, layer, misc); \
            G2Sched S{mi, (const char*)(ws + WS_H), (const char*)(ws + WS_WDN + (size_t)layer * WS_MOE_LSTRIDE), G, vcu, 256}; \
            EpiDown E{(unsigned char*)(ws + WS_Y)}; \
            gemm_phase<EpiDown, G2Sched, false, true, true, 1>(lds, 512u, 512u, 4, S, E); } \
        if (IN((pb) + 2)) { const MoeInfo mi = moe_setup(args, layer, misc); \
            G2Sched S{mi, (const char*)(ws + WS_H), (const char*)(ws + WS_WDN + (size_t)layer * WS_MOE_LSTRIDE), G, vcu, 0}; \
            EpiDown E{(unsigned char*)(ws + WS_Y)}; \
            gemm_phase<EpiDown, G2Sched, false, true, true, 1>(lds, 512u, 512u, 4, S, E); } SEAM((pb) + 2); \
        RUN((pb) + 3) { phase_combine(args, layer, misc, vcu, G, DRY((pb) + 3)); if (layer == 0 && !DRY((pb) + 3)) { __syncthreads(); convert_static(args, 1, lds, vcu, G); } } \
    } while (0)
    MOE_PHASES(0, 5); SEAM(8);
    RUN(9) { DenseSched S{(const char*)(ws + WS_XB), (const char*)(ws + WS_WSIN), 2048u, 2048u, 0u, 64, 16, 1024, G, bx};
        EpiBf16<1, true, false> E{(bf16*)(ws + WS_HS), 4096, args.in[I_SBIN], nullptr};
        gemm_phase<EpiBf16<1, true, false>, DenseSched, false, true, true>(lds, 2048u, 2048u, 16, S, E); } SEAM(9);
    RUN(10) { phase_sgu_spatial(args, lds, vcu, G); } SEAM(10);
    RUN(11) { DenseSched S{(const char*)(ws + WS_GATED), (const char*)(ws + WS_WSOUT), 4096u, 4096u, 0u, 64, 4, 256, G, bx};
        EpiResid E{args.out, DRY(11) ? (float*)(ws + WS_HS) : args.out};
        gemm_phase<EpiResid, DenseSched, false, true, true>(lds, 4096u, 4096u, 32, S, E); } SEAM(11);
    MOE_PHASES(1, 12);
#undef MOE_PHASES
    if (TS_A0 >= 0 && bx == 0 && tid == 0) {
        const unsigned long long tend = __builtin_amdgcn_s_memrealtime();
        const unsigned long long t0 = __hip_atomic_load(tsbuf + TS_A0, RLX_AGENT), t1 = (TS_A1 + 1 >= N_PHASES) ? tend : __hip_atomic_load(tsbuf + TS_A1 + 1, RLX_AGENT);
        const unsigned long long wait = (t1 - t0) * TS_M;
        while (__builtin_amdgcn_s_memrealtime() - tend < wait) __builtin_amdgcn_s_sleep(8);
    }
#undef IN
#undef SEAM
}

extern "C" void kernel_launch(void* const* d_in, const int* in_sizes, int n_in, void* d_out, int out_size, void* d_ws, size_t ws_size, hipStream_t stream) {
    static int grid = 0;
    if (grid == 0) {
        if (n_in != 24 || out_size != T_TOK * DM || ws_size < WS_END) { fprintf(stderr, "kernel_launch: unexpected shapes (n_in %d out %d ws %zu)\n", n_in, out_size, ws_size); grid = -1; return; }
        int dev = 0, cus = 0;
        if (hipGetDevice(&dev) != hipSuccess || hipDeviceGetAttribute(&cus, hipDeviceAttributeMultiprocessorCount, dev) != hipSuccess) { grid = -1; return; }
        if (hipFuncSetAttribute((const void*)mk_fwd, hipFuncAttributeMaxDynamicSharedMemorySize, LDS_BYTES) != hipSuccess) { fprintf(stderr, "kernel_launch: hipFuncSetAttribute failed\n"); grid = -1; return; }
        int per_cu = 0;
        if (hipOccupancyMaxActiveBlocksPerMultiprocessor(&per_cu, (const void*)mk_fwd, NTHR, LDS_BYTES) != hipSuccess || per_cu < 1) fprintf(stderr, "kernel_launch: occupancy query says %d\n", per_cu);
        (void)hipGetLastError();
        grid = cus;
        if (grid != 256) { fprintf(stderr, "kernel_launch: built for a 256-CU device (got %d)\n", cus); grid = -1; return; }
    }
    if (grid < 0) return;
    (void)hipMemsetAsync((char*)d_ws + WS_CTL, 0, CTL_ZERO_BYTES, stream);
    Args a{};
    for (int i = 0; i < 24; ++i) a.in[i] = (const float*)d_in[i];
    a.out = (float*)d_out; a.ws = (unsigned char*)d_ws;
#if MK_PER_PHASE
    for (int p = 0; p < N_PHASES; ++p) { a.ph_lo = p; a.ph_hi = p + 1; hipLaunchKernelGGL(mk_fwd, dim3(grid), dim3(NTHR), LDS_BYTES, stream, a); }
#else
    a.ph_lo = 0; a.ph_hi = N_PHASES; hipLaunchKernelGGL(mk_fwd, dim3(grid), dim3(NTHR), LDS_BYTES, stream, a);
#endif
}
```

```cpp
#include <hip/hip_runtime.h>
#include <cstdio>
#include <cstdint>

#ifndef MK_PER_PHASE
#define MK_PER_PHASE 0
#endif

#define GAS __attribute__((address_space(1)))
#define LAS __attribute__((address_space(3)))
typedef unsigned short bf16;
typedef unsigned v4u __attribute__((ext_vector_type(4)));
typedef unsigned v2u __attribute__((ext_vector_type(2)));
typedef float f32x4 __attribute__((ext_vector_type(4)));
typedef float f32x2 __attribute__((ext_vector_type(2)));
typedef short bf16x8 __attribute__((ext_vector_type(8)));
#define RLX_AGENT __ATOMIC_RELAXED, __HIP_MEMORY_SCOPE_AGENT
#define LDS_WAIT() asm volatile("s_waitcnt lgkmcnt(0)" ::: "memory")
#define VM_WAIT() asm volatile("s_waitcnt vmcnt(0)" ::: "memory")

constexpr int T_TOK = 16384, DM = 1024, SEQ = 4096, NE = 64, TOPK = 8, EDIM = 256;
constexpr int SGU_W = 2048, SGU_HD = 512;
constexpr float ALPHA = 1.41421356237309515f;
constexpr float LN_EPS = 1e-5f, ROUTED_SCALE = 2.5f;
constexpr int CAP = 16384;
constexpr int NWAVES = 8, NTHR = 512;

constexpr size_t MiB = 1u << 20;
constexpr size_t WS_CTL = 0, CTL_ZERO_BYTES = 65536;
constexpr size_t WS_IDENT = 256 * 1024;
constexpr size_t WS_DEST = 1 * MiB;
constexpr size_t WS_GATE = WS_DEST + 512 * 1024;
constexpr size_t WS_ROWTOK = 2 * MiB;
constexpr size_t WS_WIN = 6 * MiB;
constexpr size_t WS_WGRP = 8 * MiB;
constexpr size_t WS_WOUT = WS_WGRP + 512 * 1024;
constexpr size_t WS_WSIN = WS_WOUT + 2 * MiB;
constexpr size_t WS_WSOUT = WS_WSIN + 8 * MiB;
constexpr size_t WS_WRT = WS_WSOUT + 4 * MiB;
constexpr size_t WS_WGU = 23 * MiB;
constexpr size_t WS_WDN = WS_WGU + 65 * MiB;
constexpr size_t WS_XB = 121 * MiB;
constexpr size_t WS_H = 153 * MiB;
constexpr size_t WS_Y = 233 * MiB;
constexpr size_t WS_WGU1 = 378 * MiB, WS_WDN1 = WS_WGU1 + 65 * MiB;
constexpr size_t WS_MOE_LSTRIDE = WS_WGU1 - WS_WGU;
constexpr size_t WS_END = 476 * MiB;
constexpr size_t WS_Z = 153 * MiB, WS_POOLED = 185 * MiB, WS_YP = 217 * MiB;
constexpr size_t WS_HS = 153 * MiB;
constexpr size_t WS_GATED = 281 * MiB;
static_assert(WS_WRT + 512 * 1024 <= WS_WGU && WS_WDN + 33 * MiB <= WS_XB && WS_XB + 32 * MiB <= WS_H && WS_H + 80 * MiB <= WS_Y && WS_Y + 145 * MiB <= WS_WGU1 && WS_WDN1 + 33 * MiB <= WS_END && WS_GATED + 64 * MiB <= WS_WGU1, "ws map");
constexpr int CW_TMO = 0, CW_BAR = 64, CW_CNT = 4096, CW_QNEXT = 4608;

constexpr int RING_BYTES = 131072;
constexpr int MISC_OFF = RING_BYTES;
constexpr int LDS_BYTES = 147456;
constexpr int MI_BARW = 0, MI_CNT = 64, MI_TSTART = 320, MI_YSTART = 576, MI_NTILES = 832, MI_TILE_E = 1024;

__device__ __forceinline__ unsigned cvt_pk_bf16(float lo, float hi) { unsigned r; asm volatile("v_cvt_pk_bf16_f32 %0, %1, %2" : "=v"(r) : "v"(lo), "v"(hi)); return r; }
__device__ __forceinline__ float bf_lo(unsigned w) { return __uint_as_float(w << 16); }
__device__ __forceinline__ float bf_hi(unsigned w) { return __uint_as_float(w & 0xffff0000u); }
__device__ __forceinline__ float wave_sum(float v) {
#pragma unroll
    for (int o = 1; o < 64; o <<= 1) v += __shfl_xor(v, o);
    return v;
}
__device__ __forceinline__ float sigmoidf_(float x) { return __builtin_amdgcn_rcpf(1.0f + __builtin_amdgcn_exp2f(-1.4426950408889634f * x)); }
__device__ __forceinline__ float gelu_tanh(float v) { const float y = v + 0.044715f * v * v * v; return v * __builtin_amdgcn_rcpf(1.0f + __builtin_amdgcn_exp2f(-2.3022081983f * y)); }

#define XB_TMO      128
#define XB_XCNT(j)  (256  + 64 * (j))
#define XB_XSUB(j)  (1280 + 64 * (j))
#define XB_XGEN(j)  (2304 + 64 * (j))
#define XB_TOP      3328
#define XB_TOPGEN   3392
#define XCD_BAR_WORDS 3456
#define XB_SPIN_CAP (1u << 20)
__device__ __forceinline__ unsigned xb_ld(unsigned* p)              { return __hip_atomic_load(p, __ATOMIC_RELAXED, __HIP_MEMORY_SCOPE_AGENT); }
__device__ __forceinline__ unsigned xb_add(unsigned* p, unsigned v) { return __hip_atomic_fetch_add(p, v, __ATOMIC_RELAXED, __HIP_MEMORY_SCOPE_AGENT); }
__device__ __forceinline__ unsigned xb_xcc_id() { return (unsigned)__builtin_amdgcn_s_getreg((3 << 11) | 20) & 0xFu; }
#define XB_SPIN(cond, bar) do { unsigned _sp = 0; while (cond) { __builtin_amdgcn_s_sleep(1); \
    if ((++_sp & 255u) == 0u) { if (xb_ld(&(bar)[XB_TMO])) break; if (_sp > XB_SPIN_CAP) { atomicAdd(&(bar)[XB_TMO], 1u); break; } } } } while (0)
struct XcdBarrier { unsigned* bar; unsigned x; volatile LAS unsigned* st; };
__device__ __forceinline__ XcdBarrier xcd_barrier_post(unsigned* bar, volatile LAS unsigned* st) {
    XcdBarrier b; b.bar = bar; b.x = xb_xcc_id(); b.st = st;
    if (threadIdx.x == 0) (void)xb_add(&bar[XB_XCNT(b.x)], 1u);
    return b;
}
__device__ __forceinline__ void xcd_barrier_complete(unsigned* bar, unsigned x, unsigned& nloc, unsigned& nx) {
    const unsigned G = gridDim.x * gridDim.y * gridDim.z;
    unsigned sum, cnt, mine, sp = 0u;
    for (;;) {
        sum = 0u; cnt = 0u; mine = 0u;
#pragma unroll
        for (unsigned j = 0; j < 16; ++j) { const unsigned c = xb_ld(&bar[XB_XCNT(j)]); sum += c; cnt += (c > 0u) ? 1u : 0u; mine = (j == x) ? c : mine; }
        if (sum == G) break;
        __builtin_amdgcn_s_sleep(1);
        if ((++sp & 255u) == 0u) { if (xb_ld(&bar[XB_TMO])) break; if (sp > XB_SPIN_CAP) { atomicAdd(&bar[XB_TMO], 1u); break; } }
    }
    nloc = mine > 0u ? mine : 1u; nx = cnt > 0u ? cnt : 1u;
}
struct Args;
__device__ __forceinline__ bool convert_steal(const Args& a, int layer, LAS unsigned char* lds, int wave, int lane);
__device__ __forceinline__ void xcd_barrier(const XcdBarrier& b, const Args* bga = nullptr, int bg_layer = -1, LAS unsigned char* lds = nullptr) {
    asm volatile("s_waitcnt vmcnt(0)" ::: "memory");
    __syncthreads();
    if (threadIdx.x == 0) {
        unsigned* bar = b.bar;
        __builtin_amdgcn_s_waitcnt(0);
        unsigned nloc = b.st[0], nx = b.st[1];
        if (nloc == 0u) { xcd_barrier_complete(bar, b.x, nloc, nx); b.st[0] = nloc; b.st[1] = nx; }
        const unsigned old = xb_add(&bar[XB_XSUB(b.x)], 1u);
        const unsigned gen = old / nloc;
        if (old + 1u == (gen + 1u) * nloc) {
            __builtin_amdgcn_fence(__ATOMIC_RELEASE, "agent");
            asm volatile("s_waitcnt vmcnt(0)" ::: "memory");
            const unsigned og = xb_add(&bar[XB_TOP], 1u);
            const unsigned tg = og / nx;
            if (og + 1u == (tg + 1u) * nx) xb_add(&bar[XB_TOPGEN], 1u);
            else XB_SPIN(xb_ld(&bar[XB_TOPGEN]) == tg, bar);
            __builtin_amdgcn_fence(__ATOMIC_ACQUIRE, "agent");
            xb_add(&bar[XB_XGEN(b.x)], 1u);
            asm volatile("s_waitcnt vmcnt(0)" ::: "memory");
            b.st[2] = 0xFFFFFFFFu;
        } else if (bg_layer < 0) {
            XB_SPIN(xb_ld(&bar[XB_XGEN(b.x)]) == gen, bar);
            __builtin_amdgcn_fence(__ATOMIC_ACQUIRE, "agent");
            asm volatile("s_waitcnt vmcnt(0)" ::: "memory");
            b.st[2] = 0xFFFFFFFFu;
        } else b.st[2] = gen;
    }
    __syncthreads();
    if (bg_layer >= 0) {
        const unsigned gen = b.st[2];
        if (gen != 0xFFFFFFFFu) {
            const int lane = threadIdx.x & 63, wave = __builtin_amdgcn_readfirstlane(threadIdx.x >> 6);
            bool more = true;
            while (more && (unsigned)__builtin_amdgcn_readfirstlane((int)xb_ld(&b.bar[XB_XGEN(b.x)])) == gen) more = convert_steal(*bga, bg_layer, lds, wave, lane);
            asm volatile("s_waitcnt vmcnt(0)" ::: "memory");
            __syncthreads();
            if (threadIdx.x == 0) { XB_SPIN(xb_ld(&b.bar[XB_XGEN(b.x)]) == gen, b.bar); __builtin_amdgcn_fence(__ATOMIC_ACQUIRE, "agent"); asm volatile("s_waitcnt vmcnt(0)" ::: "memory"); }
        } else __syncthreads();
        __syncthreads();
    }
}

namespace pg8 {
constexpr int BM = 256, BK = 64, HALF = 128, HTB = HALF * BK * 2, STAGE_BYTES = 8 * HTB, NXCD = 8, WGM = 8;
__host__ __device__ __forceinline__ int lds_byte(int r, int c) { const int st = (r >> 4) * 2 + (c >> 5), rr = r & 15, cc = c & 31, ob = rr * 64 + cc * 2; return st * 1024 + (ob ^ (((ob >> 9) & 1) << 5)); }
__host__ __device__ __forceinline__ void stage_rc(int b, int& R, int& C) { const int st = b / 1024, sb = b % 1024, swz = sb ^ (((sb >> 9) & 1) << 5); R = (st >> 1) * 16 + swz / 64; C = (st & 1) * 32 + (swz % 64) / 2; }
__host__ __device__ __forceinline__ int perm32(int rho) { const int n = rho >> 4, i = rho & 15; return 8 * (i >> 2) + 4 * n + (i & 3); }

typedef int v8i __attribute__((ext_vector_type(8)));
typedef int v4i __attribute__((ext_vector_type(4)));
__device__ __forceinline__ v8i cat8(bf16x8 lo, bf16x8 hi) { const v4i a = __builtin_bit_cast(v4i, lo), b = __builtin_bit_cast(v4i, hi); return __builtin_shufflevector(a, b, 0, 1, 2, 3, 4, 5, 6, 7); }
struct Unit { const char* A; const char* B; const unsigned* gat; int nvalid; int i0, i1, i2; };

template <class Epi, class Sched, bool GATHER, bool ALIGN_EPI, bool SP2, int BMODE = 0, int F8 = 0>
__device__ __forceinline__ void gemm_phase(LAS unsigned char* lds, const unsigned lda, const unsigned ldb, const int nt, const Sched& S, const Epi& E) {
    const int tid = threadIdx.x, wid = __builtin_amdgcn_readfirstlane(tid >> 6), lane = tid & 63, wr = wid >> 2, wc = wid & 3, fr = lane & 15, fq = lane >> 4;
    int R0, C0, R1, C1; stage_rc(tid * 16, R0, C0); stage_rc(tid * 16 + 8192, R1, C1);
    const int Rb0 = BMODE == 0 ? (R0 & ~31) + perm32(R0 & 31) : 64 * (R0 >> 5) + 16 * ((R0 & 15) >> 2) + 4 * ((R0 >> 4) & 1) + (R0 & 3);
    const int Rb1 = BMODE == 0 ? (R1 & ~31) + perm32(R1 & 31) : 64 * (R1 >> 5) + 16 * ((R1 & 15) >> 2) + 4 * ((R1 >> 4) & 1) + (R1 & 3);
    const unsigned voffB0 = (unsigned)Rb0 * ldb + (unsigned)C0 * 2u, voffB1 = (unsigned)Rb1 * ldb + (unsigned)C1 * 2u;
    const size_t hstepB = (size_t)(BMODE == 0 ? HALF : 8) * ldb;
    const size_t kstep = (size_t)(BK * 2);
    const unsigned ldsw = (unsigned)wid * 1024u;
    const int aoff = lds_byte(wr * 64 + fr, F8 ? fq * 16 : fq * 8), boff = lds_byte(wc * 32 + fr, F8 ? fq * 16 : fq * 8);
    const int aoff2 = F8 ? lds_byte(wr * 64 + fr, fq * 16 + 8) : aoff + 1024, boff2 = F8 ? lds_byte(wc * 32 + fr, fq * 16 + 8) : boff + 1024;
#define PG8_SA(b, h) (((b) * 2 + (h)) * HTB)
#define PG8_SB(b, h) ((4 + (b) * 2 + (h)) * HTB)
#define PG8_STAGE(bufoff, gbase, v0, v1) do { unsigned _v0 = (v0), _v1 = (v1); asm volatile("" : "+v"(_v0), "+v"(_v1)); \
        __builtin_amdgcn_global_load_lds((const unsigned*)((const char*)(gbase) + _v0), (LAS unsigned*)(lds + (bufoff) + ldsw), 16, 0, 0); \
        __builtin_amdgcn_global_load_lds((const unsigned*)((const char*)(gbase) + _v1), (LAS unsigned*)(lds + (bufoff) + ldsw + 8192), 16, 0, 0); } while (0)
#define PG8_LDA(dst, b, h) do { _Pragma("unroll") for (int m = 0; m < 4; ++m) { dst[m][0] = *(const LAS bf16x8*)(lds + PG8_SA(b, h) + aoff + m * 2048); dst[m][1] = *(const LAS bf16x8*)(lds + PG8_SA(b, h) + aoff2 + m * 2048); } } while (0)
#define PG8_LDB(dst, b, h) do { _Pragma("unroll") for (int n = 0; n < 2; ++n) { dst[n][0] = *(const LAS bf16x8*)(lds + PG8_SB(b, h) + boff + n * 2048); dst[n][1] = *(const LAS bf16x8*)(lds + PG8_SB(b, h) + boff2 + n * 2048); } } while (0)
#define PG8_MMA(ai, bj, At, Bt) do { __builtin_amdgcn_s_setprio(1); _Pragma("unroll") for (int m = 0; m < 4; ++m) _Pragma("unroll") for (int n = 0; n < 2; ++n) { \
        if constexpr (F8) acc[ai][bj][m][n] = __builtin_amdgcn_mfma_scale_f32_16x16x128_f8f6f4(cat8(Bt[n][0], Bt[n][1]), cat8(At[m][0], At[m][1]), acc[ai][bj][m][n], 0, 0, 0, 0x7F7F7F7F, 0, 0x7F7F7F7F); \
        else { _Pragma("unroll") for (int k = 0; k < 2; ++k) acc[ai][bj][m][n] = __builtin_amdgcn_mfma_f32_16x16x32_bf16(Bt[n][k], At[m][k], acc[ai][bj][m][n], 0, 0, 0); } } __builtin_amdgcn_s_setprio(0); } while (0)
#define PG8_WAIT_V(n) asm volatile("s_waitcnt vmcnt(" #n ")" ::: "memory")
#define PG8_WAIT_L(n) asm volatile("s_waitcnt lgkmcnt(" #n ")" ::: "memory")
#define PG8_BAR __builtin_amdgcn_s_barrier()
#define PG8_SCHED __builtin_amdgcn_sched_barrier(0)
#define PG8_SETV(v00, v01, v10, v11, u) do { \
        if (GATHER) { int _t = tid; asm volatile("" : "+v"(_t)); int r0, c0, r1, c1; stage_rc(_t * 16, r0, c0); stage_rc(_t * 16 + 8192, r1, c1);     \
            const unsigned ta = r0 < (u).nvalid ? (u).gat[r0] : 0u, tb = r1 < (u).nvalid ? (u).gat[r1] : 0u, \
                                     tc = (HALF + r0) < (u).nvalid ? (u).gat[HALF + r0] : 0u, td = (HALF + r1) < (u).nvalid ? (u).gat[HALF + r1] : 0u; \
            v00 = ta * lda + (unsigned)c0 * 2u; v01 = tb * lda + (unsigned)c1 * 2u; v10 = tc * lda + (unsigned)c0 * 2u; v11 = td * lda + (unsigned)c1 * 2u; } \
        else { v00 = (unsigned)R0 * lda + (unsigned)C0 * 2u; v01 = (unsigned)R1 * lda + (unsigned)C1 * 2u; v10 = (unsigned)(HALF + R0) * lda + (unsigned)C0 * 2u; v11 = (unsigned)(HALF + R1) * lda + (unsigned)C1 * 2u; } } while (0)
    Unit cur, nxt; int ui = 0;
    if (!S.next(0, cur)) return;
    f32x4 acc[2][2][4][2];
#pragma unroll
    for (int a = 0; a < 2; ++a)
#pragma unroll
        for (int b = 0; b < 2; ++b)
#pragma unroll
            for (int m = 0; m < 4; ++m)
#pragma unroll
                for (int n = 0; n < 2; ++n) acc[a][b][m][n] = (f32x4){0.f, 0.f, 0.f, 0.f};
    bf16x8 At[4][2], B0[2][2], B1[2][2];
    const char* cA = cur.A; const char* cB = cur.B;
    unsigned cv00, cv01, cv10, cv11;
    PG8_SETV(cv00, cv01, cv10, cv11, cur);
    if constexpr (SP2) {
        PG8_STAGE(PG8_SB(0, 0), cB, voffB0, voffB1); PG8_STAGE(PG8_SB(0, 1), cB + hstepB, voffB0, voffB1); PG8_STAGE(PG8_SA(0, 0), cA, cv00, cv01); PG8_STAGE(PG8_SA(0, 1), cA, cv10, cv11);
        if (wr == 1) PG8_BAR;
        PG8_WAIT_V(2); PG8_BAR;
        PG8_STAGE(PG8_SB(1, 0), cB + kstep, voffB0, voffB1); PG8_STAGE(PG8_SA(1, 0), cA + kstep, cv00, cv01); PG8_STAGE(PG8_SB(1, 1), cB + hstepB + kstep, voffB0, voffB1);
        PG8_WAIT_V(6); PG8_BAR;
    } else {
        PG8_STAGE(PG8_SB(0, 0), cB, voffB0, voffB1); PG8_STAGE(PG8_SA(0, 0), cA, cv00, cv01); PG8_STAGE(PG8_SB(0, 1), cB + hstepB, voffB0, voffB1); PG8_STAGE(PG8_SA(0, 1), cA, cv10, cv11);
        if (wr == 1) PG8_BAR;
        PG8_WAIT_V(4); PG8_BAR;
        PG8_STAGE(PG8_SB(1, 0), cB + kstep, voffB0, voffB1); PG8_STAGE(PG8_SA(1, 0), cA + kstep, cv00, cv01); PG8_STAGE(PG8_SB(1, 1), cB + hstepB + kstep, voffB0, voffB1);
        PG8_WAIT_V(6); PG8_BAR;
    }
    for (;;) {
        const bool has_next = S.next(ui + 1, nxt);
        const char* nA = has_next ? nxt.A : cA; const char* nB = has_next ? nxt.B : cB;
#pragma unroll 1
        for (int t = 0; t < nt; t += 2) {
            const bool last = (t == nt - 2);
            const char* a1 = cA + (size_t)(t + 1) * kstep;
            const char* a2 = last ? nA : cA + (size_t)(t + 2) * kstep; const char* b2 = last ? nB : cB + (size_t)(t + 2) * kstep;
            const char* a3 = a2 + kstep; const char* b3 = b2 + kstep;
            if constexpr (SP2) {
            PG8_LDB(B0, 0, 0); PG8_LDB(B1, 0, 1); PG8_SCHED; PG8_LDA(At, 0, 0); PG8_STAGE(PG8_SA(1, 1), a1, cv10, cv11);
            PG8_WAIT_V(8); PG8_WAIT_L(0); PG8_BAR; PG8_MMA(0, 0, At, B0); PG8_MMA(0, 1, At, B1); PG8_BAR; PG8_SCHED;
            if constexpr (GATHER) { if (last && has_next) { PG8_SETV(cv00, cv01, cv10, cv11, nxt); } }
            PG8_LDA(At, 0, 1); PG8_STAGE(PG8_SB(0, 0), b2, voffB0, voffB1); PG8_STAGE(PG8_SB(0, 1), b2 + hstepB, voffB0, voffB1); PG8_STAGE(PG8_SA(0, 0), a2, cv00, cv01);
            PG8_WAIT_V(8); PG8_WAIT_L(0); PG8_BAR; PG8_MMA(1, 0, At, B0); PG8_MMA(1, 1, At, B1); PG8_BAR; PG8_SCHED;
            PG8_LDB(B0, 1, 0); PG8_LDB(B1, 1, 1); PG8_SCHED; PG8_LDA(At, 1, 0); PG8_STAGE(PG8_SA(0, 1), a2, cv10, cv11);
            PG8_WAIT_V(8); PG8_WAIT_L(0); PG8_BAR; PG8_MMA(0, 0, At, B0); PG8_MMA(0, 1, At, B1); PG8_BAR; PG8_SCHED;
            PG8_LDA(At, 1, 1); PG8_STAGE(PG8_SB(1, 0), b3, voffB0, voffB1); PG8_STAGE(PG8_SB(1, 1), b3 + hstepB, voffB0, voffB1); PG8_STAGE(PG8_SA(1, 0), a3, cv00, cv01);
            PG8_WAIT_V(8); PG8_WAIT_L(0); PG8_BAR; PG8_MMA(1, 0, At, B0); PG8_MMA(1, 1, At, B1); PG8_BAR; PG8_SCHED;
            } else {
            PG8_LDB(B0, 0, 0); PG8_SCHED; PG8_LDA(At, 0, 0); PG8_STAGE(PG8_SA(1, 1), a1, cv10, cv11);
            PG8_WAIT_L(8); PG8_BAR; PG8_WAIT_L(0); PG8_MMA(0, 0, At, B0); PG8_BAR; PG8_SCHED;
            if constexpr (GATHER) { if (last && has_next) { PG8_SETV(cv00, cv01, cv10, cv11, nxt); } }
            PG8_LDB(B1, 0, 1); PG8_STAGE(PG8_SB(0, 0), b2, voffB0, voffB1);
            PG8_BAR; PG8_WAIT_L(0); PG8_MMA(0, 1, At, B1); PG8_BAR;
            PG8_LDA(At, 0, 1); PG8_STAGE(PG8_SA(0, 0), a2, cv00, cv01);
            PG8_BAR; PG8_WAIT_L(0); PG8_MMA(1, 0, At, B0); PG8_BAR; PG8_SCHED;
            PG8_STAGE(PG8_SB(0, 1), b2 + hstepB, voffB0, voffB1);
            PG8_WAIT_V(6); PG8_BAR; PG8_MMA(1, 1, At, B1); PG8_BAR;
            PG8_LDB(B0, 1, 0); PG8_SCHED; PG8_LDA(At, 1, 0); PG8_STAGE(PG8_SA(0, 1), a2, cv10, cv11);
            PG8_WAIT_L(8); PG8_BAR; PG8_WAIT_L(0); PG8_MMA(0, 0, At, B0); PG8_BAR; PG8_SCHED;
            PG8_LDB(B1, 1, 1); PG8_STAGE(PG8_SB(1, 0), b3, voffB0, voffB1);
            PG8_BAR; PG8_WAIT_L(0); PG8_MMA(0, 1, At, B1); PG8_BAR;
            PG8_LDA(At, 1, 1); PG8_STAGE(PG8_SA(1, 0), a3, cv00, cv01);
            PG8_BAR; PG8_WAIT_L(0); PG8_MMA(1, 0, At, B0); PG8_BAR; PG8_SCHED;
            PG8_STAGE(PG8_SB(1, 1), b3 + hstepB, voffB0, voffB1);
            PG8_WAIT_V(6); PG8_BAR; PG8_MMA(1, 1, At, B1); PG8_BAR;
            }
        }
        if constexpr (ALIGN_EPI) { if (wr == 0) PG8_BAR; }
        E(acc, cur, wr, wc, fr, fq);
        if (!has_next) break;
#pragma unroll
        for (int a = 0; a < 2; ++a)
#pragma unroll
            for (int b = 0; b < 2; ++b)
#pragma unroll
                for (int m = 0; m < 4; ++m)
#pragma unroll
                    for (int n = 0; n < 2; ++n) acc[a][b][m][n] = (f32x4){0.f, 0.f, 0.f, 0.f};
        cur = nxt; cA = nA; cB = nB; ++ui;
        if constexpr (ALIGN_EPI) { if (wr == 1) PG8_BAR; }
    }
    PG8_WAIT_V(0);
    if constexpr (!ALIGN_EPI) { if (wr == 0) PG8_BAR; }
    PG8_BAR;
#undef PG8_SA
#undef PG8_SB
#undef PG8_STAGE
#undef PG8_LDA
#undef PG8_LDB
#undef PG8_MMA
#undef PG8_WAIT_V
#undef PG8_WAIT_L
#undef PG8_BAR
#undef PG8_SCHED
#undef PG8_SETV
}

struct DenseSched {
    const char* A; const char* B; unsigned lda, ldb, a_pn; int nM, nN, nwg, G, c;
    __device__ __forceinline__ bool next(int i, Unit& u) const {
        const long L = (long)i * G + c; if (L >= nwg) return false;
        int wgid = (int)L; { const int q = nwg / NXCD, r = nwg % NXCD, xcd = wgid % NXCD, off = wgid / NXCD; wgid = (xcd < r ? xcd * (q + 1) : r * (q + 1) + (xcd - r) * q) + off; }
        const int nig = WGM * nN, gid = wgid / nig, fm = gid * WGM, gsz = (nM - fm) < WGM ? (nM - fm) : WGM;
        const int pm = fm + ((wgid % nig) % gsz), pn = (wgid % nig) / gsz;
        u.A = A + (size_t)pm * BM * lda + (size_t)pn * a_pn; u.B = B + (size_t)pn * BM * ldb; u.gat = nullptr; u.nvalid = BM; u.i0 = pm; u.i1 = pn; u.i2 = 0; return true;
    }
};
struct MoeInfo { const LAS unsigned* cnt; const LAS unsigned* tstart; const LAS unsigned* ystart; const LAS unsigned char* tile_e; int ntiles; };
struct G1Sched {
    MoeInfo mi; const char* XB; const char* Wgu; const unsigned* rowtok; const unsigned* ident; int G, vcu;
    __device__ __forceinline__ bool next(int i, Unit& u) const {
        const int L = i * G + vcu; if (L >= 2 * mi.ntiles) return false;
        const int tile = L >> 1, uu = L & 1; int e;
        if (tile < 64) { e = 64; u.gat = ident + tile * 256; u.nvalid = 256; }
        else { e = __builtin_amdgcn_readfirstlane((int)mi.tile_e[tile]); const int pos0 = (tile - __builtin_amdgcn_readfirstlane((int)mi.tstart[e])) * 256; u.gat = rowtok + (size_t)e * CAP + pos0; const int rem = __builtin_amdgcn_readfirstlane((int)mi.cnt[e]) - pos0; u.nvalid = rem < 256 ? rem : 256; }
        u.A = XB; u.B = Wgu + ((size_t)e * 512 + (size_t)uu * 256) * 1024; u.i0 = tile; u.i1 = uu; u.i2 = 0; return true;
    }
};
struct G2Sched {
    MoeInfo mi; const char* H; const char* Wd; int G, vcu, L0;
    __device__ __forceinline__ bool next(int i, Unit& u) const {
        const int L = i * G + vcu + L0; if (L >= 4 * mi.ntiles) return false;
        const int tile = L >> 2, pn = L & 3; int e;
        if (tile < 64) { e = 64; u.i0 = 131072 + tile * 256; u.i2 = 0; u.nvalid = 256; }
        else { e = __builtin_amdgcn_readfirstlane((int)mi.tile_e[tile]); const int pos0 = (tile - __builtin_amdgcn_readfirstlane((int)mi.tstart[e])) * 256; u.i0 = __builtin_amdgcn_readfirstlane((int)mi.ystart[e]) + pos0; u.i2 = 0; const int rem = __builtin_amdgcn_readfirstlane((int)mi.cnt[e]) - pos0; u.nvalid = rem < 256 ? rem : 256; }
        u.A = H + (size_t)tile * 256 * 512; u.B = Wd + ((size_t)e * 1024 + (size_t)pn * 256) * 512; u.gat = nullptr; u.i1 = pn; return true;
    }
};

template <int ACT, bool BIAS, bool SCALE> struct EpiBf16 {
    bf16* O; int ldo; const float* bias; const float* scale;
    __device__ __forceinline__ void operator()(const f32x4 (&acc)[2][2][4][2], const Unit& u, int wr, int wc, int fr, int fq) const {
        const int row0 = u.i0 * BM + wr * 64 + fr, col0 = u.i1 * BM + wc * 32 + 8 * fq;
        f32x4 bv[2][2], sv[2][2];
#pragma unroll
        for (int bj = 0; bj < 2; ++bj)
#pragma unroll
            for (int n = 0; n < 2; ++n) { bv[bj][n] = BIAS ? *(const f32x4*)(bias + col0 + bj * HALF + 4 * n) : (f32x4){0.f, 0.f, 0.f, 0.f}; sv[bj][n] = SCALE ? *(const f32x4*)(scale + col0 + bj * HALF + 4 * n) : (f32x4){1.f, 1.f, 1.f, 1.f}; }
#pragma unroll
        for (int ai = 0; ai < 2; ++ai)
#pragma unroll
            for (int m = 0; m < 4; ++m) { bf16* rowp = O + (size_t)(row0 + ai * HALF + m * 16) * ldo + col0;
#pragma unroll
                for (int bj = 0; bj < 2; ++bj) { f32x4 v0 = acc[ai][bj][m][0] + bv[bj][0], v1 = acc[ai][bj][m][1] + bv[bj][1];
                    if (ACT == 1) {
#pragma unroll
                        for (int j = 0; j < 4; ++j) { v0[j] = gelu_tanh(v0[j]); v1[j] = gelu_tanh(v1[j]); } }
                    if (SCALE) { v0 = v0 * sv[bj][0]; v1 = v1 * sv[bj][1]; }
                    v4u w; w.x = cvt_pk_bf16(v0[0], v0[1]); w.y = cvt_pk_bf16(v0[2], v0[3]); w.z = cvt_pk_bf16(v1[0], v1[1]); w.w = cvt_pk_bf16(v1[2], v1[3]);
                    *(v4u*)(rowp + bj * HALF) = w; } }
    }
};
struct EpiResid {
    const float* base; float* out;
    __device__ __forceinline__ void operator()(const f32x4 (&acc)[2][2][4][2], const Unit& u, int wr, int wc, int fr, int fq) const {
        const int row0 = u.i0 * BM + wr * 64 + fr, col0 = u.i1 * BM + wc * 32 + 8 * fq;
#pragma unroll
        for (int ai = 0; ai < 2; ++ai)
#pragma unroll
            for (int m = 0; m < 4; ++m) { const size_t off = (size_t)(row0 + ai * HALF + m * 16) * DM + col0;
#pragma unroll
                for (int bj = 0; bj < 2; ++bj) { const f32x4 b0 = *(const f32x4*)(base + off + bj * HALF), b1 = *(const f32x4*)(base + off + bj * HALF + 4);
                    *(f32x4*)(out + off + bj * HALF) = b0 * ALPHA + acc[ai][bj][m][0]; *(f32x4*)(out + off + bj * HALF + 4) = b1 * ALPHA + acc[ai][bj][m][1]; }
                asm volatile("" ::: "memory"); }
    }
};
struct EpiSwiglu {
    bf16* H;
    __device__ __forceinline__ void operator()(const f32x4 (&acc)[2][2][4][2], const Unit& u, int wr, int wc, int fr, int fq) const {
        const int row0 = u.i0 * BM + wr * 64 + fr, col0 = u.i1 * HALF + wc * 32 + 8 * fq;
#pragma unroll
        for (int ai = 0; ai < 2; ++ai)
#pragma unroll
            for (int m = 0; m < 4; ++m) { bf16* rowp = H + (size_t)(row0 + ai * HALF + m * 16) * EDIM + col0; float h[8];
#pragma unroll
                for (int n = 0; n < 2; ++n)
#pragma unroll
                    for (int j = 0; j < 4; ++j) { const float g = acc[ai][0][m][n][j] * 0.03125f, up = acc[ai][1][m][n][j] * 0.03125f; h[4 * n + j] = g * sigmoidf_(g) * up; }
                v4u w; w.x = cvt_pk_bf16(h[0], h[1]); w.y = cvt_pk_bf16(h[2], h[3]); w.z = cvt_pk_bf16(h[4], h[5]); w.w = cvt_pk_bf16(h[6], h[7]);
                *(v4u*)rowp = w; }
    }
};
struct EpiDown {
    unsigned char* Y8;
    __device__ __forceinline__ void operator()(const f32x4 (&acc)[2][2][4][2], const Unit& u, int wr, int wc, int fr, int fq) const {
        const int r0 = wr * 64 + fr, col0 = u.i1 * BM + wc * 64 + 16 * fq;
#pragma unroll
        for (int ai = 0; ai < 2; ++ai)
#pragma unroll
            for (int m = 0; m < 4; ++m) { const int r = r0 + ai * HALF + m * 16;
                if (r < u.nvalid) { v4u w;
#pragma unroll
                    for (int q = 0; q < 4; ++q) { const f32x4 v = acc[ai][q >> 1][m][q & 1] * 16.0f; int t = 0; t = __builtin_amdgcn_cvt_pk_fp8_f32(v[0], v[1], t, false); t = __builtin_amdgcn_cvt_pk_fp8_f32(v[2], v[3], t, true); w[q] = (unsigned)t; }
                    *(v4u*)(Y8 + (size_t)(u.i0 + r) * DM + col0) = w; } }
    }
};
}

struct Args { const float* in[24]; float* out; unsigned char* ws; int ph_lo, ph_hi; };
enum { I_X = 0, I_PWIN, I_PWGRP, I_PSCALE, I_PWOUT, I_SWIN, I_SBIN, I_SLNG, I_SLNB, I_SWS, I_SBS, I_SWOUT, I_LNMG, I_LNMB, I_WR, I_RB, I_WG, I_WU, I_WD, I_SHG, I_SHU, I_SHD, I_LNFG, I_LNFB };

__device__ __forceinline__ void tr_item(const float* W, int N, int k0, int n0, bf16* dst  , int dpitch, LAS float* scr, int lane) {
#pragma unroll 8
    for (int i = 0; i < 32; ++i) { const int kk = 2 * i + (lane >> 5); scr[kk * 33 + (lane & 31)] = W[(size_t)(k0 + kk) * N + n0 + (lane & 31)]; }
    LDS_WAIT(); asm volatile("" ::: "memory");
    const int c = lane & 7;
#pragma unroll
    for (int j = 0; j < 4; ++j) { const int n = (lane >> 3) + 8 * j; const LAS float* s = scr + (8 * c) * 33 + n;
        v4u o; o.x = cvt_pk_bf16(s[0 * 33], s[1 * 33]); o.y = cvt_pk_bf16(s[2 * 33], s[3 * 33]); o.z = cvt_pk_bf16(s[4 * 33], s[5 * 33]); o.w = cvt_pk_bf16(s[6 * 33], s[7 * 33]);
        *(v4u*)(dst + (size_t)n * dpitch + 8 * c) = o; }
    LDS_WAIT(); asm volatile("" ::: "memory");
}
__device__ __forceinline__ void tr_item_f8(const float* W, int N, int k0, int n0, unsigned char* dst, int dpitch, float scale, LAS float* scr, int lane) {
#pragma unroll 8
    for (int i = 0; i < 32; ++i) { const int kk = 2 * i + (lane >> 5); scr[kk * 33 + (lane & 31)] = W[(size_t)(k0 + kk) * N + n0 + (lane & 31)]; }
    LDS_WAIT(); asm volatile("" ::: "memory");
    const int c = lane & 7;
#pragma unroll
    for (int j = 0; j < 4; ++j) { const int n = (lane >> 3) + 8 * j; const LAS float* s = scr + (8 * c) * 33 + n;
        int t0 = 0, t1 = 0;
        t0 = __builtin_amdgcn_cvt_pk_fp8_f32(s[0 * 33] * scale, s[1 * 33] * scale, t0, false); t0 = __builtin_amdgcn_cvt_pk_fp8_f32(s[2 * 33] * scale, s[3 * 33] * scale, t0, true);
        t1 = __builtin_amdgcn_cvt_pk_fp8_f32(s[4 * 33] * scale, s[5 * 33] * scale, t1, false); t1 = __builtin_amdgcn_cvt_pk_fp8_f32(s[6 * 33] * scale, s[7 * 33] * scale, t1, true);
        *(v2u*)(dst + (size_t)n * dpitch + 8 * c) = (v2u){(unsigned)t0, (unsigned)t1}; }
    LDS_WAIT(); asm volatile("" ::: "memory");
}
__device__ __forceinline__ void tr_item_hilo(const float* W, int N, int k0, int n0, bf16* dh, bf16* dl, int dpitch, LAS float* scr, int lane) {
#pragma unroll 8
    for (int i = 0; i < 32; ++i) { const int kk = 2 * i + (lane >> 5); scr[kk * 33 + (lane & 31)] = W[(size_t)(k0 + kk) * N + n0 + (lane & 31)]; }
    LDS_WAIT(); asm volatile("" ::: "memory");
    const int c = lane & 7;
#pragma unroll
    for (int j = 0; j < 4; ++j) { const int n = (lane >> 3) + 8 * j; const LAS float* s = scr + (8 * c) * 33 + n; float w[8];
#pragma unroll
        for (int z = 0; z < 8; ++z) w[z] = s[z * 33];
        v4u o; o.x = cvt_pk_bf16(w[0], w[1]); o.y = cvt_pk_bf16(w[2], w[3]); o.z = cvt_pk_bf16(w[4], w[5]); o.w = cvt_pk_bf16(w[6], w[7]);
        v4u l; l.x = cvt_pk_bf16(w[0] - bf_lo(o.x), w[1] - bf_hi(o.x)); l.y = cvt_pk_bf16(w[2] - bf_lo(o.y), w[3] - bf_hi(o.y)); l.z = cvt_pk_bf16(w[4] - bf_lo(o.z), w[5] - bf_hi(o.z)); l.w = cvt_pk_bf16(w[6] - bf_lo(o.w), w[7] - bf_hi(o.w));
        *(v4u*)(dh + (size_t)n * dpitch + 8 * c) = o; *(v4u*)(dl + (size_t)n * dpitch + 8 * c) = l; }
    LDS_WAIT(); asm volatile("" ::: "memory");
}
constexpr int MOE_ITEMS = 65 * 384;
__device__ __forceinline__ void convert_moe_item(const Args& a, int layer, int it, LAS float* scr, int lane) {
    bf16* WGU = (bf16*)(a.ws + WS_WGU + (size_t)layer * WS_MOE_LSTRIDE); bf16* WDN = (bf16*)(a.ws + WS_WDN + (size_t)layer * WS_MOE_LSTRIDE);
    const int e = it / 384, r = it % 384;
    if (r < 256) { const int isup = r >> 7, rr = r & 127, kb = rr >> 3, nb = rr & 7, n0 = 32 * nb, k0 = 64 * kb;
        const float* src = (e < 64) ? a.in[isup ? I_WU : I_WG] + ((size_t)layer * 64 + e) * 262144 : a.in[isup ? I_SHU : I_SHG] + (size_t)layer * 262144;
        const int drow = e * 512 + (n0 >> 7) * 256 + isup * 128 + (n0 & 127);
        tr_item_f8(src, 256, k0, n0, (unsigned char*)WGU + (size_t)drow * 1024 + k0, 1024, 32.0f, scr, lane);
    } else { const int rr = r - 256, kb = rr >> 5, nb = rr & 31, n0 = 32 * nb, k0 = 64 * kb;
        const float* src = (e < 64) ? a.in[I_WD] + ((size_t)layer * 64 + e) * 262144 : a.in[I_SHD] + (size_t)layer * 262144;
        tr_item(src, 1024, k0, n0, WDN + ((size_t)e * 1024 + n0) * 256 + k0, 256, scr, lane);
    }
}
constexpr int Q_SHARDS = 8, Q_PER_SHARD = MOE_ITEMS / Q_SHARDS;
static_assert(Q_PER_SHARD * Q_SHARDS == MOE_ITEMS, "queue shards");
template <int CHUNK> __device__ __forceinline__ bool convert_steal_n(const Args& a, int layer, LAS unsigned char* lds, int wave, int lane) {
    unsigned* q = (unsigned*)(a.ws + WS_CTL) + CW_QNEXT + 512 * layer;
    const int s0 = (int)(blockIdx.x & 7);
    for (int s = 0; s < Q_SHARDS; ++s) { const int sh = (s0 + s) & 7;
        unsigned it = 0; if (lane == 0) it = __hip_atomic_fetch_add(q + 64 * sh, (unsigned)CHUNK, RLX_AGENT);
        it = (unsigned)__builtin_amdgcn_readfirstlane((int)it);
        if (it < (unsigned)Q_PER_SHARD) {
            for (int c = 0; c < CHUNK; ++c) if (it + c < (unsigned)Q_PER_SHARD) convert_moe_item(a, layer, sh * Q_PER_SHARD + (int)it + c, (LAS float*)(lds + wave * 16384), lane);
            return true; } }
    return false;
}
__device__ __forceinline__ bool convert_steal(const Args& a, int layer, LAS unsigned char* lds, int wave, int lane) { return convert_steal_n<1>(a, layer, lds, wave, lane); }
__device__ __forceinline__ void convert_static(const Args& a, int layer, LAS unsigned char* lds, int vcu, int G) {
    const int lane = threadIdx.x & 63, wave = __builtin_amdgcn_readfirstlane(threadIdx.x >> 6);
    for (int it = vcu * NWAVES + wave; it < MOE_ITEMS; it += G * NWAVES) convert_moe_item(a, layer, it, (LAS float*)(lds + wave * 16384), lane);
}
__device__ __forceinline__ void convert_drain(const Args& a, int layer, LAS unsigned char* lds) {
    const int lane = threadIdx.x & 63, wave = __builtin_amdgcn_readfirstlane(threadIdx.x >> 6);
    while (convert_steal_n<4>(a, layer, lds, wave, lane)) {}
    __syncthreads();
}
__device__ __forceinline__ void phase_p0(const Args& a, LAS unsigned char* lds, int vcu, int G) {
    const int tid = threadIdx.x, lane = tid & 63, wave = __builtin_amdgcn_readfirstlane(tid >> 6);
    const int gw = vcu * NWAVES + wave, NGW = G * NWAVES;
    LAS float* scr = (LAS float*)(lds + wave * 16384);
    constexpr int I_IN = 16 * 32, I_GRP = 4 * 4 * 8, I_OUT = 16 * 32, I_SIN = 16 * 128, I_SOUT = 32 * 32, NIT = I_IN + I_GRP + I_OUT + I_SIN + I_SOUT;
    for (int it = gw; it < NIT; it += NGW) {
        int r = it;
        if (r < I_IN) { const int kb = r >> 5, nb = r & 31; tr_item(a.in[I_PWIN], 1024, 64 * kb, 32 * nb, (bf16*)(a.ws + WS_WIN) + (size_t)(32 * nb) * 1024 + 64 * kb, 1024, scr, lane); continue; } r -= I_IN;
        if (r < I_GRP) { const int g = r >> 5, rr = r & 31, kb = rr >> 3, nb = rr & 7; tr_item(a.in[I_PWGRP] + (size_t)g * 65536, 256, 64 * kb, 32 * nb, (bf16*)(a.ws + WS_WGRP) + (size_t)(g * 256 + 32 * nb) * 256 + 64 * kb, 256, scr, lane); continue; } r -= I_GRP;
        if (r < I_OUT) { const int kb = r >> 5, nb = r & 31; tr_item(a.in[I_PWOUT], 1024, 64 * kb, 32 * nb, (bf16*)(a.ws + WS_WOUT) + (size_t)(32 * nb) * 1024 + 64 * kb, 1024, scr, lane); continue; } r -= I_OUT;
        if (r < I_SIN) { const int kb = r >> 7, nb = r & 127; tr_item(a.in[I_SWIN], 4096, 64 * kb, 32 * nb, (bf16*)(a.ws + WS_WSIN) + (size_t)(32 * nb) * 1024 + 64 * kb, 1024, scr, lane); continue; } r -= I_SIN;
        { const int kb = r >> 5, nb = r & 31; tr_item(a.in[I_SWOUT], 1024, 64 * kb, 32 * nb, (bf16*)(a.ws + WS_WSOUT) + (size_t)(32 * nb) * 2048 + 64 * kb, 2048, scr, lane); }
    }
    for (int it = gw; it < 64; it += NGW) { const int layer = it >> 5, rr = it & 31, kb = rr >> 1, nb = rr & 1; bf16* base = (bf16*)(a.ws + WS_WRT) + (size_t)layer * 2 * 65536 + (size_t)(32 * nb) * 1024 + 64 * kb;
        tr_item_hilo(a.in[I_WR] + (size_t)layer * DM * NE, 64, 64 * kb, 32 * nb, base, base + 65536, 1024, scr, lane); }
    convert_static(a, 0, lds, vcu, G);
    const float* x = a.in[I_X]; bf16* xb = (bf16*)(a.ws + WS_XB);
    const size_t gt = (size_t)vcu * NTHR + tid, NT = (size_t)G * NTHR;
    for (size_t i = gt; i < (size_t)T_TOK * DM / 8; i += NT) { const f32x4 p = *(const f32x4*)(x + i * 8), q = *(const f32x4*)(x + i * 8 + 4);
        v4u w; w.x = cvt_pk_bf16(p[0], p[1]); w.y = cvt_pk_bf16(p[2], p[3]); w.z = cvt_pk_bf16(q[0], q[1]); w.w = cvt_pk_bf16(q[2], q[3]); *(v4u*)(xb + i * 8) = w; }
    unsigned* ident = (unsigned*)(a.ws + WS_IDENT);
    for (size_t i = gt; i < (size_t)T_TOK; i += NT) ident[i] = (unsigned)i;
}

template <int W> __device__ __forceinline__ void pool_item(const bf16* zp  , bf16* op  , int p0  ) {
    v4u q[W + 3];
#pragma unroll
    for (int i = 0; i < W + 3; ++i) { const int ii = i < p0 + 3 ? i : p0 + 3; q[i] = *(const v4u*)(zp - (size_t)ii * DM); }
#pragma unroll
    for (int o = 0; o < 4; ++o) {
        float s[8];
#pragma unroll
        for (int j = 0; j < 8; ++j) s[j] = 0.f;
#pragma unroll
        for (int i = 3 - o; i < 3 - o + W; ++i) { const float m = (i <= p0 + 3) ? 1.0f : 0.0f;
#pragma unroll
            for (int j = 0; j < 4; ++j) { s[2 * j] += m * bf_lo(q[i][j]); s[2 * j + 1] += m * bf_hi(q[i][j]); } }
        const int p = p0 + o, nw = (p + 1) < W ? (p + 1) : W; const float inv = 1.0f / (float)nw; v4u ov;
#pragma unroll
        for (int j = 0; j < 4; ++j) ov[j] = cvt_pk_bf16(s[2 * j] * inv - bf_lo(q[3 - o][j]), s[2 * j + 1] * inv - bf_hi(q[3 - o][j]));
        *(v4u*)(op + (size_t)o * DM) = ov; }
}
__device__ __forceinline__ void phase_pool(const Args& a, int vcu, int G) {
    const bf16* Z = (const bf16*)(a.ws + WS_Z); bf16* P = (bf16*)(a.ws + WS_POOLED);
    const int tid = threadIdx.x, wave = tid >> 6, lane = tid & 63;
    const int gw = vcu * NWAVES + wave, NGW = G * NWAVES;
    for (int it = gw; it < (T_TOK / 4) * 2; it += NGW) {
        const int t0 = (it >> 1) * 4, c8 = (it & 1) * 64 + lane, g = c8 >> 5, p0 = t0 & (SEQ - 1);
        const bf16* zp = Z + (size_t)(t0 + 3) * DM + c8 * 8; bf16* op = P + (size_t)t0 * DM + c8 * 8;
        if (g == 0) pool_item<2>(zp, op, p0); else if (g == 1) pool_item<4>(zp, op, p0); else if (g == 2) pool_item<8>(zp, op, p0); else pool_item<16>(zp, op, p0);
    }
}

template <int R, bool F8OUT = false> __device__ __forceinline__ void ln_rows_store(float (&v)[R][16], const float* g, const float* b, float* const (&of)[R], bf16* const (&ob)[R], int lane) {
    float s[R], s2[R];
#pragma unroll
    for (int r = 0; r < R; ++r) { s[r] = 0.f;
#pragma unroll
        for (int i = 0; i < 16; ++i) s[r] += v[r][i]; }
#pragma unroll
    for (int o = 1; o < 64; o <<= 1)
#pragma unroll
        for (int r = 0; r < R; ++r) s[r] += __shfl_xor(s[r], o);
#pragma unroll
    for (int r = 0; r < R; ++r) { const float mean = s[r] * (1.0f / DM); s2[r] = 0.f;
#pragma unroll
        for (int i = 0; i < 16; ++i) { v[r][i] -= mean; s2[r] += v[r][i] * v[r][i]; } }
#pragma unroll
    for (int o = 1; o < 64; o <<= 1)
#pragma unroll
        for (int r = 0; r < R; ++r) s2[r] += __shfl_xor(s2[r], o);
#pragma unroll
    for (int j = 0; j < 2; ++j) { const int c = 8 * lane + 512 * j;
        const f32x4 g0 = *(const f32x4*)(g + c), g1 = *(const f32x4*)(g + c + 4), b0 = *(const f32x4*)(b + c), b1 = *(const f32x4*)(b + c + 4);
#pragma unroll
        for (int r = 0; r < R; ++r) { const float rstd = 1.0f / sqrtf(s2[r] * (1.0f / DM) + LN_EPS); f32x4 y0, y1;
#pragma unroll
            for (int q = 0; q < 4; ++q) { y0[q] = v[r][8 * j + q] * rstd * g0[q] + b0[q]; y1[q] = v[r][8 * j + 4 + q] * rstd * g1[q] + b1[q]; }
            *(f32x4*)(of[r] + c) = y0; *(f32x4*)(of[r] + c + 4) = y1;
            if constexpr (F8OUT) { int t0 = 0, t1 = 0; t0 = __builtin_amdgcn_cvt_pk_fp8_f32(y0[0], y0[1], t0, false); t0 = __builtin_amdgcn_cvt_pk_fp8_f32(y0[2], y0[3], t0, true); t1 = __builtin_amdgcn_cvt_pk_fp8_f32(y1[0], y1[1], t1, false); t1 = __builtin_amdgcn_cvt_pk_fp8_f32(y1[2], y1[3], t1, true);
                *(v2u*)((unsigned char*)ob[r] + c) = (v2u){(unsigned)t0, (unsigned)t1}; }
            else { v4u w; w.x = cvt_pk_bf16(y0[0], y0[1]); w.y = cvt_pk_bf16(y0[2], y0[3]); w.z = cvt_pk_bf16(y1[0], y1[1]); w.w = cvt_pk_bf16(y1[2], y1[3]);
                *(v4u*)(ob[r] + c) = w; } } }
}

__device__ __forceinline__ void phase_lnr(const Args& a, int layer, LAS unsigned char* lds, int vcu, int G, bool dry) {
    const int tid = threadIdx.x, lane = tid & 63, wave = __builtin_amdgcn_readfirstlane(tid >> 6);
    const float* xin = a.out; float* xf = dry ? (float*)(a.ws + WS_Y) : a.out; bf16* xb = dry ? (bf16*)(a.ws + WS_Y + 72 * MiB) : (bf16*)(a.ws + WS_XB);
    const float* lng = a.in[I_LNMG] + layer * DM; const float* lnb = a.in[I_LNMB] + layer * DM;
    const float* Wr = a.in[I_WR] + (size_t)layer * DM * NE; const float* rbias = a.in[I_RB] + layer * NE;
    unsigned* gcount = (unsigned*)(a.ws + WS_CTL) + CW_CNT + layer * 64 + (dry ? 128 : 0);
    unsigned* rowtok = dry ? (unsigned*)(a.ws + WS_Y + 64 * MiB) : (unsigned*)(a.ws + WS_ROWTOK); unsigned* dest = dry ? (unsigned*)(a.ws + WS_Y + 68 * MiB) : (unsigned*)(a.ws + WS_DEST); float* gatev = dry ? (float*)(a.ws + WS_Y + 69 * MiB) : (float*)(a.ws + WS_GATE);
    LAS float* part = (LAS float*)lds;
    LAS float* mb = (LAS float*)(lds + 32768);
    LAS float* gs = (LAS float*)(lds + 49152);
    LAS unsigned* hist = (LAS unsigned*)(lds + 51200);
    LAS unsigned* basep = (LAS unsigned*)(lds + 51456);
    { const int blk = vcu;
        const int row0 = blk * 64;
        if (tid < 64) hist[tid] = 0u;
#pragma unroll 1
        for (int h4 = 0; h4 < 2; ++h4) { float v[4][16]; float* of[4]; bf16* ob[4];
#pragma unroll
            for (int r = 0; r < 4; ++r) { const int rr = wave * 8 + h4 * 4 + r; const float* xr = xin + (size_t)(row0 + rr) * DM; of[r] = xf + (size_t)(row0 + rr) * DM; ob[r] = (bf16*)((unsigned char*)xb + (size_t)(row0 + rr) * DM);
#pragma unroll
                for (int j = 0; j < 2; ++j) { const f32x4 p = *(const f32x4*)(xr + 8 * lane + 512 * j), q = *(const f32x4*)(xr + 8 * lane + 512 * j + 4);
#pragma unroll
                    for (int i = 0; i < 4; ++i) { v[r][8 * j + i] = p[i]; v[r][8 * j + 4 + i] = q[i]; } } }
            ln_rows_store<4, true>(v, lng, lnb, of, ob, lane); }
        VM_WAIT(); __syncthreads();
#ifndef DRY_PARTS
#define DRY_PARTS 7
#endif
        if (!dry || (DRY_PARTS & 2)) { const int mt = wave & 3, kh = wave >> 2, r = lane & 15, g = lane >> 4;
          f32x4 acc[4];
#pragma unroll
          for (int n = 0; n < 4; ++n) acc[n] = (f32x4){0.f, 0.f, 0.f, 0.f};
          const float* arow = xf + (size_t)(row0 + 16 * mt + r) * DM + kh * 512 + 8 * g;
          const bf16* bh = (const bf16*)(a.ws + WS_WRT) + (size_t)layer * 2 * 65536 + (size_t)r * 1024 + kh * 512 + 8 * g; const bf16* bl = bh + 65536;
          f32x4 a0 = *(const f32x4*)arow, a1 = *(const f32x4*)(arow + 4); bf16x8 wh[4], wl[4];
#pragma unroll
          for (int n = 0; n < 4; ++n) { wh[n] = *(const bf16x8*)(bh + (size_t)n * 16384); wl[n] = *(const bf16x8*)(bl + (size_t)n * 16384); }
#pragma unroll 1
          for (int s = 0; s < 16; ++s) { const int sn = s < 15 ? s + 1 : s;
              const f32x4 n0 = *(const f32x4*)(arow + 32 * sn), n1 = *(const f32x4*)(arow + 32 * sn + 4); bf16x8 nh[4], nl[4];
#pragma unroll
              for (int n = 0; n < 4; ++n) { nh[n] = *(const bf16x8*)(bh + (size_t)n * 16384 + 32 * sn); nl[n] = *(const bf16x8*)(bl + (size_t)n * 16384 + 32 * sn); }
              v4u hi, lo; hi.x = cvt_pk_bf16(a0[0], a0[1]); hi.y = cvt_pk_bf16(a0[2], a0[3]); hi.z = cvt_pk_bf16(a1[0], a1[1]); hi.w = cvt_pk_bf16(a1[2], a1[3]);
              lo.x = cvt_pk_bf16(a0[0] - bf_lo(hi.x), a0[1] - bf_hi(hi.x)); lo.y = cvt_pk_bf16(a0[2] - bf_lo(hi.y), a0[3] - bf_hi(hi.y));
              lo.z = cvt_pk_bf16(a1[0] - bf_lo(hi.z), a1[1] - bf_hi(hi.z)); lo.w = cvt_pk_bf16(a1[2] - bf_lo(hi.w), a1[3] - bf_hi(hi.w));
              const bf16x8 ah = __builtin_bit_cast(bf16x8, hi), al = __builtin_bit_cast(bf16x8, lo);
#pragma unroll
              for (int n = 0; n < 4; ++n) { acc[n] = __builtin_amdgcn_mfma_f32_16x16x32_bf16(ah, wh[n], acc[n], 0, 0, 0); acc[n] = __builtin_amdgcn_mfma_f32_16x16x32_bf16(al, wh[n], acc[n], 0, 0, 0); acc[n] = __builtin_amdgcn_mfma_f32_16x16x32_bf16(ah, wl[n], acc[n], 0, 0, 0); }
              a0 = n0; a1 = n1;
#pragma unroll
              for (int n = 0; n < 4; ++n) { wh[n] = nh[n]; wl[n] = nl[n]; } }
#pragma unroll
          for (int n = 0; n < 4; ++n)
#pragma unroll
              for (int q = 0; q < 4; ++q) part[(kh * 64 + 16 * mt + 4 * g + q) * 64 + 16 * n + r] = acc[n][q]; }
        __syncthreads();
        if (!dry || (DRY_PARTS & 4)) { const int row = tid >> 3, grp = tid & 7; float sc[8], bsd[8];
#pragma unroll
          for (int i = 0; i < 8; ++i) { const int e = 8 * grp + i; const float lg = part[row * 64 + e] + part[(64 + row) * 64 + e]; sc[i] = 1.0f / (1.0f + __expf(-lg)); bsd[i] = sc[i] + rbias[e]; }
          float m1 = -INFINITY, m2 = -INFINITY;
#pragma unroll
          for (int i = 0; i < 8; ++i) { const float v = bsd[i]; if (v > m1) { m2 = m1; m1 = v; } else if (v > m2) m2 = v; }
          const float myg = m1 + m2;
          int grank = 0;
#pragma unroll
          for (int d = 1; d < 8; ++d) { const float o = __shfl(myg, (lane & ~7) | ((grp + d) & 7)); const int g2 = (grp + d) & 7; grank += (o > myg || (o == myg && g2 < grp)) ? 1 : 0; }
          const bool gsel = grank < 4;
          float cand[8]; int rk[8]; bool sel[8];
#pragma unroll
          for (int i = 0; i < 8; ++i) { cand[i] = gsel ? bsd[i] : -INFINITY; rk[i] = 0; sel[i] = false; }
#pragma unroll 1
          for (int k = 0; k < TOPK; ++k) {
              float best = cand[0]; int bi = 0;
#pragma unroll
              for (int i = 1; i < 8; ++i) if (cand[i] > best) { best = cand[i]; bi = i; }
              int gi = 8 * grp + bi;
#pragma unroll
              for (int off = 1; off < 8; off <<= 1) { const float ov = __shfl_xor(best, off); const int oi = __shfl_xor(gi, off); if (ov > best || (ov == best && oi < gi)) { best = ov; gi = oi; } }
#pragma unroll
              for (int i = 0; i < 8; ++i) if (gi == 8 * grp + i) { cand[i] = -INFINITY; rk[i] = k; sel[i] = true; }
          }
          float psum = 0.f;
#pragma unroll
          for (int i = 0; i < 8; ++i) psum += sel[i] ? sc[i] : 0.f;
          psum += __shfl_xor(psum, 1); psum += __shfl_xor(psum, 2); psum += __shfl_xor(psum, 4);
          const float inv = ROUTED_SCALE / psum;
          unsigned loc[8];
#pragma unroll
          for (int i = 0; i < 8; ++i) { loc[i] = 0u; if (sel[i]) loc[i] = __hip_atomic_fetch_add(hist + 8 * grp + i, 1u, __ATOMIC_RELAXED, __HIP_MEMORY_SCOPE_WORKGROUP); }
          __syncthreads();
          if (tid < 64) { const unsigned h = hist[tid]; basep[tid] = h ? __hip_atomic_fetch_add(gcount + tid, h, RLX_AGENT) : 0u; }
          __syncthreads();
          const int tok = row0 + row;
#pragma unroll
          for (int i = 0; i < 8; ++i) if (sel[i]) { const int e = 8 * grp + i; const unsigned pos = basep[e] + loc[i];
              rowtok[(size_t)e * CAP + pos] = (unsigned)tok; dest[tok * 8 + rk[i]] = ((unsigned)e << 16) | pos; gatev[tok * 8 + rk[i]] = sc[i] * inv; }
        }
        __syncthreads();
    }
}

__device__ __forceinline__ pg8::MoeInfo moe_setup(const Args& a, int layer, LAS unsigned char* misc) {
    const int tid = threadIdx.x;
    unsigned* gcount = (unsigned*)(a.ws + WS_CTL) + CW_CNT + layer * 64;
    LAS unsigned* cnt = (LAS unsigned*)(misc + MI_CNT); LAS unsigned* tstart = (LAS unsigned*)(misc + MI_TSTART); LAS unsigned* ystart = (LAS unsigned*)(misc + MI_YSTART);
    LAS unsigned* ntl = (LAS unsigned*)(misc + MI_NTILES); LAS unsigned char* tile_e = (LAS unsigned char*)(misc + MI_TILE_E);
    __syncthreads();
    if (tid < 64) { unsigned c = __hip_atomic_load(gcount + tid, RLX_AGENT); if (c > (unsigned)CAP) c = CAP; cnt[tid] = c; }
    __syncthreads();
    if (tid < 64) { unsigned ts = 64u, ys = 0u; for (int e = 0; e < tid; ++e) { const unsigned c = cnt[e]; ts += (c + 255u) >> 8; ys += c; }
        tstart[tid] = ts; ystart[tid] = ys; const unsigned mynt = (cnt[tid] + 255u) >> 8;
        for (unsigned i = 0; i < mynt; ++i) if (ts + i < 640u) tile_e[ts + i] = (unsigned char)tid;
        if (tid == 63) ntl[0] = ts + mynt; }
    __syncthreads();
    pg8::MoeInfo mi; mi.cnt = cnt; mi.tstart = tstart; mi.ystart = ystart; mi.tile_e = tile_e; mi.ntiles = __builtin_amdgcn_readfirstlane((int)ntl[0]);
    if (mi.ntiles > 640) mi.ntiles = 640;
    return mi;
}

__device__ __forceinline__ void phase_combine(const Args& a, int layer, LAS unsigned char* misc, int vcu, int G, bool dry) {
    const int tid = threadIdx.x, lane = tid & 63, wave = __builtin_amdgcn_readfirstlane(tid >> 6);
    const pg8::MoeInfo mi = moe_setup(a, layer, misc);
    float* xf = a.out; bf16* xb = (bf16*)(a.ws + WS_XB); const unsigned char* Y8 = (const unsigned char*)(a.ws + WS_Y);
    const unsigned* dest = (const unsigned*)(a.ws + WS_DEST); const float* gatev = (const float*)(a.ws + WS_GATE);
    const float* lng = a.in[I_LNFG] + layer * DM; const float* lnb = a.in[I_LNFB] + layer * DM;
    const int gw = vcu * NWAVES + wave, NGW = G * NWAVES;
#pragma unroll 1
    for (int rowa = gw; rowa < T_TOK; rowa += 2 * NGW) {
        float v[2][16]; float* of[2]; bf16* ob[2]; unsigned d[2][TOPK]; float gk[2][TOPK];
#pragma unroll
        for (int r = 0; r < 2; ++r) { const int row = rowa + r * NGW;
#pragma unroll
            for (int k = 0; k < TOPK; ++k) { d[r][k] = dest[row * 8 + k]; gk[r][k] = gatev[row * 8 + k]; } }
#pragma unroll
        for (int r = 0; r < 2; ++r) { const int row = rowa + r * NGW; float* xr = xf + (size_t)row * DM; of[r] = dry ? (float*)(a.ws + WS_H) + (size_t)row * DM : xr; ob[r] = xb + (size_t)row * DM;
#pragma unroll
            for (int j = 0; j < 2; ++j) { const f32x4 p = *(const f32x4*)(xr + 8 * lane + 512 * j), q = *(const f32x4*)(xr + 8 * lane + 512 * j + 4);
#pragma unroll
                for (int i = 0; i < 4; ++i) { v[r][8 * j + i] = p[i] * ALPHA; v[r][8 * j + 4 + i] = q[i] * ALPHA; } } }
#pragma unroll
        for (int r = 0; r < 2; ++r) { const unsigned char* yr = Y8 + (size_t)(131072 + rowa + r * NGW) * DM;
#pragma unroll
            for (int j = 0; j < 2; ++j) { const v2u w = *(const v2u*)(yr + 8 * lane + 512 * j);
#pragma unroll
                for (int q = 0; q < 2; ++q) { const f32x2 lo2 = __builtin_amdgcn_cvt_pk_f32_fp8((int)w[q], false), hi2 = __builtin_amdgcn_cvt_pk_f32_fp8((int)w[q], true);
                    v[r][8 * j + 4 * q] += 0.0625f * lo2.x; v[r][8 * j + 4 * q + 1] += 0.0625f * lo2.y; v[r][8 * j + 4 * q + 2] += 0.0625f * hi2.x; v[r][8 * j + 4 * q + 3] += 0.0625f * hi2.y; } } }
#pragma unroll
        for (int r = 0; r < 2; ++r)
#pragma unroll
            for (int k = 0; k < TOPK; ++k) { const unsigned dd = (unsigned)__builtin_amdgcn_readfirstlane((int)d[r][k]); const float g = __uint_as_float((unsigned)__builtin_amdgcn_readfirstlane((int)__float_as_uint(gk[r][k])));
                const unsigned e = (dd >> 16) & 63u, pos = dd & 0xffffu; const unsigned char* yr = Y8 + (size_t)(mi.ystart[e] + pos) * DM; const float g16 = g * 0.0625f;
#pragma unroll
                for (int j = 0; j < 2; ++j) { const v2u w = *(const v2u*)(yr + 8 * lane + 512 * j);
#pragma unroll
                    for (int q = 0; q < 2; ++q) { const f32x2 lo2 = __builtin_amdgcn_cvt_pk_f32_fp8((int)w[q], false), hi2 = __builtin_amdgcn_cvt_pk_f32_fp8((int)w[q], true);
                        v[r][8 * j + 4 * q] += g16 * lo2.x; v[r][8 * j + 4 * q + 1] += g16 * lo2.y; v[r][8 * j + 4 * q + 2] += g16 * hi2.x; v[r][8 * j + 4 * q + 3] += g16 * hi2.y; } } }
        ln_rows_store<2>(v, lng, lnb, of, ob, lane);
    }
}

__device__ __forceinline__ int swz16(int row) { return (row ^ (row >> 4)) & 15; }
__device__ __forceinline__ void phase_sgu_spatial(const Args& a, LAS unsigned char* lds, int vcu, int G) {
    const int tid = threadIdx.x, lane = tid & 63, wave = __builtin_amdgcn_readfirstlane(tid >> 6), fr = lane & 15, fq = lane >> 4;
    const bf16* HS = (const bf16*)(a.ws + WS_HS); bf16* GT = (bf16*)(a.ws + WS_GATED);
    const float* lng = a.in[I_SLNG]; const float* lnb = a.in[I_SLNB]; const float* WS = a.in[I_SWS]; const float* BS = a.in[I_SBS];
    LAS unsigned char* Bs = lds;
    LAS unsigned char* As = lds + 65536;
    LAS float* stm = (LAS float*)(lds + 98304);
    LAS float* str = (LAS float*)(lds + 98304 + 512);
    for (int item = vcu; item < 512; item += G) {
        const int chunk = item >> 2, h = item & 3, t0 = chunk * 128;
        __syncthreads();
#pragma unroll 1
        for (int r4 = 0; r4 < 4; ++r4) { v4u w[4][4];
#pragma unroll
            for (int rr = 0; rr < 4; ++rr) { const bf16* vr = HS + (size_t)(t0 + wave * 16 + r4 * 4 + rr) * 4096 + SGU_W;
#pragma unroll
                for (int q = 0; q < 4; ++q) w[rr][q] = *(const v4u*)(vr + 8 * lane + 512 * q); }
            float sm[4], sq[4];
#pragma unroll
            for (int rr = 0; rr < 4; ++rr) { float s1 = 0.f;
#pragma unroll
                for (int q = 0; q < 4; ++q)
#pragma unroll
                    for (int p = 0; p < 4; ++p) s1 += bf_lo(w[rr][q][p]) + bf_hi(w[rr][q][p]);
                sm[rr] = s1; }
#pragma unroll
            for (int o = 1; o < 64; o <<= 1)
#pragma unroll
                for (int rr = 0; rr < 4; ++rr) sm[rr] += __shfl_xor(sm[rr], o);
#pragma unroll
            for (int rr = 0; rr < 4; ++rr) { const float mean = sm[rr] * (1.0f / SGU_W); float s2 = 0.f;
#pragma unroll
                for (int q = 0; q < 4; ++q)
#pragma unroll
                    for (int p = 0; p < 4; ++p) { const float d0 = bf_lo(w[rr][q][p]) - mean, d1 = bf_hi(w[rr][q][p]) - mean; s2 += d0 * d0 + d1 * d1; }
                sm[rr] = mean; sq[rr] = s2; }
#pragma unroll
            for (int o = 1; o < 64; o <<= 1)
#pragma unroll
                for (int rr = 0; rr < 4; ++rr) sq[rr] += __shfl_xor(sq[rr], o);
            if (lane == 0) {
#pragma unroll
                for (int rr = 0; rr < 4; ++rr) { const int j = wave * 16 + r4 * 4 + rr; stm[j] = sm[rr]; str[j] = 1.0f / sqrtf(sq[rr] * (1.0f / SGU_W) + LN_EPS); } } }
        for (int q = tid; q < 128 * 16; q += NTHR) { const int i = q >> 4, jc = q & 15; const float* wp = WS + ((size_t)h * 128 + i) * 128 + 8 * jc;
            const f32x4 p0 = *(const f32x4*)wp, p1 = *(const f32x4*)(wp + 4); float w8[8];
#pragma unroll
            for (int z = 0; z < 4; ++z) { w8[z] = (8 * jc + z <= i) ? p0[z] : 0.f; w8[4 + z] = (8 * jc + 4 + z <= i) ? p1[z] : 0.f; }
            v4u o; o.x = cvt_pk_bf16(w8[0], w8[1]); o.y = cvt_pk_bf16(w8[2], w8[3]); o.z = cvt_pk_bf16(w8[4], w8[5]); o.w = cvt_pk_bf16(w8[6], w8[7]);
            *(LAS v4u*)(As + i * 256 + ((jc ^ swz16(i)) << 4)) = o; }
        __syncthreads();
        for (int hh = 0; hh < 2; ++hh) {
            const int cb = h * SGU_HD + hh * 256;
#pragma unroll 2
            for (int q = tid; q < 64 * 32; q += NTHR) { const int c8 = q & 31, jp = q >> 5, j0 = 2 * jp;
                const v4u w0 = *(const v4u*)(HS + (size_t)(t0 + j0) * 4096 + SGU_W + cb + 8 * c8), w1 = *(const v4u*)(HS + (size_t)(t0 + j0 + 1) * 4096 + SGU_W + cb + 8 * c8);
                const f32x4 g0 = *(const f32x4*)(lng + cb + 8 * c8), g1 = *(const f32x4*)(lng + cb + 8 * c8 + 4), b0 = *(const f32x4*)(lnb + cb + 8 * c8), b1 = *(const f32x4*)(lnb + cb + 8 * c8 + 4);
                const float m0 = stm[j0], r0 = str[j0], m1 = stm[j0 + 1], r1 = str[j0 + 1];
#pragma unroll
                for (int z = 0; z < 8; ++z) { const float gz = z < 4 ? g0[z & 3] : g1[z & 3], bz = z < 4 ? b0[z & 3] : b1[z & 3];
                    const float xa = (z & 1) ? bf_hi(w0[z >> 1]) : bf_lo(w0[z >> 1]), xc = (z & 1) ? bf_hi(w1[z >> 1]) : bf_lo(w1[z >> 1]);
                    const float ya = (xa - m0) * r0 * gz + bz, yc = (xc - m1) * r1 * gz + bz;
                    const int cc = 8 * c8 + z, slot = (cc & ~31) | (((cc >> 2) & 1) << 4) | (((cc >> 3) & 3) << 2) | (cc & 3);
                    *(LAS unsigned*)(Bs + slot * 256 + (((j0 >> 3) ^ swz16(slot)) << 4) + (j0 & 7) * 2) = cvt_pk_bf16(ya, yc); } }
            __syncthreads();
            f32x4 acc[8][2]; bf16x8 Bf[2][4];
#pragma unroll
            for (int n = 0; n < 2; ++n)
#pragma unroll
                for (int s = 0; s < 4; ++s) { const int slot = 32 * wave + 16 * n + fr; Bf[n][s] = *(const LAS bf16x8*)(Bs + slot * 256 + (((4 * s + fq) ^ swz16(slot)) << 4)); }
#pragma unroll
            for (int m = 0; m < 8; ++m) { acc[m][0] = (f32x4){0.f, 0.f, 0.f, 0.f}; acc[m][1] = (f32x4){0.f, 0.f, 0.f, 0.f};
#pragma unroll
                for (int s = 0; s < 4; ++s) if (s <= (m >> 1)) { const int i = 16 * m + fr; const bf16x8 af = *(const LAS bf16x8*)(As + i * 256 + (((4 * s + fq) ^ swz16(i)) << 4));
                    acc[m][0] = __builtin_amdgcn_mfma_f32_16x16x32_bf16(Bf[0][s], af, acc[m][0], 0, 0, 0); acc[m][1] = __builtin_amdgcn_mfma_f32_16x16x32_bf16(Bf[1][s], af, acc[m][1], 0, 0, 0); } }
#pragma unroll
            for (int m = 0; m < 8; ++m) { const int i = 16 * m + fr; const float bsv = BS[h * 128 + i]; const size_t t = (size_t)(t0 + i);
                const v4u uw = *(const v4u*)(HS + t * 4096 + cb + 32 * wave + 8 * fq); float o[8];
#pragma unroll
                for (int n = 0; n < 2; ++n)
#pragma unroll
                    for (int z = 0; z < 4; ++z) { const int c = 4 * n + z; const float uu = (c & 1) ? bf_hi(uw[c >> 1]) : bf_lo(uw[c >> 1]); o[c] = uu * (acc[m][n][z] + bsv); }
                v4u w; w.x = cvt_pk_bf16(o[0], o[1]); w.y = cvt_pk_bf16(o[2], o[3]); w.z = cvt_pk_bf16(o[4], o[5]); w.w = cvt_pk_bf16(o[6], o[7]);
                *(v4u*)(GT + t * SGU_W + cb + 32 * wave + 8 * fq) = w; }
            __syncthreads();
        }
    }
}

__device__ __forceinline__ void phase_flush(const Args& a, int vcu, int G) {
    const size_t gt = (size_t)vcu * NTHR + threadIdx.x, NT = (size_t)G * NTHR; f32x4 acc = (f32x4){0.f, 0.f, 0.f, 0.f};
    const f32x4* p0 = (const f32x4*)a.in[I_WG]; const f32x4* p1 = (const f32x4*)a.in[I_WU];
    for (size_t i = gt; i < (size_t)33554432 / 4; i += 4 * NT) { const f32x4 x0 = p0[i], x1 = p0[i + NT], x2 = p0[i + 2 * NT], x3 = p0[i + 3 * NT], y0 = p1[i], y1 = p1[i + NT], y2 = p1[i + 2 * NT], y3 = p1[i + 3 * NT]; acc += x0 + x1 + x2 + x3 + y0 + y1 + y2 + y3; }
    if (acc[0] + acc[1] + acc[2] + acc[3] == 1.2345e-30f) ((float*)(a.ws + WS_CTL))[16000] = acc[0];
}
constexpr int N_PHASES = 16;
__global__ void __launch_bounds__(NTHR, 2) mk_fwd(Args args) {
    extern __shared__ __attribute__((aligned(16))) unsigned char lds_raw[];
    LAS unsigned char* lds = (LAS unsigned char*)lds_raw;
    LAS unsigned char* misc = lds + MISC_OFF;
    const int tid = threadIdx.x;
    const int G = gridDim.x; const int bx = blockIdx.x; const int vcu = (G % 8 == 0) ? (bx % 8) * (G / 8) + bx / 8 : bx;
    unsigned char* ws = args.ws;
    unsigned* ctl = (unsigned*)(ws + WS_CTL);
    if (tid < 16) ((LAS unsigned*)(misc + MI_BARW))[tid] = 0u;
    __syncthreads();
    const int lo = args.ph_lo, hi = args.ph_hi;
    XcdBarrier bar; bar.bar = ctl + CW_BAR; bar.x = 0; bar.st = nullptr;
    if (hi - lo > 1) bar = xcd_barrier_post(ctl + CW_BAR, (volatile LAS unsigned*)(misc + MI_BARW));
#ifndef PH_MASK
#define PH_MASK 0xFFFF
#endif
#define IN(k) (((PH_MASK >> (k)) & 1) && lo <= (k) && (k) < hi)
#ifndef TS_A0
#define TS_A0 -1
#define TS_A1 -1
#define TS_M 1
#endif
    unsigned long long* tsbuf = (unsigned long long*)(ws + 32768);
#define TS_REC(k) do { if (TS_A0 >= 0 && bx == 0 && tid == 0) __hip_atomic_store(tsbuf + (k), (unsigned long long)__builtin_amdgcn_s_memrealtime(), RLX_AGENT); } while (0)
    TS_REC(0);
#ifndef REP_PH
#define REP_PH -1
#define REP_N 1
#endif
#define NREP(k) ((k) == REP_PH ? REP_N : 1)
#ifndef FLUSH_PH
#define FLUSH_PH -2
#endif
#define RUN(k) if (IN(k)) for (int rep = 0; rep < NREP(k); ++rep) if ((((k) == FLUSH_PH && rep == NREP(k) - 1) ? (xcd_barrier(bar), phase_flush(args, vcu, G), xcd_barrier(bar), true) : true))
#define DRY(k) (rep + 1 < NREP(k))
#define BG_LAYER(k) (-1)
#define SEAM(k) do { if (IN(k) && IN((k) + 1)) xcd_barrier(bar, &args, BG_LAYER(k), lds); TS_REC((k) + 1); } while (0)
    using namespace pg8;
    RUN(0) { phase_p0(args, lds, vcu, G); } SEAM(0);
    RUN(1) { DenseSched S{(const char*)(ws + WS_XB), (const char*)(ws + WS_WIN), 2048u, 2048u, 0u, 64, 4, 256, G, bx};
        EpiBf16<0, false, false> E{(bf16*)(ws + WS_Z), DM, nullptr, nullptr};
        gemm_phase<EpiBf16<0, false, false>, DenseSched, false, true, true>(lds, 2048u, 2048u, 16, S, E); } SEAM(1);
    RUN(2) { phase_pool(args, vcu, G); } SEAM(2);
    if (REP_PH == 100 && hi - lo > 1) for (int i = 0; i < REP_N; ++i) xcd_barrier(bar);
    RUN(3) { DenseSched S{(const char*)(ws + WS_POOLED), (const char*)(ws + WS_WGRP), 2048u, 512u, 512u, 64, 4, 256, G, bx};
        EpiBf16<0, false, true> E{(bf16*)(ws + WS_YP), DM, nullptr, args.in[I_PSCALE]};
        gemm_phase<EpiBf16<0, false, true>, DenseSched, false, true, true>(lds, 2048u, 512u, 4, S, E); } SEAM(3);
    RUN(4) { DenseSched S{(const char*)(ws + WS_YP), (const char*)(ws + WS_WOUT), 2048u, 2048u, 0u, 64, 4, 256, G, bx};
        EpiResid E{args.in[I_X], args.out};
        gemm_phase<EpiResid, DenseSched, false, true, true>(lds, 2048u, 2048u, 16, S, E); } SEAM(4);
#define MOE_PHASES(layer, pb) do { \
        RUN(pb) { phase_lnr(args, layer, lds, vcu, G, DRY(pb)); } SEAM(pb); \
        RUN((pb) + 1) { const MoeInfo mi = moe_setup(args, layer, misc); \
            G1Sched S{mi, (const char*)(ws + WS_XB), (const char*)(ws + WS_WGU + (size_t)layer * WS_MOE_LSTRIDE), (const unsigned*)(ws + WS_ROWTOK), (const unsigned*)(ws + WS_IDENT), G, vcu}; \
            EpiSwiglu E{(bf16*)(ws + WS_H)}; \
            gemm_phase<EpiSwiglu, G1Sched, true, true, false, 0, 1>(lds, 1024u, 1024u, 8, S, E); } SEAM((pb) + 1); \
        if (IN((pb) + 2) && REP_PH == (pb) + 2) { const MoeInfo mi = moe_setup(args, layer, misc); \
            G2Sched S{mi, (const char*)(ws + WS_H), (const char*)(ws + WS_WDN + (size_t)layer * WS_MOE_LSTRIDE), G, vcu, 256}; \
            EpiDown E{(unsigned char*)(ws + WS_Y)}; \
            gemm_phase<EpiDown, G2Sched, false, true, true, 1>(lds, 512u, 512u, 4, S, E); } \
        if (IN((pb) + 2)) { const MoeInfo mi = moe_setup(args, layer, misc); \
            G2Sched S{mi, (const char*)(ws + WS_H), (const char*)(ws + WS_WDN + (size_t)layer * WS_MOE_LSTRIDE), G, vcu, 0}; \
            EpiDown E{(unsigned char*)(ws + WS_Y)}; \
            gemm_phase<EpiDown, G2Sched, false, true, true, 1>(lds, 512u, 512u, 4, S, E); } SEAM((pb) + 2); \
        RUN((pb) + 3) { phase_combine(args, layer, misc, vcu, G, DRY((pb) + 3)); if (layer == 0 && !DRY((pb) + 3)) { __syncthreads(); convert_static(args, 1, lds, vcu, G); } } \
    } while (0)
    MOE_PHASES(0, 5); SEAM(8);
    RUN(9) { DenseSched S{(const char*)(ws + WS_XB), (const char*)(ws + WS_WSIN), 2048u, 2048u, 0u, 64, 16, 1024, G, bx};
        EpiBf16<1, true, false> E{(bf16*)(ws + WS_HS), 4096, args.in[I_SBIN], nullptr};
        gemm_phase<EpiBf16<1, true, false>, DenseSched, false, true, true>(lds, 2048u, 2048u, 16, S, E); } SEAM(9);
    RUN(10) { phase_sgu_spatial(args, lds, vcu, G); } SEAM(10);
    RUN(11) { DenseSched S{(const char*)(ws + WS_GATED), (const char*)(ws + WS_WSOUT), 4096u, 4096u, 0u, 64, 4, 256, G, bx};
        EpiResid E{args.out, DRY(11) ? (float*)(ws + WS_HS) : args.out};
        gemm_phase<EpiResid, DenseSched, false, true, true>(lds, 4096u, 4096u, 32, S, E); } SEAM(11);
    MOE_PHASES(1, 12);
#undef MOE_PHASES
    if (TS_A0 >= 0 && bx == 0 && tid == 0) {
        const unsigned long long tend = __builtin_amdgcn_s_memrealtime();
        const unsigned long long t0 = __hip_atomic_load(tsbuf + TS_A0, RLX_AGENT), t1 = (TS_A1 + 1 >= N_PHASES) ? tend : __hip_atomic_load(tsbuf + TS_A1 + 1, RLX_AGENT);
        const unsigned long long wait = (t1 - t0) * TS_M;
        while (__builtin_amdgcn_s_memrealtime() - tend < wait) __builtin_amdgcn_s_sleep(8);
    }
#undef IN
#undef SEAM
}

extern "C" void kernel_launch(void* const* d_in, const int* in_sizes, int n_in, void* d_out, int out_size, void* d_ws, size_t ws_size, hipStream_t stream) {
    static int grid = 0;
    if (grid == 0) {
        if (n_in != 24 || out_size != T_TOK * DM || ws_size < WS_END) { fprintf(stderr, "kernel_launch: unexpected shapes (n_in %d out %d ws %zu)\n", n_in, out_size, ws_size); grid = -1; return; }
        int dev = 0, cus = 0;
        if (hipGetDevice(&dev) != hipSuccess || hipDeviceGetAttribute(&cus, hipDeviceAttributeMultiprocessorCount, dev) != hipSuccess) { grid = -1; return; }
        if (hipFuncSetAttribute((const void*)mk_fwd, hipFuncAttributeMaxDynamicSharedMemorySize, LDS_BYTES) != hipSuccess) { fprintf(stderr, "kernel_launch: hipFuncSetAttribute failed\n"); grid = -1; return; }
        int per_cu = 0;
        if (hipOccupancyMaxActiveBlocksPerMultiprocessor(&per_cu, (const void*)mk_fwd, NTHR, LDS_BYTES) != hipSuccess || per_cu < 1) fprintf(stderr, "kernel_launch: occupancy query says %d\n", per_cu);
        (void)hipGetLastError();
        grid = cus;
        if (grid != 256) { fprintf(stderr, "kernel_launch: built for a 256-CU device (got %d)\n", cus); grid = -1; return; }
    }
    if (grid < 0) return;
    (void)hipMemsetAsync((char*)d_ws + WS_CTL, 0, CTL_ZERO_BYTES, stream);
    Args a{};
    for (int i = 0; i < 24; ++i) a.in[i] = (const float*)d_in[i];
    a.out = (float*)d_out; a.ws = (unsigned char*)d_ws;
#if MK_PER_PHASE
    for (int p = 0; p < N_PHASES; ++p) { a.ph_lo = p; a.ph_hi = p + 1; hipLaunchKernelGGL(mk_fwd, dim3(grid), dim3(NTHR), LDS_BYTES, stream, a); }
#else
    a.ph_lo = 0; a.ph_hi = N_PHASES; hipLaunchKernelGGL(mk_fwd, dim3(grid), dim3(NTHR), LDS_BYTES, stream, a);
#endif
}
```

```cpp
#include <hip/hip_runtime.h>
#include <cstdio>
#include <cstdint>

#ifndef MK_PER_PHASE
#define MK_PER_PHASE 0
#endif

#define GAS __attribute__((address_space(1)))
#define LAS __attribute__((address_space(3)))
typedef unsigned short bf16;
typedef unsigned v4u __attribute__((ext_vector_type(4)));
typedef unsigned v2u __attribute__((ext_vector_type(2)));
typedef float f32x4 __attribute__((ext_vector_type(4)));
typedef float f32x2 __attribute__((ext_vector_type(2)));
typedef short bf16x8 __attribute__((ext_vector_type(8)));
#define RLX_AGENT __ATOMIC_RELAXED, __HIP_MEMORY_SCOPE_AGENT
#define LDS_WAIT() asm volatile("s_waitcnt lgkmcnt(0)" ::: "memory")
#define VM_WAIT() asm volatile("s_waitcnt vmcnt(0)" ::: "memory")

constexpr int T_TOK = 16384, DM = 1024, SEQ = 4096, NE = 64, TOPK = 8, EDIM = 256;
constexpr int SGU_W = 2048, SGU_HD = 512;
constexpr float ALPHA = 1.41421356237309515f;
constexpr float LN_EPS = 1e-5f, ROUTED_SCALE = 2.5f;
constexpr int CAP = 16384;
constexpr int NWAVES = 8, NTHR = 512;

constexpr size_t MiB = 1u << 20;
constexpr size_t WS_CTL = 0, CTL_ZERO_BYTES = 65536;
constexpr size_t WS_IDENT = 256 * 1024;
constexpr size_t WS_DEST = 1 * MiB;
constexpr size_t WS_GATE = WS_DEST + 512 * 1024;
constexpr size_t WS_ROWTOK = 2 * MiB;
constexpr size_t WS_WIN = 6 * MiB;
constexpr size_t WS_WGRP = 8 * MiB;
constexpr size_t WS_WOUT = WS_WGRP + 512 * 1024;
constexpr size_t WS_WSIN = WS_WOUT + 2 * MiB;
constexpr size_t WS_WSOUT = WS_WSIN + 8 * MiB;
constexpr size_t WS_WRT = WS_WSOUT + 4 * MiB;
constexpr size_t WS_WGU = 23 * MiB;
constexpr size_t WS_WDN = WS_WGU + 65 * MiB;
constexpr size_t WS_XB = 121 * MiB;
constexpr size_t WS_H = 153 * MiB;
constexpr size_t WS_Y = 233 * MiB;
constexpr size_t WS_WGU1 = 378 * MiB, WS_WDN1 = WS_WGU1 + 65 * MiB;
constexpr size_t WS_MOE_LSTRIDE = WS_WGU1 - WS_WGU;
constexpr size_t WS_END = 476 * MiB;
constexpr size_t WS_Z = 153 * MiB, WS_POOLED = 185 * MiB, WS_YP = 217 * MiB;
constexpr size_t WS_HS = 153 * MiB;
constexpr size_t WS_GATED = 281 * MiB;
static_assert(WS_WRT + 512 * 1024 <= WS_WGU && WS_WDN + 33 * MiB <= WS_XB && WS_XB + 32 * MiB <= WS_H && WS_H + 80 * MiB <= WS_Y && WS_Y + 145 * MiB <= WS_WGU1 && WS_WDN1 + 33 * MiB <= WS_END && WS_GATED + 64 * MiB <= WS_WGU1, "ws map");
constexpr int CW_TMO = 0, CW_BAR = 64, CW_CNT = 4096, CW_QNEXT = 4608;

constexpr int RING_BYTES = 131072;
constexpr int MISC_OFF = RING_BYTES;
constexpr int LDS_BYTES = 147456;
constexpr int MI_BARW = 0, MI_CNT = 64, MI_TSTART = 320, MI_YSTART = 576, MI_NTILES = 832, MI_TILE_E = 1024;

__device__ __forceinline__ unsigned cvt_pk_bf16(float lo, float hi) { unsigned r; asm volatile("v_cvt_pk_bf16_f32 %0, %1, %2" : "=v"(r) : "v"(lo), "v"(hi)); return r; }
__device__ __forceinline__ float bf_lo(unsigned w) { return __uint_as_float(w << 16); }
__device__ __forceinline__ float bf_hi(unsigned w) { return __uint_as_float(w & 0xffff0000u); }
__device__ __forceinline__ float wave_sum(float v) {
#pragma unroll
    for (int o = 1; o < 64; o <<= 1) v += __shfl_xor(v, o);
    return v;
}
__device__ __forceinline__ float sigmoidf_(float x) { return __builtin_amdgcn_rcpf(1.0f + __builtin_amdgcn_exp2f(-1.4426950408889634f * x)); }
__device__ __forceinline__ float gelu_tanh(float v) { const float y = v + 0.044715f * v * v * v; return v * __builtin_amdgcn_rcpf(1.0f + __builtin_amdgcn_exp2f(-2.3022081983f * y)); }

#define XB_TMO      128
#define XB_XCNT(j)  (256  + 64 * (j))
#define XB_XSUB(j)  (1280 + 64 * (j))
#define XB_XGEN(j)  (2304 + 64 * (j))
#define XB_TOP      3328
#define XB_TOPGEN   3392
#define XCD_BAR_WORDS 3456
#define XB_SPIN_CAP (1u << 20)
__device__ __forceinline__ unsigned xb_ld(unsigned* p)              { return __hip_atomic_load(p, __ATOMIC_RELAXED, __HIP_MEMORY_SCOPE_AGENT); }
__device__ __forceinline__ unsigned xb_add(unsigned* p, unsigned v) { return __hip_atomic_fetch_add(p, v, __ATOMIC_RELAXED, __HIP_MEMORY_SCOPE_AGENT); }
__device__ __forceinline__ unsigned xb_xcc_id() { return (unsigned)__builtin_amdgcn_s_getreg((3 << 11) | 20) & 0xFu; }
#define XB_SPIN(cond, bar) do { unsigned _sp = 0; while (cond) { __builtin_amdgcn_s_sleep(1); \
    if ((++_sp & 255u) == 0u) { if (xb_ld(&(bar)[XB_TMO])) break; if (_sp > XB_SPIN_CAP) { atomicAdd(&(bar)[XB_TMO], 1u); break; } } } } while (0)
struct XcdBarrier { unsigned* bar; unsigned x; volatile LAS unsigned* st; };
__device__ __forceinline__ XcdBarrier xcd_barrier_post(unsigned* bar, volatile LAS unsigned* st) {
    XcdBarrier b; b.bar = bar; b.x = xb_xcc_id(); b.st = st;
    if (threadIdx.x == 0) (void)xb_add(&bar[XB_XCNT(b.x)], 1u);
    return b;
}
__device__ __forceinline__ void xcd_barrier_complete(unsigned* bar, unsigned x, unsigned& nloc, unsigned& nx) {
    const unsigned G = gridDim.x * gridDim.y * gridDim.z;
    unsigned sum, cnt, mine, sp = 0u;
    for (;;) {
        sum = 0u; cnt = 0u; mine = 0u;
#pragma unroll
        for (unsigned j = 0; j < 16; ++j) { const unsigned c = xb_ld(&bar[XB_XCNT(j)]); sum += c; cnt += (c > 0u) ? 1u : 0u; mine = (j == x) ? c : mine; }
        if (sum == G) break;
        __builtin_amdgcn_s_sleep(1);
        if ((++sp & 255u) == 0u) { if (xb_ld(&bar[XB_TMO])) break; if (sp > XB_SPIN_CAP) { atomicAdd(&bar[XB_TMO], 1u); break; } }
    }
    nloc = mine > 0u ? mine : 1u; nx = cnt > 0u ? cnt : 1u;
}
struct Args;
__device__ __forceinline__ bool convert_steal(const Args& a, int layer, LAS unsigned char* lds, int wave, int lane);
__device__ __forceinline__ void xcd_barrier(const XcdBarrier& b, const Args* bga = nullptr, int bg_layer = -1, LAS unsigned char* lds = nullptr) {
    asm volatile("s_waitcnt vmcnt(0)" ::: "memory");
    __syncthreads();
    if (threadIdx.x == 0) {
        unsigned* bar = b.bar;
        __builtin_amdgcn_s_waitcnt(0);
        unsigned nloc = b.st[0], nx = b.st[1];
        if (nloc == 0u) { xcd_barrier_complete(bar, b.x, nloc, nx); b.st[0] = nloc; b.st[1] = nx; }
        const unsigned old = xb_add(&bar[XB_XSUB(b.x)], 1u);
        const unsigned gen = old / nloc;
        if (old + 1u == (gen + 1u) * nloc) {
            __builtin_amdgcn_fence(__ATOMIC_RELEASE, "agent");
            asm volatile("s_waitcnt vmcnt(0)" ::: "memory");
            const unsigned og = xb_add(&bar[XB_TOP], 1u);
            const unsigned tg = og / nx;
            if (og + 1u == (tg + 1u) * nx) xb_add(&bar[XB_TOPGEN], 1u);
            else XB_SPIN(xb_ld(&bar[XB_TOPGEN]) == tg, bar);
            __builtin_amdgcn_fence(__ATOMIC_ACQUIRE, "agent");
            xb_add(&bar[XB_XGEN(b.x)], 1u);
            asm volatile("s_waitcnt vmcnt(0)" ::: "memory");
            b.st[2] = 0xFFFFFFFFu;
        } else if (bg_layer < 0) {
            XB_SPIN(xb_ld(&bar[XB_XGEN(b.x)]) == gen, bar);
            __builtin_amdgcn_fence(__ATOMIC_ACQUIRE, "agent");
            asm volatile("s_waitcnt vmcnt(0)" ::: "memory");
            b.st[2] = 0xFFFFFFFFu;
        } else b.st[2] = gen;
    }
    __syncthreads();
    if (bg_layer >= 0) {
        const unsigned gen = b.st[2];
        if (gen != 0xFFFFFFFFu) {
            const int lane = threadIdx.x & 63, wave = __builtin_amdgcn_readfirstlane(threadIdx.x >> 6);
            bool more = true;
            while (more && (unsigned)__builtin_amdgcn_readfirstlane((int)xb_ld(&b.bar[XB_XGEN(b.x)])) == gen) more = convert_steal(*bga, bg_layer, lds, wave, lane);
            asm volatile("s_waitcnt vmcnt(0)" ::: "memory");
            __syncthreads();
            if (threadIdx.x == 0) { XB_SPIN(xb_ld(&b.bar[XB_XGEN(b.x)]) == gen, b.bar); __builtin_amdgcn_fence(__ATOMIC_ACQUIRE, "agent"); asm volatile("s_waitcnt vmcnt(0)" ::: "memory"); }
        } else __syncthreads();
        __syncthreads();
    }
}

namespace pg8 {
constexpr int BM = 256, BK = 64, HALF = 128, HTB = HALF * BK * 2, STAGE_BYTES = 8 * HTB, NXCD = 8, WGM = 8;
__host__ __device__ __forceinline__ int lds_byte(int r, int c) { const int st = (r >> 4) * 2 + (c >> 5), rr = r & 15, cc = c & 31, ob = rr * 64 + cc * 2; return st * 1024 + (ob ^ (((ob >> 9) & 1) << 5)); }
__host__ __device__ __forceinline__ void stage_rc(int b, int& R, int& C) { const int st = b / 1024, sb = b % 1024, swz = sb ^ (((sb >> 9) & 1) << 5); R = (st >> 1) * 16 + swz / 64; C = (st & 1) * 32 + (swz % 64) / 2; }
__host__ __device__ __forceinline__ int perm32(int rho) { const int n = rho >> 4, i = rho & 15; return 8 * (i >> 2) + 4 * n + (i & 3); }

typedef int v8i __attribute__((ext_vector_type(8)));
typedef int v4i __attribute__((ext_vector_type(4)));
__device__ __forceinline__ v8i cat8(bf16x8 lo, bf16x8 hi) { const v4i a = __builtin_bit_cast(v4i, lo), b = __builtin_bit_cast(v4i, hi); return __builtin_shufflevector(a, b, 0, 1, 2, 3, 4, 5, 6, 7); }
struct Unit { const char* A; const char* B; const unsigned* gat; int nvalid; int i0, i1, i2; };

template <class Epi, class Sched, bool GATHER, bool ALIGN_EPI, bool SP2, int BMODE = 0, int F8 = 0>
__device__ __forceinline__ void gemm_phase(LAS unsigned char* lds, const unsigned lda, const unsigned ldb, const int nt, const Sched& S, const Epi& E) {
    const int tid = threadIdx.x, wid = __builtin_amdgcn_readfirstlane(tid >> 6), lane = tid & 63, wr = wid >> 2, wc = wid & 3, fr = lane & 15, fq = lane >> 4;
    int R0, C0, R1, C1; stage_rc(tid * 16, R0, C0); stage_rc(tid * 16 + 8192, R1, C1);
    const int Rb0 = BMODE == 0 ? (R0 & ~31) + perm32(R0 & 31) : 64 * (R0 >> 5) + 16 * ((R0 & 15) >> 2) + 4 * ((R0 >> 4) & 1) + (R0 & 3);
    const int Rb1 = BMODE == 0 ? (R1 & ~31) + perm32(R1 & 31) : 64 * (R1 >> 5) + 16 * ((R1 & 15) >> 2) + 4 * ((R1 >> 4) & 1) + (R1 & 3);
    const unsigned voffB0 = (unsigned)Rb0 * ldb + (unsigned)C0 * 2u, voffB1 = (unsigned)Rb1 * ldb + (unsigned)C1 * 2u;
    const size_t hstepB = (size_t)(BMODE == 0 ? HALF : 8) * ldb;
    const size_t kstep = (size_t)(BK * 2);
    const unsigned ldsw = (unsigned)wid * 1024u;
    const int aoff = lds_byte(wr * 64 + fr, F8 ? fq * 16 : fq * 8), boff = lds_byte(wc * 32 + fr, F8 ? fq * 16 : fq * 8);
    const int aoff2 = F8 ? lds_byte(wr * 64 + fr, fq * 16 + 8) : aoff + 1024, boff2 = F8 ? lds_byte(wc * 32 + fr, fq * 16 + 8) : boff + 1024;
#define PG8_SA(b, h) (((b) * 2 + (h)) * HTB)
#define PG8_SB(b, h) ((4 + (b) * 2 + (h)) * HTB)
#define PG8_STAGE(bufoff, gbase, v0, v1) do { unsigned _v0 = (v0), _v1 = (v1); asm volatile("" : "+v"(_v0), "+v"(_v1)); \
        __builtin_amdgcn_global_load_lds((const unsigned*)((const char*)(gbase) + _v0), (LAS unsigned*)(lds + (bufoff) + ldsw), 16, 0, 0); \
        __builtin_amdgcn_global_load_lds((const unsigned*)((const char*)(gbase) + _v1), (LAS unsigned*)(lds + (bufoff) + ldsw + 8192), 16, 0, 0); } while (0)
#define PG8_LDA(dst, b, h) do { _Pragma("unroll") for (int m = 0; m < 4; ++m) { dst[m][0] = *(const LAS bf16x8*)(lds + PG8_SA(b, h) + aoff + m * 2048); dst[m][1] = *(const LAS bf16x8*)(lds + PG8_SA(b, h) + aoff2 + m * 2048); } } while (0)
#define PG8_LDB(dst, b, h) do { _Pragma("unroll") for (int n = 0; n < 2; ++n) { dst[n][0] = *(const LAS bf16x8*)(lds + PG8_SB(b, h) + boff + n * 2048); dst[n][1] = *(const LAS bf16x8*)(lds + PG8_SB(b, h) + boff2 + n * 2048); } } while (0)
#define PG8_MMA(ai, bj, At, Bt) do { __builtin_amdgcn_s_setprio(1); _Pragma("unroll") for (int m = 0; m < 4; ++m) _Pragma("unroll") for (int n = 0; n < 2; ++n) { \
        if constexpr (F8) acc[ai][bj][m][n] = __builtin_amdgcn_mfma_scale_f32_16x16x128_f8f6f4(cat8(Bt[n][0], Bt[n][1]), cat8(At[m][0], At[m][1]), acc[ai][bj][m][n], 0, 0, 0, 0x7F7F7F7F, 0, 0x7F7F7F7F); \
        else { _Pragma("unroll") for (int k = 0; k < 2; ++k) acc[ai][bj][m][n] = __builtin_amdgcn_mfma_f32_16x16x32_bf16(Bt[n][k], At[m][k], acc[ai][bj][m][n], 0, 0, 0); } } __builtin_amdgcn_s_setprio(0); } while (0)
#define PG8_WAIT_V(n) asm volatile("s_waitcnt vmcnt(" #n ")" ::: "memory")
#define PG8_WAIT_L(n) asm volatile("s_waitcnt lgkmcnt(" #n ")" ::: "memory")
#define PG8_BAR __builtin_amdgcn_s_barrier()
#define PG8_SCHED __builtin_amdgcn_sched_barrier(0)
#define PG8_SETV(v00, v01, v10, v11, u) do { \
        if (GATHER) { int _t = tid; asm volatile("" : "+v"(_t)); int r0, c0, r1, c1; stage_rc(_t * 16, r0, c0); stage_rc(_t * 16 + 8192, r1, c1);     \
            const unsigned ta = r0 < (u).nvalid ? (u).gat[r0] : 0u, tb = r1 < (u).nvalid ? (u).gat[r1] : 0u, \
                                     tc = (HALF + r0) < (u).nvalid ? (u).gat[HALF + r0] : 0u, td = (HALF + r1) < (u).nvalid ? (u).gat[HALF + r1] : 0u; \
            v00 = ta * lda + (unsigned)c0 * 2u; v01 = tb * lda + (unsigned)c1 * 2u; v10 = tc * lda + (unsigned)c0 * 2u; v11 = td * lda + (unsigned)c1 * 2u; } \
        else { v00 = (unsigned)R0 * lda + (unsigned)C0 * 2u; v01 = (unsigned)R1 * lda + (unsigned)C1 * 2u; v10 = (unsigned)(HALF + R0) * lda + (unsigned)C0 * 2u; v11 = (unsigned)(HALF + R1) * lda + (unsigned)C1 * 2u; } } while (0)
    Unit cur, nxt; int ui = 0;
    if (!S.next(0, cur)) return;
    f32x4 acc[2][2][4][2];
#pragma unroll
    for (int a = 0; a < 2; ++a)
#pragma unroll
        for (int b = 0; b < 2; ++b)
#pragma unroll
            for (int m = 0; m < 4; ++m)
#pragma unroll
                for (int n = 0; n < 2; ++n) acc[a][b][m][n] = (f32x4){0.f, 0.f, 0.f, 0.f};
    bf16x8 At[4][2], B0[2][2], B1[2][2];
    const char* cA = cur.A; const char* cB = cur.B;
    unsigned cv00, cv01, cv10, cv11;
    PG8_SETV(cv00, cv01, cv10, cv11, cur);
    if constexpr (SP2) {
        PG8_STAGE(PG8_SB(0, 0), cB, voffB0, voffB1); PG8_STAGE(PG8_SB(0, 1), cB + hstepB, voffB0, voffB1); PG8_STAGE(PG8_SA(0, 0), cA, cv00, cv01); PG8_STAGE(PG8_SA(0, 1), cA, cv10, cv11);
        if (wr == 1) PG8_BAR;
        PG8_WAIT_V(2); PG8_BAR;
        PG8_STAGE(PG8_SB(1, 0), cB + kstep, voffB0, voffB1); PG8_STAGE(PG8_SA(1, 0), cA + kstep, cv00, cv01); PG8_STAGE(PG8_SB(1, 1), cB + hstepB + kstep, voffB0, voffB1);
        PG8_WAIT_V(6); PG8_BAR;
    } else {
        PG8_STAGE(PG8_SB(0, 0), cB, voffB0, voffB1); PG8_STAGE(PG8_SA(0, 0), cA, cv00, cv01); PG8_STAGE(PG8_SB(0, 1), cB + hstepB, voffB0, voffB1); PG8_STAGE(PG8_SA(0, 1), cA, cv10, cv11);
        if (wr == 1) PG8_BAR;
        PG8_WAIT_V(4); PG8_BAR;
        PG8_STAGE(PG8_SB(1, 0), cB + kstep, voffB0, voffB1); PG8_STAGE(PG8_SA(1, 0), cA + kstep, cv00, cv01); PG8_STAGE(PG8_SB(1, 1), cB + hstepB + kstep, voffB0, voffB1);
        PG8_WAIT_V(6); PG8_BAR;
    }
    for (;;) {
        const bool has_next = S.next(ui + 1, nxt);
        const char* nA = has_next ? nxt.A : cA; const char* nB = has_next ? nxt.B : cB;
#pragma unroll 1
        for (int t = 0; t < nt; t += 2) {
            const bool last = (t == nt - 2);
            const char* a1 = cA + (size_t)(t + 1) * kstep;
            const char* a2 = last ? nA : cA + (size_t)(t + 2) * kstep; const char* b2 = last ? nB : cB + (size_t)(t + 2) * kstep;
            const char* a3 = a2 + kstep; const char* b3 = b2 + kstep;
            if constexpr (SP2) {
            PG8_LDB(B0, 0, 0); PG8_LDB(B1, 0, 1); PG8_SCHED; PG8_LDA(At, 0, 0); PG8_STAGE(PG8_SA(1, 1), a1, cv10, cv11);
            PG8_WAIT_V(8); PG8_WAIT_L(0); PG8_BAR; PG8_MMA(0, 0, At, B0); PG8_MMA(0, 1, At, B1); PG8_BAR; PG8_SCHED;
            if constexpr (GATHER) { if (last && has_next) { PG8_SETV(cv00, cv01, cv10, cv11, nxt); } }
            PG8_LDA(At, 0, 1); PG8_STAGE(PG8_SB(0, 0), b2, voffB0, voffB1); PG8_STAGE(PG8_SB(0, 1), b2 + hstepB, voffB0, voffB1); PG8_STAGE(PG8_SA(0, 0), a2, cv00, cv01);
            PG8_WAIT_V(8); PG8_WAIT_L(0); PG8_BAR; PG8_MMA(1, 0, At, B0); PG8_MMA(1, 1, At, B1); PG8_BAR; PG8_SCHED;
            PG8_LDB(B0, 1, 0); PG8_LDB(B1, 1, 1); PG8_SCHED; PG8_LDA(At, 1, 0); PG8_STAGE(PG8_SA(0, 1), a2, cv10, cv11);
            PG8_WAIT_V(8); PG8_WAIT_L(0); PG8_BAR; PG8_MMA(0, 0, At, B0); PG8_MMA(0, 1, At, B1); PG8_BAR; PG8_SCHED;
            PG8_LDA(At, 1, 1); PG8_STAGE(PG8_SB(1, 0), b3, voffB0, voffB1); PG8_STAGE(PG8_SB(1, 1), b3 + hstepB, voffB0, voffB1); PG8_STAGE(PG8_SA(1, 0), a3, cv00, cv01);
            PG8_WAIT_V(8); PG8_WAIT_L(0); PG8_BAR; PG8_MMA(1, 0, At, B0); PG8_MMA(1, 1, At, B1); PG8_BAR; PG8_SCHED;
            } else {
            PG8_LDB(B0, 0, 0); PG8_SCHED; PG8_LDA(At, 0, 0); PG8_STAGE(PG8_SA(1, 1), a1, cv10, cv11);
            PG8_WAIT_L(8); PG8_BAR; PG8_WAIT_L(0); PG8_MMA(0, 0, At, B0); PG8_BAR; PG8_SCHED;
            if constexpr (GATHER) { if (last && has_next) { PG8_SETV(cv00, cv01, cv10, cv11, nxt); } }
            PG8_LDB(B1, 0, 1); PG8_STAGE(PG8_SB(0, 0), b2, voffB0, voffB1);
            PG8_BAR; PG8_WAIT_L(0); PG8_MMA(0, 1, At, B1); PG8_BAR;
            PG8_LDA(At, 0, 1); PG8_STAGE(PG8_SA(0, 0), a2, cv00, cv01);
            PG8_BAR; PG8_WAIT_L(0); PG8_MMA(1, 0, At, B0); PG8_BAR; PG8_SCHED;
            PG8_STAGE(PG8_SB(0, 1), b2 + hstepB, voffB0, voffB1);
            PG8_WAIT_V(6); PG8_BAR; PG8_MMA(1, 1, At, B1); PG8_BAR;
            PG8_LDB(B0, 1, 0); PG8_SCHED; PG8_LDA(At, 1, 0); PG8_STAGE(PG8_SA(0, 1), a2, cv10, cv11);
            PG8_WAIT_L(8); PG8_BAR; PG8_WAIT_L(0); PG8_MMA(0, 0, At, B0); PG8_BAR; PG8_SCHED;
            PG8_LDB(B1, 1, 1); PG8_STAGE(PG8_SB(1, 0), b3, voffB0, voffB1);
            PG8_BAR; PG8_WAIT_L(0); PG8_MMA(0, 1, At, B1); PG8_BAR;
            PG8_LDA(At, 1, 1); PG8_STAGE(PG8_SA(1, 0), a3, cv00, cv01);
            PG8_BAR; PG8_WAIT_L(0); PG8_MMA(1, 0, At, B0); PG8_BAR; PG8_SCHED;
            PG8_STAGE(PG8_SB(1, 1), b3 + hstepB, voffB0, voffB1);
            PG8_WAIT_V(6); PG8_BAR; PG8_MMA(1, 1, At, B1); PG8_BAR;
            }
        }
        if constexpr (ALIGN_EPI) { if (wr == 0) PG8_BAR; }
        E(acc, cur, wr, wc, fr, fq);
        if (!has_next) break;
#pragma unroll
        for (int a = 0; a < 2; ++a)
#pragma unroll
            for (int b = 0; b < 2; ++b)
#pragma unroll
                for (int m = 0; m < 4; ++m)
#pragma unroll
                    for (int n = 0; n < 2; ++n) acc[a][b][m][n] = (f32x4){0.f, 0.f, 0.f, 0.f};
        cur = nxt; cA = nA; cB = nB; ++ui;
        if constexpr (ALIGN_EPI) { if (wr == 1) PG8_BAR; }
    }
    PG8_WAIT_V(0);
    if constexpr (!ALIGN_EPI) { if (wr == 0) PG8_BAR; }
    PG8_BAR;
#undef PG8_SA
#undef PG8_SB
#undef PG8_STAGE
#undef PG8_LDA
#undef PG8_LDB
#undef PG8_MMA
#undef PG8_WAIT_V
#undef PG8_WAIT_L
#undef PG8_BAR
#undef PG8_SCHED
#undef PG8_SETV
}

struct DenseSched {
    const char* A; const char* B; unsigned lda, ldb, a_pn; int nM, nN, nwg, G, c;
    __device__ __forceinline__ bool next(int i, Unit& u) const {
        const long L = (long)i * G + c; if (L >= nwg) return false;
        int wgid = (int)L; { const int q = nwg / NXCD, r = nwg % NXCD, xcd = wgid % NXCD, off = wgid / NXCD; wgid = (xcd < r ? xcd * (q + 1) : r * (q + 1) + (xcd - r) * q) + off; }
        const int nig = WGM * nN, gid = wgid / nig, fm = gid * WGM, gsz = (nM - fm) < WGM ? (nM - fm) : WGM;
        const int pm = fm + ((wgid % nig) % gsz), pn = (wgid % nig) / gsz;
        u.A = A + (size_t)pm * BM * lda + (size_t)pn * a_pn; u.B = B + (size_t)pn * BM * ldb; u.gat = nullptr; u.nvalid = BM; u.i0 = pm; u.i1 = pn; u.i2 = 0; return true;
    }
};
struct MoeInfo { const LAS unsigned* cnt; const LAS unsigned* tstart; const LAS unsigned* ystart; const LAS unsigned char* tile_e; int ntiles; };
struct G1Sched {
    MoeInfo mi; const char* XB; const char* Wgu; const unsigned* rowtok; const unsigned* ident; int G, vcu;
    __device__ __forceinline__ bool next(int i, Unit& u) const {
        const int L = i * G + vcu; if (L >= 2 * mi.ntiles) return false;
        const int tile = L >> 1, uu = L & 1; int e;
        if (tile < 64) { e = 64; u.gat = ident + tile * 256; u.nvalid = 256; }
        else { e = __builtin_amdgcn_readfirstlane((int)mi.tile_e[tile]); const int pos0 = (tile - __builtin_amdgcn_readfirstlane((int)mi.tstart[e])) * 256; u.gat = rowtok + (size_t)e * CAP + pos0; const int rem = __builtin_amdgcn_readfirstlane((int)mi.cnt[e]) - pos0; u.nvalid = rem < 256 ? rem : 256; }
        u.A = XB; u.B = Wgu + ((size_t)e * 512 + (size_t)uu * 256) * 1024; u.i0 = tile; u.i1 = uu; u.i2 = 0; return true;
    }
};
struct G2Sched {
    MoeInfo mi; const char* H; const char* Wd; int G, vcu, L0;
    __device__ __forceinline__ bool next(int i, Unit& u) const {
        const int L = i * G + vcu + L0; if (L >= 4 * mi.ntiles) return false;
        const int tile = L >> 2, pn = L & 3; int e;
        if (tile < 64) { e = 64; u.i0 = 131072 + tile * 256; u.i2 = 0; u.nvalid = 256; }
        else { e = __builtin_amdgcn_readfirstlane((int)mi.tile_e[tile]); const int pos0 = (tile - __builtin_amdgcn_readfirstlane((int)mi.tstart[e])) * 256; u.i0 = __builtin_amdgcn_readfirstlane((int)mi.ystart[e]) + pos0; u.i2 = 0; const int rem = __builtin_amdgcn_readfirstlane((int)mi.cnt[e]) - pos0; u.nvalid = rem < 256 ? rem : 256; }
        u.A = H + (size_t)tile * 256 * 512; u.B = Wd + ((size_t)e * 1024 + (size_t)pn * 256) * 512; u.gat = nullptr; u.i1 = pn; return true;
    }
};

template <int ACT, bool BIAS, bool SCALE> struct EpiBf16 {
    bf16* O; int ldo; const float* bias; const float* scale;
    __device__ __forceinline__ void operator()(const f32x4 (&acc)[2][2][4][2], const Unit& u, int wr, int wc, int fr, int fq) const {
        const int row0 = u.i0 * BM + wr * 64 + fr, col0 = u.i1 * BM + wc * 32 + 8 * fq;
        f32x4 bv[2][2], sv[2][2];
#pragma unroll
        for (int bj = 0; bj < 2; ++bj)
#pragma unroll
            for (int n = 0; n < 2; ++n) { bv[bj][n] = BIAS ? *(const f32x4*)(bias + col0 + bj * HALF + 4 * n) : (f32x4){0.f, 0.f, 0.f, 0.f}; sv[bj][n] = SCALE ? *(const f32x4*)(scale + col0 + bj * HALF + 4 * n) : (f32x4){1.f, 1.f, 1.f, 1.f}; }
#pragma unroll
        for (int ai = 0; ai < 2; ++ai)
#pragma unroll
            for (int m = 0; m < 4; ++m) { bf16* rowp = O + (size_t)(row0 + ai * HALF + m * 16) * ldo + col0;
#pragma unroll
                for (int bj = 0; bj < 2; ++bj) { f32x4 v0 = acc[ai][bj][m][0] + bv[bj][0], v1 = acc[ai][bj][m][1] + bv[bj][1];
                    if (ACT == 1) {
#pragma unroll
                        for (int j = 0; j < 4; ++j) { v0[j] = gelu_tanh(v0[j]); v1[j] = gelu_tanh(v1[j]); } }
                    if (SCALE) { v0 = v0 * sv[bj][0]; v1 = v1 * sv[bj][1]; }
                    v4u w; w.x = cvt_pk_bf16(v0[0], v0[1]); w.y = cvt_pk_bf16(v0[2], v0[3]); w.z = cvt_pk_bf16(v1[0], v1[1]); w.w = cvt_pk_bf16(v1[2], v1[3]);
                    *(v4u*)(rowp + bj * HALF) = w; } }
    }
};
struct EpiResid {
    const float* base; float* out;
    __device__ __forceinline__ void operator()(const f32x4 (&acc)[2][2][4][2], const Unit& u, int wr, int wc, int fr, int fq) const {
        const int row0 = u.i0 * BM + wr * 64 + fr, col0 = u.i1 * BM + wc * 32 + 8 * fq;
#pragma unroll
        for (int ai = 0; ai < 2; ++ai)
#pragma unroll
            for (int m = 0; m < 4; ++m) { const size_t off = (size_t)(row0 + ai * HALF + m * 16) * DM + col0;
#pragma unroll
                for (int bj = 0; bj < 2; ++bj) { const f32x4 b0 = *(const f32x4*)(base + off + bj * HALF), b1 = *(const f32x4*)(base + off + bj * HALF + 4);
                    *(f32x4*)(out + off + bj * HALF) = b0 * ALPHA + acc[ai][bj][m][0]; *(f32x4*)(out + off + bj * HALF + 4) = b1 * ALPHA + acc[ai][bj][m][1]; }
                asm volatile("" ::: "memory"); }
    }
};
struct EpiSwiglu {
    bf16* H;
    __device__ __forceinline__ void operator()(const f32x4 (&acc)[2][2][4][2], const Unit& u, int wr, int wc, int fr, int fq) const {
        const int row0 = u.i0 * BM + wr * 64 + fr, col0 = u.i1 * HALF + wc * 32 + 8 * fq;
#pragma unroll
        for (int ai = 0; ai < 2; ++ai)
#pragma unroll
            for (int m = 0; m < 4; ++m) { bf16* rowp = H + (size_t)(row0 + ai * HALF + m * 16) * EDIM + col0; float h[8];
#pragma unroll
                for (int n = 0; n < 2; ++n)
#pragma unroll
                    for (int j = 0; j < 4; ++j) { const float g = acc[ai][0][m][n][j] * 0.03125f, up = acc[ai][1][m][n][j] * 0.03125f; h[4 * n + j] = g * sigmoidf_(g) * up; }
                v4u w; w.x = cvt_pk_bf16(h[0], h[1]); w.y = cvt_pk_bf16(h[2], h[3]); w.z = cvt_pk_bf16(h[4], h[5]); w.w = cvt_pk_bf16(h[6], h[7]);
                *(v4u*)rowp = w; }
    }
};
struct EpiDown {
    unsigned char* Y8;
    __device__ __forceinline__ void operator()(const f32x4 (&acc)[2][2][4][2], const Unit& u, int wr, int wc, int fr, int fq) const {
        const int r0 = wr * 64 + fr, col0 = u.i1 * BM + wc * 64 + 16 * fq;
#pragma unroll
        for (int ai = 0; ai < 2; ++ai)
#pragma unroll
            for (int m = 0; m < 4; ++m) { const int r = r0 + ai * HALF + m * 16;
                if (r < u.nvalid) { v4u w;
#pragma unroll
                    for (int q = 0; q < 4; ++q) { const f32x4 v = acc[ai][q >> 1][m][q & 1] * 16.0f; int t = 0; t = __builtin_amdgcn_cvt_pk_fp8_f32(v[0], v[1], t, false); t = __builtin_amdgcn_cvt_pk_fp8_f32(v[2], v[3], t, true); w[q] = (unsigned)t; }
                    *(v4u*)(Y8 + (size_t)(u.i0 + r) * DM + col0) = w; } }
    }
};
}

struct Args { const float* in[24]; float* out; unsigned char* ws; int ph_lo, ph_hi; };
enum { I_X = 0, I_PWIN, I_PWGRP, I_PSCALE, I_PWOUT, I_SWIN, I_SBIN, I_SLNG, I_SLNB, I_SWS, I_SBS, I_SWOUT, I_LNMG, I_LNMB, I_WR, I_RB, I_WG, I_WU, I_WD, I_SHG, I_SHU, I_SHD, I_LNFG, I_LNFB };

__device__ __forceinline__ void tr_item(const float* W, int N, int k0, int n0, bf16* dst  , int dpitch, LAS float* scr, int lane) {
#pragma unroll 8
    for (int i = 0; i < 32; ++i) { const int kk = 2 * i + (lane >> 5); scr[kk * 33 + (lane & 31)] = W[(size_t)(k0 + kk) * N + n0 + (lane & 31)]; }
    LDS_WAIT(); asm volatile("" ::: "memory");
    const int c = lane & 7;
#pragma unroll
    for (int j = 0; j < 4; ++j) { const int n = (lane >> 3) + 8 * j; const LAS float* s = scr + (8 * c) * 33 + n;
        v4u o; o.x = cvt_pk_bf16(s[0 * 33], s[1 * 33]); o.y = cvt_pk_bf16(s[2 * 33], s[3 * 33]); o.z = cvt_pk_bf16(s[4 * 33], s[5 * 33]); o.w = cvt_pk_bf16(s[6 * 33], s[7 * 33]);
        *(v4u*)(dst + (size_t)n * dpitch + 8 * c) = o; }
    LDS_WAIT(); asm volatile("" ::: "memory");
}
__device__ __forceinline__ void tr_item_f8(const float* W, int N, int k0, int n0, unsigned char* dst, int dpitch, float scale, LAS float* scr, int lane) {
#pragma unroll 8
    for (int i = 0; i < 32; ++i) { const int kk = 2 * i + (lane >> 5); scr[kk * 33 + (lane & 31)] = W[(size_t)(k0 + kk) * N + n0 + (lane & 31)]; }
    LDS_WAIT(); asm volatile("" ::: "memory");
    const int c = lane & 7;
#pragma unroll
    for (int j = 0; j < 4; ++j) { const int n = (lane >> 3) + 8 * j; const LAS float* s = scr + (8 * c) * 33 + n;
        int t0 = 0, t1 = 0;
        t0 = __builtin_amdgcn_cvt_pk_fp8_f32(s[0 * 33] * scale, s[1 * 33] * scale, t0, false); t0 = __builtin_amdgcn_cvt_pk_fp8_f32(s[2 * 33] * scale, s[3 * 33] * scale, t0, true);
        t1 = __builtin_amdgcn_cvt_pk_fp8_f32(s[4 * 33] * scale, s[5 * 33] * scale, t1, false); t1 = __builtin_amdgcn_cvt_pk_fp8_f32(s[6 * 33] * scale, s[7 * 33] * scale, t1, true);
        *(v2u*)(dst + (size_t)n * dpitch + 8 * c) = (v2u){(unsigned)t0, (unsigned)t1}; }
    LDS_WAIT(); asm volatile("" ::: "memory");
}
__device__ __forceinline__ void tr_item_hilo(const float* W, int N, int k0, int n0, bf16* dh, bf16* dl, int dpitch, LAS float* scr, int lane) {
#pragma unroll 8
    for (int i = 0; i < 32; ++i) { const int kk = 2 * i + (lane >> 5); scr[kk * 33 + (lane & 31)] = W[(size_t)(k0 + kk) * N + n0 + (lane & 31)]; }
    LDS_WAIT(); asm volatile("" ::: "memory");
    const int c = lane & 7;
#pragma unroll
    for (int j = 0; j < 4; ++j) { const int n = (lane >> 3) + 8 * j; const LAS float* s = scr + (8 * c) * 33 + n; float w[8];
#pragma unroll
        for (int z = 0; z < 8; ++z) w[z] = s[z * 33];
        v4u o; o.x = cvt_pk_bf16(w[0], w[1]); o.y = cvt_pk_bf16(w[2], w[3]); o.z = cvt_pk_bf16(w[4], w[5]); o.w = cvt_pk_bf16(w[6], w[7]);
        v4u l; l.x = cvt_pk_bf16(w[0] - bf_lo(o.x), w[1] - bf_hi(o.x)); l.y = cvt_pk_bf16(w[2] - bf_lo(o.y), w[3] - bf_hi(o.y)); l.z = cvt_pk_bf16(w[4] - bf_lo(o.z), w[5] - bf_hi(o.z)); l.w = cvt_pk_bf16(w[6] - bf_lo(o.w), w[7] - bf_hi(o.w));
        *(v4u*)(dh + (size_t)n * dpitch + 8 * c) = o; *(v4u*)(dl + (size_t)n * dpitch + 8 * c) = l; }
    LDS_WAIT(); asm volatile("" ::: "memory");
}
constexpr int MOE_ITEMS = 65 * 384;
__device__ __forceinline__ void convert_moe_item(const Args& a, int layer, int it, LAS float* scr, int lane) {
    bf16* WGU = (bf16*)(a.ws + WS_WGU + (size_t)layer * WS_MOE_LSTRIDE); bf16* WDN = (bf16*)(a.ws + WS_WDN + (size_t)layer * WS_MOE_LSTRIDE);
    const int e = it / 384, r = it % 384;
    if (r < 256) { const int isup = r >> 7, rr = r & 127, kb = rr >> 3, nb = rr & 7, n0 = 32 * nb, k0 = 64 * kb;
        const float* src = (e < 64) ? a.in[isup ? I_WU : I_WG] + ((size_t)layer * 64 + e) * 262144 : a.in[isup ? I_SHU : I_SHG] + (size_t)layer * 262144;
        const int drow = e * 512 + (n0 >> 7) * 256 + isup * 128 + (n0 & 127);
        tr_item_f8(src, 256, k0, n0, (unsigned char*)WGU + (size_t)drow * 1024 + k0, 1024, 32.0f, scr, lane);
    } else { const int rr = r - 256, kb = rr >> 5, nb = rr & 31, n0 = 32 * nb, k0 = 64 * kb;
        const float* src = (e < 64) ? a.in[I_WD] + ((size_t)layer * 64 + e) * 262144 : a.in[I_SHD] + (size_t)layer * 262144;
        tr_item(src, 1024, k0, n0, WDN + ((size_t)e * 1024 + n0) * 256 + k0, 256, scr, lane);
    }
}
constexpr int Q_SHARDS = 8, Q_PER_SHARD = MOE_ITEMS / Q_SHARDS;
static_assert(Q_PER_SHARD * Q_SHARDS == MOE_ITEMS, "queue shards");
template <int CHUNK> __device__ __forceinline__ bool convert_steal_n(const Args& a, int layer, LAS unsigned char* lds, int wave, int lane) {
    unsigned* q = (unsigned*)(a.ws + WS_CTL) + CW_QNEXT + 512 * layer;
    const int s0 = (int)(blockIdx.x & 7);
    for (int s = 0; s < Q_SHARDS; ++s) { const int sh = (s0 + s) & 7;
        unsigned it = 0; if (lane == 0) it = __hip_atomic_fetch_add(q + 64 * sh, (unsigned)CHUNK, RLX_AGENT);
        it = (unsigned)__builtin_amdgcn_readfirstlane((int)it);
        if (it < (unsigned)Q_PER_SHARD) {
            for (int c = 0; c < CHUNK; ++c) if (it + c < (unsigned)Q_PER_SHARD) convert_moe_item(a, layer, sh * Q_PER_SHARD + (int)it + c, (LAS float*)(lds + wave * 16384), lane);
            return true; } }
    return false;
}
__device__ __forceinline__ bool convert_steal(const Args& a, int layer, LAS unsigned char* lds, int wave, int lane) { return convert_steal_n<1>(a, layer, lds, wave, lane); }
__device__ __forceinline__ void convert_static(const Args& a, int layer, LAS unsigned char* lds, int vcu, int G) {
    const int lane = threadIdx.x & 63, wave = __builtin_amdgcn_readfirstlane(threadIdx.x >> 6);
    for (int it = vcu * NWAVES + wave; it < MOE_ITEMS; it += G * NWAVES) convert_moe_item(a, layer, it, (LAS float*)(lds + wave * 16384), lane);
}
__device__ __forceinline__ void convert_drain(const Args& a, int layer, LAS unsigned char* lds) {
    const int lane = threadIdx.x & 63, wave = __builtin_amdgcn_readfirstlane(threadIdx.x >> 6);
    while (convert_steal_n<4>(a, layer, lds, wave, lane)) {}
    __syncthreads();
}
__device__ __forceinline__ void phase_p0(const Args& a, LAS unsigned char* lds, int vcu, int G) {
    const int tid = threadIdx.x, lane = tid & 63, wave = __builtin_amdgcn_readfirstlane(tid >> 6);
    const int gw = vcu * NWAVES + wave, NGW = G * NWAVES;
    LAS float* scr = (LAS float*)(lds + wave * 16384);
    constexpr int I_IN = 16 * 32, I_GRP = 4 * 4 * 8, I_OUT = 16 * 32, I_SIN = 16 * 128, I_SOUT = 32 * 32, NIT = I_IN + I_GRP + I_OUT + I_SIN + I_SOUT;
    for (int it = gw; it < NIT; it += NGW) {
        int r = it;
        if (r < I_IN) { const int kb = r >> 5, nb = r & 31; tr_item(a.in[I_PWIN], 1024, 64 * kb, 32 * nb, (bf16*)(a.ws + WS_WIN) + (size_t)(32 * nb) * 1024 + 64 * kb, 1024, scr, lane); continue; } r -= I_IN;
        if (r < I_GRP) { const int g = r >> 5, rr = r & 31, kb = rr >> 3, nb = rr & 7; tr_item(a.in[I_PWGRP] + (size_t)g * 65536, 256, 64 * kb, 32 * nb, (bf16*)(a.ws + WS_WGRP) + (size_t)(g * 256 + 32 * nb) * 256 + 64 * kb, 256, scr, lane); continue; } r -= I_GRP;
        if (r < I_OUT) { const int kb = r >> 5, nb = r & 31; tr_item(a.in[I_PWOUT], 1024, 64 * kb, 32 * nb, (bf16*)(a.ws + WS_WOUT) + (size_t)(32 * nb) * 1024 + 64 * kb, 1024, scr, lane); continue; } r -= I_OUT;
        if (r < I_SIN) { const int kb = r >> 7, nb = r & 127; tr_item(a.in[I_SWIN], 4096, 64 * kb, 32 * nb, (bf16*)(a.ws + WS_WSIN) + (size_t)(32 * nb) * 1024 + 64 * kb, 1024, scr, lane); continue; } r -= I_SIN;
        { const int kb = r >> 5, nb = r & 31; tr_item(a.in[I_SWOUT], 1024, 64 * kb, 32 * nb, (bf16*)(a.ws + WS_WSOUT) + (size_t)(32 * nb) * 2048 + 64 * kb, 2048, scr, lane); }
    }
    for (int it = gw; it < 64; it += NGW) { const int layer = it >> 5, rr = it & 31, kb = rr >> 1, nb = rr & 1; bf16* base = (bf16*)(a.ws + WS_WRT) + (size_t)layer * 2 * 65536 + (size_t)(32 * nb) * 1024 + 64 * kb;
        tr_item_hilo(a.in[I_WR] + (size_t)layer * DM * NE, 64, 64 * kb, 32 * nb, base, base + 65536, 1024, scr, lane); }
    convert_static(a, 0, lds, vcu, G);
    const float* x = a.in[I_X]; bf16* xb = (bf16*)(a.ws + WS_XB);
    const size_t gt = (size_t)vcu * NTHR + tid, NT = (size_t)G * NTHR;
    for (size_t i = gt; i < (size_t)T_TOK * DM / 8; i += NT) { const f32x4 p = *(const f32x4*)(x + i * 8), q = *(const f32x4*)(x + i * 8 + 4);
        v4u w; w.x = cvt_pk_bf16(p[0], p[1]); w.y = cvt_pk_bf16(p[2], p[3]); w.z = cvt_pk_bf16(q[0], q[1]); w.w = cvt_pk_bf16(q[2], q[3]); *(v4u*)(xb + i * 8) = w; }
    unsigned* ident = (unsigned*)(a.ws + WS_IDENT);
    for (size_t i = gt; i < (size_t)T_TOK; i += NT) ident[i] = (unsigned)i;
}

template <int W> __device__ __forceinline__ void pool_item(const bf16* zp  , bf16* op  , int p0  ) {
    v4u q[W + 3];
#pragma unroll
    for (int i = 0; i < W + 3; ++i) { const int ii = i < p0 + 3 ? i : p0 + 3; q[i] = *(const v4u*)(zp - (size_t)ii * DM); }
#pragma unroll
    for (int o = 0; o < 4; ++o) {
        float s[8];
#pragma unroll
        for (int j = 0; j < 8; ++j) s[j] = 0.f;
#pragma unroll
        for (int i = 3 - o; i < 3 - o + W; ++i) { const float m = (i <= p0 + 3) ? 1.0f : 0.0f;
#pragma unroll
            for (int j = 0; j < 4; ++j) { s[2 * j] += m * bf_lo(q[i][j]); s[2 * j + 1] += m * bf_hi(q[i][j]); } }
        const int p = p0 + o, nw = (p + 1) < W ? (p + 1) : W; const float inv = 1.0f / (float)nw; v4u ov;
#pragma unroll
        for (int j = 0; j < 4; ++j) ov[j] = cvt_pk_bf16(s[2 * j] * inv - bf_lo(q[3 - o][j]), s[2 * j + 1] * inv - bf_hi(q[3 - o][j]));
        *(v4u*)(op + (size_t)o * DM) = ov; }
}
__device__ __forceinline__ void pool_block(const Args& a, int pm, int g) {
    const bf16* Z = (const bf16*)(a.ws + WS_Z); bf16* P = (bf16*)(a.ws + WS_POOLED);
    const int tid = threadIdx.x;
#pragma unroll 1
    for (int q = tid; q < 64 * 32; q += NTHR) { const int c8 = q & 31, tg = q >> 5, t0 = pm * 256 + tg * 4, p0 = t0 & (SEQ - 1);
        const bf16* zp = Z + (size_t)(t0 + 3) * DM + g * 256 + c8 * 8; bf16* op = P + (size_t)t0 * DM + g * 256 + c8 * 8;
        if (g == 0) pool_item<2>(zp, op, p0); else if (g == 1) pool_item<4>(zp, op, p0); else if (g == 2) pool_item<8>(zp, op, p0); else pool_item<16>(zp, op, p0); }
    VM_WAIT(); __syncthreads();
}
__device__ __forceinline__ void phase_pool(const Args& a, int vcu, int G) {
    const bf16* Z = (const bf16*)(a.ws + WS_Z); bf16* P = (bf16*)(a.ws + WS_POOLED);
    const int tid = threadIdx.x, wave = tid >> 6, lane = tid & 63;
    const int gw = vcu * NWAVES + wave, NGW = G * NWAVES;
    for (int it = gw; it < (T_TOK / 4) * 2; it += NGW) {
        const int t0 = (it >> 1) * 4, c8 = (it & 1) * 64 + lane, g = c8 >> 5, p0 = t0 & (SEQ - 1);
        const bf16* zp = Z + (size_t)(t0 + 3) * DM + c8 * 8; bf16* op = P + (size_t)t0 * DM + c8 * 8;
        if (g == 0) pool_item<2>(zp, op, p0); else if (g == 1) pool_item<4>(zp, op, p0); else if (g == 2) pool_item<8>(zp, op, p0); else pool_item<16>(zp, op, p0);
    }
}

template <int R, bool F8OUT = false> __device__ __forceinline__ void ln_rows_store(float (&v)[R][16], const float* g, const float* b, float* const (&of)[R], bf16* const (&ob)[R], int lane) {
    float s[R], s2[R];
#pragma unroll
    for (int r = 0; r < R; ++r) { s[r] = 0.f;
#pragma unroll
        for (int i = 0; i < 16; ++i) s[r] += v[r][i]; }
#pragma unroll
    for (int o = 1; o < 64; o <<= 1)
#pragma unroll
        for (int r = 0; r < R; ++r) s[r] += __shfl_xor(s[r], o);
#pragma unroll
    for (int r = 0; r < R; ++r) { const float mean = s[r] * (1.0f / DM); s2[r] = 0.f;
#pragma unroll
        for (int i = 0; i < 16; ++i) { v[r][i] -= mean; s2[r] += v[r][i] * v[r][i]; } }
#pragma unroll
    for (int o = 1; o < 64; o <<= 1)
#pragma unroll
        for (int r = 0; r < R; ++r) s2[r] += __shfl_xor(s2[r], o);
#pragma unroll
    for (int j = 0; j < 2; ++j) { const int c = 8 * lane + 512 * j;
        const f32x4 g0 = *(const f32x4*)(g + c), g1 = *(const f32x4*)(g + c + 4), b0 = *(const f32x4*)(b + c), b1 = *(const f32x4*)(b + c + 4);
#pragma unroll
        for (int r = 0; r < R; ++r) { const float rstd = 1.0f / sqrtf(s2[r] * (1.0f / DM) + LN_EPS); f32x4 y0, y1;
#pragma unroll
            for (int q = 0; q < 4; ++q) { y0[q] = v[r][8 * j + q] * rstd * g0[q] + b0[q]; y1[q] = v[r][8 * j + 4 + q] * rstd * g1[q] + b1[q]; }
            *(f32x4*)(of[r] + c) = y0; *(f32x4*)(of[r] + c + 4) = y1;
            if constexpr (F8OUT) { int t0 = 0, t1 = 0; t0 = __builtin_amdgcn_cvt_pk_fp8_f32(y0[0], y0[1], t0, false); t0 = __builtin_amdgcn_cvt_pk_fp8_f32(y0[2], y0[3], t0, true); t1 = __builtin_amdgcn_cvt_pk_fp8_f32(y1[0], y1[1], t1, false); t1 = __builtin_amdgcn_cvt_pk_fp8_f32(y1[2], y1[3], t1, true);
                *(v2u*)((unsigned char*)ob[r] + c) = (v2u){(unsigned)t0, (unsigned)t1}; }
            else { v4u w; w.x = cvt_pk_bf16(y0[0], y0[1]); w.y = cvt_pk_bf16(y0[2], y0[3]); w.z = cvt_pk_bf16(y1[0], y1[1]); w.w = cvt_pk_bf16(y1[2], y1[3]);
                *(v4u*)(ob[r] + c) = w; } } }
}

__device__ __forceinline__ void phase_lnr(const Args& a, int layer, LAS unsigned char* lds, int vcu, int G, bool dry) {
    const int tid = threadIdx.x, lane = tid & 63, wave = __builtin_amdgcn_readfirstlane(tid >> 6);
    const float* xin = a.out; float* xf = dry ? (float*)(a.ws + WS_Y) : a.out; bf16* xb = dry ? (bf16*)(a.ws + WS_Y + 72 * MiB) : (bf16*)(a.ws + WS_XB);
    const float* lng = a.in[I_LNMG] + layer * DM; const float* lnb = a.in[I_LNMB] + layer * DM;
    const float* Wr = a.in[I_WR] + (size_t)layer * DM * NE; const float* rbias = a.in[I_RB] + layer * NE;
    unsigned* gcount = (unsigned*)(a.ws + WS_CTL) + CW_CNT + layer * 64 + (dry ? 128 : 0);
    unsigned* rowtok = dry ? (unsigned*)(a.ws + WS_Y + 64 * MiB) : (unsigned*)(a.ws + WS_ROWTOK); unsigned* dest = dry ? (unsigned*)(a.ws + WS_Y + 68 * MiB) : (unsigned*)(a.ws + WS_DEST); float* gatev = dry ? (float*)(a.ws + WS_Y + 69 * MiB) : (float*)(a.ws + WS_GATE);
    LAS float* part = (LAS float*)lds;
    LAS float* mb = (LAS float*)(lds + 32768);
    LAS float* gs = (LAS float*)(lds + 49152);
    LAS unsigned* hist = (LAS unsigned*)(lds + 51200);
    LAS unsigned* basep = (LAS unsigned*)(lds + 51456);
    { const int blk = vcu;
        const int row0 = blk * 64;
        if (tid < 64) hist[tid] = 0u;
#pragma unroll 1
        for (int h4 = 0; h4 < 2; ++h4) { float v[4][16]; float* of[4]; bf16* ob[4];
#pragma unroll
            for (int r = 0; r < 4; ++r) { const int rr = wave * 8 + h4 * 4 + r; const float* xr = xin + (size_t)(row0 + rr) * DM; of[r] = xf + (size_t)(row0 + rr) * DM; ob[r] = (bf16*)((unsigned char*)xb + (size_t)(row0 + rr) * DM);
#pragma unroll
                for (int j = 0; j < 2; ++j) { const f32x4 p = *(const f32x4*)(xr + 8 * lane + 512 * j), q = *(const f32x4*)(xr + 8 * lane + 512 * j + 4);
#pragma unroll
                    for (int i = 0; i < 4; ++i) { v[r][8 * j + i] = p[i]; v[r][8 * j + 4 + i] = q[i]; } } }
            ln_rows_store<4, true>(v, lng, lnb, of, ob, lane); }
        VM_WAIT(); __syncthreads();
#ifndef DRY_PARTS
#define DRY_PARTS 7
#endif
        if (!dry || (DRY_PARTS & 2)) { const int mt = wave & 3, kh = wave >> 2, r = lane & 15, g = lane >> 4;
          f32x4 acc[4];
#pragma unroll
          for (int n = 0; n < 4; ++n) acc[n] = (f32x4){0.f, 0.f, 0.f, 0.f};
          const float* arow = xf + (size_t)(row0 + 16 * mt + r) * DM + kh * 512 + 8 * g;
          const bf16* bh = (const bf16*)(a.ws + WS_WRT) + (size_t)layer * 2 * 65536 + (size_t)r * 1024 + kh * 512 + 8 * g; const bf16* bl = bh + 65536;
          f32x4 a0 = *(const f32x4*)arow, a1 = *(const f32x4*)(arow + 4); bf16x8 wh[4], wl[4];
#pragma unroll
          for (int n = 0; n < 4; ++n) { wh[n] = *(const bf16x8*)(bh + (size_t)n * 16384); wl[n] = *(const bf16x8*)(bl + (size_t)n * 16384); }
#pragma unroll 1
          for (int s = 0; s < 16; ++s) { const int sn = s < 15 ? s + 1 : s;
              const f32x4 n0 = *(const f32x4*)(arow + 32 * sn), n1 = *(const f32x4*)(arow + 32 * sn + 4); bf16x8 nh[4], nl[4];
#pragma unroll
              for (int n = 0; n < 4; ++n) { nh[n] = *(const bf16x8*)(bh + (size_t)n * 16384 + 32 * sn); nl[n] = *(const bf16x8*)(bl + (size_t)n * 16384 + 32 * sn); }
              v4u hi, lo; hi.x = cvt_pk_bf16(a0[0], a0[1]); hi.y = cvt_pk_bf16(a0[2], a0[3]); hi.z = cvt_pk_bf16(a1[0], a1[1]); hi.w = cvt_pk_bf16(a1[2], a1[3]);
              lo.x = cvt_pk_bf16(a0[0] - bf_lo(hi.x), a0[1] - bf_hi(hi.x)); lo.y = cvt_pk_bf16(a0[2] - bf_lo(hi.y), a0[3] - bf_hi(hi.y));
              lo.z = cvt_pk_bf16(a1[0] - bf_lo(hi.z), a1[1] - bf_hi(hi.z)); lo.w = cvt_pk_bf16(a1[2] - bf_lo(hi.w), a1[3] - bf_hi(hi.w));
              const bf16x8 ah = __builtin_bit_cast(bf16x8, hi), al = __builtin_bit_cast(bf16x8, lo);
#pragma unroll
              for (int n = 0; n < 4; ++n) { acc[n] = __builtin_amdgcn_mfma_f32_16x16x32_bf16(ah, wh[n], acc[n], 0, 0, 0); acc[n] = __builtin_amdgcn_mfma_f32_16x16x32_bf16(al, wh[n], acc[n], 0, 0, 0); acc[n] = __builtin_amdgcn_mfma_f32_16x16x32_bf16(ah, wl[n], acc[n], 0, 0, 0); }
              a0 = n0; a1 = n1;
#pragma unroll
              for (int n = 0; n < 4; ++n) { wh[n] = nh[n]; wl[n] = nl[n]; } }
#pragma unroll
          for (int n = 0; n < 4; ++n)
#pragma unroll
              for (int q = 0; q < 4; ++q) part[(kh * 64 + 16 * mt + 4 * g + q) * 64 + 16 * n + r] = acc[n][q]; }
        __syncthreads();
        if (!dry || (DRY_PARTS & 4)) { const int row = tid >> 3, grp = tid & 7; float sc[8], bsd[8];
#pragma unroll
          for (int i = 0; i < 8; ++i) { const int e = 8 * grp + i; const float lg = part[row * 64 + e] + part[(64 + row) * 64 + e]; sc[i] = 1.0f / (1.0f + __expf(-lg)); bsd[i] = sc[i] + rbias[e]; }
          float m1 = -INFINITY, m2 = -INFINITY;
#pragma unroll
          for (int i = 0; i < 8; ++i) { const float v = bsd[i]; if (v > m1) { m2 = m1; m1 = v; } else if (v > m2) m2 = v; }
          const float myg = m1 + m2;
          int grank = 0;
#pragma unroll
          for (int d = 1; d < 8; ++d) { const float o = __shfl(myg, (lane & ~7) | ((grp + d) & 7)); const int g2 = (grp + d) & 7; grank += (o > myg || (o == myg && g2 < grp)) ? 1 : 0; }
          const bool gsel = grank < 4;
          float cand[8]; int rk[8]; bool sel[8];
#pragma unroll
          for (int i = 0; i < 8; ++i) { cand[i] = gsel ? bsd[i] : -INFINITY; rk[i] = 0; sel[i] = false; }
#pragma unroll 1
          for (int k = 0; k < TOPK; ++k) {
              float best = cand[0]; int bi = 0;
#pragma unroll
              for (int i = 1; i < 8; ++i) if (cand[i] > best) { best = cand[i]; bi = i; }
              int gi = 8 * grp + bi;
#pragma unroll
              for (int off = 1; off < 8; off <<= 1) { const float ov = __shfl_xor(best, off); const int oi = __shfl_xor(gi, off); if (ov > best || (ov == best && oi < gi)) { best = ov; gi = oi; } }
#pragma unroll
              for (int i = 0; i < 8; ++i) if (gi == 8 * grp + i) { cand[i] = -INFINITY; rk[i] = k; sel[i] = true; }
          }
          float psum = 0.f;
#pragma unroll
          for (int i = 0; i < 8; ++i) psum += sel[i] ? sc[i] : 0.f;
          psum += __shfl_xor(psum, 1); psum += __shfl_xor(psum, 2); psum += __shfl_xor(psum, 4);
          const float inv = ROUTED_SCALE / psum;
          unsigned loc[8];
#pragma unroll
          for (int i = 0; i < 8; ++i) { loc[i] = 0u; if (sel[i]) loc[i] = __hip_atomic_fetch_add(hist + 8 * grp + i, 1u, __ATOMIC_RELAXED, __HIP_MEMORY_SCOPE_WORKGROUP); }
          __syncthreads();
          if (tid < 64) { const unsigned h = hist[tid]; basep[tid] = h ? __hip_atomic_fetch_add(gcount + tid, h, RLX_AGENT) : 0u; }
          __syncthreads();
          const int tok = row0 + row;
#pragma unroll
          for (int i = 0; i < 8; ++i) if (sel[i]) { const int e = 8 * grp + i; const unsigned pos = basep[e] + loc[i];
              rowtok[(size_t)e * CAP + pos] = (unsigned)tok; dest[tok * 8 + rk[i]] = ((unsigned)e << 16) | pos; gatev[tok * 8 + rk[i]] = sc[i] * inv; }
        }
        __syncthreads();
    }
}

__device__ __forceinline__ pg8::MoeInfo moe_setup(const Args& a, int layer, LAS unsigned char* misc) {
    const int tid = threadIdx.x;
    unsigned* gcount = (unsigned*)(a.ws + WS_CTL) + CW_CNT + layer * 64;
    LAS unsigned* cnt = (LAS unsigned*)(misc + MI_CNT); LAS unsigned* tstart = (LAS unsigned*)(misc + MI_TSTART); LAS unsigned* ystart = (LAS unsigned*)(misc + MI_YSTART);
    LAS unsigned* ntl = (LAS unsigned*)(misc + MI_NTILES); LAS unsigned char* tile_e = (LAS unsigned char*)(misc + MI_TILE_E);
    __syncthreads();
    if (tid < 64) { unsigned c = __hip_atomic_load(gcount + tid, RLX_AGENT); if (c > (unsigned)CAP) c = CAP; cnt[tid] = c; }
    __syncthreads();
    if (tid < 64) { unsigned ts = 64u, ys = 0u; for (int e = 0; e < tid; ++e) { const unsigned c = cnt[e]; ts += (c + 255u) >> 8; ys += c; }
        tstart[tid] = ts; ystart[tid] = ys; const unsigned mynt = (cnt[tid] + 255u) >> 8;
        for (unsigned i = 0; i < mynt; ++i) if (ts + i < 640u) tile_e[ts + i] = (unsigned char)tid;
        if (tid == 63) ntl[0] = ts + mynt; }
    __syncthreads();
    pg8::MoeInfo mi; mi.cnt = cnt; mi.tstart = tstart; mi.ystart = ystart; mi.tile_e = tile_e; mi.ntiles = __builtin_amdgcn_readfirstlane((int)ntl[0]);
    if (mi.ntiles > 640) mi.ntiles = 640;
    return mi;
}

__device__ __forceinline__ void phase_combine(const Args& a, int layer, LAS unsigned char* misc, int vcu, int G, bool dry) {
    const int tid = threadIdx.x, lane = tid & 63, wave = __builtin_amdgcn_readfirstlane(tid >> 6);
    const pg8::MoeInfo mi = moe_setup(a, layer, misc);
    float* xf = a.out; bf16* xb = (bf16*)(a.ws + WS_XB); const unsigned char* Y8 = (const unsigned char*)(a.ws + WS_Y);
    const unsigned* dest = (const unsigned*)(a.ws + WS_DEST); const float* gatev = (const float*)(a.ws + WS_GATE);
    const float* lng = a.in[I_LNFG] + layer * DM; const float* lnb = a.in[I_LNFB] + layer * DM;
    const int gw = vcu * NWAVES + wave, NGW = G * NWAVES;
#pragma unroll 1
    for (int rowa = gw; rowa < T_TOK; rowa += 2 * NGW) {
        float v[2][16]; float* of[2]; bf16* ob[2]; unsigned d[2][TOPK]; float gk[2][TOPK];
#pragma unroll
        for (int r = 0; r < 2; ++r) { const int row = rowa + r * NGW;
#pragma unroll
            for (int k = 0; k < TOPK; ++k) { d[r][k] = dest[row * 8 + k]; gk[r][k] = gatev[row * 8 + k]; } }
#pragma unroll
        for (int r = 0; r < 2; ++r) { const int row = rowa + r * NGW; float* xr = xf + (size_t)row * DM; of[r] = dry ? (float*)(a.ws + WS_H) + (size_t)row * DM : xr; ob[r] = xb + (size_t)row * DM;
#pragma unroll
            for (int j = 0; j < 2; ++j) { const f32x4 p = *(const f32x4*)(xr + 8 * lane + 512 * j), q = *(const f32x4*)(xr + 8 * lane + 512 * j + 4);
#pragma unroll
                for (int i = 0; i < 4; ++i) { v[r][8 * j + i] = p[i] * ALPHA; v[r][8 * j + 4 + i] = q[i] * ALPHA; } } }
#pragma unroll
        for (int r = 0; r < 2; ++r) { const unsigned char* yr = Y8 + (size_t)(131072 + rowa + r * NGW) * DM;
#pragma unroll
            for (int j = 0; j < 2; ++j) { const v2u w = *(const v2u*)(yr + 8 * lane + 512 * j);
#pragma unroll
                for (int q = 0; q < 2; ++q) { const f32x2 lo2 = __builtin_amdgcn_cvt_pk_f32_fp8((int)w[q], false), hi2 = __builtin_amdgcn_cvt_pk_f32_fp8((int)w[q], true);
                    v[r][8 * j + 4 * q] += 0.0625f * lo2.x; v[r][8 * j + 4 * q + 1] += 0.0625f * lo2.y; v[r][8 * j + 4 * q + 2] += 0.0625f * hi2.x; v[r][8 * j + 4 * q + 3] += 0.0625f * hi2.y; } } }
#pragma unroll
        for (int r = 0; r < 2; ++r)
#pragma unroll
            for (int k = 0; k < TOPK; ++k) { const unsigned dd = (unsigned)__builtin_amdgcn_readfirstlane((int)d[r][k]); const float g = __uint_as_float((unsigned)__builtin_amdgcn_readfirstlane((int)__float_as_uint(gk[r][k])));
                const unsigned e = (dd >> 16) & 63u, pos = dd & 0xffffu; const unsigned char* yr = Y8 + (size_t)(mi.ystart[e] + pos) * DM; const float g16 = g * 0.0625f;
#pragma unroll
                for (int j = 0; j < 2; ++j) { const v2u w = *(const v2u*)(yr + 8 * lane + 512 * j);
#pragma unroll
                    for (int q = 0; q < 2; ++q) { const f32x2 lo2 = __builtin_amdgcn_cvt_pk_f32_fp8((int)w[q], false), hi2 = __builtin_amdgcn_cvt_pk_f32_fp8((int)w[q], true);
                        v[r][8 * j + 4 * q] += g16 * lo2.x; v[r][8 * j + 4 * q + 1] += g16 * lo2.y; v[r][8 * j + 4 * q + 2] += g16 * hi2.x; v[r][8 * j + 4 * q + 3] += g16 * hi2.y; } } }
        ln_rows_store<2>(v, lng, lnb, of, ob, lane);
    }
}

__device__ __forceinline__ int swz16(int row) { return (row ^ (row >> 4)) & 15; }
__device__ __forceinline__ void phase_sgu_spatial(const Args& a, LAS unsigned char* lds, int vcu, int G) {
    const int tid = threadIdx.x, lane = tid & 63, wave = __builtin_amdgcn_readfirstlane(tid >> 6), fr = lane & 15, fq = lane >> 4;
    const bf16* HS = (const bf16*)(a.ws + WS_HS); bf16* GT = (bf16*)(a.ws + WS_GATED);
    const float* lng = a.in[I_SLNG]; const float* lnb = a.in[I_SLNB]; const float* WS = a.in[I_SWS]; const float* BS = a.in[I_SBS];
    LAS unsigned char* Bs = lds;
    LAS unsigned char* As = lds + 65536;
    LAS float* stm = (LAS float*)(lds + 98304);
    LAS float* str = (LAS float*)(lds + 98304 + 512);
    for (int item = vcu; item < 512; item += G) {
        const int chunk = item >> 2, h = item & 3, t0 = chunk * 128;
        __syncthreads();
#pragma unroll 1
        for (int r4 = 0; r4 < 4; ++r4) { v4u w[4][4];
#pragma unroll
            for (int rr = 0; rr < 4; ++rr) { const bf16* vr = HS + (size_t)(t0 + wave * 16 + r4 * 4 + rr) * 4096 + SGU_W;
#pragma unroll
                for (int q = 0; q < 4; ++q) w[rr][q] = *(const v4u*)(vr + 8 * lane + 512 * q); }
            float sm[4], sq[4];
#pragma unroll
            for (int rr = 0; rr < 4; ++rr) { float s1 = 0.f;
#pragma unroll
                for (int q = 0; q < 4; ++q)
#pragma unroll
                    for (int p = 0; p < 4; ++p) s1 += bf_lo(w[rr][q][p]) + bf_hi(w[rr][q][p]);
                sm[rr] = s1; }
#pragma unroll
            for (int o = 1; o < 64; o <<= 1)
#pragma unroll
                for (int rr = 0; rr < 4; ++rr) sm[rr] += __shfl_xor(sm[rr], o);
#pragma unroll
            for (int rr = 0; rr < 4; ++rr) { const float mean = sm[rr] * (1.0f / SGU_W); float s2 = 0.f;
#pragma unroll
                for (int q = 0; q < 4; ++q)
#pragma unroll
                    for (int p = 0; p < 4; ++p) { const float d0 = bf_lo(w[rr][q][p]) - mean, d1 = bf_hi(w[rr][q][p]) - mean; s2 += d0 * d0 + d1 * d1; }
                sm[rr] = mean; sq[rr] = s2; }
#pragma unroll
            for (int o = 1; o < 64; o <<= 1)
#pragma unroll
                for (int rr = 0; rr < 4; ++rr) sq[rr] += __shfl_xor(sq[rr], o);
            if (lane == 0) {
#pragma unroll
                for (int rr = 0; rr < 4; ++rr) { const int j = wave * 16 + r4 * 4 + rr; stm[j] = sm[rr]; str[j] = 1.0f / sqrtf(sq[rr] * (1.0f / SGU_W) + LN_EPS); } } }
        for (int q = tid; q < 128 * 16; q += NTHR) { const int i = q >> 4, jc = q & 15; const float* wp = WS + ((size_t)h * 128 + i) * 128 + 8 * jc;
            const f32x4 p0 = *(const f32x4*)wp, p1 = *(const f32x4*)(wp + 4); float w8[8];
#pragma unroll
            for (int z = 0; z < 4; ++z) { w8[z] = (8 * jc + z <= i) ? p0[z] : 0.f; w8[4 + z] = (8 * jc + 4 + z <= i) ? p1[z] : 0.f; }
            v4u o; o.x = cvt_pk_bf16(w8[0], w8[1]); o.y = cvt_pk_bf16(w8[2], w8[3]); o.z = cvt_pk_bf16(w8[4], w8[5]); o.w = cvt_pk_bf16(w8[6], w8[7]);
            *(LAS v4u*)(As + i * 256 + ((jc ^ swz16(i)) << 4)) = o; }
        __syncthreads();
        for (int hh = 0; hh < 2; ++hh) {
            const int cb = h * SGU_HD + hh * 256;
#pragma unroll 2
            for (int q = tid; q < 64 * 32; q += NTHR) { const int c8 = q & 31, jp = q >> 5, j0 = 2 * jp;
                const v4u w0 = *(const v4u*)(HS + (size_t)(t0 + j0) * 4096 + SGU_W + cb + 8 * c8), w1 = *(const v4u*)(HS + (size_t)(t0 + j0 + 1) * 4096 + SGU_W + cb + 8 * c8);
                const f32x4 g0 = *(const f32x4*)(lng + cb + 8 * c8), g1 = *(const f32x4*)(lng + cb + 8 * c8 + 4), b0 = *(const f32x4*)(lnb + cb + 8 * c8), b1 = *(const f32x4*)(lnb + cb + 8 * c8 + 4);
                const float m0 = stm[j0], r0 = str[j0], m1 = stm[j0 + 1], r1 = str[j0 + 1];
#pragma unroll
                for (int z = 0; z < 8; ++z) { const float gz = z < 4 ? g0[z & 3] : g1[z & 3], bz = z < 4 ? b0[z & 3] : b1[z & 3];
                    const float xa = (z & 1) ? bf_hi(w0[z >> 1]) : bf_lo(w0[z >> 1]), xc = (z & 1) ? bf_hi(w1[z >> 1]) : bf_lo(w1[z >> 1]);
                    const float ya = (xa - m0) * r0 * gz + bz, yc = (xc - m1) * r1 * gz + bz;
                    const int cc = 8 * c8 + z, slot = (cc & ~31) | (((cc >> 2) & 1) << 4) | (((cc >> 3) & 3) << 2) | (cc & 3);
                    *(LAS unsigned*)(Bs + slot * 256 + (((j0 >> 3) ^ swz16(slot)) << 4) + (j0 & 7) * 2) = cvt_pk_bf16(ya, yc); } }
            __syncthreads();
            f32x4 acc[8][2]; bf16x8 Bf[2][4];
#pragma unroll
            for (int n = 0; n < 2; ++n)
#pragma unroll
                for (int s = 0; s < 4; ++s) { const int slot = 32 * wave + 16 * n + fr; Bf[n][s] = *(const LAS bf16x8*)(Bs + slot * 256 + (((4 * s + fq) ^ swz16(slot)) << 4)); }
#pragma unroll
            for (int m = 0; m < 8; ++m) { acc[m][0] = (f32x4){0.f, 0.f, 0.f, 0.f}; acc[m][1] = (f32x4){0.f, 0.f, 0.f, 0.f};
#pragma unroll
                for (int s = 0; s < 4; ++s) if (s <= (m >> 1)) { const int i = 16 * m + fr; const bf16x8 af = *(const LAS bf16x8*)(As + i * 256 + (((4 * s + fq) ^ swz16(i)) << 4));
                    acc[m][0] = __builtin_amdgcn_mfma_f32_16x16x32_bf16(Bf[0][s], af, acc[m][0], 0, 0, 0); acc[m][1] = __builtin_amdgcn_mfma_f32_16x16x32_bf16(Bf[1][s], af, acc[m][1], 0, 0, 0); } }
#pragma unroll
            for (int m = 0; m < 8; ++m) { const int i = 16 * m + fr; const float bsv = BS[h * 128 + i]; const size_t t = (size_t)(t0 + i);
                const v4u uw = *(const v4u*)(HS + t * 4096 + cb + 32 * wave + 8 * fq); float o[8];
#pragma unroll
                for (int n = 0; n < 2; ++n)
#pragma unroll
                    for (int z = 0; z < 4; ++z) { const int c = 4 * n + z; const float uu = (c & 1) ? bf_hi(uw[c >> 1]) : bf_lo(uw[c >> 1]); o[c] = uu * (acc[m][n][z] + bsv); }
                v4u w; w.x = cvt_pk_bf16(o[0], o[1]); w.y = cvt_pk_bf16(o[2], o[3]); w.z = cvt_pk_bf16(o[4], o[5]); w.w = cvt_pk_bf16(o[6], o[7]);
                *(v4u*)(GT + t * SGU_W + cb + 32 * wave + 8 * fq) = w; }
            __syncthreads();
        }
    }
}

__device__ __forceinline__ void phase_flush(const Args& a, int vcu, int G) {
    const size_t gt = (size_t)vcu * NTHR + threadIdx.x, NT = (size_t)G * NTHR; f32x4 acc = (f32x4){0.f, 0.f, 0.f, 0.f};
    const f32x4* p0 = (const f32x4*)a.in[I_WG]; const f32x4* p1 = (const f32x4*)a.in[I_WU];
    for (size_t i = gt; i < (size_t)33554432 / 4; i += 4 * NT) { const f32x4 x0 = p0[i], x1 = p0[i + NT], x2 = p0[i + 2 * NT], x3 = p0[i + 3 * NT], y0 = p1[i], y1 = p1[i + NT], y2 = p1[i + 2 * NT], y3 = p1[i + 3 * NT]; acc += x0 + x1 + x2 + x3 + y0 + y1 + y2 + y3; }
    if (acc[0] + acc[1] + acc[2] + acc[3] == 1.2345e-30f) ((float*)(a.ws + WS_CTL))[16000] = acc[0];
}
constexpr int N_PHASES = 16;
__global__ void __launch_bounds__(NTHR, 2) mk_fwd(Args args) {
    extern __shared__ __attribute__((aligned(16))) unsigned char lds_raw[];
    LAS unsigned char* lds = (LAS unsigned char*)lds_raw;
    LAS unsigned char* misc = lds + MISC_OFF;
    const int tid = threadIdx.x;
    const int G = gridDim.x; const int bx = blockIdx.x; const int vcu = (G % 8 == 0) ? (bx % 8) * (G / 8) + bx / 8 : bx;
    unsigned char* ws = args.ws;
    unsigned* ctl = (unsigned*)(ws + WS_CTL);
    if (tid < 16) ((LAS unsigned*)(misc + MI_BARW))[tid] = 0u;
    __syncthreads();
    const int lo = args.ph_lo, hi = args.ph_hi;
    XcdBarrier bar; bar.bar = ctl + CW_BAR; bar.x = 0; bar.st = nullptr;
    if (hi - lo > 1) bar = xcd_barrier_post(ctl + CW_BAR, (volatile LAS unsigned*)(misc + MI_BARW));
#ifndef PH_MASK
#define PH_MASK 0xFFFF
#endif
#define IN(k) (((PH_MASK >> (k)) & 1) && lo <= (k) && (k) < hi)
#ifndef TS_A0
#define TS_A0 -1
#define TS_A1 -1
#define TS_M 1
#endif
    unsigned long long* tsbuf = (unsigned long long*)(ws + 32768);
#define TS_REC(k) do { if (TS_A0 >= 0 && bx == 0 && tid == 0) __hip_atomic_store(tsbuf + (k), (unsigned long long)__builtin_amdgcn_s_memrealtime(), RLX_AGENT); } while (0)
    TS_REC(0);
#ifndef REP_PH
#define REP_PH -1
#define REP_N 1
#endif
#define NREP(k) ((k) == REP_PH ? REP_N : 1)
#ifndef FLUSH_PH
#define FLUSH_PH -2
#endif
#define RUN(k) if (IN(k)) for (int rep = 0; rep < NREP(k); ++rep) if ((((k) == FLUSH_PH && rep == NREP(k) - 1) ? (xcd_barrier(bar), phase_flush(args, vcu, G), xcd_barrier(bar), true) : true))
#define DRY(k) (rep + 1 < NREP(k))
#define BG_LAYER(k) (-1)
#define SEAM(k) do { if (IN(k) && IN((k) + 1)) xcd_barrier(bar, &args, BG_LAYER(k), lds); TS_REC((k) + 1); } while (0)
    using namespace pg8;
    RUN(0) { phase_p0(args, lds, vcu, G); } SEAM(0);
    RUN(1) { DenseSched S{(const char*)(ws + WS_XB), (const char*)(ws + WS_WIN), 2048u, 2048u, 0u, 64, 4, 256, G, bx};
        EpiBf16<0, false, false> E{(bf16*)(ws + WS_Z), DM, nullptr, nullptr};
        gemm_phase<EpiBf16<0, false, false>, DenseSched, false, true, true>(lds, 2048u, 2048u, 16, S, E); } SEAM(1);
    if (REP_PH == 100 && hi - lo > 1) for (int i = 0; i < REP_N; ++i) xcd_barrier(bar);
    RUN(3) { DenseSched S{(const char*)(ws + WS_POOLED), (const char*)(ws + WS_WGRP), 2048u, 512u, 512u, 64, 4, 256, G, bx};
        { Unit u0; if (S.next(0, u0)) pool_block(args, u0.i0, u0.i1); }
        EpiBf16<0, false, true> E{(bf16*)(ws + WS_YP), DM, nullptr, args.in[I_PSCALE]};
        gemm_phase<EpiBf16<0, false, true>, DenseSched, false, true, true>(lds, 2048u, 512u, 4, S, E); } SEAM(3);
    RUN(4) { DenseSched S{(const char*)(ws + WS_YP), (const char*)(ws + WS_WOUT), 2048u, 2048u, 0u, 64, 4, 256, G, bx};
        EpiResid E{args.in[I_X], args.out};
        gemm_phase<EpiResid, DenseSched, false, true, true>(lds, 2048u, 2048u, 16, S, E); } SEAM(4);
#define MOE_PHASES(layer, pb) do { \
        RUN(pb) { phase_lnr(args, layer, lds, vcu, G, DRY(pb)); } SEAM(pb); \
        RUN((pb) + 1) { const MoeInfo mi = moe_setup(args, layer, misc); \
            G1Sched S{mi, (const char*)(ws + WS_XB), (const char*)(ws + WS_WGU + (size_t)layer * WS_MOE_LSTRIDE), (const unsigned*)(ws + WS_ROWTOK), (const unsigned*)(ws + WS_IDENT), G, vcu}; \
            EpiSwiglu E{(bf16*)(ws + WS_H)}; \
            gemm_phase<EpiSwiglu, G1Sched, true, true, false, 0, 1>(lds, 1024u, 1024u, 8, S, E); } SEAM((pb) + 1); \
        if (IN((pb) + 2) && REP_PH == (pb) + 2) { const MoeInfo mi = moe_setup(args, layer, misc); \
            G2Sched S{mi, (const char*)(ws + WS_H), (const char*)(ws + WS_WDN + (size_t)layer * WS_MOE_LSTRIDE), G, vcu, 256}; \
            EpiDown E{(unsigned char*)(ws + WS_Y)}; \
            gemm_phase<EpiDown, G2Sched, false, true, true, 1>(lds, 512u, 512u, 4, S, E); } \
        if (IN((pb) + 2)) { const MoeInfo mi = moe_setup(args, layer, misc); \
            G2Sched S{mi, (const char*)(ws + WS_H), (const char*)(ws + WS_WDN + (size_t)layer * WS_MOE_LSTRIDE), G, vcu, 0}; \
            EpiDown E{(unsigned char*)(ws + WS_Y)}; \
            gemm_phase<EpiDown, G2Sched, false, true, true, 1>(lds, 512u, 512u, 4, S, E); } SEAM((pb) + 2); \
        RUN((pb) + 3) { phase_combine(args, layer, misc, vcu, G, DRY((pb) + 3)); if (layer == 0 && !DRY((pb) + 3)) { __syncthreads(); convert_static(args, 1, lds, vcu, G); } } \
    } while (0)
    MOE_PHASES(0, 5); SEAM(8);
    RUN(9) { DenseSched S{(const char*)(ws + WS_XB), (const char*)(ws + WS_WSIN), 2048u, 2048u, 0u, 64, 16, 1024, G, bx};
        EpiBf16<1, true, false> E{(bf16*)(ws + WS_HS), 4096, args.in[I_SBIN], nullptr};
        gemm_phase<EpiBf16<1, true, false>, DenseSched, false, true, true>(lds, 2048u, 2048u, 16, S, E); } SEAM(9);
    RUN(10) { phase_sgu_spatial(args, lds, vcu, G); } SEAM(10);
    RUN(11) { DenseSched S{(const char*)(ws + WS_GATED), (const char*)(ws + WS_WSOUT), 4096u, 4096u, 0u, 64, 4, 256, G, bx};
        EpiResid E{args.out, DRY(11) ? (float*)(ws + WS_HS) : args.out};
        gemm_phase<EpiResid, DenseSched, false, true, true>(lds, 4096u, 4096u, 32, S, E); } SEAM(11);
    MOE_PHASES(1, 12);
#undef MOE_PHASES
    if (TS_A0 >= 0 && bx == 0 && tid == 0) {
        const unsigned long long tend = __builtin_amdgcn_s_memrealtime();
        const unsigned long long t0 = __hip_atomic_load(tsbuf + TS_A0, RLX_AGENT), t1 = (TS_A1 + 1 >= N_PHASES) ? tend : __hip_atomic_load(tsbuf + TS_A1 + 1, RLX_AGENT);
        const unsigned long long wait = (t1 - t0) * TS_M;
        while (__builtin_amdgcn_s_memrealtime() - tend < wait) __builtin_amdgcn_s_sleep(8);
    }
#undef IN
#undef SEAM
}

extern "C" void kernel_launch(void* const* d_in, const int* in_sizes, int n_in, void* d_out, int out_size, void* d_ws, size_t ws_size, hipStream_t stream) {
    static int grid = 0;
    if (grid == 0) {
        if (n_in != 24 || out_size != T_TOK * DM || ws_size < WS_END) { fprintf(stderr, "kernel_launch: unexpected shapes (n_in %d out %d ws %zu)\n", n_in, out_size, ws_size); grid = -1; return; }
        int dev = 0, cus = 0;
        if (hipGetDevice(&dev) != hipSuccess || hipDeviceGetAttribute(&cus, hipDeviceAttributeMultiprocessorCount, dev) != hipSuccess) { grid = -1; return; }
        if (hipFuncSetAttribute((const void*)mk_fwd, hipFuncAttributeMaxDynamicSharedMemorySize, LDS_BYTES) != hipSuccess) { fprintf(stderr, "kernel_launch: hipFuncSetAttribute failed\n"); grid = -1; return; }
        int per_cu = 0;
        if (hipOccupancyMaxActiveBlocksPerMultiprocessor(&per_cu, (const void*)mk_fwd, NTHR, LDS_BYTES) != hipSuccess || per_cu < 1) fprintf(stderr, "kernel_launch: occupancy query says %d\n", per_cu);
        (void)hipGetLastError();
        grid = cus;
        if (grid != 256) { fprintf(stderr, "kernel_launch: built for a 256-CU device (got %d)\n", cus); grid = -1; return; }
    }
    if (grid < 0) return;
    (void)hipMemsetAsync((char*)d_ws + WS_CTL, 0, CTL_ZERO_BYTES, stream);
    Args a{};
    for (int i = 0; i < 24; ++i) a.in[i] = (const float*)d_in[i];
    a.out = (float*)d_out; a.ws = (unsigned char*)d_ws;
#if MK_PER_PHASE
    for (int p = 0; p < N_PHASES; ++p) { a.ph_lo = p; a.ph_hi = p + 1; hipLaunchKernelGGL(mk_fwd, dim3(grid), dim3(NTHR), LDS_BYTES, stream, a); }
#else
    a.ph_lo = 0; a.ph_hi = N_PHASES; hipLaunchKernelGGL(mk_fwd, dim3(grid), dim3(NTHR), LDS_BYTES, stream, a);
#endif
}
```

```cpp
#include <hip/hip_runtime.h>
#include <cstdio>
#include <cstdint>

#ifndef MK_PER_PHASE
#define MK_PER_PHASE 0
#endif

#define GAS __attribute__((address_space(1)))
#define LAS __attribute__((address_space(3)))
typedef unsigned short bf16;
typedef unsigned v4u __attribute__((ext_vector_type(4)));
typedef unsigned v2u __attribute__((ext_vector_type(2)));
typedef float f32x4 __attribute__((ext_vector_type(4)));
typedef float f32x2 __attribute__((ext_vector_type(2)));
typedef short bf16x8 __attribute__((ext_vector_type(8)));
#define RLX_AGENT __ATOMIC_RELAXED, __HIP_MEMORY_SCOPE_AGENT
#define LDS_WAIT() asm volatile("s_waitcnt lgkmcnt(0)" ::: "memory")
#define VM_WAIT() asm volatile("s_waitcnt vmcnt(0)" ::: "memory")

constexpr int T_TOK = 16384, DM = 1024, SEQ = 4096, NE = 64, TOPK = 8, EDIM = 256;
constexpr int SGU_W = 2048, SGU_HD = 512;
constexpr float ALPHA = 1.41421356237309515f;
constexpr float LN_EPS = 1e-5f, ROUTED_SCALE = 2.5f;
constexpr int CAP = 16384;
constexpr int NWAVES = 8, NTHR = 512;

constexpr size_t MiB = 1u << 20;
constexpr size_t WS_CTL = 0, CTL_ZERO_BYTES = 65536;
constexpr size_t WS_IDENT = 256 * 1024;
constexpr size_t WS_DEST = 1 * MiB;
constexpr size_t WS_GATE = WS_DEST + 512 * 1024;
constexpr size_t WS_ROWTOK = 2 * MiB;
constexpr size_t WS_WIN = 6 * MiB;
constexpr size_t WS_WGRP = 8 * MiB;
constexpr size_t WS_WOUT = WS_WGRP + 512 * 1024;
constexpr size_t WS_WSIN = WS_WOUT + 2 * MiB;
constexpr size_t WS_WSOUT = WS_WSIN + 8 * MiB;
constexpr size_t WS_WRT = WS_WSOUT + 4 * MiB;
constexpr size_t WS_WGU = 23 * MiB;
constexpr size_t WS_WDN = WS_WGU + 65 * MiB;
constexpr size_t WS_XB = 121 * MiB;
constexpr size_t WS_H = 153 * MiB;
constexpr size_t WS_Y = 233 * MiB;
constexpr size_t WS_WGU1 = 378 * MiB, WS_WDN1 = WS_WGU1 + 65 * MiB;
constexpr size_t WS_MOE_LSTRIDE = WS_WGU1 - WS_WGU;
constexpr size_t WS_END = 476 * MiB;
constexpr size_t WS_Z = 153 * MiB, WS_POOLED = 185 * MiB, WS_YP = 217 * MiB;
constexpr size_t WS_HS = 153 * MiB;
constexpr size_t WS_GATED = 281 * MiB;
static_assert(WS_WRT + 512 * 1024 <= WS_WGU && WS_WDN + 33 * MiB <= WS_XB && WS_XB + 32 * MiB <= WS_H && WS_H + 80 * MiB <= WS_Y && WS_Y + 145 * MiB <= WS_WGU1 && WS_WDN1 + 33 * MiB <= WS_END && WS_GATED + 64 * MiB <= WS_WGU1, "ws map");
constexpr int CW_TMO = 0, CW_BAR = 64, CW_CNT = 4096, CW_QNEXT = 4608;

constexpr int RING_BYTES = 131072;
constexpr int MISC_OFF = RING_BYTES;
constexpr int LDS_BYTES = 147456;
constexpr int MI_BARW = 0, MI_CNT = 64, MI_TSTART = 320, MI_YSTART = 576, MI_NTILES = 832, MI_TILE_E = 1024;

__device__ __forceinline__ unsigned cvt_pk_bf16(float lo, float hi) { unsigned r; asm volatile("v_cvt_pk_bf16_f32 %0, %1, %2" : "=v"(r) : "v"(lo), "v"(hi)); return r; }
__device__ __forceinline__ float bf_lo(unsigned w) { return __uint_as_float(w << 16); }
__device__ __forceinline__ float bf_hi(unsigned w) { return __uint_as_float(w & 0xffff0000u); }
__device__ __forceinline__ float wave_sum(float v) {
#pragma unroll
    for (int o = 1; o < 64; o <<= 1) v += __shfl_xor(v, o);
    return v;
}
__device__ __forceinline__ float sigmoidf_(float x) { return __builtin_amdgcn_rcpf(1.0f + __builtin_amdgcn_exp2f(-1.4426950408889634f * x)); }
__device__ __forceinline__ float gelu_tanh(float v) { const float y = v + 0.044715f * v * v * v; return v * __builtin_amdgcn_rcpf(1.0f + __builtin_amdgcn_exp2f(-2.3022081983f * y)); }

#define XB_TMO      128
#define XB_XCNT(j)  (256  + 64 * (j))
#define XB_XSUB(j)  (1280 + 64 * (j))
#define XB_XGEN(j)  (2304 + 64 * (j))
#define XB_TOP      3328
#define XB_TOPGEN   3392
#define XCD_BAR_WORDS 3456
#define XB_SPIN_CAP (1u << 20)
__device__ __forceinline__ unsigned xb_ld(unsigned* p)              { return __hip_atomic_load(p, __ATOMIC_RELAXED, __HIP_MEMORY_SCOPE_AGENT); }
__device__ __forceinline__ unsigned xb_add(unsigned* p, unsigned v) { return __hip_atomic_fetch_add(p, v, __ATOMIC_RELAXED, __HIP_MEMORY_SCOPE_AGENT); }
__device__ __forceinline__ unsigned xb_xcc_id() { return (unsigned)__builtin_amdgcn_s_getreg((3 << 11) | 20) & 0xFu; }
#define XB_SPIN(cond, bar) do { unsigned _sp = 0; while (cond) { __builtin_amdgcn_s_sleep(1); \
    if ((++_sp & 255u) == 0u) { if (xb_ld(&(bar)[XB_TMO])) break; if (_sp > XB_SPIN_CAP) { atomicAdd(&(bar)[XB_TMO], 1u); break; } } } } while (0)
struct XcdBarrier { unsigned* bar; unsigned x; volatile LAS unsigned* st; };
__device__ __forceinline__ XcdBarrier xcd_barrier_post(unsigned* bar, volatile LAS unsigned* st) {
    XcdBarrier b; b.bar = bar; b.x = xb_xcc_id(); b.st = st;
    if (threadIdx.x == 0) (void)xb_add(&bar[XB_XCNT(b.x)], 1u);
    return b;
}
__device__ __forceinline__ void xcd_barrier_complete(unsigned* bar, unsigned x, unsigned& nloc, unsigned& nx) {
    const unsigned G = gridDim.x * gridDim.y * gridDim.z;
    unsigned sum, cnt, mine, sp = 0u;
    for (;;) {
        sum = 0u; cnt = 0u; mine = 0u;
#pragma unroll
        for (unsigned j = 0; j < 16; ++j) { const unsigned c = xb_ld(&bar[XB_XCNT(j)]); sum += c; cnt += (c > 0u) ? 1u : 0u; mine = (j == x) ? c : mine; }
        if (sum == G) break;
        __builtin_amdgcn_s_sleep(1);
        if ((++sp & 255u) == 0u) { if (xb_ld(&bar[XB_TMO])) break; if (sp > XB_SPIN_CAP) { atomicAdd(&bar[XB_TMO], 1u); break; } }
    }
    nloc = mine > 0u ? mine : 1u; nx = cnt > 0u ? cnt : 1u;
}
struct Args;
__device__ __forceinline__ bool convert_steal(const Args& a, int layer, LAS unsigned char* lds, int wave, int lane);
__device__ __forceinline__ void xcd_barrier(const XcdBarrier& b, const Args* bga = nullptr, int bg_layer = -1, LAS unsigned char* lds = nullptr) {
    asm volatile("s_waitcnt vmcnt(0)" ::: "memory");
    __syncthreads();
    if (threadIdx.x == 0) {
        unsigned* bar = b.bar;
        __builtin_amdgcn_s_waitcnt(0);
        unsigned nloc = b.st[0], nx = b.st[1];
        if (nloc == 0u) { xcd_barrier_complete(bar, b.x, nloc, nx); b.st[0] = nloc; b.st[1] = nx; }
        const unsigned old = xb_add(&bar[XB_XSUB(b.x)], 1u);
        const unsigned gen = old / nloc;
        if (old + 1u == (gen + 1u) * nloc) {
            __builtin_amdgcn_fence(__ATOMIC_RELEASE, "agent");
            asm volatile("s_waitcnt vmcnt(0)" ::: "memory");
            const unsigned og = xb_add(&bar[XB_TOP], 1u);
            const unsigned tg = og / nx;
            if (og + 1u == (tg + 1u) * nx) xb_add(&bar[XB_TOPGEN], 1u);
            else XB_SPIN(xb_ld(&bar[XB_TOPGEN]) == tg, bar);
            __builtin_amdgcn_fence(__ATOMIC_ACQUIRE, "agent");
            xb_add(&bar[XB_XGEN(b.x)], 1u);
            asm volatile("s_waitcnt vmcnt(0)" ::: "memory");
            b.st[2] = 0xFFFFFFFFu;
        } else if (bg_layer < 0) {
            XB_SPIN(xb_ld(&bar[XB_XGEN(b.x)]) == gen, bar);
            __builtin_amdgcn_fence(__ATOMIC_ACQUIRE, "agent");
            asm volatile("s_waitcnt vmcnt(0)" ::: "memory");
            b.st[2] = 0xFFFFFFFFu;
        } else b.st[2] = gen;
    }
    __syncthreads();
    if (bg_layer >= 0) {
        const unsigned gen = b.st[2];
        if (gen != 0xFFFFFFFFu) {
            const int lane = threadIdx.x & 63, wave = __builtin_amdgcn_readfirstlane(threadIdx.x >> 6);
            bool more = true;
            while (more && (unsigned)__builtin_amdgcn_readfirstlane((int)xb_ld(&b.bar[XB_XGEN(b.x)])) == gen) more = convert_steal(*bga, bg_layer, lds, wave, lane);
            asm volatile("s_waitcnt vmcnt(0)" ::: "memory");
            __syncthreads();
            if (threadIdx.x == 0) { XB_SPIN(xb_ld(&b.bar[XB_XGEN(b.x)]) == gen, b.bar); __builtin_amdgcn_fence(__ATOMIC_ACQUIRE, "agent"); asm volatile("s_waitcnt vmcnt(0)" ::: "memory"); }
        } else __syncthreads();
        __syncthreads();
    }
}

namespace pg8 {
constexpr int BM = 256, BK = 64, HALF = 128, HTB = HALF * BK * 2, STAGE_BYTES = 8 * HTB, NXCD = 8, WGM = 8;
__host__ __device__ __forceinline__ int lds_byte(int r, int c) { const int st = (r >> 4) * 2 + (c >> 5), rr = r & 15, cc = c & 31, ob = rr * 64 + cc * 2; return st * 1024 + (ob ^ (((ob >> 9) & 1) << 5)); }
__host__ __device__ __forceinline__ void stage_rc(int b, int& R, int& C) { const int st = b / 1024, sb = b % 1024, swz = sb ^ (((sb >> 9) & 1) << 5); R = (st >> 1) * 16 + swz / 64; C = (st & 1) * 32 + (swz % 64) / 2; }
__host__ __device__ __forceinline__ int perm32(int rho) { const int n = rho >> 4, i = rho & 15; return 8 * (i >> 2) + 4 * n + (i & 3); }

typedef int v8i __attribute__((ext_vector_type(8)));
typedef int v4i __attribute__((ext_vector_type(4)));
__device__ __forceinline__ v8i cat8(bf16x8 lo, bf16x8 hi) { const v4i a = __builtin_bit_cast(v4i, lo), b = __builtin_bit_cast(v4i, hi); return __builtin_shufflevector(a, b, 0, 1, 2, 3, 4, 5, 6, 7); }
struct Unit { const char* A; const char* B; const unsigned* gat; int nvalid; int i0, i1, i2; };

template <class Epi, class Sched, bool GATHER, bool ALIGN_EPI, bool SP2, int BMODE = 0, int F8 = 0>
__device__ __forceinline__ void gemm_phase(LAS unsigned char* lds, const unsigned lda, const unsigned ldb, const int nt, const Sched& S, const Epi& E) {
    const int tid = threadIdx.x, wid = __builtin_amdgcn_readfirstlane(tid >> 6), lane = tid & 63, wr = wid >> 2, wc = wid & 3, fr = lane & 15, fq = lane >> 4;
    int R0, C0, R1, C1; stage_rc(tid * 16, R0, C0); stage_rc(tid * 16 + 8192, R1, C1);
    const int Rb0 = BMODE == 0 ? (R0 & ~31) + perm32(R0 & 31) : 64 * (R0 >> 5) + 16 * ((R0 & 15) >> 2) + 4 * ((R0 >> 4) & 1) + (R0 & 3);
    const int Rb1 = BMODE == 0 ? (R1 & ~31) + perm32(R1 & 31) : 64 * (R1 >> 5) + 16 * ((R1 & 15) >> 2) + 4 * ((R1 >> 4) & 1) + (R1 & 3);
    const unsigned voffB0 = (unsigned)Rb0 * ldb + (unsigned)C0 * 2u, voffB1 = (unsigned)Rb1 * ldb + (unsigned)C1 * 2u;
    const size_t hstepB = (size_t)(BMODE == 0 ? HALF : 8) * ldb;
    const size_t kstep = (size_t)(BK * 2);
    const unsigned ldsw = (unsigned)wid * 1024u;
    const int aoff = lds_byte(wr * 64 + fr, F8 ? fq * 16 : fq * 8), boff = lds_byte(wc * 32 + fr, F8 ? fq * 16 : fq * 8);
    const int aoff2 = F8 ? lds_byte(wr * 64 + fr, fq * 16 + 8) : aoff + 1024, boff2 = F8 ? lds_byte(wc * 32 + fr, fq * 16 + 8) : boff + 1024;
#define PG8_SA(b, h) (((b) * 2 + (h)) * HTB)
#define PG8_SB(b, h) ((4 + (b) * 2 + (h)) * HTB)
#define PG8_STAGE(bufoff, gbase, v0, v1) do { unsigned _v0 = (v0), _v1 = (v1); asm volatile("" : "+v"(_v0), "+v"(_v1)); \
        __builtin_amdgcn_global_load_lds((const unsigned*)((const char*)(gbase) + _v0), (LAS unsigned*)(lds + (bufoff) + ldsw), 16, 0, 0); \
        __builtin_amdgcn_global_load_lds((const unsigned*)((const char*)(gbase) + _v1), (LAS unsigned*)(lds + (bufoff) + ldsw + 8192), 16, 0, 0); } while (0)
#define PG8_LDA(dst, b, h) do { _Pragma("unroll") for (int m = 0; m < 4; ++m) { dst[m][0] = *(const LAS bf16x8*)(lds + PG8_SA(b, h) + aoff + m * 2048); dst[m][1] = *(const LAS bf16x8*)(lds + PG8_SA(b, h) + aoff2 + m * 2048); } } while (0)
#define PG8_LDB(dst, b, h) do { _Pragma("unroll") for (int n = 0; n < 2; ++n) { dst[n][0] = *(const LAS bf16x8*)(lds + PG8_SB(b, h) + boff + n * 2048); dst[n][1] = *(const LAS bf16x8*)(lds + PG8_SB(b, h) + boff2 + n * 2048); } } while (0)
#define PG8_MMA(ai, bj, At, Bt) do { __builtin_amdgcn_s_setprio(1); _Pragma("unroll") for (int m = 0; m < 4; ++m) _Pragma("unroll") for (int n = 0; n < 2; ++n) { \
        if constexpr (F8) acc[ai][bj][m][n] = __builtin_amdgcn_mfma_scale_f32_16x16x128_f8f6f4(cat8(Bt[n][0], Bt[n][1]), cat8(At[m][0], At[m][1]), acc[ai][bj][m][n], 0, 0, 0, 0x7F7F7F7F, 0, 0x7F7F7F7F); \
        else { _Pragma("unroll") for (int k = 0; k < 2; ++k) acc[ai][bj][m][n] = __builtin_amdgcn_mfma_f32_16x16x32_bf16(Bt[n][k], At[m][k], acc[ai][bj][m][n], 0, 0, 0); } } __builtin_amdgcn_s_setprio(0); } while (0)
#define PG8_WAIT_V(n) asm volatile("s_waitcnt vmcnt(" #n ")" ::: "memory")
#define PG8_WAIT_L(n) asm volatile("s_waitcnt lgkmcnt(" #n ")" ::: "memory")
#define PG8_BAR __builtin_amdgcn_s_barrier()
#define PG8_SCHED __builtin_amdgcn_sched_barrier(0)
#define PG8_SETV(v00, v01, v10, v11, u) do { \
        if (GATHER) { int _t = tid; asm volatile("" : "+v"(_t)); int r0, c0, r1, c1; stage_rc(_t * 16, r0, c0); stage_rc(_t * 16 + 8192, r1, c1);     \
            const unsigned ta = r0 < (u).nvalid ? (u).gat[r0] : 0u, tb = r1 < (u).nvalid ? (u).gat[r1] : 0u, \
                                     tc = (HALF + r0) < (u).nvalid ? (u).gat[HALF + r0] : 0u, td = (HALF + r1) < (u).nvalid ? (u).gat[HALF + r1] : 0u; \
            v00 = ta * lda + (unsigned)c0 * 2u; v01 = tb * lda + (unsigned)c1 * 2u; v10 = tc * lda + (unsigned)c0 * 2u; v11 = td * lda + (unsigned)c1 * 2u; } \
        else { v00 = (unsigned)R0 * lda + (unsigned)C0 * 2u; v01 = (unsigned)R1 * lda + (unsigned)C1 * 2u; v10 = (unsigned)(HALF + R0) * lda + (unsigned)C0 * 2u; v11 = (unsigned)(HALF + R1) * lda + (unsigned)C1 * 2u; } } while (0)
    Unit cur, nxt; int ui = 0;
    if (!S.next(0, cur)) return;
    f32x4 acc[2][2][4][2];
#pragma unroll
    for (int a = 0; a < 2; ++a)
#pragma unroll
        for (int b = 0; b < 2; ++b)
#pragma unroll
            for (int m = 0; m < 4; ++m)
#pragma unroll
                for (int n = 0; n < 2; ++n) acc[a][b][m][n] = (f32x4){0.f, 0.f, 0.f, 0.f};
    bf16x8 At[4][2], B0[2][2], B1[2][2];
    const char* cA = cur.A; const char* cB = cur.B;
    unsigned cv00, cv01, cv10, cv11;
    PG8_SETV(cv00, cv01, cv10, cv11, cur);
    if constexpr (SP2) {
        PG8_STAGE(PG8_SB(0, 0), cB, voffB0, voffB1); PG8_STAGE(PG8_SB(0, 1), cB + hstepB, voffB0, voffB1); PG8_STAGE(PG8_SA(0, 0), cA, cv00, cv01); PG8_STAGE(PG8_SA(0, 1), cA, cv10, cv11);
        if (wr == 1) PG8_BAR;
        PG8_WAIT_V(2); PG8_BAR;
        PG8_STAGE(PG8_SB(1, 0), cB + kstep, voffB0, voffB1); PG8_STAGE(PG8_SA(1, 0), cA + kstep, cv00, cv01); PG8_STAGE(PG8_SB(1, 1), cB + hstepB + kstep, voffB0, voffB1);
        PG8_WAIT_V(6); PG8_BAR;
    } else {
        PG8_STAGE(PG8_SB(0, 0), cB, voffB0, voffB1); PG8_STAGE(PG8_SA(0, 0), cA, cv00, cv01); PG8_STAGE(PG8_SB(0, 1), cB + hstepB, voffB0, voffB1); PG8_STAGE(PG8_SA(0, 1), cA, cv10, cv11);
        if (wr == 1) PG8_BAR;
        PG8_WAIT_V(4); PG8_BAR;
        PG8_STAGE(PG8_SB(1, 0), cB + kstep, voffB0, voffB1); PG8_STAGE(PG8_SA(1, 0), cA + kstep, cv00, cv01); PG8_STAGE(PG8_SB(1, 1), cB + hstepB + kstep, voffB0, voffB1);
        PG8_WAIT_V(6); PG8_BAR;
    }
    for (;;) {
        const bool has_next = S.next(ui + 1, nxt);
        const char* nA = has_next ? nxt.A : cA; const char* nB = has_next ? nxt.B : cB;
#pragma unroll 1
        for (int t = 0; t < nt; t += 2) {
            const bool last = (t == nt - 2);
            const char* a1 = cA + (size_t)(t + 1) * kstep;
            const char* a2 = last ? nA : cA + (size_t)(t + 2) * kstep; const char* b2 = last ? nB : cB + (size_t)(t + 2) * kstep;
            const char* a3 = a2 + kstep; const char* b3 = b2 + kstep;
            if constexpr (SP2) {
            PG8_LDB(B0, 0, 0); PG8_LDB(B1, 0, 1); PG8_SCHED; PG8_LDA(At, 0, 0); PG8_STAGE(PG8_SA(1, 1), a1, cv10, cv11);
            PG8_WAIT_V(8); PG8_WAIT_L(0); PG8_BAR; PG8_MMA(0, 0, At, B0); PG8_MMA(0, 1, At, B1); PG8_BAR; PG8_SCHED;
            if constexpr (GATHER) { if (last && has_next) { PG8_SETV(cv00, cv01, cv10, cv11, nxt); } }
            PG8_LDA(At, 0, 1); PG8_STAGE(PG8_SB(0, 0), b2, voffB0, voffB1); PG8_STAGE(PG8_SB(0, 1), b2 + hstepB, voffB0, voffB1); PG8_STAGE(PG8_SA(0, 0), a2, cv00, cv01);
            PG8_WAIT_V(8); PG8_WAIT_L(0); PG8_BAR; PG8_MMA(1, 0, At, B0); PG8_MMA(1, 1, At, B1); PG8_BAR; PG8_SCHED;
            PG8_LDB(B0, 1, 0); PG8_LDB(B1, 1, 1); PG8_SCHED; PG8_LDA(At, 1, 0); PG8_STAGE(PG8_SA(0, 1), a2, cv10, cv11);
            PG8_WAIT_V(8); PG8_WAIT_L(0); PG8_BAR; PG8_MMA(0, 0, At, B0); PG8_MMA(0, 1, At, B1); PG8_BAR; PG8_SCHED;
            PG8_LDA(At, 1, 1); PG8_STAGE(PG8_SB(1, 0), b3, voffB0, voffB1); PG8_STAGE(PG8_SB(1, 1), b3 + hstepB, voffB0, voffB1); PG8_STAGE(PG8_SA(1, 0), a3, cv00, cv01);
            PG8_WAIT_V(8); PG8_WAIT_L(0); PG8_BAR; PG8_MMA(1, 0, At, B0); PG8_MMA(1, 1, At, B1); PG8_BAR; PG8_SCHED;
            } else {
            PG8_LDB(B0, 0, 0); PG8_SCHED; PG8_LDA(At, 0, 0); PG8_STAGE(PG8_SA(1, 1), a1, cv10, cv11);
            PG8_WAIT_L(8); PG8_BAR; PG8_WAIT_L(0); PG8_MMA(0, 0, At, B0); PG8_BAR; PG8_SCHED;
            if constexpr (GATHER) { if (last && has_next) { PG8_SETV(cv00, cv01, cv10, cv11, nxt); } }
            PG8_LDB(B1, 0, 1); PG8_STAGE(PG8_SB(0, 0), b2, voffB0, voffB1);
            PG8_BAR; PG8_WAIT_L(0); PG8_MMA(0, 1, At, B1); PG8_BAR;
            PG8_LDA(At, 0, 1); PG8_STAGE(PG8_SA(0, 0), a2, cv00, cv01);
            PG8_BAR; PG8_WAIT_L(0); PG8_MMA(1, 0, At, B0); PG8_BAR; PG8_SCHED;
            PG8_STAGE(PG8_SB(0, 1), b2 + hstepB, voffB0, voffB1);
            PG8_WAIT_V(6); PG8_BAR; PG8_MMA(1, 1, At, B1); PG8_BAR;
            PG8_LDB(B0, 1, 0); PG8_SCHED; PG8_LDA(At, 1, 0); PG8_STAGE(PG8_SA(0, 1), a2, cv10, cv11);
            PG8_WAIT_L(8); PG8_BAR; PG8_WAIT_L(0); PG8_MMA(0, 0, At, B0); PG8_BAR; PG8_SCHED;
            PG8_LDB(B1, 1, 1); PG8_STAGE(PG8_SB(1, 0), b3, voffB0, voffB1);
            PG8_BAR; PG8_WAIT_L(0); PG8_MMA(0, 1, At, B1); PG8_BAR;
            PG8_LDA(At, 1, 1); PG8_STAGE(PG8_SA(1, 0), a3, cv00, cv01);
            PG8_BAR; PG8_WAIT_L(0); PG8_MMA(1, 0, At, B0); PG8_BAR; PG8_SCHED;
            PG8_STAGE(PG8_SB(1, 1), b3 + hstepB, voffB0, voffB1);
            PG8_WAIT_V(6); PG8_BAR; PG8_MMA(1, 1, At, B1); PG8_BAR;
            }
        }
        if constexpr (ALIGN_EPI) { if (wr == 0) PG8_BAR; }
        E(acc, cur, wr, wc, fr, fq);
        if (!has_next) break;
#pragma unroll
        for (int a = 0; a < 2; ++a)
#pragma unroll
            for (int b = 0; b < 2; ++b)
#pragma unroll
                for (int m = 0; m < 4; ++m)
#pragma unroll
                    for (int n = 0; n < 2; ++n) acc[a][b][m][n] = (f32x4){0.f, 0.f, 0.f, 0.f};
        cur = nxt; cA = nA; cB = nB; ++ui;
        if constexpr (ALIGN_EPI) { if (wr == 1) PG8_BAR; }
    }
    PG8_WAIT_V(0);
    if constexpr (!ALIGN_EPI) { if (wr == 0) PG8_BAR; }
    PG8_BAR;
#undef PG8_SA
#undef PG8_SB
#undef PG8_STAGE
#undef PG8_LDA
#undef PG8_LDB
#undef PG8_MMA
#undef PG8_WAIT_V
#undef PG8_WAIT_L
#undef PG8_BAR
#undef PG8_SCHED
#undef PG8_SETV
}

struct DenseSched {
    const char* A; const char* B; unsigned lda, ldb, a_pn; int nM, nN, nwg, G, c;
    __device__ __forceinline__ bool next(int i, Unit& u) const {
        const long L = (long)i * G + c; if (L >= nwg) return false;
        int wgid = (int)L; { const int q = nwg / NXCD, r = nwg % NXCD, xcd = wgid % NXCD, off = wgid / NXCD; wgid = (xcd < r ? xcd * (q + 1) : r * (q + 1) + (xcd - r) * q) + off; }
        const int nig = WGM * nN, gid = wgid / nig, fm = gid * WGM, gsz = (nM - fm) < WGM ? (nM - fm) : WGM;
        const int pm = fm + ((wgid % nig) % gsz), pn = (wgid % nig) / gsz;
        u.A = A + (size_t)pm * BM * lda + (size_t)pn * a_pn; u.B = B + (size_t)pn * BM * ldb; u.gat = nullptr; u.nvalid = BM; u.i0 = pm; u.i1 = pn; u.i2 = 0; return true;
    }
};
struct MoeInfo { const LAS unsigned* cnt; const LAS unsigned* tstart; const LAS unsigned* ystart; const LAS unsigned char* tile_e; int ntiles; };
struct G1Sched {
    MoeInfo mi; const char* XB; const char* Wgu; const unsigned* rowtok; const unsigned* ident; int G, vcu;
    __device__ __forceinline__ bool next(int i, Unit& u) const {
        const int L = i * G + vcu; if (L >= 2 * mi.ntiles) return false;
        const int tile = L >> 1, uu = L & 1; int e;
        if (tile < 64) { e = 64; u.gat = ident + tile * 256; u.nvalid = 256; }
        else { e = __builtin_amdgcn_readfirstlane((int)mi.tile_e[tile]); const int pos0 = (tile - __builtin_amdgcn_readfirstlane((int)mi.tstart[e])) * 256; u.gat = rowtok + (size_t)e * CAP + pos0; const int rem = __builtin_amdgcn_readfirstlane((int)mi.cnt[e]) - pos0; u.nvalid = rem < 256 ? rem : 256; }
        u.A = XB; u.B = Wgu + ((size_t)e * 512 + (size_t)uu * 256) * 1024; u.i0 = tile; u.i1 = uu; u.i2 = 0; return true;
    }
};
struct G2Sched {
    MoeInfo mi; const char* H; const char* Wd; int G, vcu, L0;
    __device__ __forceinline__ bool next(int i, Unit& u) const {
        const int L = i * G + vcu + L0; if (L >= 4 * mi.ntiles) return false;
        const int tile = L >> 2, pn = L & 3; int e;
        if (tile < 64) { e = 64; u.i0 = 131072 + tile * 256; u.i2 = 0; u.nvalid = 256; }
        else { e = __builtin_amdgcn_readfirstlane((int)mi.tile_e[tile]); const int pos0 = (tile - __builtin_amdgcn_readfirstlane((int)mi.tstart[e])) * 256; u.i0 = __builtin_amdgcn_readfirstlane((int)mi.ystart[e]) + pos0; u.i2 = 0; const int rem = __builtin_amdgcn_readfirstlane((int)mi.cnt[e]) - pos0; u.nvalid = rem < 256 ? rem : 256; }
        u.A = H + (size_t)tile * 256 * 256; u.B = Wd + ((size_t)e * 1024 + (size_t)pn * 256) * 256; u.gat = nullptr; u.i1 = pn; return true;
    }
};

template <int ACT, bool BIAS, bool SCALE> struct EpiBf16 {
    bf16* O; int ldo; const float* bias; const float* scale;
    __device__ __forceinline__ void operator()(const f32x4 (&acc)[2][2][4][2], const Unit& u, int wr, int wc, int fr, int fq) const {
        const int row0 = u.i0 * BM + wr * 64 + fr, col0 = u.i1 * BM + wc * 32 + 8 * fq;
        f32x4 bv[2][2], sv[2][2];
#pragma unroll
        for (int bj = 0; bj < 2; ++bj)
#pragma unroll
            for (int n = 0; n < 2; ++n) { bv[bj][n] = BIAS ? *(const f32x4*)(bias + col0 + bj * HALF + 4 * n) : (f32x4){0.f, 0.f, 0.f, 0.f}; sv[bj][n] = SCALE ? *(const f32x4*)(scale + col0 + bj * HALF + 4 * n) : (f32x4){1.f, 1.f, 1.f, 1.f}; }
#pragma unroll
        for (int ai = 0; ai < 2; ++ai)
#pragma unroll
            for (int m = 0; m < 4; ++m) { bf16* rowp = O + (size_t)(row0 + ai * HALF + m * 16) * ldo + col0;
#pragma unroll
                for (int bj = 0; bj < 2; ++bj) { f32x4 v0 = acc[ai][bj][m][0] + bv[bj][0], v1 = acc[ai][bj][m][1] + bv[bj][1];
                    if (ACT == 1) {
#pragma unroll
                        for (int j = 0; j < 4; ++j) { v0[j] = gelu_tanh(v0[j]); v1[j] = gelu_tanh(v1[j]); } }
                    if (SCALE) { v0 = v0 * sv[bj][0]; v1 = v1 * sv[bj][1]; }
                    v4u w; w.x = cvt_pk_bf16(v0[0], v0[1]); w.y = cvt_pk_bf16(v0[2], v0[3]); w.z = cvt_pk_bf16(v1[0], v1[1]); w.w = cvt_pk_bf16(v1[2], v1[3]);
                    *(v4u*)(rowp + bj * HALF) = w; } }
    }
};
struct EpiResid {
    const float* base; float* out;
    __device__ __forceinline__ void operator()(const f32x4 (&acc)[2][2][4][2], const Unit& u, int wr, int wc, int fr, int fq) const {
        const int row0 = u.i0 * BM + wr * 64 + fr, col0 = u.i1 * BM + wc * 32 + 8 * fq;
#pragma unroll
        for (int ai = 0; ai < 2; ++ai)
#pragma unroll
            for (int m = 0; m < 4; ++m) { const size_t off = (size_t)(row0 + ai * HALF + m * 16) * DM + col0;
#pragma unroll
                for (int bj = 0; bj < 2; ++bj) { const f32x4 b0 = *(const f32x4*)(base + off + bj * HALF), b1 = *(const f32x4*)(base + off + bj * HALF + 4);
                    *(f32x4*)(out + off + bj * HALF) = b0 * ALPHA + acc[ai][bj][m][0]; *(f32x4*)(out + off + bj * HALF + 4) = b1 * ALPHA + acc[ai][bj][m][1]; }
                asm volatile("" ::: "memory"); }
    }
};
struct EpiSwiglu {
    unsigned char* H8;
    __device__ __forceinline__ void operator()(const f32x4 (&acc)[2][2][4][2], const Unit& u, int wr, int wc, int fr, int fq) const {
        const int row0 = u.i0 * BM + wr * 64 + fr, col0 = u.i1 * HALF + wc * 32 + 8 * fq;
#pragma unroll
        for (int ai = 0; ai < 2; ++ai)
#pragma unroll
            for (int m = 0; m < 4; ++m) { unsigned char* rowp = H8 + (size_t)(row0 + ai * HALF + m * 16) * EDIM + col0; float h[8];
#pragma unroll
                for (int n = 0; n < 2; ++n)
#pragma unroll
                    for (int j = 0; j < 4; ++j) { const float g = acc[ai][0][m][n][j] * 0.03125f, up = acc[ai][1][m][n][j] * 0.25f; h[4 * n + j] = g * sigmoidf_(g) * up; }
                int t0 = 0, t1 = 0; t0 = __builtin_amdgcn_cvt_pk_fp8_f32(h[0], h[1], t0, false); t0 = __builtin_amdgcn_cvt_pk_fp8_f32(h[2], h[3], t0, true); t1 = __builtin_amdgcn_cvt_pk_fp8_f32(h[4], h[5], t1, false); t1 = __builtin_amdgcn_cvt_pk_fp8_f32(h[6], h[7], t1, true);
                *(v2u*)rowp = (v2u){(unsigned)t0, (unsigned)t1}; }
    }
};
struct EpiDown {
    unsigned char* Y8;
    __device__ __forceinline__ void operator()(const f32x4 (&acc)[2][2][4][2], const Unit& u, int wr, int wc, int fr, int fq) const {
        const int r0 = wr * 64 + fr, col0 = u.i1 * BM + wc * 64 + 16 * fq;
#pragma unroll
        for (int ai = 0; ai < 2; ++ai)
#pragma unroll
            for (int m = 0; m < 4; ++m) { const int r = r0 + ai * HALF + m * 16;
                if (r < u.nvalid) { v4u w;
#pragma unroll
                    for (int q = 0; q < 4; ++q) { const f32x4 v = acc[ai][q >> 1][m][q & 1] * 0.0625f;     int t = 0; t = __builtin_amdgcn_cvt_pk_fp8_f32(v[0], v[1], t, false); t = __builtin_amdgcn_cvt_pk_fp8_f32(v[2], v[3], t, true); w[q] = (unsigned)t; }
                    *(v4u*)(Y8 + (size_t)(u.i0 + r) * DM + col0) = w; } }
    }
};
}

struct Args { const float* in[24]; float* out; unsigned char* ws; int ph_lo, ph_hi; };
enum { I_X = 0, I_PWIN, I_PWGRP, I_PSCALE, I_PWOUT, I_SWIN, I_SBIN, I_SLNG, I_SLNB, I_SWS, I_SBS, I_SWOUT, I_LNMG, I_LNMB, I_WR, I_RB, I_WG, I_WU, I_WD, I_SHG, I_SHU, I_SHD, I_LNFG, I_LNFB };

__device__ __forceinline__ void tr_item(const float* W, int N, int k0, int n0, bf16* dst  , int dpitch, LAS float* scr, int lane) {
#pragma unroll 8
    for (int i = 0; i < 32; ++i) { const int kk = 2 * i + (lane >> 5); scr[kk * 33 + (lane & 31)] = W[(size_t)(k0 + kk) * N + n0 + (lane & 31)]; }
    LDS_WAIT(); asm volatile("" ::: "memory");
    const int c = lane & 7;
#pragma unroll
    for (int j = 0; j < 4; ++j) { const int n = (lane >> 3) + 8 * j; const LAS float* s = scr + (8 * c) * 33 + n;
        v4u o; o.x = cvt_pk_bf16(s[0 * 33], s[1 * 33]); o.y = cvt_pk_bf16(s[2 * 33], s[3 * 33]); o.z = cvt_pk_bf16(s[4 * 33], s[5 * 33]); o.w = cvt_pk_bf16(s[6 * 33], s[7 * 33]);
        *(v4u*)(dst + (size_t)n * dpitch + 8 * c) = o; }
    LDS_WAIT(); asm volatile("" ::: "memory");
}
__device__ __forceinline__ void tr_item_f8(const float* W, int N, int k0, int n0, unsigned char* dst, int dpitch, float scale, LAS float* scr, int lane) {
#pragma unroll 8
    for (int i = 0; i < 32; ++i) { const int kk = 2 * i + (lane >> 5); scr[kk * 33 + (lane & 31)] = W[(size_t)(k0 + kk) * N + n0 + (lane & 31)]; }
    LDS_WAIT(); asm volatile("" ::: "memory");
    const int c = lane & 7;
#pragma unroll
    for (int j = 0; j < 4; ++j) { const int n = (lane >> 3) + 8 * j; const LAS float* s = scr + (8 * c) * 33 + n;
        int t0 = 0, t1 = 0;
        t0 = __builtin_amdgcn_cvt_pk_fp8_f32(s[0 * 33] * scale, s[1 * 33] * scale, t0, false); t0 = __builtin_amdgcn_cvt_pk_fp8_f32(s[2 * 33] * scale, s[3 * 33] * scale, t0, true);
        t1 = __builtin_amdgcn_cvt_pk_fp8_f32(s[4 * 33] * scale, s[5 * 33] * scale, t1, false); t1 = __builtin_amdgcn_cvt_pk_fp8_f32(s[6 * 33] * scale, s[7 * 33] * scale, t1, true);
        *(v2u*)(dst + (size_t)n * dpitch + 8 * c) = (v2u){(unsigned)t0, (unsigned)t1}; }
    LDS_WAIT(); asm volatile("" ::: "memory");
}
__device__ __forceinline__ void tr_item_hilo(const float* W, int N, int k0, int n0, bf16* dh, bf16* dl, int dpitch, LAS float* scr, int lane) {
#pragma unroll 8
    for (int i = 0; i < 32; ++i) { const int kk = 2 * i + (lane >> 5); scr[kk * 33 + (lane & 31)] = W[(size_t)(k0 + kk) * N + n0 + (lane & 31)]; }
    LDS_WAIT(); asm volatile("" ::: "memory");
    const int c = lane & 7;
#pragma unroll
    for (int j = 0; j < 4; ++j) { const int n = (lane >> 3) + 8 * j; const LAS float* s = scr + (8 * c) * 33 + n; float w[8];
#pragma unroll
        for (int z = 0; z < 8; ++z) w[z] = s[z * 33];
        v4u o; o.x = cvt_pk_bf16(w[0], w[1]); o.y = cvt_pk_bf16(w[2], w[3]); o.z = cvt_pk_bf16(w[4], w[5]); o.w = cvt_pk_bf16(w[6], w[7]);
        v4u l; l.x = cvt_pk_bf16(w[0] - bf_lo(o.x), w[1] - bf_hi(o.x)); l.y = cvt_pk_bf16(w[2] - bf_lo(o.y), w[3] - bf_hi(o.y)); l.z = cvt_pk_bf16(w[4] - bf_lo(o.z), w[5] - bf_hi(o.z)); l.w = cvt_pk_bf16(w[6] - bf_lo(o.w), w[7] - bf_hi(o.w));
        *(v4u*)(dh + (size_t)n * dpitch + 8 * c) = o; *(v4u*)(dl + (size_t)n * dpitch + 8 * c) = l; }
    LDS_WAIT(); asm volatile("" ::: "memory");
}
constexpr int MOE_ITEMS = 65 * 384;
__device__ __forceinline__ void convert_moe_item(const Args& a, int layer, int it, LAS float* scr, int lane) {
    bf16* WGU = (bf16*)(a.ws + WS_WGU + (size_t)layer * WS_MOE_LSTRIDE); bf16* WDN = (bf16*)(a.ws + WS_WDN + (size_t)layer * WS_MOE_LSTRIDE);
    const int e = it / 384, r = it % 384;
    if (r < 256) { const int isup = r >> 7, rr = r & 127, kb = rr >> 3, nb = rr & 7, n0 = 32 * nb, k0 = 64 * kb;
        const float* src = (e < 64) ? a.in[isup ? I_WU : I_WG] + ((size_t)layer * 64 + e) * 262144 : a.in[isup ? I_SHU : I_SHG] + (size_t)layer * 262144;
        const int drow = e * 512 + (n0 >> 7) * 256 + isup * 128 + (n0 & 127);
        tr_item_f8(src, 256, k0, n0, (unsigned char*)WGU + (size_t)drow * 1024 + k0, 1024, 32.0f, scr, lane);
    } else { const int rr = r - 256, kb = rr >> 5, nb = rr & 31, n0 = 32 * nb, k0 = 64 * kb;
        const float* src = (e < 64) ? a.in[I_WD] + ((size_t)layer * 64 + e) * 262144 : a.in[I_SHD] + (size_t)layer * 262144;
        tr_item_f8(src, 1024, k0, n0, (unsigned char*)WDN + ((size_t)e * 1024 + n0) * 256 + k0, 256, 32.0f, scr, lane);
    }
}
constexpr int Q_SHARDS = 8, Q_PER_SHARD = MOE_ITEMS / Q_SHARDS;
static_assert(Q_PER_SHARD * Q_SHARDS == MOE_ITEMS, "queue shards");
template <int CHUNK> __device__ __forceinline__ bool convert_steal_n(const Args& a, int layer, LAS unsigned char* lds, int wave, int lane) {
    unsigned* q = (unsigned*)(a.ws + WS_CTL) + CW_QNEXT + 512 * layer;
    const int s0 = (int)(blockIdx.x & 7);
    for (int s = 0; s < Q_SHARDS; ++s) { const int sh = (s0 + s) & 7;
        unsigned it = 0; if (lane == 0) it = __hip_atomic_fetch_add(q + 64 * sh, (unsigned)CHUNK, RLX_AGENT);
        it = (unsigned)__builtin_amdgcn_readfirstlane((int)it);
        if (it < (unsigned)Q_PER_SHARD) {
            for (int c = 0; c < CHUNK; ++c) if (it + c < (unsigned)Q_PER_SHARD) convert_moe_item(a, layer, sh * Q_PER_SHARD + (int)it + c, (LAS float*)(lds + wave * 16384), lane);
            return true; } }
    return false;
}
__device__ __forceinline__ bool convert_steal(const Args& a, int layer, LAS unsigned char* lds, int wave, int lane) { return convert_steal_n<1>(a, layer, lds, wave, lane); }
__device__ __forceinline__ void convert_static(const Args& a, int layer, LAS unsigned char* lds, int vcu, int G) {
    const int lane = threadIdx.x & 63, wave = __builtin_amdgcn_readfirstlane(threadIdx.x >> 6);
    for (int it = vcu * NWAVES + wave; it < MOE_ITEMS; it += G * NWAVES) convert_moe_item(a, layer, it, (LAS float*)(lds + wave * 16384), lane);
}
__device__ __forceinline__ void convert_drain(const Args& a, int layer, LAS unsigned char* lds) {
    const int lane = threadIdx.x & 63, wave = __builtin_amdgcn_readfirstlane(threadIdx.x >> 6);
    while (convert_steal_n<4>(a, layer, lds, wave, lane)) {}
    __syncthreads();
}
__device__ __forceinline__ void phase_p0(const Args& a, LAS unsigned char* lds, int vcu, int G) {
    const int tid = threadIdx.x, lane = tid & 63, wave = __builtin_amdgcn_readfirstlane(tid >> 6);
    const int gw = vcu * NWAVES + wave, NGW = G * NWAVES;
    LAS float* scr = (LAS float*)(lds + wave * 16384);
    constexpr int I_IN = 16 * 32, I_GRP = 4 * 4 * 8, I_OUT = 16 * 32, I_SIN = 16 * 128, I_SOUT = 32 * 32, NIT = I_IN + I_GRP + I_OUT + I_SIN + I_SOUT;
    for (int it = gw; it < NIT; it += NGW) {
        int r = it;
        if (r < I_IN) { const int kb = r >> 5, nb = r & 31; tr_item(a.in[I_PWIN], 1024, 64 * kb, 32 * nb, (bf16*)(a.ws + WS_WIN) + (size_t)(32 * nb) * 1024 + 64 * kb, 1024, scr, lane); continue; } r -= I_IN;
        if (r < I_GRP) { const int g = r >> 5, rr = r & 31, kb = rr >> 3, nb = rr & 7; tr_item(a.in[I_PWGRP] + (size_t)g * 65536, 256, 64 * kb, 32 * nb, (bf16*)(a.ws + WS_WGRP) + (size_t)(g * 256 + 32 * nb) * 256 + 64 * kb, 256, scr, lane); continue; } r -= I_GRP;
        if (r < I_OUT) { const int kb = r >> 5, nb = r & 31; tr_item(a.in[I_PWOUT], 1024, 64 * kb, 32 * nb, (bf16*)(a.ws + WS_WOUT) + (size_t)(32 * nb) * 1024 + 64 * kb, 1024, scr, lane); continue; } r -= I_OUT;
        if (r < I_SIN) { const int kb = r >> 7, nb = r & 127; tr_item(a.in[I_SWIN], 4096, 64 * kb, 32 * nb, (bf16*)(a.ws + WS_WSIN) + (size_t)(32 * nb) * 1024 + 64 * kb, 1024, scr, lane); continue; } r -= I_SIN;
        { const int kb = r >> 5, nb = r & 31; tr_item(a.in[I_SWOUT], 1024, 64 * kb, 32 * nb, (bf16*)(a.ws + WS_WSOUT) + (size_t)(32 * nb) * 2048 + 64 * kb, 2048, scr, lane); }
    }
    for (int it = gw; it < 64; it += NGW) { const int layer = it >> 5, rr = it & 31, kb = rr >> 1, nb = rr & 1; bf16* base = (bf16*)(a.ws + WS_WRT) + (size_t)layer * 2 * 65536 + (size_t)(32 * nb) * 1024 + 64 * kb;
        tr_item_hilo(a.in[I_WR] + (size_t)layer * DM * NE, 64, 64 * kb, 32 * nb, base, base + 65536, 1024, scr, lane); }
    convert_static(a, 0, lds, vcu, G);
    const float* x = a.in[I_X]; bf16* xb = (bf16*)(a.ws + WS_XB);
    const size_t gt = (size_t)vcu * NTHR + tid, NT = (size_t)G * NTHR;
    for (size_t i = gt; i < (size_t)T_TOK * DM / 8; i += NT) { const f32x4 p = *(const f32x4*)(x + i * 8), q = *(const f32x4*)(x + i * 8 + 4);
        v4u w; w.x = cvt_pk_bf16(p[0], p[1]); w.y = cvt_pk_bf16(p[2], p[3]); w.z = cvt_pk_bf16(q[0], q[1]); w.w = cvt_pk_bf16(q[2], q[3]); *(v4u*)(xb + i * 8) = w; }
    unsigned* ident = (unsigned*)(a.ws + WS_IDENT);
    for (size_t i = gt; i < (size_t)T_TOK; i += NT) ident[i] = (unsigned)i;
}

template <int W> __device__ __forceinline__ void pool_item(const bf16* zp  , bf16* op  , int p0  ) {
    v4u q[W + 3];
#pragma unroll
    for (int i = 0; i < W + 3; ++i) { const int ii = i < p0 + 3 ? i : p0 + 3; q[i] = *(const v4u*)(zp - (size_t)ii * DM); }
#pragma unroll
    for (int o = 0; o < 4; ++o) {
        float s[8];
#pragma unroll
        for (int j = 0; j < 8; ++j) s[j] = 0.f;
#pragma unroll
        for (int i = 3 - o; i < 3 - o + W; ++i) { const float m = (i <= p0 + 3) ? 1.0f : 0.0f;
#pragma unroll
            for (int j = 0; j < 4; ++j) { s[2 * j] += m * bf_lo(q[i][j]); s[2 * j + 1] += m * bf_hi(q[i][j]); } }
        const int p = p0 + o, nw = (p + 1) < W ? (p + 1) : W; const float inv = 1.0f / (float)nw; v4u ov;
#pragma unroll
        for (int j = 0; j < 4; ++j) ov[j] = cvt_pk_bf16(s[2 * j] * inv - bf_lo(q[3 - o][j]), s[2 * j + 1] * inv - bf_hi(q[3 - o][j]));
        *(v4u*)(op + (size_t)o * DM) = ov; }
}
__device__ __forceinline__ void pool_block(const Args& a, int pm, int g) {
    const bf16* Z = (const bf16*)(a.ws + WS_Z); bf16* P = (bf16*)(a.ws + WS_POOLED);
    const int tid = threadIdx.x;
#pragma unroll 1
    for (int q = tid; q < 64 * 32; q += NTHR) { const int c8 = q & 31, tg = q >> 5, t0 = pm * 256 + tg * 4, p0 = t0 & (SEQ - 1);
        const bf16* zp = Z + (size_t)(t0 + 3) * DM + g * 256 + c8 * 8; bf16* op = P + (size_t)t0 * DM + g * 256 + c8 * 8;
        if (g == 0) pool_item<2>(zp, op, p0); else if (g == 1) pool_item<4>(zp, op, p0); else if (g == 2) pool_item<8>(zp, op, p0); else pool_item<16>(zp, op, p0); }
    VM_WAIT(); __syncthreads();
}
__device__ __forceinline__ void phase_pool(const Args& a, int vcu, int G) {
    const bf16* Z = (const bf16*)(a.ws + WS_Z); bf16* P = (bf16*)(a.ws + WS_POOLED);
    const int tid = threadIdx.x, wave = tid >> 6, lane = tid & 63;
    const int gw = vcu * NWAVES + wave, NGW = G * NWAVES;
    for (int it = gw; it < (T_TOK / 4) * 2; it += NGW) {
        const int t0 = (it >> 1) * 4, c8 = (it & 1) * 64 + lane, g = c8 >> 5, p0 = t0 & (SEQ - 1);
        const bf16* zp = Z + (size_t)(t0 + 3) * DM + c8 * 8; bf16* op = P + (size_t)t0 * DM + c8 * 8;
        if (g == 0) pool_item<2>(zp, op, p0); else if (g == 1) pool_item<4>(zp, op, p0); else if (g == 2) pool_item<8>(zp, op, p0); else pool_item<16>(zp, op, p0);
    }
}

template <int R, bool F8OUT = false> __device__ __forceinline__ void ln_rows_store(float (&v)[R][16], const float* g, const float* b, float* const (&of)[R], bf16* const (&ob)[R], int lane) {
    float s[R], s2[R];
#pragma unroll
    for (int r = 0; r < R; ++r) { s[r] = 0.f;
#pragma unroll
        for (int i = 0; i < 16; ++i) s[r] += v[r][i]; }
#pragma unroll
    for (int o = 1; o < 64; o <<= 1)
#pragma unroll
        for (int r = 0; r < R; ++r) s[r] += __shfl_xor(s[r], o);
#pragma unroll
    for (int r = 0; r < R; ++r) { const float mean = s[r] * (1.0f / DM); s2[r] = 0.f;
#pragma unroll
        for (int i = 0; i < 16; ++i) { v[r][i] -= mean; s2[r] += v[r][i] * v[r][i]; } }
#pragma unroll
    for (int o = 1; o < 64; o <<= 1)
#pragma unroll
        for (int r = 0; r < R; ++r) s2[r] += __shfl_xor(s2[r], o);
#pragma unroll
    for (int j = 0; j < 2; ++j) { const int c = 8 * lane + 512 * j;
        const f32x4 g0 = *(const f32x4*)(g + c), g1 = *(const f32x4*)(g + c + 4), b0 = *(const f32x4*)(b + c), b1 = *(const f32x4*)(b + c + 4);
#pragma unroll
        for (int r = 0; r < R; ++r) { const float rstd = 1.0f / sqrtf(s2[r] * (1.0f / DM) + LN_EPS); f32x4 y0, y1;
#pragma unroll
            for (int q = 0; q < 4; ++q) { y0[q] = v[r][8 * j + q] * rstd * g0[q] + b0[q]; y1[q] = v[r][8 * j + 4 + q] * rstd * g1[q] + b1[q]; }
            *(f32x4*)(of[r] + c) = y0; *(f32x4*)(of[r] + c + 4) = y1;
            if constexpr (F8OUT) { int t0 = 0, t1 = 0; t0 = __builtin_amdgcn_cvt_pk_fp8_f32(y0[0], y0[1], t0, false); t0 = __builtin_amdgcn_cvt_pk_fp8_f32(y0[2], y0[3], t0, true); t1 = __builtin_amdgcn_cvt_pk_fp8_f32(y1[0], y1[1], t1, false); t1 = __builtin_amdgcn_cvt_pk_fp8_f32(y1[2], y1[3], t1, true);
                *(v2u*)((unsigned char*)ob[r] + c) = (v2u){(unsigned)t0, (unsigned)t1}; }
            else { v4u w; w.x = cvt_pk_bf16(y0[0], y0[1]); w.y = cvt_pk_bf16(y0[2], y0[3]); w.z = cvt_pk_bf16(y1[0], y1[1]); w.w = cvt_pk_bf16(y1[2], y1[3]);
                *(v4u*)(ob[r] + c) = w; } } }
}

__device__ __forceinline__ void phase_lnr(const Args& a, int layer, LAS unsigned char* lds, int vcu, int G, bool dry) {
    const int tid = threadIdx.x, lane = tid & 63, wave = __builtin_amdgcn_readfirstlane(tid >> 6);
    const float* xin = a.out; float* xf = dry ? (float*)(a.ws + WS_Y) : a.out; bf16* xb = dry ? (bf16*)(a.ws + WS_Y + 72 * MiB) : (bf16*)(a.ws + WS_XB);
    const float* lng = a.in[I_LNMG] + layer * DM; const float* lnb = a.in[I_LNMB] + layer * DM;
    const float* Wr = a.in[I_WR] + (size_t)layer * DM * NE; const float* rbias = a.in[I_RB] + layer * NE;
    unsigned* gcount = (unsigned*)(a.ws + WS_CTL) + CW_CNT + layer * 64 + (dry ? 128 : 0);
    unsigned* rowtok = dry ? (unsigned*)(a.ws + WS_Y + 64 * MiB) : (unsigned*)(a.ws + WS_ROWTOK); unsigned* dest = dry ? (unsigned*)(a.ws + WS_Y + 68 * MiB) : (unsigned*)(a.ws + WS_DEST); float* gatev = dry ? (float*)(a.ws + WS_Y + 69 * MiB) : (float*)(a.ws + WS_GATE);
    LAS float* part = (LAS float*)lds;
    LAS float* mb = (LAS float*)(lds + 32768);
    LAS float* gs = (LAS float*)(lds + 49152);
    LAS unsigned* hist = (LAS unsigned*)(lds + 51200);
    LAS unsigned* basep = (LAS unsigned*)(lds + 51456);
    { const int blk = vcu;
        const int row0 = blk * 64;
        if (tid < 64) hist[tid] = 0u;
#pragma unroll 1
        for (int h4 = 0; h4 < 2; ++h4) { float v[4][16]; float* of[4]; bf16* ob[4];
#pragma unroll
            for (int r = 0; r < 4; ++r) { const int rr = wave * 8 + h4 * 4 + r; const float* xr = xin + (size_t)(row0 + rr) * DM; of[r] = xf + (size_t)(row0 + rr) * DM; ob[r] = (bf16*)((unsigned char*)xb + (size_t)(row0 + rr) * DM);
#pragma unroll
                for (int j = 0; j < 2; ++j) { const f32x4 p = *(const f32x4*)(xr + 8 * lane + 512 * j), q = *(const f32x4*)(xr + 8 * lane + 512 * j + 4);
#pragma unroll
                    for (int i = 0; i < 4; ++i) { v[r][8 * j + i] = p[i]; v[r][8 * j + 4 + i] = q[i]; } } }
            ln_rows_store<4, true>(v, lng, lnb, of, ob, lane); }
        VM_WAIT(); __syncthreads();
#ifndef DRY_PARTS
#define DRY_PARTS 7
#endif
        if (!dry || (DRY_PARTS & 2)) { const int mt = wave & 3, kh = wave >> 2, r = lane & 15, g = lane >> 4;
          f32x4 acc[4];
#pragma unroll
          for (int n = 0; n < 4; ++n) acc[n] = (f32x4){0.f, 0.f, 0.f, 0.f};
          const float* arow = xf + (size_t)(row0 + 16 * mt + r) * DM + kh * 512 + 8 * g;
          const bf16* bh = (const bf16*)(a.ws + WS_WRT) + (size_t)layer * 2 * 65536 + (size_t)r * 1024 + kh * 512 + 8 * g; const bf16* bl = bh + 65536;
          f32x4 a0 = *(const f32x4*)arow, a1 = *(const f32x4*)(arow + 4); bf16x8 wh[4], wl[4];
#pragma unroll
          for (int n = 0; n < 4; ++n) { wh[n] = *(const bf16x8*)(bh + (size_t)n * 16384); wl[n] = *(const bf16x8*)(bl + (size_t)n * 16384); }
#pragma unroll 1
          for (int s = 0; s < 16; ++s) { const int sn = s < 15 ? s + 1 : s;
              const f32x4 n0 = *(const f32x4*)(arow + 32 * sn), n1 = *(const f32x4*)(arow + 32 * sn + 4); bf16x8 nh[4], nl[4];
#pragma unroll
              for (int n = 0; n < 4; ++n) { nh[n] = *(const bf16x8*)(bh + (size_t)n * 16384 + 32 * sn); nl[n] = *(const bf16x8*)(bl + (size_t)n * 16384 + 32 * sn); }
              v4u hi, lo; hi.x = cvt_pk_bf16(a0[0], a0[1]); hi.y = cvt_pk_bf16(a0[2], a0[3]); hi.z = cvt_pk_bf16(a1[0], a1[1]); hi.w = cvt_pk_bf16(a1[2], a1[3]);
              lo.x = cvt_pk_bf16(a0[0] - bf_lo(hi.x), a0[1] - bf_hi(hi.x)); lo.y = cvt_pk_bf16(a0[2] - bf_lo(hi.y), a0[3] - bf_hi(hi.y));
              lo.z = cvt_pk_bf16(a1[0] - bf_lo(hi.z), a1[1] - bf_hi(hi.z)); lo.w = cvt_pk_bf16(a1[2] - bf_lo(hi.w), a1[3] - bf_hi(hi.w));
              const bf16x8 ah = __builtin_bit_cast(bf16x8, hi), al = __builtin_bit_cast(bf16x8, lo);
#pragma unroll
              for (int n = 0; n < 4; ++n) { acc[n] = __builtin_amdgcn_mfma_f32_16x16x32_bf16(ah, wh[n], acc[n], 0, 0, 0); acc[n] = __builtin_amdgcn_mfma_f32_16x16x32_bf16(al, wh[n], acc[n], 0, 0, 0); acc[n] = __builtin_amdgcn_mfma_f32_16x16x32_bf16(ah, wl[n], acc[n], 0, 0, 0); }
              a0 = n0; a1 = n1;
#pragma unroll
              for (int n = 0; n < 4; ++n) { wh[n] = nh[n]; wl[n] = nl[n]; } }
#pragma unroll
          for (int n = 0; n < 4; ++n)
#pragma unroll
              for (int q = 0; q < 4; ++q) part[(kh * 64 + 16 * mt + 4 * g + q) * 64 + 16 * n + r] = acc[n][q]; }
        __syncthreads();
        if (!dry || (DRY_PARTS & 4)) { const int row = tid >> 3, grp = tid & 7; float sc[8], bsd[8];
#pragma unroll
          for (int i = 0; i < 8; ++i) { const int e = 8 * grp + i; const float lg = part[row * 64 + e] + part[(64 + row) * 64 + e]; sc[i] = 1.0f / (1.0f + __expf(-lg)); bsd[i] = sc[i] + rbias[e]; }
          float m1 = -INFINITY, m2 = -INFINITY;
#pragma unroll
          for (int i = 0; i < 8; ++i) { const float v = bsd[i]; if (v > m1) { m2 = m1; m1 = v; } else if (v > m2) m2 = v; }
          const float myg = m1 + m2;
          int grank = 0;
#pragma unroll
          for (int d = 1; d < 8; ++d) { const float o = __shfl(myg, (lane & ~7) | ((grp + d) & 7)); const int g2 = (grp + d) & 7; grank += (o > myg || (o == myg && g2 < grp)) ? 1 : 0; }
          const bool gsel = grank < 4;
          float cand[8]; int rk[8]; bool sel[8];
#pragma unroll
          for (int i = 0; i < 8; ++i) { cand[i] = gsel ? bsd[i] : -INFINITY; rk[i] = 0; sel[i] = false; }
#pragma unroll 1
          for (int k = 0; k < TOPK; ++k) {
              float best = cand[0]; int bi = 0;
#pragma unroll
              for (int i = 1; i < 8; ++i) if (cand[i] > best) { best = cand[i]; bi = i; }
              int gi = 8 * grp + bi;
#pragma unroll
              for (int off = 1; off < 8; off <<= 1) { const float ov = __shfl_xor(best, off); const int oi = __shfl_xor(gi, off); if (ov > best || (ov == best && oi < gi)) { best = ov; gi = oi; } }
#pragma unroll
              for (int i = 0; i < 8; ++i) if (gi == 8 * grp + i) { cand[i] = -INFINITY; rk[i] = k; sel[i] = true; }
          }
          float psum = 0.f;
#pragma unroll
          for (int i = 0; i < 8; ++i) psum += sel[i] ? sc[i] : 0.f;
          psum += __shfl_xor(psum, 1); psum += __shfl_xor(psum, 2); psum += __shfl_xor(psum, 4);
          const float inv = ROUTED_SCALE / psum;
          unsigned loc[8];
#pragma unroll
          for (int i = 0; i < 8; ++i) { loc[i] = 0u; if (sel[i]) loc[i] = __hip_atomic_fetch_add(hist + 8 * grp + i, 1u, __ATOMIC_RELAXED, __HIP_MEMORY_SCOPE_WORKGROUP); }
          __syncthreads();
          if (tid < 64) { const unsigned h = hist[tid]; basep[tid] = h ? __hip_atomic_fetch_add(gcount + tid, h, RLX_AGENT) : 0u; }
          __syncthreads();
          const int tok = row0 + row;
#pragma unroll
          for (int i = 0; i < 8; ++i) if (sel[i]) { const int e = 8 * grp + i; const unsigned pos = basep[e] + loc[i];
              rowtok[(size_t)e * CAP + pos] = (unsigned)tok; dest[tok * 8 + rk[i]] = ((unsigned)e << 16) | pos; gatev[tok * 8 + rk[i]] = sc[i] * inv; }
        }
        __syncthreads();
    }
}

__device__ __forceinline__ pg8::MoeInfo moe_setup(const Args& a, int layer, LAS unsigned char* misc) {
    const int tid = threadIdx.x;
    unsigned* gcount = (unsigned*)(a.ws + WS_CTL) + CW_CNT + layer * 64;
    LAS unsigned* cnt = (LAS unsigned*)(misc + MI_CNT); LAS unsigned* tstart = (LAS unsigned*)(misc + MI_TSTART); LAS unsigned* ystart = (LAS unsigned*)(misc + MI_YSTART);
    LAS unsigned* ntl = (LAS unsigned*)(misc + MI_NTILES); LAS unsigned char* tile_e = (LAS unsigned char*)(misc + MI_TILE_E);
    __syncthreads();
    if (tid < 64) { unsigned c = __hip_atomic_load(gcount + tid, RLX_AGENT); if (c > (unsigned)CAP) c = CAP; cnt[tid] = c; }
    __syncthreads();
    if (tid < 64) { unsigned ts = 64u, ys = 0u; for (int e = 0; e < tid; ++e) { const unsigned c = cnt[e]; ts += (c + 255u) >> 8; ys += c; }
        tstart[tid] = ts; ystart[tid] = ys; const unsigned mynt = (cnt[tid] + 255u) >> 8;
        for (unsigned i = 0; i < mynt; ++i) if (ts + i < 640u) tile_e[ts + i] = (unsigned char)tid;
        if (tid == 63) ntl[0] = ts + mynt; }
    __syncthreads();
    pg8::MoeInfo mi; mi.cnt = cnt; mi.tstart = tstart; mi.ystart = ystart; mi.tile_e = tile_e; mi.ntiles = __builtin_amdgcn_readfirstlane((int)ntl[0]);
    if (mi.ntiles > 640) mi.ntiles = 640;
    return mi;
}

__device__ __forceinline__ void phase_combine(const Args& a, int layer, LAS unsigned char* misc, int vcu, int G, bool dry) {
    const int tid = threadIdx.x, lane = tid & 63, wave = __builtin_amdgcn_readfirstlane(tid >> 6);
    const pg8::MoeInfo mi = moe_setup(a, layer, misc);
    float* xf = a.out; bf16* xb = (bf16*)(a.ws + WS_XB); const unsigned char* Y8 = (const unsigned char*)(a.ws + WS_Y);
    const unsigned* dest = (const unsigned*)(a.ws + WS_DEST); const float* gatev = (const float*)(a.ws + WS_GATE);
    const float* lng = a.in[I_LNFG] + layer * DM; const float* lnb = a.in[I_LNFB] + layer * DM;
    const int gw = vcu * NWAVES + wave, NGW = G * NWAVES;
#pragma unroll 1
    for (int rowa = gw; rowa < T_TOK; rowa += 2 * NGW) {
        float v[2][16]; float* of[2]; bf16* ob[2]; unsigned d[2][TOPK]; float gk[2][TOPK];
#pragma unroll
        for (int r = 0; r < 2; ++r) { const int row = rowa + r * NGW;
#pragma unroll
            for (int k = 0; k < TOPK; ++k) { d[r][k] = dest[row * 8 + k]; gk[r][k] = gatev[row * 8 + k]; } }
#pragma unroll
        for (int r = 0; r < 2; ++r) { const int row = rowa + r * NGW; float* xr = xf + (size_t)row * DM; of[r] = dry ? (float*)(a.ws + WS_H) + (size_t)row * DM : xr; ob[r] = xb + (size_t)row * DM;
#pragma unroll
            for (int j = 0; j < 2; ++j) { const f32x4 p = *(const f32x4*)(xr + 8 * lane + 512 * j), q = *(const f32x4*)(xr + 8 * lane + 512 * j + 4);
#pragma unroll
                for (int i = 0; i < 4; ++i) { v[r][8 * j + i] = p[i] * ALPHA; v[r][8 * j + 4 + i] = q[i] * ALPHA; } } }
#pragma unroll
        for (int r = 0; r < 2; ++r) { const unsigned char* yr = Y8 + (size_t)(131072 + rowa + r * NGW) * DM;
#pragma unroll
            for (int j = 0; j < 2; ++j) { const v2u w = *(const v2u*)(yr + 8 * lane + 512 * j);
#pragma unroll
                for (int q = 0; q < 2; ++q) { const f32x2 lo2 = __builtin_amdgcn_cvt_pk_f32_fp8((int)w[q], false), hi2 = __builtin_amdgcn_cvt_pk_f32_fp8((int)w[q], true);
                    v[r][8 * j + 4 * q] += 0.0625f * lo2.x; v[r][8 * j + 4 * q + 1] += 0.0625f * lo2.y; v[r][8 * j + 4 * q + 2] += 0.0625f * hi2.x; v[r][8 * j + 4 * q + 3] += 0.0625f * hi2.y; } } }
#pragma unroll
        for (int r = 0; r < 2; ++r)
#pragma unroll
            for (int k = 0; k < TOPK; ++k) { const unsigned dd = (unsigned)__builtin_amdgcn_readfirstlane((int)d[r][k]); const float g = __uint_as_float((unsigned)__builtin_amdgcn_readfirstlane((int)__float_as_uint(gk[r][k])));
                const unsigned e = (dd >> 16) & 63u, pos = dd & 0xffffu; const unsigned char* yr = Y8 + (size_t)(mi.ystart[e] + pos) * DM; const float g16 = g * 0.0625f;
#pragma unroll
                for (int j = 0; j < 2; ++j) { const v2u w = *(const v2u*)(yr + 8 * lane + 512 * j);
#pragma unroll
                    for (int q = 0; q < 2; ++q) { const f32x2 lo2 = __builtin_amdgcn_cvt_pk_f32_fp8((int)w[q], false), hi2 = __builtin_amdgcn_cvt_pk_f32_fp8((int)w[q], true);
                        v[r][8 * j + 4 * q] += g16 * lo2.x; v[r][8 * j + 4 * q + 1] += g16 * lo2.y; v[r][8 * j + 4 * q + 2] += g16 * hi2.x; v[r][8 * j + 4 * q + 3] += g16 * hi2.y; } } }
        ln_rows_store<2>(v, lng, lnb, of, ob, lane);
    }
}

__device__ __forceinline__ int swz16(int row) { return (row ^ (row >> 4)) & 15; }
__device__ __forceinline__ void phase_sgu_spatial(const Args& a, LAS unsigned char* lds, int vcu, int G) {
    const int tid = threadIdx.x, lane = tid & 63, wave = __builtin_amdgcn_readfirstlane(tid >> 6), fr = lane & 15, fq = lane >> 4;
    const bf16* HS = (const bf16*)(a.ws + WS_HS); bf16* GT = (bf16*)(a.ws + WS_GATED);
    const float* lng = a.in[I_SLNG]; const float* lnb = a.in[I_SLNB]; const float* WS = a.in[I_SWS]; const float* BS = a.in[I_SBS];
    LAS unsigned char* Bs = lds;
    LAS unsigned char* As = lds + 65536;
    LAS float* stm = (LAS float*)(lds + 98304);
    LAS float* str = (LAS float*)(lds + 98304 + 512);
    for (int item = vcu; item < 512; item += G) {
        const int chunk = item >> 2, h = item & 3, t0 = chunk * 128;
        __syncthreads();
#pragma unroll 1
        for (int r4 = 0; r4 < 4; ++r4) { v4u w[4][4];
#pragma unroll
            for (int rr = 0; rr < 4; ++rr) { const bf16* vr = HS + (size_t)(t0 + wave * 16 + r4 * 4 + rr) * 4096 + SGU_W;
#pragma unroll
                for (int q = 0; q < 4; ++q) w[rr][q] = *(const v4u*)(vr + 8 * lane + 512 * q); }
            float sm[4], sq[4];
#pragma unroll
            for (int rr = 0; rr < 4; ++rr) { float s1 = 0.f;
#pragma unroll
                for (int q = 0; q < 4; ++q)
#pragma unroll
                    for (int p = 0; p < 4; ++p) s1 += bf_lo(w[rr][q][p]) + bf_hi(w[rr][q][p]);
                sm[rr] = s1; }
#pragma unroll
            for (int o = 1; o < 64; o <<= 1)
#pragma unroll
                for (int rr = 0; rr < 4; ++rr) sm[rr] += __shfl_xor(sm[rr], o);
#pragma unroll
            for (int rr = 0; rr < 4; ++rr) { const float mean = sm[rr] * (1.0f / SGU_W); float s2 = 0.f;
#pragma unroll
                for (int q = 0; q < 4; ++q)
#pragma unroll
                    for (int p = 0; p < 4; ++p) { const float d0 = bf_lo(w[rr][q][p]) - mean, d1 = bf_hi(w[rr][q][p]) - mean; s2 += d0 * d0 + d1 * d1; }
                sm[rr] = mean; sq[rr] = s2; }
#pragma unroll
            for (int o = 1; o < 64; o <<= 1)
#pragma unroll
                for (int rr = 0; rr < 4; ++rr) sq[rr] += __shfl_xor(sq[rr], o);
            if (lane == 0) {
#pragma unroll
                for (int rr = 0; rr < 4; ++rr) { const int j = wave * 16 + r4 * 4 + rr; stm[j] = sm[rr]; str[j] = 1.0f / sqrtf(sq[rr] * (1.0f / SGU_W) + LN_EPS); } } }
        for (int q = tid; q < 128 * 16; q += NTHR) { const int i = q >> 4, jc = q & 15; const float* wp = WS + ((size_t)h * 128 + i) * 128 + 8 * jc;
            const f32x4 p0 = *(const f32x4*)wp, p1 = *(const f32x4*)(wp + 4); float w8[8];
#pragma unroll
            for (int z = 0; z < 4; ++z) { w8[z] = (8 * jc + z <= i) ? p0[z] : 0.f; w8[4 + z] = (8 * jc + 4 + z <= i) ? p1[z] : 0.f; }
            v4u o; o.x = cvt_pk_bf16(w8[0], w8[1]); o.y = cvt_pk_bf16(w8[2], w8[3]); o.z = cvt_pk_bf16(w8[4], w8[5]); o.w = cvt_pk_bf16(w8[6], w8[7]);
            *(LAS v4u*)(As + i * 256 + ((jc ^ swz16(i)) << 4)) = o; }
        __syncthreads();
        for (int hh = 0; hh < 2; ++hh) {
            const int cb = h * SGU_HD + hh * 256;
#pragma unroll 2
            for (int q = tid; q < 64 * 32; q += NTHR) { const int c8 = q & 31, jp = q >> 5, j0 = 2 * jp;
                const v4u w0 = *(const v4u*)(HS + (size_t)(t0 + j0) * 4096 + SGU_W + cb + 8 * c8), w1 = *(const v4u*)(HS + (size_t)(t0 + j0 + 1) * 4096 + SGU_W + cb + 8 * c8);
                const f32x4 g0 = *(const f32x4*)(lng + cb + 8 * c8), g1 = *(const f32x4*)(lng + cb + 8 * c8 + 4), b0 = *(const f32x4*)(lnb + cb + 8 * c8), b1 = *(const f32x4*)(lnb + cb + 8 * c8 + 4);
                const float m0 = stm[j0], r0 = str[j0], m1 = stm[j0 + 1], r1 = str[j0 + 1];
#pragma unroll
                for (int z = 0; z < 8; ++z) { const float gz = z < 4 ? g0[z & 3] : g1[z & 3], bz = z < 4 ? b0[z & 3] : b1[z & 3];
                    const float xa = (z & 1) ? bf_hi(w0[z >> 1]) : bf_lo(w0[z >> 1]), xc = (z & 1) ? bf_hi(w1[z >> 1]) : bf_lo(w1[z >> 1]);
                    const float ya = (xa - m0) * r0 * gz + bz, yc = (xc - m1) * r1 * gz + bz;
                    const int cc = 8 * c8 + z, slot = (cc & ~31) | (((cc >> 2) & 1) << 4) | (((cc >> 3) & 3) << 2) | (cc & 3);
                    *(LAS unsigned*)(Bs + slot * 256 + (((j0 >> 3) ^ swz16(slot)) << 4) + (j0 & 7) * 2) = cvt_pk_bf16(ya, yc); } }
            __syncthreads();
            f32x4 acc[8][2]; bf16x8 Bf[2][4];
#pragma unroll
            for (int n = 0; n < 2; ++n)
#pragma unroll
                for (int s = 0; s < 4; ++s) { const int slot = 32 * wave + 16 * n + fr; Bf[n][s] = *(const LAS bf16x8*)(Bs + slot * 256 + (((4 * s + fq) ^ swz16(slot)) << 4)); }
#pragma unroll
            for (int m = 0; m < 8; ++m) { acc[m][0] = (f32x4){0.f, 0.f, 0.f, 0.f}; acc[m][1] = (f32x4){0.f, 0.f, 0.f, 0.f};
#pragma unroll
                for (int s = 0; s < 4; ++s) if (s <= (m >> 1)) { const int i = 16 * m + fr; const bf16x8 af = *(const LAS bf16x8*)(As + i * 256 + (((4 * s + fq) ^ swz16(i)) << 4));
                    acc[m][0] = __builtin_amdgcn_mfma_f32_16x16x32_bf16(Bf[0][s], af, acc[m][0], 0, 0, 0); acc[m][1] = __builtin_amdgcn_mfma_f32_16x16x32_bf16(Bf[1][s], af, acc[m][1], 0, 0, 0); } }
#pragma unroll
            for (int m = 0; m < 8; ++m) { const int i = 16 * m + fr; const float bsv = BS[h * 128 + i]; const size_t t = (size_t)(t0 + i);
                const v4u uw = *(const v4u*)(HS + t * 4096 + cb + 32 * wave + 8 * fq); float o[8];
#pragma unroll
                for (int n = 0; n < 2; ++n)
#pragma unroll
                    for (int z = 0; z < 4; ++z) { const int c = 4 * n + z; const float uu = (c & 1) ? bf_hi(uw[c >> 1]) : bf_lo(uw[c >> 1]); o[c] = uu * (acc[m][n][z] + bsv); }
                v4u w; w.x = cvt_pk_bf16(o[0], o[1]); w.y = cvt_pk_bf16(o[2], o[3]); w.z = cvt_pk_bf16(o[4], o[5]); w.w = cvt_pk_bf16(o[6], o[7]);
                *(v4u*)(GT + t * SGU_W + cb + 32 * wave + 8 * fq) = w; }
            __syncthreads();
        }
    }
}

__device__ __forceinline__ void phase_flush(const Args& a, int vcu, int G) {
    const size_t gt = (size_t)vcu * NTHR + threadIdx.x, NT = (size_t)G * NTHR; f32x4 acc = (f32x4){0.f, 0.f, 0.f, 0.f};
    const f32x4* p0 = (const f32x4*)a.in[I_WG]; const f32x4* p1 = (const f32x4*)a.in[I_WU];
    for (size_t i = gt; i < (size_t)33554432 / 4; i += 4 * NT) { const f32x4 x0 = p0[i], x1 = p0[i + NT], x2 = p0[i + 2 * NT], x3 = p0[i + 3 * NT], y0 = p1[i], y1 = p1[i + NT], y2 = p1[i + 2 * NT], y3 = p1[i + 3 * NT]; acc += x0 + x1 + x2 + x3 + y0 + y1 + y2 + y3; }
    if (acc[0] + acc[1] + acc[2] + acc[3] == 1.2345e-30f) ((float*)(a.ws + WS_CTL))[16000] = acc[0];
}
constexpr int N_PHASES = 16;
__global__ void __launch_bounds__(NTHR, 2) mk_fwd(Args args) {
    extern __shared__ __attribute__((aligned(16))) unsigned char lds_raw[];
    LAS unsigned char* lds = (LAS unsigned char*)lds_raw;
    LAS unsigned char* misc = lds + MISC_OFF;
    const int tid = threadIdx.x;
    const int G = gridDim.x; const int bx = blockIdx.x; const int vcu = (G % 8 == 0) ? (bx % 8) * (G / 8) + bx / 8 : bx;
    unsigned char* ws = args.ws;
    unsigned* ctl = (unsigned*)(ws + WS_CTL);
    if (tid < 16) ((LAS unsigned*)(misc + MI_BARW))[tid] = 0u;
    __syncthreads();
    const int lo = args.ph_lo, hi = args.ph_hi;
    XcdBarrier bar; bar.bar = ctl + CW_BAR; bar.x = 0; bar.st = nullptr;
    if (hi - lo > 1) bar = xcd_barrier_post(ctl + CW_BAR, (volatile LAS unsigned*)(misc + MI_BARW));
#ifndef PH_MASK
#define PH_MASK 0xFFFF
#endif
#define IN(k) (((PH_MASK >> (k)) & 1) && lo <= (k) && (k) < hi)
#ifndef TS_A0
#define TS_A0 -1
#define TS_A1 -1
#define TS_M 1
#endif
    unsigned long long* tsbuf = (unsigned long long*)(ws + 32768);
#define TS_REC(k) do { if (TS_A0 >= 0 && bx == 0 && tid == 0) __hip_atomic_store(tsbuf + (k), (unsigned long long)__builtin_amdgcn_s_memrealtime(), RLX_AGENT); } while (0)
    TS_REC(0);
#ifndef REP_PH
#define REP_PH -1
#define REP_N 1
#endif
#define NREP(k) ((k) == REP_PH ? REP_N : 1)
#ifndef FLUSH_PH
#define FLUSH_PH -2
#endif
#define RUN(k) if (IN(k)) for (int rep = 0; rep < NREP(k); ++rep) if ((((k) == FLUSH_PH && rep == NREP(k) - 1) ? (xcd_barrier(bar), phase_flush(args, vcu, G), xcd_barrier(bar), true) : true))
#define DRY(k) (rep + 1 < NREP(k))
#define BG_LAYER(k) (-1)
#define SEAM(k) do { if (IN(k) && IN((k) + 1)) xcd_barrier(bar, &args, BG_LAYER(k), lds); TS_REC((k) + 1); } while (0)
    using namespace pg8;
    RUN(0) { phase_p0(args, lds, vcu, G); } SEAM(0);
    RUN(1) { DenseSched S{(const char*)(ws + WS_XB), (const char*)(ws + WS_WIN), 2048u, 2048u, 0u, 64, 4, 256, G, bx};
        EpiBf16<0, false, false> E{(bf16*)(ws + WS_Z), DM, nullptr, nullptr};
        gemm_phase<EpiBf16<0, false, false>, DenseSched, false, true, true>(lds, 2048u, 2048u, 16, S, E); } SEAM(1);
    if (REP_PH == 100 && hi - lo > 1) for (int i = 0; i < REP_N; ++i) xcd_barrier(bar);
    RUN(3) { DenseSched S{(const char*)(ws + WS_POOLED), (const char*)(ws + WS_WGRP), 2048u, 512u, 512u, 64, 4, 256, G, bx};
        { Unit u0; if (S.next(0, u0)) pool_block(args, u0.i0, u0.i1); }
        EpiBf16<0, false, true> E{(bf16*)(ws + WS_YP), DM, nullptr, args.in[I_PSCALE]};
        gemm_phase<EpiBf16<0, false, true>, DenseSched, false, true, true>(lds, 2048u, 512u, 4, S, E); } SEAM(3);
    RUN(4) { DenseSched S{(const char*)(ws + WS_YP), (const char*)(ws + WS_WOUT), 2048u, 2048u, 0u, 64, 4, 256, G, bx};
        EpiResid E{args.in[I_X], args.out};
        gemm_phase<EpiResid, DenseSched, false, true, true>(lds, 2048u, 2048u, 16, S, E); } SEAM(4);
#define MOE_PHASES(layer, pb) do { \
        RUN(pb) { phase_lnr(args, layer, lds, vcu, G, DRY(pb)); } SEAM(pb); \
        RUN((pb) + 1) { const MoeInfo mi = moe_setup(args, layer, misc); \
            G1Sched S{mi, (const char*)(ws + WS_XB), (const char*)(ws + WS_WGU + (size_t)layer * WS_MOE_LSTRIDE), (const unsigned*)(ws + WS_ROWTOK), (const unsigned*)(ws + WS_IDENT), G, vcu}; \
            EpiSwiglu E{(unsigned char*)(ws + WS_H)}; \
            gemm_phase<EpiSwiglu, G1Sched, true, true, false, 0, 1>(lds, 1024u, 1024u, 8, S, E); } SEAM((pb) + 1); \
        if (IN((pb) + 2) && REP_PH == (pb) + 2) { const MoeInfo mi = moe_setup(args, layer, misc); \
            G2Sched S{mi, (const char*)(ws + WS_H), (const char*)(ws + WS_WDN + (size_t)layer * WS_MOE_LSTRIDE), G, vcu, 256}; \
            EpiDown E{(unsigned char*)(ws + WS_Y)}; \
            gemm_phase<EpiDown, G2Sched, false, true, true, 1, 1>(lds, 256u, 256u, 2, S, E); } \
        if (IN((pb) + 2)) { const MoeInfo mi = moe_setup(args, layer, misc); \
            G2Sched S{mi, (const char*)(ws + WS_H), (const char*)(ws + WS_WDN + (size_t)layer * WS_MOE_LSTRIDE), G, vcu, 0}; \
            EpiDown E{(unsigned char*)(ws + WS_Y)}; \
            gemm_phase<EpiDown, G2Sched, false, true, true, 1, 1>(lds, 256u, 256u, 2, S, E); } SEAM((pb) + 2); \
        RUN((pb) + 3) { phase_combine(args, layer, misc, vcu, G, DRY((pb) + 3)); if (layer == 0 && !DRY((pb) + 3)) { __syncthreads(); convert_static(args, 1, lds, vcu, G); } } \
    } while (0)
    MOE_PHASES(0, 5); SEAM(8);
    RUN(9) { DenseSched S{(const char*)(ws + WS_XB), (const char*)(ws + WS_WSIN), 2048u, 2048u, 0u, 64, 16, 1024, G, bx};
        EpiBf16<1, true, false> E{(bf16*)(ws + WS_HS), 4096, args.in[I_SBIN], nullptr};
        gemm_phase<EpiBf16<1, true, false>, DenseSched, false, true, true>(lds, 2048u, 2048u, 16, S, E); } SEAM(9);
    RUN(10) { phase_sgu_spatial(args, lds, vcu, G); } SEAM(10);
    RUN(11) { DenseSched S{(const char*)(ws + WS_GATED), (const char*)(ws + WS_WSOUT), 4096u, 4096u, 0u, 64, 4, 256, G, bx};
        EpiResid E{args.out, DRY(11) ? (float*)(ws + WS_HS) : args.out};
        gemm_phase<EpiResid, DenseSched, false, true, true>(lds, 4096u, 4096u, 32, S, E); } SEAM(11);
    MOE_PHASES(1, 12);
#undef MOE_PHASES
    if (TS_A0 >= 0 && bx == 0 && tid == 0) {
        const unsigned long long tend = __builtin_amdgcn_s_memrealtime();
        const unsigned long long t0 = __hip_atomic_load(tsbuf + TS_A0, RLX_AGENT), t1 = (TS_A1 + 1 >= N_PHASES) ? tend : __hip_atomic_load(tsbuf + TS_A1 + 1, RLX_AGENT);
        const unsigned long long wait = (t1 - t0) * TS_M;
        while (__builtin_amdgcn_s_memrealtime() - tend < wait) __builtin_amdgcn_s_sleep(8);
    }
#undef IN
#undef SEAM
}

extern "C" void kernel_launch(void* const* d_in, const int* in_sizes, int n_in, void* d_out, int out_size, void* d_ws, size_t ws_size, hipStream_t stream) {
    static int grid = 0;
    if (grid == 0) {
        if (n_in != 24 || out_size != T_TOK * DM || ws_size < WS_END) { fprintf(stderr, "kernel_launch: unexpected shapes (n_in %d out %d ws %zu)\n", n_in, out_size, ws_size); grid = -1; return; }
        int dev = 0, cus = 0;
        if (hipGetDevice(&dev) != hipSuccess || hipDeviceGetAttribute(&cus, hipDeviceAttributeMultiprocessorCount, dev) != hipSuccess) { grid = -1; return; }
        if (hipFuncSetAttribute((const void*)mk_fwd, hipFuncAttributeMaxDynamicSharedMemorySize, LDS_BYTES) != hipSuccess) { fprintf(stderr, "kernel_launch: hipFuncSetAttribute failed\n"); grid = -1; return; }
        int per_cu = 0;
        if (hipOccupancyMaxActiveBlocksPerMultiprocessor(&per_cu, (const void*)mk_fwd, NTHR, LDS_BYTES) != hipSuccess || per_cu < 1) fprintf(stderr, "kernel_launch: occupancy query says %d\n", per_cu);
        (void)hipGetLastError();
        grid = cus;
        if (grid != 256) { fprintf(stderr, "kernel_launch: built for a 256-CU device (got %d)\n", cus); grid = -1; return; }
    }
    if (grid < 0) return;
    (void)hipMemsetAsync((char*)d_ws + WS_CTL, 0, CTL_ZERO_BYTES, stream);
    Args a{};
    for (int i = 0; i < 24; ++i) a.in[i] = (const float*)d_in[i];
    a.out = (float*)d_out; a.ws = (unsigned char*)d_ws;
#if MK_PER_PHASE
    for (int p = 0; p < N_PHASES; ++p) { a.ph_lo = p; a.ph_hi = p + 1; hipLaunchKernelGGL(mk_fwd, dim3(grid), dim3(NTHR), LDS_BYTES, stream, a); }
#else
    a.ph_lo = 0; a.ph_hi = N_PHASES; hipLaunchKernelGGL(mk_fwd, dim3(grid), dim3(NTHR), LDS_BYTES, stream, a);
#endif
}
```

```cpp
#include <hip/hip_runtime.h>
#include <cstdio>
#include <cstdint>

#ifndef MK_PER_PHASE
#define MK_PER_PHASE 0
#endif

#define GAS __attribute__((address_space(1)))
#define LAS __attribute__((address_space(3)))
typedef unsigned short bf16;
typedef unsigned v4u __attribute__((ext_vector_type(4)));
typedef unsigned v2u __attribute__((ext_vector_type(2)));
typedef float f32x4 __attribute__((ext_vector_type(4)));
typedef float f32x2 __attribute__((ext_vector_type(2)));
typedef short bf16x8 __attribute__((ext_vector_type(8)));
#define RLX_AGENT __ATOMIC_RELAXED, __HIP_MEMORY_SCOPE_AGENT
#define LDS_WAIT() asm volatile("s_waitcnt lgkmcnt(0)" ::: "memory")
#define VM_WAIT() asm volatile("s_waitcnt vmcnt(0)" ::: "memory")

constexpr int T_TOK = 16384, DM = 1024, SEQ = 4096, NE = 64, TOPK = 8, EDIM = 256;
constexpr int SGU_W = 2048, SGU_HD = 512;
constexpr float ALPHA = 1.41421356237309515f;
constexpr float LN_EPS = 1e-5f, ROUTED_SCALE = 2.5f;
constexpr int CAP = 16384;
constexpr int NWAVES = 8, NTHR = 512;

constexpr size_t MiB = 1u << 20;
constexpr size_t WS_CTL = 0, CTL_ZERO_BYTES = 65536;
constexpr size_t WS_IDENT = 256 * 1024;
constexpr size_t WS_DEST = 1 * MiB;
constexpr size_t WS_GATE = WS_DEST + 512 * 1024;
constexpr size_t WS_ROWTOK = 2 * MiB;
constexpr size_t WS_WIN = 6 * MiB;
constexpr size_t WS_WGRP = 8 * MiB;
constexpr size_t WS_WOUT = WS_WGRP + 512 * 1024;
constexpr size_t WS_WSIN = WS_WOUT + 2 * MiB;
constexpr size_t WS_WSOUT = WS_WSIN + 8 * MiB;
constexpr size_t WS_WRT = WS_WSOUT + 4 * MiB;
constexpr size_t WS_WGU = 23 * MiB;
constexpr size_t WS_WDN = WS_WGU + 65 * MiB;
constexpr size_t WS_XB = 121 * MiB;
constexpr size_t WS_H = 153 * MiB;
constexpr size_t WS_Y = 233 * MiB;
constexpr size_t WS_WGU1 = 378 * MiB, WS_WDN1 = WS_WGU1 + 65 * MiB;
constexpr size_t WS_MOE_LSTRIDE = WS_WGU1 - WS_WGU;
constexpr size_t WS_END = 476 * MiB;
constexpr size_t WS_Z = 153 * MiB, WS_POOLED = 185 * MiB, WS_YP = 217 * MiB;
constexpr size_t WS_HS = 153 * MiB;
constexpr size_t WS_GATED = 281 * MiB;
static_assert(WS_WRT + 512 * 1024 <= WS_WGU && WS_WDN + 33 * MiB <= WS_XB && WS_XB + 32 * MiB <= WS_H && WS_H + 80 * MiB <= WS_Y && WS_Y + 145 * MiB <= WS_WGU1 && WS_WDN1 + 33 * MiB <= WS_END && WS_GATED + 64 * MiB <= WS_WGU1, "ws map");
constexpr int CW_TMO = 0, CW_BAR = 64, CW_CNT = 4096, CW_QNEXT = 4608;

constexpr int RING_BYTES = 131072;
constexpr int MISC_OFF = RING_BYTES;
constexpr int LDS_BYTES = 147456;
constexpr int MI_BARW = 0, MI_CNT = 64, MI_TSTART = 320, MI_YSTART = 576, MI_NTILES = 832, MI_TILE_E = 1024;

__device__ __forceinline__ unsigned cvt_pk_bf16(float lo, float hi) { unsigned r; asm volatile("v_cvt_pk_bf16_f32 %0, %1, %2" : "=v"(r) : "v"(lo), "v"(hi)); return r; }
__device__ __forceinline__ float bf_lo(unsigned w) { return __uint_as_float(w << 16); }
__device__ __forceinline__ float bf_hi(unsigned w) { return __uint_as_float(w & 0xffff0000u); }
__device__ __forceinline__ float wave_sum(float v) {
#pragma unroll
    for (int o = 1; o < 64; o <<= 1) v += __shfl_xor(v, o);
    return v;
}
__device__ __forceinline__ float sigmoidf_(float x) { return __builtin_amdgcn_rcpf(1.0f + __builtin_amdgcn_exp2f(-1.4426950408889634f * x)); }
__device__ __forceinline__ float gelu_tanh(float v) { const float y = v + 0.044715f * v * v * v; return v * __builtin_amdgcn_rcpf(1.0f + __builtin_amdgcn_exp2f(-2.3022081983f * y)); }

#define XB_TMO      128
#define XB_XCNT(j)  (256  + 64 * (j))
#define XB_XSUB(j)  (1280 + 64 * (j))
#define XB_XGEN(j)  (2304 + 64 * (j))
#define XB_TOP      3328
#define XB_TOPGEN   3392
#define XCD_BAR_WORDS 3456
#define XB_SPIN_CAP (1u << 20)
__device__ __forceinline__ unsigned xb_ld(unsigned* p)              { return __hip_atomic_load(p, __ATOMIC_RELAXED, __HIP_MEMORY_SCOPE_AGENT); }
__device__ __forceinline__ unsigned xb_add(unsigned* p, unsigned v) { return __hip_atomic_fetch_add(p, v, __ATOMIC_RELAXED, __HIP_MEMORY_SCOPE_AGENT); }
__device__ __forceinline__ unsigned xb_xcc_id() { return (unsigned)__builtin_amdgcn_s_getreg((3 << 11) | 20) & 0xFu; }
#define XB_SPIN(cond, bar) do { unsigned _sp = 0; while (cond) { __builtin_amdgcn_s_sleep(1); \
    if ((++_sp & 255u) == 0u) { if (xb_ld(&(bar)[XB_TMO])) break; if (_sp > XB_SPIN_CAP) { atomicAdd(&(bar)[XB_TMO], 1u); break; } } } } while (0)
struct XcdBarrier { unsigned* bar; unsigned x; volatile LAS unsigned* st; };
__device__ __forceinline__ XcdBarrier xcd_barrier_post(unsigned* bar, volatile LAS unsigned* st) {
    XcdBarrier b; b.bar = bar; b.x = xb_xcc_id(); b.st = st;
    if (threadIdx.x == 0) (void)xb_add(&bar[XB_XCNT(b.x)], 1u);
    return b;
}
__device__ __forceinline__ void xcd_barrier_complete(unsigned* bar, unsigned x, unsigned& nloc, unsigned& nx) {
    const unsigned G = gridDim.x * gridDim.y * gridDim.z;
    unsigned sum, cnt, mine, sp = 0u;
    for (;;) {
        sum = 0u; cnt = 0u; mine = 0u;
#pragma unroll
        for (unsigned j = 0; j < 16; ++j) { const unsigned c = xb_ld(&bar[XB_XCNT(j)]); sum += c; cnt += (c > 0u) ? 1u : 0u; mine = (j == x) ? c : mine; }
        if (sum == G) break;
        __builtin_amdgcn_s_sleep(1);
        if ((++sp & 255u) == 0u) { if (xb_ld(&bar[XB_TMO])) break; if (sp > XB_SPIN_CAP) { atomicAdd(&bar[XB_TMO], 1u); break; } }
    }
    nloc = mine > 0u ? mine : 1u; nx = cnt > 0u ? cnt : 1u;
}
struct Args;
__device__ __forceinline__ bool convert_steal(const Args& a, int layer, LAS unsigned char* lds, int wave, int lane);
__device__ __forceinline__ void xcd_barrier(const XcdBarrier& b, const Args* bga = nullptr, int bg_layer = -1, LAS unsigned char* lds = nullptr) {
    asm volatile("s_waitcnt vmcnt(0)" ::: "memory");
    __syncthreads();
    if (threadIdx.x == 0) {
        unsigned* bar = b.bar;
        __builtin_amdgcn_s_waitcnt(0);
        unsigned nloc = b.st[0], nx = b.st[1];
        if (nloc == 0u) { xcd_barrier_complete(bar, b.x, nloc, nx); b.st[0] = nloc; b.st[1] = nx; }
        const unsigned old = xb_add(&bar[XB_XSUB(b.x)], 1u);
        const unsigned gen = old / nloc;
        if (old + 1u == (gen + 1u) * nloc) {
            __builtin_amdgcn_fence(__ATOMIC_RELEASE, "agent");
            asm volatile("s_waitcnt vmcnt(0)" ::: "memory");
            const unsigned og = xb_add(&bar[XB_TOP], 1u);
            const unsigned tg = og / nx;
            if (og + 1u == (tg + 1u) * nx) xb_add(&bar[XB_TOPGEN], 1u);
            else XB_SPIN(xb_ld(&bar[XB_TOPGEN]) == tg, bar);
            __builtin_amdgcn_fence(__ATOMIC_ACQUIRE, "agent");
            xb_add(&bar[XB_XGEN(b.x)], 1u);
            asm volatile("s_waitcnt vmcnt(0)" ::: "memory");
            b.st[2] = 0xFFFFFFFFu;
        } else if (bg_layer < 0) {
            XB_SPIN(xb_ld(&bar[XB_XGEN(b.x)]) == gen, bar);
            __builtin_amdgcn_fence(__ATOMIC_ACQUIRE, "agent");
            asm volatile("s_waitcnt vmcnt(0)" ::: "memory");
            b.st[2] = 0xFFFFFFFFu;
        } else b.st[2] = gen;
    }
    __syncthreads();
    if (bg_layer >= 0) {
        const unsigned gen = b.st[2];
        if (gen != 0xFFFFFFFFu) {
            const int lane = threadIdx.x & 63, wave = __builtin_amdgcn_readfirstlane(threadIdx.x >> 6);
            bool more = true;
            while (more && (unsigned)__builtin_amdgcn_readfirstlane((int)xb_ld(&b.bar[XB_XGEN(b.x)])) == gen) more = convert_steal(*bga, bg_layer, lds, wave, lane);
            asm volatile("s_waitcnt vmcnt(0)" ::: "memory");
            __syncthreads();
            if (threadIdx.x == 0) { XB_SPIN(xb_ld(&b.bar[XB_XGEN(b.x)]) == gen, b.bar); __builtin_amdgcn_fence(__ATOMIC_ACQUIRE, "agent"); asm volatile("s_waitcnt vmcnt(0)" ::: "memory"); }
        } else __syncthreads();
        __syncthreads();
    }
}

namespace pg8 {
constexpr int BM = 256, BK = 64, HALF = 128, HTB = HALF * BK * 2, STAGE_BYTES = 8 * HTB, NXCD = 8, WGM = 8;
__host__ __device__ __forceinline__ int lds_byte(int r, int c) { const int st = (r >> 4) * 2 + (c >> 5), rr = r & 15, cc = c & 31, ob = rr * 64 + cc * 2; return st * 1024 + (ob ^ (((ob >> 9) & 1) << 5)); }
__host__ __device__ __forceinline__ void stage_rc(int b, int& R, int& C) { const int st = b / 1024, sb = b % 1024, swz = sb ^ (((sb >> 9) & 1) << 5); R = (st >> 1) * 16 + swz / 64; C = (st & 1) * 32 + (swz % 64) / 2; }
__host__ __device__ __forceinline__ int perm32(int rho) { const int n = rho >> 4, i = rho & 15; return 8 * (i >> 2) + 4 * n + (i & 3); }

typedef int v8i __attribute__((ext_vector_type(8)));
typedef int v4i __attribute__((ext_vector_type(4)));
__device__ __forceinline__ v8i cat8(bf16x8 lo, bf16x8 hi) { const v4i a = __builtin_bit_cast(v4i, lo), b = __builtin_bit_cast(v4i, hi); return __builtin_shufflevector(a, b, 0, 1, 2, 3, 4, 5, 6, 7); }
struct Unit { const char* A; const char* B; const unsigned* gat; int nvalid; int i0, i1, i2; };

template <class Epi, class Sched, bool GATHER, bool ALIGN_EPI, bool SP2, int BMODE = 0, int F8 = 0>
__device__ __forceinline__ void gemm_phase(LAS unsigned char* lds, const unsigned lda, const unsigned ldb, const int nt, const Sched& S, const Epi& E) {
    const int tid = threadIdx.x, wid = __builtin_amdgcn_readfirstlane(tid >> 6), lane = tid & 63, wr = wid >> 2, wc = wid & 3, fr = lane & 15, fq = lane >> 4;
    int R0, C0, R1, C1; stage_rc(tid * 16, R0, C0); stage_rc(tid * 16 + 8192, R1, C1);
    const int Rb0 = BMODE == 0 ? (R0 & ~31) + perm32(R0 & 31) : 64 * (R0 >> 5) + 16 * ((R0 & 15) >> 2) + 4 * ((R0 >> 4) & 1) + (R0 & 3);
    const int Rb1 = BMODE == 0 ? (R1 & ~31) + perm32(R1 & 31) : 64 * (R1 >> 5) + 16 * ((R1 & 15) >> 2) + 4 * ((R1 >> 4) & 1) + (R1 & 3);
    const unsigned voffB0 = (unsigned)Rb0 * ldb + (unsigned)C0 * 2u, voffB1 = (unsigned)Rb1 * ldb + (unsigned)C1 * 2u;
    const size_t hstepB = (size_t)(BMODE == 0 ? HALF : 8) * ldb;
    const size_t kstep = (size_t)(BK * 2);
    const unsigned ldsw = (unsigned)wid * 1024u;
    const int aoff = lds_byte(wr * 64 + fr, F8 ? fq * 16 : fq * 8), boff = lds_byte(wc * 32 + fr, F8 ? fq * 16 : fq * 8);
    const int aoff2 = F8 ? lds_byte(wr * 64 + fr, fq * 16 + 8) : aoff + 1024, boff2 = F8 ? lds_byte(wc * 32 + fr, fq * 16 + 8) : boff + 1024;
#define PG8_SA(b, h) (((b) * 2 + (h)) * HTB)
#define PG8_SB(b, h) ((4 + (b) * 2 + (h)) * HTB)
#define PG8_STAGE(bufoff, gbase, v0, v1) do { unsigned _v0 = (v0), _v1 = (v1); asm volatile("" : "+v"(_v0), "+v"(_v1)); \
        __builtin_amdgcn_global_load_lds((const unsigned*)((const char*)(gbase) + _v0), (LAS unsigned*)(lds + (bufoff) + ldsw), 16, 0, 0); \
        __builtin_amdgcn_global_load_lds((const unsigned*)((const char*)(gbase) + _v1), (LAS unsigned*)(lds + (bufoff) + ldsw + 8192), 16, 0, 0); } while (0)
#define PG8_LDA(dst, b, h) do { _Pragma("unroll") for (int m = 0; m < 4; ++m) { dst[m][0] = *(const LAS bf16x8*)(lds + PG8_SA(b, h) + aoff + m * 2048); dst[m][1] = *(const LAS bf16x8*)(lds + PG8_SA(b, h) + aoff2 + m * 2048); } } while (0)
#define PG8_LDB(dst, b, h) do { _Pragma("unroll") for (int n = 0; n < 2; ++n) { dst[n][0] = *(const LAS bf16x8*)(lds + PG8_SB(b, h) + boff + n * 2048); dst[n][1] = *(const LAS bf16x8*)(lds + PG8_SB(b, h) + boff2 + n * 2048); } } while (0)
#define PG8_MMA(ai, bj, At, Bt) do { __builtin_amdgcn_s_setprio(1); _Pragma("unroll") for (int m = 0; m < 4; ++m) _Pragma("unroll") for (int n = 0; n < 2; ++n) { \
        if constexpr (F8) acc[ai][bj][m][n] = __builtin_amdgcn_mfma_scale_f32_16x16x128_f8f6f4(cat8(Bt[n][0], Bt[n][1]), cat8(At[m][0], At[m][1]), acc[ai][bj][m][n], 0, 0, 0, 0x7F7F7F7F, 0, 0x7F7F7F7F); \
        else { _Pragma("unroll") for (int k = 0; k < 2; ++k) acc[ai][bj][m][n] = __builtin_amdgcn_mfma_f32_16x16x32_bf16(Bt[n][k], At[m][k], acc[ai][bj][m][n], 0, 0, 0); } } __builtin_amdgcn_s_setprio(0); } while (0)
#define PG8_WAIT_V(n) asm volatile("s_waitcnt vmcnt(" #n ")" ::: "memory")
#define PG8_WAIT_L(n) asm volatile("s_waitcnt lgkmcnt(" #n ")" ::: "memory")
#define PG8_BAR __builtin_amdgcn_s_barrier()
#define PG8_SCHED __builtin_amdgcn_sched_barrier(0)
#define PG8_SETV(v00, v01, v10, v11, u) do { \
        if (GATHER) { int _t = tid; asm volatile("" : "+v"(_t)); int r0, c0, r1, c1; stage_rc(_t * 16, r0, c0); stage_rc(_t * 16 + 8192, r1, c1);     \
            const unsigned ta = r0 < (u).nvalid ? (u).gat[r0] : 0u, tb = r1 < (u).nvalid ? (u).gat[r1] : 0u, \
                                     tc = (HALF + r0) < (u).nvalid ? (u).gat[HALF + r0] : 0u, td = (HALF + r1) < (u).nvalid ? (u).gat[HALF + r1] : 0u; \
            v00 = ta * lda + (unsigned)c0 * 2u; v01 = tb * lda + (unsigned)c1 * 2u; v10 = tc * lda + (unsigned)c0 * 2u; v11 = td * lda + (unsigned)c1 * 2u; } \
        else { v00 = (unsigned)R0 * lda + (unsigned)C0 * 2u; v01 = (unsigned)R1 * lda + (unsigned)C1 * 2u; v10 = (unsigned)(HALF + R0) * lda + (unsigned)C0 * 2u; v11 = (unsigned)(HALF + R1) * lda + (unsigned)C1 * 2u; } } while (0)
    Unit cur, nxt; int ui = 0;
    if (!S.next(0, cur)) return;
    f32x4 acc[2][2][4][2];
#pragma unroll
    for (int a = 0; a < 2; ++a)
#pragma unroll
        for (int b = 0; b < 2; ++b)
#pragma unroll
            for (int m = 0; m < 4; ++m)
#pragma unroll
                for (int n = 0; n < 2; ++n) acc[a][b][m][n] = (f32x4){0.f, 0.f, 0.f, 0.f};
    bf16x8 At[4][2], B0[2][2], B1[2][2];
    const char* cA = cur.A; const char* cB = cur.B;
    unsigned cv00, cv01, cv10, cv11;
    PG8_SETV(cv00, cv01, cv10, cv11, cur);
    if constexpr (SP2) {
        PG8_STAGE(PG8_SB(0, 0), cB, voffB0, voffB1); PG8_STAGE(PG8_SB(0, 1), cB + hstepB, voffB0, voffB1); PG8_STAGE(PG8_SA(0, 0), cA, cv00, cv01); PG8_STAGE(PG8_SA(0, 1), cA, cv10, cv11);
        if (wr == 1) PG8_BAR;
        PG8_WAIT_V(2); PG8_BAR;
        PG8_STAGE(PG8_SB(1, 0), cB + kstep, voffB0, voffB1); PG8_STAGE(PG8_SA(1, 0), cA + kstep, cv00, cv01); PG8_STAGE(PG8_SB(1, 1), cB + hstepB + kstep, voffB0, voffB1);
        PG8_WAIT_V(6); PG8_BAR;
    } else {
        PG8_STAGE(PG8_SB(0, 0), cB, voffB0, voffB1); PG8_STAGE(PG8_SA(0, 0), cA, cv00, cv01); PG8_STAGE(PG8_SB(0, 1), cB + hstepB, voffB0, voffB1); PG8_STAGE(PG8_SA(0, 1), cA, cv10, cv11);
        if (wr == 1) PG8_BAR;
        PG8_WAIT_V(4); PG8_BAR;
        PG8_STAGE(PG8_SB(1, 0), cB + kstep, voffB0, voffB1); PG8_STAGE(PG8_SA(1, 0), cA + kstep, cv00, cv01); PG8_STAGE(PG8_SB(1, 1), cB + hstepB + kstep, voffB0, voffB1);
        PG8_WAIT_V(6); PG8_BAR;
    }
    for (;;) {
        const bool has_next = S.next(ui + 1, nxt);
        const char* nA = has_next ? nxt.A : cA; const char* nB = has_next ? nxt.B : cB;
#pragma unroll 1
        for (int t = 0; t < nt; t += 2) {
            const bool last = (t == nt - 2);
            const char* a1 = cA + (size_t)(t + 1) * kstep;
            const char* a2 = last ? nA : cA + (size_t)(t + 2) * kstep; const char* b2 = last ? nB : cB + (size_t)(t + 2) * kstep;
            const char* a3 = a2 + kstep; const char* b3 = b2 + kstep;
            if constexpr (SP2) {
            PG8_LDB(B0, 0, 0); PG8_LDB(B1, 0, 1); PG8_SCHED; PG8_LDA(At, 0, 0); PG8_STAGE(PG8_SA(1, 1), a1, cv10, cv11);
            PG8_WAIT_V(8); PG8_WAIT_L(0); PG8_BAR; PG8_MMA(0, 0, At, B0); PG8_MMA(0, 1, At, B1); PG8_BAR; PG8_SCHED;
            if constexpr (GATHER) { if (last && has_next) { PG8_SETV(cv00, cv01, cv10, cv11, nxt); } }
            PG8_LDA(At, 0, 1); PG8_STAGE(PG8_SB(0, 0), b2, voffB0, voffB1); PG8_STAGE(PG8_SB(0, 1), b2 + hstepB, voffB0, voffB1); PG8_STAGE(PG8_SA(0, 0), a2, cv00, cv01);
            PG8_WAIT_V(8); PG8_WAIT_L(0); PG8_BAR; PG8_MMA(1, 0, At, B0); PG8_MMA(1, 1, At, B1); PG8_BAR; PG8_SCHED;
            PG8_LDB(B0, 1, 0); PG8_LDB(B1, 1, 1); PG8_SCHED; PG8_LDA(At, 1, 0); PG8_STAGE(PG8_SA(0, 1), a2, cv10, cv11);
            PG8_WAIT_V(8); PG8_WAIT_L(0); PG8_BAR; PG8_MMA(0, 0, At, B0); PG8_MMA(0, 1, At, B1); PG8_BAR; PG8_SCHED;
            PG8_LDA(At, 1, 1); PG8_STAGE(PG8_SB(1, 0), b3, voffB0, voffB1); PG8_STAGE(PG8_SB(1, 1), b3 + hstepB, voffB0, voffB1); PG8_STAGE(PG8_SA(1, 0), a3, cv00, cv01);
            PG8_WAIT_V(8); PG8_WAIT_L(0); PG8_BAR; PG8_MMA(1, 0, At, B0); PG8_MMA(1, 1, At, B1); PG8_BAR; PG8_SCHED;
            } else {
            PG8_LDB(B0, 0, 0); PG8_SCHED; PG8_LDA(At, 0, 0); PG8_STAGE(PG8_SA(1, 1), a1, cv10, cv11);
            PG8_WAIT_L(8); PG8_BAR; PG8_WAIT_L(0); PG8_MMA(0, 0, At, B0); PG8_BAR; PG8_SCHED;
            if constexpr (GATHER) { if (last && has_next) { PG8_SETV(cv00, cv01, cv10, cv11, nxt); } }
            PG8_LDB(B1, 0, 1); PG8_STAGE(PG8_SB(0, 0), b2, voffB0, voffB1);
            PG8_BAR; PG8_WAIT_L(0); PG8_MMA(0, 1, At, B1); PG8_BAR;
            PG8_LDA(At, 0, 1); PG8_STAGE(PG8_SA(0, 0), a2, cv00, cv01);
            PG8_BAR; PG8_WAIT_L(0); PG8_MMA(1, 0, At, B0); PG8_BAR; PG8_SCHED;
            PG8_STAGE(PG8_SB(0, 1), b2 + hstepB, voffB0, voffB1);
            PG8_WAIT_V(6); PG8_BAR; PG8_MMA(1, 1, At, B1); PG8_BAR;
            PG8_LDB(B0, 1, 0); PG8_SCHED; PG8_LDA(At, 1, 0); PG8_STAGE(PG8_SA(0, 1), a2, cv10, cv11);
            PG8_WAIT_L(8); PG8_BAR; PG8_WAIT_L(0); PG8_MMA(0, 0, At, B0); PG8_BAR; PG8_SCHED;
            PG8_LDB(B1, 1, 1); PG8_STAGE(PG8_SB(1, 0), b3, voffB0, voffB1);
            PG8_BAR; PG8_WAIT_L(0); PG8_MMA(0, 1, At, B1); PG8_BAR;
            PG8_LDA(At, 1, 1); PG8_STAGE(PG8_SA(1, 0), a3, cv00, cv01);
            PG8_BAR; PG8_WAIT_L(0); PG8_MMA(1, 0, At, B0); PG8_BAR; PG8_SCHED;
            PG8_STAGE(PG8_SB(1, 1), b3 + hstepB, voffB0, voffB1);
            PG8_WAIT_V(6); PG8_BAR; PG8_MMA(1, 1, At, B1); PG8_BAR;
            }
        }
        if constexpr (ALIGN_EPI) { if (wr == 0) PG8_BAR; }
        { int t2 = tid; asm volatile("" : "+v"(t2));
          E(acc, cur, wr, wc, t2 & 15, (t2 & 63) >> 4); }
        if (!has_next) break;
#pragma unroll
        for (int a = 0; a < 2; ++a)
#pragma unroll
            for (int b = 0; b < 2; ++b)
#pragma unroll
                for (int m = 0; m < 4; ++m)
#pragma unroll
                    for (int n = 0; n < 2; ++n) acc[a][b][m][n] = (f32x4){0.f, 0.f, 0.f, 0.f};
        cur = nxt; cA = nA; cB = nB; ++ui;
        if constexpr (ALIGN_EPI) { if (wr == 1) PG8_BAR; }
    }
    PG8_WAIT_V(0);
    if constexpr (!ALIGN_EPI) { if (wr == 0) PG8_BAR; }
    PG8_BAR;
#undef PG8_SA
#undef PG8_SB
#undef PG8_STAGE
#undef PG8_LDA
#undef PG8_LDB
#undef PG8_MMA
#undef PG8_WAIT_V
#undef PG8_WAIT_L
#undef PG8_BAR
#undef PG8_SCHED
#undef PG8_SETV
}

struct DenseSched {
    const char* A; const char* B; unsigned lda, ldb, a_pn; int nM, nN, nwg, G, c; const unsigned* ident = nullptr;
    __device__ __forceinline__ bool next(int i, Unit& u) const {
        const long L = (long)i * G + c; if (L >= nwg) return false;
        int wgid = (int)L; { const int q = nwg / NXCD, r = nwg % NXCD, xcd = wgid % NXCD, off = wgid / NXCD; wgid = (xcd < r ? xcd * (q + 1) : r * (q + 1) + (xcd - r) * q) + off; }
        const int nig = WGM * nN, gid = wgid / nig, fm = gid * WGM, gsz = (nM - fm) < WGM ? (nM - fm) : WGM;
        const int pm = fm + ((wgid % nig) % gsz), pn = (wgid % nig) / gsz;
        u.A = ident ? A : A + (size_t)pm * BM * lda + (size_t)pn * a_pn; u.B = B + (size_t)pn * BM * ldb; u.gat = ident ? ident + pm * BM : nullptr; u.nvalid = BM; u.i0 = pm; u.i1 = pn; u.i2 = 0; return true;
    }
};
struct MoeInfo { const LAS unsigned* cnt; const LAS unsigned* tstart; const LAS unsigned* ystart; const LAS unsigned char* tile_e; int ntiles; };
struct G1Sched {
    MoeInfo mi; const char* XB; const char* Wgu; const unsigned* rowtok; const unsigned* ident; int G, vcu;
    __device__ __forceinline__ bool next(int i, Unit& u) const {
        const int L = i * G + vcu; if (L >= 2 * mi.ntiles) return false;
        const int tile = L >> 1, uu = L & 1; int e;
        if (tile < 64) { e = 64; u.gat = ident + tile * 256; u.nvalid = 256; }
        else { e = __builtin_amdgcn_readfirstlane((int)mi.tile_e[tile]); const int pos0 = (tile - __builtin_amdgcn_readfirstlane((int)mi.tstart[e])) * 256; u.gat = rowtok + (size_t)e * CAP + pos0; const int rem = __builtin_amdgcn_readfirstlane((int)mi.cnt[e]) - pos0; u.nvalid = rem < 256 ? rem : 256; }
        u.A = XB; u.B = Wgu + ((size_t)e * 512 + (size_t)uu * 256) * 1024; u.i0 = tile; u.i1 = uu; u.i2 = 0; return true;
    }
};
struct G2Sched {
    MoeInfo mi; const char* H; const char* Wd; int G, vcu, L0;
    __device__ __forceinline__ bool next(int i, Unit& u) const {
        const int L = i * G + vcu + L0; if (L >= 4 * mi.ntiles) return false;
        const int tile = L >> 2, pn = L & 3; int e;
        if (tile < 64) { e = 64; u.i0 = 131072 + tile * 256; u.i2 = 0; u.nvalid = 256; }
        else { e = __builtin_amdgcn_readfirstlane((int)mi.tile_e[tile]); const int pos0 = (tile - __builtin_amdgcn_readfirstlane((int)mi.tstart[e])) * 256; u.i0 = __builtin_amdgcn_readfirstlane((int)mi.ystart[e]) + pos0; u.i2 = 0; const int rem = __builtin_amdgcn_readfirstlane((int)mi.cnt[e]) - pos0; u.nvalid = rem < 256 ? rem : 256; }
        u.A = H + (size_t)tile * 256 * 256; u.B = Wd + ((size_t)e * 1024 + (size_t)pn * 256) * 256; u.gat = nullptr; u.i1 = pn; return true;
    }
};

template <int ACT, bool BIAS, bool SCALE, bool W32 = false> struct EpiBf16 {
    bf16* O; int ldo; const float* bias; const float* scale;
    __device__ __forceinline__ void operator()(const f32x4 (&acc)[2][2][4][2], const Unit& u, int wr, int wc, int fr, int fq) const {
        const int row0 = u.i0 * BM + wr * 64 + fr, col0 = u.i1 * BM + wc * 32 + 8 * fq;
        f32x4 bv[2][2], sv[2][2];
#pragma unroll
        for (int bj = 0; bj < 2; ++bj)
#pragma unroll
            for (int n = 0; n < 2; ++n) { bv[bj][n] = BIAS ? *(const f32x4*)(bias + col0 + bj * HALF + 4 * n) : (f32x4){0.f, 0.f, 0.f, 0.f}; sv[bj][n] = SCALE ? *(const f32x4*)(scale + col0 + bj * HALF + 4 * n) : (f32x4){1.f, 1.f, 1.f, 1.f}; }
#pragma unroll
        for (int ai = 0; ai < 2; ++ai)
#pragma unroll
            for (int m = 0; m < 4; ++m) { bf16* rowp = O + (size_t)(row0 + ai * HALF + m * 16) * ldo + col0;
#pragma unroll
                for (int bj = 0; bj < 2; ++bj) { f32x4 v0 = acc[ai][bj][m][0] * (W32 ? 0.03125f : 1.0f) + bv[bj][0], v1 = acc[ai][bj][m][1] * (W32 ? 0.03125f : 1.0f) + bv[bj][1];
                    if (ACT == 1) {
#pragma unroll
                        for (int j = 0; j < 4; ++j) { v0[j] = gelu_tanh(v0[j]); v1[j] = gelu_tanh(v1[j]); } }
                    if (SCALE) { v0 = v0 * sv[bj][0]; v1 = v1 * sv[bj][1]; }
                    v4u w; w.x = cvt_pk_bf16(v0[0], v0[1]); w.y = cvt_pk_bf16(v0[2], v0[3]); w.z = cvt_pk_bf16(v1[0], v1[1]); w.w = cvt_pk_bf16(v1[2], v1[3]);
                    *(v4u*)(rowp + bj * HALF) = w; } }
    }
};
struct EpiResid {
    const float* base; float* out;
    __device__ __forceinline__ void operator()(const f32x4 (&acc)[2][2][4][2], const Unit& u, int wr, int wc, int fr, int fq) const {
        const int row0 = u.i0 * BM + wr * 64 + fr, col0 = u.i1 * BM + wc * 32 + 8 * fq;
#pragma unroll
        for (int ai = 0; ai < 2; ++ai)
#pragma unroll
            for (int m = 0; m < 4; ++m) { const size_t off = (size_t)(row0 + ai * HALF + m * 16) * DM + col0;
#pragma unroll
                for (int bj = 0; bj < 2; ++bj) { const f32x4 b0 = *(const f32x4*)(base + off + bj * HALF), b1 = *(const f32x4*)(base + off + bj * HALF + 4);
                    *(f32x4*)(out + off + bj * HALF) = b0 * ALPHA + acc[ai][bj][m][0]; *(f32x4*)(out + off + bj * HALF + 4) = b1 * ALPHA + acc[ai][bj][m][1]; }
                asm volatile("" ::: "memory"); }
    }
};
struct EpiSwiglu {
    unsigned char* H8;
    __device__ __forceinline__ void operator()(const f32x4 (&acc)[2][2][4][2], const Unit& u, int wr, int wc, int fr, int fq) const {
        const int row0 = u.i0 * BM + wr * 64 + fr, col0 = u.i1 * HALF + wc * 32 + 8 * fq;
#pragma unroll
        for (int ai = 0; ai < 2; ++ai)
#pragma unroll
            for (int m = 0; m < 4; ++m) { unsigned char* rowp = H8 + (size_t)(row0 + ai * HALF + m * 16) * EDIM + col0; float h[8];
#pragma unroll
                for (int n = 0; n < 2; ++n)
#pragma unroll
                    for (int j = 0; j < 4; ++j) { const float g = acc[ai][0][m][n][j] * 0.03125f, up = acc[ai][1][m][n][j] * 0.25f; h[4 * n + j] = g * sigmoidf_(g) * up; }
                int t0 = 0, t1 = 0; t0 = __builtin_amdgcn_cvt_pk_fp8_f32(h[0], h[1], t0, false); t0 = __builtin_amdgcn_cvt_pk_fp8_f32(h[2], h[3], t0, true); t1 = __builtin_amdgcn_cvt_pk_fp8_f32(h[4], h[5], t1, false); t1 = __builtin_amdgcn_cvt_pk_fp8_f32(h[6], h[7], t1, true);
                *(v2u*)rowp = (v2u){(unsigned)t0, (unsigned)t1}; }
    }
};
struct EpiDown {
    unsigned char* Y8;
    __device__ __forceinline__ void operator()(const f32x4 (&acc)[2][2][4][2], const Unit& u, int wr, int wc, int fr, int fq) const {
        const int r0 = wr * 64 + fr, col0 = u.i1 * BM + wc * 64 + 16 * fq;
#pragma unroll
        for (int ai = 0; ai < 2; ++ai)
#pragma unroll
            for (int m = 0; m < 4; ++m) { const int r = r0 + ai * HALF + m * 16;
                if (r < u.nvalid) { v4u w;
#pragma unroll
                    for (int q = 0; q < 4; ++q) { const f32x4 v = acc[ai][q >> 1][m][q & 1] * 0.0625f;     int t = 0; t = __builtin_amdgcn_cvt_pk_fp8_f32(v[0], v[1], t, false); t = __builtin_amdgcn_cvt_pk_fp8_f32(v[2], v[3], t, true); w[q] = (unsigned)t; }
                    *(v4u*)(Y8 + (size_t)(u.i0 + r) * DM + col0) = w; } }
    }
};
}

struct Args { const float* in[24]; float* out; unsigned char* ws; int ph_lo, ph_hi; };
enum { I_X = 0, I_PWIN, I_PWGRP, I_PSCALE, I_PWOUT, I_SWIN, I_SBIN, I_SLNG, I_SLNB, I_SWS, I_SBS, I_SWOUT, I_LNMG, I_LNMB, I_WR, I_RB, I_WG, I_WU, I_WD, I_SHG, I_SHU, I_SHD, I_LNFG, I_LNFB };

__device__ __forceinline__ void tr_item(const float* W, int N, int k0, int n0, bf16* dst  , int dpitch, LAS float* scr, int lane) {
#pragma unroll 8
    for (int i = 0; i < 32; ++i) { const int kk = 2 * i + (lane >> 5); scr[kk * 33 + (lane & 31)] = W[(size_t)(k0 + kk) * N + n0 + (lane & 31)]; }
    LDS_WAIT(); asm volatile("" ::: "memory");
    const int c = lane & 7;
#pragma unroll
    for (int j = 0; j < 4; ++j) { const int n = (lane >> 3) + 8 * j; const LAS float* s = scr + (8 * c) * 33 + n;
        v4u o; o.x = cvt_pk_bf16(s[0 * 33], s[1 * 33]); o.y = cvt_pk_bf16(s[2 * 33], s[3 * 33]); o.z = cvt_pk_bf16(s[4 * 33], s[5 * 33]); o.w = cvt_pk_bf16(s[6 * 33], s[7 * 33]);
        *(v4u*)(dst + (size_t)n * dpitch + 8 * c) = o; }
    LDS_WAIT(); asm volatile("" ::: "memory");
}
__device__ __forceinline__ void tr_item_f8(const float* W, int N, int k0, int n0, unsigned char* dst, int dpitch, float scale, LAS float* scr, int lane) {
#pragma unroll 8
    for (int i = 0; i < 32; ++i) { const int kk = 2 * i + (lane >> 5); scr[kk * 33 + (lane & 31)] = W[(size_t)(k0 + kk) * N + n0 + (lane & 31)]; }
    LDS_WAIT(); asm volatile("" ::: "memory");
    const int c = lane & 7;
#pragma unroll
    for (int j = 0; j < 4; ++j) { const int n = (lane >> 3) + 8 * j; const LAS float* s = scr + (8 * c) * 33 + n;
        int t0 = 0, t1 = 0;
        t0 = __builtin_amdgcn_cvt_pk_fp8_f32(s[0 * 33] * scale, s[1 * 33] * scale, t0, false); t0 = __builtin_amdgcn_cvt_pk_fp8_f32(s[2 * 33] * scale, s[3 * 33] * scale, t0, true);
        t1 = __builtin_amdgcn_cvt_pk_fp8_f32(s[4 * 33] * scale, s[5 * 33] * scale, t1, false); t1 = __builtin_amdgcn_cvt_pk_fp8_f32(s[6 * 33] * scale, s[7 * 33] * scale, t1, true);
        *(v2u*)(dst + (size_t)n * dpitch + 8 * c) = (v2u){(unsigned)t0, (unsigned)t1}; }
    LDS_WAIT(); asm volatile("" ::: "memory");
}
__device__ __forceinline__ void tr_tall_f8(const float* W, int N, int k0, int n0, unsigned char* dst, int dpitch, float scale, LAS float* scr, int lane) {
    f32x4 q[16]; const int r8 = lane >> 3, c4 = 4 * (lane & 7);
#pragma unroll
    for (int i = 0; i < 16; ++i) q[i] = *(const f32x4*)(W + (size_t)(k0 + 8 * i + r8) * N + n0 + c4);
#pragma unroll
    for (int i = 0; i < 16; ++i) { const int kk = 8 * i + r8; *(LAS f32x4*)(scr + kk * 32 + ((c4 + 4 * (kk >> 4)) & 31)) = q[i]; }
    LDS_WAIT(); asm volatile("" ::: "memory");
    const int c = lane & 7;
#pragma unroll
    for (int j = 0; j < 4; ++j) { const int n = r8 + 8 * j; const int col = (n + 4 * c) & 31; v4u o;
#pragma unroll
        for (int z = 0; z < 4; ++z) { const LAS float* sp = scr + (16 * c + 4 * z) * 32 + col; int t = 0;
            t = __builtin_amdgcn_cvt_pk_fp8_f32(sp[0] * scale, sp[32] * scale, t, false); t = __builtin_amdgcn_cvt_pk_fp8_f32(sp[64] * scale, sp[96] * scale, t, true); o[z] = (unsigned)t; }
        *(v4u*)(dst + (size_t)n * dpitch + 16 * c) = o; }
    LDS_WAIT(); asm volatile("" ::: "memory");
}
template <bool SPLIT> __device__ __forceinline__ void tr_block_f8(const float* W, int N, int k0, int n0, unsigned char* dst, int dpitch, float scale, LAS float* tile, int wave, int lane) {
    f32x4 q[16];
#pragma unroll
    for (int i = 0; i < 16; ++i) q[i] = *(const f32x4*)(W + (size_t)(k0 + 16 * wave + i) * N + n0 + 4 * lane);
#pragma unroll
    for (int i = 0; i < 16; ++i) { const int kk = 16 * wave + i; *(LAS f32x4*)(tile + kk * 256 + ((4 * lane + 4 * (kk >> 4)) & 255)) = q[i]; }
    LDS_WAIT(); __syncthreads();
    const int c = lane & 7, r8 = lane >> 3;
#pragma unroll
    for (int j = 0; j < 4; ++j) { const int n = 32 * wave + r8 + 8 * j; const int col = (n + 4 * c) & 255; v4u o;
#pragma unroll
        for (int z = 0; z < 4; ++z) { const LAS float* sp = tile + (16 * c + 4 * z) * 256 + col; int t = 0;
            t = __builtin_amdgcn_cvt_pk_fp8_f32(sp[0] * scale, sp[256] * scale, t, false); t = __builtin_amdgcn_cvt_pk_fp8_f32(sp[512] * scale, sp[768] * scale, t, true); o[z] = (unsigned)t; }
        *(v4u*)(dst + (size_t)(SPLIT ? ((n >> 7) * 256 + (n & 127)) : n) * dpitch + 16 * c) = o; }
    LDS_WAIT(); __syncthreads();
}
__device__ __forceinline__ void tr_item_hilo(const float* W, int N, int k0, int n0, bf16* dh, bf16* dl, int dpitch, LAS float* scr, int lane) {
#pragma unroll 8
    for (int i = 0; i < 32; ++i) { const int kk = 2 * i + (lane >> 5); scr[kk * 33 + (lane & 31)] = W[(size_t)(k0 + kk) * N + n0 + (lane & 31)]; }
    LDS_WAIT(); asm volatile("" ::: "memory");
    const int c = lane & 7;
#pragma unroll
    for (int j = 0; j < 4; ++j) { const int n = (lane >> 3) + 8 * j; const LAS float* s = scr + (8 * c) * 33 + n; float w[8];
#pragma unroll
        for (int z = 0; z < 8; ++z) w[z] = s[z * 33];
        v4u o; o.x = cvt_pk_bf16(w[0], w[1]); o.y = cvt_pk_bf16(w[2], w[3]); o.z = cvt_pk_bf16(w[4], w[5]); o.w = cvt_pk_bf16(w[6], w[7]);
        v4u l; l.x = cvt_pk_bf16(w[0] - bf_lo(o.x), w[1] - bf_hi(o.x)); l.y = cvt_pk_bf16(w[2] - bf_lo(o.y), w[3] - bf_hi(o.y)); l.z = cvt_pk_bf16(w[4] - bf_lo(o.z), w[5] - bf_hi(o.z)); l.w = cvt_pk_bf16(w[6] - bf_lo(o.w), w[7] - bf_hi(o.w));
        *(v4u*)(dh + (size_t)n * dpitch + 8 * c) = o; *(v4u*)(dl + (size_t)n * dpitch + 8 * c) = l; }
    LDS_WAIT(); asm volatile("" ::: "memory");
}
constexpr int MOE_ITEMS = 65 * 192;
__device__ __forceinline__ void convert_moe_item(const Args& a, int layer, int it, LAS float* scr, int lane) {
    unsigned char* WGU = a.ws + WS_WGU + (size_t)layer * WS_MOE_LSTRIDE; unsigned char* WDN = a.ws + WS_WDN + (size_t)layer * WS_MOE_LSTRIDE;
    const int e = it / 192, r = it % 192;
    if (r < 128) { const int isup = r >> 6, rr = r & 63, kb = rr >> 3, nb = rr & 7, n0 = 32 * nb, k0 = 128 * kb;
        const float* src = (e < 64) ? a.in[isup ? I_WU : I_WG] + ((size_t)layer * 64 + e) * 262144 : a.in[isup ? I_SHU : I_SHG] + (size_t)layer * 262144;
        const int drow = e * 512 + (n0 >> 7) * 256 + isup * 128 + (n0 & 127);
        tr_tall_f8(src, 256, k0, n0, WGU + (size_t)drow * 1024 + k0, 1024, 32.0f, scr, lane);
    } else { const int rr = r - 128, kb = rr >> 5, nb = rr & 31, n0 = 32 * nb, k0 = 128 * kb;
        const float* src = (e < 64) ? a.in[I_WD] + ((size_t)layer * 64 + e) * 262144 : a.in[I_SHD] + (size_t)layer * 262144;
        tr_tall_f8(src, 1024, k0, n0, WDN + ((size_t)e * 1024 + n0) * 256 + k0, 256, 32.0f, scr, lane);
    }
}
constexpr int Q_SHARDS = 8, Q_PER_SHARD = MOE_ITEMS / Q_SHARDS;
static_assert(Q_PER_SHARD * Q_SHARDS == MOE_ITEMS, "queue shards");
template <int CHUNK> __device__ __forceinline__ bool convert_steal_n(const Args& a, int layer, LAS unsigned char* lds, int wave, int lane) {
    unsigned* q = (unsigned*)(a.ws + WS_CTL) + CW_QNEXT + 512 * layer;
    const int s0 = (int)(blockIdx.x & 7);
    for (int s = 0; s < Q_SHARDS; ++s) { const int sh = (s0 + s) & 7;
        unsigned it = 0; if (lane == 0) it = __hip_atomic_fetch_add(q + 64 * sh, (unsigned)CHUNK, RLX_AGENT);
        it = (unsigned)__builtin_amdgcn_readfirstlane((int)it);
        if (it < (unsigned)Q_PER_SHARD) {
            for (int c = 0; c < CHUNK; ++c) if (it + c < (unsigned)Q_PER_SHARD) convert_moe_item(a, layer, sh * Q_PER_SHARD + (int)it + c, (LAS float*)(lds + wave * 16384), lane);
            return true; } }
    return false;
}
__device__ __forceinline__ bool convert_steal(const Args& a, int layer, LAS unsigned char* lds, int wave, int lane) { return convert_steal_n<1>(a, layer, lds, wave, lane); }
constexpr int MOE_WG_ITEMS = 65 * 24;
__device__ __forceinline__ void convert_static(const Args& a, int layer, LAS unsigned char* lds, int vcu, int G) {
    const int lane = threadIdx.x & 63, wave = __builtin_amdgcn_readfirstlane(threadIdx.x >> 6);
    unsigned char* WGU = a.ws + WS_WGU + (size_t)layer * WS_MOE_LSTRIDE; unsigned char* WDN = a.ws + WS_WDN + (size_t)layer * WS_MOE_LSTRIDE;
    __syncthreads();
#pragma unroll 1
    for (int it = vcu; it < MOE_WG_ITEMS; it += G) { const int e = it / 24, r = it % 24;
        if (r < 16) { const int isup = r >> 3, k0 = 128 * (r & 7);
            const float* src = (e < 64) ? a.in[isup ? I_WU : I_WG] + ((size_t)layer * 64 + e) * 262144 : a.in[isup ? I_SHU : I_SHG] + (size_t)layer * 262144;
            tr_block_f8<true>(src, 256, k0, 0, WGU + ((size_t)e * 512 + isup * 128) * 1024 + k0, 1024, 32.0f, (LAS float*)lds, wave, lane);
        } else { const int rr = r - 16, k0 = 128 * (rr >> 2), n0 = 256 * (rr & 3);
            const float* src = (e < 64) ? a.in[I_WD] + ((size_t)layer * 64 + e) * 262144 : a.in[I_SHD] + (size_t)layer * 262144;
            tr_block_f8<false>(src, 1024, k0, n0, WDN + ((size_t)e * 1024 + n0) * 256 + k0, 256, 32.0f, (LAS float*)lds, wave, lane);
        } }
}
__device__ __forceinline__ void convert_drain(const Args& a, int layer, LAS unsigned char* lds) {
    const int lane = threadIdx.x & 63, wave = __builtin_amdgcn_readfirstlane(threadIdx.x >> 6);
    while (convert_steal_n<4>(a, layer, lds, wave, lane)) {}
    __syncthreads();
}
__device__ __forceinline__ void phase_p0(const Args& a, LAS unsigned char* lds, int vcu, int G) {
    const int tid = threadIdx.x, lane = tid & 63, wave = __builtin_amdgcn_readfirstlane(tid >> 6);
    const int gw = vcu * NWAVES + wave, NGW = G * NWAVES;
    LAS float* scr = (LAS float*)(lds + wave * 16384);
    constexpr int I_IN = 16 * 32, I_GRP = 4 * 4 * 8, I_OUT = 16 * 32, I_SIN = 16 * 128, I_SOUT = 32 * 32, NIT = I_IN + I_GRP + I_OUT + I_SIN + I_SOUT;
    for (int it = gw; it < NIT; it += NGW) {
        int r = it;
        if (r < I_IN) { const int kb = r >> 5, nb = r & 31; tr_item(a.in[I_PWIN], 1024, 64 * kb, 32 * nb, (bf16*)(a.ws + WS_WIN) + (size_t)(32 * nb) * 1024 + 64 * kb, 1024, scr, lane); continue; } r -= I_IN;
        if (r < I_GRP) { const int g = r >> 5, rr = r & 31, kb = rr >> 3, nb = rr & 7; tr_item(a.in[I_PWGRP] + (size_t)g * 65536, 256, 64 * kb, 32 * nb, (bf16*)(a.ws + WS_WGRP) + (size_t)(g * 256 + 32 * nb) * 256 + 64 * kb, 256, scr, lane); continue; } r -= I_GRP;
        if (r < I_OUT) { const int kb = r >> 5, nb = r & 31; tr_item(a.in[I_PWOUT], 1024, 64 * kb, 32 * nb, (bf16*)(a.ws + WS_WOUT) + (size_t)(32 * nb) * 1024 + 64 * kb, 1024, scr, lane); continue; } r -= I_OUT;
        if (r < I_SIN) { const int kb = r >> 7, nb = r & 127; tr_item_f8(a.in[I_SWIN], 4096, 64 * kb, 32 * nb, a.ws + WS_WSIN + (size_t)(32 * nb) * 1024 + 64 * kb, 1024, 32.0f, scr, lane); continue; } r -= I_SIN;
        { const int kb = r >> 5, nb = r & 31; tr_item(a.in[I_SWOUT], 1024, 64 * kb, 32 * nb, (bf16*)(a.ws + WS_WSOUT) + (size_t)(32 * nb) * 2048 + 64 * kb, 2048, scr, lane); }
    }
    for (int it = gw; it < 64; it += NGW) { const int layer = it >> 5, rr = it & 31, kb = rr >> 1, nb = rr & 1; bf16* base = (bf16*)(a.ws + WS_WRT) + (size_t)layer * 2 * 65536 + (size_t)(32 * nb) * 1024 + 64 * kb;
        tr_item_hilo(a.in[I_WR] + (size_t)layer * DM * NE, 64, 64 * kb, 32 * nb, base, base + 65536, 1024, scr, lane); }
    convert_static(a, 0, lds, vcu, G);
    const float* x = a.in[I_X]; bf16* xb = (bf16*)(a.ws + WS_XB);
    const size_t gt = (size_t)vcu * NTHR + tid, NT = (size_t)G * NTHR;
#pragma unroll 1
    for (size_t i0 = gt; i0 < (size_t)T_TOK * DM / 8; i0 += 8 * NT) { f32x4 p[8], q[8];
#pragma unroll
        for (int u = 0; u < 8; ++u) { const size_t i = i0 + (size_t)u * NT; p[u] = *(const f32x4*)(x + i * 8); q[u] = *(const f32x4*)(x + i * 8 + 4); }
#pragma unroll
        for (int u = 0; u < 8; ++u) { const size_t i = i0 + (size_t)u * NT; v4u w; w.x = cvt_pk_bf16(p[u][0], p[u][1]); w.y = cvt_pk_bf16(p[u][2], p[u][3]); w.z = cvt_pk_bf16(q[u][0], q[u][1]); w.w = cvt_pk_bf16(q[u][2], q[u][3]); *(v4u*)(xb + i * 8) = w; } }
    unsigned* ident = (unsigned*)(a.ws + WS_IDENT);
    for (size_t i = gt; i < (size_t)T_TOK; i += NT) ident[i] = (unsigned)i;
}

template <int W> __device__ __forceinline__ void pool_item(const bf16* zp  , bf16* op  , int p0  ) {
    v4u q[W + 3];
#pragma unroll
    for (int i = 0; i < W + 3; ++i) { const int ii = i < p0 + 3 ? i : p0 + 3; q[i] = *(const v4u*)(zp - (size_t)ii * DM); }
#pragma unroll
    for (int o = 0; o < 4; ++o) {
        float s[8];
#pragma unroll
        for (int j = 0; j < 8; ++j) s[j] = 0.f;
#pragma unroll
        for (int i = 3 - o; i < 3 - o + W; ++i) { const float m = (i <= p0 + 3) ? 1.0f : 0.0f;
#pragma unroll
            for (int j = 0; j < 4; ++j) { s[2 * j] += m * bf_lo(q[i][j]); s[2 * j + 1] += m * bf_hi(q[i][j]); } }
        const int p = p0 + o, nw = (p + 1) < W ? (p + 1) : W; const float inv = 1.0f / (float)nw; v4u ov;
#pragma unroll
        for (int j = 0; j < 4; ++j) ov[j] = cvt_pk_bf16(s[2 * j] * inv - bf_lo(q[3 - o][j]), s[2 * j + 1] * inv - bf_hi(q[3 - o][j]));
        *(v4u*)(op + (size_t)o * DM) = ov; }
}
__device__ __forceinline__ void pool_block(const Args& a, int pm, int g) {
    const bf16* Z = (const bf16*)(a.ws + WS_Z); bf16* P = (bf16*)(a.ws + WS_POOLED);
    const int tid = threadIdx.x;
#pragma unroll 1
    for (int q = tid; q < 64 * 32; q += NTHR) { const int c8 = q & 31, tg = q >> 5, t0 = pm * 256 + tg * 4, p0 = t0 & (SEQ - 1);
        const bf16* zp = Z + (size_t)(t0 + 3) * DM + g * 256 + c8 * 8; bf16* op = P + (size_t)t0 * DM + g * 256 + c8 * 8;
        if (g == 0) pool_item<2>(zp, op, p0); else if (g == 1) pool_item<4>(zp, op, p0); else if (g == 2) pool_item<8>(zp, op, p0); else pool_item<16>(zp, op, p0); }
    VM_WAIT(); __syncthreads();
}
__device__ __forceinline__ void phase_pool(const Args& a, int vcu, int G) {
    const bf16* Z = (const bf16*)(a.ws + WS_Z); bf16* P = (bf16*)(a.ws + WS_POOLED);
    const int tid = threadIdx.x, wave = tid >> 6, lane = tid & 63;
    const int gw = vcu * NWAVES + wave, NGW = G * NWAVES;
    for (int it = gw; it < (T_TOK / 4) * 2; it += NGW) {
        const int t0 = (it >> 1) * 4, c8 = (it & 1) * 64 + lane, g = c8 >> 5, p0 = t0 & (SEQ - 1);
        const bf16* zp = Z + (size_t)(t0 + 3) * DM + c8 * 8; bf16* op = P + (size_t)t0 * DM + c8 * 8;
        if (g == 0) pool_item<2>(zp, op, p0); else if (g == 1) pool_item<4>(zp, op, p0); else if (g == 2) pool_item<8>(zp, op, p0); else pool_item<16>(zp, op, p0);
    }
}

template <int R, bool F8OUT = false> __device__ __forceinline__ void ln_rows_store(float (&v)[R][16], const float* g, const float* b, float* const (&of)[R], bf16* const (&ob)[R], int lane) {
    float s[R], s2[R];
#pragma unroll
    for (int r = 0; r < R; ++r) { s[r] = 0.f;
#pragma unroll
        for (int i = 0; i < 16; ++i) s[r] += v[r][i]; }
#pragma unroll
    for (int o = 1; o < 64; o <<= 1)
#pragma unroll
        for (int r = 0; r < R; ++r) s[r] += __shfl_xor(s[r], o);
#pragma unroll
    for (int r = 0; r < R; ++r) { const float mean = s[r] * (1.0f / DM); s2[r] = 0.f;
#pragma unroll
        for (int i = 0; i < 16; ++i) { v[r][i] -= mean; s2[r] += v[r][i] * v[r][i]; } }
#pragma unroll
    for (int o = 1; o < 64; o <<= 1)
#pragma unroll
        for (int r = 0; r < R; ++r) s2[r] += __shfl_xor(s2[r], o);
#pragma unroll
    for (int j = 0; j < 2; ++j) { const int c = 8 * lane + 512 * j;
        const f32x4 g0 = *(const f32x4*)(g + c), g1 = *(const f32x4*)(g + c + 4), b0 = *(const f32x4*)(b + c), b1 = *(const f32x4*)(b + c + 4);
#pragma unroll
        for (int r = 0; r < R; ++r) { const float rstd = 1.0f / sqrtf(s2[r] * (1.0f / DM) + LN_EPS); f32x4 y0, y1;
#pragma unroll
            for (int q = 0; q < 4; ++q) { y0[q] = v[r][8 * j + q] * rstd * g0[q] + b0[q]; y1[q] = v[r][8 * j + 4 + q] * rstd * g1[q] + b1[q]; }
            *(f32x4*)(of[r] + c) = y0; *(f32x4*)(of[r] + c + 4) = y1;
            if constexpr (F8OUT) { int t0 = 0, t1 = 0; t0 = __builtin_amdgcn_cvt_pk_fp8_f32(y0[0], y0[1], t0, false); t0 = __builtin_amdgcn_cvt_pk_fp8_f32(y0[2], y0[3], t0, true); t1 = __builtin_amdgcn_cvt_pk_fp8_f32(y1[0], y1[1], t1, false); t1 = __builtin_amdgcn_cvt_pk_fp8_f32(y1[2], y1[3], t1, true);
                *(v2u*)((unsigned char*)ob[r] + c) = (v2u){(unsigned)t0, (unsigned)t1}; }
            else { v4u w; w.x = cvt_pk_bf16(y0[0], y0[1]); w.y = cvt_pk_bf16(y0[2], y0[3]); w.z = cvt_pk_bf16(y1[0], y1[1]); w.w = cvt_pk_bf16(y1[2], y1[3]);
                *(v4u*)(ob[r] + c) = w; } } }
}

__device__ __forceinline__ void phase_lnr(const Args& a, int layer, LAS unsigned char* lds, int vcu, int G, bool dry) {
    const int tid = threadIdx.x, lane = tid & 63, wave = __builtin_amdgcn_readfirstlane(tid >> 6);
    const float* xin = a.out; float* xf = dry ? (float*)(a.ws + WS_Y) : a.out; bf16* xb = dry ? (bf16*)(a.ws + WS_Y + 72 * MiB) : (bf16*)(a.ws + WS_XB);
    const float* lng = a.in[I_LNMG] + layer * DM; const float* lnb = a.in[I_LNMB] + layer * DM;
    const float* Wr = a.in[I_WR] + (size_t)layer * DM * NE; const float* rbias = a.in[I_RB] + layer * NE;
    unsigned* gcount = (unsigned*)(a.ws + WS_CTL) + CW_CNT + layer * 64 + (dry ? 128 : 0);
    unsigned* rowtok = dry ? (unsigned*)(a.ws + WS_Y + 64 * MiB) : (unsigned*)(a.ws + WS_ROWTOK); unsigned* dest = dry ? (unsigned*)(a.ws + WS_Y + 68 * MiB) : (unsigned*)(a.ws + WS_DEST); float* gatev = dry ? (float*)(a.ws + WS_Y + 69 * MiB) : (float*)(a.ws + WS_GATE);
    LAS float* part = (LAS float*)lds;
    LAS float* mb = (LAS float*)(lds + 32768);
    LAS float* gs = (LAS float*)(lds + 49152);
    LAS unsigned* hist = (LAS unsigned*)(lds + 51200);
    LAS unsigned* basep = (LAS unsigned*)(lds + 51456);
    { const int blk = vcu;
        const int row0 = blk * 64;
        if (tid < 64) hist[tid] = 0u;
#pragma unroll 1
        for (int h4 = 0; h4 < 2; ++h4) { float v[4][16]; float* of[4]; bf16* ob[4];
#pragma unroll
            for (int r = 0; r < 4; ++r) { const int rr = wave * 8 + h4 * 4 + r; const float* xr = xin + (size_t)(row0 + rr) * DM; of[r] = xf + (size_t)(row0 + rr) * DM; ob[r] = (bf16*)((unsigned char*)xb + (size_t)(row0 + rr) * DM);
#pragma unroll
                for (int j = 0; j < 2; ++j) { const f32x4 p = *(const f32x4*)(xr + 8 * lane + 512 * j), q = *(const f32x4*)(xr + 8 * lane + 512 * j + 4);
#pragma unroll
                    for (int i = 0; i < 4; ++i) { v[r][8 * j + i] = p[i]; v[r][8 * j + 4 + i] = q[i]; } } }
            ln_rows_store<4, true>(v, lng, lnb, of, ob, lane); }
        VM_WAIT(); __syncthreads();
#ifndef DRY_PARTS
#define DRY_PARTS 7
#endif
        if (!dry || (DRY_PARTS & 2)) { const int mt = wave & 3, kh = wave >> 2, r = lane & 15, g = lane >> 4;
          f32x4 acc[4];
#pragma unroll
          for (int n = 0; n < 4; ++n) acc[n] = (f32x4){0.f, 0.f, 0.f, 0.f};
          const float* arow = xf + (size_t)(row0 + 16 * mt + r) * DM + kh * 512 + 8 * g;
          const bf16* bh = (const bf16*)(a.ws + WS_WRT) + (size_t)layer * 2 * 65536 + (size_t)r * 1024 + kh * 512 + 8 * g; const bf16* bl = bh + 65536;
          f32x4 a0 = *(const f32x4*)arow, a1 = *(const f32x4*)(arow + 4); bf16x8 wh[4], wl[4];
#pragma unroll
          for (int n = 0; n < 4; ++n) { wh[n] = *(const bf16x8*)(bh + (size_t)n * 16384); wl[n] = *(const bf16x8*)(bl + (size_t)n * 16384); }
#pragma unroll 1
          for (int s = 0; s < 16; ++s) { const int sn = s < 15 ? s + 1 : s;
              const f32x4 n0 = *(const f32x4*)(arow + 32 * sn), n1 = *(const f32x4*)(arow + 32 * sn + 4); bf16x8 nh[4], nl[4];
#pragma unroll
              for (int n = 0; n < 4; ++n) { nh[n] = *(const bf16x8*)(bh + (size_t)n * 16384 + 32 * sn); nl[n] = *(const bf16x8*)(bl + (size_t)n * 16384 + 32 * sn); }
              v4u hi, lo; hi.x = cvt_pk_bf16(a0[0], a0[1]); hi.y = cvt_pk_bf16(a0[2], a0[3]); hi.z = cvt_pk_bf16(a1[0], a1[1]); hi.w = cvt_pk_bf16(a1[2], a1[3]);
              lo.x = cvt_pk_bf16(a0[0] - bf_lo(hi.x), a0[1] - bf_hi(hi.x)); lo.y = cvt_pk_bf16(a0[2] - bf_lo(hi.y), a0[3] - bf_hi(hi.y));
              lo.z = cvt_pk_bf16(a1[0] - bf_lo(hi.z), a1[1] - bf_hi(hi.z)); lo.w = cvt_pk_bf16(a1[2] - bf_lo(hi.w), a1[3] - bf_hi(hi.w));
              const bf16x8 ah = __builtin_bit_cast(bf16x8, hi), al = __builtin_bit_cast(bf16x8, lo);
#pragma unroll
              for (int n = 0; n < 4; ++n) { acc[n] = __builtin_amdgcn_mfma_f32_16x16x32_bf16(ah, wh[n], acc[n], 0, 0, 0); acc[n] = __builtin_amdgcn_mfma_f32_16x16x32_bf16(al, wh[n], acc[n], 0, 0, 0); acc[n] = __builtin_amdgcn_mfma_f32_16x16x32_bf16(ah, wl[n], acc[n], 0, 0, 0); }
              a0 = n0; a1 = n1;
#pragma unroll
              for (int n = 0; n < 4; ++n) { wh[n] = nh[n]; wl[n] = nl[n]; } }
#pragma unroll
          for (int n = 0; n < 4; ++n)
#pragma unroll
              for (int q = 0; q < 4; ++q) part[(kh * 64 + 16 * mt + 4 * g + q) * 64 + 16 * n + r] = acc[n][q]; }
        __syncthreads();
        if (!dry || (DRY_PARTS & 4)) { const int row = tid >> 3, grp = tid & 7; float sc[8], bsd[8];
#pragma unroll
          for (int i = 0; i < 8; ++i) { const int e = 8 * grp + i; const float lg = part[row * 64 + e] + part[(64 + row) * 64 + e]; sc[i] = 1.0f / (1.0f + __expf(-lg)); bsd[i] = sc[i] + rbias[e]; }
          float m1 = -INFINITY, m2 = -INFINITY;
#pragma unroll
          for (int i = 0; i < 8; ++i) { const float v = bsd[i]; if (v > m1) { m2 = m1; m1 = v; } else if (v > m2) m2 = v; }
          const float myg = m1 + m2;
          int grank = 0;
#pragma unroll
          for (int d = 1; d < 8; ++d) { const float o = __shfl(myg, (lane & ~7) | ((grp + d) & 7)); const int g2 = (grp + d) & 7; grank += (o > myg || (o == myg && g2 < grp)) ? 1 : 0; }
          const bool gsel = grank < 4;
          float cand[8]; int rk[8]; bool sel[8];
#pragma unroll
          for (int i = 0; i < 8; ++i) { cand[i] = gsel ? bsd[i] : -INFINITY; rk[i] = 0; sel[i] = false; }
#pragma unroll 1
          for (int k = 0; k < TOPK; ++k) {
              float best = cand[0]; int bi = 0;
#pragma unroll
              for (int i = 1; i < 8; ++i) if (cand[i] > best) { best = cand[i]; bi = i; }
              int gi = 8 * grp + bi;
#pragma unroll
              for (int off = 1; off < 8; off <<= 1) { const float ov = __shfl_xor(best, off); const int oi = __shfl_xor(gi, off); if (ov > best || (ov == best && oi < gi)) { best = ov; gi = oi; } }
#pragma unroll
              for (int i = 0; i < 8; ++i) if (gi == 8 * grp + i) { cand[i] = -INFINITY; rk[i] = k; sel[i] = true; }
          }
          float psum = 0.f;
#pragma unroll
          for (int i = 0; i < 8; ++i) psum += sel[i] ? sc[i] : 0.f;
          psum += __shfl_xor(psum, 1); psum += __shfl_xor(psum, 2); psum += __shfl_xor(psum, 4);
          const float inv = ROUTED_SCALE / psum;
          unsigned loc[8];
#pragma unroll
          for (int i = 0; i < 8; ++i) { loc[i] = 0u; if (sel[i]) loc[i] = __hip_atomic_fetch_add(hist + 8 * grp + i, 1u, __ATOMIC_RELAXED, __HIP_MEMORY_SCOPE_WORKGROUP); }
          __syncthreads();
          if (tid < 64) { const unsigned h = hist[tid]; basep[tid] = h ? __hip_atomic_fetch_add(gcount + tid, h, RLX_AGENT) : 0u; }
          __syncthreads();
          const int tok = row0 + row;
#pragma unroll
          for (int i = 0; i < 8; ++i) if (sel[i]) { const int e = 8 * grp + i; const unsigned pos = basep[e] + loc[i];
              rowtok[(size_t)e * CAP + pos] = (unsigned)tok; dest[tok * 8 + rk[i]] = ((unsigned)e << 16) | pos; gatev[tok * 8 + rk[i]] = sc[i] * inv; }
        }
        __syncthreads();
    }
}

__device__ __forceinline__ pg8::MoeInfo moe_setup(const Args& a, int layer, LAS unsigned char* misc) {
    const int tid = threadIdx.x;
    unsigned* gcount = (unsigned*)(a.ws + WS_CTL) + CW_CNT + layer * 64;
    LAS unsigned* cnt = (LAS unsigned*)(misc + MI_CNT); LAS unsigned* tstart = (LAS unsigned*)(misc + MI_TSTART); LAS unsigned* ystart = (LAS unsigned*)(misc + MI_YSTART);
    LAS unsigned* ntl = (LAS unsigned*)(misc + MI_NTILES); LAS unsigned char* tile_e = (LAS unsigned char*)(misc + MI_TILE_E);
    __syncthreads();
    if (tid < 64) { unsigned c = __hip_atomic_load(gcount + tid, RLX_AGENT); if (c > (unsigned)CAP) c = CAP; cnt[tid] = c; }
    __syncthreads();
    if (tid < 64) { unsigned ts = 64u, ys = 0u; for (int e = 0; e < tid; ++e) { const unsigned c = cnt[e]; ts += (c + 255u) >> 8; ys += c; }
        tstart[tid] = ts; ystart[tid] = ys; const unsigned mynt = (cnt[tid] + 255u) >> 8;
        for (unsigned i = 0; i < mynt; ++i) if (ts + i < 640u) tile_e[ts + i] = (unsigned char)tid;
        if (tid == 63) ntl[0] = ts + mynt; }
    __syncthreads();
    pg8::MoeInfo mi; mi.cnt = cnt; mi.tstart = tstart; mi.ystart = ystart; mi.tile_e = tile_e; mi.ntiles = __builtin_amdgcn_readfirstlane((int)ntl[0]);
    if (mi.ntiles > 640) mi.ntiles = 640;
    return mi;
}

__device__ __forceinline__ void phase_combine(const Args& a, int layer, LAS unsigned char* misc, int vcu, int G, bool dry) {
    const int tid = threadIdx.x, lane = tid & 63, wave = __builtin_amdgcn_readfirstlane(tid >> 6);
    const pg8::MoeInfo mi = moe_setup(a, layer, misc);
    float* xf = a.out; bf16* xb = (bf16*)(a.ws + WS_XB); const unsigned char* Y8 = (const unsigned char*)(a.ws + WS_Y);
    const unsigned* dest = (const unsigned*)(a.ws + WS_DEST); const float* gatev = (const float*)(a.ws + WS_GATE);
    const float* lng = a.in[I_LNFG] + layer * DM; const float* lnb = a.in[I_LNFB] + layer * DM;
    const int gw = vcu * NWAVES + wave, NGW = G * NWAVES;
#pragma unroll 1
    for (int rowa = gw; rowa < T_TOK; rowa += 2 * NGW) {
        float v[2][16]; float* of[2]; bf16* ob[2]; unsigned d[2][TOPK]; float gk[2][TOPK];
#pragma unroll
        for (int r = 0; r < 2; ++r) { const int row = rowa + r * NGW;
#pragma unroll
            for (int k = 0; k < TOPK; ++k) { d[r][k] = dest[row * 8 + k]; gk[r][k] = gatev[row * 8 + k]; } }
#pragma unroll
        for (int r = 0; r < 2; ++r) { const int row = rowa + r * NGW; float* xr = xf + (size_t)row * DM; of[r] = dry ? (float*)(a.ws + WS_H) + (size_t)row * DM : xr; ob[r] = xb + (size_t)row * DM;
#pragma unroll
            for (int j = 0; j < 2; ++j) { const f32x4 p = *(const f32x4*)(xr + 8 * lane + 512 * j), q = *(const f32x4*)(xr + 8 * lane + 512 * j + 4);
#pragma unroll
                for (int i = 0; i < 4; ++i) { v[r][8 * j + i] = p[i] * ALPHA; v[r][8 * j + 4 + i] = q[i] * ALPHA; } } }
#pragma unroll
        for (int r = 0; r < 2; ++r) { const unsigned char* yr = Y8 + (size_t)(131072 + rowa + r * NGW) * DM;
#pragma unroll
            for (int j = 0; j < 2; ++j) { const v2u w = *(const v2u*)(yr + 8 * lane + 512 * j);
#pragma unroll
                for (int q = 0; q < 2; ++q) { const f32x2 lo2 = __builtin_amdgcn_cvt_pk_f32_fp8((int)w[q], false), hi2 = __builtin_amdgcn_cvt_pk_f32_fp8((int)w[q], true);
                    v[r][8 * j + 4 * q] += 0.0625f * lo2.x; v[r][8 * j + 4 * q + 1] += 0.0625f * lo2.y; v[r][8 * j + 4 * q + 2] += 0.0625f * hi2.x; v[r][8 * j + 4 * q + 3] += 0.0625f * hi2.y; } } }
#pragma unroll
        for (int r = 0; r < 2; ++r)
#pragma unroll
            for (int k = 0; k < TOPK; ++k) { const unsigned dd = (unsigned)__builtin_amdgcn_readfirstlane((int)d[r][k]); const float g = __uint_as_float((unsigned)__builtin_amdgcn_readfirstlane((int)__float_as_uint(gk[r][k])));
                const unsigned e = (dd >> 16) & 63u, pos = dd & 0xffffu; const unsigned char* yr = Y8 + (size_t)(mi.ystart[e] + pos) * DM; const float g16 = g * 0.0625f;
#pragma unroll
                for (int j = 0; j < 2; ++j) { const v2u w = *(const v2u*)(yr + 8 * lane + 512 * j);
#pragma unroll
                    for (int q = 0; q < 2; ++q) { const f32x2 lo2 = __builtin_amdgcn_cvt_pk_f32_fp8((int)w[q], false), hi2 = __builtin_amdgcn_cvt_pk_f32_fp8((int)w[q], true);
                        v[r][8 * j + 4 * q] += g16 * lo2.x; v[r][8 * j + 4 * q + 1] += g16 * lo2.y; v[r][8 * j + 4 * q + 2] += g16 * hi2.x; v[r][8 * j + 4 * q + 3] += g16 * hi2.y; } } }
        for (int r = 0; r < 2; ++r) ob[r] = (bf16*)((unsigned char*)xb + (size_t)(rowa + r * NGW) * DM);
        ln_rows_store<2, true>(v, lng, lnb, of, ob, lane);
    }
}

__device__ __forceinline__ int swz16(int row) { return (row ^ (row >> 4)) & 15; }
__device__ __forceinline__ void phase_sgu_spatial(const Args& a, LAS unsigned char* lds, int vcu, int G) {
    const int tid = threadIdx.x, lane = tid & 63, wave = __builtin_amdgcn_readfirstlane(tid >> 6), fr = lane & 15, fq = lane >> 4;
    const bf16* HS = (const bf16*)(a.ws + WS_HS); bf16* GT = (bf16*)(a.ws + WS_GATED);
    const float* lng = a.in[I_SLNG]; const float* lnb = a.in[I_SLNB]; const float* WS = a.in[I_SWS]; const float* BS = a.in[I_SBS];
    LAS unsigned char* Bs = lds;
    LAS unsigned char* As = lds + 65536;
    LAS float* stm = (LAS float*)(lds + 98304);
    LAS float* str = (LAS float*)(lds + 98304 + 512);
    for (int item = vcu; item < 512; item += G) {
        const int chunk = item >> 2, h = item & 3, t0 = chunk * 128;
        __syncthreads();
#pragma unroll 1
        for (int r4 = 0; r4 < 4; ++r4) { v4u w[4][4];
#pragma unroll
            for (int rr = 0; rr < 4; ++rr) { const bf16* vr = HS + (size_t)(t0 + wave * 16 + r4 * 4 + rr) * 4096 + SGU_W;
#pragma unroll
                for (int q = 0; q < 4; ++q) w[rr][q] = *(const v4u*)(vr + 8 * lane + 512 * q); }
            float sm[4], sq[4];
#pragma unroll
            for (int rr = 0; rr < 4; ++rr) { float s1 = 0.f;
#pragma unroll
                for (int q = 0; q < 4; ++q)
#pragma unroll
                    for (int p = 0; p < 4; ++p) s1 += bf_lo(w[rr][q][p]) + bf_hi(w[rr][q][p]);
                sm[rr] = s1; }
#pragma unroll
            for (int o = 1; o < 64; o <<= 1)
#pragma unroll
                for (int rr = 0; rr < 4; ++rr) sm[rr] += __shfl_xor(sm[rr], o);
#pragma unroll
            for (int rr = 0; rr < 4; ++rr) { const float mean = sm[rr] * (1.0f / SGU_W); float s2 = 0.f;
#pragma unroll
                for (int q = 0; q < 4; ++q)
#pragma unroll
                    for (int p = 0; p < 4; ++p) { const float d0 = bf_lo(w[rr][q][p]) - mean, d1 = bf_hi(w[rr][q][p]) - mean; s2 += d0 * d0 + d1 * d1; }
                sm[rr] = mean; sq[rr] = s2; }
#pragma unroll
            for (int o = 1; o < 64; o <<= 1)
#pragma unroll
                for (int rr = 0; rr < 4; ++rr) sq[rr] += __shfl_xor(sq[rr], o);
            if (lane == 0) {
#pragma unroll
                for (int rr = 0; rr < 4; ++rr) { const int j = wave * 16 + r4 * 4 + rr; stm[j] = sm[rr]; str[j] = 1.0f / sqrtf(sq[rr] * (1.0f / SGU_W) + LN_EPS); } } }
        for (int q = tid; q < 128 * 16; q += NTHR) { const int i = q >> 4, jc = q & 15; const float* wp = WS + ((size_t)h * 128 + i) * 128 + 8 * jc;
            const f32x4 p0 = *(const f32x4*)wp, p1 = *(const f32x4*)(wp + 4); float w8[8];
#pragma unroll
            for (int z = 0; z < 4; ++z) { w8[z] = (8 * jc + z <= i) ? p0[z] : 0.f; w8[4 + z] = (8 * jc + 4 + z <= i) ? p1[z] : 0.f; }
            v4u o; o.x = cvt_pk_bf16(w8[0], w8[1]); o.y = cvt_pk_bf16(w8[2], w8[3]); o.z = cvt_pk_bf16(w8[4], w8[5]); o.w = cvt_pk_bf16(w8[6], w8[7]);
            *(LAS v4u*)(As + i * 256 + ((jc ^ swz16(i)) << 4)) = o; }
        __syncthreads();
        for (int hh = 0; hh < 2; ++hh) {
            const int cb = h * SGU_HD + hh * 256;
#pragma unroll 2
            for (int q = tid; q < 64 * 32; q += NTHR) { const int c8 = q & 31, jp = q >> 5, j0 = 2 * jp;
                const v4u w0 = *(const v4u*)(HS + (size_t)(t0 + j0) * 4096 + SGU_W + cb + 8 * c8), w1 = *(const v4u*)(HS + (size_t)(t0 + j0 + 1) * 4096 + SGU_W + cb + 8 * c8);
                const f32x4 g0 = *(const f32x4*)(lng + cb + 8 * c8), g1 = *(const f32x4*)(lng + cb + 8 * c8 + 4), b0 = *(const f32x4*)(lnb + cb + 8 * c8), b1 = *(const f32x4*)(lnb + cb + 8 * c8 + 4);
                const float m0 = stm[j0], r0 = str[j0], m1 = stm[j0 + 1], r1 = str[j0 + 1];
#pragma unroll
                for (int z = 0; z < 8; ++z) { const float gz = z < 4 ? g0[z & 3] : g1[z & 3], bz = z < 4 ? b0[z & 3] : b1[z & 3];
                    const float xa = (z & 1) ? bf_hi(w0[z >> 1]) : bf_lo(w0[z >> 1]), xc = (z & 1) ? bf_hi(w1[z >> 1]) : bf_lo(w1[z >> 1]);
                    const float ya = (xa - m0) * r0 * gz + bz, yc = (xc - m1) * r1 * gz + bz;
                    const int cc = 8 * c8 + z, slot = (cc & ~31) | (((cc >> 2) & 1) << 4) | (((cc >> 3) & 3) << 2) | (cc & 3);
                    *(LAS unsigned*)(Bs + slot * 256 + (((j0 >> 3) ^ swz16(slot)) << 4) + (j0 & 7) * 2) = cvt_pk_bf16(ya, yc); } }
            __syncthreads();
            f32x4 acc[8][2]; bf16x8 Bf[2][4];
#pragma unroll
            for (int n = 0; n < 2; ++n)
#pragma unroll
                for (int s = 0; s < 4; ++s) { const int slot = 32 * wave + 16 * n + fr; Bf[n][s] = *(const LAS bf16x8*)(Bs + slot * 256 + (((4 * s + fq) ^ swz16(slot)) << 4)); }
#pragma unroll
            for (int m = 0; m < 8; ++m) { acc[m][0] = (f32x4){0.f, 0.f, 0.f, 0.f}; acc[m][1] = (f32x4){0.f, 0.f, 0.f, 0.f};
#pragma unroll
                for (int s = 0; s < 4; ++s) if (s <= (m >> 1)) { const int i = 16 * m + fr; const bf16x8 af = *(const LAS bf16x8*)(As + i * 256 + (((4 * s + fq) ^ swz16(i)) << 4));
                    acc[m][0] = __builtin_amdgcn_mfma_f32_16x16x32_bf16(Bf[0][s], af, acc[m][0], 0, 0, 0); acc[m][1] = __builtin_amdgcn_mfma_f32_16x16x32_bf16(Bf[1][s], af, acc[m][1], 0, 0, 0); } }
#pragma unroll
            for (int m = 0; m < 8; ++m) { const int i = 16 * m + fr; const float bsv = BS[h * 128 + i]; const size_t t = (size_t)(t0 + i);
                const v4u uw = *(const v4u*)(HS + t * 4096 + cb + 32 * wave + 8 * fq); float o[8];
#pragma unroll
                for (int n = 0; n < 2; ++n)
#pragma unroll
                    for (int z = 0; z < 4; ++z) { const int c = 4 * n + z; const float uu = (c & 1) ? bf_hi(uw[c >> 1]) : bf_lo(uw[c >> 1]); o[c] = uu * (acc[m][n][z] + bsv); }
                v4u w; w.x = cvt_pk_bf16(o[0], o[1]); w.y = cvt_pk_bf16(o[2], o[3]); w.z = cvt_pk_bf16(o[4], o[5]); w.w = cvt_pk_bf16(o[6], o[7]);
                *(v4u*)(GT + t * SGU_W + cb + 32 * wave + 8 * fq) = w; }
            __syncthreads();
        }
    }
}

__device__ __forceinline__ void phase_flush(const Args& a, int vcu, int G) {
    const size_t gt = (size_t)vcu * NTHR + threadIdx.x, NT = (size_t)G * NTHR; f32x4 acc = (f32x4){0.f, 0.f, 0.f, 0.f};
    const f32x4* p0 = (const f32x4*)a.in[I_WG]; const f32x4* p1 = (const f32x4*)a.in[I_WU];
    for (size_t i = gt; i < (size_t)33554432 / 4; i += 4 * NT) { const f32x4 x0 = p0[i], x1 = p0[i + NT], x2 = p0[i + 2 * NT], x3 = p0[i + 3 * NT], y0 = p1[i], y1 = p1[i + NT], y2 = p1[i + 2 * NT], y3 = p1[i + 3 * NT]; acc += x0 + x1 + x2 + x3 + y0 + y1 + y2 + y3; }
    if (acc[0] + acc[1] + acc[2] + acc[3] == 1.2345e-30f) ((float*)(a.ws + WS_CTL))[16000] = acc[0];
}
constexpr int N_PHASES = 16;
__global__ void __launch_bounds__(NTHR, 2) mk_fwd(Args args) {
    extern __shared__ __attribute__((aligned(16))) unsigned char lds_raw[];
    LAS unsigned char* lds = (LAS unsigned char*)lds_raw;
    LAS unsigned char* misc = lds + MISC_OFF;
    const int tid = threadIdx.x;
    const int G = gridDim.x; const int bx = blockIdx.x; const int vcu = (G % 8 == 0) ? (bx % 8) * (G / 8) + bx / 8 : bx;
    unsigned char* ws = args.ws;
    unsigned* ctl = (unsigned*)(ws + WS_CTL);
    if (tid < 16) ((LAS unsigned*)(misc + MI_BARW))[tid] = 0u;
    __syncthreads();
    const int lo = args.ph_lo, hi = args.ph_hi;
    XcdBarrier bar; bar.bar = ctl + CW_BAR; bar.x = 0; bar.st = nullptr;
    if (hi - lo > 1) bar = xcd_barrier_post(ctl + CW_BAR, (volatile LAS unsigned*)(misc + MI_BARW));
#ifndef PH_MASK
#define PH_MASK 0xFFFF
#endif
#define IN(k) (((PH_MASK >> (k)) & 1) && lo <= (k) && (k) < hi)
#ifndef TS_A0
#define TS_A0 -1
#define TS_A1 -1
#define TS_M 1
#endif
    unsigned long long* tsbuf = (unsigned long long*)(ws + 32768);
#define TS_REC(k) do { if (TS_A0 >= 0 && bx == 0 && tid == 0) __hip_atomic_store(tsbuf + (k), (unsigned long long)__builtin_amdgcn_s_memrealtime(), RLX_AGENT); } while (0)
    TS_REC(0);
#ifndef REP_PH
#define REP_PH -1
#define REP_N 1
#endif
#define NREP(k) ((k) == REP_PH ? REP_N : 1)
#ifndef FLUSH_PH
#define FLUSH_PH -2
#endif
#define RUN(k) if (IN(k)) for (int rep = 0; rep < NREP(k); ++rep) if ((((k) == FLUSH_PH && rep == NREP(k) - 1) ? (xcd_barrier(bar), phase_flush(args, vcu, G), xcd_barrier(bar), true) : true))
#define DRY(k) (rep + 1 < NREP(k))
#define BG_LAYER(k) (-1)
#define SEAM(k) do { if (IN(k) && IN((k) + 1)) xcd_barrier(bar, &args, BG_LAYER(k), lds); TS_REC((k) + 1); } while (0)
    using namespace pg8;
    RUN(0) { phase_p0(args, lds, vcu, G); } SEAM(0);
    RUN(1) { DenseSched S{(const char*)(ws + WS_XB), (const char*)(ws + WS_WIN), 2048u, 2048u, 0u, 64, 4, 256, G, bx};
        EpiBf16<0, false, false> E{(bf16*)(ws + WS_Z), DM, nullptr, nullptr};
        gemm_phase<EpiBf16<0, false, false>, DenseSched, false, true, true>(lds, 2048u, 2048u, 16, S, E); } SEAM(1);
    if (REP_PH == 100 && hi - lo > 1) for (int i = 0; i < REP_N; ++i) xcd_barrier(bar);
    RUN(3) { DenseSched S{(const char*)(ws + WS_POOLED), (const char*)(ws + WS_WGRP), 2048u, 512u, 512u, 64, 4, 256, G, bx};
        { Unit u0; if (S.next(0, u0)) pool_block(args, u0.i0, u0.i1); }
        EpiBf16<0, false, true> E{(bf16*)(ws + WS_YP), DM, nullptr, args.in[I_PSCALE]};
        gemm_phase<EpiBf16<0, false, true>, DenseSched, false, true, true>(lds, 2048u, 512u, 4, S, E); } SEAM(3);
    RUN(4) { DenseSched S{(const char*)(ws + WS_YP), (const char*)(ws + WS_WOUT), 2048u, 2048u, 0u, 64, 4, 256, G, bx};
        EpiResid E{args.in[I_X], args.out};
        gemm_phase<EpiResid, DenseSched, false, true, true>(lds, 2048u, 2048u, 16, S, E); } SEAM(4);
#define MOE_PHASES(layer, pb) do { \
        RUN(pb) { phase_lnr(args, layer, lds, vcu, G, DRY(pb)); } SEAM(pb); \
        RUN((pb) + 1) { const MoeInfo mi = moe_setup(args, layer, misc); \
            G1Sched S{mi, (const char*)(ws + WS_XB), (const char*)(ws + WS_WGU + (size_t)layer * WS_MOE_LSTRIDE), (const unsigned*)(ws + WS_ROWTOK), (const unsigned*)(ws + WS_IDENT), G, vcu}; \
            EpiSwiglu E{(unsigned char*)(ws + WS_H)}; \
            gemm_phase<EpiSwiglu, G1Sched, true, true, false, 0, 1>(lds, 1024u, 1024u, 8, S, E); } SEAM((pb) + 1); \
        if (IN((pb) + 2) && REP_PH == (pb) + 2) { const MoeInfo mi = moe_setup(args, layer, misc); \
            G2Sched S{mi, (const char*)(ws + WS_H), (const char*)(ws + WS_WDN + (size_t)layer * WS_MOE_LSTRIDE), G, vcu, 256}; \
            EpiDown E{(unsigned char*)(ws + WS_Y)}; \
            gemm_phase<EpiDown, G2Sched, false, true, true, 1, 1>(lds, 256u, 256u, 2, S, E); } \
        if (IN((pb) + 2)) { const MoeInfo mi = moe_setup(args, layer, misc); \
            G2Sched S{mi, (const char*)(ws + WS_H), (const char*)(ws + WS_WDN + (size_t)layer * WS_MOE_LSTRIDE), G, vcu, 0}; \
            EpiDown E{(unsigned char*)(ws + WS_Y)}; \
            gemm_phase<EpiDown, G2Sched, false, true, true, 1, 1>(lds, 256u, 256u, 2, S, E); } SEAM((pb) + 2); \
        RUN((pb) + 3) { phase_combine(args, layer, misc, vcu, G, DRY((pb) + 3)); if (layer == 0 && !DRY((pb) + 3)) { __syncthreads(); convert_static(args, 1, lds, vcu, G); } } \
    } while (0)
    MOE_PHASES(0, 5); SEAM(8);
    RUN(9) { DenseSched S{(const char*)(ws + WS_XB), (const char*)(ws + WS_WSIN), 1024u, 1024u, 0u, 64, 16, 1024, G, bx, (const unsigned*)(ws + WS_IDENT)};
        EpiBf16<1, true, false, true> E{(bf16*)(ws + WS_HS), 4096, args.in[I_SBIN], nullptr};
        gemm_phase<EpiBf16<1, true, false, true>, DenseSched, true, true, false, 0, 1>(lds, 1024u, 1024u, 8, S, E); } SEAM(9);
    RUN(10) { phase_sgu_spatial(args, lds, vcu, G); } SEAM(10);
    RUN(11) { DenseSched S{(const char*)(ws + WS_GATED), (const char*)(ws + WS_WSOUT), 4096u, 4096u, 0u, 64, 4, 256, G, bx};
        EpiResid E{args.out, DRY(11) ? (float*)(ws + WS_HS) : args.out};
        gemm_phase<EpiResid, DenseSched, false, true, true>(lds, 4096u, 4096u, 32, S, E); } SEAM(11);
    MOE_PHASES(1, 12);
#undef MOE_PHASES
    if (TS_A0 >= 0 && bx == 0 && tid == 0) {
        const unsigned long long tend = __builtin_amdgcn_s_memrealtime();
        const unsigned long long t0 = __hip_atomic_load(tsbuf + TS_A0, RLX_AGENT), t1 = (TS_A1 + 1 >= N_PHASES) ? tend : __hip_atomic_load(tsbuf + TS_A1 + 1, RLX_AGENT);
        const unsigned long long wait = (t1 - t0) * TS_M;
        while (__builtin_amdgcn_s_memrealtime() - tend < wait) __builtin_amdgcn_s_sleep(8);
    }
#undef IN
#undef SEAM
}

extern "C" void kernel_launch(void* const* d_in, const int* in_sizes, int n_in, void* d_out, int out_size, void* d_ws, size_t ws_size, hipStream_t stream) {
    static int grid = 0;
    if (grid == 0) {
        if (n_in != 24 || out_size != T_TOK * DM || ws_size < WS_END) { fprintf(stderr, "kernel_launch: unexpected shapes (n_in %d out %d ws %zu)\n", n_in, out_size, ws_size); grid = -1; return; }
        int dev = 0, cus = 0;
        if (hipGetDevice(&dev) != hipSuccess || hipDeviceGetAttribute(&cus, hipDeviceAttributeMultiprocessorCount, dev) != hipSuccess) { grid = -1; return; }
        if (hipFuncSetAttribute((const void*)mk_fwd, hipFuncAttributeMaxDynamicSharedMemorySize, LDS_BYTES) != hipSuccess) { fprintf(stderr, "kernel_launch: hipFuncSetAttribute failed\n"); grid = -1; return; }
        int per_cu = 0;
        if (hipOccupancyMaxActiveBlocksPerMultiprocessor(&per_cu, (const void*)mk_fwd, NTHR, LDS_BYTES) != hipSuccess || per_cu < 1) fprintf(stderr, "kernel_launch: occupancy query says %d\n", per_cu);
        (void)hipGetLastError();
        grid = cus;
        if (grid != 256) { fprintf(stderr, "kernel_launch: built for a 256-CU device (got %d)\n", cus); grid = -1; return; }
    }
    if (grid < 0) return;
    (void)hipMemsetAsync((char*)d_ws + WS_CTL, 0, CTL_ZERO_BYTES, stream);
    Args a{};
    for (int i = 0; i < 24; ++i) a.in[i] = (const float*)d_in[i];
    a.out = (float*)d_out; a.ws = (unsigned char*)d_ws;
#if MK_PER_PHASE
    for (int p = 0; p < N_PHASES; ++p) { a.ph_lo = p; a.ph_hi = p + 1; hipLaunchKernelGGL(mk_fwd, dim3(grid), dim3(NTHR), LDS_BYTES, stream, a); }
#else
    a.ph_lo = 0; a.ph_hi = N_PHASES; hipLaunchKernelGGL(mk_fwd, dim3(grid), dim3(NTHR), LDS_BYTES, stream, a);
#endif
}
```

```cpp
#include <hip/hip_runtime.h>
#include <cstdio>
#include <cstdint>

#ifndef MK_PER_PHASE
#define MK_PER_PHASE 0
#endif

#define GAS __attribute__((address_space(1)))
#define LAS __attribute__((address_space(3)))
typedef unsigned short bf16;
typedef unsigned v4u __attribute__((ext_vector_type(4)));
typedef unsigned v2u __attribute__((ext_vector_type(2)));
typedef float f32x4 __attribute__((ext_vector_type(4)));
typedef float f32x2 __attribute__((ext_vector_type(2)));
typedef short bf16x8 __attribute__((ext_vector_type(8)));
#define RLX_AGENT __ATOMIC_RELAXED, __HIP_MEMORY_SCOPE_AGENT
#define LDS_WAIT() asm volatile("s_waitcnt lgkmcnt(0)" ::: "memory")
#define VM_WAIT() asm volatile("s_waitcnt vmcnt(0)" ::: "memory")

constexpr int T_TOK = 16384, DM = 1024, SEQ = 4096, NE = 64, TOPK = 8, EDIM = 256;
constexpr int SGU_W = 2048, SGU_HD = 512;
constexpr float ALPHA = 1.41421356237309515f;
constexpr float LN_EPS = 1e-5f, ROUTED_SCALE = 2.5f;
constexpr int CAP = 16384;
constexpr int NWAVES = 8, NTHR = 512;

constexpr size_t MiB = 1u << 20;
constexpr size_t WS_CTL = 0, CTL_ZERO_BYTES = 65536;
constexpr size_t WS_IDENT = 256 * 1024;
constexpr size_t WS_DEST = 1 * MiB;
constexpr size_t WS_GATE = WS_DEST + 512 * 1024;
constexpr size_t WS_ROWTOK = 2 * MiB;
constexpr size_t WS_WIN = 6 * MiB;
constexpr size_t WS_WGRP = 8 * MiB;
constexpr size_t WS_WOUT = WS_WGRP + 512 * 1024;
constexpr size_t WS_WSIN = WS_WOUT + 2 * MiB;
constexpr size_t WS_WSOUT = WS_WSIN + 8 * MiB;
constexpr size_t WS_WRT = WS_WSOUT + 4 * MiB;
constexpr size_t WS_WGU = 23 * MiB;
constexpr size_t WS_WDN = WS_WGU + 65 * MiB;
constexpr size_t WS_XB = 121 * MiB;
constexpr size_t WS_H = 153 * MiB;
constexpr size_t WS_Y = 233 * MiB;
constexpr size_t WS_WGU1 = 378 * MiB, WS_WDN1 = WS_WGU1 + 65 * MiB;
constexpr size_t WS_MOE_LSTRIDE = WS_WGU1 - WS_WGU;
constexpr size_t WS_END = 476 * MiB;
constexpr size_t WS_Z = 153 * MiB, WS_POOLED = 185 * MiB, WS_YP = 217 * MiB;
constexpr size_t WS_HS = 153 * MiB;
constexpr size_t WS_GATED = 281 * MiB;
static_assert(WS_WRT + 512 * 1024 <= WS_WGU && WS_WDN + 33 * MiB <= WS_XB && WS_XB + 32 * MiB <= WS_H && WS_H + 80 * MiB <= WS_Y && WS_Y + 145 * MiB <= WS_WGU1 && WS_WDN1 + 33 * MiB <= WS_END && WS_GATED + 64 * MiB <= WS_WGU1, "ws map");
constexpr int CW_TMO = 0, CW_BAR = 64, CW_CNT = 4096, CW_QNEXT = 4608;

constexpr int RING_BYTES = 131072;
constexpr int MISC_OFF = RING_BYTES;
constexpr int LDS_BYTES = 147456;
constexpr int MI_BARW = 0, MI_CNT = 64, MI_TSTART = 320, MI_YSTART = 576, MI_NTILES = 832, MI_TILE_E = 1024;

__device__ __forceinline__ unsigned cvt_pk_bf16(float lo, float hi) { unsigned r; asm volatile("v_cvt_pk_bf16_f32 %0, %1, %2" : "=v"(r) : "v"(lo), "v"(hi)); return r; }
__device__ __forceinline__ float bf_lo(unsigned w) { return __uint_as_float(w << 16); }
__device__ __forceinline__ float bf_hi(unsigned w) { return __uint_as_float(w & 0xffff0000u); }
__device__ __forceinline__ float wave_sum(float v) {
#pragma unroll
    for (int o = 1; o < 64; o <<= 1) v += __shfl_xor(v, o);
    return v;
}
__device__ __forceinline__ float sigmoidf_(float x) { return __builtin_amdgcn_rcpf(1.0f + __builtin_amdgcn_exp2f(-1.4426950408889634f * x)); }
__device__ __forceinline__ float gelu_tanh(float v) { const float y = v + 0.044715f * v * v * v; return v * __builtin_amdgcn_rcpf(1.0f + __builtin_amdgcn_exp2f(-2.3022081983f * y)); }

#define XB_TMO      128
#define XB_XCNT(j)  (256  + 64 * (j))
#define XB_XSUB(j)  (1280 + 64 * (j))
#define XB_XGEN(j)  (2304 + 64 * (j))
#define XB_TOP      3328
#define XB_TOPGEN   3392
#define XCD_BAR_WORDS 3456
#define XB_SPIN_CAP (1u << 20)
__device__ __forceinline__ unsigned xb_ld(unsigned* p)              { return __hip_atomic_load(p, __ATOMIC_RELAXED, __HIP_MEMORY_SCOPE_AGENT); }
__device__ __forceinline__ unsigned xb_add(unsigned* p, unsigned v) { return __hip_atomic_fetch_add(p, v, __ATOMIC_RELAXED, __HIP_MEMORY_SCOPE_AGENT); }
__device__ __forceinline__ unsigned xb_xcc_id() { return (unsigned)__builtin_amdgcn_s_getreg((3 << 11) | 20) & 0xFu; }
#define XB_SPIN(cond, bar) do { unsigned _sp = 0; while (cond) { __builtin_amdgcn_s_sleep(1); \
    if ((++_sp & 255u) == 0u) { if (xb_ld(&(bar)[XB_TMO])) break; if (_sp > XB_SPIN_CAP) { atomicAdd(&(bar)[XB_TMO], 1u); break; } } } } while (0)
struct XcdBarrier { unsigned* bar; unsigned x; volatile LAS unsigned* st; };
__device__ __forceinline__ XcdBarrier xcd_barrier_post(unsigned* bar, volatile LAS unsigned* st) {
    XcdBarrier b; b.bar = bar; b.x = xb_xcc_id(); b.st = st;
    if (threadIdx.x == 0) (void)xb_add(&bar[XB_XCNT(b.x)], 1u);
    return b;
}
__device__ __forceinline__ void xcd_barrier_complete(unsigned* bar, unsigned x, unsigned& nloc, unsigned& nx) {
    const unsigned G = gridDim.x * gridDim.y * gridDim.z;
    unsigned sum, cnt, mine, sp = 0u;
    for (;;) {
        sum = 0u; cnt = 0u; mine = 0u;
#pragma unroll
        for (unsigned j = 0; j < 16; ++j) { const unsigned c = xb_ld(&bar[XB_XCNT(j)]); sum += c; cnt += (c > 0u) ? 1u : 0u; mine = (j == x) ? c : mine; }
        if (sum == G) break;
        __builtin_amdgcn_s_sleep(1);
        if ((++sp & 255u) == 0u) { if (xb_ld(&bar[XB_TMO])) break; if (sp > XB_SPIN_CAP) { atomicAdd(&bar[XB_TMO], 1u); break; } }
    }
    nloc = mine > 0u ? mine : 1u; nx = cnt > 0u ? cnt : 1u;
}
struct Args;
__device__ __forceinline__ bool convert_steal(const Args& a, int layer, LAS unsigned char* lds, int wave, int lane);
__device__ __forceinline__ void xcd_barrier(const XcdBarrier& b, const Args* bga = nullptr, int bg_layer = -1, LAS unsigned char* lds = nullptr) {
    asm volatile("s_waitcnt vmcnt(0)" ::: "memory");
    __syncthreads();
    if (threadIdx.x == 0) {
        unsigned* bar = b.bar;
        __builtin_amdgcn_s_waitcnt(0);
        unsigned nloc = b.st[0], nx = b.st[1];
        if (nloc == 0u) { xcd_barrier_complete(bar, b.x, nloc, nx); b.st[0] = nloc; b.st[1] = nx; }
        const unsigned old = xb_add(&bar[XB_XSUB(b.x)], 1u);
        const unsigned gen = old / nloc;
        if (old + 1u == (gen + 1u) * nloc) {
            __builtin_amdgcn_fence(__ATOMIC_RELEASE, "agent");
            asm volatile("s_waitcnt vmcnt(0)" ::: "memory");
            const unsigned og = xb_add(&bar[XB_TOP], 1u);
            const unsigned tg = og / nx;
            if (og + 1u == (tg + 1u) * nx) xb_add(&bar[XB_TOPGEN], 1u);
            else XB_SPIN(xb_ld(&bar[XB_TOPGEN]) == tg, bar);
            __builtin_amdgcn_fence(__ATOMIC_ACQUIRE, "agent");
            xb_add(&bar[XB_XGEN(b.x)], 1u);
            asm volatile("s_waitcnt vmcnt(0)" ::: "memory");
            b.st[2] = 0xFFFFFFFFu;
        } else if (bg_layer < 0) {
            XB_SPIN(xb_ld(&bar[XB_XGEN(b.x)]) == gen, bar);
            __builtin_amdgcn_fence(__ATOMIC_ACQUIRE, "agent");
            asm volatile("s_waitcnt vmcnt(0)" ::: "memory");
            b.st[2] = 0xFFFFFFFFu;
        } else b.st[2] = gen;
    }
    __syncthreads();
    if (bg_layer >= 0) {
        const unsigned gen = b.st[2];
        if (gen != 0xFFFFFFFFu) {
            const int lane = threadIdx.x & 63, wave = __builtin_amdgcn_readfirstlane(threadIdx.x >> 6);
            bool more = true;
            while (more && (unsigned)__builtin_amdgcn_readfirstlane((int)xb_ld(&b.bar[XB_XGEN(b.x)])) == gen) more = convert_steal(*bga, bg_layer, lds, wave, lane);
            asm volatile("s_waitcnt vmcnt(0)" ::: "memory");
            __syncthreads();
            if (threadIdx.x == 0) { XB_SPIN(xb_ld(&b.bar[XB_XGEN(b.x)]) == gen, b.bar); __builtin_amdgcn_fence(__ATOMIC_ACQUIRE, "agent"); asm volatile("s_waitcnt vmcnt(0)" ::: "memory"); }
        } else __syncthreads();
        __syncthreads();
    }
}

namespace pg8 {
constexpr int BM = 256, BK = 64, HALF = 128, HTB = HALF * BK * 2, STAGE_BYTES = 8 * HTB, NXCD = 8, WGM = 8;
__host__ __device__ __forceinline__ int lds_byte(int r, int c) { const int st = (r >> 4) * 2 + (c >> 5), rr = r & 15, cc = c & 31, ob = rr * 64 + cc * 2; return st * 1024 + (ob ^ (((ob >> 9) & 1) << 5)); }
__host__ __device__ __forceinline__ void stage_rc(int b, int& R, int& C) { const int st = b / 1024, sb = b % 1024, swz = sb ^ (((sb >> 9) & 1) << 5); R = (st >> 1) * 16 + swz / 64; C = (st & 1) * 32 + (swz % 64) / 2; }
__host__ __device__ __forceinline__ int perm32(int rho) { const int n = rho >> 4, i = rho & 15; return 8 * (i >> 2) + 4 * n + (i & 3); }

typedef int v8i __attribute__((ext_vector_type(8)));
typedef int v4i __attribute__((ext_vector_type(4)));
__device__ __forceinline__ v8i cat8(bf16x8 lo, bf16x8 hi) { const v4i a = __builtin_bit_cast(v4i, lo), b = __builtin_bit_cast(v4i, hi); return __builtin_shufflevector(a, b, 0, 1, 2, 3, 4, 5, 6, 7); }
struct Unit { const char* A; const char* B; const unsigned* gat; int nvalid; int i0, i1, i2; };

template <class Epi, class Sched, bool GATHER, bool ALIGN_EPI, bool SP2, int BMODE = 0, int F8 = 0>
__device__ __forceinline__ void gemm_phase(LAS unsigned char* lds, const unsigned lda, const unsigned ldb, const int nt, const Sched& S, const Epi& E) {
    const int tid = threadIdx.x, wid = __builtin_amdgcn_readfirstlane(tid >> 6), lane = tid & 63, wr = wid >> 2, wc = wid & 3, fr = lane & 15, fq = lane >> 4;
    int R0, C0, R1, C1; stage_rc(tid * 16, R0, C0); stage_rc(tid * 16 + 8192, R1, C1);
    const int Rb0 = BMODE == 0 ? (R0 & ~31) + perm32(R0 & 31) : 64 * (R0 >> 5) + 16 * ((R0 & 15) >> 2) + 4 * ((R0 >> 4) & 1) + (R0 & 3);
    const int Rb1 = BMODE == 0 ? (R1 & ~31) + perm32(R1 & 31) : 64 * (R1 >> 5) + 16 * ((R1 & 15) >> 2) + 4 * ((R1 >> 4) & 1) + (R1 & 3);
    const unsigned voffB0 = (unsigned)Rb0 * ldb + (unsigned)C0 * 2u, voffB1 = (unsigned)Rb1 * ldb + (unsigned)C1 * 2u;
    const size_t hstepB = (size_t)(BMODE == 0 ? HALF : 8) * ldb;
    const size_t kstep = (size_t)(BK * 2);
    const unsigned ldsw = (unsigned)wid * 1024u;
    const int aoff = lds_byte(wr * 64 + fr, F8 ? fq * 16 : fq * 8), boff = lds_byte(wc * 32 + fr, F8 ? fq * 16 : fq * 8);
    const int aoff2 = F8 ? lds_byte(wr * 64 + fr, fq * 16 + 8) : aoff + 1024, boff2 = F8 ? lds_byte(wc * 32 + fr, fq * 16 + 8) : boff + 1024;
#define PG8_SA(b, h) (((b) * 2 + (h)) * HTB)
#define PG8_SB(b, h) ((4 + (b) * 2 + (h)) * HTB)
#define PG8_STAGE(bufoff, gbase, v0, v1) do { unsigned _v0 = (v0), _v1 = (v1); asm volatile("" : "+v"(_v0), "+v"(_v1)); \
        __builtin_amdgcn_global_load_lds((const unsigned*)((const char*)(gbase) + _v0), (LAS unsigned*)(lds + (bufoff) + ldsw), 16, 0, 0); \
        __builtin_amdgcn_global_load_lds((const unsigned*)((const char*)(gbase) + _v1), (LAS unsigned*)(lds + (bufoff) + ldsw + 8192), 16, 0, 0); } while (0)
#define PG8_LDA(dst, b, h) do { _Pragma("unroll") for (int m = 0; m < 4; ++m) { dst[m][0] = *(const LAS bf16x8*)(lds + PG8_SA(b, h) + aoff + m * 2048); dst[m][1] = *(const LAS bf16x8*)(lds + PG8_SA(b, h) + aoff2 + m * 2048); } } while (0)
#define PG8_LDB(dst, b, h) do { _Pragma("unroll") for (int n = 0; n < 2; ++n) { dst[n][0] = *(const LAS bf16x8*)(lds + PG8_SB(b, h) + boff + n * 2048); dst[n][1] = *(const LAS bf16x8*)(lds + PG8_SB(b, h) + boff2 + n * 2048); } } while (0)
#define PG8_MMA(ai, bj, At, Bt) do { __builtin_amdgcn_s_setprio(1); _Pragma("unroll") for (int m = 0; m < 4; ++m) _Pragma("unroll") for (int n = 0; n < 2; ++n) { \
        if constexpr (F8) acc[ai][bj][m][n] = __builtin_amdgcn_mfma_scale_f32_16x16x128_f8f6f4(cat8(Bt[n][0], Bt[n][1]), cat8(At[m][0], At[m][1]), acc[ai][bj][m][n], 0, 0, 0, 0x7F7F7F7F, 0, 0x7F7F7F7F); \
        else { _Pragma("unroll") for (int k = 0; k < 2; ++k) acc[ai][bj][m][n] = __builtin_amdgcn_mfma_f32_16x16x32_bf16(Bt[n][k], At[m][k], acc[ai][bj][m][n], 0, 0, 0); } } __builtin_amdgcn_s_setprio(0); } while (0)
#define PG8_WAIT_V(n) asm volatile("s_waitcnt vmcnt(" #n ")" ::: "memory")
#define PG8_WAIT_L(n) asm volatile("s_waitcnt lgkmcnt(" #n ")" ::: "memory")
#define PG8_BAR __builtin_amdgcn_s_barrier()
#define PG8_SCHED __builtin_amdgcn_sched_barrier(0)
#define PG8_SETV(v00, v01, v10, v11, u) do { \
        if (GATHER) { int _t = tid; asm volatile("" : "+v"(_t)); int r0, c0, r1, c1; stage_rc(_t * 16, r0, c0); stage_rc(_t * 16 + 8192, r1, c1);     \
            const unsigned ta = r0 < (u).nvalid ? (u).gat[r0] : 0u, tb = r1 < (u).nvalid ? (u).gat[r1] : 0u, \
                                     tc = (HALF + r0) < (u).nvalid ? (u).gat[HALF + r0] : 0u, td = (HALF + r1) < (u).nvalid ? (u).gat[HALF + r1] : 0u; \
            v00 = ta * lda + (unsigned)c0 * 2u; v01 = tb * lda + (unsigned)c1 * 2u; v10 = tc * lda + (unsigned)c0 * 2u; v11 = td * lda + (unsigned)c1 * 2u; } \
        else { v00 = (unsigned)R0 * lda + (unsigned)C0 * 2u; v01 = (unsigned)R1 * lda + (unsigned)C1 * 2u; v10 = (unsigned)(HALF + R0) * lda + (unsigned)C0 * 2u; v11 = (unsigned)(HALF + R1) * lda + (unsigned)C1 * 2u; } } while (0)
    Unit cur, nxt; int ui = 0;
    if (!S.next(0, cur)) return;
    f32x4 acc[2][2][4][2];
#pragma unroll
    for (int a = 0; a < 2; ++a)
#pragma unroll
        for (int b = 0; b < 2; ++b)
#pragma unroll
            for (int m = 0; m < 4; ++m)
#pragma unroll
                for (int n = 0; n < 2; ++n) acc[a][b][m][n] = (f32x4){0.f, 0.f, 0.f, 0.f};
    bf16x8 At[4][2], B0[2][2], B1[2][2];
    const char* cA = cur.A; const char* cB = cur.B;
    unsigned cv00, cv01, cv10, cv11;
    PG8_SETV(cv00, cv01, cv10, cv11, cur);
    if constexpr (SP2) {
        PG8_STAGE(PG8_SB(0, 0), cB, voffB0, voffB1); PG8_STAGE(PG8_SB(0, 1), cB + hstepB, voffB0, voffB1); PG8_STAGE(PG8_SA(0, 0), cA, cv00, cv01); PG8_STAGE(PG8_SA(0, 1), cA, cv10, cv11);
        if (wr == 1) PG8_BAR;
        PG8_WAIT_V(2); PG8_BAR;
        PG8_STAGE(PG8_SB(1, 0), cB + kstep, voffB0, voffB1); PG8_STAGE(PG8_SA(1, 0), cA + kstep, cv00, cv01); PG8_STAGE(PG8_SB(1, 1), cB + hstepB + kstep, voffB0, voffB1);
        PG8_WAIT_V(6); PG8_BAR;
    } else {
        PG8_STAGE(PG8_SB(0, 0), cB, voffB0, voffB1); PG8_STAGE(PG8_SA(0, 0), cA, cv00, cv01); PG8_STAGE(PG8_SB(0, 1), cB + hstepB, voffB0, voffB1); PG8_STAGE(PG8_SA(0, 1), cA, cv10, cv11);
        if (wr == 1) PG8_BAR;
        PG8_WAIT_V(4); PG8_BAR;
        PG8_STAGE(PG8_SB(1, 0), cB + kstep, voffB0, voffB1); PG8_STAGE(PG8_SA(1, 0), cA + kstep, cv00, cv01); PG8_STAGE(PG8_SB(1, 1), cB + hstepB + kstep, voffB0, voffB1);
        PG8_WAIT_V(6); PG8_BAR;
    }
    for (;;) {
        const bool has_next = S.next(ui + 1, nxt);
        const char* nA = has_next ? nxt.A : cA; const char* nB = has_next ? nxt.B : cB;
#pragma unroll 1
        for (int t = 0; t < nt; t += 2) {
            const bool last = (t == nt - 2);
            const char* a1 = cA + (size_t)(t + 1) * kstep;
            const char* a2 = last ? nA : cA + (size_t)(t + 2) * kstep; const char* b2 = last ? nB : cB + (size_t)(t + 2) * kstep;
            const char* a3 = a2 + kstep; const char* b3 = b2 + kstep;
            if constexpr (SP2) {
            PG8_LDB(B0, 0, 0); PG8_LDB(B1, 0, 1); PG8_SCHED; PG8_LDA(At, 0, 0); PG8_STAGE(PG8_SA(1, 1), a1, cv10, cv11);
            PG8_WAIT_V(8); PG8_WAIT_L(0); PG8_BAR; PG8_MMA(0, 0, At, B0); PG8_MMA(0, 1, At, B1); PG8_BAR; PG8_SCHED;
            if constexpr (GATHER) { if (last && has_next) { PG8_SETV(cv00, cv01, cv10, cv11, nxt); } }
            PG8_LDA(At, 0, 1); PG8_STAGE(PG8_SB(0, 0), b2, voffB0, voffB1); PG8_STAGE(PG8_SB(0, 1), b2 + hstepB, voffB0, voffB1); PG8_STAGE(PG8_SA(0, 0), a2, cv00, cv01);
            PG8_WAIT_V(8); PG8_WAIT_L(0); PG8_BAR; PG8_MMA(1, 0, At, B0); PG8_MMA(1, 1, At, B1); PG8_BAR; PG8_SCHED;
            PG8_LDB(B0, 1, 0); PG8_LDB(B1, 1, 1); PG8_SCHED; PG8_LDA(At, 1, 0); PG8_STAGE(PG8_SA(0, 1), a2, cv10, cv11);
            PG8_WAIT_V(8); PG8_WAIT_L(0); PG8_BAR; PG8_MMA(0, 0, At, B0); PG8_MMA(0, 1, At, B1); PG8_BAR; PG8_SCHED;
            PG8_LDA(At, 1, 1); PG8_STAGE(PG8_SB(1, 0), b3, voffB0, voffB1); PG8_STAGE(PG8_SB(1, 1), b3 + hstepB, voffB0, voffB1); PG8_STAGE(PG8_SA(1, 0), a3, cv00, cv01);
            PG8_WAIT_V(8); PG8_WAIT_L(0); PG8_BAR; PG8_MMA(1, 0, At, B0); PG8_MMA(1, 1, At, B1); PG8_BAR; PG8_SCHED;
            } else {
            PG8_LDB(B0, 0, 0); PG8_SCHED; PG8_LDA(At, 0, 0); PG8_STAGE(PG8_SA(1, 1), a1, cv10, cv11);
            PG8_WAIT_L(8); PG8_BAR; PG8_WAIT_L(0); PG8_MMA(0, 0, At, B0); PG8_BAR; PG8_SCHED;
            if constexpr (GATHER) { if (last && has_next) { PG8_SETV(cv00, cv01, cv10, cv11, nxt); } }
            PG8_LDB(B1, 0, 1); PG8_STAGE(PG8_SB(0, 0), b2, voffB0, voffB1);
            PG8_BAR; PG8_WAIT_L(0); PG8_MMA(0, 1, At, B1); PG8_BAR;
            PG8_LDA(At, 0, 1); PG8_STAGE(PG8_SA(0, 0), a2, cv00, cv01);
            PG8_BAR; PG8_WAIT_L(0); PG8_MMA(1, 0, At, B0); PG8_BAR; PG8_SCHED;
            PG8_STAGE(PG8_SB(0, 1), b2 + hstepB, voffB0, voffB1);
            PG8_WAIT_V(6); PG8_BAR; PG8_MMA(1, 1, At, B1); PG8_BAR;
            PG8_LDB(B0, 1, 0); PG8_SCHED; PG8_LDA(At, 1, 0); PG8_STAGE(PG8_SA(0, 1), a2, cv10, cv11);
            PG8_WAIT_L(8); PG8_BAR; PG8_WAIT_L(0); PG8_MMA(0, 0, At, B0); PG8_BAR; PG8_SCHED;
            PG8_LDB(B1, 1, 1); PG8_STAGE(PG8_SB(1, 0), b3, voffB0, voffB1);
            PG8_BAR; PG8_WAIT_L(0); PG8_MMA(0, 1, At, B1); PG8_BAR;
            PG8_LDA(At, 1, 1); PG8_STAGE(PG8_SA(1, 0), a3, cv00, cv01);
            PG8_BAR; PG8_WAIT_L(0); PG8_MMA(1, 0, At, B0); PG8_BAR; PG8_SCHED;
            PG8_STAGE(PG8_SB(1, 1), b3 + hstepB, voffB0, voffB1);
            PG8_WAIT_V(6); PG8_BAR; PG8_MMA(1, 1, At, B1); PG8_BAR;
            }
        }
        if constexpr (ALIGN_EPI) { if (wr == 0) PG8_BAR; }
        { int t2 = tid; asm volatile("" : "+v"(t2));
          E(acc, cur, wr, wc, t2 & 15, (t2 & 63) >> 4); }
        if (!has_next) break;
#pragma unroll
        for (int a = 0; a < 2; ++a)
#pragma unroll
            for (int b = 0; b < 2; ++b)
#pragma unroll
                for (int m = 0; m < 4; ++m)
#pragma unroll
                    for (int n = 0; n < 2; ++n) acc[a][b][m][n] = (f32x4){0.f, 0.f, 0.f, 0.f};
        cur = nxt; cA = nA; cB = nB; ++ui;
        if constexpr (ALIGN_EPI) { if (wr == 1) PG8_BAR; }
    }
    PG8_WAIT_V(0);
    if constexpr (!ALIGN_EPI) { if (wr == 0) PG8_BAR; }
    PG8_BAR;
#undef PG8_SA
#undef PG8_SB
#undef PG8_STAGE
#undef PG8_LDA
#undef PG8_LDB
#undef PG8_MMA
#undef PG8_WAIT_V
#undef PG8_WAIT_L
#undef PG8_BAR
#undef PG8_SCHED
#undef PG8_SETV
}

struct DenseSched {
    const char* A; const char* B; unsigned lda, ldb, a_pn; int nM, nN, nwg, G, c; const unsigned* ident = nullptr;
    __device__ __forceinline__ bool next(int i, Unit& u) const {
        const long L = (long)i * G + c; if (L >= nwg) return false;
        int wgid = (int)L; { const int q = nwg / NXCD, r = nwg % NXCD, xcd = wgid % NXCD, off = wgid / NXCD; wgid = (xcd < r ? xcd * (q + 1) : r * (q + 1) + (xcd - r) * q) + off; }
        const int nig = WGM * nN, gid = wgid / nig, fm = gid * WGM, gsz = (nM - fm) < WGM ? (nM - fm) : WGM;
        const int pm = fm + ((wgid % nig) % gsz), pn = (wgid % nig) / gsz;
        u.A = ident ? A : A + (size_t)pm * BM * lda + (size_t)pn * a_pn; u.B = B + (size_t)pn * BM * ldb; u.gat = ident ? ident + pm * BM : nullptr; u.nvalid = BM; u.i0 = pm; u.i1 = pn; u.i2 = 0; return true;
    }
};
struct MoeInfo { const LAS unsigned* cnt; const LAS unsigned* tstart; const LAS unsigned* ystart; const LAS unsigned char* tile_e; int ntiles; };
struct G1Sched {
    MoeInfo mi; const char* XB; const char* Wgu; const unsigned* rowtok; const unsigned* ident; int G, vcu;
    __device__ __forceinline__ bool next(int i, Unit& u) const {
        const int L = i * G + vcu; if (L >= 2 * mi.ntiles) return false;
        const int tile = L >> 1, uu = L & 1; int e;
        if (tile < 64) { e = 64; u.gat = ident + tile * 256; u.nvalid = 256; }
        else { e = __builtin_amdgcn_readfirstlane((int)mi.tile_e[tile]); const int pos0 = (tile - __builtin_amdgcn_readfirstlane((int)mi.tstart[e])) * 256; u.gat = rowtok + (size_t)e * CAP + pos0; const int rem = __builtin_amdgcn_readfirstlane((int)mi.cnt[e]) - pos0; u.nvalid = rem < 256 ? rem : 256; }
        u.A = XB; u.B = Wgu + ((size_t)e * 512 + (size_t)uu * 256) * 1024; u.i0 = tile; u.i1 = uu; u.i2 = 0; return true;
    }
};
struct G2Sched {
    MoeInfo mi; const char* H; const char* Wd; int G, vcu, L0;
    __device__ __forceinline__ bool next(int i, Unit& u) const {
        const int L = i * G + vcu + L0; if (L >= 4 * mi.ntiles) return false;
        const int tile = L >> 2, pn = L & 3; int e;
        if (tile < 64) { e = 64; u.i0 = 131072 + tile * 256; u.i2 = 0; u.nvalid = 256; }
        else { e = __builtin_amdgcn_readfirstlane((int)mi.tile_e[tile]); const int pos0 = (tile - __builtin_amdgcn_readfirstlane((int)mi.tstart[e])) * 256; u.i0 = __builtin_amdgcn_readfirstlane((int)mi.ystart[e]) + pos0; u.i2 = 0; const int rem = __builtin_amdgcn_readfirstlane((int)mi.cnt[e]) - pos0; u.nvalid = rem < 256 ? rem : 256; }
        u.A = H + (size_t)tile * 256 * 256; u.B = Wd + ((size_t)e * 1024 + (size_t)pn * 256) * 256; u.gat = nullptr; u.i1 = pn; return true;
    }
};

template <int ACT, bool BIAS, bool SCALE, bool W32 = false> struct EpiBf16 {
    bf16* O; int ldo; const float* bias; const float* scale;
    __device__ __forceinline__ void operator()(const f32x4 (&acc)[2][2][4][2], const Unit& u, int wr, int wc, int fr, int fq) const {
        const int row0 = u.i0 * BM + wr * 64 + fr, col0 = u.i1 * BM + wc * 32 + 8 * fq;
        f32x4 bv[2][2], sv[2][2];
#pragma unroll
        for (int bj = 0; bj < 2; ++bj)
#pragma unroll
            for (int n = 0; n < 2; ++n) { bv[bj][n] = BIAS ? *(const f32x4*)(bias + col0 + bj * HALF + 4 * n) : (f32x4){0.f, 0.f, 0.f, 0.f}; sv[bj][n] = SCALE ? *(const f32x4*)(scale + col0 + bj * HALF + 4 * n) : (f32x4){1.f, 1.f, 1.f, 1.f}; }
#pragma unroll
        for (int ai = 0; ai < 2; ++ai)
#pragma unroll
            for (int m = 0; m < 4; ++m) { bf16* rowp = O + (size_t)(row0 + ai * HALF + m * 16) * ldo + col0;
#pragma unroll
                for (int bj = 0; bj < 2; ++bj) { f32x4 v0 = acc[ai][bj][m][0] * (W32 ? 0.03125f : 1.0f) + bv[bj][0], v1 = acc[ai][bj][m][1] * (W32 ? 0.03125f : 1.0f) + bv[bj][1];
                    if (ACT == 1) {
#pragma unroll
                        for (int j = 0; j < 4; ++j) { v0[j] = gelu_tanh(v0[j]); v1[j] = gelu_tanh(v1[j]); } }
                    if (SCALE) { v0 = v0 * sv[bj][0]; v1 = v1 * sv[bj][1]; }
                    v4u w; w.x = cvt_pk_bf16(v0[0], v0[1]); w.y = cvt_pk_bf16(v0[2], v0[3]); w.z = cvt_pk_bf16(v1[0], v1[1]); w.w = cvt_pk_bf16(v1[2], v1[3]);
                    *(v4u*)(rowp + bj * HALF) = w; } }
    }
};
struct EpiResid {
    const float* base; float* out;
    __device__ __forceinline__ void operator()(const f32x4 (&acc)[2][2][4][2], const Unit& u, int wr, int wc, int fr, int fq) const {
        const int row0 = u.i0 * BM + wr * 64 + fr, col0 = u.i1 * BM + wc * 32 + 8 * fq;
#pragma unroll
        for (int ai = 0; ai < 2; ++ai)
#pragma unroll
            for (int m = 0; m < 4; ++m) { const size_t off = (size_t)(row0 + ai * HALF + m * 16) * DM + col0;
#pragma unroll
                for (int bj = 0; bj < 2; ++bj) { const f32x4 b0 = *(const f32x4*)(base + off + bj * HALF), b1 = *(const f32x4*)(base + off + bj * HALF + 4);
                    *(f32x4*)(out + off + bj * HALF) = b0 * ALPHA + acc[ai][bj][m][0]; *(f32x4*)(out + off + bj * HALF + 4) = b1 * ALPHA + acc[ai][bj][m][1]; }
                asm volatile("" ::: "memory"); }
    }
};
struct EpiSwiglu {
    unsigned char* H8;
    __device__ __forceinline__ void operator()(const f32x4 (&acc)[2][2][4][2], const Unit& u, int wr, int wc, int fr, int fq) const {
        const int row0 = u.i0 * BM + wr * 64 + fr, col0 = u.i1 * HALF + wc * 32 + 8 * fq;
#pragma unroll
        for (int ai = 0; ai < 2; ++ai)
#pragma unroll
            for (int m = 0; m < 4; ++m) { unsigned char* rowp = H8 + (size_t)(row0 + ai * HALF + m * 16) * EDIM + col0; float h[8];
#pragma unroll
                for (int n = 0; n < 2; ++n)
#pragma unroll
                    for (int j = 0; j < 4; ++j) { const float g = acc[ai][0][m][n][j] * 0.03125f, up = acc[ai][1][m][n][j] * 0.25f; h[4 * n + j] = g * sigmoidf_(g) * up; }
                int t0 = 0, t1 = 0; t0 = __builtin_amdgcn_cvt_pk_fp8_f32(h[0], h[1], t0, false); t0 = __builtin_amdgcn_cvt_pk_fp8_f32(h[2], h[3], t0, true); t1 = __builtin_amdgcn_cvt_pk_fp8_f32(h[4], h[5], t1, false); t1 = __builtin_amdgcn_cvt_pk_fp8_f32(h[6], h[7], t1, true);
                *(v2u*)rowp = (v2u){(unsigned)t0, (unsigned)t1}; }
    }
};
struct EpiDown {
    unsigned char* Y8;
    __device__ __forceinline__ void operator()(const f32x4 (&acc)[2][2][4][2], const Unit& u, int wr, int wc, int fr, int fq) const {
        const int r0 = wr * 64 + fr, col0 = u.i1 * BM + wc * 64 + 16 * fq;
#pragma unroll
        for (int ai = 0; ai < 2; ++ai)
#pragma unroll
            for (int m = 0; m < 4; ++m) { const int r = r0 + ai * HALF + m * 16;
                if (r < u.nvalid) { v4u w;
#pragma unroll
                    for (int q = 0; q < 4; ++q) { const f32x4 v = acc[ai][q >> 1][m][q & 1] * 0.0625f;     int t = 0; t = __builtin_amdgcn_cvt_pk_fp8_f32(v[0], v[1], t, false); t = __builtin_amdgcn_cvt_pk_fp8_f32(v[2], v[3], t, true); w[q] = (unsigned)t; }
                    *(v4u*)(Y8 + (size_t)(u.i0 + r) * DM + col0) = w; } }
    }
};
}

struct Args { const float* in[24]; float* out; unsigned char* ws; int ph_lo, ph_hi; };
enum { I_X = 0, I_PWIN, I_PWGRP, I_PSCALE, I_PWOUT, I_SWIN, I_SBIN, I_SLNG, I_SLNB, I_SWS, I_SBS, I_SWOUT, I_LNMG, I_LNMB, I_WR, I_RB, I_WG, I_WU, I_WD, I_SHG, I_SHU, I_SHD, I_LNFG, I_LNFB };

__device__ __forceinline__ void tr_item(const float* W, int N, int k0, int n0, bf16* dst  , int dpitch, LAS float* scr, int lane) {
#pragma unroll 8
    for (int i = 0; i < 32; ++i) { const int kk = 2 * i + (lane >> 5); scr[kk * 33 + (lane & 31)] = W[(size_t)(k0 + kk) * N + n0 + (lane & 31)]; }
    LDS_WAIT(); asm volatile("" ::: "memory");
    const int c = lane & 7;
#pragma unroll
    for (int j = 0; j < 4; ++j) { const int n = (lane >> 3) + 8 * j; const LAS float* s = scr + (8 * c) * 33 + n;
        v4u o; o.x = cvt_pk_bf16(s[0 * 33], s[1 * 33]); o.y = cvt_pk_bf16(s[2 * 33], s[3 * 33]); o.z = cvt_pk_bf16(s[4 * 33], s[5 * 33]); o.w = cvt_pk_bf16(s[6 * 33], s[7 * 33]);
        *(v4u*)(dst + (size_t)n * dpitch + 8 * c) = o; }
    LDS_WAIT(); asm volatile("" ::: "memory");
}
__device__ __forceinline__ void tr_item_f8(const float* W, int N, int k0, int n0, unsigned char* dst, int dpitch, float scale, LAS float* scr, int lane) {
#pragma unroll 8
    for (int i = 0; i < 32; ++i) { const int kk = 2 * i + (lane >> 5); scr[kk * 33 + (lane & 31)] = W[(size_t)(k0 + kk) * N + n0 + (lane & 31)]; }
    LDS_WAIT(); asm volatile("" ::: "memory");
    const int c = lane & 7;
#pragma unroll
    for (int j = 0; j < 4; ++j) { const int n = (lane >> 3) + 8 * j; const LAS float* s = scr + (8 * c) * 33 + n;
        int t0 = 0, t1 = 0;
        t0 = __builtin_amdgcn_cvt_pk_fp8_f32(s[0 * 33] * scale, s[1 * 33] * scale, t0, false); t0 = __builtin_amdgcn_cvt_pk_fp8_f32(s[2 * 33] * scale, s[3 * 33] * scale, t0, true);
        t1 = __builtin_amdgcn_cvt_pk_fp8_f32(s[4 * 33] * scale, s[5 * 33] * scale, t1, false); t1 = __builtin_amdgcn_cvt_pk_fp8_f32(s[6 * 33] * scale, s[7 * 33] * scale, t1, true);
        *(v2u*)(dst + (size_t)n * dpitch + 8 * c) = (v2u){(unsigned)t0, (unsigned)t1}; }
    LDS_WAIT(); asm volatile("" ::: "memory");
}
__device__ __forceinline__ void tr_tall_f8(const float* W, int N, int k0, int n0, unsigned char* dst, int dpitch, float scale, LAS float* scr, int lane) {
    f32x4 q[16]; const int r8 = lane >> 3, c4 = 4 * (lane & 7);
#pragma unroll
    for (int i = 0; i < 16; ++i) q[i] = *(const f32x4*)(W + (size_t)(k0 + 8 * i + r8) * N + n0 + c4);
#pragma unroll
    for (int i = 0; i < 16; ++i) { const int kk = 8 * i + r8; *(LAS f32x4*)(scr + kk * 32 + ((c4 + 4 * (kk >> 4)) & 31)) = q[i]; }
    LDS_WAIT(); asm volatile("" ::: "memory");
    const int c = lane & 7;
#pragma unroll
    for (int j = 0; j < 4; ++j) { const int n = r8 + 8 * j; const int col = (n + 4 * c) & 31; v4u o;
#pragma unroll
        for (int z = 0; z < 4; ++z) { const LAS float* sp = scr + (16 * c + 4 * z) * 32 + col; int t = 0;
            t = __builtin_amdgcn_cvt_pk_fp8_f32(sp[0] * scale, sp[32] * scale, t, false); t = __builtin_amdgcn_cvt_pk_fp8_f32(sp[64] * scale, sp[96] * scale, t, true); o[z] = (unsigned)t; }
        *(v4u*)(dst + (size_t)n * dpitch + 16 * c) = o; }
    LDS_WAIT(); asm volatile("" ::: "memory");
}
template <bool SPLIT> __device__ __forceinline__ void tr_block_f8(const float* W, int N, int k0, int n0, unsigned char* dst, int dpitch, float scale, LAS float* tile, int wave, int lane) {
    f32x4 q[16];
#pragma unroll
    for (int i = 0; i < 16; ++i) q[i] = *(const f32x4*)(W + (size_t)(k0 + 16 * wave + i) * N + n0 + 4 * lane);
#pragma unroll
    for (int i = 0; i < 16; ++i) { const int kk = 16 * wave + i; *(LAS f32x4*)(tile + kk * 256 + ((4 * lane + 4 * (kk >> 4)) & 255)) = q[i]; }
    LDS_WAIT(); __syncthreads();
    const int c = lane & 7, r8 = lane >> 3;
#pragma unroll
    for (int j = 0; j < 4; ++j) { const int n = 32 * wave + r8 + 8 * j; const int col = (n + 4 * c) & 255; v4u o;
#pragma unroll
        for (int z = 0; z < 4; ++z) { const LAS float* sp = tile + (16 * c + 4 * z) * 256 + col; int t = 0;
            t = __builtin_amdgcn_cvt_pk_fp8_f32(sp[0] * scale, sp[256] * scale, t, false); t = __builtin_amdgcn_cvt_pk_fp8_f32(sp[512] * scale, sp[768] * scale, t, true); o[z] = (unsigned)t; }
        *(v4u*)(dst + (size_t)(SPLIT ? ((n >> 7) * 256 + (n & 127)) : n) * dpitch + 16 * c) = o; }
    LDS_WAIT(); __syncthreads();
}
__device__ __forceinline__ void tr_item_hilo(const float* W, int N, int k0, int n0, bf16* dh, bf16* dl, int dpitch, LAS float* scr, int lane) {
#pragma unroll 8
    for (int i = 0; i < 32; ++i) { const int kk = 2 * i + (lane >> 5); scr[kk * 33 + (lane & 31)] = W[(size_t)(k0 + kk) * N + n0 + (lane & 31)]; }
    LDS_WAIT(); asm volatile("" ::: "memory");
    const int c = lane & 7;
#pragma unroll
    for (int j = 0; j < 4; ++j) { const int n = (lane >> 3) + 8 * j; const LAS float* s = scr + (8 * c) * 33 + n; float w[8];
#pragma unroll
        for (int z = 0; z < 8; ++z) w[z] = s[z * 33];
        v4u o; o.x = cvt_pk_bf16(w[0], w[1]); o.y = cvt_pk_bf16(w[2], w[3]); o.z = cvt_pk_bf16(w[4], w[5]); o.w = cvt_pk_bf16(w[6], w[7]);
        v4u l; l.x = cvt_pk_bf16(w[0] - bf_lo(o.x), w[1] - bf_hi(o.x)); l.y = cvt_pk_bf16(w[2] - bf_lo(o.y), w[3] - bf_hi(o.y)); l.z = cvt_pk_bf16(w[4] - bf_lo(o.z), w[5] - bf_hi(o.z)); l.w = cvt_pk_bf16(w[6] - bf_lo(o.w), w[7] - bf_hi(o.w));
        *(v4u*)(dh + (size_t)n * dpitch + 8 * c) = o; *(v4u*)(dl + (size_t)n * dpitch + 8 * c) = l; }
    LDS_WAIT(); asm volatile("" ::: "memory");
}
constexpr int MOE_ITEMS = 65 * 192;
__device__ __forceinline__ void convert_moe_item(const Args& a, int layer, int it, LAS float* scr, int lane) {
    unsigned char* WGU = a.ws + WS_WGU + (size_t)layer * WS_MOE_LSTRIDE; unsigned char* WDN = a.ws + WS_WDN + (size_t)layer * WS_MOE_LSTRIDE;
    const int e = it / 192, r = it % 192;
    if (r < 128) { const int isup = r >> 6, rr = r & 63, kb = rr >> 3, nb = rr & 7, n0 = 32 * nb, k0 = 128 * kb;
        const float* src = (e < 64) ? a.in[isup ? I_WU : I_WG] + ((size_t)layer * 64 + e) * 262144 : a.in[isup ? I_SHU : I_SHG] + (size_t)layer * 262144;
        const int drow = e * 512 + (n0 >> 7) * 256 + isup * 128 + (n0 & 127);
        tr_tall_f8(src, 256, k0, n0, WGU + (size_t)drow * 1024 + k0, 1024, 32.0f, scr, lane);
    } else { const int rr = r - 128, kb = rr >> 5, nb = rr & 31, n0 = 32 * nb, k0 = 128 * kb;
        const float* src = (e < 64) ? a.in[I_WD] + ((size_t)layer * 64 + e) * 262144 : a.in[I_SHD] + (size_t)layer * 262144;
        tr_tall_f8(src, 1024, k0, n0, WDN + ((size_t)e * 1024 + n0) * 256 + k0, 256, 32.0f, scr, lane);
    }
}
constexpr int Q_SHARDS = 8, Q_PER_SHARD = MOE_ITEMS / Q_SHARDS;
static_assert(Q_PER_SHARD * Q_SHARDS == MOE_ITEMS, "queue shards");
template <int CHUNK> __device__ __forceinline__ bool convert_steal_n(const Args& a, int layer, LAS unsigned char* lds, int wave, int lane) {
    unsigned* q = (unsigned*)(a.ws + WS_CTL) + CW_QNEXT + 512 * layer;
    const int s0 = (int)(blockIdx.x & 7);
    for (int s = 0; s < Q_SHARDS; ++s) { const int sh = (s0 + s) & 7;
        unsigned it = 0; if (lane == 0) it = __hip_atomic_fetch_add(q + 64 * sh, (unsigned)CHUNK, RLX_AGENT);
        it = (unsigned)__builtin_amdgcn_readfirstlane((int)it);
        if (it < (unsigned)Q_PER_SHARD) {
            for (int c = 0; c < CHUNK; ++c) if (it + c < (unsigned)Q_PER_SHARD) convert_moe_item(a, layer, sh * Q_PER_SHARD + (int)it + c, (LAS float*)(lds + wave * 16384), lane);
            return true; } }
    return false;
}
__device__ __forceinline__ bool convert_steal(const Args& a, int layer, LAS unsigned char* lds, int wave, int lane) { return convert_steal_n<1>(a, layer, lds, wave, lane); }
constexpr int MOE_WG_ITEMS = 65 * 24;
__device__ __forceinline__ void convert_static(const Args& a, int layer, LAS unsigned char* lds, int vcu, int G) {
    const int lane = threadIdx.x & 63, wave = __builtin_amdgcn_readfirstlane(threadIdx.x >> 6);
    unsigned char* WGU = a.ws + WS_WGU + (size_t)layer * WS_MOE_LSTRIDE; unsigned char* WDN = a.ws + WS_WDN + (size_t)layer * WS_MOE_LSTRIDE;
    __syncthreads();
#pragma unroll 1
    for (int it = vcu; it < MOE_WG_ITEMS; it += G) { const int e = it / 24, r = it % 24;
        if (r < 16) { const int isup = r >> 3, k0 = 128 * (r & 7);
            const float* src = (e < 64) ? a.in[isup ? I_WU : I_WG] + ((size_t)layer * 64 + e) * 262144 : a.in[isup ? I_SHU : I_SHG] + (size_t)layer * 262144;
            tr_block_f8<true>(src, 256, k0, 0, WGU + ((size_t)e * 512 + isup * 128) * 1024 + k0, 1024, 32.0f, (LAS float*)lds, wave, lane);
        } else { const int rr = r - 16, k0 = 128 * (rr >> 2), n0 = 256 * (rr & 3);
            const float* src = (e < 64) ? a.in[I_WD] + ((size_t)layer * 64 + e) * 262144 : a.in[I_SHD] + (size_t)layer * 262144;
            tr_block_f8<false>(src, 1024, k0, n0, WDN + ((size_t)e * 1024 + n0) * 256 + k0, 256, 32.0f, (LAS float*)lds, wave, lane);
        } }
}
__device__ __forceinline__ void convert_drain(const Args& a, int layer, LAS unsigned char* lds) {
    const int lane = threadIdx.x & 63, wave = __builtin_amdgcn_readfirstlane(threadIdx.x >> 6);
    while (convert_steal_n<4>(a, layer, lds, wave, lane)) {}
    __syncthreads();
}
__device__ __forceinline__ void phase_p0(const Args& a, LAS unsigned char* lds, int vcu, int G) {
    const int tid = threadIdx.x, lane = tid & 63, wave = __builtin_amdgcn_readfirstlane(tid >> 6);
    const int gw = vcu * NWAVES + wave, NGW = G * NWAVES;
    LAS float* scr = (LAS float*)(lds + wave * 16384);
    constexpr int I_IN = 16 * 32, I_GRP = 4 * 4 * 8, I_OUT = 16 * 32, I_SIN = 16 * 128, I_SOUT = 32 * 32, NIT = I_IN + I_GRP + I_OUT + I_SIN + I_SOUT;
    for (int it = gw; it < NIT; it += NGW) {
        int r = it;
        if (r < I_IN) { const int kb = r >> 5, nb = r & 31; tr_item(a.in[I_PWIN], 1024, 64 * kb, 32 * nb, (bf16*)(a.ws + WS_WIN) + (size_t)(32 * nb) * 1024 + 64 * kb, 1024, scr, lane); continue; } r -= I_IN;
        if (r < I_GRP) { const int g = r >> 5, rr = r & 31, kb = rr >> 3, nb = rr & 7; tr_item(a.in[I_PWGRP] + (size_t)g * 65536, 256, 64 * kb, 32 * nb, (bf16*)(a.ws + WS_WGRP) + (size_t)(g * 256 + 32 * nb) * 256 + 64 * kb, 256, scr, lane); continue; } r -= I_GRP;
        if (r < I_OUT) { const int kb = r >> 5, nb = r & 31; tr_item(a.in[I_PWOUT], 1024, 64 * kb, 32 * nb, (bf16*)(a.ws + WS_WOUT) + (size_t)(32 * nb) * 1024 + 64 * kb, 1024, scr, lane); continue; } r -= I_OUT;
        if (r < I_SIN) { const int kb = r >> 7, nb = r & 127; tr_item_f8(a.in[I_SWIN], 4096, 64 * kb, 32 * nb, a.ws + WS_WSIN + (size_t)(32 * nb) * 1024 + 64 * kb, 1024, 32.0f, scr, lane); continue; } r -= I_SIN;
        { const int kb = r >> 5, nb = r & 31; tr_item(a.in[I_SWOUT], 1024, 64 * kb, 32 * nb, (bf16*)(a.ws + WS_WSOUT) + (size_t)(32 * nb) * 2048 + 64 * kb, 2048, scr, lane); }
    }
    for (int it = gw; it < 64; it += NGW) { const int layer = it >> 5, rr = it & 31, kb = rr >> 1, nb = rr & 1; bf16* base = (bf16*)(a.ws + WS_WRT) + (size_t)layer * 2 * 65536 + (size_t)(32 * nb) * 1024 + 64 * kb;
        tr_item_hilo(a.in[I_WR] + (size_t)layer * DM * NE, 64, 64 * kb, 32 * nb, base, base + 65536, 1024, scr, lane); }
    convert_static(a, 0, lds, vcu, G);
    const float* x = a.in[I_X]; bf16* xb = (bf16*)(a.ws + WS_XB);
    const size_t gt = (size_t)vcu * NTHR + tid, NT = (size_t)G * NTHR;
#pragma unroll 1
    for (size_t i0 = gt; i0 < (size_t)T_TOK * DM / 8; i0 += 8 * NT) { f32x4 p[8], q[8];
#pragma unroll
        for (int u = 0; u < 8; ++u) { const size_t i = i0 + (size_t)u * NT; p[u] = *(const f32x4*)(x + i * 8); q[u] = *(const f32x4*)(x + i * 8 + 4); }
#pragma unroll
        for (int u = 0; u < 8; ++u) { const size_t i = i0 + (size_t)u * NT; v4u w; w.x = cvt_pk_bf16(p[u][0], p[u][1]); w.y = cvt_pk_bf16(p[u][2], p[u][3]); w.z = cvt_pk_bf16(q[u][0], q[u][1]); w.w = cvt_pk_bf16(q[u][2], q[u][3]); *(v4u*)(xb + i * 8) = w; } }
    unsigned* ident = (unsigned*)(a.ws + WS_IDENT);
    for (size_t i = gt; i < (size_t)T_TOK; i += NT) ident[i] = (unsigned)i;
}

template <int W> __device__ __forceinline__ void pool_item(const bf16* zp  , bf16* op  , int p0  ) {
    v4u q[W + 3];
#pragma unroll
    for (int i = 0; i < W + 3; ++i) { const int ii = i < p0 + 3 ? i : p0 + 3; q[i] = *(const v4u*)(zp - (size_t)ii * DM); }
#pragma unroll
    for (int o = 0; o < 4; ++o) {
        float s[8];
#pragma unroll
        for (int j = 0; j < 8; ++j) s[j] = 0.f;
#pragma unroll
        for (int i = 3 - o; i < 3 - o + W; ++i) { const float m = (i <= p0 + 3) ? 1.0f : 0.0f;
#pragma unroll
            for (int j = 0; j < 4; ++j) { s[2 * j] += m * bf_lo(q[i][j]); s[2 * j + 1] += m * bf_hi(q[i][j]); } }
        const int p = p0 + o, nw = (p + 1) < W ? (p + 1) : W; const float inv = 1.0f / (float)nw; v4u ov;
#pragma unroll
        for (int j = 0; j < 4; ++j) ov[j] = cvt_pk_bf16(s[2 * j] * inv - bf_lo(q[3 - o][j]), s[2 * j + 1] * inv - bf_hi(q[3 - o][j]));
        *(v4u*)(op + (size_t)o * DM) = ov; }
}
__device__ __forceinline__ void pool_block(const Args& a, int pm, int g) {
    const bf16* Z = (const bf16*)(a.ws + WS_Z); bf16* P = (bf16*)(a.ws + WS_POOLED);
    const int tid = threadIdx.x;
#pragma unroll 1
    for (int q = tid; q < 64 * 32; q += NTHR) { const int c8 = q & 31, tg = q >> 5, t0 = pm * 256 + tg * 4, p0 = t0 & (SEQ - 1);
        const bf16* zp = Z + (size_t)(t0 + 3) * DM + g * 256 + c8 * 8; bf16* op = P + (size_t)t0 * DM + g * 256 + c8 * 8;
        if (g == 0) pool_item<2>(zp, op, p0); else if (g == 1) pool_item<4>(zp, op, p0); else if (g == 2) pool_item<8>(zp, op, p0); else pool_item<16>(zp, op, p0); }
    VM_WAIT(); __syncthreads();
}
__device__ __forceinline__ void phase_pool(const Args& a, int vcu, int G) {
    const bf16* Z = (const bf16*)(a.ws + WS_Z); bf16* P = (bf16*)(a.ws + WS_POOLED);
    const int tid = threadIdx.x, wave = tid >> 6, lane = tid & 63;
    const int gw = vcu * NWAVES + wave, NGW = G * NWAVES;
    for (int it = gw; it < (T_TOK / 4) * 2; it += NGW) {
        const int t0 = (it >> 1) * 4, c8 = (it & 1) * 64 + lane, g = c8 >> 5, p0 = t0 & (SEQ - 1);
        const bf16* zp = Z + (size_t)(t0 + 3) * DM + c8 * 8; bf16* op = P + (size_t)t0 * DM + c8 * 8;
        if (g == 0) pool_item<2>(zp, op, p0); else if (g == 1) pool_item<4>(zp, op, p0); else if (g == 2) pool_item<8>(zp, op, p0); else pool_item<16>(zp, op, p0);
    }
}

template <int R, bool F8OUT = false> __device__ __forceinline__ void ln_rows_store(float (&v)[R][16], const float* g, const float* b, float* const (&of)[R], bf16* const (&ob)[R], int lane) {
    float s[R], s2[R];
#pragma unroll
    for (int r = 0; r < R; ++r) { s[r] = 0.f;
#pragma unroll
        for (int i = 0; i < 16; ++i) s[r] += v[r][i]; }
#pragma unroll
    for (int o = 1; o < 64; o <<= 1)
#pragma unroll
        for (int r = 0; r < R; ++r) s[r] += __shfl_xor(s[r], o);
#pragma unroll
    for (int r = 0; r < R; ++r) { const float mean = s[r] * (1.0f / DM); s2[r] = 0.f;
#pragma unroll
        for (int i = 0; i < 16; ++i) { v[r][i] -= mean; s2[r] += v[r][i] * v[r][i]; } }
#pragma unroll
    for (int o = 1; o < 64; o <<= 1)
#pragma unroll
        for (int r = 0; r < R; ++r) s2[r] += __shfl_xor(s2[r], o);
#pragma unroll
    for (int j = 0; j < 2; ++j) { const int c = 8 * lane + 512 * j;
        const f32x4 g0 = *(const f32x4*)(g + c), g1 = *(const f32x4*)(g + c + 4), b0 = *(const f32x4*)(b + c), b1 = *(const f32x4*)(b + c + 4);
#pragma unroll
        for (int r = 0; r < R; ++r) { const float rstd = 1.0f / sqrtf(s2[r] * (1.0f / DM) + LN_EPS); f32x4 y0, y1;
#pragma unroll
            for (int q = 0; q < 4; ++q) { y0[q] = v[r][8 * j + q] * rstd * g0[q] + b0[q]; y1[q] = v[r][8 * j + 4 + q] * rstd * g1[q] + b1[q]; }
            *(f32x4*)(of[r] + c) = y0; *(f32x4*)(of[r] + c + 4) = y1;
            if constexpr (F8OUT) { int t0 = 0, t1 = 0; t0 = __builtin_amdgcn_cvt_pk_fp8_f32(y0[0], y0[1], t0, false); t0 = __builtin_amdgcn_cvt_pk_fp8_f32(y0[2], y0[3], t0, true); t1 = __builtin_amdgcn_cvt_pk_fp8_f32(y1[0], y1[1], t1, false); t1 = __builtin_amdgcn_cvt_pk_fp8_f32(y1[2], y1[3], t1, true);
                *(v2u*)((unsigned char*)ob[r] + c) = (v2u){(unsigned)t0, (unsigned)t1}; }
            else { v4u w; w.x = cvt_pk_bf16(y0[0], y0[1]); w.y = cvt_pk_bf16(y0[2], y0[3]); w.z = cvt_pk_bf16(y1[0], y1[1]); w.w = cvt_pk_bf16(y1[2], y1[3]);
                *(v4u*)(ob[r] + c) = w; } } }
}

__device__ __forceinline__ void phase_lnr(const Args& a, int layer, LAS unsigned char* lds, int vcu, int G, bool dry) {
    const int tid = threadIdx.x, lane = tid & 63, wave = __builtin_amdgcn_readfirstlane(tid >> 6);
    const float* xin = a.out; float* xf = dry ? (float*)(a.ws + WS_Y) : a.out; bf16* xb = dry ? (bf16*)(a.ws + WS_Y + 72 * MiB) : (bf16*)(a.ws + WS_XB);
    const float* lng = a.in[I_LNMG] + layer * DM; const float* lnb = a.in[I_LNMB] + layer * DM;
    const float* Wr = a.in[I_WR] + (size_t)layer * DM * NE; const float* rbias = a.in[I_RB] + layer * NE;
    unsigned* gcount = (unsigned*)(a.ws + WS_CTL) + CW_CNT + layer * 64 + (dry ? 128 : 0);
    unsigned* rowtok = dry ? (unsigned*)(a.ws + WS_Y + 64 * MiB) : (unsigned*)(a.ws + WS_ROWTOK); unsigned* dest = dry ? (unsigned*)(a.ws + WS_Y + 68 * MiB) : (unsigned*)(a.ws + WS_DEST); float* gatev = dry ? (float*)(a.ws + WS_Y + 69 * MiB) : (float*)(a.ws + WS_GATE);
    LAS float* part = (LAS float*)lds;
    LAS unsigned* hist = (LAS unsigned*)(lds + 65536);
    LAS unsigned* basep = (LAS unsigned*)(lds + 65536 + 256);
    { const int blk = vcu;
        const int row0 = blk * 64;
        if (tid < 64) hist[tid] = 0u;
        { float v[8][16]; float* of[8]; bf16* ob[8];
#pragma unroll
            for (int r = 0; r < 8; ++r) { const int rr = wave * 8 + r; const float* xr = xin + (size_t)(row0 + rr) * DM; of[r] = xf + (size_t)(row0 + rr) * DM; ob[r] = (bf16*)((unsigned char*)xb + (size_t)(row0 + rr) * DM);
#pragma unroll
                for (int j = 0; j < 2; ++j) { const f32x4 p = *(const f32x4*)(xr + 8 * lane + 512 * j), q = *(const f32x4*)(xr + 8 * lane + 512 * j + 4);
#pragma unroll
                    for (int i = 0; i < 4; ++i) { v[r][8 * j + i] = p[i]; v[r][8 * j + 4 + i] = q[i]; } } }
            ln_rows_store<8, true>(v, lng, lnb, of, ob, lane); }
        VM_WAIT(); __syncthreads();
#ifndef DRY_PARTS
#define DRY_PARTS 7
#endif
        if (!dry || (DRY_PARTS & 2)) { const int kq = wave & 3, mh = wave >> 2, r = lane & 15, g = lane >> 4;
          f32x4 acc[2][4];
#pragma unroll
          for (int m = 0; m < 2; ++m)
#pragma unroll
              for (int n = 0; n < 4; ++n) acc[m][n] = (f32x4){0.f, 0.f, 0.f, 0.f};
          const float* arow = xf + (size_t)(row0 + 32 * mh + r) * DM + kq * 256 + 8 * g;
          const bf16* bh = (const bf16*)(a.ws + WS_WRT) + (size_t)layer * 2 * 65536 + (size_t)r * 1024 + kq * 256 + 8 * g; const bf16* bl = bh + 65536;
          f32x4 a0[2], a1[2]; bf16x8 wh[4], wl[4];
#pragma unroll
          for (int m = 0; m < 2; ++m) { a0[m] = *(const f32x4*)(arow + (size_t)m * 16 * DM); a1[m] = *(const f32x4*)(arow + (size_t)m * 16 * DM + 4); }
#pragma unroll
          for (int n = 0; n < 4; ++n) { wh[n] = *(const bf16x8*)(bh + (size_t)n * 16384); wl[n] = *(const bf16x8*)(bl + (size_t)n * 16384); }
#pragma unroll 1
          for (int s = 0; s < 8; ++s) { const int sn = s < 7 ? s + 1 : s;
              f32x4 n0[2], n1[2]; bf16x8 nh[4], nl[4];
#pragma unroll
              for (int m = 0; m < 2; ++m) { n0[m] = *(const f32x4*)(arow + (size_t)m * 16 * DM + 32 * sn); n1[m] = *(const f32x4*)(arow + (size_t)m * 16 * DM + 32 * sn + 4); }
#pragma unroll
              for (int n = 0; n < 4; ++n) { nh[n] = *(const bf16x8*)(bh + (size_t)n * 16384 + 32 * sn); nl[n] = *(const bf16x8*)(bl + (size_t)n * 16384 + 32 * sn); }
#pragma unroll
              for (int m = 0; m < 2; ++m) {
                  v4u hi, lo; hi.x = cvt_pk_bf16(a0[m][0], a0[m][1]); hi.y = cvt_pk_bf16(a0[m][2], a0[m][3]); hi.z = cvt_pk_bf16(a1[m][0], a1[m][1]); hi.w = cvt_pk_bf16(a1[m][2], a1[m][3]);
                  lo.x = cvt_pk_bf16(a0[m][0] - bf_lo(hi.x), a0[m][1] - bf_hi(hi.x)); lo.y = cvt_pk_bf16(a0[m][2] - bf_lo(hi.y), a0[m][3] - bf_hi(hi.y));
                  lo.z = cvt_pk_bf16(a1[m][0] - bf_lo(hi.z), a1[m][1] - bf_hi(hi.z)); lo.w = cvt_pk_bf16(a1[m][2] - bf_lo(hi.w), a1[m][3] - bf_hi(hi.w));
                  const bf16x8 ah = __builtin_bit_cast(bf16x8, hi), al = __builtin_bit_cast(bf16x8, lo);
#pragma unroll
                  for (int n = 0; n < 4; ++n) { acc[m][n] = __builtin_amdgcn_mfma_f32_16x16x32_bf16(ah, wh[n], acc[m][n], 0, 0, 0); acc[m][n] = __builtin_amdgcn_mfma_f32_16x16x32_bf16(al, wh[n], acc[m][n], 0, 0, 0); acc[m][n] = __builtin_amdgcn_mfma_f32_16x16x32_bf16(ah, wl[n], acc[m][n], 0, 0, 0); } }
#pragma unroll
              for (int m = 0; m < 2; ++m) { a0[m] = n0[m]; a1[m] = n1[m]; }
#pragma unroll
              for (int n = 0; n < 4; ++n) { wh[n] = nh[n]; wl[n] = nl[n]; } }
#pragma unroll
          for (int m = 0; m < 2; ++m)
#pragma unroll
              for (int n = 0; n < 4; ++n)
#pragma unroll
                  for (int q = 0; q < 4; ++q) part[(kq * 64 + 32 * mh + 16 * m + 4 * g + q) * 64 + 16 * n + r] = acc[m][n][q]; }
        __syncthreads();
        if (!dry || (DRY_PARTS & 4)) { const int row = tid >> 3, grp = tid & 7; float sc[8], bsd[8];
#pragma unroll
          for (int i = 0; i < 8; ++i) { const int e = 8 * grp + i; const float lg = (part[row * 64 + e] + part[(64 + row) * 64 + e]) + (part[(128 + row) * 64 + e] + part[(192 + row) * 64 + e]); sc[i] = 1.0f / (1.0f + __expf(-lg)); bsd[i] = sc[i] + rbias[e]; }
          float m1 = -INFINITY, m2 = -INFINITY;
#pragma unroll
          for (int i = 0; i < 8; ++i) { const float v = bsd[i]; if (v > m1) { m2 = m1; m1 = v; } else if (v > m2) m2 = v; }
          const float myg = m1 + m2;
          int grank = 0;
#pragma unroll
          for (int d = 1; d < 8; ++d) { const float o = __shfl(myg, (lane & ~7) | ((grp + d) & 7)); const int g2 = (grp + d) & 7; grank += (o > myg || (o == myg && g2 < grp)) ? 1 : 0; }
          const bool gsel = grank < 4;
          float cand[8]; int rk[8]; bool sel[8];
#pragma unroll
          for (int i = 0; i < 8; ++i) { cand[i] = gsel ? bsd[i] : -INFINITY; rk[i] = 0; sel[i] = false; }
#pragma unroll 1
          for (int k = 0; k < TOPK; ++k) {
              float best = cand[0]; int bi = 0;
#pragma unroll
              for (int i = 1; i < 8; ++i) if (cand[i] > best) { best = cand[i]; bi = i; }
              int gi = 8 * grp + bi;
#define LNR_RED(CTRL) { const float ov = __builtin_bit_cast(float, __builtin_amdgcn_update_dpp(0, __builtin_bit_cast(int, best), CTRL, 0xF, 0xF, false)); const int oi = __builtin_amdgcn_update_dpp(0, gi, CTRL, 0xF, 0xF, false); if (ov > best || (ov == best && oi < gi)) { best = ov; gi = oi; } }
              LNR_RED(0xB1) LNR_RED(0x4E) LNR_RED(0x141)
#undef LNR_RED
#pragma unroll
              for (int i = 0; i < 8; ++i) if (gi == 8 * grp + i) { cand[i] = -INFINITY; rk[i] = k; sel[i] = true; }
          }
          float psum = 0.f;
#pragma unroll
          for (int i = 0; i < 8; ++i) psum += sel[i] ? sc[i] : 0.f;
          psum += __shfl_xor(psum, 1); psum += __shfl_xor(psum, 2); psum += __shfl_xor(psum, 4);
          const float inv = ROUTED_SCALE / psum;
          unsigned loc[8];
#pragma unroll
          for (int i = 0; i < 8; ++i) { loc[i] = 0u; if (sel[i]) loc[i] = __hip_atomic_fetch_add(hist + 8 * grp + i, 1u, __ATOMIC_RELAXED, __HIP_MEMORY_SCOPE_WORKGROUP); }
          __syncthreads();
          if (tid < 64) { const unsigned h = hist[tid]; basep[tid] = h ? __hip_atomic_fetch_add(gcount + tid, h, RLX_AGENT) : 0u; }
          __syncthreads();
          const int tok = row0 + row;
#pragma unroll
          for (int i = 0; i < 8; ++i) if (sel[i]) { const int e = 8 * grp + i; const unsigned pos = basep[e] + loc[i];
              rowtok[(size_t)e * CAP + pos] = (unsigned)tok; dest[tok * 8 + rk[i]] = ((unsigned)e << 16) | pos; gatev[tok * 8 + rk[i]] = sc[i] * inv; }
        }
        __syncthreads();
    }
}

__device__ __forceinline__ pg8::MoeInfo moe_setup(const Args& a, int layer, LAS unsigned char* misc) {
    const int tid = threadIdx.x;
    unsigned* gcount = (unsigned*)(a.ws + WS_CTL) + CW_CNT + layer * 64;
    LAS unsigned* cnt = (LAS unsigned*)(misc + MI_CNT); LAS unsigned* tstart = (LAS unsigned*)(misc + MI_TSTART); LAS unsigned* ystart = (LAS unsigned*)(misc + MI_YSTART);
    LAS unsigned* ntl = (LAS unsigned*)(misc + MI_NTILES); LAS unsigned char* tile_e = (LAS unsigned char*)(misc + MI_TILE_E);
    __syncthreads();
    if (tid < 64) { unsigned c = __hip_atomic_load(gcount + tid, RLX_AGENT); if (c > (unsigned)CAP) c = CAP; cnt[tid] = c; }
    __syncthreads();
    if (tid < 64) { unsigned ts = 64u, ys = 0u; for (int e = 0; e < tid; ++e) { const unsigned c = cnt[e]; ts += (c + 255u) >> 8; ys += c; }
        tstart[tid] = ts; ystart[tid] = ys; const unsigned mynt = (cnt[tid] + 255u) >> 8;
        for (unsigned i = 0; i < mynt; ++i) if (ts + i < 640u) tile_e[ts + i] = (unsigned char)tid;
        if (tid == 63) ntl[0] = ts + mynt; }
    __syncthreads();
    pg8::MoeInfo mi; mi.cnt = cnt; mi.tstart = tstart; mi.ystart = ystart; mi.tile_e = tile_e; mi.ntiles = __builtin_amdgcn_readfirstlane((int)ntl[0]);
    if (mi.ntiles > 640) mi.ntiles = 640;
    return mi;
}

__device__ __forceinline__ void phase_combine(const Args& a, int layer, LAS unsigned char* misc, int vcu, int G, bool dry) {
    const int tid = threadIdx.x, lane = tid & 63, wave = __builtin_amdgcn_readfirstlane(tid >> 6);
    const pg8::MoeInfo mi = moe_setup(a, layer, misc);
    float* xf = a.out; bf16* xb = (bf16*)(a.ws + WS_XB); const unsigned char* Y8 = (const unsigned char*)(a.ws + WS_Y);
    const unsigned* dest = (const unsigned*)(a.ws + WS_DEST); const float* gatev = (const float*)(a.ws + WS_GATE);
    const float* lng = a.in[I_LNFG] + layer * DM; const float* lnb = a.in[I_LNFB] + layer * DM;
    const int gw = vcu * NWAVES + wave, NGW = G * NWAVES;
#pragma unroll 1
    for (int rowa = gw; rowa < T_TOK; rowa += 2 * NGW) {
        float v[2][16]; float* of[2]; bf16* ob[2]; unsigned d[2][TOPK]; float gk[2][TOPK];
#pragma unroll
        for (int r = 0; r < 2; ++r) { const int row = rowa + r * NGW;
#pragma unroll
            for (int k = 0; k < TOPK; ++k) { d[r][k] = dest[row * 8 + k]; gk[r][k] = gatev[row * 8 + k]; } }
#pragma unroll
        for (int r = 0; r < 2; ++r) { const int row = rowa + r * NGW; float* xr = xf + (size_t)row * DM; of[r] = dry ? (float*)(a.ws + WS_H) + (size_t)row * DM : xr; ob[r] = xb + (size_t)row * DM;
#pragma unroll
            for (int j = 0; j < 2; ++j) { const f32x4 p = *(const f32x4*)(xr + 8 * lane + 512 * j), q = *(const f32x4*)(xr + 8 * lane + 512 * j + 4);
#pragma unroll
                for (int i = 0; i < 4; ++i) { v[r][8 * j + i] = p[i] * ALPHA; v[r][8 * j + 4 + i] = q[i] * ALPHA; } } }
#pragma unroll
        for (int r = 0; r < 2; ++r) { const unsigned char* yr = Y8 + (size_t)(131072 + rowa + r * NGW) * DM;
#pragma unroll
            for (int j = 0; j < 2; ++j) { const v2u w = *(const v2u*)(yr + 8 * lane + 512 * j);
#pragma unroll
                for (int q = 0; q < 2; ++q) { const f32x2 lo2 = __builtin_amdgcn_cvt_pk_f32_fp8((int)w[q], false), hi2 = __builtin_amdgcn_cvt_pk_f32_fp8((int)w[q], true);
                    v[r][8 * j + 4 * q] += 0.0625f * lo2.x; v[r][8 * j + 4 * q + 1] += 0.0625f * lo2.y; v[r][8 * j + 4 * q + 2] += 0.0625f * hi2.x; v[r][8 * j + 4 * q + 3] += 0.0625f * hi2.y; } } }
#pragma unroll
        for (int r = 0; r < 2; ++r)
#pragma unroll
            for (int k = 0; k < TOPK; ++k) { const unsigned dd = (unsigned)__builtin_amdgcn_readfirstlane((int)d[r][k]); const float g = __uint_as_float((unsigned)__builtin_amdgcn_readfirstlane((int)__float_as_uint(gk[r][k])));
                const unsigned e = (dd >> 16) & 63u, pos = dd & 0xffffu; const unsigned char* yr = Y8 + (size_t)(mi.ystart[e] + pos) * DM; const float g16 = g * 0.0625f;
#pragma unroll
                for (int j = 0; j < 2; ++j) { const v2u w = *(const v2u*)(yr + 8 * lane + 512 * j);
#pragma unroll
                    for (int q = 0; q < 2; ++q) { const f32x2 lo2 = __builtin_amdgcn_cvt_pk_f32_fp8((int)w[q], false), hi2 = __builtin_amdgcn_cvt_pk_f32_fp8((int)w[q], true);
                        v[r][8 * j + 4 * q] += g16 * lo2.x; v[r][8 * j + 4 * q + 1] += g16 * lo2.y; v[r][8 * j + 4 * q + 2] += g16 * hi2.x; v[r][8 * j + 4 * q + 3] += g16 * hi2.y; } } }
        for (int r = 0; r < 2; ++r) ob[r] = (bf16*)((unsigned char*)xb + (size_t)(rowa + r * NGW) * DM);
        ln_rows_store<2, true>(v, lng, lnb, of, ob, lane);
    }
}

__device__ __forceinline__ int swz16(int row) { return (row ^ (row >> 4)) & 15; }
__device__ __forceinline__ void phase_sgu_spatial(const Args& a, LAS unsigned char* lds, int vcu, int G) {
    const int tid = threadIdx.x, lane = tid & 63, wave = __builtin_amdgcn_readfirstlane(tid >> 6), fr = lane & 15, fq = lane >> 4;
    const bf16* HS = (const bf16*)(a.ws + WS_HS); bf16* GT = (bf16*)(a.ws + WS_GATED);
    const float* lng = a.in[I_SLNG]; const float* lnb = a.in[I_SLNB]; const float* WS = a.in[I_SWS]; const float* BS = a.in[I_SBS];
    LAS unsigned char* Bs = lds;
    LAS unsigned char* As = lds + 65536;
    LAS float* stm = (LAS float*)(lds + 98304);
    LAS float* str = (LAS float*)(lds + 98304 + 512);
    for (int item = vcu; item < 512; item += G) {
        const int chunk = item >> 2, h = item & 3, t0 = chunk * 128;
        __syncthreads();
#pragma unroll 1
        for (int r4 = 0; r4 < 4; ++r4) { v4u w[4][4];
#pragma unroll
            for (int rr = 0; rr < 4; ++rr) { const bf16* vr = HS + (size_t)(t0 + wave * 16 + r4 * 4 + rr) * 4096 + SGU_W;
#pragma unroll
                for (int q = 0; q < 4; ++q) w[rr][q] = *(const v4u*)(vr + 8 * lane + 512 * q); }
            float sm[4], sq[4];
#pragma unroll
            for (int rr = 0; rr < 4; ++rr) { float s1 = 0.f;
#pragma unroll
                for (int q = 0; q < 4; ++q)
#pragma unroll
                    for (int p = 0; p < 4; ++p) s1 += bf_lo(w[rr][q][p]) + bf_hi(w[rr][q][p]);
                sm[rr] = s1; }
#pragma unroll
            for (int o = 1; o < 64; o <<= 1)
#pragma unroll
                for (int rr = 0; rr < 4; ++rr) sm[rr] += __shfl_xor(sm[rr], o);
#pragma unroll
            for (int rr = 0; rr < 4; ++rr) { const float mean = sm[rr] * (1.0f / SGU_W); float s2 = 0.f;
#pragma unroll
                for (int q = 0; q < 4; ++q)
#pragma unroll
                    for (int p = 0; p < 4; ++p) { const float d0 = bf_lo(w[rr][q][p]) - mean, d1 = bf_hi(w[rr][q][p]) - mean; s2 += d0 * d0 + d1 * d1; }
                sm[rr] = mean; sq[rr] = s2; }
#pragma unroll
            for (int o = 1; o < 64; o <<= 1)
#pragma unroll
                for (int rr = 0; rr < 4; ++rr) sq[rr] += __shfl_xor(sq[rr], o);
            if (lane == 0) {
#pragma unroll
                for (int rr = 0; rr < 4; ++rr) { const int j = wave * 16 + r4 * 4 + rr; stm[j] = sm[rr]; str[j] = 1.0f / sqrtf(sq[rr] * (1.0f / SGU_W) + LN_EPS); } } }
        for (int q = tid; q < 128 * 16; q += NTHR) { const int i = q >> 4, jc = q & 15; const float* wp = WS + ((size_t)h * 128 + i) * 128 + 8 * jc;
            const f32x4 p0 = *(const f32x4*)wp, p1 = *(const f32x4*)(wp + 4); float w8[8];
#pragma unroll
            for (int z = 0; z < 4; ++z) { w8[z] = (8 * jc + z <= i) ? p0[z] : 0.f; w8[4 + z] = (8 * jc + 4 + z <= i) ? p1[z] : 0.f; }
            v4u o; o.x = cvt_pk_bf16(w8[0], w8[1]); o.y = cvt_pk_bf16(w8[2], w8[3]); o.z = cvt_pk_bf16(w8[4], w8[5]); o.w = cvt_pk_bf16(w8[6], w8[7]);
            *(LAS v4u*)(As + i * 256 + ((jc ^ swz16(i)) << 4)) = o; }
        __syncthreads();
        for (int hh = 0; hh < 2; ++hh) {
            const int cb = h * SGU_HD + hh * 256;
#pragma unroll 2
            for (int q = tid; q < 64 * 32; q += NTHR) { const int c8 = q & 31, jp = q >> 5, j0 = 2 * jp;
                const v4u w0 = *(const v4u*)(HS + (size_t)(t0 + j0) * 4096 + SGU_W + cb + 8 * c8), w1 = *(const v4u*)(HS + (size_t)(t0 + j0 + 1) * 4096 + SGU_W + cb + 8 * c8);
                const f32x4 g0 = *(const f32x4*)(lng + cb + 8 * c8), g1 = *(const f32x4*)(lng + cb + 8 * c8 + 4), b0 = *(const f32x4*)(lnb + cb + 8 * c8), b1 = *(const f32x4*)(lnb + cb + 8 * c8 + 4);
                const float m0 = stm[j0], r0 = str[j0], m1 = stm[j0 + 1], r1 = str[j0 + 1];
#pragma unroll
                for (int z = 0; z < 8; ++z) { const float gz = z < 4 ? g0[z & 3] : g1[z & 3], bz = z < 4 ? b0[z & 3] : b1[z & 3];
                    const float xa = (z & 1) ? bf_hi(w0[z >> 1]) : bf_lo(w0[z >> 1]), xc = (z & 1) ? bf_hi(w1[z >> 1]) : bf_lo(w1[z >> 1]);
                    const float ya = (xa - m0) * r0 * gz + bz, yc = (xc - m1) * r1 * gz + bz;
                    const int cc = 8 * c8 + z, slot = (cc & ~31) | (((cc >> 2) & 1) << 4) | (((cc >> 3) & 3) << 2) | (cc & 3);
                    *(LAS unsigned*)(Bs + slot * 256 + (((j0 >> 3) ^ swz16(slot)) << 4) + (j0 & 7) * 2) = cvt_pk_bf16(ya, yc); } }
            __syncthreads();
            f32x4 acc[8][2]; bf16x8 Bf[2][4];
#pragma unroll
            for (int n = 0; n < 2; ++n)
#pragma unroll
                for (int s = 0; s < 4; ++s) { const int slot = 32 * wave + 16 * n + fr; Bf[n][s] = *(const LAS bf16x8*)(Bs + slot * 256 + (((4 * s + fq) ^ swz16(slot)) << 4)); }
#pragma unroll
            for (int m = 0; m < 8; ++m) { acc[m][0] = (f32x4){0.f, 0.f, 0.f, 0.f}; acc[m][1] = (f32x4){0.f, 0.f, 0.f, 0.f};
#pragma unroll
                for (int s = 0; s < 4; ++s) if (s <= (m >> 1)) { const int i = 16 * m + fr; const bf16x8 af = *(const LAS bf16x8*)(As + i * 256 + (((4 * s + fq) ^ swz16(i)) << 4));
                    acc[m][0] = __builtin_amdgcn_mfma_f32_16x16x32_bf16(Bf[0][s], af, acc[m][0], 0, 0, 0); acc[m][1] = __builtin_amdgcn_mfma_f32_16x16x32_bf16(Bf[1][s], af, acc[m][1], 0, 0, 0); } }
#pragma unroll
            for (int m = 0; m < 8; ++m) { const int i = 16 * m + fr; const float bsv = BS[h * 128 + i]; const size_t t = (size_t)(t0 + i);
                const v4u uw = *(const v4u*)(HS + t * 4096 + cb + 32 * wave + 8 * fq); float o[8];
#pragma unroll
                for (int n = 0; n < 2; ++n)
#pragma unroll
                    for (int z = 0; z < 4; ++z) { const int c = 4 * n + z; const float uu = (c & 1) ? bf_hi(uw[c >> 1]) : bf_lo(uw[c >> 1]); o[c] = uu * (acc[m][n][z] + bsv); }
                v4u w; w.x = cvt_pk_bf16(o[0], o[1]); w.y = cvt_pk_bf16(o[2], o[3]); w.z = cvt_pk_bf16(o[4], o[5]); w.w = cvt_pk_bf16(o[6], o[7]);
                *(v4u*)(GT + t * SGU_W + cb + 32 * wave + 8 * fq) = w; }
            __syncthreads();
        }
    }
}

__device__ __forceinline__ void phase_flush(const Args& a, int vcu, int G) {
    const size_t gt = (size_t)vcu * NTHR + threadIdx.x, NT = (size_t)G * NTHR; f32x4 acc = (f32x4){0.f, 0.f, 0.f, 0.f};
    const f32x4* p0 = (const f32x4*)a.in[I_WG]; const f32x4* p1 = (const f32x4*)a.in[I_WU];
    for (size_t i = gt; i < (size_t)33554432 / 4; i += 4 * NT) { const f32x4 x0 = p0[i], x1 = p0[i + NT], x2 = p0[i + 2 * NT], x3 = p0[i + 3 * NT], y0 = p1[i], y1 = p1[i + NT], y2 = p1[i + 2 * NT], y3 = p1[i + 3 * NT]; acc += x0 + x1 + x2 + x3 + y0 + y1 + y2 + y3; }
    if (acc[0] + acc[1] + acc[2] + acc[3] == 1.2345e-30f) ((float*)(a.ws + WS_CTL))[16000] = acc[0];
}
constexpr int N_PHASES = 16;
__global__ void __launch_bounds__(NTHR, 2) mk_fwd(Args args) {
    extern __shared__ __attribute__((aligned(16))) unsigned char lds_raw[];
    LAS unsigned char* lds = (LAS unsigned char*)lds_raw;
    LAS unsigned char* misc = lds + MISC_OFF;
    const int tid = threadIdx.x;
    const int G = gridDim.x; const int bx = blockIdx.x; const int vcu = (G % 8 == 0) ? (bx % 8) * (G / 8) + bx / 8 : bx;
    unsigned char* ws = args.ws;
    unsigned* ctl = (unsigned*)(ws + WS_CTL);
    if (tid < 16) ((LAS unsigned*)(misc + MI_BARW))[tid] = 0u;
    __syncthreads();
    const int lo = args.ph_lo, hi = args.ph_hi;
    XcdBarrier bar; bar.bar = ctl + CW_BAR; bar.x = 0; bar.st = nullptr;
    if (hi - lo > 1) bar = xcd_barrier_post(ctl + CW_BAR, (volatile LAS unsigned*)(misc + MI_BARW));
#ifndef PH_MASK
#define PH_MASK 0xFFFF
#endif
#define IN(k) (((PH_MASK >> (k)) & 1) && lo <= (k) && (k) < hi)
#ifndef TS_A0
#define TS_A0 -1
#define TS_A1 -1
#define TS_M 1
#endif
    unsigned long long* tsbuf = (unsigned long long*)(ws + 32768);
#define TS_REC(k) do { if (TS_A0 >= 0 && bx == 0 && tid == 0) __hip_atomic_store(tsbuf + (k), (unsigned long long)__builtin_amdgcn_s_memrealtime(), RLX_AGENT); } while (0)
    TS_REC(0);
#ifndef REP_PH
#define REP_PH -1
#define REP_N 1
#endif
#define NREP(k) ((k) == REP_PH ? REP_N : 1)
#ifndef FLUSH_PH
#define FLUSH_PH -2
#endif
#define RUN(k) if (IN(k)) for (int rep = 0; rep < NREP(k); ++rep) if ((((k) == FLUSH_PH && rep == NREP(k) - 1) ? (xcd_barrier(bar), phase_flush(args, vcu, G), xcd_barrier(bar), true) : true))
#define DRY(k) (rep + 1 < NREP(k))
#define BG_LAYER(k) (-1)
#define SEAM(k) do { if (IN(k) && IN((k) + 1)) xcd_barrier(bar, &args, BG_LAYER(k), lds); TS_REC((k) + 1); } while (0)
    using namespace pg8;
    RUN(0) { phase_p0(args, lds, vcu, G); } SEAM(0);
    RUN(1) { DenseSched S{(const char*)(ws + WS_XB), (const char*)(ws + WS_WIN), 2048u, 2048u, 0u, 64, 4, 256, G, bx};
        EpiBf16<0, false, false> E{(bf16*)(ws + WS_Z), DM, nullptr, nullptr};
        gemm_phase<EpiBf16<0, false, false>, DenseSched, false, true, true>(lds, 2048u, 2048u, 16, S, E); } SEAM(1);
    if (REP_PH == 100 && hi - lo > 1) for (int i = 0; i < REP_N; ++i) xcd_barrier(bar);
    RUN(3) { DenseSched S{(const char*)(ws + WS_POOLED), (const char*)(ws + WS_WGRP), 2048u, 512u, 512u, 64, 4, 256, G, bx};
        { Unit u0; if (S.next(0, u0)) pool_block(args, u0.i0, u0.i1); }
        EpiBf16<0, false, true> E{(bf16*)(ws + WS_YP), DM, nullptr, args.in[I_PSCALE]};
        gemm_phase<EpiBf16<0, false, true>, DenseSched, false, true, true>(lds, 2048u, 512u, 4, S, E); } SEAM(3);
    RUN(4) { DenseSched S{(const char*)(ws + WS_YP), (const char*)(ws + WS_WOUT), 2048u, 2048u, 0u, 64, 4, 256, G, bx};
        EpiResid E{args.in[I_X], args.out};
        gemm_phase<EpiResid, DenseSched, false, true, true>(lds, 2048u, 2048u, 16, S, E); } SEAM(4);
#define MOE_PHASES(layer, pb) do { \
        RUN(pb) { phase_lnr(args, layer, lds, vcu, G, DRY(pb)); } SEAM(pb); \
        RUN((pb) + 1) { const MoeInfo mi = moe_setup(args, layer, misc); \
            G1Sched S{mi, (const char*)(ws + WS_XB), (const char*)(ws + WS_WGU + (size_t)layer * WS_MOE_LSTRIDE), (const unsigned*)(ws + WS_ROWTOK), (const unsigned*)(ws + WS_IDENT), G, vcu}; \
            EpiSwiglu E{(unsigned char*)(ws + WS_H)}; \
            gemm_phase<EpiSwiglu, G1Sched, true, true, false, 0, 1>(lds, 1024u, 1024u, 8, S, E); } SEAM((pb) + 1); \
        if (IN((pb) + 2) && REP_PH == (pb) + 2) { const MoeInfo mi = moe_setup(args, layer, misc); \
            G2Sched S{mi, (const char*)(ws + WS_H), (const char*)(ws + WS_WDN + (size_t)layer * WS_MOE_LSTRIDE), G, vcu, 256}; \
            EpiDown E{(unsigned char*)(ws + WS_Y)}; \
            gemm_phase<EpiDown, G2Sched, false, true, true, 1, 1>(lds, 256u, 256u, 2, S, E); } \
        if (IN((pb) + 2)) { const MoeInfo mi = moe_setup(args, layer, misc); \
            G2Sched S{mi, (const char*)(ws + WS_H), (const char*)(ws + WS_WDN + (size_t)layer * WS_MOE_LSTRIDE), G, vcu, 0}; \
            EpiDown E{(unsigned char*)(ws + WS_Y)}; \
            gemm_phase<EpiDown, G2Sched, false, true, true, 1, 1>(lds, 256u, 256u, 2, S, E); } SEAM((pb) + 2); \
        RUN((pb) + 3) { phase_combine(args, layer, misc, vcu, G, DRY((pb) + 3)); if (layer == 0 && !DRY((pb) + 3)) { __syncthreads(); convert_static(args, 1, lds, vcu, G); } } \
    } while (0)
    MOE_PHASES(0, 5); SEAM(8);
    RUN(9) { DenseSched S{(const char*)(ws + WS_XB), (const char*)(ws + WS_WSIN), 1024u, 1024u, 0u, 64, 16, 1024, G, bx, (const unsigned*)(ws + WS_IDENT)};
        EpiBf16<1, true, false, true> E{(bf16*)(ws + WS_HS), 4096, args.in[I_SBIN], nullptr};
        gemm_phase<EpiBf16<1, true, false, true>, DenseSched, true, true, false, 0, 1>(lds, 1024u, 1024u, 8, S, E); } SEAM(9);
    RUN(10) { phase_sgu_spatial(args, lds, vcu, G); } SEAM(10);
    RUN(11) { DenseSched S{(const char*)(ws + WS_GATED), (const char*)(ws + WS_WSOUT), 4096u, 4096u, 0u, 64, 4, 256, G, bx};
        EpiResid E{args.out, DRY(11) ? (float*)(ws + WS_HS) : args.out};
        gemm_phase<EpiResid, DenseSched, false, true, true>(lds, 4096u, 4096u, 32, S, E); } SEAM(11);
    MOE_PHASES(1, 12);
#undef MOE_PHASES
    if (TS_A0 >= 0 && bx == 0 && tid == 0) {
        const unsigned long long tend = __builtin_amdgcn_s_memrealtime();
        const unsigned long long t0 = __hip_atomic_load(tsbuf + TS_A0, RLX_AGENT), t1 = (TS_A1 + 1 >= N_PHASES) ? tend : __hip_atomic_load(tsbuf + TS_A1 + 1, RLX_AGENT);
        const unsigned long long wait = (t1 - t0) * TS_M;
        while (__builtin_amdgcn_s_memrealtime() - tend < wait) __builtin_amdgcn_s_sleep(8);
    }
#undef IN
#undef SEAM
}

extern "C" void kernel_launch(void* const* d_in, const int* in_sizes, int n_in, void* d_out, int out_size, void* d_ws, size_t ws_size, hipStream_t stream) {
    static int grid = 0;
    if (grid == 0) {
        if (n_in != 24 || out_size != T_TOK * DM || ws_size < WS_END) { fprintf(stderr, "kernel_launch: unexpected shapes (n_in %d out %d ws %zu)\n", n_in, out_size, ws_size); grid = -1; return; }
        int dev = 0, cus = 0;
        if (hipGetDevice(&dev) != hipSuccess || hipDeviceGetAttribute(&cus, hipDeviceAttributeMultiprocessorCount, dev) != hipSuccess) { grid = -1; return; }
        if (hipFuncSetAttribute((const void*)mk_fwd, hipFuncAttributeMaxDynamicSharedMemorySize, LDS_BYTES) != hipSuccess) { fprintf(stderr, "kernel_launch: hipFuncSetAttribute failed\n"); grid = -1; return; }
        int per_cu = 0;
        if (hipOccupancyMaxActiveBlocksPerMultiprocessor(&per_cu, (const void*)mk_fwd, NTHR, LDS_BYTES) != hipSuccess || per_cu < 1) fprintf(stderr, "kernel_launch: occupancy query says %d\n", per_cu);
        (void)hipGetLastError();
        grid = cus;
        if (grid != 256) { fprintf(stderr, "kernel_launch: built for a 256-CU device (got %d)\n", cus); grid = -1; return; }
    }
    if (grid < 0) return;
    (void)hipMemsetAsync((char*)d_ws + WS_CTL, 0, CTL_ZERO_BYTES, stream);
    Args a{};
    for (int i = 0; i < 24; ++i) a.in[i] = (const float*)d_in[i];
    a.out = (float*)d_out; a.ws = (unsigned char*)d_ws;
#if MK_PER_PHASE
    for (int p = 0; p < N_PHASES; ++p) { a.ph_lo = p; a.ph_hi = p + 1; hipLaunchKernelGGL(mk_fwd, dim3(grid), dim3(NTHR), LDS_BYTES, stream, a); }
#else
    a.ph_lo = 0; a.ph_hi = N_PHASES; hipLaunchKernelGGL(mk_fwd, dim3(grid), dim3(NTHR), LDS_BYTES, stream, a);
#endif
}
```

```cpp
#include <hip/hip_runtime.h>
#include <cstdio>
#include <cstdint>

#ifndef MK_PER_PHASE
#define MK_PER_PHASE 0
#endif

#define GAS __attribute__((address_space(1)))
#define LAS __attribute__((address_space(3)))
typedef unsigned short bf16;
typedef unsigned v4u __attribute__((ext_vector_type(4)));
typedef unsigned v2u __attribute__((ext_vector_type(2)));
typedef float f32x4 __attribute__((ext_vector_type(4)));
typedef float f32x2 __attribute__((ext_vector_type(2)));
typedef short bf16x8 __attribute__((ext_vector_type(8)));
#define RLX_AGENT __ATOMIC_RELAXED, __HIP_MEMORY_SCOPE_AGENT
#define LDS_WAIT() asm volatile("s_waitcnt lgkmcnt(0)" ::: "memory")
#define VM_WAIT() asm volatile("s_waitcnt vmcnt(0)" ::: "memory")

constexpr int T_TOK = 16384, DM = 1024, SEQ = 4096, NE = 64, TOPK = 8, EDIM = 256;
constexpr int SGU_W = 2048, SGU_HD = 512;
constexpr float ALPHA = 1.41421356237309515f;
constexpr float LN_EPS = 1e-5f, ROUTED_SCALE = 2.5f;
constexpr int CAP = 16384;
constexpr int NWAVES = 8, NTHR = 512;

constexpr size_t MiB = 1u << 20;
constexpr size_t WS_CTL = 0, CTL_ZERO_BYTES = 65536;
constexpr size_t WS_IDENT = 256 * 1024;
constexpr size_t WS_DEST = 1 * MiB;
constexpr size_t WS_GATE = WS_DEST + 512 * 1024;
constexpr size_t WS_ROWTOK = 2 * MiB;
constexpr size_t WS_WIN = 6 * MiB;
constexpr size_t WS_WGRP = 8 * MiB;
constexpr size_t WS_WOUT = WS_WGRP + 512 * 1024;
constexpr size_t WS_WSIN = WS_WOUT + 2 * MiB;
constexpr size_t WS_WSOUT = WS_WSIN + 8 * MiB;
constexpr size_t WS_WRT = WS_WSOUT + 4 * MiB;
constexpr size_t WS_WGU = 23 * MiB;
constexpr size_t WS_WDN = WS_WGU + 65 * MiB;
constexpr size_t WS_XB = 121 * MiB;
constexpr size_t WS_H = 153 * MiB;
constexpr size_t WS_Y = 233 * MiB;
constexpr size_t WS_WGU1 = 378 * MiB, WS_WDN1 = WS_WGU1 + 65 * MiB;
constexpr size_t WS_MOE_LSTRIDE = WS_WGU1 - WS_WGU;
constexpr size_t WS_XR = 476 * MiB;
constexpr size_t WS_END = 508 * MiB;
constexpr size_t WS_Z = 153 * MiB, WS_POOLED = 185 * MiB, WS_YP = 217 * MiB;
constexpr size_t WS_HS = 153 * MiB;
constexpr size_t WS_GATED = 281 * MiB;
static_assert(WS_WRT + 512 * 1024 <= WS_WGU && WS_WDN + 33 * MiB <= WS_XB && WS_XB + 32 * MiB <= WS_H && WS_H + 80 * MiB <= WS_Y && WS_Y + 145 * MiB <= WS_WGU1 && WS_WDN1 + 33 * MiB <= WS_END && WS_GATED + 64 * MiB <= WS_WGU1, "ws map");
constexpr int CW_TMO = 0, CW_BAR = 64, CW_CNT = 4096, CW_QNEXT = 4608;

constexpr int RING_BYTES = 131072;
constexpr int MISC_OFF = RING_BYTES;
constexpr int LDS_BYTES = 147456;
constexpr int MI_BARW = 0, MI_CNT = 64, MI_TSTART = 320, MI_YSTART = 576, MI_NTILES = 832, MI_TILE_E = 1024;

__device__ __forceinline__ unsigned cvt_pk_bf16(float lo, float hi) { unsigned r; asm volatile("v_cvt_pk_bf16_f32 %0, %1, %2" : "=v"(r) : "v"(lo), "v"(hi)); return r; }
__device__ __forceinline__ float bf_lo(unsigned w) { return __uint_as_float(w << 16); }
__device__ __forceinline__ float bf_hi(unsigned w) { return __uint_as_float(w & 0xffff0000u); }
__device__ __forceinline__ float wave_sum(float v) {
#pragma unroll
    for (int o = 1; o < 64; o <<= 1) v += __shfl_xor(v, o);
    return v;
}
__device__ __forceinline__ float sigmoidf_(float x) { return __builtin_amdgcn_rcpf(1.0f + __builtin_amdgcn_exp2f(-1.4426950408889634f * x)); }
__device__ __forceinline__ float gelu_tanh(float v) { const float y = v + 0.044715f * v * v * v; return v * __builtin_amdgcn_rcpf(1.0f + __builtin_amdgcn_exp2f(-2.3022081983f * y)); }

#define XB_TMO      128
#define XB_XCNT(j)  (256  + 64 * (j))
#define XB_XSUB(j)  (1280 + 64 * (j))
#define XB_XGEN(j)  (2304 + 64 * (j))
#define XB_TOP      3328
#define XB_TOPGEN   3392
#define XCD_BAR_WORDS 3456
#define XB_SPIN_CAP (1u << 20)
__device__ __forceinline__ unsigned xb_ld(unsigned* p)              { return __hip_atomic_load(p, __ATOMIC_RELAXED, __HIP_MEMORY_SCOPE_AGENT); }
__device__ __forceinline__ unsigned xb_add(unsigned* p, unsigned v) { return __hip_atomic_fetch_add(p, v, __ATOMIC_RELAXED, __HIP_MEMORY_SCOPE_AGENT); }
__device__ __forceinline__ unsigned xb_xcc_id() { return (unsigned)__builtin_amdgcn_s_getreg((3 << 11) | 20) & 0xFu; }
#define XB_SPIN(cond, bar) do { unsigned _sp = 0; while (cond) { __builtin_amdgcn_s_sleep(1); \
    if ((++_sp & 255u) == 0u) { if (xb_ld(&(bar)[XB_TMO])) break; if (_sp > XB_SPIN_CAP) { atomicAdd(&(bar)[XB_TMO], 1u); break; } } } } while (0)
struct XcdBarrier { unsigned* bar; unsigned x; volatile LAS unsigned* st; };
__device__ __forceinline__ XcdBarrier xcd_barrier_post(unsigned* bar, volatile LAS unsigned* st) {
    XcdBarrier b; b.bar = bar; b.x = xb_xcc_id(); b.st = st;
    if (threadIdx.x == 0) (void)xb_add(&bar[XB_XCNT(b.x)], 1u);
    return b;
}
__device__ __forceinline__ void xcd_barrier_complete(unsigned* bar, unsigned x, unsigned& nloc, unsigned& nx) {
    const unsigned G = gridDim.x * gridDim.y * gridDim.z;
    unsigned sum, cnt, mine, sp = 0u;
    for (;;) {
        sum = 0u; cnt = 0u; mine = 0u;
#pragma unroll
        for (unsigned j = 0; j < 16; ++j) { const unsigned c = xb_ld(&bar[XB_XCNT(j)]); sum += c; cnt += (c > 0u) ? 1u : 0u; mine = (j == x) ? c : mine; }
        if (sum == G) break;
        __builtin_amdgcn_s_sleep(1);
        if ((++sp & 255u) == 0u) { if (xb_ld(&bar[XB_TMO])) break; if (sp > XB_SPIN_CAP) { atomicAdd(&bar[XB_TMO], 1u); break; } }
    }
    nloc = mine > 0u ? mine : 1u; nx = cnt > 0u ? cnt : 1u;
}
struct Args;
__device__ __forceinline__ bool convert_steal(const Args& a, int layer, LAS unsigned char* lds, int wave, int lane);
__device__ __forceinline__ void xcd_barrier(const XcdBarrier& b, const Args* bga = nullptr, int bg_layer = -1, LAS unsigned char* lds = nullptr) {
    asm volatile("s_waitcnt vmcnt(0)" ::: "memory");
    __syncthreads();
    if (threadIdx.x == 0) {
        unsigned* bar = b.bar;
        __builtin_amdgcn_s_waitcnt(0);
        unsigned nloc = b.st[0], nx = b.st[1];
        if (nloc == 0u) { xcd_barrier_complete(bar, b.x, nloc, nx); b.st[0] = nloc; b.st[1] = nx; }
        const unsigned old = xb_add(&bar[XB_XSUB(b.x)], 1u);
        const unsigned gen = old / nloc;
        if (old + 1u == (gen + 1u) * nloc) {
            __builtin_amdgcn_fence(__ATOMIC_RELEASE, "agent");
            asm volatile("s_waitcnt vmcnt(0)" ::: "memory");
            const unsigned og = xb_add(&bar[XB_TOP], 1u);
            const unsigned tg = og / nx;
            if (og + 1u == (tg + 1u) * nx) xb_add(&bar[XB_TOPGEN], 1u);
            else XB_SPIN(xb_ld(&bar[XB_TOPGEN]) == tg, bar);
            __builtin_amdgcn_fence(__ATOMIC_ACQUIRE, "agent");
            xb_add(&bar[XB_XGEN(b.x)], 1u);
            asm volatile("s_waitcnt vmcnt(0)" ::: "memory");
            b.st[2] = 0xFFFFFFFFu;
        } else if (bg_layer < 0) {
            XB_SPIN(xb_ld(&bar[XB_XGEN(b.x)]) == gen, bar);
            __builtin_amdgcn_fence(__ATOMIC_ACQUIRE, "agent");
            asm volatile("s_waitcnt vmcnt(0)" ::: "memory");
            b.st[2] = 0xFFFFFFFFu;
        } else b.st[2] = gen;
    }
    __syncthreads();
    if (bg_layer >= 0) {
        const unsigned gen = b.st[2];
        if (gen != 0xFFFFFFFFu) {
            const int lane = threadIdx.x & 63, wave = __builtin_amdgcn_readfirstlane(threadIdx.x >> 6);
            bool more = true;
            while (more && (unsigned)__builtin_amdgcn_readfirstlane((int)xb_ld(&b.bar[XB_XGEN(b.x)])) == gen) more = convert_steal(*bga, bg_layer, lds, wave, lane);
            asm volatile("s_waitcnt vmcnt(0)" ::: "memory");
            __syncthreads();
            if (threadIdx.x == 0) { XB_SPIN(xb_ld(&b.bar[XB_XGEN(b.x)]) == gen, b.bar); __builtin_amdgcn_fence(__ATOMIC_ACQUIRE, "agent"); asm volatile("s_waitcnt vmcnt(0)" ::: "memory"); }
        } else __syncthreads();
        __syncthreads();
    }
}

namespace pg8 {
constexpr int BM = 256, BK = 64, HALF = 128, HTB = HALF * BK * 2, STAGE_BYTES = 8 * HTB, NXCD = 8, WGM = 8;
__host__ __device__ __forceinline__ int lds_byte(int r, int c) { const int st = (r >> 4) * 2 + (c >> 5), rr = r & 15, cc = c & 31, ob = rr * 64 + cc * 2; return st * 1024 + (ob ^ (((ob >> 9) & 1) << 5)); }
__host__ __device__ __forceinline__ void stage_rc(int b, int& R, int& C) { const int st = b / 1024, sb = b % 1024, swz = sb ^ (((sb >> 9) & 1) << 5); R = (st >> 1) * 16 + swz / 64; C = (st & 1) * 32 + (swz % 64) / 2; }
__host__ __device__ __forceinline__ int perm32(int rho) { const int n = rho >> 4, i = rho & 15; return 8 * (i >> 2) + 4 * n + (i & 3); }

typedef int v8i __attribute__((ext_vector_type(8)));
typedef int v4i __attribute__((ext_vector_type(4)));
__device__ __forceinline__ v8i cat8(bf16x8 lo, bf16x8 hi) { const v4i a = __builtin_bit_cast(v4i, lo), b = __builtin_bit_cast(v4i, hi); return __builtin_shufflevector(a, b, 0, 1, 2, 3, 4, 5, 6, 7); }
struct Unit { const char* A; const char* B; const unsigned* gat; int nvalid; int i0, i1, i2; };

template <class Epi, class Sched, bool GATHER, bool ALIGN_EPI, bool SP2, int BMODE = 0, int F8 = 0>
__device__ __forceinline__ void gemm_phase(LAS unsigned char* lds, const unsigned lda, const unsigned ldb, const int nt, const Sched& S, const Epi& E) {
    const int tid = threadIdx.x, wid = __builtin_amdgcn_readfirstlane(tid >> 6), lane = tid & 63, wr = wid >> 2, wc = wid & 3, fr = lane & 15, fq = lane >> 4;
    int R0, C0, R1, C1; stage_rc(tid * 16, R0, C0); stage_rc(tid * 16 + 8192, R1, C1);
    const int Rb0 = BMODE == 0 ? (R0 & ~31) + perm32(R0 & 31) : 64 * (R0 >> 5) + 16 * ((R0 & 15) >> 2) + 4 * ((R0 >> 4) & 1) + (R0 & 3);
    const int Rb1 = BMODE == 0 ? (R1 & ~31) + perm32(R1 & 31) : 64 * (R1 >> 5) + 16 * ((R1 & 15) >> 2) + 4 * ((R1 >> 4) & 1) + (R1 & 3);
    const unsigned voffB0 = (unsigned)Rb0 * ldb + (unsigned)C0 * 2u, voffB1 = (unsigned)Rb1 * ldb + (unsigned)C1 * 2u;
    const size_t hstepB = (size_t)(BMODE == 0 ? HALF : 8) * ldb;
    const size_t kstep = (size_t)(BK * 2);
    const unsigned ldsw = (unsigned)wid * 1024u;
    const int aoff = lds_byte(wr * 64 + fr, F8 ? fq * 16 : fq * 8), boff = lds_byte(wc * 32 + fr, F8 ? fq * 16 : fq * 8);
    const int aoff2 = F8 ? lds_byte(wr * 64 + fr, fq * 16 + 8) : aoff + 1024, boff2 = F8 ? lds_byte(wc * 32 + fr, fq * 16 + 8) : boff + 1024;
#define PG8_SA(b, h) (((b) * 2 + (h)) * HTB)
#define PG8_SB(b, h) ((4 + (b) * 2 + (h)) * HTB)
#define PG8_STAGE(bufoff, gbase, v0, v1) do { unsigned _v0 = (v0), _v1 = (v1); asm volatile("" : "+v"(_v0), "+v"(_v1)); \
        __builtin_amdgcn_global_load_lds((const unsigned*)((const char*)(gbase) + _v0), (LAS unsigned*)(lds + (bufoff) + ldsw), 16, 0, 0); \
        __builtin_amdgcn_global_load_lds((const unsigned*)((const char*)(gbase) + _v1), (LAS unsigned*)(lds + (bufoff) + ldsw + 8192), 16, 0, 0); } while (0)
#define PG8_LDA(dst, b, h) do { _Pragma("unroll") for (int m = 0; m < 4; ++m) { dst[m][0] = *(const LAS bf16x8*)(lds + PG8_SA(b, h) + aoff + m * 2048); dst[m][1] = *(const LAS bf16x8*)(lds + PG8_SA(b, h) + aoff2 + m * 2048); } } while (0)
#define PG8_LDB(dst, b, h) do { _Pragma("unroll") for (int n = 0; n < 2; ++n) { dst[n][0] = *(const LAS bf16x8*)(lds + PG8_SB(b, h) + boff + n * 2048); dst[n][1] = *(const LAS bf16x8*)(lds + PG8_SB(b, h) + boff2 + n * 2048); } } while (0)
#define PG8_MMA(ai, bj, At, Bt) do { __builtin_amdgcn_s_setprio(1); _Pragma("unroll") for (int m = 0; m < 4; ++m) _Pragma("unroll") for (int n = 0; n < 2; ++n) { \
        if constexpr (F8) acc[ai][bj][m][n] = __builtin_amdgcn_mfma_scale_f32_16x16x128_f8f6f4(cat8(Bt[n][0], Bt[n][1]), cat8(At[m][0], At[m][1]), acc[ai][bj][m][n], 0, 0, 0, 0x7F7F7F7F, 0, 0x7F7F7F7F); \
        else { _Pragma("unroll") for (int k = 0; k < 2; ++k) acc[ai][bj][m][n] = __builtin_amdgcn_mfma_f32_16x16x32_bf16(Bt[n][k], At[m][k], acc[ai][bj][m][n], 0, 0, 0); } } __builtin_amdgcn_s_setprio(0); } while (0)
#define PG8_WAIT_V(n) asm volatile("s_waitcnt vmcnt(" #n ")" ::: "memory")
#define PG8_WAIT_L(n) asm volatile("s_waitcnt lgkmcnt(" #n ")" ::: "memory")
#define PG8_BAR __builtin_amdgcn_s_barrier()
#define PG8_SCHED __builtin_amdgcn_sched_barrier(0)
#define PG8_SETV(v00, v01, v10, v11, u) do { \
        if (GATHER) { int _t = tid; asm volatile("" : "+v"(_t)); int r0, c0, r1, c1; stage_rc(_t * 16, r0, c0); stage_rc(_t * 16 + 8192, r1, c1);     \
            const unsigned ta = r0 < (u).nvalid ? (u).gat[r0] : 0u, tb = r1 < (u).nvalid ? (u).gat[r1] : 0u, \
                                     tc = (HALF + r0) < (u).nvalid ? (u).gat[HALF + r0] : 0u, td = (HALF + r1) < (u).nvalid ? (u).gat[HALF + r1] : 0u; \
            v00 = ta * lda + (unsigned)c0 * 2u; v01 = tb * lda + (unsigned)c1 * 2u; v10 = tc * lda + (unsigned)c0 * 2u; v11 = td * lda + (unsigned)c1 * 2u; } \
        else { v00 = (unsigned)R0 * lda + (unsigned)C0 * 2u; v01 = (unsigned)R1 * lda + (unsigned)C1 * 2u; v10 = (unsigned)(HALF + R0) * lda + (unsigned)C0 * 2u; v11 = (unsigned)(HALF + R1) * lda + (unsigned)C1 * 2u; } } while (0)
    Unit cur, nxt; int ui = 0;
    if (!S.next(0, cur)) return;
    f32x4 acc[2][2][4][2];
#pragma unroll
    for (int a = 0; a < 2; ++a)
#pragma unroll
        for (int b = 0; b < 2; ++b)
#pragma unroll
            for (int m = 0; m < 4; ++m)
#pragma unroll
                for (int n = 0; n < 2; ++n) acc[a][b][m][n] = (f32x4){0.f, 0.f, 0.f, 0.f};
    bf16x8 At[4][2], B0[2][2], B1[2][2];
    const char* cA = cur.A; const char* cB = cur.B;
    unsigned cv00, cv01, cv10, cv11;
    PG8_SETV(cv00, cv01, cv10, cv11, cur);
    if constexpr (SP2) {
        PG8_STAGE(PG8_SB(0, 0), cB, voffB0, voffB1); PG8_STAGE(PG8_SB(0, 1), cB + hstepB, voffB0, voffB1); PG8_STAGE(PG8_SA(0, 0), cA, cv00, cv01); PG8_STAGE(PG8_SA(0, 1), cA, cv10, cv11);
        if (wr == 1) PG8_BAR;
        PG8_WAIT_V(2); PG8_BAR;
        PG8_STAGE(PG8_SB(1, 0), cB + kstep, voffB0, voffB1); PG8_STAGE(PG8_SA(1, 0), cA + kstep, cv00, cv01); PG8_STAGE(PG8_SB(1, 1), cB + hstepB + kstep, voffB0, voffB1);
        PG8_WAIT_V(6); PG8_BAR;
    } else {
        PG8_STAGE(PG8_SB(0, 0), cB, voffB0, voffB1); PG8_STAGE(PG8_SA(0, 0), cA, cv00, cv01); PG8_STAGE(PG8_SB(0, 1), cB + hstepB, voffB0, voffB1); PG8_STAGE(PG8_SA(0, 1), cA, cv10, cv11);
        if (wr == 1) PG8_BAR;
        PG8_WAIT_V(4); PG8_BAR;
        PG8_STAGE(PG8_SB(1, 0), cB + kstep, voffB0, voffB1); PG8_STAGE(PG8_SA(1, 0), cA + kstep, cv00, cv01); PG8_STAGE(PG8_SB(1, 1), cB + hstepB + kstep, voffB0, voffB1);
        PG8_WAIT_V(6); PG8_BAR;
    }
    for (;;) {
        const bool has_next = S.next(ui + 1, nxt);
        const char* nA = has_next ? nxt.A : cA; const char* nB = has_next ? nxt.B : cB;
#pragma unroll 1
        for (int t = 0; t < nt; t += 2) {
            const bool last = (t == nt - 2);
            const char* a1 = cA + (size_t)(t + 1) * kstep;
            const char* a2 = last ? nA : cA + (size_t)(t + 2) * kstep; const char* b2 = last ? nB : cB + (size_t)(t + 2) * kstep;
            const char* a3 = a2 + kstep; const char* b3 = b2 + kstep;
            if constexpr (SP2) {
            PG8_LDB(B0, 0, 0); PG8_LDB(B1, 0, 1); PG8_SCHED; PG8_LDA(At, 0, 0); PG8_STAGE(PG8_SA(1, 1), a1, cv10, cv11);
            PG8_WAIT_V(8); PG8_WAIT_L(0); PG8_BAR; PG8_MMA(0, 0, At, B0); PG8_MMA(0, 1, At, B1); PG8_BAR; PG8_SCHED;
            if constexpr (GATHER) { if (last && has_next) { PG8_SETV(cv00, cv01, cv10, cv11, nxt); } }
            PG8_LDA(At, 0, 1); PG8_STAGE(PG8_SB(0, 0), b2, voffB0, voffB1); PG8_STAGE(PG8_SB(0, 1), b2 + hstepB, voffB0, voffB1); PG8_STAGE(PG8_SA(0, 0), a2, cv00, cv01);
            PG8_WAIT_V(8); PG8_WAIT_L(0); PG8_BAR; PG8_MMA(1, 0, At, B0); PG8_MMA(1, 1, At, B1); PG8_BAR; PG8_SCHED;
            PG8_LDB(B0, 1, 0); PG8_LDB(B1, 1, 1); PG8_SCHED; PG8_LDA(At, 1, 0); PG8_STAGE(PG8_SA(0, 1), a2, cv10, cv11);
            PG8_WAIT_V(8); PG8_WAIT_L(0); PG8_BAR; PG8_MMA(0, 0, At, B0); PG8_MMA(0, 1, At, B1); PG8_BAR; PG8_SCHED;
            PG8_LDA(At, 1, 1); PG8_STAGE(PG8_SB(1, 0), b3, voffB0, voffB1); PG8_STAGE(PG8_SB(1, 1), b3 + hstepB, voffB0, voffB1); PG8_STAGE(PG8_SA(1, 0), a3, cv00, cv01);
            PG8_WAIT_V(8); PG8_WAIT_L(0); PG8_BAR; PG8_MMA(1, 0, At, B0); PG8_MMA(1, 1, At, B1); PG8_BAR; PG8_SCHED;
            } else {
            PG8_LDB(B0, 0, 0); PG8_SCHED; PG8_LDA(At, 0, 0); PG8_STAGE(PG8_SA(1, 1), a1, cv10, cv11);
            PG8_WAIT_L(8); PG8_BAR; PG8_WAIT_L(0); PG8_MMA(0, 0, At, B0); PG8_BAR; PG8_SCHED;
            if constexpr (GATHER) { if (last && has_next) { PG8_SETV(cv00, cv01, cv10, cv11, nxt); } }
            PG8_LDB(B1, 0, 1); PG8_STAGE(PG8_SB(0, 0), b2, voffB0, voffB1);
            PG8_BAR; PG8_WAIT_L(0); PG8_MMA(0, 1, At, B1); PG8_BAR;
            PG8_LDA(At, 0, 1); PG8_STAGE(PG8_SA(0, 0), a2, cv00, cv01);
            PG8_BAR; PG8_WAIT_L(0); PG8_MMA(1, 0, At, B0); PG8_BAR; PG8_SCHED;
            PG8_STAGE(PG8_SB(0, 1), b2 + hstepB, voffB0, voffB1);
            PG8_WAIT_V(6); PG8_BAR; PG8_MMA(1, 1, At, B1); PG8_BAR;
            PG8_LDB(B0, 1, 0); PG8_SCHED; PG8_LDA(At, 1, 0); PG8_STAGE(PG8_SA(0, 1), a2, cv10, cv11);
            PG8_WAIT_L(8); PG8_BAR; PG8_WAIT_L(0); PG8_MMA(0, 0, At, B0); PG8_BAR; PG8_SCHED;
            PG8_LDB(B1, 1, 1); PG8_STAGE(PG8_SB(1, 0), b3, voffB0, voffB1);
            PG8_BAR; PG8_WAIT_L(0); PG8_MMA(0, 1, At, B1); PG8_BAR;
            PG8_LDA(At, 1, 1); PG8_STAGE(PG8_SA(1, 0), a3, cv00, cv01);
            PG8_BAR; PG8_WAIT_L(0); PG8_MMA(1, 0, At, B0); PG8_BAR; PG8_SCHED;
            PG8_STAGE(PG8_SB(1, 1), b3 + hstepB, voffB0, voffB1);
            PG8_WAIT_V(6); PG8_BAR; PG8_MMA(1, 1, At, B1); PG8_BAR;
            }
        }
        if constexpr (ALIGN_EPI) { if (wr == 0) PG8_BAR; }
        { int t2 = tid; asm volatile("" : "+v"(t2));
          E(acc, cur, wr, wc, t2 & 15, (t2 & 63) >> 4); }
        if (!has_next) break;
#pragma unroll
        for (int a = 0; a < 2; ++a)
#pragma unroll
            for (int b = 0; b < 2; ++b)
#pragma unroll
                for (int m = 0; m < 4; ++m)
#pragma unroll
                    for (int n = 0; n < 2; ++n) acc[a][b][m][n] = (f32x4){0.f, 0.f, 0.f, 0.f};
        cur = nxt; cA = nA; cB = nB; ++ui;
        if constexpr (ALIGN_EPI) { if (wr == 1) PG8_BAR; }
    }
    PG8_WAIT_V(0);
    if constexpr (!ALIGN_EPI) { if (wr == 0) PG8_BAR; }
    PG8_BAR;
#undef PG8_SA
#undef PG8_SB
#undef PG8_STAGE
#undef PG8_LDA
#undef PG8_LDB
#undef PG8_MMA
#undef PG8_WAIT_V
#undef PG8_WAIT_L
#undef PG8_BAR
#undef PG8_SCHED
#undef PG8_SETV
}

struct DenseSched {
    const char* A; const char* B; unsigned lda, ldb, a_pn; int nM, nN, nwg, G, c; const unsigned* ident = nullptr;
    __device__ __forceinline__ bool next(int i, Unit& u) const {
        const long L = (long)i * G + c; if (L >= nwg) return false;
        int wgid = (int)L; { const int q = nwg / NXCD, r = nwg % NXCD, xcd = wgid % NXCD, off = wgid / NXCD; wgid = (xcd < r ? xcd * (q + 1) : r * (q + 1) + (xcd - r) * q) + off; }
        const int nig = WGM * nN, gid = wgid / nig, fm = gid * WGM, gsz = (nM - fm) < WGM ? (nM - fm) : WGM;
        const int pm = fm + ((wgid % nig) % gsz), pn = (wgid % nig) / gsz;
        u.A = ident ? A : A + (size_t)pm * BM * lda + (size_t)pn * a_pn; u.B = B + (size_t)pn * BM * ldb; u.gat = ident ? ident + pm * BM : nullptr; u.nvalid = BM; u.i0 = pm; u.i1 = pn; u.i2 = 0; return true;
    }
};
struct MoeInfo { const LAS unsigned* cnt; const LAS unsigned* tstart; const LAS unsigned* ystart; const LAS unsigned char* tile_e; int ntiles; };
struct G1Sched {
    MoeInfo mi; const char* XB; const char* Wgu; const unsigned* rowtok; const unsigned* ident; int G, vcu;
    __device__ __forceinline__ bool next(int i, Unit& u) const {
        const int L = i * G + vcu; if (L >= 2 * mi.ntiles) return false;
        const int tile = L >> 1, uu = L & 1; int e;
        if (tile < 64) { e = 64; u.gat = ident + tile * 256; u.nvalid = 256; }
        else { e = __builtin_amdgcn_readfirstlane((int)mi.tile_e[tile]); const int pos0 = (tile - __builtin_amdgcn_readfirstlane((int)mi.tstart[e])) * 256; u.gat = rowtok + (size_t)e * CAP + pos0; const int rem = __builtin_amdgcn_readfirstlane((int)mi.cnt[e]) - pos0; u.nvalid = rem < 256 ? rem : 256; }
        u.A = XB; u.B = Wgu + ((size_t)e * 512 + (size_t)uu * 256) * 1024; u.i0 = tile; u.i1 = uu; u.i2 = 0; return true;
    }
};
struct G2Sched {
    MoeInfo mi; const char* H; const char* Wd; int G, vcu, L0;
    __device__ __forceinline__ bool next(int i, Unit& u) const {
        const int L = i * G + vcu + L0; if (L >= 4 * mi.ntiles) return false;
        const int tile = L >> 2, pn = L & 3; int e;
        if (tile < 64) { e = 64; u.i0 = 131072 + tile * 256; u.i2 = 0; u.nvalid = 256; }
        else { e = __builtin_amdgcn_readfirstlane((int)mi.tile_e[tile]); const int pos0 = (tile - __builtin_amdgcn_readfirstlane((int)mi.tstart[e])) * 256; u.i0 = __builtin_amdgcn_readfirstlane((int)mi.ystart[e]) + pos0; u.i2 = 0; const int rem = __builtin_amdgcn_readfirstlane((int)mi.cnt[e]) - pos0; u.nvalid = rem < 256 ? rem : 256; }
        u.A = H + (size_t)tile * 256 * 256; u.B = Wd + ((size_t)e * 1024 + (size_t)pn * 256) * 256; u.gat = nullptr; u.i1 = pn; return true;
    }
};

template <int ACT, bool BIAS, bool SCALE, bool W32 = false> struct EpiBf16 {
    bf16* O; int ldo; const float* bias; const float* scale;
    __device__ __forceinline__ void operator()(const f32x4 (&acc)[2][2][4][2], const Unit& u, int wr, int wc, int fr, int fq) const {
        const int row0 = u.i0 * BM + wr * 64 + fr, col0 = u.i1 * BM + wc * 32 + 8 * fq;
        f32x4 bv[2][2], sv[2][2];
#pragma unroll
        for (int bj = 0; bj < 2; ++bj)
#pragma unroll
            for (int n = 0; n < 2; ++n) { bv[bj][n] = BIAS ? *(const f32x4*)(bias + col0 + bj * HALF + 4 * n) : (f32x4){0.f, 0.f, 0.f, 0.f}; sv[bj][n] = SCALE ? *(const f32x4*)(scale + col0 + bj * HALF + 4 * n) : (f32x4){1.f, 1.f, 1.f, 1.f}; }
#pragma unroll
        for (int ai = 0; ai < 2; ++ai)
#pragma unroll
            for (int m = 0; m < 4; ++m) { bf16* rowp = O + (size_t)(row0 + ai * HALF + m * 16) * ldo + col0;
#pragma unroll
                for (int bj = 0; bj < 2; ++bj) { f32x4 v0 = acc[ai][bj][m][0] * (W32 ? 0.03125f : 1.0f) + bv[bj][0], v1 = acc[ai][bj][m][1] * (W32 ? 0.03125f : 1.0f) + bv[bj][1];
                    if (ACT == 1) {
#pragma unroll
                        for (int j = 0; j < 4; ++j) { v0[j] = gelu_tanh(v0[j]); v1[j] = gelu_tanh(v1[j]); } }
                    if (SCALE) { v0 = v0 * sv[bj][0]; v1 = v1 * sv[bj][1]; }
                    v4u w; w.x = cvt_pk_bf16(v0[0], v0[1]); w.y = cvt_pk_bf16(v0[2], v0[3]); w.z = cvt_pk_bf16(v1[0], v1[1]); w.w = cvt_pk_bf16(v1[2], v1[3]);
                    *(v4u*)(rowp + bj * HALF) = w; } }
    }
};
template <bool BASE_BF16> struct EpiResidB {
    const void* base; bf16* outb;
    __device__ __forceinline__ void operator()(const f32x4 (&acc)[2][2][4][2], const Unit& u, int wr, int wc, int fr, int fq) const {
        const int row0 = u.i0 * BM + wr * 64 + fr, col0 = u.i1 * BM + wc * 32 + 8 * fq;
#pragma unroll
        for (int ai = 0; ai < 2; ++ai)
#pragma unroll
            for (int m = 0; m < 4; ++m) { const size_t off = (size_t)(row0 + ai * HALF + m * 16) * DM + col0;
#pragma unroll
                for (int bj = 0; bj < 2; ++bj) { f32x4 b0, b1;
                    if constexpr (BASE_BF16) { const v4u w = *(const v4u*)((const bf16*)base + off + bj * HALF); b0 = (f32x4){bf_lo(w.x), bf_hi(w.x), bf_lo(w.y), bf_hi(w.y)}; b1 = (f32x4){bf_lo(w.z), bf_hi(w.z), bf_lo(w.w), bf_hi(w.w)}; }
                    else { b0 = *(const f32x4*)((const float*)base + off + bj * HALF); b1 = *(const f32x4*)((const float*)base + off + bj * HALF + 4); }
                    const f32x4 o0 = b0 * ALPHA + acc[ai][bj][m][0], o1 = b1 * ALPHA + acc[ai][bj][m][1];
                    v4u o; o.x = cvt_pk_bf16(o0[0], o0[1]); o.y = cvt_pk_bf16(o0[2], o0[3]); o.z = cvt_pk_bf16(o1[0], o1[1]); o.w = cvt_pk_bf16(o1[2], o1[3]);
                    *(v4u*)(outb + off + bj * HALF) = o; }
                asm volatile("" ::: "memory"); }
    }
};
struct EpiResid {
    const float* base; float* out;
    __device__ __forceinline__ void operator()(const f32x4 (&acc)[2][2][4][2], const Unit& u, int wr, int wc, int fr, int fq) const {
        const int row0 = u.i0 * BM + wr * 64 + fr, col0 = u.i1 * BM + wc * 32 + 8 * fq;
#pragma unroll
        for (int ai = 0; ai < 2; ++ai)
#pragma unroll
            for (int m = 0; m < 4; ++m) { const size_t off = (size_t)(row0 + ai * HALF + m * 16) * DM + col0;
#pragma unroll
                for (int bj = 0; bj < 2; ++bj) { const f32x4 b0 = *(const f32x4*)(base + off + bj * HALF), b1 = *(const f32x4*)(base + off + bj * HALF + 4);
                    *(f32x4*)(out + off + bj * HALF) = b0 * ALPHA + acc[ai][bj][m][0]; *(f32x4*)(out + off + bj * HALF + 4) = b1 * ALPHA + acc[ai][bj][m][1]; }
                asm volatile("" ::: "memory"); }
    }
};
struct EpiSwiglu {
    unsigned char* H8;
    __device__ __forceinline__ void operator()(const f32x4 (&acc)[2][2][4][2], const Unit& u, int wr, int wc, int fr, int fq) const {
        const int row0 = u.i0 * BM + wr * 64 + fr, col0 = u.i1 * HALF + wc * 32 + 8 * fq;
#pragma unroll
        for (int ai = 0; ai < 2; ++ai)
#pragma unroll
            for (int m = 0; m < 4; ++m) { unsigned char* rowp = H8 + (size_t)(row0 + ai * HALF + m * 16) * EDIM + col0; float h[8];
#pragma unroll
                for (int n = 0; n < 2; ++n)
#pragma unroll
                    for (int j = 0; j < 4; ++j) { const float g = acc[ai][0][m][n][j] * 0.03125f, up = acc[ai][1][m][n][j] * 0.25f; h[4 * n + j] = g * sigmoidf_(g) * up; }
                int t0 = 0, t1 = 0; t0 = __builtin_amdgcn_cvt_pk_fp8_f32(h[0], h[1], t0, false); t0 = __builtin_amdgcn_cvt_pk_fp8_f32(h[2], h[3], t0, true); t1 = __builtin_amdgcn_cvt_pk_fp8_f32(h[4], h[5], t1, false); t1 = __builtin_amdgcn_cvt_pk_fp8_f32(h[6], h[7], t1, true);
                *(v2u*)rowp = (v2u){(unsigned)t0, (unsigned)t1}; }
    }
};
struct EpiDown {
    unsigned char* Y8;
    __device__ __forceinline__ void operator()(const f32x4 (&acc)[2][2][4][2], const Unit& u, int wr, int wc, int fr, int fq) const {
        const int r0 = wr * 64 + fr, col0 = u.i1 * BM + wc * 64 + 16 * fq;
#pragma unroll
        for (int ai = 0; ai < 2; ++ai)
#pragma unroll
            for (int m = 0; m < 4; ++m) { const int r = r0 + ai * HALF + m * 16;
                if (r < u.nvalid) { v4u w;
#pragma unroll
                    for (int q = 0; q < 4; ++q) { const f32x4 v = acc[ai][q >> 1][m][q & 1] * 0.0625f;     int t = 0; t = __builtin_amdgcn_cvt_pk_fp8_f32(v[0], v[1], t, false); t = __builtin_amdgcn_cvt_pk_fp8_f32(v[2], v[3], t, true); w[q] = (unsigned)t; }
                    *(v4u*)(Y8 + (size_t)(u.i0 + r) * DM + col0) = w; } }
    }
};
}

struct Args { const float* in[24]; float* out; unsigned char* ws; int ph_lo, ph_hi; };
enum { I_X = 0, I_PWIN, I_PWGRP, I_PSCALE, I_PWOUT, I_SWIN, I_SBIN, I_SLNG, I_SLNB, I_SWS, I_SBS, I_SWOUT, I_LNMG, I_LNMB, I_WR, I_RB, I_WG, I_WU, I_WD, I_SHG, I_SHU, I_SHD, I_LNFG, I_LNFB };

__device__ __forceinline__ void tr_item(const float* W, int N, int k0, int n0, bf16* dst  , int dpitch, LAS float* scr, int lane) {
#pragma unroll 8
    for (int i = 0; i < 32; ++i) { const int kk = 2 * i + (lane >> 5); scr[kk * 33 + (lane & 31)] = W[(size_t)(k0 + kk) * N + n0 + (lane & 31)]; }
    LDS_WAIT(); asm volatile("" ::: "memory");
    const int c = lane & 7;
#pragma unroll
    for (int j = 0; j < 4; ++j) { const int n = (lane >> 3) + 8 * j; const LAS float* s = scr + (8 * c) * 33 + n;
        v4u o; o.x = cvt_pk_bf16(s[0 * 33], s[1 * 33]); o.y = cvt_pk_bf16(s[2 * 33], s[3 * 33]); o.z = cvt_pk_bf16(s[4 * 33], s[5 * 33]); o.w = cvt_pk_bf16(s[6 * 33], s[7 * 33]);
        *(v4u*)(dst + (size_t)n * dpitch + 8 * c) = o; }
    LDS_WAIT(); asm volatile("" ::: "memory");
}
__device__ __forceinline__ void tr_item_f8(const float* W, int N, int k0, int n0, unsigned char* dst, int dpitch, float scale, LAS float* scr, int lane) {
#pragma unroll 8
    for (int i = 0; i < 32; ++i) { const int kk = 2 * i + (lane >> 5); scr[kk * 33 + (lane & 31)] = W[(size_t)(k0 + kk) * N + n0 + (lane & 31)]; }
    LDS_WAIT(); asm volatile("" ::: "memory");
    const int c = lane & 7;
#pragma unroll
    for (int j = 0; j < 4; ++j) { const int n = (lane >> 3) + 8 * j; const LAS float* s = scr + (8 * c) * 33 + n;
        int t0 = 0, t1 = 0;
        t0 = __builtin_amdgcn_cvt_pk_fp8_f32(s[0 * 33] * scale, s[1 * 33] * scale, t0, false); t0 = __builtin_amdgcn_cvt_pk_fp8_f32(s[2 * 33] * scale, s[3 * 33] * scale, t0, true);
        t1 = __builtin_amdgcn_cvt_pk_fp8_f32(s[4 * 33] * scale, s[5 * 33] * scale, t1, false); t1 = __builtin_amdgcn_cvt_pk_fp8_f32(s[6 * 33] * scale, s[7 * 33] * scale, t1, true);
        *(v2u*)(dst + (size_t)n * dpitch + 8 * c) = (v2u){(unsigned)t0, (unsigned)t1}; }
    LDS_WAIT(); asm volatile("" ::: "memory");
}
__device__ __forceinline__ void tr_tall_f8(const float* W, int N, int k0, int n0, unsigned char* dst, int dpitch, float scale, LAS float* scr, int lane) {
    f32x4 q[16]; const int r8 = lane >> 3, c4 = 4 * (lane & 7);
#pragma unroll
    for (int i = 0; i < 16; ++i) q[i] = *(const f32x4*)(W + (size_t)(k0 + 8 * i + r8) * N + n0 + c4);
#pragma unroll
    for (int i = 0; i < 16; ++i) { const int kk = 8 * i + r8; *(LAS f32x4*)(scr + kk * 32 + ((c4 + 4 * (kk >> 4)) & 31)) = q[i]; }
    LDS_WAIT(); asm volatile("" ::: "memory");
    const int c = lane & 7;
#pragma unroll
    for (int j = 0; j < 4; ++j) { const int n = r8 + 8 * j; const int col = (n + 4 * c) & 31; v4u o;
#pragma unroll
        for (int z = 0; z < 4; ++z) { const LAS float* sp = scr + (16 * c + 4 * z) * 32 + col; int t = 0;
            t = __builtin_amdgcn_cvt_pk_fp8_f32(sp[0] * scale, sp[32] * scale, t, false); t = __builtin_amdgcn_cvt_pk_fp8_f32(sp[64] * scale, sp[96] * scale, t, true); o[z] = (unsigned)t; }
        *(v4u*)(dst + (size_t)n * dpitch + 16 * c) = o; }
    LDS_WAIT(); asm volatile("" ::: "memory");
}
template <bool SPLIT> __device__ __forceinline__ void tr_block_f8(const float* W, int N, int k0, int n0, unsigned char* dst, int dpitch, float scale, LAS float* tile, int wave, int lane) {
    f32x4 q[16];
#pragma unroll
    for (int i = 0; i < 16; ++i) q[i] = *(const f32x4*)(W + (size_t)(k0 + 16 * wave + i) * N + n0 + 4 * lane);
#pragma unroll
    for (int i = 0; i < 16; ++i) { const int kk = 16 * wave + i; *(LAS f32x4*)(tile + kk * 256 + ((4 * lane + 4 * (kk >> 4)) & 255)) = q[i]; }
    LDS_WAIT(); __syncthreads();
    const int c = lane & 7, r8 = lane >> 3;
#pragma unroll
    for (int j = 0; j < 4; ++j) { const int n = 32 * wave + r8 + 8 * j; const int col = (n + 4 * c) & 255; v4u o;
#pragma unroll
        for (int z = 0; z < 4; ++z) { const LAS float* sp = tile + (16 * c + 4 * z) * 256 + col; int t = 0;
            t = __builtin_amdgcn_cvt_pk_fp8_f32(sp[0] * scale, sp[256] * scale, t, false); t = __builtin_amdgcn_cvt_pk_fp8_f32(sp[512] * scale, sp[768] * scale, t, true); o[z] = (unsigned)t; }
        *(v4u*)(dst + (size_t)(SPLIT ? ((n >> 7) * 256 + (n & 127)) : n) * dpitch + 16 * c) = o; }
    LDS_WAIT(); __syncthreads();
}
__device__ __forceinline__ void tr_item_hilo(const float* W, int N, int k0, int n0, bf16* dh, bf16* dl, int dpitch, LAS float* scr, int lane) {
#pragma unroll 8
    for (int i = 0; i < 32; ++i) { const int kk = 2 * i + (lane >> 5); scr[kk * 33 + (lane & 31)] = W[(size_t)(k0 + kk) * N + n0 + (lane & 31)]; }
    LDS_WAIT(); asm volatile("" ::: "memory");
    const int c = lane & 7;
#pragma unroll
    for (int j = 0; j < 4; ++j) { const int n = (lane >> 3) + 8 * j; const LAS float* s = scr + (8 * c) * 33 + n; float w[8];
#pragma unroll
        for (int z = 0; z < 8; ++z) w[z] = s[z * 33];
        v4u o; o.x = cvt_pk_bf16(w[0], w[1]); o.y = cvt_pk_bf16(w[2], w[3]); o.z = cvt_pk_bf16(w[4], w[5]); o.w = cvt_pk_bf16(w[6], w[7]);
        v4u l; l.x = cvt_pk_bf16(w[0] - bf_lo(o.x), w[1] - bf_hi(o.x)); l.y = cvt_pk_bf16(w[2] - bf_lo(o.y), w[3] - bf_hi(o.y)); l.z = cvt_pk_bf16(w[4] - bf_lo(o.z), w[5] - bf_hi(o.z)); l.w = cvt_pk_bf16(w[6] - bf_lo(o.w), w[7] - bf_hi(o.w));
        *(v4u*)(dh + (size_t)n * dpitch + 8 * c) = o; *(v4u*)(dl + (size_t)n * dpitch + 8 * c) = l; }
    LDS_WAIT(); asm volatile("" ::: "memory");
}
constexpr int MOE_ITEMS = 65 * 192;
__device__ __forceinline__ void convert_moe_item(const Args& a, int layer, int it, LAS float* scr, int lane) {
    unsigned char* WGU = a.ws + WS_WGU + (size_t)layer * WS_MOE_LSTRIDE; unsigned char* WDN = a.ws + WS_WDN + (size_t)layer * WS_MOE_LSTRIDE;
    const int e = it / 192, r = it % 192;
    if (r < 128) { const int isup = r >> 6, rr = r & 63, kb = rr >> 3, nb = rr & 7, n0 = 32 * nb, k0 = 128 * kb;
        const float* src = (e < 64) ? a.in[isup ? I_WU : I_WG] + ((size_t)layer * 64 + e) * 262144 : a.in[isup ? I_SHU : I_SHG] + (size_t)layer * 262144;
        const int drow = e * 512 + (n0 >> 7) * 256 + isup * 128 + (n0 & 127);
        tr_tall_f8(src, 256, k0, n0, WGU + (size_t)drow * 1024 + k0, 1024, 32.0f, scr, lane);
    } else { const int rr = r - 128, kb = rr >> 5, nb = rr & 31, n0 = 32 * nb, k0 = 128 * kb;
        const float* src = (e < 64) ? a.in[I_WD] + ((size_t)layer * 64 + e) * 262144 : a.in[I_SHD] + (size_t)layer * 262144;
        tr_tall_f8(src, 1024, k0, n0, WDN + ((size_t)e * 1024 + n0) * 256 + k0, 256, 32.0f, scr, lane);
    }
}
constexpr int Q_SHARDS = 8, Q_PER_SHARD = MOE_ITEMS / Q_SHARDS;
static_assert(Q_PER_SHARD * Q_SHARDS == MOE_ITEMS, "queue shards");
template <int CHUNK> __device__ __forceinline__ bool convert_steal_n(const Args& a, int layer, LAS unsigned char* lds, int wave, int lane) {
    unsigned* q = (unsigned*)(a.ws + WS_CTL) + CW_QNEXT + 512 * layer;
    const int s0 = (int)(blockIdx.x & 7);
    for (int s = 0; s < Q_SHARDS; ++s) { const int sh = (s0 + s) & 7;
        unsigned it = 0; if (lane == 0) it = __hip_atomic_fetch_add(q + 64 * sh, (unsigned)CHUNK, RLX_AGENT);
        it = (unsigned)__builtin_amdgcn_readfirstlane((int)it);
        if (it < (unsigned)Q_PER_SHARD) {
            for (int c = 0; c < CHUNK; ++c) if (it + c < (unsigned)Q_PER_SHARD) convert_moe_item(a, layer, sh * Q_PER_SHARD + (int)it + c, (LAS float*)(lds + wave * 16384), lane);
            return true; } }
    return false;
}
__device__ __forceinline__ bool convert_steal(const Args& a, int layer, LAS unsigned char* lds, int wave, int lane) { return convert_steal_n<1>(a, layer, lds, wave, lane); }
constexpr int MOE_WG_ITEMS = 65 * 24;
__device__ __forceinline__ void convert_static(const Args& a, int layer, LAS unsigned char* lds, int vcu, int G) {
    const int lane = threadIdx.x & 63, wave = __builtin_amdgcn_readfirstlane(threadIdx.x >> 6);
    unsigned char* WGU = a.ws + WS_WGU + (size_t)layer * WS_MOE_LSTRIDE; unsigned char* WDN = a.ws + WS_WDN + (size_t)layer * WS_MOE_LSTRIDE;
    __syncthreads();
#pragma unroll 1
    for (int it = vcu; it < MOE_WG_ITEMS; it += G) { const int e = it / 24, r = it % 24;
        if (r < 16) { const int isup = r >> 3, k0 = 128 * (r & 7);
            const float* src = (e < 64) ? a.in[isup ? I_WU : I_WG] + ((size_t)layer * 64 + e) * 262144 : a.in[isup ? I_SHU : I_SHG] + (size_t)layer * 262144;
            tr_block_f8<true>(src, 256, k0, 0, WGU + ((size_t)e * 512 + isup * 128) * 1024 + k0, 1024, 32.0f, (LAS float*)lds, wave, lane);
        } else { const int rr = r - 16, k0 = 128 * (rr >> 2), n0 = 256 * (rr & 3);
            const float* src = (e < 64) ? a.in[I_WD] + ((size_t)layer * 64 + e) * 262144 : a.in[I_SHD] + (size_t)layer * 262144;
            tr_block_f8<false>(src, 1024, k0, n0, WDN + ((size_t)e * 1024 + n0) * 256 + k0, 256, 32.0f, (LAS float*)lds, wave, lane);
        } }
}
__device__ __forceinline__ void convert_drain(const Args& a, int layer, LAS unsigned char* lds) {
    const int lane = threadIdx.x & 63, wave = __builtin_amdgcn_readfirstlane(threadIdx.x >> 6);
    while (convert_steal_n<4>(a, layer, lds, wave, lane)) {}
    __syncthreads();
}
__device__ __forceinline__ void phase_p0(const Args& a, LAS unsigned char* lds, int vcu, int G) {
    const int tid = threadIdx.x, lane = tid & 63, wave = __builtin_amdgcn_readfirstlane(tid >> 6);
    const int gw = vcu * NWAVES + wave, NGW = G * NWAVES;
    LAS float* scr = (LAS float*)(lds + wave * 16384);
    constexpr int I_IN = 16 * 32, I_GRP = 4 * 4 * 8, I_OUT = 16 * 32, I_SIN = 16 * 128, I_SOUT = 32 * 32, NIT = I_IN + I_GRP + I_OUT + I_SIN + I_SOUT;
    for (int it = gw; it < NIT; it += NGW) {
        int r = it;
        if (r < I_IN) { const int kb = r >> 5, nb = r & 31; tr_item(a.in[I_PWIN], 1024, 64 * kb, 32 * nb, (bf16*)(a.ws + WS_WIN) + (size_t)(32 * nb) * 1024 + 64 * kb, 1024, scr, lane); continue; } r -= I_IN;
        if (r < I_GRP) { const int g = r >> 5, rr = r & 31, kb = rr >> 3, nb = rr & 7; tr_item(a.in[I_PWGRP] + (size_t)g * 65536, 256, 64 * kb, 32 * nb, (bf16*)(a.ws + WS_WGRP) + (size_t)(g * 256 + 32 * nb) * 256 + 64 * kb, 256, scr, lane); continue; } r -= I_GRP;
        if (r < I_OUT) { const int kb = r >> 5, nb = r & 31; tr_item(a.in[I_PWOUT], 1024, 64 * kb, 32 * nb, (bf16*)(a.ws + WS_WOUT) + (size_t)(32 * nb) * 1024 + 64 * kb, 1024, scr, lane); continue; } r -= I_OUT;
        if (r < I_SIN) { const int kb = r >> 7, nb = r & 127; tr_item_f8(a.in[I_SWIN], 4096, 64 * kb, 32 * nb, a.ws + WS_WSIN + (size_t)(32 * nb) * 1024 + 64 * kb, 1024, 32.0f, scr, lane); continue; } r -= I_SIN;
        { const int kb = r >> 5, nb = r & 31; tr_item(a.in[I_SWOUT], 1024, 64 * kb, 32 * nb, (bf16*)(a.ws + WS_WSOUT) + (size_t)(32 * nb) * 2048 + 64 * kb, 2048, scr, lane); }
    }
    for (int it = gw; it < 64; it += NGW) { const int layer = it >> 5, rr = it & 31, kb = rr >> 1, nb = rr & 1; bf16* base = (bf16*)(a.ws + WS_WRT) + (size_t)layer * 2 * 65536 + (size_t)(32 * nb) * 1024 + 64 * kb;
        tr_item_hilo(a.in[I_WR] + (size_t)layer * DM * NE, 64, 64 * kb, 32 * nb, base, base + 65536, 1024, scr, lane); }
    convert_static(a, 0, lds, vcu, G);
    const float* x = a.in[I_X]; bf16* xb = (bf16*)(a.ws + WS_XB);
    const size_t gt = (size_t)vcu * NTHR + tid, NT = (size_t)G * NTHR;
#pragma unroll 1
    for (size_t i0 = gt; i0 < (size_t)T_TOK * DM / 8; i0 += 8 * NT) { f32x4 p[8], q[8];
#pragma unroll
        for (int u = 0; u < 8; ++u) { const size_t i = i0 + (size_t)u * NT; p[u] = *(const f32x4*)(x + i * 8); q[u] = *(const f32x4*)(x + i * 8 + 4); }
#pragma unroll
        for (int u = 0; u < 8; ++u) { const size_t i = i0 + (size_t)u * NT; v4u w; w.x = cvt_pk_bf16(p[u][0], p[u][1]); w.y = cvt_pk_bf16(p[u][2], p[u][3]); w.z = cvt_pk_bf16(q[u][0], q[u][1]); w.w = cvt_pk_bf16(q[u][2], q[u][3]); *(v4u*)(xb + i * 8) = w; } }
    unsigned* ident = (unsigned*)(a.ws + WS_IDENT);
    for (size_t i = gt; i < (size_t)T_TOK; i += NT) ident[i] = (unsigned)i;
}

template <int W> __device__ __forceinline__ void pool_item(const bf16* zp  , bf16* op  , int p0  ) {
    v4u q[W + 3];
#pragma unroll
    for (int i = 0; i < W + 3; ++i) { const int ii = i < p0 + 3 ? i : p0 + 3; q[i] = *(const v4u*)(zp - (size_t)ii * DM); }
#pragma unroll
    for (int o = 0; o < 4; ++o) {
        float s[8];
#pragma unroll
        for (int j = 0; j < 8; ++j) s[j] = 0.f;
#pragma unroll
        for (int i = 3 - o; i < 3 - o + W; ++i) { const float m = (i <= p0 + 3) ? 1.0f : 0.0f;
#pragma unroll
            for (int j = 0; j < 4; ++j) { s[2 * j] += m * bf_lo(q[i][j]); s[2 * j + 1] += m * bf_hi(q[i][j]); } }
        const int p = p0 + o, nw = (p + 1) < W ? (p + 1) : W; const float inv = 1.0f / (float)nw; v4u ov;
#pragma unroll
        for (int j = 0; j < 4; ++j) ov[j] = cvt_pk_bf16(s[2 * j] * inv - bf_lo(q[3 - o][j]), s[2 * j + 1] * inv - bf_hi(q[3 - o][j]));
        *(v4u*)(op + (size_t)o * DM) = ov; }
}
__device__ __forceinline__ void pool_block(const Args& a, int pm, int g) {
    const bf16* Z = (const bf16*)(a.ws + WS_Z); bf16* P = (bf16*)(a.ws + WS_POOLED);
    const int tid = threadIdx.x;
#pragma unroll 1
    for (int q = tid; q < 64 * 32; q += NTHR) { const int c8 = q & 31, tg = q >> 5, t0 = pm * 256 + tg * 4, p0 = t0 & (SEQ - 1);
        const bf16* zp = Z + (size_t)(t0 + 3) * DM + g * 256 + c8 * 8; bf16* op = P + (size_t)t0 * DM + g * 256 + c8 * 8;
        if (g == 0) pool_item<2>(zp, op, p0); else if (g == 1) pool_item<4>(zp, op, p0); else if (g == 2) pool_item<8>(zp, op, p0); else pool_item<16>(zp, op, p0); }
    VM_WAIT(); __syncthreads();
}
__device__ __forceinline__ void phase_pool(const Args& a, int vcu, int G) {
    const bf16* Z = (const bf16*)(a.ws + WS_Z); bf16* P = (bf16*)(a.ws + WS_POOLED);
    const int tid = threadIdx.x, wave = tid >> 6, lane = tid & 63;
    const int gw = vcu * NWAVES + wave, NGW = G * NWAVES;
    for (int it = gw; it < (T_TOK / 4) * 2; it += NGW) {
        const int t0 = (it >> 1) * 4, c8 = (it & 1) * 64 + lane, g = c8 >> 5, p0 = t0 & (SEQ - 1);
        const bf16* zp = Z + (size_t)(t0 + 3) * DM + c8 * 8; bf16* op = P + (size_t)t0 * DM + c8 * 8;
        if (g == 0) pool_item<2>(zp, op, p0); else if (g == 1) pool_item<4>(zp, op, p0); else if (g == 2) pool_item<8>(zp, op, p0); else pool_item<16>(zp, op, p0);
    }
}

template <int R, int MODE> __device__ __forceinline__ void ln_rows_store(float (&v)[R][16], const float* g, const float* b, float* const (&of)[R], bf16* const (&obf)[R], unsigned char* const (&o8)[R], int lane) {
    float s[R], s2[R];
#pragma unroll
    for (int r = 0; r < R; ++r) { s[r] = 0.f;
#pragma unroll
        for (int i = 0; i < 16; ++i) s[r] += v[r][i]; }
#pragma unroll
    for (int o = 1; o < 64; o <<= 1)
#pragma unroll
        for (int r = 0; r < R; ++r) s[r] += __shfl_xor(s[r], o);
#pragma unroll
    for (int r = 0; r < R; ++r) { const float mean = s[r] * (1.0f / DM); s2[r] = 0.f;
#pragma unroll
        for (int i = 0; i < 16; ++i) { v[r][i] -= mean; s2[r] += v[r][i] * v[r][i]; } }
#pragma unroll
    for (int o = 1; o < 64; o <<= 1)
#pragma unroll
        for (int r = 0; r < R; ++r) s2[r] += __shfl_xor(s2[r], o);
#pragma unroll
    for (int j = 0; j < 2; ++j) { const int c = 8 * lane + 512 * j;
        const f32x4 g0 = *(const f32x4*)(g + c), g1 = *(const f32x4*)(g + c + 4), b0 = *(const f32x4*)(b + c), b1 = *(const f32x4*)(b + c + 4);
#pragma unroll
        for (int r = 0; r < R; ++r) { const float rstd = 1.0f / sqrtf(s2[r] * (1.0f / DM) + LN_EPS); f32x4 y0, y1;
#pragma unroll
            for (int q = 0; q < 4; ++q) { y0[q] = v[r][8 * j + q] * rstd * g0[q] + b0[q]; y1[q] = v[r][8 * j + 4 + q] * rstd * g1[q] + b1[q]; }
            if constexpr (MODE & 1) { *(f32x4*)(of[r] + c) = y0; *(f32x4*)(of[r] + c + 4) = y1; }
            if constexpr (MODE & 2) { v4u w; w.x = cvt_pk_bf16(y0[0], y0[1]); w.y = cvt_pk_bf16(y0[2], y0[3]); w.z = cvt_pk_bf16(y1[0], y1[1]); w.w = cvt_pk_bf16(y1[2], y1[3]); *(v4u*)(obf[r] + c) = w; }
            if constexpr (MODE & 4) { int t0 = 0, t1 = 0; t0 = __builtin_amdgcn_cvt_pk_fp8_f32(y0[0], y0[1], t0, false); t0 = __builtin_amdgcn_cvt_pk_fp8_f32(y0[2], y0[3], t0, true); t1 = __builtin_amdgcn_cvt_pk_fp8_f32(y1[0], y1[1], t1, false); t1 = __builtin_amdgcn_cvt_pk_fp8_f32(y1[2], y1[3], t1, true);
                *(v2u*)(o8[r] + c) = (v2u){(unsigned)t0, (unsigned)t1}; } } }
}

__device__ __forceinline__ void phase_lnr(const Args& a, int layer, LAS unsigned char* lds, int vcu, int G, bool dry) {
    const int tid = threadIdx.x, lane = tid & 63, wave = __builtin_amdgcn_readfirstlane(tid >> 6);
    const bf16* xin = (const bf16*)(a.ws + WS_XR); float* xf = dry ? (float*)(a.ws + WS_Y) : a.out; bf16* xb = dry ? (bf16*)(a.ws + WS_Y + 72 * MiB) : (bf16*)(a.ws + WS_XB);
    const float* lng = a.in[I_LNMG] + layer * DM; const float* lnb = a.in[I_LNMB] + layer * DM;
    const float* Wr = a.in[I_WR] + (size_t)layer * DM * NE; const float* rbias = a.in[I_RB] + layer * NE;
    unsigned* gcount = (unsigned*)(a.ws + WS_CTL) + CW_CNT + layer * 64 + (dry ? 128 : 0);
    unsigned* rowtok = dry ? (unsigned*)(a.ws + WS_Y + 64 * MiB) : (unsigned*)(a.ws + WS_ROWTOK); unsigned* dest = dry ? (unsigned*)(a.ws + WS_Y + 68 * MiB) : (unsigned*)(a.ws + WS_DEST); float* gatev = dry ? (float*)(a.ws + WS_Y + 69 * MiB) : (float*)(a.ws + WS_GATE);
    LAS float* part = (LAS float*)lds;
    LAS unsigned* hist = (LAS unsigned*)(lds + 65536);
    LAS unsigned* basep = (LAS unsigned*)(lds + 65536 + 256);
    { const int blk = vcu;
        const int row0 = blk * 64;
        if (tid < 64) hist[tid] = 0u;
        { float v[8][16]; float* of[8]; bf16* obf[8]; unsigned char* o8[8];
#pragma unroll
            for (int r = 0; r < 8; ++r) { const int rr = wave * 8 + r; const bf16* xr = xin + (size_t)(row0 + rr) * DM; of[r] = xf + (size_t)(row0 + rr) * DM; obf[r] = nullptr; o8[r] = (unsigned char*)xb + (size_t)(row0 + rr) * DM;
#pragma unroll
                for (int j = 0; j < 2; ++j) { const v4u p = *(const v4u*)(xr + 8 * lane + 512 * j);
#pragma unroll
                    for (int i = 0; i < 4; ++i) { v[r][8 * j + 2 * i] = bf_lo(p[i]); v[r][8 * j + 2 * i + 1] = bf_hi(p[i]); } } }
            ln_rows_store<8, 5>(v, lng, lnb, of, obf, o8, lane); }
        VM_WAIT(); __syncthreads();
#ifndef DRY_PARTS
#define DRY_PARTS 7
#endif
        if (!dry || (DRY_PARTS & 2)) { const int kq = wave & 3, mh = wave >> 2, r = lane & 15, g = lane >> 4;
          f32x4 acc[2][4];
#pragma unroll
          for (int m = 0; m < 2; ++m)
#pragma unroll
              for (int n = 0; n < 4; ++n) acc[m][n] = (f32x4){0.f, 0.f, 0.f, 0.f};
          const float* arow = xf + (size_t)(row0 + 32 * mh + r) * DM + kq * 256 + 8 * g;
          const bf16* bh = (const bf16*)(a.ws + WS_WRT) + (size_t)layer * 2 * 65536 + (size_t)r * 1024 + kq * 256 + 8 * g; const bf16* bl = bh + 65536;
          f32x4 a0[2], a1[2]; bf16x8 wh[4], wl[4];
#pragma unroll
          for (int m = 0; m < 2; ++m) { a0[m] = *(const f32x4*)(arow + (size_t)m * 16 * DM); a1[m] = *(const f32x4*)(arow + (size_t)m * 16 * DM + 4); }
#pragma unroll
          for (int n = 0; n < 4; ++n) { wh[n] = *(const bf16x8*)(bh + (size_t)n * 16384); wl[n] = *(const bf16x8*)(bl + (size_t)n * 16384); }
#pragma unroll 1
          for (int s = 0; s < 8; ++s) { const int sn = s < 7 ? s + 1 : s;
              f32x4 n0[2], n1[2]; bf16x8 nh[4], nl[4];
#pragma unroll
              for (int m = 0; m < 2; ++m) { n0[m] = *(const f32x4*)(arow + (size_t)m * 16 * DM + 32 * sn); n1[m] = *(const f32x4*)(arow + (size_t)m * 16 * DM + 32 * sn + 4); }
#pragma unroll
              for (int n = 0; n < 4; ++n) { nh[n] = *(const bf16x8*)(bh + (size_t)n * 16384 + 32 * sn); nl[n] = *(const bf16x8*)(bl + (size_t)n * 16384 + 32 * sn); }
#pragma unroll
              for (int m = 0; m < 2; ++m) {
                  v4u hi, lo; hi.x = cvt_pk_bf16(a0[m][0], a0[m][1]); hi.y = cvt_pk_bf16(a0[m][2], a0[m][3]); hi.z = cvt_pk_bf16(a1[m][0], a1[m][1]); hi.w = cvt_pk_bf16(a1[m][2], a1[m][3]);
                  lo.x = cvt_pk_bf16(a0[m][0] - bf_lo(hi.x), a0[m][1] - bf_hi(hi.x)); lo.y = cvt_pk_bf16(a0[m][2] - bf_lo(hi.y), a0[m][3] - bf_hi(hi.y));
                  lo.z = cvt_pk_bf16(a1[m][0] - bf_lo(hi.z), a1[m][1] - bf_hi(hi.z)); lo.w = cvt_pk_bf16(a1[m][2] - bf_lo(hi.w), a1[m][3] - bf_hi(hi.w));
                  const bf16x8 ah = __builtin_bit_cast(bf16x8, hi), al = __builtin_bit_cast(bf16x8, lo);
#pragma unroll
                  for (int n = 0; n < 4; ++n) { acc[m][n] = __builtin_amdgcn_mfma_f32_16x16x32_bf16(ah, wh[n], acc[m][n], 0, 0, 0); acc[m][n] = __builtin_amdgcn_mfma_f32_16x16x32_bf16(al, wh[n], acc[m][n], 0, 0, 0); acc[m][n] = __builtin_amdgcn_mfma_f32_16x16x32_bf16(ah, wl[n], acc[m][n], 0, 0, 0); } }
#pragma unroll
              for (int m = 0; m < 2; ++m) { a0[m] = n0[m]; a1[m] = n1[m]; }
#pragma unroll
              for (int n = 0; n < 4; ++n) { wh[n] = nh[n]; wl[n] = nl[n]; } }
#pragma unroll
          for (int m = 0; m < 2; ++m)
#pragma unroll
              for (int n = 0; n < 4; ++n)
#pragma unroll
                  for (int q = 0; q < 4; ++q) part[(kq * 64 + 32 * mh + 16 * m + 4 * g + q) * 64 + 16 * n + r] = acc[m][n][q]; }
        __syncthreads();
        if (!dry || (DRY_PARTS & 4)) { const int row = tid >> 3, grp = tid & 7; float sc[8], bsd[8];
#pragma unroll
          for (int i = 0; i < 8; ++i) { const int e = 8 * grp + i; const float lg = (part[row * 64 + e] + part[(64 + row) * 64 + e]) + (part[(128 + row) * 64 + e] + part[(192 + row) * 64 + e]); sc[i] = 1.0f / (1.0f + __expf(-lg)); bsd[i] = sc[i] + rbias[e]; }
          float m1 = -INFINITY, m2 = -INFINITY;
#pragma unroll
          for (int i = 0; i < 8; ++i) { const float v = bsd[i]; if (v > m1) { m2 = m1; m1 = v; } else if (v > m2) m2 = v; }
          const float myg = m1 + m2;
          int grank = 0;
#pragma unroll
          for (int d = 1; d < 8; ++d) { const float o = __shfl(myg, (lane & ~7) | ((grp + d) & 7)); const int g2 = (grp + d) & 7; grank += (o > myg || (o == myg && g2 < grp)) ? 1 : 0; }
          const bool gsel = grank < 4;
          float cand[8]; int rk[8]; bool sel[8];
#pragma unroll
          for (int i = 0; i < 8; ++i) { cand[i] = gsel ? bsd[i] : -INFINITY; rk[i] = 0; sel[i] = false; }
#pragma unroll 1
          for (int k = 0; k < TOPK; ++k) {
              float best = cand[0]; int bi = 0;
#pragma unroll
              for (int i = 1; i < 8; ++i) if (cand[i] > best) { best = cand[i]; bi = i; }
              int gi = 8 * grp + bi;
#define LNR_RED(CTRL) { const float ov = __builtin_bit_cast(float, __builtin_amdgcn_update_dpp(0, __builtin_bit_cast(int, best), CTRL, 0xF, 0xF, false)); const int oi = __builtin_amdgcn_update_dpp(0, gi, CTRL, 0xF, 0xF, false); if (ov > best || (ov == best && oi < gi)) { best = ov; gi = oi; } }
              LNR_RED(0xB1) LNR_RED(0x4E) LNR_RED(0x141)
#undef LNR_RED
#pragma unroll
              for (int i = 0; i < 8; ++i) if (gi == 8 * grp + i) { cand[i] = -INFINITY; rk[i] = k; sel[i] = true; }
          }
          float psum = 0.f;
#pragma unroll
          for (int i = 0; i < 8; ++i) psum += sel[i] ? sc[i] : 0.f;
          psum += __shfl_xor(psum, 1); psum += __shfl_xor(psum, 2); psum += __shfl_xor(psum, 4);
          const float inv = ROUTED_SCALE / psum;
          unsigned loc[8];
#pragma unroll
          for (int i = 0; i < 8; ++i) { loc[i] = 0u; if (sel[i]) loc[i] = __hip_atomic_fetch_add(hist + 8 * grp + i, 1u, __ATOMIC_RELAXED, __HIP_MEMORY_SCOPE_WORKGROUP); }
          __syncthreads();
          if (tid < 64) { const unsigned h = hist[tid]; basep[tid] = h ? __hip_atomic_fetch_add(gcount + tid, h, RLX_AGENT) : 0u; }
          __syncthreads();
          const int tok = row0 + row;
#pragma unroll
          for (int i = 0; i < 8; ++i) if (sel[i]) { const int e = 8 * grp + i; const unsigned pos = basep[e] + loc[i];
              rowtok[(size_t)e * CAP + pos] = (unsigned)tok; dest[tok * 8 + rk[i]] = ((unsigned)e << 16) | pos; gatev[tok * 8 + rk[i]] = sc[i] * inv; }
        }
        __syncthreads();
    }
}

__device__ __forceinline__ pg8::MoeInfo moe_setup(const Args& a, int layer, LAS unsigned char* misc) {
    const int tid = threadIdx.x;
    unsigned* gcount = (unsigned*)(a.ws + WS_CTL) + CW_CNT + layer * 64;
    LAS unsigned* cnt = (LAS unsigned*)(misc + MI_CNT); LAS unsigned* tstart = (LAS unsigned*)(misc + MI_TSTART); LAS unsigned* ystart = (LAS unsigned*)(misc + MI_YSTART);
    LAS unsigned* ntl = (LAS unsigned*)(misc + MI_NTILES); LAS unsigned char* tile_e = (LAS unsigned char*)(misc + MI_TILE_E);
    __syncthreads();
    if (tid < 64) { unsigned c = __hip_atomic_load(gcount + tid, RLX_AGENT); if (c > (unsigned)CAP) c = CAP; cnt[tid] = c; }
    __syncthreads();
    if (tid < 64) { unsigned ts = 64u, ys = 0u; for (int e = 0; e < tid; ++e) { const unsigned c = cnt[e]; ts += (c + 255u) >> 8; ys += c; }
        tstart[tid] = ts; ystart[tid] = ys; const unsigned mynt = (cnt[tid] + 255u) >> 8;
        for (unsigned i = 0; i < mynt; ++i) if (ts + i < 640u) tile_e[ts + i] = (unsigned char)tid;
        if (tid == 63) ntl[0] = ts + mynt; }
    __syncthreads();
    pg8::MoeInfo mi; mi.cnt = cnt; mi.tstart = tstart; mi.ystart = ystart; mi.tile_e = tile_e; mi.ntiles = __builtin_amdgcn_readfirstlane((int)ntl[0]);
    if (mi.ntiles > 640) mi.ntiles = 640;
    return mi;
}

__device__ __forceinline__ void phase_combine(const Args& a, int layer, LAS unsigned char* misc, int vcu, int G, bool dry) {
    const int tid = threadIdx.x, lane = tid & 63, wave = __builtin_amdgcn_readfirstlane(tid >> 6);
    const pg8::MoeInfo mi = moe_setup(a, layer, misc);
    float* xf = a.out; bf16* xb = (bf16*)(a.ws + WS_XB); const unsigned char* Y8 = (const unsigned char*)(a.ws + WS_Y);
    const unsigned* dest = (const unsigned*)(a.ws + WS_DEST); const float* gatev = (const float*)(a.ws + WS_GATE);
    const float* lng = a.in[I_LNFG] + layer * DM; const float* lnb = a.in[I_LNFB] + layer * DM;
    const int gw = vcu * NWAVES + wave, NGW = G * NWAVES;
#pragma unroll 1
    for (int rowa = gw; rowa < T_TOK; rowa += 2 * NGW) {
        float v[2][16]; float* of[2]; bf16* obf[2]; unsigned char* o8[2]; unsigned d[2][TOPK]; float gk[2][TOPK];
#pragma unroll
        for (int r = 0; r < 2; ++r) { const int row = rowa + r * NGW;
#pragma unroll
            for (int k = 0; k < TOPK; ++k) { d[r][k] = dest[row * 8 + k]; gk[r][k] = gatev[row * 8 + k]; } }
#pragma unroll
        for (int r = 0; r < 2; ++r) { const int row = rowa + r * NGW; float* xr = xf + (size_t)row * DM; of[r] = dry ? (float*)(a.ws + WS_H) + (size_t)row * DM : xr; obf[r] = (bf16*)(a.ws + WS_XR) + (size_t)row * DM; o8[r] = (unsigned char*)xb + (size_t)row * DM;
#pragma unroll
            for (int j = 0; j < 2; ++j) { const f32x4 p = *(const f32x4*)(xr + 8 * lane + 512 * j), q = *(const f32x4*)(xr + 8 * lane + 512 * j + 4);
#pragma unroll
                for (int i = 0; i < 4; ++i) { v[r][8 * j + i] = p[i] * ALPHA; v[r][8 * j + 4 + i] = q[i] * ALPHA; } } }
#pragma unroll
        for (int r = 0; r < 2; ++r) { const unsigned char* yr = Y8 + (size_t)(131072 + rowa + r * NGW) * DM;
#pragma unroll
            for (int j = 0; j < 2; ++j) { const v2u w = *(const v2u*)(yr + 8 * lane + 512 * j);
#pragma unroll
                for (int q = 0; q < 2; ++q) { const f32x2 lo2 = __builtin_amdgcn_cvt_pk_f32_fp8((int)w[q], false), hi2 = __builtin_amdgcn_cvt_pk_f32_fp8((int)w[q], true);
                    v[r][8 * j + 4 * q] += 0.0625f * lo2.x; v[r][8 * j + 4 * q + 1] += 0.0625f * lo2.y; v[r][8 * j + 4 * q + 2] += 0.0625f * hi2.x; v[r][8 * j + 4 * q + 3] += 0.0625f * hi2.y; } } }
#pragma unroll
        for (int r = 0; r < 2; ++r)
#pragma unroll
            for (int k = 0; k < TOPK; ++k) { const unsigned dd = (unsigned)__builtin_amdgcn_readfirstlane((int)d[r][k]); const float g = __uint_as_float((unsigned)__builtin_amdgcn_readfirstlane((int)__float_as_uint(gk[r][k])));
                const unsigned e = (dd >> 16) & 63u, pos = dd & 0xffffu; const unsigned char* yr = Y8 + (size_t)(mi.ystart[e] + pos) * DM; const float g16 = g * 0.0625f;
#pragma unroll
                for (int j = 0; j < 2; ++j) { const v2u w = *(const v2u*)(yr + 8 * lane + 512 * j);
#pragma unroll
                    for (int q = 0; q < 2; ++q) { const f32x2 lo2 = __builtin_amdgcn_cvt_pk_f32_fp8((int)w[q], false), hi2 = __builtin_amdgcn_cvt_pk_f32_fp8((int)w[q], true);
                        v[r][8 * j + 4 * q] += g16 * lo2.x; v[r][8 * j + 4 * q + 1] += g16 * lo2.y; v[r][8 * j + 4 * q + 2] += g16 * hi2.x; v[r][8 * j + 4 * q + 3] += g16 * hi2.y; } } }
        if (layer == 0 && !dry) ln_rows_store<2, 6>(v, lng, lnb, of, obf, o8, lane);
        else ln_rows_store<2, 1>(v, lng, lnb, of, obf, o8, lane);
    }
}

__device__ __forceinline__ int swz16(int row) { return (row ^ (row >> 4)) & 15; }
__device__ __forceinline__ void phase_sgu_spatial(const Args& a, LAS unsigned char* lds, int vcu, int G) {
    const int tid = threadIdx.x, lane = tid & 63, wave = __builtin_amdgcn_readfirstlane(tid >> 6), fr = lane & 15, fq = lane >> 4;
    const bf16* HS = (const bf16*)(a.ws + WS_HS); bf16* GT = (bf16*)(a.ws + WS_GATED);
    const float* lng = a.in[I_SLNG]; const float* lnb = a.in[I_SLNB]; const float* WS = a.in[I_SWS]; const float* BS = a.in[I_SBS];
    LAS unsigned char* Bs = lds;
    LAS unsigned char* As = lds + 65536;
    LAS float* stm = (LAS float*)(lds + 98304);
    LAS float* str = (LAS float*)(lds + 98304 + 512);
    for (int item = vcu; item < 512; item += G) {
        const int chunk = item >> 2, h = item & 3, t0 = chunk * 128;
        __syncthreads();
#pragma unroll 1
        for (int r4 = 0; r4 < 4; ++r4) { v4u w[4][4];
#pragma unroll
            for (int rr = 0; rr < 4; ++rr) { const bf16* vr = HS + (size_t)(t0 + wave * 16 + r4 * 4 + rr) * 4096 + SGU_W;
#pragma unroll
                for (int q = 0; q < 4; ++q) w[rr][q] = *(const v4u*)(vr + 8 * lane + 512 * q); }
            float sm[4], sq[4];
#pragma unroll
            for (int rr = 0; rr < 4; ++rr) { float s1 = 0.f;
#pragma unroll
                for (int q = 0; q < 4; ++q)
#pragma unroll
                    for (int p = 0; p < 4; ++p) s1 += bf_lo(w[rr][q][p]) + bf_hi(w[rr][q][p]);
                sm[rr] = s1; }
#pragma unroll
            for (int o = 1; o < 64; o <<= 1)
#pragma unroll
                for (int rr = 0; rr < 4; ++rr) sm[rr] += __shfl_xor(sm[rr], o);
#pragma unroll
            for (int rr = 0; rr < 4; ++rr) { const float mean = sm[rr] * (1.0f / SGU_W); float s2 = 0.f;
#pragma unroll
                for (int q = 0; q < 4; ++q)
#pragma unroll
                    for (int p = 0; p < 4; ++p) { const float d0 = bf_lo(w[rr][q][p]) - mean, d1 = bf_hi(w[rr][q][p]) - mean; s2 += d0 * d0 + d1 * d1; }
                sm[rr] = mean; sq[rr] = s2; }
#pragma unroll
            for (int o = 1; o < 64; o <<= 1)
#pragma unroll
                for (int rr = 0; rr < 4; ++rr) sq[rr] += __shfl_xor(sq[rr], o);
            if (lane == 0) {
#pragma unroll
                for (int rr = 0; rr < 4; ++rr) { const int j = wave * 16 + r4 * 4 + rr; stm[j] = sm[rr]; str[j] = 1.0f / sqrtf(sq[rr] * (1.0f / SGU_W) + LN_EPS); } } }
        for (int q = tid; q < 128 * 16; q += NTHR) { const int i = q >> 4, jc = q & 15; const float* wp = WS + ((size_t)h * 128 + i) * 128 + 8 * jc;
            const f32x4 p0 = *(const f32x4*)wp, p1 = *(const f32x4*)(wp + 4); float w8[8];
#pragma unroll
            for (int z = 0; z < 4; ++z) { w8[z] = (8 * jc + z <= i) ? p0[z] : 0.f; w8[4 + z] = (8 * jc + 4 + z <= i) ? p1[z] : 0.f; }
            v4u o; o.x = cvt_pk_bf16(w8[0], w8[1]); o.y = cvt_pk_bf16(w8[2], w8[3]); o.z = cvt_pk_bf16(w8[4], w8[5]); o.w = cvt_pk_bf16(w8[6], w8[7]);
            *(LAS v4u*)(As + i * 256 + ((jc ^ swz16(i)) << 4)) = o; }
        __syncthreads();
        for (int hh = 0; hh < 2; ++hh) {
            const int cb = h * SGU_HD + hh * 256;
#pragma unroll 2
            for (int q = tid; q < 64 * 32; q += NTHR) { const int c8 = q & 31, jp = q >> 5, j0 = 2 * jp;
                const v4u w0 = *(const v4u*)(HS + (size_t)(t0 + j0) * 4096 + SGU_W + cb + 8 * c8), w1 = *(const v4u*)(HS + (size_t)(t0 + j0 + 1) * 4096 + SGU_W + cb + 8 * c8);
                const f32x4 g0 = *(const f32x4*)(lng + cb + 8 * c8), g1 = *(const f32x4*)(lng + cb + 8 * c8 + 4), b0 = *(const f32x4*)(lnb + cb + 8 * c8), b1 = *(const f32x4*)(lnb + cb + 8 * c8 + 4);
                const float m0 = stm[j0], r0 = str[j0], m1 = stm[j0 + 1], r1 = str[j0 + 1];
#pragma unroll
                for (int z = 0; z < 8; ++z) { const float gz = z < 4 ? g0[z & 3] : g1[z & 3], bz = z < 4 ? b0[z & 3] : b1[z & 3];
                    const float xa = (z & 1) ? bf_hi(w0[z >> 1]) : bf_lo(w0[z >> 1]), xc = (z & 1) ? bf_hi(w1[z >> 1]) : bf_lo(w1[z >> 1]);
                    const float ya = (xa - m0) * r0 * gz + bz, yc = (xc - m1) * r1 * gz + bz;
                    const int cc = 8 * c8 + z, slot = (cc & ~31) | (((cc >> 2) & 1) << 4) | (((cc >> 3) & 3) << 2) | (cc & 3);
                    *(LAS unsigned*)(Bs + slot * 256 + (((j0 >> 3) ^ swz16(slot)) << 4) + (j0 & 7) * 2) = cvt_pk_bf16(ya, yc); } }
            __syncthreads();
            f32x4 acc[8][2]; bf16x8 Bf[2][4];
#pragma unroll
            for (int n = 0; n < 2; ++n)
#pragma unroll
                for (int s = 0; s < 4; ++s) { const int slot = 32 * wave + 16 * n + fr; Bf[n][s] = *(const LAS bf16x8*)(Bs + slot * 256 + (((4 * s + fq) ^ swz16(slot)) << 4)); }
#pragma unroll
            for (int m = 0; m < 8; ++m) { acc[m][0] = (f32x4){0.f, 0.f, 0.f, 0.f}; acc[m][1] = (f32x4){0.f, 0.f, 0.f, 0.f};
#pragma unroll
                for (int s = 0; s < 4; ++s) if (s <= (m >> 1)) { const int i = 16 * m + fr; const bf16x8 af = *(const LAS bf16x8*)(As + i * 256 + (((4 * s + fq) ^ swz16(i)) << 4));
                    acc[m][0] = __builtin_amdgcn_mfma_f32_16x16x32_bf16(Bf[0][s], af, acc[m][0], 0, 0, 0); acc[m][1] = __builtin_amdgcn_mfma_f32_16x16x32_bf16(Bf[1][s], af, acc[m][1], 0, 0, 0); } }
#pragma unroll
            for (int m = 0; m < 8; ++m) { const int i = 16 * m + fr; const float bsv = BS[h * 128 + i]; const size_t t = (size_t)(t0 + i);
                const v4u uw = *(const v4u*)(HS + t * 4096 + cb + 32 * wave + 8 * fq); float o[8];
#pragma unroll
                for (int n = 0; n < 2; ++n)
#pragma unroll
                    for (int z = 0; z < 4; ++z) { const int c = 4 * n + z; const float uu = (c & 1) ? bf_hi(uw[c >> 1]) : bf_lo(uw[c >> 1]); o[c] = uu * (acc[m][n][z] + bsv); }
                v4u w; w.x = cvt_pk_bf16(o[0], o[1]); w.y = cvt_pk_bf16(o[2], o[3]); w.z = cvt_pk_bf16(o[4], o[5]); w.w = cvt_pk_bf16(o[6], o[7]);
                *(v4u*)(GT + t * SGU_W + cb + 32 * wave + 8 * fq) = w; }
            __syncthreads();
        }
    }
}

__device__ __forceinline__ void phase_flush(const Args& a, int vcu, int G) {
    const size_t gt = (size_t)vcu * NTHR + threadIdx.x, NT = (size_t)G * NTHR; f32x4 acc = (f32x4){0.f, 0.f, 0.f, 0.f};
    const f32x4* p0 = (const f32x4*)a.in[I_WG]; const f32x4* p1 = (const f32x4*)a.in[I_WU];
    for (size_t i = gt; i < (size_t)33554432 / 4; i += 4 * NT) { const f32x4 x0 = p0[i], x1 = p0[i + NT], x2 = p0[i + 2 * NT], x3 = p0[i + 3 * NT], y0 = p1[i], y1 = p1[i + NT], y2 = p1[i + 2 * NT], y3 = p1[i + 3 * NT]; acc += x0 + x1 + x2 + x3 + y0 + y1 + y2 + y3; }
    if (acc[0] + acc[1] + acc[2] + acc[3] == 1.2345e-30f) ((float*)(a.ws + WS_CTL))[16000] = acc[0];
}
constexpr int N_PHASES = 16;
__global__ void __launch_bounds__(NTHR, 2) mk_fwd(Args args) {
    extern __shared__ __attribute__((aligned(16))) unsigned char lds_raw[];
    LAS unsigned char* lds = (LAS unsigned char*)lds_raw;
    LAS unsigned char* misc = lds + MISC_OFF;
    const int tid = threadIdx.x;
    const int G = gridDim.x; const int bx = blockIdx.x; const int vcu = (G % 8 == 0) ? (bx % 8) * (G / 8) + bx / 8 : bx;
    unsigned char* ws = args.ws;
    unsigned* ctl = (unsigned*)(ws + WS_CTL);
    if (tid < 16) ((LAS unsigned*)(misc + MI_BARW))[tid] = 0u;
    __syncthreads();
    const int lo = args.ph_lo, hi = args.ph_hi;
    XcdBarrier bar; bar.bar = ctl + CW_BAR; bar.x = 0; bar.st = nullptr;
    if (hi - lo > 1) bar = xcd_barrier_post(ctl + CW_BAR, (volatile LAS unsigned*)(misc + MI_BARW));
#ifndef PH_MASK
#define PH_MASK 0xFFFF
#endif
#define IN(k) (((PH_MASK >> (k)) & 1) && lo <= (k) && (k) < hi)
#ifndef TS_A0
#define TS_A0 -1
#define TS_A1 -1
#define TS_M 1
#endif
    unsigned long long* tsbuf = (unsigned long long*)(ws + 32768);
#define TS_REC(k) do { if (TS_A0 >= 0 && bx == 0 && tid == 0) __hip_atomic_store(tsbuf + (k), (unsigned long long)__builtin_amdgcn_s_memrealtime(), RLX_AGENT); } while (0)
    TS_REC(0);
#ifndef REP_PH
#define REP_PH -1
#define REP_N 1
#endif
#define NREP(k) ((k) == REP_PH ? REP_N : 1)
#ifndef FLUSH_PH
#define FLUSH_PH -2
#endif
#define RUN(k) if (IN(k)) for (int rep = 0; rep < NREP(k); ++rep) if ((((k) == FLUSH_PH && rep == NREP(k) - 1) ? (xcd_barrier(bar), phase_flush(args, vcu, G), xcd_barrier(bar), true) : true))
#define DRY(k) (rep + 1 < NREP(k))
#define BG_LAYER(k) (-1)
#define SEAM(k) do { if (IN(k) && IN((k) + 1)) xcd_barrier(bar, &args, BG_LAYER(k), lds); TS_REC((k) + 1); } while (0)
    using namespace pg8;
    RUN(0) { phase_p0(args, lds, vcu, G); } SEAM(0);
    RUN(1) { DenseSched S{(const char*)(ws + WS_XB), (const char*)(ws + WS_WIN), 2048u, 2048u, 0u, 64, 4, 256, G, bx};
        EpiBf16<0, false, false> E{(bf16*)(ws + WS_Z), DM, nullptr, nullptr};
        gemm_phase<EpiBf16<0, false, false>, DenseSched, false, true, true>(lds, 2048u, 2048u, 16, S, E); } SEAM(1);
    if (REP_PH == 100 && hi - lo > 1) for (int i = 0; i < REP_N; ++i) xcd_barrier(bar);
    RUN(3) { DenseSched S{(const char*)(ws + WS_POOLED), (const char*)(ws + WS_WGRP), 2048u, 512u, 512u, 64, 4, 256, G, bx};
        { Unit u0; if (S.next(0, u0)) pool_block(args, u0.i0, u0.i1); }
        EpiBf16<0, false, true> E{(bf16*)(ws + WS_YP), DM, nullptr, args.in[I_PSCALE]};
        gemm_phase<EpiBf16<0, false, true>, DenseSched, false, true, true>(lds, 2048u, 512u, 4, S, E); } SEAM(3);
    RUN(4) { DenseSched S{(const char*)(ws + WS_YP), (const char*)(ws + WS_WOUT), 2048u, 2048u, 0u, 64, 4, 256, G, bx};
        EpiResidB<false> E{args.in[I_X], (bf16*)(ws + WS_XR)};
        gemm_phase<EpiResidB<false>, DenseSched, false, true, true>(lds, 2048u, 2048u, 16, S, E); } SEAM(4);
#define MOE_PHASES(layer, pb) do { \
        RUN(pb) { phase_lnr(args, layer, lds, vcu, G, DRY(pb)); } SEAM(pb); \
        RUN((pb) + 1) { const MoeInfo mi = moe_setup(args, layer, misc); \
            G1Sched S{mi, (const char*)(ws + WS_XB), (const char*)(ws + WS_WGU + (size_t)layer * WS_MOE_LSTRIDE), (const unsigned*)(ws + WS_ROWTOK), (const unsigned*)(ws + WS_IDENT), G, vcu}; \
            EpiSwiglu E{(unsigned char*)(ws + WS_H)}; \
            gemm_phase<EpiSwiglu, G1Sched, true, true, false, 0, 1>(lds, 1024u, 1024u, 8, S, E); } SEAM((pb) + 1); \
        if (IN((pb) + 2) && REP_PH == (pb) + 2) { const MoeInfo mi = moe_setup(args, layer, misc); \
            G2Sched S{mi, (const char*)(ws + WS_H), (const char*)(ws + WS_WDN + (size_t)layer * WS_MOE_LSTRIDE), G, vcu, 256}; \
            EpiDown E{(unsigned char*)(ws + WS_Y)}; \
            gemm_phase<EpiDown, G2Sched, false, true, true, 1, 1>(lds, 256u, 256u, 2, S, E); } \
        if (IN((pb) + 2)) { const MoeInfo mi = moe_setup(args, layer, misc); \
            G2Sched S{mi, (const char*)(ws + WS_H), (const char*)(ws + WS_WDN + (size_t)layer * WS_MOE_LSTRIDE), G, vcu, 0}; \
            EpiDown E{(unsigned char*)(ws + WS_Y)}; \
            gemm_phase<EpiDown, G2Sched, false, true, true, 1, 1>(lds, 256u, 256u, 2, S, E); } SEAM((pb) + 2); \
        RUN((pb) + 3) { phase_combine(args, layer, misc, vcu, G, DRY((pb) + 3)); if (layer == 0 && !DRY((pb) + 3)) { __syncthreads(); convert_static(args, 1, lds, vcu, G); } } \
    } while (0)
    MOE_PHASES(0, 5); SEAM(8);
    RUN(9) { DenseSched S{(const char*)(ws + WS_XB), (const char*)(ws + WS_WSIN), 1024u, 1024u, 0u, 64, 16, 1024, G, bx, (const unsigned*)(ws + WS_IDENT)};
        EpiBf16<1, true, false, true> E{(bf16*)(ws + WS_HS), 4096, args.in[I_SBIN], nullptr};
        gemm_phase<EpiBf16<1, true, false, true>, DenseSched, true, true, false, 0, 1>(lds, 1024u, 1024u, 8, S, E); } SEAM(9);
    RUN(10) { phase_sgu_spatial(args, lds, vcu, G); } SEAM(10);
    RUN(11) { DenseSched S{(const char*)(ws + WS_GATED), (const char*)(ws + WS_WSOUT), 4096u, 4096u, 0u, 64, 4, 256, G, bx};
        EpiResidB<true> E{ws + WS_XR, (bf16*)(ws + WS_XR)};
        gemm_phase<EpiResidB<true>, DenseSched, false, true, true>(lds, 4096u, 4096u, 32, S, E); } SEAM(11);
    MOE_PHASES(1, 12);
#undef MOE_PHASES
    if (TS_A0 >= 0 && bx == 0 && tid == 0) {
        const unsigned long long tend = __builtin_amdgcn_s_memrealtime();
        const unsigned long long t0 = __hip_atomic_load(tsbuf + TS_A0, RLX_AGENT), t1 = (TS_A1 + 1 >= N_PHASES) ? tend : __hip_atomic_load(tsbuf + TS_A1 + 1, RLX_AGENT);
        const unsigned long long wait = (t1 - t0) * TS_M;
        while (__builtin_amdgcn_s_memrealtime() - tend < wait) __builtin_amdgcn_s_sleep(8);
    }
#undef IN
#undef SEAM
}

extern "C" void kernel_launch(void* const* d_in, const int* in_sizes, int n_in, void* d_out, int out_size, void* d_ws, size_t ws_size, hipStream_t stream) {
    static int grid = 0;
    if (grid == 0) {
        if (n_in != 24 || out_size != T_TOK * DM || ws_size < WS_END) { fprintf(stderr, "kernel_launch: unexpected shapes (n_in %d out %d ws %zu)\n", n_in, out_size, ws_size); grid = -1; return; }
        int dev = 0, cus = 0;
        if (hipGetDevice(&dev) != hipSuccess || hipDeviceGetAttribute(&cus, hipDeviceAttributeMultiprocessorCount, dev) != hipSuccess) { grid = -1; return; }
        if (hipFuncSetAttribute((const void*)mk_fwd, hipFuncAttributeMaxDynamicSharedMemorySize, LDS_BYTES) != hipSuccess) { fprintf(stderr, "kernel_launch: hipFuncSetAttribute failed\n"); grid = -1; return; }
        int per_cu = 0;
        if (hipOccupancyMaxActiveBlocksPerMultiprocessor(&per_cu, (const void*)mk_fwd, NTHR, LDS_BYTES) != hipSuccess || per_cu < 1) fprintf(stderr, "kernel_launch: occupancy query says %d\n", per_cu);
        (void)hipGetLastError();
        grid = cus;
        if (grid != 256) { fprintf(stderr, "kernel_launch: built for a 256-CU device (got %d)\n", cus); grid = -1; return; }
    }
    if (grid < 0) return;
    (void)hipMemsetAsync((char*)d_ws + WS_CTL, 0, CTL_ZERO_BYTES, stream);
    Args a{};
    for (int i = 0; i < 24; ++i) a.in[i] = (const float*)d_in[i];
    a.out = (float*)d_out; a.ws = (unsigned char*)d_ws;
#if MK_PER_PHASE
    for (int p = 0; p < N_PHASES; ++p) { a.ph_lo = p; a.ph_hi = p + 1; hipLaunchKernelGGL(mk_fwd, dim3(grid), dim3(NTHR), LDS_BYTES, stream, a); }
#else
    a.ph_lo = 0; a.ph_hi = N_PHASES; hipLaunchKernelGGL(mk_fwd, dim3(grid), dim3(NTHR), LDS_BYTES, stream, a);
#endif
}
```

```cpp
#include <hip/hip_runtime.h>
#include <cstdio>
#include <cstdint>

#ifndef MK_PER_PHASE
#define MK_PER_PHASE 0
#endif

#define GAS __attribute__((address_space(1)))
#define LAS __attribute__((address_space(3)))
typedef unsigned short bf16;
typedef unsigned v4u __attribute__((ext_vector_type(4)));
typedef unsigned v2u __attribute__((ext_vector_type(2)));
typedef float f32x4 __attribute__((ext_vector_type(4)));
typedef float f32x2 __attribute__((ext_vector_type(2)));
typedef short bf16x8 __attribute__((ext_vector_type(8)));
#define RLX_AGENT __ATOMIC_RELAXED, __HIP_MEMORY_SCOPE_AGENT
#define LDS_WAIT() asm volatile("s_waitcnt lgkmcnt(0)" ::: "memory")
#define VM_WAIT() asm volatile("s_waitcnt vmcnt(0)" ::: "memory")

constexpr int T_TOK = 16384, DM = 1024, SEQ = 4096, NE = 64, TOPK = 8, EDIM = 256;
constexpr int SGU_W = 2048, SGU_HD = 512;
constexpr float ALPHA = 1.41421356237309515f;
constexpr float LN_EPS = 1e-5f, ROUTED_SCALE = 2.5f;
constexpr int CAP = 16384;
constexpr int NWAVES = 8, NTHR = 512;

constexpr size_t MiB = 1u << 20;
constexpr size_t WS_CTL = 0, CTL_ZERO_BYTES = 65536;
constexpr size_t WS_IDENT = 256 * 1024;
constexpr size_t WS_DEST = 1 * MiB;
constexpr size_t WS_GATE = WS_DEST + 512 * 1024;
constexpr size_t WS_ROWTOK = 2 * MiB;
constexpr size_t WS_VSTAT = WS_ROWTOK;
constexpr size_t WS_WIN = 6 * MiB;
constexpr size_t WS_WGRP = 8 * MiB;
constexpr size_t WS_WOUT = WS_WGRP + 512 * 1024;
constexpr size_t WS_WSIN = WS_WOUT + 2 * MiB;
constexpr size_t WS_WSOUT = WS_WSIN + 8 * MiB;
constexpr size_t WS_WRT = WS_WSOUT + 4 * MiB;
constexpr size_t WS_WGU = 23 * MiB;
constexpr size_t WS_WDN = WS_WGU + 65 * MiB;
constexpr size_t WS_XB = 121 * MiB;
constexpr size_t WS_H = 153 * MiB;
constexpr size_t WS_Y = 233 * MiB;
constexpr size_t WS_WGU1 = 378 * MiB, WS_WDN1 = WS_WGU1 + 65 * MiB;
constexpr size_t WS_MOE_LSTRIDE = WS_WGU1 - WS_WGU;
constexpr size_t WS_XR = 476 * MiB;
constexpr size_t WS_END = 508 * MiB;
constexpr size_t WS_Z = 153 * MiB, WS_POOLED = 185 * MiB, WS_YP = 217 * MiB;
constexpr size_t WS_HS = 153 * MiB;
constexpr size_t WS_GATED = 281 * MiB;
static_assert(WS_WRT + 512 * 1024 <= WS_WGU && WS_WDN + 33 * MiB <= WS_XB && WS_XB + 32 * MiB <= WS_H && WS_H + 80 * MiB <= WS_Y && WS_Y + 145 * MiB <= WS_WGU1 && WS_WDN1 + 33 * MiB <= WS_END && WS_GATED + 64 * MiB <= WS_WGU1, "ws map");
constexpr int CW_TMO = 0, CW_BAR = 64, CW_CNT = 4096, CW_QNEXT = 4608;

constexpr int RING_BYTES = 131072;
constexpr int MISC_OFF = RING_BYTES;
constexpr int LDS_BYTES = 147456;
constexpr int MI_BARW = 0, MI_CNT = 64, MI_TSTART = 320, MI_YSTART = 576, MI_NTILES = 832, MI_TILE_E = 1024;

__device__ __forceinline__ unsigned cvt_pk_bf16(float lo, float hi) { unsigned r; asm volatile("v_cvt_pk_bf16_f32 %0, %1, %2" : "=v"(r) : "v"(lo), "v"(hi)); return r; }
__device__ __forceinline__ float bf_lo(unsigned w) { return __uint_as_float(w << 16); }
__device__ __forceinline__ float bf_hi(unsigned w) { return __uint_as_float(w & 0xffff0000u); }
__device__ __forceinline__ float wave_sum(float v) {
#pragma unroll
    for (int o = 1; o < 64; o <<= 1) v += __shfl_xor(v, o);
    return v;
}
__device__ __forceinline__ float sigmoidf_(float x) { return __builtin_amdgcn_rcpf(1.0f + __builtin_amdgcn_exp2f(-1.4426950408889634f * x)); }
__device__ __forceinline__ float gelu_tanh(float v) { const float y = v + 0.044715f * v * v * v; return v * __builtin_amdgcn_rcpf(1.0f + __builtin_amdgcn_exp2f(-2.3022081983f * y)); }

#define XB_TMO      128
#define XB_XCNT(j)  (256  + 64 * (j))
#define XB_XSUB(j)  (1280 + 64 * (j))
#define XB_XGEN(j)  (2304 + 64 * (j))
#define XB_TOP      3328
#define XB_TOPGEN   3392
#define XCD_BAR_WORDS 3456
#define XB_SPIN_CAP (1u << 20)
__device__ __forceinline__ unsigned xb_ld(unsigned* p)              { return __hip_atomic_load(p, __ATOMIC_RELAXED, __HIP_MEMORY_SCOPE_AGENT); }
__device__ __forceinline__ unsigned xb_add(unsigned* p, unsigned v) { return __hip_atomic_fetch_add(p, v, __ATOMIC_RELAXED, __HIP_MEMORY_SCOPE_AGENT); }
__device__ __forceinline__ unsigned xb_xcc_id() { return (unsigned)__builtin_amdgcn_s_getreg((3 << 11) | 20) & 0xFu; }
#define XB_SPIN(cond, bar) do { unsigned _sp = 0; while (cond) { __builtin_amdgcn_s_sleep(1); \
    if ((++_sp & 255u) == 0u) { if (xb_ld(&(bar)[XB_TMO])) break; if (_sp > XB_SPIN_CAP) { atomicAdd(&(bar)[XB_TMO], 1u); break; } } } } while (0)
struct XcdBarrier { unsigned* bar; unsigned x; volatile LAS unsigned* st; };
__device__ __forceinline__ XcdBarrier xcd_barrier_post(unsigned* bar, volatile LAS unsigned* st) {
    XcdBarrier b; b.bar = bar; b.x = xb_xcc_id(); b.st = st;
    if (threadIdx.x == 0) (void)xb_add(&bar[XB_XCNT(b.x)], 1u);
    return b;
}
__device__ __forceinline__ void xcd_barrier_complete(unsigned* bar, unsigned x, unsigned& nloc, unsigned& nx) {
    const unsigned G = gridDim.x * gridDim.y * gridDim.z;
    unsigned sum, cnt, mine, sp = 0u;
    for (;;) {
        sum = 0u; cnt = 0u; mine = 0u;
#pragma unroll
        for (unsigned j = 0; j < 16; ++j) { const unsigned c = xb_ld(&bar[XB_XCNT(j)]); sum += c; cnt += (c > 0u) ? 1u : 0u; mine = (j == x) ? c : mine; }
        if (sum == G) break;
        __builtin_amdgcn_s_sleep(1);
        if ((++sp & 255u) == 0u) { if (xb_ld(&bar[XB_TMO])) break; if (sp > XB_SPIN_CAP) { atomicAdd(&bar[XB_TMO], 1u); break; } }
    }
    nloc = mine > 0u ? mine : 1u; nx = cnt > 0u ? cnt : 1u;
}
struct Args;
__device__ __forceinline__ bool convert_steal(const Args& a, int layer, LAS unsigned char* lds, int wave, int lane);
__device__ __forceinline__ void xcd_barrier(const XcdBarrier& b, const Args* bga = nullptr, int bg_layer = -1, LAS unsigned char* lds = nullptr) {
    asm volatile("s_waitcnt vmcnt(0)" ::: "memory");
    __syncthreads();
    if (threadIdx.x == 0) {
        unsigned* bar = b.bar;
        __builtin_amdgcn_s_waitcnt(0);
        unsigned nloc = b.st[0], nx = b.st[1];
        if (nloc == 0u) { xcd_barrier_complete(bar, b.x, nloc, nx); b.st[0] = nloc; b.st[1] = nx; }
        const unsigned old = xb_add(&bar[XB_XSUB(b.x)], 1u);
        const unsigned gen = old / nloc;
        if (old + 1u == (gen + 1u) * nloc) {
            __builtin_amdgcn_fence(__ATOMIC_RELEASE, "agent");
            asm volatile("s_waitcnt vmcnt(0)" ::: "memory");
            const unsigned og = xb_add(&bar[XB_TOP], 1u);
            const unsigned tg = og / nx;
            if (og + 1u == (tg + 1u) * nx) xb_add(&bar[XB_TOPGEN], 1u);
            else XB_SPIN(xb_ld(&bar[XB_TOPGEN]) == tg, bar);
            __builtin_amdgcn_fence(__ATOMIC_ACQUIRE, "agent");
            xb_add(&bar[XB_XGEN(b.x)], 1u);
            asm volatile("s_waitcnt vmcnt(0)" ::: "memory");
            b.st[2] = 0xFFFFFFFFu;
        } else if (bg_layer < 0) {
            XB_SPIN(xb_ld(&bar[XB_XGEN(b.x)]) == gen, bar);
            __builtin_amdgcn_fence(__ATOMIC_ACQUIRE, "agent");
            asm volatile("s_waitcnt vmcnt(0)" ::: "memory");
            b.st[2] = 0xFFFFFFFFu;
        } else b.st[2] = gen;
    }
    __syncthreads();
    if (bg_layer >= 0) {
        const unsigned gen = b.st[2];
        if (gen != 0xFFFFFFFFu) {
            const int lane = threadIdx.x & 63, wave = __builtin_amdgcn_readfirstlane(threadIdx.x >> 6);
            bool more = true;
            while (more && (unsigned)__builtin_amdgcn_readfirstlane((int)xb_ld(&b.bar[XB_XGEN(b.x)])) == gen) more = convert_steal(*bga, bg_layer, lds, wave, lane);
            asm volatile("s_waitcnt vmcnt(0)" ::: "memory");
            __syncthreads();
            if (threadIdx.x == 0) { XB_SPIN(xb_ld(&b.bar[XB_XGEN(b.x)]) == gen, b.bar); __builtin_amdgcn_fence(__ATOMIC_ACQUIRE, "agent"); asm volatile("s_waitcnt vmcnt(0)" ::: "memory"); }
        } else __syncthreads();
        __syncthreads();
    }
}

namespace pg8 {
constexpr int BM = 256, BK = 64, HALF = 128, HTB = HALF * BK * 2, STAGE_BYTES = 8 * HTB, NXCD = 8, WGM = 8;
__host__ __device__ __forceinline__ int lds_byte(int r, int c) { const int st = (r >> 4) * 2 + (c >> 5), rr = r & 15, cc = c & 31, ob = rr * 64 + cc * 2; return st * 1024 + (ob ^ (((ob >> 9) & 1) << 5)); }
__host__ __device__ __forceinline__ void stage_rc(int b, int& R, int& C) { const int st = b / 1024, sb = b % 1024, swz = sb ^ (((sb >> 9) & 1) << 5); R = (st >> 1) * 16 + swz / 64; C = (st & 1) * 32 + (swz % 64) / 2; }
__host__ __device__ __forceinline__ int perm32(int rho) { const int n = rho >> 4, i = rho & 15; return 8 * (i >> 2) + 4 * n + (i & 3); }

typedef int v8i __attribute__((ext_vector_type(8)));
typedef int v4i __attribute__((ext_vector_type(4)));
__device__ __forceinline__ v8i cat8(bf16x8 lo, bf16x8 hi) { const v4i a = __builtin_bit_cast(v4i, lo), b = __builtin_bit_cast(v4i, hi); return __builtin_shufflevector(a, b, 0, 1, 2, 3, 4, 5, 6, 7); }
struct Unit { const char* A; const char* B; const unsigned* gat; int nvalid; int i0, i1, i2; };

template <class Epi, class Sched, bool GATHER, bool ALIGN_EPI, bool SP2, int BMODE = 0, int F8 = 0>
__device__ __forceinline__ void gemm_phase(LAS unsigned char* lds, const unsigned lda, const unsigned ldb, const int nt, const Sched& S, const Epi& E) {
    const int tid = threadIdx.x, wid = __builtin_amdgcn_readfirstlane(tid >> 6), lane = tid & 63, wr = wid >> 2, wc = wid & 3, fr = lane & 15, fq = lane >> 4;
    int R0, C0, R1, C1; stage_rc(tid * 16, R0, C0); stage_rc(tid * 16 + 8192, R1, C1);
    const int Rb0 = BMODE == 0 ? (R0 & ~31) + perm32(R0 & 31) : 64 * (R0 >> 5) + 16 * ((R0 & 15) >> 2) + 4 * ((R0 >> 4) & 1) + (R0 & 3);
    const int Rb1 = BMODE == 0 ? (R1 & ~31) + perm32(R1 & 31) : 64 * (R1 >> 5) + 16 * ((R1 & 15) >> 2) + 4 * ((R1 >> 4) & 1) + (R1 & 3);
    const unsigned voffB0 = (unsigned)Rb0 * ldb + (unsigned)C0 * 2u, voffB1 = (unsigned)Rb1 * ldb + (unsigned)C1 * 2u;
    const size_t hstepB = (size_t)(BMODE == 0 ? HALF : 8) * ldb;
    const size_t kstep = (size_t)(BK * 2);
    const unsigned ldsw = (unsigned)wid * 1024u;
    const int aoff = lds_byte(wr * 64 + fr, F8 ? fq * 16 : fq * 8), boff = lds_byte(wc * 32 + fr, F8 ? fq * 16 : fq * 8);
    const int aoff2 = F8 ? lds_byte(wr * 64 + fr, fq * 16 + 8) : aoff + 1024, boff2 = F8 ? lds_byte(wc * 32 + fr, fq * 16 + 8) : boff + 1024;
#define PG8_SA(b, h) (((b) * 2 + (h)) * HTB)
#define PG8_SB(b, h) ((4 + (b) * 2 + (h)) * HTB)
#define PG8_STAGE(bufoff, gbase, v0, v1) do { unsigned _v0 = (v0), _v1 = (v1); asm volatile("" : "+v"(_v0), "+v"(_v1)); \
        __builtin_amdgcn_global_load_lds((const unsigned*)((const char*)(gbase) + _v0), (LAS unsigned*)(lds + (bufoff) + ldsw), 16, 0, 0); \
        __builtin_amdgcn_global_load_lds((const unsigned*)((const char*)(gbase) + _v1), (LAS unsigned*)(lds + (bufoff) + ldsw + 8192), 16, 0, 0); } while (0)
#define PG8_LDA(dst, b, h) do { _Pragma("unroll") for (int m = 0; m < 4; ++m) { dst[m][0] = *(const LAS bf16x8*)(lds + PG8_SA(b, h) + aoff + m * 2048); dst[m][1] = *(const LAS bf16x8*)(lds + PG8_SA(b, h) + aoff2 + m * 2048); } } while (0)
#define PG8_LDB(dst, b, h) do { _Pragma("unroll") for (int n = 0; n < 2; ++n) { dst[n][0] = *(const LAS bf16x8*)(lds + PG8_SB(b, h) + boff + n * 2048); dst[n][1] = *(const LAS bf16x8*)(lds + PG8_SB(b, h) + boff2 + n * 2048); } } while (0)
#define PG8_MMA(ai, bj, At, Bt) do { __builtin_amdgcn_s_setprio(1); _Pragma("unroll") for (int m = 0; m < 4; ++m) _Pragma("unroll") for (int n = 0; n < 2; ++n) { \
        if constexpr (F8) acc[ai][bj][m][n] = __builtin_amdgcn_mfma_scale_f32_16x16x128_f8f6f4(cat8(Bt[n][0], Bt[n][1]), cat8(At[m][0], At[m][1]), acc[ai][bj][m][n], 0, 0, 0, 0x7F7F7F7F, 0, 0x7F7F7F7F); \
        else { _Pragma("unroll") for (int k = 0; k < 2; ++k) acc[ai][bj][m][n] = __builtin_amdgcn_mfma_f32_16x16x32_bf16(Bt[n][k], At[m][k], acc[ai][bj][m][n], 0, 0, 0); } } __builtin_amdgcn_s_setprio(0); } while (0)
#define PG8_WAIT_V(n) asm volatile("s_waitcnt vmcnt(" #n ")" ::: "memory")
#define PG8_WAIT_L(n) asm volatile("s_waitcnt lgkmcnt(" #n ")" ::: "memory")
#define PG8_BAR __builtin_amdgcn_s_barrier()
#define PG8_SCHED __builtin_amdgcn_sched_barrier(0)
#define PG8_SETV(v00, v01, v10, v11, u) do { \
        if (GATHER) { int _t = tid; asm volatile("" : "+v"(_t)); int r0, c0, r1, c1; stage_rc(_t * 16, r0, c0); stage_rc(_t * 16 + 8192, r1, c1);     \
            const unsigned ta = r0 < (u).nvalid ? (u).gat[r0] : 0u, tb = r1 < (u).nvalid ? (u).gat[r1] : 0u, \
                                     tc = (HALF + r0) < (u).nvalid ? (u).gat[HALF + r0] : 0u, td = (HALF + r1) < (u).nvalid ? (u).gat[HALF + r1] : 0u; \
            v00 = ta * lda + (unsigned)c0 * 2u; v01 = tb * lda + (unsigned)c1 * 2u; v10 = tc * lda + (unsigned)c0 * 2u; v11 = td * lda + (unsigned)c1 * 2u; } \
        else { v00 = (unsigned)R0 * lda + (unsigned)C0 * 2u; v01 = (unsigned)R1 * lda + (unsigned)C1 * 2u; v10 = (unsigned)(HALF + R0) * lda + (unsigned)C0 * 2u; v11 = (unsigned)(HALF + R1) * lda + (unsigned)C1 * 2u; } } while (0)
    Unit cur, nxt; int ui = 0;
    if (!S.next(0, cur)) return;
    f32x4 acc[2][2][4][2];
#pragma unroll
    for (int a = 0; a < 2; ++a)
#pragma unroll
        for (int b = 0; b < 2; ++b)
#pragma unroll
            for (int m = 0; m < 4; ++m)
#pragma unroll
                for (int n = 0; n < 2; ++n) acc[a][b][m][n] = (f32x4){0.f, 0.f, 0.f, 0.f};
    bf16x8 At[4][2], B0[2][2], B1[2][2];
    const char* cA = cur.A; const char* cB = cur.B;
    unsigned cv00, cv01, cv10, cv11;
    PG8_SETV(cv00, cv01, cv10, cv11, cur);
    if constexpr (SP2) {
        PG8_STAGE(PG8_SB(0, 0), cB, voffB0, voffB1); PG8_STAGE(PG8_SB(0, 1), cB + hstepB, voffB0, voffB1); PG8_STAGE(PG8_SA(0, 0), cA, cv00, cv01); PG8_STAGE(PG8_SA(0, 1), cA, cv10, cv11);
        if (wr == 1) PG8_BAR;
        PG8_WAIT_V(2); PG8_BAR;
        PG8_STAGE(PG8_SB(1, 0), cB + kstep, voffB0, voffB1); PG8_STAGE(PG8_SA(1, 0), cA + kstep, cv00, cv01); PG8_STAGE(PG8_SB(1, 1), cB + hstepB + kstep, voffB0, voffB1);
        PG8_WAIT_V(6); PG8_BAR;
    } else {
        PG8_STAGE(PG8_SB(0, 0), cB, voffB0, voffB1); PG8_STAGE(PG8_SA(0, 0), cA, cv00, cv01); PG8_STAGE(PG8_SB(0, 1), cB + hstepB, voffB0, voffB1); PG8_STAGE(PG8_SA(0, 1), cA, cv10, cv11);
        if (wr == 1) PG8_BAR;
        PG8_WAIT_V(4); PG8_BAR;
        PG8_STAGE(PG8_SB(1, 0), cB + kstep, voffB0, voffB1); PG8_STAGE(PG8_SA(1, 0), cA + kstep, cv00, cv01); PG8_STAGE(PG8_SB(1, 1), cB + hstepB + kstep, voffB0, voffB1);
        PG8_WAIT_V(6); PG8_BAR;
    }
    for (;;) {
        const bool has_next = S.next(ui + 1, nxt);
        const char* nA = has_next ? nxt.A : cA; const char* nB = has_next ? nxt.B : cB;
#pragma unroll 1
        for (int t = 0; t < nt; t += 2) {
            const bool last = (t == nt - 2);
            const char* a1 = cA + (size_t)(t + 1) * kstep;
            const char* a2 = last ? nA : cA + (size_t)(t + 2) * kstep; const char* b2 = last ? nB : cB + (size_t)(t + 2) * kstep;
            const char* a3 = a2 + kstep; const char* b3 = b2 + kstep;
            if constexpr (SP2) {
            PG8_LDB(B0, 0, 0); PG8_LDB(B1, 0, 1); PG8_SCHED; PG8_LDA(At, 0, 0); PG8_STAGE(PG8_SA(1, 1), a1, cv10, cv11);
            PG8_WAIT_V(8); PG8_WAIT_L(0); PG8_BAR; PG8_MMA(0, 0, At, B0); PG8_MMA(0, 1, At, B1); PG8_BAR; PG8_SCHED;
            if constexpr (GATHER) { if (last && has_next) { PG8_SETV(cv00, cv01, cv10, cv11, nxt); } }
            PG8_LDA(At, 0, 1); PG8_STAGE(PG8_SB(0, 0), b2, voffB0, voffB1); PG8_STAGE(PG8_SB(0, 1), b2 + hstepB, voffB0, voffB1); PG8_STAGE(PG8_SA(0, 0), a2, cv00, cv01);
            PG8_WAIT_V(8); PG8_WAIT_L(0); PG8_BAR; PG8_MMA(1, 0, At, B0); PG8_MMA(1, 1, At, B1); PG8_BAR; PG8_SCHED;
            PG8_LDB(B0, 1, 0); PG8_LDB(B1, 1, 1); PG8_SCHED; PG8_LDA(At, 1, 0); PG8_STAGE(PG8_SA(0, 1), a2, cv10, cv11);
            PG8_WAIT_V(8); PG8_WAIT_L(0); PG8_BAR; PG8_MMA(0, 0, At, B0); PG8_MMA(0, 1, At, B1); PG8_BAR; PG8_SCHED;
            PG8_LDA(At, 1, 1); PG8_STAGE(PG8_SB(1, 0), b3, voffB0, voffB1); PG8_STAGE(PG8_SB(1, 1), b3 + hstepB, voffB0, voffB1); PG8_STAGE(PG8_SA(1, 0), a3, cv00, cv01);
            PG8_WAIT_V(8); PG8_WAIT_L(0); PG8_BAR; PG8_MMA(1, 0, At, B0); PG8_MMA(1, 1, At, B1); PG8_BAR; PG8_SCHED;
            } else {
            PG8_LDB(B0, 0, 0); PG8_SCHED; PG8_LDA(At, 0, 0); PG8_STAGE(PG8_SA(1, 1), a1, cv10, cv11);
            PG8_WAIT_L(8); PG8_BAR; PG8_WAIT_L(0); PG8_MMA(0, 0, At, B0); PG8_BAR; PG8_SCHED;
            if constexpr (GATHER) { if (last && has_next) { PG8_SETV(cv00, cv01, cv10, cv11, nxt); } }
            PG8_LDB(B1, 0, 1); PG8_STAGE(PG8_SB(0, 0), b2, voffB0, voffB1);
            PG8_BAR; PG8_WAIT_L(0); PG8_MMA(0, 1, At, B1); PG8_BAR;
            PG8_LDA(At, 0, 1); PG8_STAGE(PG8_SA(0, 0), a2, cv00, cv01);
            PG8_BAR; PG8_WAIT_L(0); PG8_MMA(1, 0, At, B0); PG8_BAR; PG8_SCHED;
            PG8_STAGE(PG8_SB(0, 1), b2 + hstepB, voffB0, voffB1);
            PG8_WAIT_V(6); PG8_BAR; PG8_MMA(1, 1, At, B1); PG8_BAR;
            PG8_LDB(B0, 1, 0); PG8_SCHED; PG8_LDA(At, 1, 0); PG8_STAGE(PG8_SA(0, 1), a2, cv10, cv11);
            PG8_WAIT_L(8); PG8_BAR; PG8_WAIT_L(0); PG8_MMA(0, 0, At, B0); PG8_BAR; PG8_SCHED;
            PG8_LDB(B1, 1, 1); PG8_STAGE(PG8_SB(1, 0), b3, voffB0, voffB1);
            PG8_BAR; PG8_WAIT_L(0); PG8_MMA(0, 1, At, B1); PG8_BAR;
            PG8_LDA(At, 1, 1); PG8_STAGE(PG8_SA(1, 0), a3, cv00, cv01);
            PG8_BAR; PG8_WAIT_L(0); PG8_MMA(1, 0, At, B0); PG8_BAR; PG8_SCHED;
            PG8_STAGE(PG8_SB(1, 1), b3 + hstepB, voffB0, voffB1);
            PG8_WAIT_V(6); PG8_BAR; PG8_MMA(1, 1, At, B1); PG8_BAR;
            }
        }
        if constexpr (ALIGN_EPI) { if (wr == 0) PG8_BAR; }
        { int t2 = tid; asm volatile("" : "+v"(t2));
          E(acc, cur, wr, wc, t2 & 15, (t2 & 63) >> 4); }
        if (!has_next) break;
#pragma unroll
        for (int a = 0; a < 2; ++a)
#pragma unroll
            for (int b = 0; b < 2; ++b)
#pragma unroll
                for (int m = 0; m < 4; ++m)
#pragma unroll
                    for (int n = 0; n < 2; ++n) acc[a][b][m][n] = (f32x4){0.f, 0.f, 0.f, 0.f};
        cur = nxt; cA = nA; cB = nB; ++ui;
        if constexpr (ALIGN_EPI) { if (wr == 1) PG8_BAR; }
    }
    PG8_WAIT_V(0);
    if constexpr (!ALIGN_EPI) { if (wr == 0) PG8_BAR; }
    PG8_BAR;
#undef PG8_SA
#undef PG8_SB
#undef PG8_STAGE
#undef PG8_LDA
#undef PG8_LDB
#undef PG8_MMA
#undef PG8_WAIT_V
#undef PG8_WAIT_L
#undef PG8_BAR
#undef PG8_SCHED
#undef PG8_SETV
}

struct DenseSched {
    const char* A; const char* B; unsigned lda, ldb, a_pn; int nM, nN, nwg, G, c; const unsigned* ident = nullptr;
    __device__ __forceinline__ bool next(int i, Unit& u) const {
        const long L = (long)i * G + c; if (L >= nwg) return false;
        int wgid = (int)L; { const int q = nwg / NXCD, r = nwg % NXCD, xcd = wgid % NXCD, off = wgid / NXCD; wgid = (xcd < r ? xcd * (q + 1) : r * (q + 1) + (xcd - r) * q) + off; }
        const int nig = WGM * nN, gid = wgid / nig, fm = gid * WGM, gsz = (nM - fm) < WGM ? (nM - fm) : WGM;
        const int pm = fm + ((wgid % nig) % gsz), pn = (wgid % nig) / gsz;
        u.A = ident ? A : A + (size_t)pm * BM * lda + (size_t)pn * a_pn; u.B = B + (size_t)pn * BM * ldb; u.gat = ident ? ident + pm * BM : nullptr; u.nvalid = BM; u.i0 = pm; u.i1 = pn; u.i2 = 0; return true;
    }
};
struct MoeInfo { const LAS unsigned* cnt; const LAS unsigned* tstart; const LAS unsigned* ystart; const LAS unsigned char* tile_e; int ntiles; };
struct G1Sched {
    MoeInfo mi; const char* XB; const char* Wgu; const unsigned* rowtok; const unsigned* ident; int G, vcu;
    __device__ __forceinline__ bool next(int i, Unit& u) const {
        const int L = i * G + vcu; if (L >= 2 * mi.ntiles) return false;
        const int tile = L >> 1, uu = L & 1; int e;
        if (tile < 64) { e = 64; u.gat = ident + tile * 256; u.nvalid = 256; }
        else { e = __builtin_amdgcn_readfirstlane((int)mi.tile_e[tile]); const int pos0 = (tile - __builtin_amdgcn_readfirstlane((int)mi.tstart[e])) * 256; u.gat = rowtok + (size_t)e * CAP + pos0; const int rem = __builtin_amdgcn_readfirstlane((int)mi.cnt[e]) - pos0; u.nvalid = rem < 256 ? rem : 256; }
        u.A = XB; u.B = Wgu + ((size_t)e * 512 + (size_t)uu * 256) * 1024; u.i0 = tile; u.i1 = uu; u.i2 = 0; return true;
    }
};
struct G2Sched {
    MoeInfo mi; const char* H; const char* Wd; int G, vcu, L0;
    __device__ __forceinline__ bool next(int i, Unit& u) const {
        const int L = i * G + vcu + L0; if (L >= 4 * mi.ntiles) return false;
        const int tile = L >> 2, pn = L & 3; int e;
        if (tile < 64) { e = 64; u.i0 = 131072 + tile * 256; u.i2 = 0; u.nvalid = 256; }
        else { e = __builtin_amdgcn_readfirstlane((int)mi.tile_e[tile]); const int pos0 = (tile - __builtin_amdgcn_readfirstlane((int)mi.tstart[e])) * 256; u.i0 = __builtin_amdgcn_readfirstlane((int)mi.ystart[e]) + pos0; u.i2 = 0; const int rem = __builtin_amdgcn_readfirstlane((int)mi.cnt[e]) - pos0; u.nvalid = rem < 256 ? rem : 256; }
        u.A = H + (size_t)tile * 256 * 256; u.B = Wd + ((size_t)e * 1024 + (size_t)pn * 256) * 256; u.gat = nullptr; u.i1 = pn; return true;
    }
};

template <int ACT, bool BIAS, bool SCALE, bool W32 = false, bool VSTAT = false> struct EpiBf16 {
    bf16* O; int ldo; const float* bias; const float* scale; float* vstat;
    __device__ __forceinline__ void operator()(const f32x4 (&acc)[2][2][4][2], const Unit& u, int wr, int wc, int fr, int fq) const {
        const int row0 = u.i0 * BM + wr * 64 + fr, col0 = u.i1 * BM + wc * 32 + 8 * fq;
        const bool dostat = VSTAT && u.i1 >= 8;
        f32x4 bv[2][2], sv[2][2];
#pragma unroll
        for (int bj = 0; bj < 2; ++bj)
#pragma unroll
            for (int n = 0; n < 2; ++n) { bv[bj][n] = BIAS ? *(const f32x4*)(bias + col0 + bj * HALF + 4 * n) : (f32x4){0.f, 0.f, 0.f, 0.f}; sv[bj][n] = SCALE ? *(const f32x4*)(scale + col0 + bj * HALF + 4 * n) : (f32x4){1.f, 1.f, 1.f, 1.f}; }
#pragma unroll
        for (int ai = 0; ai < 2; ++ai)
#pragma unroll
            for (int m = 0; m < 4; ++m) { bf16* rowp = O + (size_t)(row0 + ai * HALF + m * 16) * ldo + col0; float ssum = 0.f, ssq = 0.f;
#pragma unroll
                for (int bj = 0; bj < 2; ++bj) { f32x4 v0 = acc[ai][bj][m][0] * (W32 ? 0.03125f : 1.0f) + bv[bj][0], v1 = acc[ai][bj][m][1] * (W32 ? 0.03125f : 1.0f) + bv[bj][1];
                    if (ACT == 1) {
#pragma unroll
                        for (int j = 0; j < 4; ++j) { v0[j] = gelu_tanh(v0[j]); v1[j] = gelu_tanh(v1[j]); } }
                    if (SCALE) { v0 = v0 * sv[bj][0]; v1 = v1 * sv[bj][1]; }
                    v4u w; w.x = cvt_pk_bf16(v0[0], v0[1]); w.y = cvt_pk_bf16(v0[2], v0[3]); w.z = cvt_pk_bf16(v1[0], v1[1]); w.w = cvt_pk_bf16(v1[2], v1[3]);
                    *(v4u*)(rowp + bj * HALF) = w;
                    if constexpr (VSTAT) {
#pragma unroll
                        for (int j = 0; j < 4; ++j) { ssum += v0[j] + v1[j]; ssq += v0[j] * v0[j] + v1[j] * v1[j]; } } }
                if constexpr (VSTAT) { if (dostat) {
                    ssum += __shfl_xor(ssum, 16); ssq += __shfl_xor(ssq, 16); ssum += __shfl_xor(ssum, 32); ssq += __shfl_xor(ssq, 32);
                    if (fq == 0) *(f32x2*)(vstat + ((size_t)(row0 + ai * HALF + m * 16) * 32 + (size_t)(u.i1 - 8) * 4 + wc) * 2) = (f32x2){ssum, ssq}; } } }
    }
};
template <bool BASE_BF16> struct EpiResidB {
    const void* base; bf16* outb;
    __device__ __forceinline__ void operator()(const f32x4 (&acc)[2][2][4][2], const Unit& u, int wr, int wc, int fr, int fq) const {
        const int row0 = u.i0 * BM + wr * 64 + fr, col0 = u.i1 * BM + wc * 32 + 8 * fq;
#pragma unroll
        for (int ai = 0; ai < 2; ++ai)
#pragma unroll
            for (int m = 0; m < 4; ++m) { const size_t off = (size_t)(row0 + ai * HALF + m * 16) * DM + col0;
#pragma unroll
                for (int bj = 0; bj < 2; ++bj) { f32x4 b0, b1;
                    if constexpr (BASE_BF16) { const v4u w = *(const v4u*)((const bf16*)base + off + bj * HALF); b0 = (f32x4){bf_lo(w.x), bf_hi(w.x), bf_lo(w.y), bf_hi(w.y)}; b1 = (f32x4){bf_lo(w.z), bf_hi(w.z), bf_lo(w.w), bf_hi(w.w)}; }
                    else { b0 = *(const f32x4*)((const float*)base + off + bj * HALF); b1 = *(const f32x4*)((const float*)base + off + bj * HALF + 4); }
                    const f32x4 o0 = b0 * ALPHA + acc[ai][bj][m][0], o1 = b1 * ALPHA + acc[ai][bj][m][1];
                    v4u o; o.x = cvt_pk_bf16(o0[0], o0[1]); o.y = cvt_pk_bf16(o0[2], o0[3]); o.z = cvt_pk_bf16(o1[0], o1[1]); o.w = cvt_pk_bf16(o1[2], o1[3]);
                    *(v4u*)(outb + off + bj * HALF) = o; }
                asm volatile("" ::: "memory"); }
    }
};
struct EpiResid {
    const float* base; float* out;
    __device__ __forceinline__ void operator()(const f32x4 (&acc)[2][2][4][2], const Unit& u, int wr, int wc, int fr, int fq) const {
        const int row0 = u.i0 * BM + wr * 64 + fr, col0 = u.i1 * BM + wc * 32 + 8 * fq;
#pragma unroll
        for (int ai = 0; ai < 2; ++ai)
#pragma unroll
            for (int m = 0; m < 4; ++m) { const size_t off = (size_t)(row0 + ai * HALF + m * 16) * DM + col0;
#pragma unroll
                for (int bj = 0; bj < 2; ++bj) { const f32x4 b0 = *(const f32x4*)(base + off + bj * HALF), b1 = *(const f32x4*)(base + off + bj * HALF + 4);
                    *(f32x4*)(out + off + bj * HALF) = b0 * ALPHA + acc[ai][bj][m][0]; *(f32x4*)(out + off + bj * HALF + 4) = b1 * ALPHA + acc[ai][bj][m][1]; }
                asm volatile("" ::: "memory"); }
    }
};
struct EpiSwiglu {
    unsigned char* H8;
    __device__ __forceinline__ void operator()(const f32x4 (&acc)[2][2][4][2], const Unit& u, int wr, int wc, int fr, int fq) const {
        const int row0 = u.i0 * BM + wr * 64 + fr, col0 = u.i1 * HALF + wc * 32 + 8 * fq;
#pragma unroll
        for (int ai = 0; ai < 2; ++ai)
#pragma unroll
            for (int m = 0; m < 4; ++m) { unsigned char* rowp = H8 + (size_t)(row0 + ai * HALF + m * 16) * EDIM + col0; float h[8];
#pragma unroll
                for (int n = 0; n < 2; ++n)
#pragma unroll
                    for (int j = 0; j < 4; ++j) { const float g = acc[ai][0][m][n][j] * 0.03125f, up = acc[ai][1][m][n][j] * 0.25f; h[4 * n + j] = g * sigmoidf_(g) * up; }
                int t0 = 0, t1 = 0; t0 = __builtin_amdgcn_cvt_pk_fp8_f32(h[0], h[1], t0, false); t0 = __builtin_amdgcn_cvt_pk_fp8_f32(h[2], h[3], t0, true); t1 = __builtin_amdgcn_cvt_pk_fp8_f32(h[4], h[5], t1, false); t1 = __builtin_amdgcn_cvt_pk_fp8_f32(h[6], h[7], t1, true);
                *(v2u*)rowp = (v2u){(unsigned)t0, (unsigned)t1}; }
    }
};
struct EpiDown {
    unsigned char* Y8;
    __device__ __forceinline__ void operator()(const f32x4 (&acc)[2][2][4][2], const Unit& u, int wr, int wc, int fr, int fq) const {
        const int r0 = wr * 64 + fr, col0 = u.i1 * BM + wc * 64 + 16 * fq;
#pragma unroll
        for (int ai = 0; ai < 2; ++ai)
#pragma unroll
            for (int m = 0; m < 4; ++m) { const int r = r0 + ai * HALF + m * 16;
                if (r < u.nvalid) { v4u w;
#pragma unroll
                    for (int q = 0; q < 4; ++q) { const f32x4 v = acc[ai][q >> 1][m][q & 1] * 0.0625f;     int t = 0; t = __builtin_amdgcn_cvt_pk_fp8_f32(v[0], v[1], t, false); t = __builtin_amdgcn_cvt_pk_fp8_f32(v[2], v[3], t, true); w[q] = (unsigned)t; }
                    *(v4u*)(Y8 + (size_t)(u.i0 + r) * DM + col0) = w; } }
    }
};
}

struct Args { const float* in[24]; float* out; unsigned char* ws; int ph_lo, ph_hi; };
enum { I_X = 0, I_PWIN, I_PWGRP, I_PSCALE, I_PWOUT, I_SWIN, I_SBIN, I_SLNG, I_SLNB, I_SWS, I_SBS, I_SWOUT, I_LNMG, I_LNMB, I_WR, I_RB, I_WG, I_WU, I_WD, I_SHG, I_SHU, I_SHD, I_LNFG, I_LNFB };

__device__ __forceinline__ void tr_item(const float* W, int N, int k0, int n0, bf16* dst  , int dpitch, LAS float* scr, int lane) {
#pragma unroll 8
    for (int i = 0; i < 32; ++i) { const int kk = 2 * i + (lane >> 5); scr[kk * 33 + (lane & 31)] = W[(size_t)(k0 + kk) * N + n0 + (lane & 31)]; }
    LDS_WAIT(); asm volatile("" ::: "memory");
    const int c = lane & 7;
#pragma unroll
    for (int j = 0; j < 4; ++j) { const int n = (lane >> 3) + 8 * j; const LAS float* s = scr + (8 * c) * 33 + n;
        v4u o; o.x = cvt_pk_bf16(s[0 * 33], s[1 * 33]); o.y = cvt_pk_bf16(s[2 * 33], s[3 * 33]); o.z = cvt_pk_bf16(s[4 * 33], s[5 * 33]); o.w = cvt_pk_bf16(s[6 * 33], s[7 * 33]);
        *(v4u*)(dst + (size_t)n * dpitch + 8 * c) = o; }
    LDS_WAIT(); asm volatile("" ::: "memory");
}
__device__ __forceinline__ void tr_item_f8(const float* W, int N, int k0, int n0, unsigned char* dst, int dpitch, float scale, LAS float* scr, int lane) {
#pragma unroll 8
    for (int i = 0; i < 32; ++i) { const int kk = 2 * i + (lane >> 5); scr[kk * 33 + (lane & 31)] = W[(size_t)(k0 + kk) * N + n0 + (lane & 31)]; }
    LDS_WAIT(); asm volatile("" ::: "memory");
    const int c = lane & 7;
#pragma unroll
    for (int j = 0; j < 4; ++j) { const int n = (lane >> 3) + 8 * j; const LAS float* s = scr + (8 * c) * 33 + n;
        int t0 = 0, t1 = 0;
        t0 = __builtin_amdgcn_cvt_pk_fp8_f32(s[0 * 33] * scale, s[1 * 33] * scale, t0, false); t0 = __builtin_amdgcn_cvt_pk_fp8_f32(s[2 * 33] * scale, s[3 * 33] * scale, t0, true);
        t1 = __builtin_amdgcn_cvt_pk_fp8_f32(s[4 * 33] * scale, s[5 * 33] * scale, t1, false); t1 = __builtin_amdgcn_cvt_pk_fp8_f32(s[6 * 33] * scale, s[7 * 33] * scale, t1, true);
        *(v2u*)(dst + (size_t)n * dpitch + 8 * c) = (v2u){(unsigned)t0, (unsigned)t1}; }
    LDS_WAIT(); asm volatile("" ::: "memory");
}
__device__ __forceinline__ void tr_tall_f8(const float* W, int N, int k0, int n0, unsigned char* dst, int dpitch, float scale, LAS float* scr, int lane) {
    f32x4 q[16]; const int r8 = lane >> 3, c4 = 4 * (lane & 7);
#pragma unroll
    for (int i = 0; i < 16; ++i) q[i] = *(const f32x4*)(W + (size_t)(k0 + 8 * i + r8) * N + n0 + c4);
#pragma unroll
    for (int i = 0; i < 16; ++i) { const int kk = 8 * i + r8; *(LAS f32x4*)(scr + kk * 32 + ((c4 + 4 * (kk >> 4)) & 31)) = q[i]; }
    LDS_WAIT(); asm volatile("" ::: "memory");
    const int c = lane & 7;
#pragma unroll
    for (int j = 0; j < 4; ++j) { const int n = r8 + 8 * j; const int col = (n + 4 * c) & 31; v4u o;
#pragma unroll
        for (int z = 0; z < 4; ++z) { const LAS float* sp = scr + (16 * c + 4 * z) * 32 + col; int t = 0;
            t = __builtin_amdgcn_cvt_pk_fp8_f32(sp[0] * scale, sp[32] * scale, t, false); t = __builtin_amdgcn_cvt_pk_fp8_f32(sp[64] * scale, sp[96] * scale, t, true); o[z] = (unsigned)t; }
        *(v4u*)(dst + (size_t)n * dpitch + 16 * c) = o; }
    LDS_WAIT(); asm volatile("" ::: "memory");
}
template <bool SPLIT> __device__ __forceinline__ void tr_block_f8(const float* W, int N, int k0, int n0, unsigned char* dst, int dpitch, float scale, LAS float* tile, int wave, int lane) {
    f32x4 q[16];
#pragma unroll
    for (int i = 0; i < 16; ++i) q[i] = *(const f32x4*)(W + (size_t)(k0 + 16 * wave + i) * N + n0 + 4 * lane);
#pragma unroll
    for (int i = 0; i < 16; ++i) { const int kk = 16 * wave + i; *(LAS f32x4*)(tile + kk * 256 + ((4 * lane + 4 * (kk >> 4)) & 255)) = q[i]; }
    LDS_WAIT(); __syncthreads();
    const int c = lane & 7, r8 = lane >> 3;
#pragma unroll
    for (int j = 0; j < 4; ++j) { const int n = 32 * wave + r8 + 8 * j; const int col = (n + 4 * c) & 255; v4u o;
#pragma unroll
        for (int z = 0; z < 4; ++z) { const LAS float* sp = tile + (16 * c + 4 * z) * 256 + col; int t = 0;
            t = __builtin_amdgcn_cvt_pk_fp8_f32(sp[0] * scale, sp[256] * scale, t, false); t = __builtin_amdgcn_cvt_pk_fp8_f32(sp[512] * scale, sp[768] * scale, t, true); o[z] = (unsigned)t; }
        *(v4u*)(dst + (size_t)(SPLIT ? ((n >> 7) * 256 + (n & 127)) : n) * dpitch + 16 * c) = o; }
    LDS_WAIT(); __syncthreads();
}
__device__ __forceinline__ void tr_item_hilo(const float* W, int N, int k0, int n0, bf16* dh, bf16* dl, int dpitch, LAS float* scr, int lane) {
#pragma unroll 8
    for (int i = 0; i < 32; ++i) { const int kk = 2 * i + (lane >> 5); scr[kk * 33 + (lane & 31)] = W[(size_t)(k0 + kk) * N + n0 + (lane & 31)]; }
    LDS_WAIT(); asm volatile("" ::: "memory");
    const int c = lane & 7;
#pragma unroll
    for (int j = 0; j < 4; ++j) { const int n = (lane >> 3) + 8 * j; const LAS float* s = scr + (8 * c) * 33 + n; float w[8];
#pragma unroll
        for (int z = 0; z < 8; ++z) w[z] = s[z * 33];
        v4u o; o.x = cvt_pk_bf16(w[0], w[1]); o.y = cvt_pk_bf16(w[2], w[3]); o.z = cvt_pk_bf16(w[4], w[5]); o.w = cvt_pk_bf16(w[6], w[7]);
        v4u l; l.x = cvt_pk_bf16(w[0] - bf_lo(o.x), w[1] - bf_hi(o.x)); l.y = cvt_pk_bf16(w[2] - bf_lo(o.y), w[3] - bf_hi(o.y)); l.z = cvt_pk_bf16(w[4] - bf_lo(o.z), w[5] - bf_hi(o.z)); l.w = cvt_pk_bf16(w[6] - bf_lo(o.w), w[7] - bf_hi(o.w));
        *(v4u*)(dh + (size_t)n * dpitch + 8 * c) = o; *(v4u*)(dl + (size_t)n * dpitch + 8 * c) = l; }
    LDS_WAIT(); asm volatile("" ::: "memory");
}
constexpr int MOE_ITEMS = 65 * 192;
__device__ __forceinline__ void convert_moe_item(const Args& a, int layer, int it, LAS float* scr, int lane) {
    unsigned char* WGU = a.ws + WS_WGU + (size_t)layer * WS_MOE_LSTRIDE; unsigned char* WDN = a.ws + WS_WDN + (size_t)layer * WS_MOE_LSTRIDE;
    const int e = it / 192, r = it % 192;
    if (r < 128) { const int isup = r >> 6, rr = r & 63, kb = rr >> 3, nb = rr & 7, n0 = 32 * nb, k0 = 128 * kb;
        const float* src = (e < 64) ? a.in[isup ? I_WU : I_WG] + ((size_t)layer * 64 + e) * 262144 : a.in[isup ? I_SHU : I_SHG] + (size_t)layer * 262144;
        const int drow = e * 512 + (n0 >> 7) * 256 + isup * 128 + (n0 & 127);
        tr_tall_f8(src, 256, k0, n0, WGU + (size_t)drow * 1024 + k0, 1024, 32.0f, scr, lane);
    } else { const int rr = r - 128, kb = rr >> 5, nb = rr & 31, n0 = 32 * nb, k0 = 128 * kb;
        const float* src = (e < 64) ? a.in[I_WD] + ((size_t)layer * 64 + e) * 262144 : a.in[I_SHD] + (size_t)layer * 262144;
        tr_tall_f8(src, 1024, k0, n0, WDN + ((size_t)e * 1024 + n0) * 256 + k0, 256, 32.0f, scr, lane);
    }
}
constexpr int Q_SHARDS = 8, Q_PER_SHARD = MOE_ITEMS / Q_SHARDS;
static_assert(Q_PER_SHARD * Q_SHARDS == MOE_ITEMS, "queue shards");
template <int CHUNK> __device__ __forceinline__ bool convert_steal_n(const Args& a, int layer, LAS unsigned char* lds, int wave, int lane) {
    unsigned* q = (unsigned*)(a.ws + WS_CTL) + CW_QNEXT + 512 * layer;
    const int s0 = (int)(blockIdx.x & 7);
    for (int s = 0; s < Q_SHARDS; ++s) { const int sh = (s0 + s) & 7;
        unsigned it = 0; if (lane == 0) it = __hip_atomic_fetch_add(q + 64 * sh, (unsigned)CHUNK, RLX_AGENT);
        it = (unsigned)__builtin_amdgcn_readfirstlane((int)it);
        if (it < (unsigned)Q_PER_SHARD) {
            for (int c = 0; c < CHUNK; ++c) if (it + c < (unsigned)Q_PER_SHARD) convert_moe_item(a, layer, sh * Q_PER_SHARD + (int)it + c, (LAS float*)(lds + wave * 16384), lane);
            return true; } }
    return false;
}
__device__ __forceinline__ bool convert_steal(const Args& a, int layer, LAS unsigned char* lds, int wave, int lane) { return convert_steal_n<1>(a, layer, lds, wave, lane); }
constexpr int MOE_WG_ITEMS = 65 * 24;
__device__ __forceinline__ void convert_static(const Args& a, int layer, LAS unsigned char* lds, int vcu, int G) {
    const int lane = threadIdx.x & 63, wave = __builtin_amdgcn_readfirstlane(threadIdx.x >> 6);
    unsigned char* WGU = a.ws + WS_WGU + (size_t)layer * WS_MOE_LSTRIDE; unsigned char* WDN = a.ws + WS_WDN + (size_t)layer * WS_MOE_LSTRIDE;
    __syncthreads();
#pragma unroll 1
    for (int it = vcu; it < MOE_WG_ITEMS; it += G) { const int e = it / 24, r = it % 24;
        if (r < 16) { const int isup = r >> 3, k0 = 128 * (r & 7);
            const float* src = (e < 64) ? a.in[isup ? I_WU : I_WG] + ((size_t)layer * 64 + e) * 262144 : a.in[isup ? I_SHU : I_SHG] + (size_t)layer * 262144;
            tr_block_f8<true>(src, 256, k0, 0, WGU + ((size_t)e * 512 + isup * 128) * 1024 + k0, 1024, 32.0f, (LAS float*)lds, wave, lane);
        } else { const int rr = r - 16, k0 = 128 * (rr >> 2), n0 = 256 * (rr & 3);
            const float* src = (e < 64) ? a.in[I_WD] + ((size_t)layer * 64 + e) * 262144 : a.in[I_SHD] + (size_t)layer * 262144;
            tr_block_f8<false>(src, 1024, k0, n0, WDN + ((size_t)e * 1024 + n0) * 256 + k0, 256, 32.0f, (LAS float*)lds, wave, lane);
        } }
}
__device__ __forceinline__ void convert_drain(const Args& a, int layer, LAS unsigned char* lds) {
    const int lane = threadIdx.x & 63, wave = __builtin_amdgcn_readfirstlane(threadIdx.x >> 6);
    while (convert_steal_n<4>(a, layer, lds, wave, lane)) {}
    __syncthreads();
}
__device__ __forceinline__ void phase_p0(const Args& a, LAS unsigned char* lds, int vcu, int G) {
    const int tid = threadIdx.x, lane = tid & 63, wave = __builtin_amdgcn_readfirstlane(tid >> 6);
    const int gw = vcu * NWAVES + wave, NGW = G * NWAVES;
    LAS float* scr = (LAS float*)(lds + wave * 16384);
    constexpr int I_IN = 16 * 32, I_GRP = 4 * 4 * 8, I_OUT = 16 * 32, I_SIN = 16 * 128, I_SOUT = 32 * 32, NIT = I_IN + I_GRP + I_OUT + I_SIN + I_SOUT;
    for (int it = gw; it < NIT; it += NGW) {
        int r = it;
        if (r < I_IN) { const int kb = r >> 5, nb = r & 31; tr_item(a.in[I_PWIN], 1024, 64 * kb, 32 * nb, (bf16*)(a.ws + WS_WIN) + (size_t)(32 * nb) * 1024 + 64 * kb, 1024, scr, lane); continue; } r -= I_IN;
        if (r < I_GRP) { const int g = r >> 5, rr = r & 31, kb = rr >> 3, nb = rr & 7; tr_item(a.in[I_PWGRP] + (size_t)g * 65536, 256, 64 * kb, 32 * nb, (bf16*)(a.ws + WS_WGRP) + (size_t)(g * 256 + 32 * nb) * 256 + 64 * kb, 256, scr, lane); continue; } r -= I_GRP;
        if (r < I_OUT) { const int kb = r >> 5, nb = r & 31; tr_item(a.in[I_PWOUT], 1024, 64 * kb, 32 * nb, (bf16*)(a.ws + WS_WOUT) + (size_t)(32 * nb) * 1024 + 64 * kb, 1024, scr, lane); continue; } r -= I_OUT;
        if (r < I_SIN) { const int kb = r >> 7, nb = r & 127; tr_item_f8(a.in[I_SWIN], 4096, 64 * kb, 32 * nb, a.ws + WS_WSIN + (size_t)(32 * nb) * 1024 + 64 * kb, 1024, 32.0f, scr, lane); continue; } r -= I_SIN;
        { const int kb = r >> 5, nb = r & 31; tr_item(a.in[I_SWOUT], 1024, 64 * kb, 32 * nb, (bf16*)(a.ws + WS_WSOUT) + (size_t)(32 * nb) * 2048 + 64 * kb, 2048, scr, lane); }
    }
    for (int it = gw; it < 64; it += NGW) { const int layer = it >> 5, rr = it & 31, kb = rr >> 1, nb = rr & 1; bf16* base = (bf16*)(a.ws + WS_WRT) + (size_t)layer * 2 * 65536 + (size_t)(32 * nb) * 1024 + 64 * kb;
        tr_item_hilo(a.in[I_WR] + (size_t)layer * DM * NE, 64, 64 * kb, 32 * nb, base, base + 65536, 1024, scr, lane); }
    convert_static(a, 0, lds, vcu, G);
    const float* x = a.in[I_X]; bf16* xb = (bf16*)(a.ws + WS_XB);
    const size_t gt = (size_t)vcu * NTHR + tid, NT = (size_t)G * NTHR;
#pragma unroll 1
    for (size_t i0 = gt; i0 < (size_t)T_TOK * DM / 8; i0 += 8 * NT) { f32x4 p[8], q[8];
#pragma unroll
        for (int u = 0; u < 8; ++u) { const size_t i = i0 + (size_t)u * NT; p[u] = *(const f32x4*)(x + i * 8); q[u] = *(const f32x4*)(x + i * 8 + 4); }
#pragma unroll
        for (int u = 0; u < 8; ++u) { const size_t i = i0 + (size_t)u * NT; v4u w; w.x = cvt_pk_bf16(p[u][0], p[u][1]); w.y = cvt_pk_bf16(p[u][2], p[u][3]); w.z = cvt_pk_bf16(q[u][0], q[u][1]); w.w = cvt_pk_bf16(q[u][2], q[u][3]); *(v4u*)(xb + i * 8) = w; } }
    unsigned* ident = (unsigned*)(a.ws + WS_IDENT);
    for (size_t i = gt; i < (size_t)T_TOK; i += NT) ident[i] = (unsigned)i;
}

template <int W> __device__ __forceinline__ void pool_item(const bf16* zp  , bf16* op  , int p0  ) {
    v4u q[W + 3];
#pragma unroll
    for (int i = 0; i < W + 3; ++i) { const int ii = i < p0 + 3 ? i : p0 + 3; q[i] = *(const v4u*)(zp - (size_t)ii * DM); }
#pragma unroll
    for (int o = 0; o < 4; ++o) {
        float s[8];
#pragma unroll
        for (int j = 0; j < 8; ++j) s[j] = 0.f;
#pragma unroll
        for (int i = 3 - o; i < 3 - o + W; ++i) { const float m = (i <= p0 + 3) ? 1.0f : 0.0f;
#pragma unroll
            for (int j = 0; j < 4; ++j) { s[2 * j] += m * bf_lo(q[i][j]); s[2 * j + 1] += m * bf_hi(q[i][j]); } }
        const int p = p0 + o, nw = (p + 1) < W ? (p + 1) : W; const float inv = 1.0f / (float)nw; v4u ov;
#pragma unroll
        for (int j = 0; j < 4; ++j) ov[j] = cvt_pk_bf16(s[2 * j] * inv - bf_lo(q[3 - o][j]), s[2 * j + 1] * inv - bf_hi(q[3 - o][j]));
        *(v4u*)(op + (size_t)o * DM) = ov; }
}
__device__ __forceinline__ void pool_block(const Args& a, int pm, int g) {
    const bf16* Z = (const bf16*)(a.ws + WS_Z); bf16* P = (bf16*)(a.ws + WS_POOLED);
    const int tid = threadIdx.x;
#pragma unroll 1
    for (int q = tid; q < 64 * 32; q += NTHR) { const int c8 = q & 31, tg = q >> 5, t0 = pm * 256 + tg * 4, p0 = t0 & (SEQ - 1);
        const bf16* zp = Z + (size_t)(t0 + 3) * DM + g * 256 + c8 * 8; bf16* op = P + (size_t)t0 * DM + g * 256 + c8 * 8;
        if (g == 0) pool_item<2>(zp, op, p0); else if (g == 1) pool_item<4>(zp, op, p0); else if (g == 2) pool_item<8>(zp, op, p0); else pool_item<16>(zp, op, p0); }
    VM_WAIT(); __syncthreads();
}
__device__ __forceinline__ void phase_pool(const Args& a, int vcu, int G) {
    const bf16* Z = (const bf16*)(a.ws + WS_Z); bf16* P = (bf16*)(a.ws + WS_POOLED);
    const int tid = threadIdx.x, wave = tid >> 6, lane = tid & 63;
    const int gw = vcu * NWAVES + wave, NGW = G * NWAVES;
    for (int it = gw; it < (T_TOK / 4) * 2; it += NGW) {
        const int t0 = (it >> 1) * 4, c8 = (it & 1) * 64 + lane, g = c8 >> 5, p0 = t0 & (SEQ - 1);
        const bf16* zp = Z + (size_t)(t0 + 3) * DM + c8 * 8; bf16* op = P + (size_t)t0 * DM + c8 * 8;
        if (g == 0) pool_item<2>(zp, op, p0); else if (g == 1) pool_item<4>(zp, op, p0); else if (g == 2) pool_item<8>(zp, op, p0); else pool_item<16>(zp, op, p0);
    }
}

template <int R, int MODE> __device__ __forceinline__ void ln_rows_store(float (&v)[R][16], const float* g, const float* b, float* const (&of)[R], bf16* const (&obf)[R], unsigned char* const (&o8)[R], int lane) {
    float s[R], s2[R];
#pragma unroll
    for (int r = 0; r < R; ++r) { s[r] = 0.f;
#pragma unroll
        for (int i = 0; i < 16; ++i) s[r] += v[r][i]; }
#pragma unroll
    for (int o = 1; o < 64; o <<= 1)
#pragma unroll
        for (int r = 0; r < R; ++r) s[r] += __shfl_xor(s[r], o);
#pragma unroll
    for (int r = 0; r < R; ++r) { const float mean = s[r] * (1.0f / DM); s2[r] = 0.f;
#pragma unroll
        for (int i = 0; i < 16; ++i) { v[r][i] -= mean; s2[r] += v[r][i] * v[r][i]; } }
#pragma unroll
    for (int o = 1; o < 64; o <<= 1)
#pragma unroll
        for (int r = 0; r < R; ++r) s2[r] += __shfl_xor(s2[r], o);
#pragma unroll
    for (int j = 0; j < 2; ++j) { const int c = 8 * lane + 512 * j;
        const f32x4 g0 = *(const f32x4*)(g + c), g1 = *(const f32x4*)(g + c + 4), b0 = *(const f32x4*)(b + c), b1 = *(const f32x4*)(b + c + 4);
#pragma unroll
        for (int r = 0; r < R; ++r) { const float rstd = 1.0f / sqrtf(s2[r] * (1.0f / DM) + LN_EPS); f32x4 y0, y1;
#pragma unroll
            for (int q = 0; q < 4; ++q) { y0[q] = v[r][8 * j + q] * rstd * g0[q] + b0[q]; y1[q] = v[r][8 * j + 4 + q] * rstd * g1[q] + b1[q]; }
            if constexpr (MODE & 1) { *(f32x4*)(of[r] + c) = y0; *(f32x4*)(of[r] + c + 4) = y1; }
            if constexpr (MODE & 2) { v4u w; w.x = cvt_pk_bf16(y0[0], y0[1]); w.y = cvt_pk_bf16(y0[2], y0[3]); w.z = cvt_pk_bf16(y1[0], y1[1]); w.w = cvt_pk_bf16(y1[2], y1[3]); *(v4u*)(obf[r] + c) = w; }
            if constexpr (MODE & 4) { int t0 = 0, t1 = 0; t0 = __builtin_amdgcn_cvt_pk_fp8_f32(y0[0], y0[1], t0, false); t0 = __builtin_amdgcn_cvt_pk_fp8_f32(y0[2], y0[3], t0, true); t1 = __builtin_amdgcn_cvt_pk_fp8_f32(y1[0], y1[1], t1, false); t1 = __builtin_amdgcn_cvt_pk_fp8_f32(y1[2], y1[3], t1, true);
                *(v2u*)(o8[r] + c) = (v2u){(unsigned)t0, (unsigned)t1}; } } }
}

__device__ __forceinline__ void phase_lnr(const Args& a, int layer, LAS unsigned char* lds, int vcu, int G, bool dry) {
    const int tid = threadIdx.x, lane = tid & 63, wave = __builtin_amdgcn_readfirstlane(tid >> 6);
    const bf16* xin = (const bf16*)(a.ws + WS_XR); float* xf = dry ? (float*)(a.ws + WS_Y) : a.out; bf16* xb = dry ? (bf16*)(a.ws + WS_Y + 72 * MiB) : (bf16*)(a.ws + WS_XB);
    const float* lng = a.in[I_LNMG] + layer * DM; const float* lnb = a.in[I_LNMB] + layer * DM;
    const float* Wr = a.in[I_WR] + (size_t)layer * DM * NE; const float* rbias = a.in[I_RB] + layer * NE;
    unsigned* gcount = (unsigned*)(a.ws + WS_CTL) + CW_CNT + layer * 64 + (dry ? 128 : 0);
    unsigned* rowtok = dry ? (unsigned*)(a.ws + WS_Y + 64 * MiB) : (unsigned*)(a.ws + WS_ROWTOK); unsigned* dest = dry ? (unsigned*)(a.ws + WS_Y + 68 * MiB) : (unsigned*)(a.ws + WS_DEST); float* gatev = dry ? (float*)(a.ws + WS_Y + 69 * MiB) : (float*)(a.ws + WS_GATE);
    LAS float* part = (LAS float*)lds;
    LAS unsigned* hist = (LAS unsigned*)(lds + 65536);
    LAS unsigned* basep = (LAS unsigned*)(lds + 65536 + 256);
    { const int blk = vcu;
        const int row0 = blk * 64;
        if (tid < 64) hist[tid] = 0u;
        { float v[8][16]; float* of[8]; bf16* obf[8]; unsigned char* o8[8];
#pragma unroll
            for (int r = 0; r < 8; ++r) { const int rr = wave * 8 + r; const bf16* xr = xin + (size_t)(row0 + rr) * DM; of[r] = xf + (size_t)(row0 + rr) * DM; obf[r] = nullptr; o8[r] = (unsigned char*)xb + (size_t)(row0 + rr) * DM;
#pragma unroll
                for (int j = 0; j < 2; ++j) { const v4u p = *(const v4u*)(xr + 8 * lane + 512 * j);
#pragma unroll
                    for (int i = 0; i < 4; ++i) { v[r][8 * j + 2 * i] = bf_lo(p[i]); v[r][8 * j + 2 * i + 1] = bf_hi(p[i]); } } }
            ln_rows_store<8, 5>(v, lng, lnb, of, obf, o8, lane); }
        VM_WAIT(); __syncthreads();
#ifndef DRY_PARTS
#define DRY_PARTS 7
#endif
        if (!dry || (DRY_PARTS & 2)) { const int kq = wave & 3, mh = wave >> 2, r = lane & 15, g = lane >> 4;
          f32x4 acc[2][4];
#pragma unroll
          for (int m = 0; m < 2; ++m)
#pragma unroll
              for (int n = 0; n < 4; ++n) acc[m][n] = (f32x4){0.f, 0.f, 0.f, 0.f};
          const float* arow = xf + (size_t)(row0 + 32 * mh + r) * DM + kq * 256 + 8 * g;
          const bf16* bh = (const bf16*)(a.ws + WS_WRT) + (size_t)layer * 2 * 65536 + (size_t)r * 1024 + kq * 256 + 8 * g; const bf16* bl = bh + 65536;
          f32x4 a0[2], a1[2]; bf16x8 wh[4], wl[4];
#pragma unroll
          for (int m = 0; m < 2; ++m) { a0[m] = *(const f32x4*)(arow + (size_t)m * 16 * DM); a1[m] = *(const f32x4*)(arow + (size_t)m * 16 * DM + 4); }
#pragma unroll
          for (int n = 0; n < 4; ++n) { wh[n] = *(const bf16x8*)(bh + (size_t)n * 16384); wl[n] = *(const bf16x8*)(bl + (size_t)n * 16384); }
#pragma unroll 1
          for (int s = 0; s < 8; ++s) { const int sn = s < 7 ? s + 1 : s;
              f32x4 n0[2], n1[2]; bf16x8 nh[4], nl[4];
#pragma unroll
              for (int m = 0; m < 2; ++m) { n0[m] = *(const f32x4*)(arow + (size_t)m * 16 * DM + 32 * sn); n1[m] = *(const f32x4*)(arow + (size_t)m * 16 * DM + 32 * sn + 4); }
#pragma unroll
              for (int n = 0; n < 4; ++n) { nh[n] = *(const bf16x8*)(bh + (size_t)n * 16384 + 32 * sn); nl[n] = *(const bf16x8*)(bl + (size_t)n * 16384 + 32 * sn); }
#pragma unroll
              for (int m = 0; m < 2; ++m) {
                  v4u hi, lo; hi.x = cvt_pk_bf16(a0[m][0], a0[m][1]); hi.y = cvt_pk_bf16(a0[m][2], a0[m][3]); hi.z = cvt_pk_bf16(a1[m][0], a1[m][1]); hi.w = cvt_pk_bf16(a1[m][2], a1[m][3]);
                  lo.x = cvt_pk_bf16(a0[m][0] - bf_lo(hi.x), a0[m][1] - bf_hi(hi.x)); lo.y = cvt_pk_bf16(a0[m][2] - bf_lo(hi.y), a0[m][3] - bf_hi(hi.y));
                  lo.z = cvt_pk_bf16(a1[m][0] - bf_lo(hi.z), a1[m][1] - bf_hi(hi.z)); lo.w = cvt_pk_bf16(a1[m][2] - bf_lo(hi.w), a1[m][3] - bf_hi(hi.w));
                  const bf16x8 ah = __builtin_bit_cast(bf16x8, hi), al = __builtin_bit_cast(bf16x8, lo);
#pragma unroll
                  for (int n = 0; n < 4; ++n) { acc[m][n] = __builtin_amdgcn_mfma_f32_16x16x32_bf16(ah, wh[n], acc[m][n], 0, 0, 0); acc[m][n] = __builtin_amdgcn_mfma_f32_16x16x32_bf16(al, wh[n], acc[m][n], 0, 0, 0); acc[m][n] = __builtin_amdgcn_mfma_f32_16x16x32_bf16(ah, wl[n], acc[m][n], 0, 0, 0); } }
#pragma unroll
              for (int m = 0; m < 2; ++m) { a0[m] = n0[m]; a1[m] = n1[m]; }
#pragma unroll
              for (int n = 0; n < 4; ++n) { wh[n] = nh[n]; wl[n] = nl[n]; } }
#pragma unroll
          for (int m = 0; m < 2; ++m)
#pragma unroll
              for (int n = 0; n < 4; ++n)
#pragma unroll
                  for (int q = 0; q < 4; ++q) part[(kq * 64 + 32 * mh + 16 * m + 4 * g + q) * 64 + 16 * n + r] = acc[m][n][q]; }
        __syncthreads();
        if (!dry || (DRY_PARTS & 4)) { const int row = tid >> 3, grp = tid & 7; float sc[8], bsd[8];
#pragma unroll
          for (int i = 0; i < 8; ++i) { const int e = 8 * grp + i; const float lg = (part[row * 64 + e] + part[(64 + row) * 64 + e]) + (part[(128 + row) * 64 + e] + part[(192 + row) * 64 + e]); sc[i] = 1.0f / (1.0f + __expf(-lg)); bsd[i] = sc[i] + rbias[e]; }
          float m1 = -INFINITY, m2 = -INFINITY;
#pragma unroll
          for (int i = 0; i < 8; ++i) { const float v = bsd[i]; if (v > m1) { m2 = m1; m1 = v; } else if (v > m2) m2 = v; }
          const float myg = m1 + m2;
          int grank = 0;
#pragma unroll
          for (int d = 1; d < 8; ++d) { const float o = __shfl(myg, (lane & ~7) | ((grp + d) & 7)); const int g2 = (grp + d) & 7; grank += (o > myg || (o == myg && g2 < grp)) ? 1 : 0; }
          const bool gsel = grank < 4;
          float cand[8]; int rk[8]; bool sel[8];
#pragma unroll
          for (int i = 0; i < 8; ++i) { cand[i] = gsel ? bsd[i] : -INFINITY; rk[i] = 0; sel[i] = false; }
#pragma unroll 1
          for (int k = 0; k < TOPK; ++k) {
              float best = cand[0]; int bi = 0;
#pragma unroll
              for (int i = 1; i < 8; ++i) if (cand[i] > best) { best = cand[i]; bi = i; }
              int gi = 8 * grp + bi;
#define LNR_RED(CTRL) { const float ov = __builtin_bit_cast(float, __builtin_amdgcn_update_dpp(0, __builtin_bit_cast(int, best), CTRL, 0xF, 0xF, false)); const int oi = __builtin_amdgcn_update_dpp(0, gi, CTRL, 0xF, 0xF, false); if (ov > best || (ov == best && oi < gi)) { best = ov; gi = oi; } }
              LNR_RED(0xB1) LNR_RED(0x4E) LNR_RED(0x141)
#undef LNR_RED
#pragma unroll
              for (int i = 0; i < 8; ++i) if (gi == 8 * grp + i) { cand[i] = -INFINITY; rk[i] = k; sel[i] = true; }
          }
          float psum = 0.f;
#pragma unroll
          for (int i = 0; i < 8; ++i) psum += sel[i] ? sc[i] : 0.f;
          psum += __shfl_xor(psum, 1); psum += __shfl_xor(psum, 2); psum += __shfl_xor(psum, 4);
          const float inv = ROUTED_SCALE / psum;
          unsigned loc[8];
#pragma unroll
          for (int i = 0; i < 8; ++i) { loc[i] = 0u; if (sel[i]) loc[i] = __hip_atomic_fetch_add(hist + 8 * grp + i, 1u, __ATOMIC_RELAXED, __HIP_MEMORY_SCOPE_WORKGROUP); }
          __syncthreads();
          if (tid < 64) { const unsigned h = hist[tid]; basep[tid] = h ? __hip_atomic_fetch_add(gcount + tid, h, RLX_AGENT) : 0u; }
          __syncthreads();
          const int tok = row0 + row;
#pragma unroll
          for (int i = 0; i < 8; ++i) if (sel[i]) { const int e = 8 * grp + i; const unsigned pos = basep[e] + loc[i];
              rowtok[(size_t)e * CAP + pos] = (unsigned)tok; dest[tok * 8 + rk[i]] = ((unsigned)e << 16) | pos; gatev[tok * 8 + rk[i]] = sc[i] * inv; }
        }
        __syncthreads();
    }
}

__device__ __forceinline__ pg8::MoeInfo moe_setup(const Args& a, int layer, LAS unsigned char* misc) {
    const int tid = threadIdx.x;
    unsigned* gcount = (unsigned*)(a.ws + WS_CTL) + CW_CNT + layer * 64;
    LAS unsigned* cnt = (LAS unsigned*)(misc + MI_CNT); LAS unsigned* tstart = (LAS unsigned*)(misc + MI_TSTART); LAS unsigned* ystart = (LAS unsigned*)(misc + MI_YSTART);
    LAS unsigned* ntl = (LAS unsigned*)(misc + MI_NTILES); LAS unsigned char* tile_e = (LAS unsigned char*)(misc + MI_TILE_E);
    __syncthreads();
    if (tid < 64) { unsigned c = __hip_atomic_load(gcount + tid, RLX_AGENT); if (c > (unsigned)CAP) c = CAP; cnt[tid] = c; }
    __syncthreads();
    if (tid < 64) { unsigned ts = 64u, ys = 0u; for (int e = 0; e < tid; ++e) { const unsigned c = cnt[e]; ts += (c + 255u) >> 8; ys += c; }
        tstart[tid] = ts; ystart[tid] = ys; const unsigned mynt = (cnt[tid] + 255u) >> 8;
        for (unsigned i = 0; i < mynt; ++i) if (ts + i < 640u) tile_e[ts + i] = (unsigned char)tid;
        if (tid == 63) ntl[0] = ts + mynt; }
    __syncthreads();
    pg8::MoeInfo mi; mi.cnt = cnt; mi.tstart = tstart; mi.ystart = ystart; mi.tile_e = tile_e; mi.ntiles = __builtin_amdgcn_readfirstlane((int)ntl[0]);
    if (mi.ntiles > 640) mi.ntiles = 640;
    return mi;
}

__device__ __forceinline__ void phase_combine(const Args& a, int layer, LAS unsigned char* misc, int vcu, int G, bool dry) {
    const int tid = threadIdx.x, lane = tid & 63, wave = __builtin_amdgcn_readfirstlane(tid >> 6);
    const pg8::MoeInfo mi = moe_setup(a, layer, misc);
    float* xf = a.out; bf16* xb = (bf16*)(a.ws + WS_XB); const unsigned char* Y8 = (const unsigned char*)(a.ws + WS_Y);
    const unsigned* dest = (const unsigned*)(a.ws + WS_DEST); const float* gatev = (const float*)(a.ws + WS_GATE);
    const float* lng = a.in[I_LNFG] + layer * DM; const float* lnb = a.in[I_LNFB] + layer * DM;
    const int gw = vcu * NWAVES + wave, NGW = G * NWAVES;
#pragma unroll 1
    for (int rowa = gw; rowa < T_TOK; rowa += 2 * NGW) {
        float v[2][16]; float* of[2]; bf16* obf[2]; unsigned char* o8[2]; unsigned d[2][TOPK]; float gk[2][TOPK];
#pragma unroll
        for (int r = 0; r < 2; ++r) { const int row = rowa + r * NGW;
#pragma unroll
            for (int k = 0; k < TOPK; ++k) { d[r][k] = dest[row * 8 + k]; gk[r][k] = gatev[row * 8 + k]; } }
#pragma unroll
        for (int r = 0; r < 2; ++r) { const int row = rowa + r * NGW; float* xr = xf + (size_t)row * DM; of[r] = dry ? (float*)(a.ws + WS_H) + (size_t)row * DM : xr; obf[r] = (bf16*)(a.ws + WS_XR) + (size_t)row * DM; o8[r] = (unsigned char*)xb + (size_t)row * DM;
#pragma unroll
            for (int j = 0; j < 2; ++j) { const f32x4 p = *(const f32x4*)(xr + 8 * lane + 512 * j), q = *(const f32x4*)(xr + 8 * lane + 512 * j + 4);
#pragma unroll
                for (int i = 0; i < 4; ++i) { v[r][8 * j + i] = p[i] * ALPHA; v[r][8 * j + 4 + i] = q[i] * ALPHA; } } }
#pragma unroll
        for (int r = 0; r < 2; ++r) { const unsigned char* yr = Y8 + (size_t)(131072 + rowa + r * NGW) * DM;
#pragma unroll
            for (int j = 0; j < 2; ++j) { const v2u w = *(const v2u*)(yr + 8 * lane + 512 * j);
#pragma unroll
                for (int q = 0; q < 2; ++q) { const f32x2 lo2 = __builtin_amdgcn_cvt_pk_f32_fp8((int)w[q], false), hi2 = __builtin_amdgcn_cvt_pk_f32_fp8((int)w[q], true);
                    v[r][8 * j + 4 * q] += 0.0625f * lo2.x; v[r][8 * j + 4 * q + 1] += 0.0625f * lo2.y; v[r][8 * j + 4 * q + 2] += 0.0625f * hi2.x; v[r][8 * j + 4 * q + 3] += 0.0625f * hi2.y; } } }
#pragma unroll
        for (int r = 0; r < 2; ++r)
#pragma unroll
            for (int k = 0; k < TOPK; ++k) { const unsigned dd = (unsigned)__builtin_amdgcn_readfirstlane((int)d[r][k]); const float g = __uint_as_float((unsigned)__builtin_amdgcn_readfirstlane((int)__float_as_uint(gk[r][k])));
                const unsigned e = (dd >> 16) & 63u, pos = dd & 0xffffu; const unsigned char* yr = Y8 + (size_t)(mi.ystart[e] + pos) * DM; const float g16 = g * 0.0625f;
#pragma unroll
                for (int j = 0; j < 2; ++j) { const v2u w = *(const v2u*)(yr + 8 * lane + 512 * j);
#pragma unroll
                    for (int q = 0; q < 2; ++q) { const f32x2 lo2 = __builtin_amdgcn_cvt_pk_f32_fp8((int)w[q], false), hi2 = __builtin_amdgcn_cvt_pk_f32_fp8((int)w[q], true);
                        v[r][8 * j + 4 * q] += g16 * lo2.x; v[r][8 * j + 4 * q + 1] += g16 * lo2.y; v[r][8 * j + 4 * q + 2] += g16 * hi2.x; v[r][8 * j + 4 * q + 3] += g16 * hi2.y; } } }
        if (layer == 0 && !dry) ln_rows_store<2, 6>(v, lng, lnb, of, obf, o8, lane);
        else ln_rows_store<2, 1>(v, lng, lnb, of, obf, o8, lane);
    }
}

__device__ __forceinline__ int swz16(int row) { return (row ^ (row >> 4)) & 15; }
__device__ __forceinline__ void phase_sgu_spatial(const Args& a, LAS unsigned char* lds, int vcu, int G) {
    const int tid = threadIdx.x, lane = tid & 63, wave = __builtin_amdgcn_readfirstlane(tid >> 6), fr = lane & 15, fq = lane >> 4;
    const bf16* HS = (const bf16*)(a.ws + WS_HS); bf16* GT = (bf16*)(a.ws + WS_GATED);
    const float* lng = a.in[I_SLNG]; const float* lnb = a.in[I_SLNB]; const float* WS = a.in[I_SWS]; const float* BS = a.in[I_SBS];
    LAS unsigned char* Bs = lds;
    LAS unsigned char* As = lds + 65536;
    LAS float* stm = (LAS float*)(lds + 98304);
    LAS float* str = (LAS float*)(lds + 98304 + 512);
    for (int item = vcu; item < 512; item += G) {
        const int chunk = item >> 2, h = item & 3, t0 = chunk * 128;
        __syncthreads();
        if (tid < 128) { const f32x4* vs = (const f32x4*)((const float*)(a.ws + WS_VSTAT) + (size_t)(t0 + tid) * 64); float S = 0.f, Q = 0.f;
#pragma unroll
            for (int i = 0; i < 16; ++i) { const f32x4 p = vs[i]; S += p[0] + p[2]; Q += p[1] + p[3]; }
            const float mean = S * (1.0f / SGU_W); const float var = Q * (1.0f / SGU_W) - mean * mean;
            stm[tid] = mean; str[tid] = 1.0f / sqrtf((var > 0.f ? var : 0.f) + LN_EPS); }
        for (int q = tid; q < 128 * 16; q += NTHR) { const int i = q >> 4, jc = q & 15; const float* wp = WS + ((size_t)h * 128 + i) * 128 + 8 * jc;
            const f32x4 p0 = *(const f32x4*)wp, p1 = *(const f32x4*)(wp + 4); float w8[8];
#pragma unroll
            for (int z = 0; z < 4; ++z) { w8[z] = (8 * jc + z <= i) ? p0[z] : 0.f; w8[4 + z] = (8 * jc + 4 + z <= i) ? p1[z] : 0.f; }
            v4u o; o.x = cvt_pk_bf16(w8[0], w8[1]); o.y = cvt_pk_bf16(w8[2], w8[3]); o.z = cvt_pk_bf16(w8[4], w8[5]); o.w = cvt_pk_bf16(w8[6], w8[7]);
            *(LAS v4u*)(As + i * 256 + ((jc ^ swz16(i)) << 4)) = o; }
        __syncthreads();
        for (int hh = 0; hh < 2; ++hh) {
            const int cb = h * SGU_HD + hh * 256;
#pragma unroll 2
            for (int q = tid; q < 64 * 32; q += NTHR) { const int c8 = q & 31, jp = q >> 5, j0 = 2 * jp;
                const v4u w0 = *(const v4u*)(HS + (size_t)(t0 + j0) * 4096 + SGU_W + cb + 8 * c8), w1 = *(const v4u*)(HS + (size_t)(t0 + j0 + 1) * 4096 + SGU_W + cb + 8 * c8);
                const f32x4 g0 = *(const f32x4*)(lng + cb + 8 * c8), g1 = *(const f32x4*)(lng + cb + 8 * c8 + 4), b0 = *(const f32x4*)(lnb + cb + 8 * c8), b1 = *(const f32x4*)(lnb + cb + 8 * c8 + 4);
                const float m0 = stm[j0], r0 = str[j0], m1 = stm[j0 + 1], r1 = str[j0 + 1];
#pragma unroll
                for (int z = 0; z < 8; ++z) { const float gz = z < 4 ? g0[z & 3] : g1[z & 3], bz = z < 4 ? b0[z & 3] : b1[z & 3];
                    const float xa = (z & 1) ? bf_hi(w0[z >> 1]) : bf_lo(w0[z >> 1]), xc = (z & 1) ? bf_hi(w1[z >> 1]) : bf_lo(w1[z >> 1]);
                    const float ya = (xa - m0) * r0 * gz + bz, yc = (xc - m1) * r1 * gz + bz;
                    const int cc = 8 * c8 + z, slot = (cc & ~31) | (((cc >> 2) & 1) << 4) | (((cc >> 3) & 3) << 2) | (cc & 3);
                    *(LAS unsigned*)(Bs + slot * 256 + (((j0 >> 3) ^ swz16(slot)) << 4) + (j0 & 7) * 2) = cvt_pk_bf16(ya, yc); } }
            __syncthreads();
            f32x4 acc[8][2]; bf16x8 Bf[2][4];
#pragma unroll
            for (int n = 0; n < 2; ++n)
#pragma unroll
                for (int s = 0; s < 4; ++s) { const int slot = 32 * wave + 16 * n + fr; Bf[n][s] = *(const LAS bf16x8*)(Bs + slot * 256 + (((4 * s + fq) ^ swz16(slot)) << 4)); }
#pragma unroll
            for (int m = 0; m < 8; ++m) { acc[m][0] = (f32x4){0.f, 0.f, 0.f, 0.f}; acc[m][1] = (f32x4){0.f, 0.f, 0.f, 0.f};
#pragma unroll
                for (int s = 0; s < 4; ++s) if (s <= (m >> 1)) { const int i = 16 * m + fr; const bf16x8 af = *(const LAS bf16x8*)(As + i * 256 + (((4 * s + fq) ^ swz16(i)) << 4));
                    acc[m][0] = __builtin_amdgcn_mfma_f32_16x16x32_bf16(Bf[0][s], af, acc[m][0], 0, 0, 0); acc[m][1] = __builtin_amdgcn_mfma_f32_16x16x32_bf16(Bf[1][s], af, acc[m][1], 0, 0, 0); } }
#pragma unroll
            for (int m = 0; m < 8; ++m) { const int i = 16 * m + fr; const float bsv = BS[h * 128 + i]; const size_t t = (size_t)(t0 + i);
                const v4u uw = *(const v4u*)(HS + t * 4096 + cb + 32 * wave + 8 * fq); float o[8];
#pragma unroll
                for (int n = 0; n < 2; ++n)
#pragma unroll
                    for (int z = 0; z < 4; ++z) { const int c = 4 * n + z; const float uu = (c & 1) ? bf_hi(uw[c >> 1]) : bf_lo(uw[c >> 1]); o[c] = uu * (acc[m][n][z] + bsv); }
                v4u w; w.x = cvt_pk_bf16(o[0], o[1]); w.y = cvt_pk_bf16(o[2], o[3]); w.z = cvt_pk_bf16(o[4], o[5]); w.w = cvt_pk_bf16(o[6], o[7]);
                *(v4u*)(GT + t * SGU_W + cb + 32 * wave + 8 * fq) = w; }
            __syncthreads();
        }
    }
}

__device__ __forceinline__ void phase_flush(const Args& a, int vcu, int G) {
    const size_t gt = (size_t)vcu * NTHR + threadIdx.x, NT = (size_t)G * NTHR; f32x4 acc = (f32x4){0.f, 0.f, 0.f, 0.f};
    const f32x4* p0 = (const f32x4*)a.in[I_WG]; const f32x4* p1 = (const f32x4*)a.in[I_WU];
    for (size_t i = gt; i < (size_t)33554432 / 4; i += 4 * NT) { const f32x4 x0 = p0[i], x1 = p0[i + NT], x2 = p0[i + 2 * NT], x3 = p0[i + 3 * NT], y0 = p1[i], y1 = p1[i + NT], y2 = p1[i + 2 * NT], y3 = p1[i + 3 * NT]; acc += x0 + x1 + x2 + x3 + y0 + y1 + y2 + y3; }
    if (acc[0] + acc[1] + acc[2] + acc[3] == 1.2345e-30f) ((float*)(a.ws + WS_CTL))[16000] = acc[0];
}
constexpr int N_PHASES = 16;
__global__ void __launch_bounds__(NTHR, 2) mk_fwd(Args args) {
    extern __shared__ __attribute__((aligned(16))) unsigned char lds_raw[];
    LAS unsigned char* lds = (LAS unsigned char*)lds_raw;
    LAS unsigned char* misc = lds + MISC_OFF;
    const int tid = threadIdx.x;
    const int G = gridDim.x; const int bx = blockIdx.x; const int vcu = (G % 8 == 0) ? (bx % 8) * (G / 8) + bx / 8 : bx;
    unsigned char* ws = args.ws;
    unsigned* ctl = (unsigned*)(ws + WS_CTL);
    if (tid < 16) ((LAS unsigned*)(misc + MI_BARW))[tid] = 0u;
    __syncthreads();
    const int lo = args.ph_lo, hi = args.ph_hi;
    XcdBarrier bar; bar.bar = ctl + CW_BAR; bar.x = 0; bar.st = nullptr;
    if (hi - lo > 1) bar = xcd_barrier_post(ctl + CW_BAR, (volatile LAS unsigned*)(misc + MI_BARW));
#ifndef PH_MASK
#define PH_MASK 0xFFFF
#endif
#define IN(k) (((PH_MASK >> (k)) & 1) && lo <= (k) && (k) < hi)
#ifndef TS_A0
#define TS_A0 -1
#define TS_A1 -1
#define TS_M 1
#endif
    unsigned long long* tsbuf = (unsigned long long*)(ws + 32768);
#define TS_REC(k) do { if (TS_A0 >= 0 && bx == 0 && tid == 0) __hip_atomic_store(tsbuf + (k), (unsigned long long)__builtin_amdgcn_s_memrealtime(), RLX_AGENT); } while (0)
    TS_REC(0);
#ifndef REP_PH
#define REP_PH -1
#define REP_N 1
#endif
#define NREP(k) ((k) == REP_PH ? REP_N : 1)
#ifndef FLUSH_PH
#define FLUSH_PH -2
#endif
#define RUN(k) if (IN(k)) for (int rep = 0; rep < NREP(k); ++rep) if ((((k) == FLUSH_PH && rep == NREP(k) - 1) ? (xcd_barrier(bar), phase_flush(args, vcu, G), xcd_barrier(bar), true) : true))
#define DRY(k) (rep + 1 < NREP(k))
#define BG_LAYER(k) (-1)
#define SEAM(k) do { if (IN(k) && IN((k) + 1)) xcd_barrier(bar, &args, BG_LAYER(k), lds); TS_REC((k) + 1); } while (0)
    using namespace pg8;
    RUN(0) { phase_p0(args, lds, vcu, G); } SEAM(0);
    RUN(1) { DenseSched S{(const char*)(ws + WS_XB), (const char*)(ws + WS_WIN), 2048u, 2048u, 0u, 64, 4, 256, G, bx};
        EpiBf16<0, false, false> E{(bf16*)(ws + WS_Z), DM, nullptr, nullptr, nullptr};
        gemm_phase<EpiBf16<0, false, false>, DenseSched, false, true, true>(lds, 2048u, 2048u, 16, S, E); } SEAM(1);
    if (REP_PH == 100 && hi - lo > 1) for (int i = 0; i < REP_N; ++i) xcd_barrier(bar);
    RUN(3) { DenseSched S{(const char*)(ws + WS_POOLED), (const char*)(ws + WS_WGRP), 2048u, 512u, 512u, 64, 4, 256, G, bx};
        { Unit u0; if (S.next(0, u0)) pool_block(args, u0.i0, u0.i1); }
        EpiBf16<0, false, true> E{(bf16*)(ws + WS_YP), DM, nullptr, args.in[I_PSCALE], nullptr};
        gemm_phase<EpiBf16<0, false, true>, DenseSched, false, true, true>(lds, 2048u, 512u, 4, S, E); } SEAM(3);
    RUN(4) { DenseSched S{(const char*)(ws + WS_YP), (const char*)(ws + WS_WOUT), 2048u, 2048u, 0u, 64, 4, 256, G, bx};
        EpiResidB<false> E{args.in[I_X], (bf16*)(ws + WS_XR)};
        gemm_phase<EpiResidB<false>, DenseSched, false, true, true>(lds, 2048u, 2048u, 16, S, E); } SEAM(4);
#define MOE_PHASES(layer, pb) do { \
        RUN(pb) { phase_lnr(args, layer, lds, vcu, G, DRY(pb)); } SEAM(pb); \
        RUN((pb) + 1) { const MoeInfo mi = moe_setup(args, layer, misc); \
            G1Sched S{mi, (const char*)(ws + WS_XB), (const char*)(ws + WS_WGU + (size_t)layer * WS_MOE_LSTRIDE), (const unsigned*)(ws + WS_ROWTOK), (const unsigned*)(ws + WS_IDENT), G, vcu}; \
            EpiSwiglu E{(unsigned char*)(ws + WS_H)}; \
            gemm_phase<EpiSwiglu, G1Sched, true, true, false, 0, 1>(lds, 1024u, 1024u, 8, S, E); } SEAM((pb) + 1); \
        if (IN((pb) + 2) && REP_PH == (pb) + 2) { const MoeInfo mi = moe_setup(args, layer, misc); \
            G2Sched S{mi, (const char*)(ws + WS_H), (const char*)(ws + WS_WDN + (size_t)layer * WS_MOE_LSTRIDE), G, vcu, 256}; \
            EpiDown E{(unsigned char*)(ws + WS_Y)}; \
            gemm_phase<EpiDown, G2Sched, false, true, true, 1, 1>(lds, 256u, 256u, 2, S, E); } \
        if (IN((pb) + 2)) { const MoeInfo mi = moe_setup(args, layer, misc); \
            G2Sched S{mi, (const char*)(ws + WS_H), (const char*)(ws + WS_WDN + (size_t)layer * WS_MOE_LSTRIDE), G, vcu, 0}; \
            EpiDown E{(unsigned char*)(ws + WS_Y)}; \
            gemm_phase<EpiDown, G2Sched, false, true, true, 1, 1>(lds, 256u, 256u, 2, S, E); } SEAM((pb) + 2); \
        RUN((pb) + 3) { phase_combine(args, layer, misc, vcu, G, DRY((pb) + 3)); if (layer == 0 && !DRY((pb) + 3)) { __syncthreads(); convert_static(args, 1, lds, vcu, G); } } \
    } while (0)
    MOE_PHASES(0, 5); SEAM(8);
    RUN(9) { DenseSched S{(const char*)(ws + WS_XB), (const char*)(ws + WS_WSIN), 1024u, 1024u, 0u, 64, 16, 1024, G, bx, (const unsigned*)(ws + WS_IDENT)};
        EpiBf16<1, true, false, true, true> E{(bf16*)(ws + WS_HS), 4096, args.in[I_SBIN], nullptr, (float*)(ws + WS_VSTAT)};
        gemm_phase<EpiBf16<1, true, false, true, true>, DenseSched, true, true, false, 0, 1>(lds, 1024u, 1024u, 8, S, E); } SEAM(9);
    RUN(10) { phase_sgu_spatial(args, lds, vcu, G); } SEAM(10);
    RUN(11) { DenseSched S{(const char*)(ws + WS_GATED), (const char*)(ws + WS_WSOUT), 4096u, 4096u, 0u, 64, 4, 256, G, bx};
        EpiResidB<true> E{ws + WS_XR, (bf16*)(ws + WS_XR)};
        gemm_phase<EpiResidB<true>, DenseSched, false, true, true>(lds, 4096u, 4096u, 32, S, E); } SEAM(11);
    MOE_PHASES(1, 12);
#undef MOE_PHASES
    if (TS_A0 >= 0 && bx == 0 && tid == 0) {
        const unsigned long long tend = __builtin_amdgcn_s_memrealtime();
        const unsigned long long t0 = __hip_atomic_load(tsbuf + TS_A0, RLX_AGENT), t1 = (TS_A1 + 1 >= N_PHASES) ? tend : __hip_atomic_load(tsbuf + TS_A1 + 1, RLX_AGENT);
        const unsigned long long wait = (t1 - t0) * TS_M;
        while (__builtin_amdgcn_s_memrealtime() - tend < wait) __builtin_amdgcn_s_sleep(8);
    }
#undef IN
#undef SEAM
}

extern "C" void kernel_launch(void* const* d_in, const int* in_sizes, int n_in, void* d_out, int out_size, void* d_ws, size_t ws_size, hipStream_t stream) {
    static int grid = 0;
    if (grid == 0) {
        if (n_in != 24 || out_size != T_TOK * DM || ws_size < WS_END) { fprintf(stderr, "kernel_launch: unexpected shapes (n_in %d out %d ws %zu)\n", n_in, out_size, ws_size); grid = -1; return; }
        int dev = 0, cus = 0;
        if (hipGetDevice(&dev) != hipSuccess || hipDeviceGetAttribute(&cus, hipDeviceAttributeMultiprocessorCount, dev) != hipSuccess) { grid = -1; return; }
        if (hipFuncSetAttribute((const void*)mk_fwd, hipFuncAttributeMaxDynamicSharedMemorySize, LDS_BYTES) != hipSuccess) { fprintf(stderr, "kernel_launch: hipFuncSetAttribute failed\n"); grid = -1; return; }
        int per_cu = 0;
        if (hipOccupancyMaxActiveBlocksPerMultiprocessor(&per_cu, (const void*)mk_fwd, NTHR, LDS_BYTES) != hipSuccess || per_cu < 1) fprintf(stderr, "kernel_launch: occupancy query says %d\n", per_cu);
        (void)hipGetLastError();
        grid = cus;
        if (grid != 256) { fprintf(stderr, "kernel_launch: built for a 256-CU device (got %d)\n", cus); grid = -1; return; }
    }
    if (grid < 0) return;
    (void)hipMemsetAsync((char*)d_ws + WS_CTL, 0, CTL_ZERO_BYTES, stream);
    Args a{};
    for (int i = 0; i < 24; ++i) a.in[i] = (const float*)d_in[i];
    a.out = (float*)d_out; a.ws = (unsigned char*)d_ws;
#if MK_PER_PHASE
    for (int p = 0; p < N_PHASES; ++p) { a.ph_lo = p; a.ph_hi = p + 1; hipLaunchKernelGGL(mk_fwd, dim3(grid), dim3(NTHR), LDS_BYTES, stream, a); }
#else
    a.ph_lo = 0; a.ph_hi = N_PHASES; hipLaunchKernelGGL(mk_fwd, dim3(grid), dim3(NTHR), LDS_BYTES, stream, a);
#endif
}
```

```cpp
#include <hip/hip_runtime.h>
#include <cstdio>
#include <cstdint>

#ifndef MK_PER_PHASE
#define MK_PER_PHASE 0
#endif

#define GAS __attribute__((address_space(1)))
#define LAS __attribute__((address_space(3)))
typedef unsigned short bf16;
typedef unsigned v4u __attribute__((ext_vector_type(4)));
typedef unsigned v2u __attribute__((ext_vector_type(2)));
typedef float f32x4 __attribute__((ext_vector_type(4)));
typedef float f32x2 __attribute__((ext_vector_type(2)));
typedef short bf16x8 __attribute__((ext_vector_type(8)));
#define RLX_AGENT __ATOMIC_RELAXED, __HIP_MEMORY_SCOPE_AGENT
#define LDS_WAIT() asm volatile("s_waitcnt lgkmcnt(0)" ::: "memory")
#define VM_WAIT() asm volatile("s_waitcnt vmcnt(0)" ::: "memory")

constexpr int T_TOK = 16384, DM = 1024, SEQ = 4096, NE = 64, TOPK = 8, EDIM = 256;
constexpr int SGU_W = 2048, SGU_HD = 512;
constexpr float ALPHA = 1.41421356237309515f;
constexpr float LN_EPS = 1e-5f, ROUTED_SCALE = 2.5f;
constexpr int CAP = 16384;
constexpr int NWAVES = 8, NTHR = 512;

constexpr size_t MiB = 1u << 20;
constexpr size_t WS_CTL = 0, CTL_ZERO_BYTES = 65536;
constexpr size_t WS_IDENT = 256 * 1024;
constexpr size_t WS_DEST = 1 * MiB;
constexpr size_t WS_GATE = WS_DEST + 512 * 1024;
constexpr size_t WS_ROWTOK = 2 * MiB;
constexpr size_t WS_VSTAT = WS_ROWTOK;
constexpr size_t WS_WIN = 6 * MiB;
constexpr size_t WS_WGRP = 8 * MiB;
constexpr size_t WS_WOUT = WS_WGRP + 512 * 1024;
constexpr size_t WS_WSIN = WS_WOUT + 2 * MiB;
constexpr size_t WS_WSOUT = WS_WSIN + 8 * MiB;
constexpr size_t WS_WRT = WS_WSOUT + 4 * MiB;
constexpr size_t WS_WGU = 23 * MiB;
constexpr size_t WS_WDN = WS_WGU + 65 * MiB;
constexpr size_t WS_XB = 121 * MiB;
constexpr size_t WS_H = 153 * MiB;
constexpr size_t WS_Y = 233 * MiB;
constexpr size_t WS_WGU1 = 378 * MiB, WS_WDN1 = WS_WGU1 + 65 * MiB;
constexpr size_t WS_MOE_LSTRIDE = WS_WGU1 - WS_WGU;
constexpr size_t WS_XR = 476 * MiB;
constexpr size_t WS_END = 508 * MiB;
constexpr size_t WS_Z = 153 * MiB, WS_POOLED = 185 * MiB, WS_YP = 217 * MiB;
constexpr size_t WS_HS = 153 * MiB;
constexpr size_t WS_GATED = 281 * MiB;
static_assert(WS_WRT + 512 * 1024 <= WS_WGU && WS_WDN + 33 * MiB <= WS_XB && WS_XB + 32 * MiB <= WS_H && WS_H + 80 * MiB <= WS_Y && WS_Y + 145 * MiB <= WS_WGU1 && WS_WDN1 + 33 * MiB <= WS_END && WS_GATED + 64 * MiB <= WS_WGU1, "ws map");
constexpr int CW_TMO = 0, CW_BAR = 64, CW_CNT = 4096, CW_QNEXT = 4608;

constexpr int RING_BYTES = 131072;
constexpr int MISC_OFF = RING_BYTES;
constexpr int LDS_BYTES = 147456;
constexpr int MI_BARW = 0, MI_CNT = 64, MI_TSTART = 320, MI_YSTART = 576, MI_NTILES = 832, MI_TILE_E = 1024;

__device__ __forceinline__ unsigned cvt_pk_bf16(float lo, float hi) { unsigned r; asm volatile("v_cvt_pk_bf16_f32 %0, %1, %2" : "=v"(r) : "v"(lo), "v"(hi)); return r; }
__device__ __forceinline__ float bf_lo(unsigned w) { return __uint_as_float(w << 16); }
__device__ __forceinline__ float bf_hi(unsigned w) { return __uint_as_float(w & 0xffff0000u); }
__device__ __forceinline__ float wave_sum(float v) {
#pragma unroll
    for (int o = 1; o < 64; o <<= 1) v += __shfl_xor(v, o);
    return v;
}
__device__ __forceinline__ float sigmoidf_(float x) { return __builtin_amdgcn_rcpf(1.0f + __builtin_amdgcn_exp2f(-1.4426950408889634f * x)); }
__device__ __forceinline__ f32x2 gelu_tanh2(f32x2 v) { const f32x2 v2 = v * v; const f32x2 y = v * (v2 * 0.044715f + 1.0f); const f32x2 t = y * (-2.3022081983f);
    f32x2 e; e.x = __builtin_amdgcn_exp2f(t.x); e.y = __builtin_amdgcn_exp2f(t.y); const f32x2 d = e + 1.0f; f32x2 r; r.x = __builtin_amdgcn_rcpf(d.x); r.y = __builtin_amdgcn_rcpf(d.y); return v * r; }
__device__ __forceinline__ float gelu_tanh(float v) { const float y = v + 0.044715f * v * v * v; return v * __builtin_amdgcn_rcpf(1.0f + __builtin_amdgcn_exp2f(-2.3022081983f * y)); }

#define XB_TMO      128
#define XB_XCNT(j)  (256  + 64 * (j))
#define XB_XSUB(j)  (1280 + 64 * (j))
#define XB_XGEN(j)  (2304 + 64 * (j))
#define XB_TOP      3328
#define XB_TOPGEN   3392
#define XCD_BAR_WORDS 3456
#define XB_SPIN_CAP (1u << 20)
__device__ __forceinline__ unsigned xb_ld(unsigned* p)              { return __hip_atomic_load(p, __ATOMIC_RELAXED, __HIP_MEMORY_SCOPE_AGENT); }
__device__ __forceinline__ unsigned xb_add(unsigned* p, unsigned v) { return __hip_atomic_fetch_add(p, v, __ATOMIC_RELAXED, __HIP_MEMORY_SCOPE_AGENT); }
__device__ __forceinline__ unsigned xb_xcc_id() { return (unsigned)__builtin_amdgcn_s_getreg((3 << 11) | 20) & 0xFu; }
#define XB_SPIN(cond, bar) do { unsigned _sp = 0; while (cond) { __builtin_amdgcn_s_sleep(1); \
    if ((++_sp & 255u) == 0u) { if (xb_ld(&(bar)[XB_TMO])) break; if (_sp > XB_SPIN_CAP) { atomicAdd(&(bar)[XB_TMO], 1u); break; } } } } while (0)
struct XcdBarrier { unsigned* bar; unsigned x; volatile LAS unsigned* st; };
__device__ __forceinline__ XcdBarrier xcd_barrier_post(unsigned* bar, volatile LAS unsigned* st) {
    XcdBarrier b; b.bar = bar; b.x = xb_xcc_id(); b.st = st;
    if (threadIdx.x == 0) (void)xb_add(&bar[XB_XCNT(b.x)], 1u);
    return b;
}
__device__ __forceinline__ void xcd_barrier_complete(unsigned* bar, unsigned x, unsigned& nloc, unsigned& nx) {
    const unsigned G = gridDim.x * gridDim.y * gridDim.z;
    unsigned sum, cnt, mine, sp = 0u;
    for (;;) {
        sum = 0u; cnt = 0u; mine = 0u;
#pragma unroll
        for (unsigned j = 0; j < 16; ++j) { const unsigned c = xb_ld(&bar[XB_XCNT(j)]); sum += c; cnt += (c > 0u) ? 1u : 0u; mine = (j == x) ? c : mine; }
        if (sum == G) break;
        __builtin_amdgcn_s_sleep(1);
        if ((++sp & 255u) == 0u) { if (xb_ld(&bar[XB_TMO])) break; if (sp > XB_SPIN_CAP) { atomicAdd(&bar[XB_TMO], 1u); break; } }
    }
    nloc = mine > 0u ? mine : 1u; nx = cnt > 0u ? cnt : 1u;
}
struct Args;
__device__ __forceinline__ bool convert_steal(const Args& a, int layer, LAS unsigned char* lds, int wave, int lane);
__device__ __forceinline__ void xcd_barrier(const XcdBarrier& b, const Args* bga = nullptr, int bg_layer = -1, LAS unsigned char* lds = nullptr) {
    asm volatile("s_waitcnt vmcnt(0)" ::: "memory");
    __syncthreads();
    if (threadIdx.x == 0) {
        unsigned* bar = b.bar;
        __builtin_amdgcn_s_waitcnt(0);
        unsigned nloc = b.st[0], nx = b.st[1];
        if (nloc == 0u) { xcd_barrier_complete(bar, b.x, nloc, nx); b.st[0] = nloc; b.st[1] = nx; }
        const unsigned old = xb_add(&bar[XB_XSUB(b.x)], 1u);
        const unsigned gen = old / nloc;
        if (old + 1u == (gen + 1u) * nloc) {
            __builtin_amdgcn_fence(__ATOMIC_RELEASE, "agent");
            asm volatile("s_waitcnt vmcnt(0)" ::: "memory");
            const unsigned og = xb_add(&bar[XB_TOP], 1u);
            const unsigned tg = og / nx;
            if (og + 1u == (tg + 1u) * nx) xb_add(&bar[XB_TOPGEN], 1u);
            else XB_SPIN(xb_ld(&bar[XB_TOPGEN]) == tg, bar);
            __builtin_amdgcn_fence(__ATOMIC_ACQUIRE, "agent");
            xb_add(&bar[XB_XGEN(b.x)], 1u);
            asm volatile("s_waitcnt vmcnt(0)" ::: "memory");
            b.st[2] = 0xFFFFFFFFu;
        } else if (bg_layer < 0) {
            XB_SPIN(xb_ld(&bar[XB_XGEN(b.x)]) == gen, bar);
            __builtin_amdgcn_fence(__ATOMIC_ACQUIRE, "agent");
            asm volatile("s_waitcnt vmcnt(0)" ::: "memory");
            b.st[2] = 0xFFFFFFFFu;
        } else b.st[2] = gen;
    }
    __syncthreads();
    if (bg_layer >= 0) {
        const unsigned gen = b.st[2];
        if (gen != 0xFFFFFFFFu) {
            const int lane = threadIdx.x & 63, wave = __builtin_amdgcn_readfirstlane(threadIdx.x >> 6);
            bool more = true;
            while (more && (unsigned)__builtin_amdgcn_readfirstlane((int)xb_ld(&b.bar[XB_XGEN(b.x)])) == gen) more = convert_steal(*bga, bg_layer, lds, wave, lane);
            asm volatile("s_waitcnt vmcnt(0)" ::: "memory");
            __syncthreads();
            if (threadIdx.x == 0) { XB_SPIN(xb_ld(&b.bar[XB_XGEN(b.x)]) == gen, b.bar); __builtin_amdgcn_fence(__ATOMIC_ACQUIRE, "agent"); asm volatile("s_waitcnt vmcnt(0)" ::: "memory"); }
        } else __syncthreads();
        __syncthreads();
    }
}

namespace pg8 {
constexpr int BM = 256, BK = 64, HALF = 128, HTB = HALF * BK * 2, STAGE_BYTES = 8 * HTB, NXCD = 8, WGM = 8;
__host__ __device__ __forceinline__ int lds_byte(int r, int c) { const int st = (r >> 4) * 2 + (c >> 5), rr = r & 15, cc = c & 31, ob = rr * 64 + cc * 2; return st * 1024 + (ob ^ (((ob >> 9) & 1) << 5)); }
__host__ __device__ __forceinline__ void stage_rc(int b, int& R, int& C) { const int st = b / 1024, sb = b % 1024, swz = sb ^ (((sb >> 9) & 1) << 5); R = (st >> 1) * 16 + swz / 64; C = (st & 1) * 32 + (swz % 64) / 2; }
__host__ __device__ __forceinline__ int perm32(int rho) { const int n = rho >> 4, i = rho & 15; return 8 * (i >> 2) + 4 * n + (i & 3); }

typedef int v8i __attribute__((ext_vector_type(8)));
typedef int v4i __attribute__((ext_vector_type(4)));
__device__ __forceinline__ v8i cat8(bf16x8 lo, bf16x8 hi) { const v4i a = __builtin_bit_cast(v4i, lo), b = __builtin_bit_cast(v4i, hi); return __builtin_shufflevector(a, b, 0, 1, 2, 3, 4, 5, 6, 7); }
struct Unit { const char* A; const char* B; const unsigned* gat; int nvalid; int i0, i1, i2; };

template <class Epi, class Sched, bool GATHER, bool ALIGN_EPI, bool SP2, int BMODE = 0, int F8 = 0>
__device__ __forceinline__ void gemm_phase(LAS unsigned char* lds, const unsigned lda, const unsigned ldb, const int nt, const Sched& S, const Epi& E) {
    const int tid = threadIdx.x, wid = __builtin_amdgcn_readfirstlane(tid >> 6), lane = tid & 63, wr = wid >> 2, wc = wid & 3, fr = lane & 15, fq = lane >> 4;
    int R0, C0, R1, C1; stage_rc(tid * 16, R0, C0); stage_rc(tid * 16 + 8192, R1, C1);
    const int Rb0 = BMODE == 0 ? (R0 & ~31) + perm32(R0 & 31) : 64 * (R0 >> 5) + 16 * ((R0 & 15) >> 2) + 4 * ((R0 >> 4) & 1) + (R0 & 3);
    const int Rb1 = BMODE == 0 ? (R1 & ~31) + perm32(R1 & 31) : 64 * (R1 >> 5) + 16 * ((R1 & 15) >> 2) + 4 * ((R1 >> 4) & 1) + (R1 & 3);
    const unsigned voffB0 = (unsigned)Rb0 * ldb + (unsigned)C0 * 2u, voffB1 = (unsigned)Rb1 * ldb + (unsigned)C1 * 2u;
    const size_t hstepB = (size_t)(BMODE == 0 ? HALF : 8) * ldb;
    const size_t kstep = (size_t)(BK * 2);
    const unsigned ldsw = (unsigned)wid * 1024u;
    const int aoff = lds_byte(wr * 64 + fr, F8 ? fq * 16 : fq * 8), boff = lds_byte(wc * 32 + fr, F8 ? fq * 16 : fq * 8);
    const int aoff2 = F8 ? lds_byte(wr * 64 + fr, fq * 16 + 8) : aoff + 1024, boff2 = F8 ? lds_byte(wc * 32 + fr, fq * 16 + 8) : boff + 1024;
#define PG8_SA(b, h) (((b) * 2 + (h)) * HTB)
#define PG8_SB(b, h) ((4 + (b) * 2 + (h)) * HTB)
#define PG8_STAGE(bufoff, gbase, v0, v1) do { unsigned _v0 = (v0), _v1 = (v1); asm volatile("" : "+v"(_v0), "+v"(_v1)); \
        __builtin_amdgcn_global_load_lds((const unsigned*)((const char*)(gbase) + _v0), (LAS unsigned*)(lds + (bufoff) + ldsw), 16, 0, 0); \
        __builtin_amdgcn_global_load_lds((const unsigned*)((const char*)(gbase) + _v1), (LAS unsigned*)(lds + (bufoff) + ldsw + 8192), 16, 0, 0); } while (0)
#define PG8_LDA(dst, b, h) do { _Pragma("unroll") for (int m = 0; m < 4; ++m) { dst[m][0] = *(const LAS bf16x8*)(lds + PG8_SA(b, h) + aoff + m * 2048); dst[m][1] = *(const LAS bf16x8*)(lds + PG8_SA(b, h) + aoff2 + m * 2048); } } while (0)
#define PG8_LDB(dst, b, h) do { _Pragma("unroll") for (int n = 0; n < 2; ++n) { dst[n][0] = *(const LAS bf16x8*)(lds + PG8_SB(b, h) + boff + n * 2048); dst[n][1] = *(const LAS bf16x8*)(lds + PG8_SB(b, h) + boff2 + n * 2048); } } while (0)
#define PG8_MMA(ai, bj, At, Bt) do { __builtin_amdgcn_s_setprio(1); _Pragma("unroll") for (int m = 0; m < 4; ++m) _Pragma("unroll") for (int n = 0; n < 2; ++n) { \
        if constexpr (F8) acc[ai][bj][m][n] = __builtin_amdgcn_mfma_scale_f32_16x16x128_f8f6f4(cat8(Bt[n][0], Bt[n][1]), cat8(At[m][0], At[m][1]), acc[ai][bj][m][n], 0, 0, 0, 0x7F7F7F7F, 0, 0x7F7F7F7F); \
        else { _Pragma("unroll") for (int k = 0; k < 2; ++k) acc[ai][bj][m][n] = __builtin_amdgcn_mfma_f32_16x16x32_bf16(Bt[n][k], At[m][k], acc[ai][bj][m][n], 0, 0, 0); } } __builtin_amdgcn_s_setprio(0); } while (0)
#define PG8_WAIT_V(n) asm volatile("s_waitcnt vmcnt(" #n ")" ::: "memory")
#define PG8_WAIT_L(n) asm volatile("s_waitcnt lgkmcnt(" #n ")" ::: "memory")
#define PG8_BAR __builtin_amdgcn_s_barrier()
#define PG8_SCHED __builtin_amdgcn_sched_barrier(0)
#define PG8_SETV(v00, v01, v10, v11, u) do { \
        if (GATHER) { int _t = tid; asm volatile("" : "+v"(_t)); int r0, c0, r1, c1; stage_rc(_t * 16, r0, c0); stage_rc(_t * 16 + 8192, r1, c1);     \
            const unsigned ta = r0 < (u).nvalid ? (u).gat[r0] : 0u, tb = r1 < (u).nvalid ? (u).gat[r1] : 0u, \
                                     tc = (HALF + r0) < (u).nvalid ? (u).gat[HALF + r0] : 0u, td = (HALF + r1) < (u).nvalid ? (u).gat[HALF + r1] : 0u; \
            v00 = ta * lda + (unsigned)c0 * 2u; v01 = tb * lda + (unsigned)c1 * 2u; v10 = tc * lda + (unsigned)c0 * 2u; v11 = td * lda + (unsigned)c1 * 2u; } \
        else { v00 = (unsigned)R0 * lda + (unsigned)C0 * 2u; v01 = (unsigned)R1 * lda + (unsigned)C1 * 2u; v10 = (unsigned)(HALF + R0) * lda + (unsigned)C0 * 2u; v11 = (unsigned)(HALF + R1) * lda + (unsigned)C1 * 2u; } } while (0)
    Unit cur, nxt; int ui = 0;
    if (!S.next(0, cur)) return;
    f32x4 acc[2][2][4][2];
#pragma unroll
    for (int a = 0; a < 2; ++a)
#pragma unroll
        for (int b = 0; b < 2; ++b)
#pragma unroll
            for (int m = 0; m < 4; ++m)
#pragma unroll
                for (int n = 0; n < 2; ++n) acc[a][b][m][n] = (f32x4){0.f, 0.f, 0.f, 0.f};
    bf16x8 At[4][2], B0[2][2], B1[2][2];
    const char* cA = cur.A; const char* cB = cur.B;
    unsigned cv00, cv01, cv10, cv11;
    PG8_SETV(cv00, cv01, cv10, cv11, cur);
    if constexpr (SP2) {
        PG8_STAGE(PG8_SB(0, 0), cB, voffB0, voffB1); PG8_STAGE(PG8_SB(0, 1), cB + hstepB, voffB0, voffB1); PG8_STAGE(PG8_SA(0, 0), cA, cv00, cv01); PG8_STAGE(PG8_SA(0, 1), cA, cv10, cv11);
        if (wr == 1) PG8_BAR;
        PG8_WAIT_V(2); PG8_BAR;
        PG8_STAGE(PG8_SB(1, 0), cB + kstep, voffB0, voffB1); PG8_STAGE(PG8_SA(1, 0), cA + kstep, cv00, cv01); PG8_STAGE(PG8_SB(1, 1), cB + hstepB + kstep, voffB0, voffB1);
        PG8_WAIT_V(6); PG8_BAR;
    } else {
        PG8_STAGE(PG8_SB(0, 0), cB, voffB0, voffB1); PG8_STAGE(PG8_SA(0, 0), cA, cv00, cv01); PG8_STAGE(PG8_SB(0, 1), cB + hstepB, voffB0, voffB1); PG8_STAGE(PG8_SA(0, 1), cA, cv10, cv11);
        if (wr == 1) PG8_BAR;
        PG8_WAIT_V(4); PG8_BAR;
        PG8_STAGE(PG8_SB(1, 0), cB + kstep, voffB0, voffB1); PG8_STAGE(PG8_SA(1, 0), cA + kstep, cv00, cv01); PG8_STAGE(PG8_SB(1, 1), cB + hstepB + kstep, voffB0, voffB1);
        PG8_WAIT_V(6); PG8_BAR;
    }
    for (;;) {
        const bool has_next = S.next(ui + 1, nxt);
        const char* nA = has_next ? nxt.A : cA; const char* nB = has_next ? nxt.B : cB;
#pragma unroll 1
        for (int t = 0; t < nt; t += 2) {
            const bool last = (t == nt - 2);
            const char* a1 = cA + (size_t)(t + 1) * kstep;
            const char* a2 = last ? nA : cA + (size_t)(t + 2) * kstep; const char* b2 = last ? nB : cB + (size_t)(t + 2) * kstep;
            const char* a3 = a2 + kstep; const char* b3 = b2 + kstep;
            if constexpr (SP2) {
            PG8_LDB(B0, 0, 0); PG8_LDB(B1, 0, 1); PG8_SCHED; PG8_LDA(At, 0, 0); PG8_STAGE(PG8_SA(1, 1), a1, cv10, cv11);
            PG8_WAIT_V(8); PG8_WAIT_L(0); PG8_BAR; PG8_MMA(0, 0, At, B0); PG8_MMA(0, 1, At, B1); PG8_BAR; PG8_SCHED;
            if constexpr (GATHER) { if (last && has_next) { PG8_SETV(cv00, cv01, cv10, cv11, nxt); } }
            PG8_LDA(At, 0, 1); PG8_STAGE(PG8_SB(0, 0), b2, voffB0, voffB1); PG8_STAGE(PG8_SB(0, 1), b2 + hstepB, voffB0, voffB1); PG8_STAGE(PG8_SA(0, 0), a2, cv00, cv01);
            PG8_WAIT_V(8); PG8_WAIT_L(0); PG8_BAR; PG8_MMA(1, 0, At, B0); PG8_MMA(1, 1, At, B1); PG8_BAR; PG8_SCHED;
            PG8_LDB(B0, 1, 0); PG8_LDB(B1, 1, 1); PG8_SCHED; PG8_LDA(At, 1, 0); PG8_STAGE(PG8_SA(0, 1), a2, cv10, cv11);
            PG8_WAIT_V(8); PG8_WAIT_L(0); PG8_BAR; PG8_MMA(0, 0, At, B0); PG8_MMA(0, 1, At, B1); PG8_BAR; PG8_SCHED;
            PG8_LDA(At, 1, 1); PG8_STAGE(PG8_SB(1, 0), b3, voffB0, voffB1); PG8_STAGE(PG8_SB(1, 1), b3 + hstepB, voffB0, voffB1); PG8_STAGE(PG8_SA(1, 0), a3, cv00, cv01);
            PG8_WAIT_V(8); PG8_WAIT_L(0); PG8_BAR; PG8_MMA(1, 0, At, B0); PG8_MMA(1, 1, At, B1); PG8_BAR; PG8_SCHED;
            } else {
            PG8_LDB(B0, 0, 0); PG8_SCHED; PG8_LDA(At, 0, 0); PG8_STAGE(PG8_SA(1, 1), a1, cv10, cv11);
            PG8_WAIT_L(8); PG8_BAR; PG8_WAIT_L(0); PG8_MMA(0, 0, At, B0); PG8_BAR; PG8_SCHED;
            if constexpr (GATHER) { if (last && has_next) { PG8_SETV(cv00, cv01, cv10, cv11, nxt); } }
            PG8_LDB(B1, 0, 1); PG8_STAGE(PG8_SB(0, 0), b2, voffB0, voffB1);
            PG8_BAR; PG8_WAIT_L(0); PG8_MMA(0, 1, At, B1); PG8_BAR;
            PG8_LDA(At, 0, 1); PG8_STAGE(PG8_SA(0, 0), a2, cv00, cv01);
            PG8_BAR; PG8_WAIT_L(0); PG8_MMA(1, 0, At, B0); PG8_BAR; PG8_SCHED;
            PG8_STAGE(PG8_SB(0, 1), b2 + hstepB, voffB0, voffB1);
            PG8_WAIT_V(6); PG8_BAR; PG8_MMA(1, 1, At, B1); PG8_BAR;
            PG8_LDB(B0, 1, 0); PG8_SCHED; PG8_LDA(At, 1, 0); PG8_STAGE(PG8_SA(0, 1), a2, cv10, cv11);
            PG8_WAIT_L(8); PG8_BAR; PG8_WAIT_L(0); PG8_MMA(0, 0, At, B0); PG8_BAR; PG8_SCHED;
            PG8_LDB(B1, 1, 1); PG8_STAGE(PG8_SB(1, 0), b3, voffB0, voffB1);
            PG8_BAR; PG8_WAIT_L(0); PG8_MMA(0, 1, At, B1); PG8_BAR;
            PG8_LDA(At, 1, 1); PG8_STAGE(PG8_SA(1, 0), a3, cv00, cv01);
            PG8_BAR; PG8_WAIT_L(0); PG8_MMA(1, 0, At, B0); PG8_BAR; PG8_SCHED;
            PG8_STAGE(PG8_SB(1, 1), b3 + hstepB, voffB0, voffB1);
            PG8_WAIT_V(6); PG8_BAR; PG8_MMA(1, 1, At, B1); PG8_BAR;
            }
        }
        if constexpr (ALIGN_EPI) { if (wr == 0) PG8_BAR; }
        { int t2 = tid; asm volatile("" : "+v"(t2));
          E(acc, cur, wr, wc, t2 & 15, (t2 & 63) >> 4); }
        if (!has_next) break;
#pragma unroll
        for (int a = 0; a < 2; ++a)
#pragma unroll
            for (int b = 0; b < 2; ++b)
#pragma unroll
                for (int m = 0; m < 4; ++m)
#pragma unroll
                    for (int n = 0; n < 2; ++n) acc[a][b][m][n] = (f32x4){0.f, 0.f, 0.f, 0.f};
        cur = nxt; cA = nA; cB = nB; ++ui;
        if constexpr (ALIGN_EPI) { if (wr == 1) PG8_BAR; }
    }
    PG8_WAIT_V(0);
    if constexpr (!ALIGN_EPI) { if (wr == 0) PG8_BAR; }
    PG8_BAR;
#undef PG8_SA
#undef PG8_SB
#undef PG8_STAGE
#undef PG8_LDA
#undef PG8_LDB
#undef PG8_MMA
#undef PG8_WAIT_V
#undef PG8_WAIT_L
#undef PG8_BAR
#undef PG8_SCHED
#undef PG8_SETV
}

struct DenseSched {
    const char* A; const char* B; unsigned lda, ldb, a_pn; int nM, nN, nwg, G, c; const unsigned* ident = nullptr;
    __device__ __forceinline__ bool next(int i, Unit& u) const {
        const long L = (long)i * G + c; if (L >= nwg) return false;
        int wgid = (int)L; { const int q = nwg / NXCD, r = nwg % NXCD, xcd = wgid % NXCD, off = wgid / NXCD; wgid = (xcd < r ? xcd * (q + 1) : r * (q + 1) + (xcd - r) * q) + off; }
        const int nig = WGM * nN, gid = wgid / nig, fm = gid * WGM, gsz = (nM - fm) < WGM ? (nM - fm) : WGM;
        const int pm = fm + ((wgid % nig) % gsz), pn = (wgid % nig) / gsz;
        u.A = ident ? A : A + (size_t)pm * BM * lda + (size_t)pn * a_pn; u.B = B + (size_t)pn * BM * ldb; u.gat = ident ? ident + pm * BM : nullptr; u.nvalid = BM; u.i0 = pm; u.i1 = pn; u.i2 = 0; return true;
    }
};
struct MoeInfo { const LAS unsigned* cnt; const LAS unsigned* tstart; const LAS unsigned* ystart; const LAS unsigned char* tile_e; int ntiles; };
struct G1Sched {
    MoeInfo mi; const char* XB; const char* Wgu; const unsigned* rowtok; const unsigned* ident; int G, vcu;
    __device__ __forceinline__ bool next(int i, Unit& u) const {
        const int L = i * G + vcu; if (L >= 2 * mi.ntiles) return false;
        const int tile = L >> 1, uu = L & 1; int e;
        if (tile < 64) { e = 64; u.gat = ident + tile * 256; u.nvalid = 256; }
        else { e = __builtin_amdgcn_readfirstlane((int)mi.tile_e[tile]); const int pos0 = (tile - __builtin_amdgcn_readfirstlane((int)mi.tstart[e])) * 256; u.gat = rowtok + (size_t)e * CAP + pos0; const int rem = __builtin_amdgcn_readfirstlane((int)mi.cnt[e]) - pos0; u.nvalid = rem < 256 ? rem : 256; }
        u.A = XB; u.B = Wgu + ((size_t)e * 512 + (size_t)uu * 256) * 1024; u.i0 = tile; u.i1 = uu; u.i2 = 0; return true;
    }
};
struct G2Sched {
    MoeInfo mi; const char* H; const char* Wd; int G, vcu, L0;
    __device__ __forceinline__ bool next(int i, Unit& u) const {
        const int L = i * G + vcu + L0; if (L >= 4 * mi.ntiles) return false;
        const int tile = L >> 2, pn = L & 3; int e;
        if (tile < 64) { e = 64; u.i0 = 131072 + tile * 256; u.i2 = 0; u.nvalid = 256; }
        else { e = __builtin_amdgcn_readfirstlane((int)mi.tile_e[tile]); const int pos0 = (tile - __builtin_amdgcn_readfirstlane((int)mi.tstart[e])) * 256; u.i0 = __builtin_amdgcn_readfirstlane((int)mi.ystart[e]) + pos0; u.i2 = 0; const int rem = __builtin_amdgcn_readfirstlane((int)mi.cnt[e]) - pos0; u.nvalid = rem < 256 ? rem : 256; }
        u.A = H + (size_t)tile * 256 * 256; u.B = Wd + ((size_t)e * 1024 + (size_t)pn * 256) * 256; u.gat = nullptr; u.i1 = pn; return true;
    }
};

template <int ACT, bool BIAS, bool SCALE, bool W32 = false, bool VSTAT = false> struct EpiBf16 {
    bf16* O; int ldo; const float* bias; const float* scale; float* vstat;
    __device__ __forceinline__ void operator()(const f32x4 (&acc)[2][2][4][2], const Unit& u, int wr, int wc, int fr, int fq) const {
        const int row0 = u.i0 * BM + wr * 64 + fr, col0 = u.i1 * BM + wc * 32 + 8 * fq;
        const bool dostat = VSTAT && u.i1 >= 8;
        f32x4 bv[2][2], sv[2][2];
#pragma unroll
        for (int bj = 0; bj < 2; ++bj)
#pragma unroll
            for (int n = 0; n < 2; ++n) { bv[bj][n] = BIAS ? *(const f32x4*)(bias + col0 + bj * HALF + 4 * n) : (f32x4){0.f, 0.f, 0.f, 0.f}; sv[bj][n] = SCALE ? *(const f32x4*)(scale + col0 + bj * HALF + 4 * n) : (f32x4){1.f, 1.f, 1.f, 1.f}; }
#pragma unroll
        for (int ai = 0; ai < 2; ++ai)
#pragma unroll
            for (int m = 0; m < 4; ++m) { bf16* rowp = O + (size_t)(row0 + ai * HALF + m * 16) * ldo + col0; float ssum = 0.f, ssq = 0.f;
#pragma unroll
                for (int bj = 0; bj < 2; ++bj) { f32x4 v0 = acc[ai][bj][m][0] * (W32 ? 0.03125f : 1.0f) + bv[bj][0], v1 = acc[ai][bj][m][1] * (W32 ? 0.03125f : 1.0f) + bv[bj][1];
                    if (ACT == 1) { const f32x2 a0 = gelu_tanh2((f32x2){v0[0], v0[1]}), a1 = gelu_tanh2((f32x2){v0[2], v0[3]}), a2 = gelu_tanh2((f32x2){v1[0], v1[1]}), a3 = gelu_tanh2((f32x2){v1[2], v1[3]});
                        v0 = (f32x4){a0.x, a0.y, a1.x, a1.y}; v1 = (f32x4){a2.x, a2.y, a3.x, a3.y}; }
                    if (SCALE) { v0 = v0 * sv[bj][0]; v1 = v1 * sv[bj][1]; }
                    v4u w; w.x = cvt_pk_bf16(v0[0], v0[1]); w.y = cvt_pk_bf16(v0[2], v0[3]); w.z = cvt_pk_bf16(v1[0], v1[1]); w.w = cvt_pk_bf16(v1[2], v1[3]);
                    *(v4u*)(rowp + bj * HALF) = w;
                    if constexpr (VSTAT) {
#pragma unroll
                        for (int j = 0; j < 4; ++j) { ssum += v0[j] + v1[j]; ssq += v0[j] * v0[j] + v1[j] * v1[j]; } } }
                if constexpr (VSTAT) { if (dostat) {
                    ssum += __shfl_xor(ssum, 16); ssq += __shfl_xor(ssq, 16); ssum += __shfl_xor(ssum, 32); ssq += __shfl_xor(ssq, 32);
                    if (fq == 0) *(f32x2*)(vstat + ((size_t)(row0 + ai * HALF + m * 16) * 32 + (size_t)(u.i1 - 8) * 4 + wc) * 2) = (f32x2){ssum, ssq}; } } }
    }
};
template <bool BASE_BF16> struct EpiResidB {
    const void* base; bf16* outb;
    __device__ __forceinline__ void operator()(const f32x4 (&acc)[2][2][4][2], const Unit& u, int wr, int wc, int fr, int fq) const {
        const int row0 = u.i0 * BM + wr * 64 + fr, col0 = u.i1 * BM + wc * 32 + 8 * fq;
#pragma unroll
        for (int ai = 0; ai < 2; ++ai)
#pragma unroll
            for (int m = 0; m < 4; ++m) { const size_t off = (size_t)(row0 + ai * HALF + m * 16) * DM + col0;
#pragma unroll
                for (int bj = 0; bj < 2; ++bj) { f32x4 b0, b1;
                    if constexpr (BASE_BF16) { const v4u w = *(const v4u*)((const bf16*)base + off + bj * HALF); b0 = (f32x4){bf_lo(w.x), bf_hi(w.x), bf_lo(w.y), bf_hi(w.y)}; b1 = (f32x4){bf_lo(w.z), bf_hi(w.z), bf_lo(w.w), bf_hi(w.w)}; }
                    else { b0 = *(const f32x4*)((const float*)base + off + bj * HALF); b1 = *(const f32x4*)((const float*)base + off + bj * HALF + 4); }
                    const f32x4 o0 = b0 * ALPHA + acc[ai][bj][m][0], o1 = b1 * ALPHA + acc[ai][bj][m][1];
                    v4u o; o.x = cvt_pk_bf16(o0[0], o0[1]); o.y = cvt_pk_bf16(o0[2], o0[3]); o.z = cvt_pk_bf16(o1[0], o1[1]); o.w = cvt_pk_bf16(o1[2], o1[3]);
                    *(v4u*)(outb + off + bj * HALF) = o; }
                asm volatile("" ::: "memory"); }
    }
};
struct EpiResid {
    const float* base; float* out;
    __device__ __forceinline__ void operator()(const f32x4 (&acc)[2][2][4][2], const Unit& u, int wr, int wc, int fr, int fq) const {
        const int row0 = u.i0 * BM + wr * 64 + fr, col0 = u.i1 * BM + wc * 32 + 8 * fq;
#pragma unroll
        for (int ai = 0; ai < 2; ++ai)
#pragma unroll
            for (int m = 0; m < 4; ++m) { const size_t off = (size_t)(row0 + ai * HALF + m * 16) * DM + col0;
#pragma unroll
                for (int bj = 0; bj < 2; ++bj) { const f32x4 b0 = *(const f32x4*)(base + off + bj * HALF), b1 = *(const f32x4*)(base + off + bj * HALF + 4);
                    *(f32x4*)(out + off + bj * HALF) = b0 * ALPHA + acc[ai][bj][m][0]; *(f32x4*)(out + off + bj * HALF + 4) = b1 * ALPHA + acc[ai][bj][m][1]; }
                asm volatile("" ::: "memory"); }
    }
};
struct EpiSwiglu {
    unsigned char* H8;
    __device__ __forceinline__ void operator()(const f32x4 (&acc)[2][2][4][2], const Unit& u, int wr, int wc, int fr, int fq) const {
        const int row0 = u.i0 * BM + wr * 64 + fr, col0 = u.i1 * HALF + wc * 32 + 8 * fq;
#pragma unroll
        for (int ai = 0; ai < 2; ++ai)
#pragma unroll
            for (int m = 0; m < 4; ++m) { unsigned char* rowp = H8 + (size_t)(row0 + ai * HALF + m * 16) * EDIM + col0; float h[8];
#pragma unroll
                for (int n = 0; n < 2; ++n)
#pragma unroll
                    for (int j = 0; j < 4; j += 2) { const f32x2 g = (f32x2){acc[ai][0][m][n][j], acc[ai][0][m][n][j + 1]} * 0.03125f, up = (f32x2){acc[ai][1][m][n][j], acc[ai][1][m][n][j + 1]} * 0.25f;
                        const f32x2 t = g * (-1.4426950408889634f); f32x2 e; e.x = __builtin_amdgcn_exp2f(t.x); e.y = __builtin_amdgcn_exp2f(t.y); const f32x2 d = e + 1.0f; f32x2 r; r.x = __builtin_amdgcn_rcpf(d.x); r.y = __builtin_amdgcn_rcpf(d.y);
                        const f32x2 hh = (g * r) * up; h[4 * n + j] = hh.x; h[4 * n + j + 1] = hh.y; }
                int t0 = 0, t1 = 0; t0 = __builtin_amdgcn_cvt_pk_fp8_f32(h[0], h[1], t0, false); t0 = __builtin_amdgcn_cvt_pk_fp8_f32(h[2], h[3], t0, true); t1 = __builtin_amdgcn_cvt_pk_fp8_f32(h[4], h[5], t1, false); t1 = __builtin_amdgcn_cvt_pk_fp8_f32(h[6], h[7], t1, true);
                *(v2u*)rowp = (v2u){(unsigned)t0, (unsigned)t1}; }
    }
};
struct EpiDown {
    unsigned char* Y8;
    __device__ __forceinline__ void operator()(const f32x4 (&acc)[2][2][4][2], const Unit& u, int wr, int wc, int fr, int fq) const {
        const int r0 = wr * 64 + fr, col0 = u.i1 * BM + wc * 64 + 16 * fq;
#pragma unroll
        for (int ai = 0; ai < 2; ++ai)
#pragma unroll
            for (int m = 0; m < 4; ++m) { const int r = r0 + ai * HALF + m * 16;
                if (r < u.nvalid) { v4u w;
#pragma unroll
                    for (int q = 0; q < 4; ++q) { const f32x4 v = acc[ai][q >> 1][m][q & 1] * 0.0625f;     int t = 0; t = __builtin_amdgcn_cvt_pk_fp8_f32(v[0], v[1], t, false); t = __builtin_amdgcn_cvt_pk_fp8_f32(v[2], v[3], t, true); w[q] = (unsigned)t; }
                    *(v4u*)(Y8 + (size_t)(u.i0 + r) * DM + col0) = w; } }
    }
};
}

struct Args { const float* in[24]; float* out; unsigned char* ws; int ph_lo, ph_hi; };
enum { I_X = 0, I_PWIN, I_PWGRP, I_PSCALE, I_PWOUT, I_SWIN, I_SBIN, I_SLNG, I_SLNB, I_SWS, I_SBS, I_SWOUT, I_LNMG, I_LNMB, I_WR, I_RB, I_WG, I_WU, I_WD, I_SHG, I_SHU, I_SHD, I_LNFG, I_LNFB };

__device__ __forceinline__ void tr_item(const float* W, int N, int k0, int n0, bf16* dst  , int dpitch, LAS float* scr, int lane) {
#pragma unroll 8
    for (int i = 0; i < 32; ++i) { const int kk = 2 * i + (lane >> 5); scr[kk * 33 + (lane & 31)] = W[(size_t)(k0 + kk) * N + n0 + (lane & 31)]; }
    LDS_WAIT(); asm volatile("" ::: "memory");
    const int c = lane & 7;
#pragma unroll
    for (int j = 0; j < 4; ++j) { const int n = (lane >> 3) + 8 * j; const LAS float* s = scr + (8 * c) * 33 + n;
        v4u o; o.x = cvt_pk_bf16(s[0 * 33], s[1 * 33]); o.y = cvt_pk_bf16(s[2 * 33], s[3 * 33]); o.z = cvt_pk_bf16(s[4 * 33], s[5 * 33]); o.w = cvt_pk_bf16(s[6 * 33], s[7 * 33]);
        *(v4u*)(dst + (size_t)n * dpitch + 8 * c) = o; }
    LDS_WAIT(); asm volatile("" ::: "memory");
}
__device__ __forceinline__ void tr_item_f8(const float* W, int N, int k0, int n0, unsigned char* dst, int dpitch, float scale, LAS float* scr, int lane) {
#pragma unroll 8
    for (int i = 0; i < 32; ++i) { const int kk = 2 * i + (lane >> 5); scr[kk * 33 + (lane & 31)] = W[(size_t)(k0 + kk) * N + n0 + (lane & 31)]; }
    LDS_WAIT(); asm volatile("" ::: "memory");
    const int c = lane & 7;
#pragma unroll
    for (int j = 0; j < 4; ++j) { const int n = (lane >> 3) + 8 * j; const LAS float* s = scr + (8 * c) * 33 + n;
        int t0 = 0, t1 = 0;
        t0 = __builtin_amdgcn_cvt_pk_fp8_f32(s[0 * 33] * scale, s[1 * 33] * scale, t0, false); t0 = __builtin_amdgcn_cvt_pk_fp8_f32(s[2 * 33] * scale, s[3 * 33] * scale, t0, true);
        t1 = __builtin_amdgcn_cvt_pk_fp8_f32(s[4 * 33] * scale, s[5 * 33] * scale, t1, false); t1 = __builtin_amdgcn_cvt_pk_fp8_f32(s[6 * 33] * scale, s[7 * 33] * scale, t1, true);
        *(v2u*)(dst + (size_t)n * dpitch + 8 * c) = (v2u){(unsigned)t0, (unsigned)t1}; }
    LDS_WAIT(); asm volatile("" ::: "memory");
}
__device__ __forceinline__ void tr_tall_f8(const float* W, int N, int k0, int n0, unsigned char* dst, int dpitch, float scale, LAS float* scr, int lane) {
    f32x4 q[16]; const int r8 = lane >> 3, c4 = 4 * (lane & 7);
#pragma unroll
    for (int i = 0; i < 16; ++i) q[i] = *(const f32x4*)(W + (size_t)(k0 + 8 * i + r8) * N + n0 + c4);
#pragma unroll
    for (int i = 0; i < 16; ++i) { const int kk = 8 * i + r8; *(LAS f32x4*)(scr + kk * 32 + ((c4 + 4 * (kk >> 4)) & 31)) = q[i]; }
    LDS_WAIT(); asm volatile("" ::: "memory");
    const int c = lane & 7;
#pragma unroll
    for (int j = 0; j < 4; ++j) { const int n = r8 + 8 * j; const int col = (n + 4 * c) & 31; v4u o;
#pragma unroll
        for (int z = 0; z < 4; ++z) { const LAS float* sp = scr + (16 * c + 4 * z) * 32 + col; int t = 0;
            t = __builtin_amdgcn_cvt_pk_fp8_f32(sp[0] * scale, sp[32] * scale, t, false); t = __builtin_amdgcn_cvt_pk_fp8_f32(sp[64] * scale, sp[96] * scale, t, true); o[z] = (unsigned)t; }
        *(v4u*)(dst + (size_t)n * dpitch + 16 * c) = o; }
    LDS_WAIT(); asm volatile("" ::: "memory");
}
template <bool SPLIT> __device__ __forceinline__ void tr_block_f8(const float* W, int N, int k0, int n0, unsigned char* dst, int dpitch, float scale, LAS float* tile, int wave, int lane) {
    f32x4 q[16];
#pragma unroll
    for (int i = 0; i < 16; ++i) q[i] = *(const f32x4*)(W + (size_t)(k0 + 16 * wave + i) * N + n0 + 4 * lane);
#pragma unroll
    for (int i = 0; i < 16; ++i) { const int kk = 16 * wave + i; *(LAS f32x4*)(tile + kk * 256 + ((4 * lane + 4 * (kk >> 4)) & 255)) = q[i]; }
    LDS_WAIT(); __syncthreads();
    const int c = lane & 7, r8 = lane >> 3;
#pragma unroll
    for (int j = 0; j < 4; ++j) { const int n = 32 * wave + r8 + 8 * j; const int col = (n + 4 * c) & 255; v4u o;
#pragma unroll
        for (int z = 0; z < 4; ++z) { const LAS float* sp = tile + (16 * c + 4 * z) * 256 + col; int t = 0;
            t = __builtin_amdgcn_cvt_pk_fp8_f32(sp[0] * scale, sp[256] * scale, t, false); t = __builtin_amdgcn_cvt_pk_fp8_f32(sp[512] * scale, sp[768] * scale, t, true); o[z] = (unsigned)t; }
        *(v4u*)(dst + (size_t)(SPLIT ? ((n >> 7) * 256 + (n & 127)) : n) * dpitch + 16 * c) = o; }
    LDS_WAIT(); __syncthreads();
}
__device__ __forceinline__ void tr_item_hilo(const float* W, int N, int k0, int n0, bf16* dh, bf16* dl, int dpitch, LAS float* scr, int lane) {
#pragma unroll 8
    for (int i = 0; i < 32; ++i) { const int kk = 2 * i + (lane >> 5); scr[kk * 33 + (lane & 31)] = W[(size_t)(k0 + kk) * N + n0 + (lane & 31)]; }
    LDS_WAIT(); asm volatile("" ::: "memory");
    const int c = lane & 7;
#pragma unroll
    for (int j = 0; j < 4; ++j) { const int n = (lane >> 3) + 8 * j; const LAS float* s = scr + (8 * c) * 33 + n; float w[8];
#pragma unroll
        for (int z = 0; z < 8; ++z) w[z] = s[z * 33];
        v4u o; o.x = cvt_pk_bf16(w[0], w[1]); o.y = cvt_pk_bf16(w[2], w[3]); o.z = cvt_pk_bf16(w[4], w[5]); o.w = cvt_pk_bf16(w[6], w[7]);
        v4u l; l.x = cvt_pk_bf16(w[0] - bf_lo(o.x), w[1] - bf_hi(o.x)); l.y = cvt_pk_bf16(w[2] - bf_lo(o.y), w[3] - bf_hi(o.y)); l.z = cvt_pk_bf16(w[4] - bf_lo(o.z), w[5] - bf_hi(o.z)); l.w = cvt_pk_bf16(w[6] - bf_lo(o.w), w[7] - bf_hi(o.w));
        *(v4u*)(dh + (size_t)n * dpitch + 8 * c) = o; *(v4u*)(dl + (size_t)n * dpitch + 8 * c) = l; }
    LDS_WAIT(); asm volatile("" ::: "memory");
}
constexpr int MOE_ITEMS = 65 * 192;
__device__ __forceinline__ void convert_moe_item(const Args& a, int layer, int it, LAS float* scr, int lane) {
    unsigned char* WGU = a.ws + WS_WGU + (size_t)layer * WS_MOE_LSTRIDE; unsigned char* WDN = a.ws + WS_WDN + (size_t)layer * WS_MOE_LSTRIDE;
    const int e = it / 192, r = it % 192;
    if (r < 128) { const int isup = r >> 6, rr = r & 63, kb = rr >> 3, nb = rr & 7, n0 = 32 * nb, k0 = 128 * kb;
        const float* src = (e < 64) ? a.in[isup ? I_WU : I_WG] + ((size_t)layer * 64 + e) * 262144 : a.in[isup ? I_SHU : I_SHG] + (size_t)layer * 262144;
        const int drow = e * 512 + (n0 >> 7) * 256 + isup * 128 + (n0 & 127);
        tr_tall_f8(src, 256, k0, n0, WGU + (size_t)drow * 1024 + k0, 1024, 32.0f, scr, lane);
    } else { const int rr = r - 128, kb = rr >> 5, nb = rr & 31, n0 = 32 * nb, k0 = 128 * kb;
        const float* src = (e < 64) ? a.in[I_WD] + ((size_t)layer * 64 + e) * 262144 : a.in[I_SHD] + (size_t)layer * 262144;
        tr_tall_f8(src, 1024, k0, n0, WDN + ((size_t)e * 1024 + n0) * 256 + k0, 256, 32.0f, scr, lane);
    }
}
constexpr int Q_SHARDS = 8, Q_PER_SHARD = MOE_ITEMS / Q_SHARDS;
static_assert(Q_PER_SHARD * Q_SHARDS == MOE_ITEMS, "queue shards");
template <int CHUNK> __device__ __forceinline__ bool convert_steal_n(const Args& a, int layer, LAS unsigned char* lds, int wave, int lane) {
    unsigned* q = (unsigned*)(a.ws + WS_CTL) + CW_QNEXT + 512 * layer;
    const int s0 = (int)(blockIdx.x & 7);
    for (int s = 0; s < Q_SHARDS; ++s) { const int sh = (s0 + s) & 7;
        unsigned it = 0; if (lane == 0) it = __hip_atomic_fetch_add(q + 64 * sh, (unsigned)CHUNK, RLX_AGENT);
        it = (unsigned)__builtin_amdgcn_readfirstlane((int)it);
        if (it < (unsigned)Q_PER_SHARD) {
            for (int c = 0; c < CHUNK; ++c) if (it + c < (unsigned)Q_PER_SHARD) convert_moe_item(a, layer, sh * Q_PER_SHARD + (int)it + c, (LAS float*)(lds + wave * 16384), lane);
            return true; } }
    return false;
}
__device__ __forceinline__ bool convert_steal(const Args& a, int layer, LAS unsigned char* lds, int wave, int lane) { return convert_steal_n<1>(a, layer, lds, wave, lane); }
constexpr int MOE_WG_ITEMS = 65 * 24;
__device__ __forceinline__ void convert_static(const Args& a, int layer, LAS unsigned char* lds, int vcu, int G) {
    const int lane = threadIdx.x & 63, wave = __builtin_amdgcn_readfirstlane(threadIdx.x >> 6);
    unsigned char* WGU = a.ws + WS_WGU + (size_t)layer * WS_MOE_LSTRIDE; unsigned char* WDN = a.ws + WS_WDN + (size_t)layer * WS_MOE_LSTRIDE;
    __syncthreads();
#pragma unroll 1
    for (int it = vcu; it < MOE_WG_ITEMS; it += G) { const int e = it / 24, r = it % 24;
        if (r < 16) { const int isup = r >> 3, k0 = 128 * (r & 7);
            const float* src = (e < 64) ? a.in[isup ? I_WU : I_WG] + ((size_t)layer * 64 + e) * 262144 : a.in[isup ? I_SHU : I_SHG] + (size_t)layer * 262144;
            tr_block_f8<true>(src, 256, k0, 0, WGU + ((size_t)e * 512 + isup * 128) * 1024 + k0, 1024, 32.0f, (LAS float*)lds, wave, lane);
        } else { const int rr = r - 16, k0 = 128 * (rr >> 2), n0 = 256 * (rr & 3);
            const float* src = (e < 64) ? a.in[I_WD] + ((size_t)layer * 64 + e) * 262144 : a.in[I_SHD] + (size_t)layer * 262144;
            tr_block_f8<false>(src, 1024, k0, n0, WDN + ((size_t)e * 1024 + n0) * 256 + k0, 256, 32.0f, (LAS float*)lds, wave, lane);
        } }
}
__device__ __forceinline__ void convert_drain(const Args& a, int layer, LAS unsigned char* lds) {
    const int lane = threadIdx.x & 63, wave = __builtin_amdgcn_readfirstlane(threadIdx.x >> 6);
    while (convert_steal_n<4>(a, layer, lds, wave, lane)) {}
    __syncthreads();
}
__device__ __forceinline__ void phase_p0(const Args& a, LAS unsigned char* lds, int vcu, int G) {
    const int tid = threadIdx.x, lane = tid & 63, wave = __builtin_amdgcn_readfirstlane(tid >> 6);
    const int gw = vcu * NWAVES + wave, NGW = G * NWAVES;
    LAS float* scr = (LAS float*)(lds + wave * 16384);
    constexpr int I_IN = 16 * 32, I_GRP = 4 * 4 * 8, I_OUT = 16 * 32, I_SIN = 16 * 128, I_SOUT = 32 * 32, NIT = I_IN + I_GRP + I_OUT + I_SIN + I_SOUT;
    for (int it = gw; it < NIT; it += NGW) {
        int r = it;
        if (r < I_IN) { const int kb = r >> 5, nb = r & 31; tr_item(a.in[I_PWIN], 1024, 64 * kb, 32 * nb, (bf16*)(a.ws + WS_WIN) + (size_t)(32 * nb) * 1024 + 64 * kb, 1024, scr, lane); continue; } r -= I_IN;
        if (r < I_GRP) { const int g = r >> 5, rr = r & 31, kb = rr >> 3, nb = rr & 7; tr_item(a.in[I_PWGRP] + (size_t)g * 65536, 256, 64 * kb, 32 * nb, (bf16*)(a.ws + WS_WGRP) + (size_t)(g * 256 + 32 * nb) * 256 + 64 * kb, 256, scr, lane); continue; } r -= I_GRP;
        if (r < I_OUT) { const int kb = r >> 5, nb = r & 31; tr_item(a.in[I_PWOUT], 1024, 64 * kb, 32 * nb, (bf16*)(a.ws + WS_WOUT) + (size_t)(32 * nb) * 1024 + 64 * kb, 1024, scr, lane); continue; } r -= I_OUT;
        if (r < I_SIN) { const int kb = r >> 7, nb = r & 127; tr_item_f8(a.in[I_SWIN], 4096, 64 * kb, 32 * nb, a.ws + WS_WSIN + (size_t)(32 * nb) * 1024 + 64 * kb, 1024, 32.0f, scr, lane); continue; } r -= I_SIN;
        { const int kb = r >> 5, nb = r & 31; tr_item(a.in[I_SWOUT], 1024, 64 * kb, 32 * nb, (bf16*)(a.ws + WS_WSOUT) + (size_t)(32 * nb) * 2048 + 64 * kb, 2048, scr, lane); }
    }
    for (int it = gw; it < 64; it += NGW) { const int layer = it >> 5, rr = it & 31, kb = rr >> 1, nb = rr & 1; bf16* base = (bf16*)(a.ws + WS_WRT) + (size_t)layer * 2 * 65536 + (size_t)(32 * nb) * 1024 + 64 * kb;
        tr_item_hilo(a.in[I_WR] + (size_t)layer * DM * NE, 64, 64 * kb, 32 * nb, base, base + 65536, 1024, scr, lane); }
    convert_static(a, 0, lds, vcu, G);
    const float* x = a.in[I_X]; bf16* xb = (bf16*)(a.ws + WS_XB);
    const size_t gt = (size_t)vcu * NTHR + tid, NT = (size_t)G * NTHR;
#pragma unroll 1
    for (size_t i0 = gt; i0 < (size_t)T_TOK * DM / 8; i0 += 8 * NT) { f32x4 p[8], q[8];
#pragma unroll
        for (int u = 0; u < 8; ++u) { const size_t i = i0 + (size_t)u * NT; p[u] = *(const f32x4*)(x + i * 8); q[u] = *(const f32x4*)(x + i * 8 + 4); }
#pragma unroll
        for (int u = 0; u < 8; ++u) { const size_t i = i0 + (size_t)u * NT; v4u w; w.x = cvt_pk_bf16(p[u][0], p[u][1]); w.y = cvt_pk_bf16(p[u][2], p[u][3]); w.z = cvt_pk_bf16(q[u][0], q[u][1]); w.w = cvt_pk_bf16(q[u][2], q[u][3]); *(v4u*)(xb + i * 8) = w; } }
    unsigned* ident = (unsigned*)(a.ws + WS_IDENT);
    for (size_t i = gt; i < (size_t)T_TOK; i += NT) ident[i] = (unsigned)i;
}

template <int W> __device__ __forceinline__ void pool_item(const bf16* zp  , bf16* op  , int p0  ) {
    v4u q[W + 3];
#pragma unroll
    for (int i = 0; i < W + 3; ++i) { const int ii = i < p0 + 3 ? i : p0 + 3; q[i] = *(const v4u*)(zp - (size_t)ii * DM); }
#pragma unroll
    for (int o = 0; o < 4; ++o) {
        float s[8];
#pragma unroll
        for (int j = 0; j < 8; ++j) s[j] = 0.f;
#pragma unroll
        for (int i = 3 - o; i < 3 - o + W; ++i) { const float m = (i <= p0 + 3) ? 1.0f : 0.0f;
#pragma unroll
            for (int j = 0; j < 4; ++j) { s[2 * j] += m * bf_lo(q[i][j]); s[2 * j + 1] += m * bf_hi(q[i][j]); } }
        const int p = p0 + o, nw = (p + 1) < W ? (p + 1) : W; const float inv = 1.0f / (float)nw; v4u ov;
#pragma unroll
        for (int j = 0; j < 4; ++j) ov[j] = cvt_pk_bf16(s[2 * j] * inv - bf_lo(q[3 - o][j]), s[2 * j + 1] * inv - bf_hi(q[3 - o][j]));
        *(v4u*)(op + (size_t)o * DM) = ov; }
}
__device__ __forceinline__ void pool_block(const Args& a, int pm, int g) {
    const bf16* Z = (const bf16*)(a.ws + WS_Z); bf16* P = (bf16*)(a.ws + WS_POOLED);
    const int tid = threadIdx.x;
#pragma unroll 1
    for (int q = tid; q < 64 * 32; q += NTHR) { const int c8 = q & 31, tg = q >> 5, t0 = pm * 256 + tg * 4, p0 = t0 & (SEQ - 1);
        const bf16* zp = Z + (size_t)(t0 + 3) * DM + g * 256 + c8 * 8; bf16* op = P + (size_t)t0 * DM + g * 256 + c8 * 8;
        if (g == 0) pool_item<2>(zp, op, p0); else if (g == 1) pool_item<4>(zp, op, p0); else if (g == 2) pool_item<8>(zp, op, p0); else pool_item<16>(zp, op, p0); }
    VM_WAIT(); __syncthreads();
}
__device__ __forceinline__ void phase_pool(const Args& a, int vcu, int G) {
    const bf16* Z = (const bf16*)(a.ws + WS_Z); bf16* P = (bf16*)(a.ws + WS_POOLED);
    const int tid = threadIdx.x, wave = tid >> 6, lane = tid & 63;
    const int gw = vcu * NWAVES + wave, NGW = G * NWAVES;
    for (int it = gw; it < (T_TOK / 4) * 2; it += NGW) {
        const int t0 = (it >> 1) * 4, c8 = (it & 1) * 64 + lane, g = c8 >> 5, p0 = t0 & (SEQ - 1);
        const bf16* zp = Z + (size_t)(t0 + 3) * DM + c8 * 8; bf16* op = P + (size_t)t0 * DM + c8 * 8;
        if (g == 0) pool_item<2>(zp, op, p0); else if (g == 1) pool_item<4>(zp, op, p0); else if (g == 2) pool_item<8>(zp, op, p0); else pool_item<16>(zp, op, p0);
    }
}

template <int R, int MODE> __device__ __forceinline__ void ln_rows_store(float (&v)[R][16], const float* g, const float* b, float* const (&of)[R], bf16* const (&obf)[R], unsigned char* const (&o8)[R], int lane) {
    float s[R], s2[R];
#pragma unroll
    for (int r = 0; r < R; ++r) { s[r] = 0.f;
#pragma unroll
        for (int i = 0; i < 16; ++i) s[r] += v[r][i]; }
#pragma unroll
    for (int o = 1; o < 64; o <<= 1)
#pragma unroll
        for (int r = 0; r < R; ++r) s[r] += __shfl_xor(s[r], o);
#pragma unroll
    for (int r = 0; r < R; ++r) { const float mean = s[r] * (1.0f / DM); s2[r] = 0.f;
#pragma unroll
        for (int i = 0; i < 16; ++i) { v[r][i] -= mean; s2[r] += v[r][i] * v[r][i]; } }
#pragma unroll
    for (int o = 1; o < 64; o <<= 1)
#pragma unroll
        for (int r = 0; r < R; ++r) s2[r] += __shfl_xor(s2[r], o);
#pragma unroll
    for (int j = 0; j < 2; ++j) { const int c = 8 * lane + 512 * j;
        const f32x4 g0 = *(const f32x4*)(g + c), g1 = *(const f32x4*)(g + c + 4), b0 = *(const f32x4*)(b + c), b1 = *(const f32x4*)(b + c + 4);
#pragma unroll
        for (int r = 0; r < R; ++r) { const float rstd = 1.0f / sqrtf(s2[r] * (1.0f / DM) + LN_EPS); f32x4 y0, y1;
#pragma unroll
            for (int q = 0; q < 4; ++q) { y0[q] = v[r][8 * j + q] * rstd * g0[q] + b0[q]; y1[q] = v[r][8 * j + 4 + q] * rstd * g1[q] + b1[q]; }
            if constexpr (MODE & 1) { *(f32x4*)(of[r] + c) = y0; *(f32x4*)(of[r] + c + 4) = y1; }
            if constexpr (MODE & 2) { v4u w; w.x = cvt_pk_bf16(y0[0], y0[1]); w.y = cvt_pk_bf16(y0[2], y0[3]); w.z = cvt_pk_bf16(y1[0], y1[1]); w.w = cvt_pk_bf16(y1[2], y1[3]); *(v4u*)(obf[r] + c) = w; }
            if constexpr (MODE & 4) { int t0 = 0, t1 = 0; t0 = __builtin_amdgcn_cvt_pk_fp8_f32(y0[0], y0[1], t0, false); t0 = __builtin_amdgcn_cvt_pk_fp8_f32(y0[2], y0[3], t0, true); t1 = __builtin_amdgcn_cvt_pk_fp8_f32(y1[0], y1[1], t1, false); t1 = __builtin_amdgcn_cvt_pk_fp8_f32(y1[2], y1[3], t1, true);
                *(v2u*)(o8[r] + c) = (v2u){(unsigned)t0, (unsigned)t1}; } } }
}

__device__ __forceinline__ void phase_lnr(const Args& a, int layer, LAS unsigned char* lds, int vcu, int G, bool dry) {
    const int tid = threadIdx.x, lane = tid & 63, wave = __builtin_amdgcn_readfirstlane(tid >> 6);
    const bf16* xin = (const bf16*)(a.ws + WS_XR); float* xf = dry ? (float*)(a.ws + WS_Y) : a.out; bf16* xb = dry ? (bf16*)(a.ws + WS_Y + 72 * MiB) : (bf16*)(a.ws + WS_XB);
    const float* lng = a.in[I_LNMG] + layer * DM; const float* lnb = a.in[I_LNMB] + layer * DM;
    const float* Wr = a.in[I_WR] + (size_t)layer * DM * NE; const float* rbias = a.in[I_RB] + layer * NE;
    unsigned* gcount = (unsigned*)(a.ws + WS_CTL) + CW_CNT + layer * 64 + (dry ? 128 : 0);
    unsigned* rowtok = dry ? (unsigned*)(a.ws + WS_Y + 64 * MiB) : (unsigned*)(a.ws + WS_ROWTOK); unsigned* dest = dry ? (unsigned*)(a.ws + WS_Y + 68 * MiB) : (unsigned*)(a.ws + WS_DEST); float* gatev = dry ? (float*)(a.ws + WS_Y + 69 * MiB) : (float*)(a.ws + WS_GATE);
    LAS float* part = (LAS float*)lds;
    LAS unsigned* hist = (LAS unsigned*)(lds + 65536);
    LAS unsigned* basep = (LAS unsigned*)(lds + 65536 + 256);
    { const int blk = vcu;
        const int row0 = blk * 64;
        if (tid < 64) hist[tid] = 0u;
        { float v[8][16]; float* of[8]; bf16* obf[8]; unsigned char* o8[8];
#pragma unroll
            for (int r = 0; r < 8; ++r) { const int rr = wave * 8 + r; const bf16* xr = xin + (size_t)(row0 + rr) * DM; of[r] = xf + (size_t)(row0 + rr) * DM; obf[r] = nullptr; o8[r] = (unsigned char*)xb + (size_t)(row0 + rr) * DM;
#pragma unroll
                for (int j = 0; j < 2; ++j) { const v4u p = *(const v4u*)(xr + 8 * lane + 512 * j);
#pragma unroll
                    for (int i = 0; i < 4; ++i) { v[r][8 * j + 2 * i] = bf_lo(p[i]); v[r][8 * j + 2 * i + 1] = bf_hi(p[i]); } } }
            ln_rows_store<8, 5>(v, lng, lnb, of, obf, o8, lane); }
        VM_WAIT(); __syncthreads();
#ifndef DRY_PARTS
#define DRY_PARTS 7
#endif
        if (!dry || (DRY_PARTS & 2)) { const int kq = wave & 3, mh = wave >> 2, r = lane & 15, g = lane >> 4;
          f32x4 acc[2][4];
#pragma unroll
          for (int m = 0; m < 2; ++m)
#pragma unroll
              for (int n = 0; n < 4; ++n) acc[m][n] = (f32x4){0.f, 0.f, 0.f, 0.f};
          const float* arow = xf + (size_t)(row0 + 32 * mh + r) * DM + kq * 256 + 8 * g;
          const bf16* bh = (const bf16*)(a.ws + WS_WRT) + (size_t)layer * 2 * 65536 + (size_t)r * 1024 + kq * 256 + 8 * g; const bf16* bl = bh + 65536;
          f32x4 a0[2], a1[2]; bf16x8 wh[4], wl[4];
#pragma unroll
          for (int m = 0; m < 2; ++m) { a0[m] = *(const f32x4*)(arow + (size_t)m * 16 * DM); a1[m] = *(const f32x4*)(arow + (size_t)m * 16 * DM + 4); }
#pragma unroll
          for (int n = 0; n < 4; ++n) { wh[n] = *(const bf16x8*)(bh + (size_t)n * 16384); wl[n] = *(const bf16x8*)(bl + (size_t)n * 16384); }
#pragma unroll 1
          for (int s = 0; s < 8; ++s) { const int sn = s < 7 ? s + 1 : s;
              f32x4 n0[2], n1[2]; bf16x8 nh[4], nl[4];
#pragma unroll
              for (int m = 0; m < 2; ++m) { n0[m] = *(const f32x4*)(arow + (size_t)m * 16 * DM + 32 * sn); n1[m] = *(const f32x4*)(arow + (size_t)m * 16 * DM + 32 * sn + 4); }
#pragma unroll
              for (int n = 0; n < 4; ++n) { nh[n] = *(const bf16x8*)(bh + (size_t)n * 16384 + 32 * sn); nl[n] = *(const bf16x8*)(bl + (size_t)n * 16384 + 32 * sn); }
#pragma unroll
              for (int m = 0; m < 2; ++m) {
                  v4u hi, lo; hi.x = cvt_pk_bf16(a0[m][0], a0[m][1]); hi.y = cvt_pk_bf16(a0[m][2], a0[m][3]); hi.z = cvt_pk_bf16(a1[m][0], a1[m][1]); hi.w = cvt_pk_bf16(a1[m][2], a1[m][3]);
                  lo.x = cvt_pk_bf16(a0[m][0] - bf_lo(hi.x), a0[m][1] - bf_hi(hi.x)); lo.y = cvt_pk_bf16(a0[m][2] - bf_lo(hi.y), a0[m][3] - bf_hi(hi.y));
                  lo.z = cvt_pk_bf16(a1[m][0] - bf_lo(hi.z), a1[m][1] - bf_hi(hi.z)); lo.w = cvt_pk_bf16(a1[m][2] - bf_lo(hi.w), a1[m][3] - bf_hi(hi.w));
                  const bf16x8 ah = __builtin_bit_cast(bf16x8, hi), al = __builtin_bit_cast(bf16x8, lo);
#pragma unroll
                  for (int n = 0; n < 4; ++n) { acc[m][n] = __builtin_amdgcn_mfma_f32_16x16x32_bf16(ah, wh[n], acc[m][n], 0, 0, 0); acc[m][n] = __builtin_amdgcn_mfma_f32_16x16x32_bf16(al, wh[n], acc[m][n], 0, 0, 0); acc[m][n] = __builtin_amdgcn_mfma_f32_16x16x32_bf16(ah, wl[n], acc[m][n], 0, 0, 0); } }
#pragma unroll
              for (int m = 0; m < 2; ++m) { a0[m] = n0[m]; a1[m] = n1[m]; }
#pragma unroll
              for (int n = 0; n < 4; ++n) { wh[n] = nh[n]; wl[n] = nl[n]; } }
#pragma unroll
          for (int m = 0; m < 2; ++m)
#pragma unroll
              for (int n = 0; n < 4; ++n)
#pragma unroll
                  for (int q = 0; q < 4; ++q) part[(kq * 64 + 32 * mh + 16 * m + 4 * g + q) * 64 + 16 * n + r] = acc[m][n][q]; }
        __syncthreads();
        if (!dry || (DRY_PARTS & 4)) { const int row = tid >> 3, grp = tid & 7; float sc[8], bsd[8];
#pragma unroll
          for (int i = 0; i < 8; ++i) { const int e = 8 * grp + i; const float lg = (part[row * 64 + e] + part[(64 + row) * 64 + e]) + (part[(128 + row) * 64 + e] + part[(192 + row) * 64 + e]); sc[i] = 1.0f / (1.0f + __expf(-lg)); bsd[i] = sc[i] + rbias[e]; }
          float m1 = -INFINITY, m2 = -INFINITY;
#pragma unroll
          for (int i = 0; i < 8; ++i) { const float v = bsd[i]; if (v > m1) { m2 = m1; m1 = v; } else if (v > m2) m2 = v; }
          const float myg = m1 + m2;
          int grank = 0;
#pragma unroll
          for (int d = 1; d < 8; ++d) { const float o = __shfl(myg, (lane & ~7) | ((grp + d) & 7)); const int g2 = (grp + d) & 7; grank += (o > myg || (o == myg && g2 < grp)) ? 1 : 0; }
          const bool gsel = grank < 4;
          float cand[8]; int rk[8]; bool sel[8];
#pragma unroll
          for (int i = 0; i < 8; ++i) { cand[i] = gsel ? bsd[i] : -INFINITY; rk[i] = 0; sel[i] = false; }
#pragma unroll 1
          for (int k = 0; k < TOPK; ++k) {
              float best = cand[0]; int bi = 0;
#pragma unroll
              for (int i = 1; i < 8; ++i) if (cand[i] > best) { best = cand[i]; bi = i; }
              int gi = 8 * grp + bi;
#define LNR_RED(CTRL) { const float ov = __builtin_bit_cast(float, __builtin_amdgcn_update_dpp(0, __builtin_bit_cast(int, best), CTRL, 0xF, 0xF, false)); const int oi = __builtin_amdgcn_update_dpp(0, gi, CTRL, 0xF, 0xF, false); if (ov > best || (ov == best && oi < gi)) { best = ov; gi = oi; } }
              LNR_RED(0xB1) LNR_RED(0x4E) LNR_RED(0x141)
#undef LNR_RED
#pragma unroll
              for (int i = 0; i < 8; ++i) if (gi == 8 * grp + i) { cand[i] = -INFINITY; rk[i] = k; sel[i] = true; }
          }
          float psum = 0.f;
#pragma unroll
          for (int i = 0; i < 8; ++i) psum += sel[i] ? sc[i] : 0.f;
          psum += __shfl_xor(psum, 1); psum += __shfl_xor(psum, 2); psum += __shfl_xor(psum, 4);
          const float inv = ROUTED_SCALE / psum;
          unsigned loc[8];
#pragma unroll
          for (int i = 0; i < 8; ++i) { loc[i] = 0u; if (sel[i]) loc[i] = __hip_atomic_fetch_add(hist + 8 * grp + i, 1u, __ATOMIC_RELAXED, __HIP_MEMORY_SCOPE_WORKGROUP); }
          __syncthreads();
          if (tid < 64) { const unsigned h = hist[tid]; basep[tid] = h ? __hip_atomic_fetch_add(gcount + tid, h, RLX_AGENT) : 0u; }
          __syncthreads();
          const int tok = row0 + row;
#pragma unroll
          for (int i = 0; i < 8; ++i) if (sel[i]) { const int e = 8 * grp + i; const unsigned pos = basep[e] + loc[i];
              rowtok[(size_t)e * CAP + pos] = (unsigned)tok; dest[tok * 8 + rk[i]] = ((unsigned)e << 16) | pos; gatev[tok * 8 + rk[i]] = sc[i] * inv; }
        }
        __syncthreads();
    }
}

__device__ __forceinline__ pg8::MoeInfo moe_setup(const Args& a, int layer, LAS unsigned char* misc) {
    const int tid = threadIdx.x;
    unsigned* gcount = (unsigned*)(a.ws + WS_CTL) + CW_CNT + layer * 64;
    LAS unsigned* cnt = (LAS unsigned*)(misc + MI_CNT); LAS unsigned* tstart = (LAS unsigned*)(misc + MI_TSTART); LAS unsigned* ystart = (LAS unsigned*)(misc + MI_YSTART);
    LAS unsigned* ntl = (LAS unsigned*)(misc + MI_NTILES); LAS unsigned char* tile_e = (LAS unsigned char*)(misc + MI_TILE_E);
    __syncthreads();
    if (tid < 64) { unsigned c = __hip_atomic_load(gcount + tid, RLX_AGENT); if (c > (unsigned)CAP) c = CAP; cnt[tid] = c; }
    __syncthreads();
    if (tid < 64) { unsigned ts = 64u, ys = 0u; for (int e = 0; e < tid; ++e) { const unsigned c = cnt[e]; ts += (c + 255u) >> 8; ys += c; }
        tstart[tid] = ts; ystart[tid] = ys; const unsigned mynt = (cnt[tid] + 255u) >> 8;
        for (unsigned i = 0; i < mynt; ++i) if (ts + i < 640u) tile_e[ts + i] = (unsigned char)tid;
        if (tid == 63) ntl[0] = ts + mynt; }
    __syncthreads();
    pg8::MoeInfo mi; mi.cnt = cnt; mi.tstart = tstart; mi.ystart = ystart; mi.tile_e = tile_e; mi.ntiles = __builtin_amdgcn_readfirstlane((int)ntl[0]);
    if (mi.ntiles > 640) mi.ntiles = 640;
    return mi;
}

__device__ __forceinline__ void phase_combine(const Args& a, int layer, LAS unsigned char* misc, int vcu, int G, bool dry) {
    const int tid = threadIdx.x, lane = tid & 63, wave = __builtin_amdgcn_readfirstlane(tid >> 6);
    const pg8::MoeInfo mi = moe_setup(a, layer, misc);
    float* xf = a.out; bf16* xb = (bf16*)(a.ws + WS_XB); const unsigned char* Y8 = (const unsigned char*)(a.ws + WS_Y);
    const unsigned* dest = (const unsigned*)(a.ws + WS_DEST); const float* gatev = (const float*)(a.ws + WS_GATE);
    const float* lng = a.in[I_LNFG] + layer * DM; const float* lnb = a.in[I_LNFB] + layer * DM;
    const int gw = vcu * NWAVES + wave, NGW = G * NWAVES;
#pragma unroll 1
    for (int rowa = gw; rowa < T_TOK; rowa += 2 * NGW) {
        float v[2][16]; float* of[2]; bf16* obf[2]; unsigned char* o8[2]; unsigned d[2][TOPK]; float gk[2][TOPK];
#pragma unroll
        for (int r = 0; r < 2; ++r) { const int row = rowa + r * NGW;
#pragma unroll
            for (int k = 0; k < TOPK; ++k) { d[r][k] = dest[row * 8 + k]; gk[r][k] = gatev[row * 8 + k]; } }
#pragma unroll
        for (int r = 0; r < 2; ++r) { const int row = rowa + r * NGW; float* xr = xf + (size_t)row * DM; of[r] = dry ? (float*)(a.ws + WS_H) + (size_t)row * DM : xr; obf[r] = (bf16*)(a.ws + WS_XR) + (size_t)row * DM; o8[r] = (unsigned char*)xb + (size_t)row * DM;
#pragma unroll
            for (int j = 0; j < 2; ++j) { const f32x4 p = *(const f32x4*)(xr + 8 * lane + 512 * j), q = *(const f32x4*)(xr + 8 * lane + 512 * j + 4);
#pragma unroll
                for (int i = 0; i < 4; ++i) { v[r][8 * j + i] = p[i] * ALPHA; v[r][8 * j + 4 + i] = q[i] * ALPHA; } } }
#pragma unroll
        for (int r = 0; r < 2; ++r) { const unsigned char* yr = Y8 + (size_t)(131072 + rowa + r * NGW) * DM;
#pragma unroll
            for (int j = 0; j < 2; ++j) { const v2u w = *(const v2u*)(yr + 8 * lane + 512 * j);
#pragma unroll
                for (int q = 0; q < 2; ++q) { const f32x2 lo2 = __builtin_amdgcn_cvt_pk_f32_fp8((int)w[q], false), hi2 = __builtin_amdgcn_cvt_pk_f32_fp8((int)w[q], true);
                    v[r][8 * j + 4 * q] += 0.0625f * lo2.x; v[r][8 * j + 4 * q + 1] += 0.0625f * lo2.y; v[r][8 * j + 4 * q + 2] += 0.0625f * hi2.x; v[r][8 * j + 4 * q + 3] += 0.0625f * hi2.y; } } }
#pragma unroll
        for (int r = 0; r < 2; ++r)
#pragma unroll
            for (int k = 0; k < TOPK; ++k) { const unsigned dd = (unsigned)__builtin_amdgcn_readfirstlane((int)d[r][k]); const float g = __uint_as_float((unsigned)__builtin_amdgcn_readfirstlane((int)__float_as_uint(gk[r][k])));
                const unsigned e = (dd >> 16) & 63u, pos = dd & 0xffffu; const unsigned char* yr = Y8 + (size_t)(mi.ystart[e] + pos) * DM; const float g16 = g * 0.0625f;
#pragma unroll
                for (int j = 0; j < 2; ++j) { const v2u w = *(const v2u*)(yr + 8 * lane + 512 * j);
#pragma unroll
                    for (int q = 0; q < 2; ++q) { const f32x2 lo2 = __builtin_amdgcn_cvt_pk_f32_fp8((int)w[q], false), hi2 = __builtin_amdgcn_cvt_pk_f32_fp8((int)w[q], true);
                        v[r][8 * j + 4 * q] += g16 * lo2.x; v[r][8 * j + 4 * q + 1] += g16 * lo2.y; v[r][8 * j + 4 * q + 2] += g16 * hi2.x; v[r][8 * j + 4 * q + 3] += g16 * hi2.y; } } }
        if (layer == 0 && !dry) ln_rows_store<2, 6>(v, lng, lnb, of, obf, o8, lane);
        else ln_rows_store<2, 1>(v, lng, lnb, of, obf, o8, lane);
    }
}

__device__ __forceinline__ int swz16(int row) { return (row ^ (row >> 4)) & 15; }
__device__ __forceinline__ void phase_sgu_spatial(const Args& a, LAS unsigned char* lds, int vcu, int G) {
    const int tid = threadIdx.x, lane = tid & 63, wave = __builtin_amdgcn_readfirstlane(tid >> 6), fr = lane & 15, fq = lane >> 4;
    const bf16* HS = (const bf16*)(a.ws + WS_HS); bf16* GT = (bf16*)(a.ws + WS_GATED);
    const float* lng = a.in[I_SLNG]; const float* lnb = a.in[I_SLNB]; const float* WS = a.in[I_SWS]; const float* BS = a.in[I_SBS];
    LAS unsigned char* Bs = lds;
    LAS unsigned char* As = lds + 65536;
    LAS float* stm = (LAS float*)(lds + 98304);
    LAS float* str = (LAS float*)(lds + 98304 + 512);
    for (int item = vcu; item < 512; item += G) {
        const int chunk = item >> 2, h = item & 3, t0 = chunk * 128;
        __syncthreads();
        if (tid < 128) { const f32x4* vs = (const f32x4*)((const float*)(a.ws + WS_VSTAT) + (size_t)(t0 + tid) * 64); float S = 0.f, Q = 0.f;
#pragma unroll
            for (int i = 0; i < 16; ++i) { const f32x4 p = vs[i]; S += p[0] + p[2]; Q += p[1] + p[3]; }
            const float mean = S * (1.0f / SGU_W); const float var = Q * (1.0f / SGU_W) - mean * mean;
            stm[tid] = mean; str[tid] = 1.0f / sqrtf((var > 0.f ? var : 0.f) + LN_EPS); }
        for (int q = tid; q < 128 * 16; q += NTHR) { const int i = q >> 4, jc = q & 15; const float* wp = WS + ((size_t)h * 128 + i) * 128 + 8 * jc;
            const f32x4 p0 = *(const f32x4*)wp, p1 = *(const f32x4*)(wp + 4); float w8[8];
#pragma unroll
            for (int z = 0; z < 4; ++z) { w8[z] = (8 * jc + z <= i) ? p0[z] : 0.f; w8[4 + z] = (8 * jc + 4 + z <= i) ? p1[z] : 0.f; }
            v4u o; o.x = cvt_pk_bf16(w8[0], w8[1]); o.y = cvt_pk_bf16(w8[2], w8[3]); o.z = cvt_pk_bf16(w8[4], w8[5]); o.w = cvt_pk_bf16(w8[6], w8[7]);
            *(LAS v4u*)(As + i * 256 + ((jc ^ swz16(i)) << 4)) = o; }
        __syncthreads();
        for (int hh = 0; hh < 2; ++hh) {
            const int cb = h * SGU_HD + hh * 256;
#pragma unroll 2
            for (int q = tid; q < 64 * 32; q += NTHR) { const int c8 = q & 31, jp = q >> 5, j0 = 2 * jp;
                const v4u w0 = *(const v4u*)(HS + (size_t)(t0 + j0) * 4096 + SGU_W + cb + 8 * c8), w1 = *(const v4u*)(HS + (size_t)(t0 + j0 + 1) * 4096 + SGU_W + cb + 8 * c8);
                const f32x4 g0 = *(const f32x4*)(lng + cb + 8 * c8), g1 = *(const f32x4*)(lng + cb + 8 * c8 + 4), b0 = *(const f32x4*)(lnb + cb + 8 * c8), b1 = *(const f32x4*)(lnb + cb + 8 * c8 + 4);
                const float m0 = stm[j0], r0 = str[j0], m1 = stm[j0 + 1], r1 = str[j0 + 1];
#pragma unroll
                for (int z = 0; z < 8; ++z) { const float gz = z < 4 ? g0[z & 3] : g1[z & 3], bz = z < 4 ? b0[z & 3] : b1[z & 3];
                    const float xa = (z & 1) ? bf_hi(w0[z >> 1]) : bf_lo(w0[z >> 1]), xc = (z & 1) ? bf_hi(w1[z >> 1]) : bf_lo(w1[z >> 1]);
                    const float ya = (xa - m0) * r0 * gz + bz, yc = (xc - m1) * r1 * gz + bz;
                    const int cc = 8 * c8 + z, slot = (cc & ~31) | (((cc >> 2) & 1) << 4) | (((cc >> 3) & 3) << 2) | (cc & 3);
                    *(LAS unsigned*)(Bs + slot * 256 + (((j0 >> 3) ^ swz16(slot)) << 4) + (j0 & 7) * 2) = cvt_pk_bf16(ya, yc); } }
            __syncthreads();
            f32x4 acc[8][2]; bf16x8 Bf[2][4];
#pragma unroll
            for (int n = 0; n < 2; ++n)
#pragma unroll
                for (int s = 0; s < 4; ++s) { const int slot = 32 * wave + 16 * n + fr; Bf[n][s] = *(const LAS bf16x8*)(Bs + slot * 256 + (((4 * s + fq) ^ swz16(slot)) << 4)); }
#pragma unroll
            for (int m = 0; m < 8; ++m) { acc[m][0] = (f32x4){0.f, 0.f, 0.f, 0.f}; acc[m][1] = (f32x4){0.f, 0.f, 0.f, 0.f};
#pragma unroll
                for (int s = 0; s < 4; ++s) if (s <= (m >> 1)) { const int i = 16 * m + fr; const bf16x8 af = *(const LAS bf16x8*)(As + i * 256 + (((4 * s + fq) ^ swz16(i)) << 4));
                    acc[m][0] = __builtin_amdgcn_mfma_f32_16x16x32_bf16(Bf[0][s], af, acc[m][0], 0, 0, 0); acc[m][1] = __builtin_amdgcn_mfma_f32_16x16x32_bf16(Bf[1][s], af, acc[m][1], 0, 0, 0); } }
#pragma unroll
            for (int m = 0; m < 8; ++m) { const int i = 16 * m + fr; const float bsv = BS[h * 128 + i]; const size_t t = (size_t)(t0 + i);
                const v4u uw = *(const v4u*)(HS + t * 4096 + cb + 32 * wave + 8 * fq); float o[8];
#pragma unroll
                for (int n = 0; n < 2; ++n)
#pragma unroll
                    for (int z = 0; z < 4; ++z) { const int c = 4 * n + z; const float uu = (c & 1) ? bf_hi(uw[c >> 1]) : bf_lo(uw[c >> 1]); o[c] = uu * (acc[m][n][z] + bsv); }
                v4u w; w.x = cvt_pk_bf16(o[0], o[1]); w.y = cvt_pk_bf16(o[2], o[3]); w.z = cvt_pk_bf16(o[4], o[5]); w.w = cvt_pk_bf16(o[6], o[7]);
                *(v4u*)(GT + t * SGU_W + cb + 32 * wave + 8 * fq) = w; }
            __syncthreads();
        }
    }
}

__device__ __forceinline__ void phase_flush(const Args& a, int vcu, int G) {
    const size_t gt = (size_t)vcu * NTHR + threadIdx.x, NT = (size_t)G * NTHR; f32x4 acc = (f32x4){0.f, 0.f, 0.f, 0.f};
    const f32x4* p0 = (const f32x4*)a.in[I_WG]; const f32x4* p1 = (const f32x4*)a.in[I_WU];
    for (size_t i = gt; i < (size_t)33554432 / 4; i += 4 * NT) { const f32x4 x0 = p0[i], x1 = p0[i + NT], x2 = p0[i + 2 * NT], x3 = p0[i + 3 * NT], y0 = p1[i], y1 = p1[i + NT], y2 = p1[i + 2 * NT], y3 = p1[i + 3 * NT]; acc += x0 + x1 + x2 + x3 + y0 + y1 + y2 + y3; }
    if (acc[0] + acc[1] + acc[2] + acc[3] == 1.2345e-30f) ((float*)(a.ws + WS_CTL))[16000] = acc[0];
}
constexpr int N_PHASES = 16;
__global__ void __launch_bounds__(NTHR, 2) mk_fwd(Args args) {
    extern __shared__ __attribute__((aligned(16))) unsigned char lds_raw[];
    LAS unsigned char* lds = (LAS unsigned char*)lds_raw;
    LAS unsigned char* misc = lds + MISC_OFF;
    const int tid = threadIdx.x;
    const int G = gridDim.x; const int bx = blockIdx.x; const int vcu = (G % 8 == 0) ? (bx % 8) * (G / 8) + bx / 8 : bx;
    unsigned char* ws = args.ws;
    unsigned* ctl = (unsigned*)(ws + WS_CTL);
    if (tid < 16) ((LAS unsigned*)(misc + MI_BARW))[tid] = 0u;
    __syncthreads();
    const int lo = args.ph_lo, hi = args.ph_hi;
    XcdBarrier bar; bar.bar = ctl + CW_BAR; bar.x = 0; bar.st = nullptr;
    if (hi - lo > 1) bar = xcd_barrier_post(ctl + CW_BAR, (volatile LAS unsigned*)(misc + MI_BARW));
#ifndef PH_MASK
#define PH_MASK 0xFFFF
#endif
#define IN(k) (((PH_MASK >> (k)) & 1) && lo <= (k) && (k) < hi)
#ifndef TS_A0
#define TS_A0 -1
#define TS_A1 -1
#define TS_M 1
#endif
    unsigned long long* tsbuf = (unsigned long long*)(ws + 32768);
#define TS_REC(k) do { if (TS_A0 >= 0 && bx == 0 && tid == 0) __hip_atomic_store(tsbuf + (k), (unsigned long long)__builtin_amdgcn_s_memrealtime(), RLX_AGENT); } while (0)
    TS_REC(0);
#ifndef REP_PH
#define REP_PH -1
#define REP_N 1
#endif
#define NREP(k) ((k) == REP_PH ? REP_N : 1)
#ifndef FLUSH_PH
#define FLUSH_PH -2
#endif
#define RUN(k) if (IN(k)) for (int rep = 0; rep < NREP(k); ++rep) if ((((k) == FLUSH_PH && rep == NREP(k) - 1) ? (xcd_barrier(bar), phase_flush(args, vcu, G), xcd_barrier(bar), true) : true))
#define DRY(k) (rep + 1 < NREP(k))
#define BG_LAYER(k) (-1)
#define SEAM(k) do { if (IN(k) && IN((k) + 1)) xcd_barrier(bar, &args, BG_LAYER(k), lds); TS_REC((k) + 1); } while (0)
    using namespace pg8;
    RUN(0) { phase_p0(args, lds, vcu, G); } SEAM(0);
    RUN(1) { DenseSched S{(const char*)(ws + WS_XB), (const char*)(ws + WS_WIN), 2048u, 2048u, 0u, 64, 4, 256, G, bx};
        EpiBf16<0, false, false> E{(bf16*)(ws + WS_Z), DM, nullptr, nullptr, nullptr};
        gemm_phase<EpiBf16<0, false, false>, DenseSched, false, true, true>(lds, 2048u, 2048u, 16, S, E); } SEAM(1);
    if (REP_PH == 100 && hi - lo > 1) for (int i = 0; i < REP_N; ++i) xcd_barrier(bar);
    RUN(3) { DenseSched S{(const char*)(ws + WS_POOLED), (const char*)(ws + WS_WGRP), 2048u, 512u, 512u, 64, 4, 256, G, bx};
        { Unit u0; if (S.next(0, u0)) pool_block(args, u0.i0, u0.i1); }
        EpiBf16<0, false, true> E{(bf16*)(ws + WS_YP), DM, nullptr, args.in[I_PSCALE], nullptr};
        gemm_phase<EpiBf16<0, false, true>, DenseSched, false, true, true>(lds, 2048u, 512u, 4, S, E); } SEAM(3);
    RUN(4) { DenseSched S{(const char*)(ws + WS_YP), (const char*)(ws + WS_WOUT), 2048u, 2048u, 0u, 64, 4, 256, G, bx};
        EpiResidB<false> E{args.in[I_X], (bf16*)(ws + WS_XR)};
        gemm_phase<EpiResidB<false>, DenseSched, false, true, true>(lds, 2048u, 2048u, 16, S, E); } SEAM(4);
#define MOE_PHASES(layer, pb) do { \
        RUN(pb) { phase_lnr(args, layer, lds, vcu, G, DRY(pb)); } SEAM(pb); \
        RUN((pb) + 1) { const MoeInfo mi = moe_setup(args, layer, misc); \
            G1Sched S{mi, (const char*)(ws + WS_XB), (const char*)(ws + WS_WGU + (size_t)layer * WS_MOE_LSTRIDE), (const unsigned*)(ws + WS_ROWTOK), (const unsigned*)(ws + WS_IDENT), G, vcu}; \
            EpiSwiglu E{(unsigned char*)(ws + WS_H)}; \
            gemm_phase<EpiSwiglu, G1Sched, true, true, false, 0, 1>(lds, 1024u, 1024u, 8, S, E); } SEAM((pb) + 1); \
        if (IN((pb) + 2) && REP_PH == (pb) + 2) { const MoeInfo mi = moe_setup(args, layer, misc); \
            G2Sched S{mi, (const char*)(ws + WS_H), (const char*)(ws + WS_WDN + (size_t)layer * WS_MOE_LSTRIDE), G, vcu, 256}; \
            EpiDown E{(unsigned char*)(ws + WS_Y)}; \
            gemm_phase<EpiDown, G2Sched, false, true, true, 1, 1>(lds, 256u, 256u, 2, S, E); } \
        if (IN((pb) + 2)) { const MoeInfo mi = moe_setup(args, layer, misc); \
            G2Sched S{mi, (const char*)(ws + WS_H), (const char*)(ws + WS_WDN + (size_t)layer * WS_MOE_LSTRIDE), G, vcu, 0}; \
            EpiDown E{(unsigned char*)(ws + WS_Y)}; \
            gemm_phase<EpiDown, G2Sched, false, true, true, 1, 1>(lds, 256u, 256u, 2, S, E); } SEAM((pb) + 2); \
        RUN((pb) + 3) { phase_combine(args, layer, misc, vcu, G, DRY((pb) + 3)); if (layer == 0 && !DRY((pb) + 3)) { __syncthreads(); convert_static(args, 1, lds, vcu, G); } } \
    } while (0)
    MOE_PHASES(0, 5); SEAM(8);
    RUN(9) { DenseSched S{(const char*)(ws + WS_XB), (const char*)(ws + WS_WSIN), 1024u, 1024u, 0u, 64, 16, 1024, G, bx, (const unsigned*)(ws + WS_IDENT)};
        EpiBf16<1, true, false, true, true> E{(bf16*)(ws + WS_HS), 4096, args.in[I_SBIN], nullptr, (float*)(ws + WS_VSTAT)};
        gemm_phase<EpiBf16<1, true, false, true, true>, DenseSched, true, true, false, 0, 1>(lds, 1024u, 1024u, 8, S, E); } SEAM(9);
    RUN(10) { phase_sgu_spatial(args, lds, vcu, G); } SEAM(10);
    RUN(11) { DenseSched S{(const char*)(ws + WS_GATED), (const char*)(ws + WS_WSOUT), 4096u, 4096u, 0u, 64, 4, 256, G, bx};
        EpiResidB<true> E{ws + WS_XR, (bf16*)(ws + WS_XR)};
        gemm_phase<EpiResidB<true>, DenseSched, false, true, true>(lds, 4096u, 4096u, 32, S, E); } SEAM(11);
    MOE_PHASES(1, 12);
#undef MOE_PHASES
    if (TS_A0 >= 0 && bx == 0 && tid == 0) {
        const unsigned long long tend = __builtin_amdgcn_s_memrealtime();
        const unsigned long long t0 = __hip_atomic_load(tsbuf + TS_A0, RLX_AGENT), t1 = (TS_A1 + 1 >= N_PHASES) ? tend : __hip_atomic_load(tsbuf + TS_A1 + 1, RLX_AGENT);
        const unsigned long long wait = (t1 - t0) * TS_M;
        while (__builtin_amdgcn_s_memrealtime() - tend < wait) __builtin_amdgcn_s_sleep(8);
    }
#undef IN
#undef SEAM
}

extern "C" void kernel_launch(void* const* d_in, const int* in_sizes, int n_in, void* d_out, int out_size, void* d_ws, size_t ws_size, hipStream_t stream) {
    static int grid = 0;
    if (grid == 0) {
        if (n_in != 24 || out_size != T_TOK * DM || ws_size < WS_END) { fprintf(stderr, "kernel_launch: unexpected shapes (n_in %d out %d ws %zu)\n", n_in, out_size, ws_size); grid = -1; return; }
        int dev = 0, cus = 0;
        if (hipGetDevice(&dev) != hipSuccess || hipDeviceGetAttribute(&cus, hipDeviceAttributeMultiprocessorCount, dev) != hipSuccess) { grid = -1; return; }
        if (hipFuncSetAttribute((const void*)mk_fwd, hipFuncAttributeMaxDynamicSharedMemorySize, LDS_BYTES) != hipSuccess) { fprintf(stderr, "kernel_launch: hipFuncSetAttribute failed\n"); grid = -1; return; }
        int per_cu = 0;
        if (hipOccupancyMaxActiveBlocksPerMultiprocessor(&per_cu, (const void*)mk_fwd, NTHR, LDS_BYTES) != hipSuccess || per_cu < 1) fprintf(stderr, "kernel_launch: occupancy query says %d\n", per_cu);
        (void)hipGetLastError();
        grid = cus;
        if (grid != 256) { fprintf(stderr, "kernel_launch: built for a 256-CU device (got %d)\n", cus); grid = -1; return; }
    }
    if (grid < 0) return;
    (void)hipMemsetAsync((char*)d_ws + WS_CTL, 0, CTL_ZERO_BYTES, stream);
    Args a{};
    for (int i = 0; i < 24; ++i) a.in[i] = (const float*)d_in[i];
    a.out = (float*)d_out; a.ws = (unsigned char*)d_ws;
#if MK_PER_PHASE
    for (int p = 0; p < N_PHASES; ++p) { a.ph_lo = p; a.ph_hi = p + 1; hipLaunchKernelGGL(mk_fwd, dim3(grid), dim3(NTHR), LDS_BYTES, stream, a); }
#else
    a.ph_lo = 0; a.ph_hi = N_PHASES; hipLaunchKernelGGL(mk_fwd, dim3(grid), dim3(NTHR), LDS_BYTES, stream, a);
#endif
}
```

```cpp
#include <hip/hip_runtime.h>
#include <cstdio>
#include <cstdint>

#ifndef MK_PER_PHASE
#define MK_PER_PHASE 0
#endif

#define GAS __attribute__((address_space(1)))
#define LAS __attribute__((address_space(3)))
typedef unsigned short bf16;
typedef unsigned v4u __attribute__((ext_vector_type(4)));
typedef unsigned v2u __attribute__((ext_vector_type(2)));
typedef float f32x4 __attribute__((ext_vector_type(4)));
typedef float f32x2 __attribute__((ext_vector_type(2)));
typedef short bf16x8 __attribute__((ext_vector_type(8)));
#define RLX_AGENT __ATOMIC_RELAXED, __HIP_MEMORY_SCOPE_AGENT
#define LDS_WAIT() asm volatile("s_waitcnt lgkmcnt(0)" ::: "memory")
#define VM_WAIT() asm volatile("s_waitcnt vmcnt(0)" ::: "memory")

constexpr int T_TOK = 16384, DM = 1024, SEQ = 4096, NE = 64, TOPK = 8, EDIM = 256;
constexpr int SGU_W = 2048, SGU_HD = 512;
constexpr float ALPHA = 1.41421356237309515f;
constexpr float LN_EPS = 1e-5f, ROUTED_SCALE = 2.5f;
constexpr int CAP = 16384;
constexpr int NWAVES = 8, NTHR = 512;

constexpr size_t MiB = 1u << 20;
constexpr size_t WS_CTL = 0, CTL_ZERO_BYTES = 65536;
constexpr size_t WS_IDENT = 256 * 1024;
constexpr size_t WS_DEST = 1 * MiB;
constexpr size_t WS_GATE = WS_DEST + 512 * 1024;
constexpr size_t WS_ROWTOK = 2 * MiB;
constexpr size_t WS_VSTAT = WS_ROWTOK;
constexpr size_t WS_WIN = 6 * MiB;
constexpr size_t WS_WGRP = 8 * MiB;
constexpr size_t WS_WOUT = WS_WGRP + 512 * 1024;
constexpr size_t WS_WSIN = WS_WOUT + 2 * MiB;
constexpr size_t WS_WSOUT = WS_WSIN + 8 * MiB;
constexpr size_t WS_WRT = WS_WSOUT + 4 * MiB;
constexpr size_t WS_WGU = 23 * MiB;
constexpr size_t WS_WDN = WS_WGU + 65 * MiB;
constexpr size_t WS_XB = 121 * MiB;
constexpr size_t WS_H = 153 * MiB;
constexpr size_t WS_Y = 233 * MiB;
constexpr size_t WS_WGU1 = 378 * MiB, WS_WDN1 = WS_WGU1 + 65 * MiB;
constexpr size_t WS_MOE_LSTRIDE = WS_WGU1 - WS_WGU;
constexpr size_t WS_XR = 476 * MiB;
constexpr size_t WS_END = 508 * MiB;
constexpr size_t WS_Z = 153 * MiB, WS_POOLED = 185 * MiB, WS_YP = 217 * MiB;
constexpr size_t WS_HS = 153 * MiB;
constexpr size_t WS_GATED = 281 * MiB;
static_assert(WS_WRT + 512 * 1024 <= WS_WGU && WS_WDN + 33 * MiB <= WS_XB && WS_XB + 32 * MiB <= WS_H && WS_H + 80 * MiB <= WS_Y && WS_Y + 145 * MiB <= WS_WGU1 && WS_WDN1 + 33 * MiB <= WS_END && WS_GATED + 64 * MiB <= WS_WGU1, "ws map");
constexpr int CW_TMO = 0, CW_BAR = 64, CW_CNT = 4096, CW_QNEXT = 4608;

constexpr int RING_BYTES = 131072;
constexpr int MISC_OFF = RING_BYTES;
constexpr int LDS_BYTES = 147456;
constexpr int MI_BARW = 0, MI_CNT = 64, MI_TSTART = 320, MI_YSTART = 576, MI_NTILES = 832, MI_TILE_E = 1024;

__device__ __forceinline__ unsigned cvt_pk_bf16(float lo, float hi) { unsigned r; asm volatile("v_cvt_pk_bf16_f32 %0, %1, %2" : "=v"(r) : "v"(lo), "v"(hi)); return r; }
__device__ __forceinline__ float bf_lo(unsigned w) { return __uint_as_float(w << 16); }
__device__ __forceinline__ float bf_hi(unsigned w) { return __uint_as_float(w & 0xffff0000u); }
__device__ __forceinline__ float wave_sum(float v) {
#pragma unroll
    for (int o = 1; o < 64; o <<= 1) v += __shfl_xor(v, o);
    return v;
}
__device__ __forceinline__ float sigmoidf_(float x) { return __builtin_amdgcn_rcpf(1.0f + __builtin_amdgcn_exp2f(-1.4426950408889634f * x)); }
__device__ __forceinline__ f32x2 gelu_tanh2(f32x2 v) { const f32x2 v2 = v * v; const f32x2 y = v * (v2 * 0.044715f + 1.0f); const f32x2 t = y * (-2.3022081983f);
    f32x2 e; e.x = __builtin_amdgcn_exp2f(t.x); e.y = __builtin_amdgcn_exp2f(t.y); const f32x2 d = e + 1.0f; f32x2 r; r.x = __builtin_amdgcn_rcpf(d.x); r.y = __builtin_amdgcn_rcpf(d.y); return v * r; }
__device__ __forceinline__ float gelu_tanh(float v) { const float y = v + 0.044715f * v * v * v; return v * __builtin_amdgcn_rcpf(1.0f + __builtin_amdgcn_exp2f(-2.3022081983f * y)); }

#define XB_TMO      128
#define XB_XCNT(j)  (256  + 64 * (j))
#define XB_XSUB(j)  (1280 + 64 * (j))
#define XB_XGEN(j)  (2304 + 64 * (j))
#define XB_TOP      3328
#define XB_TOPGEN   3392
#define XCD_BAR_WORDS 3456
#define XB_SPIN_CAP (1u << 20)
__device__ __forceinline__ unsigned xb_ld(unsigned* p)              { return __hip_atomic_load(p, __ATOMIC_RELAXED, __HIP_MEMORY_SCOPE_AGENT); }
__device__ __forceinline__ unsigned xb_add(unsigned* p, unsigned v) { return __hip_atomic_fetch_add(p, v, __ATOMIC_RELAXED, __HIP_MEMORY_SCOPE_AGENT); }
__device__ __forceinline__ unsigned xb_xcc_id() { return (unsigned)__builtin_amdgcn_s_getreg((3 << 11) | 20) & 0xFu; }
#define XB_SPIN(cond, bar) do { unsigned _sp = 0; while (cond) { __builtin_amdgcn_s_sleep(1); \
    if ((++_sp & 255u) == 0u) { if (xb_ld(&(bar)[XB_TMO])) break; if (_sp > XB_SPIN_CAP) { atomicAdd(&(bar)[XB_TMO], 1u); break; } } } } while (0)
struct XcdBarrier { unsigned* bar; unsigned x; volatile LAS unsigned* st; };
__device__ __forceinline__ XcdBarrier xcd_barrier_post(unsigned* bar, volatile LAS unsigned* st) {
    XcdBarrier b; b.bar = bar; b.x = xb_xcc_id(); b.st = st;
    if (threadIdx.x == 0) (void)xb_add(&bar[XB_XCNT(b.x)], 1u);
    return b;
}
__device__ __forceinline__ void xcd_barrier_complete(unsigned* bar, unsigned x, unsigned& nloc, unsigned& nx) {
    const unsigned G = gridDim.x * gridDim.y * gridDim.z;
    unsigned sum, cnt, mine, sp = 0u;
    for (;;) {
        sum = 0u; cnt = 0u; mine = 0u;
#pragma unroll
        for (unsigned j = 0; j < 16; ++j) { const unsigned c = xb_ld(&bar[XB_XCNT(j)]); sum += c; cnt += (c > 0u) ? 1u : 0u; mine = (j == x) ? c : mine; }
        if (sum == G) break;
        __builtin_amdgcn_s_sleep(1);
        if ((++sp & 255u) == 0u) { if (xb_ld(&bar[XB_TMO])) break; if (sp > XB_SPIN_CAP) { atomicAdd(&bar[XB_TMO], 1u); break; } }
    }
    nloc = mine > 0u ? mine : 1u; nx = cnt > 0u ? cnt : 1u;
}
struct Args;
__device__ __forceinline__ bool convert_steal(const Args& a, int layer, LAS unsigned char* lds, int wave, int lane);
__device__ __forceinline__ void xcd_barrier(const XcdBarrier& b, const Args* bga = nullptr, int bg_layer = -1, LAS unsigned char* lds = nullptr) {
    asm volatile("s_waitcnt vmcnt(0)" ::: "memory");
    __syncthreads();
    if (threadIdx.x == 0) {
        unsigned* bar = b.bar;
        __builtin_amdgcn_s_waitcnt(0);
        unsigned nloc = b.st[0], nx = b.st[1];
        if (nloc == 0u) { xcd_barrier_complete(bar, b.x, nloc, nx); b.st[0] = nloc; b.st[1] = nx; }
        const unsigned old = xb_add(&bar[XB_XSUB(b.x)], 1u);
        const unsigned gen = old / nloc;
        if (old + 1u == (gen + 1u) * nloc) {
            __builtin_amdgcn_fence(__ATOMIC_RELEASE, "agent");
            asm volatile("s_waitcnt vmcnt(0)" ::: "memory");
            const unsigned og = xb_add(&bar[XB_TOP], 1u);
            const unsigned tg = og / nx;
            if (og + 1u == (tg + 1u) * nx) xb_add(&bar[XB_TOPGEN], 1u);
            else XB_SPIN(xb_ld(&bar[XB_TOPGEN]) == tg, bar);
            __builtin_amdgcn_fence(__ATOMIC_ACQUIRE, "agent");
            xb_add(&bar[XB_XGEN(b.x)], 1u);
            asm volatile("s_waitcnt vmcnt(0)" ::: "memory");
            b.st[2] = 0xFFFFFFFFu;
        } else if (bg_layer < 0) {
            XB_SPIN(xb_ld(&bar[XB_XGEN(b.x)]) == gen, bar);
            __builtin_amdgcn_fence(__ATOMIC_ACQUIRE, "agent");
            asm volatile("s_waitcnt vmcnt(0)" ::: "memory");
            b.st[2] = 0xFFFFFFFFu;
        } else b.st[2] = gen;
    }
    __syncthreads();
    if (bg_layer >= 0) {
        const unsigned gen = b.st[2];
        if (gen != 0xFFFFFFFFu) {
            const int lane = threadIdx.x & 63, wave = __builtin_amdgcn_readfirstlane(threadIdx.x >> 6);
            bool more = true;
            while (more && (unsigned)__builtin_amdgcn_readfirstlane((int)xb_ld(&b.bar[XB_XGEN(b.x)])) == gen) more = convert_steal(*bga, bg_layer, lds, wave, lane);
            asm volatile("s_waitcnt vmcnt(0)" ::: "memory");
            __syncthreads();
            if (threadIdx.x == 0) { XB_SPIN(xb_ld(&b.bar[XB_XGEN(b.x)]) == gen, b.bar); __builtin_amdgcn_fence(__ATOMIC_ACQUIRE, "agent"); asm volatile("s_waitcnt vmcnt(0)" ::: "memory"); }
        } else __syncthreads();
        __syncthreads();
    }
}

namespace pg8 {
constexpr int BM = 256, BK = 64, HALF = 128, HTB = HALF * BK * 2, STAGE_BYTES = 8 * HTB, NXCD = 8, WGM = 8;
__host__ __device__ __forceinline__ int lds_byte(int r, int c) { const int st = (r >> 4) * 2 + (c >> 5), rr = r & 15, cc = c & 31, ob = rr * 64 + cc * 2; return st * 1024 + (ob ^ (((ob >> 9) & 1) << 5)); }
__host__ __device__ __forceinline__ void stage_rc(int b, int& R, int& C) { const int st = b / 1024, sb = b % 1024, swz = sb ^ (((sb >> 9) & 1) << 5); R = (st >> 1) * 16 + swz / 64; C = (st & 1) * 32 + (swz % 64) / 2; }
__host__ __device__ __forceinline__ int perm32(int rho) { const int n = rho >> 4, i = rho & 15; return 8 * (i >> 2) + 4 * n + (i & 3); }

typedef int v8i __attribute__((ext_vector_type(8)));
typedef int v4i __attribute__((ext_vector_type(4)));
__device__ __forceinline__ v8i cat8(bf16x8 lo, bf16x8 hi) { const v4i a = __builtin_bit_cast(v4i, lo), b = __builtin_bit_cast(v4i, hi); return __builtin_shufflevector(a, b, 0, 1, 2, 3, 4, 5, 6, 7); }
struct Unit { const char* A; const char* B; const unsigned* gat; int nvalid; int i0, i1, i2; };

template <class Epi, class Sched, bool GATHER, bool ALIGN_EPI, bool SP2, int BMODE = 0, int F8 = 0>
__device__ __forceinline__ void gemm_phase(LAS unsigned char* lds, const unsigned lda, const unsigned ldb, const int nt, const Sched& S, const Epi& E) {
    const int tid = threadIdx.x, wid = __builtin_amdgcn_readfirstlane(tid >> 6), lane = tid & 63, wr = wid >> 2, wc = wid & 3, fr = lane & 15, fq = lane >> 4;
    int R0, C0, R1, C1; stage_rc(tid * 16, R0, C0); stage_rc(tid * 16 + 8192, R1, C1);
    const int Rb0 = BMODE == 0 ? (R0 & ~31) + perm32(R0 & 31) : 64 * (R0 >> 5) + 16 * ((R0 & 15) >> 2) + 4 * ((R0 >> 4) & 1) + (R0 & 3);
    const int Rb1 = BMODE == 0 ? (R1 & ~31) + perm32(R1 & 31) : 64 * (R1 >> 5) + 16 * ((R1 & 15) >> 2) + 4 * ((R1 >> 4) & 1) + (R1 & 3);
    const unsigned voffB0 = (unsigned)Rb0 * ldb + (unsigned)C0 * 2u, voffB1 = (unsigned)Rb1 * ldb + (unsigned)C1 * 2u;
    const size_t hstepB = (size_t)(BMODE == 0 ? HALF : 8) * ldb;
    const size_t kstep = (size_t)(BK * 2);
    const unsigned ldsw = (unsigned)wid * 1024u;
    const int aoff = lds_byte(wr * 64 + fr, F8 ? fq * 16 : fq * 8), boff = lds_byte(wc * 32 + fr, F8 ? fq * 16 : fq * 8);
    const int aoff2 = F8 ? lds_byte(wr * 64 + fr, fq * 16 + 8) : aoff + 1024, boff2 = F8 ? lds_byte(wc * 32 + fr, fq * 16 + 8) : boff + 1024;
#define PG8_SA(b, h) (((b) * 2 + (h)) * HTB)
#define PG8_SB(b, h) ((4 + (b) * 2 + (h)) * HTB)
#define PG8_STAGE(bufoff, gbase, v0, v1) do { unsigned _v0 = (v0), _v1 = (v1); asm volatile("" : "+v"(_v0), "+v"(_v1)); \
        __builtin_amdgcn_global_load_lds((const unsigned*)((const char*)(gbase) + _v0), (LAS unsigned*)(lds + (bufoff) + ldsw), 16, 0, 0); \
        __builtin_amdgcn_global_load_lds((const unsigned*)((const char*)(gbase) + _v1), (LAS unsigned*)(lds + (bufoff) + ldsw + 8192), 16, 0, 0); } while (0)
#define PG8_LDA(dst, b, h) do { _Pragma("unroll") for (int m = 0; m < 4; ++m) { dst[m][0] = *(const LAS bf16x8*)(lds + PG8_SA(b, h) + aoff + m * 2048); dst[m][1] = *(const LAS bf16x8*)(lds + PG8_SA(b, h) + aoff2 + m * 2048); } } while (0)
#define PG8_LDB(dst, b, h) do { _Pragma("unroll") for (int n = 0; n < 2; ++n) { dst[n][0] = *(const LAS bf16x8*)(lds + PG8_SB(b, h) + boff + n * 2048); dst[n][1] = *(const LAS bf16x8*)(lds + PG8_SB(b, h) + boff2 + n * 2048); } } while (0)
#define PG8_MMA(ai, bj, At, Bt) do { __builtin_amdgcn_s_setprio(1); _Pragma("unroll") for (int m = 0; m < 4; ++m) _Pragma("unroll") for (int n = 0; n < 2; ++n) { \
        if constexpr (F8) acc[ai][bj][m][n] = __builtin_amdgcn_mfma_scale_f32_16x16x128_f8f6f4(cat8(Bt[n][0], Bt[n][1]), cat8(At[m][0], At[m][1]), acc[ai][bj][m][n], 0, 0, 0, 0x7F7F7F7F, 0, 0x7F7F7F7F); \
        else { _Pragma("unroll") for (int k = 0; k < 2; ++k) acc[ai][bj][m][n] = __builtin_amdgcn_mfma_f32_16x16x32_bf16(Bt[n][k], At[m][k], acc[ai][bj][m][n], 0, 0, 0); } } __builtin_amdgcn_s_setprio(0); } while (0)
#define PG8_WAIT_V(n) asm volatile("s_waitcnt vmcnt(" #n ")" ::: "memory")
#define PG8_WAIT_L(n) asm volatile("s_waitcnt lgkmcnt(" #n ")" ::: "memory")
#define PG8_BAR __builtin_amdgcn_s_barrier()
#define PG8_SCHED __builtin_amdgcn_sched_barrier(0)
#define PG8_SETV(v00, v01, v10, v11, u) do { \
        if (GATHER) { int _t = tid; asm volatile("" : "+v"(_t)); int r0, c0, r1, c1; stage_rc(_t * 16, r0, c0); stage_rc(_t * 16 + 8192, r1, c1);     \
            const unsigned ta = r0 < (u).nvalid ? (u).gat[r0] : 0u, tb = r1 < (u).nvalid ? (u).gat[r1] : 0u, \
                                     tc = (HALF + r0) < (u).nvalid ? (u).gat[HALF + r0] : 0u, td = (HALF + r1) < (u).nvalid ? (u).gat[HALF + r1] : 0u; \
            v00 = ta * lda + (unsigned)c0 * 2u; v01 = tb * lda + (unsigned)c1 * 2u; v10 = tc * lda + (unsigned)c0 * 2u; v11 = td * lda + (unsigned)c1 * 2u; } \
        else { v00 = (unsigned)R0 * lda + (unsigned)C0 * 2u; v01 = (unsigned)R1 * lda + (unsigned)C1 * 2u; v10 = (unsigned)(HALF + R0) * lda + (unsigned)C0 * 2u; v11 = (unsigned)(HALF + R1) * lda + (unsigned)C1 * 2u; } } while (0)
    Unit cur, nxt; int ui = 0;
    if (!S.next(0, cur)) return;
    f32x4 acc[2][2][4][2];
#pragma unroll
    for (int a = 0; a < 2; ++a)
#pragma unroll
        for (int b = 0; b < 2; ++b)
#pragma unroll
            for (int m = 0; m < 4; ++m)
#pragma unroll
                for (int n = 0; n < 2; ++n) acc[a][b][m][n] = (f32x4){0.f, 0.f, 0.f, 0.f};
    bf16x8 At[4][2], B0[2][2], B1[2][2];
    const char* cA = cur.A; const char* cB = cur.B;
    unsigned cv00, cv01, cv10, cv11;
    PG8_SETV(cv00, cv01, cv10, cv11, cur);
    if constexpr (SP2) {
        PG8_STAGE(PG8_SB(0, 0), cB, voffB0, voffB1); PG8_STAGE(PG8_SB(0, 1), cB + hstepB, voffB0, voffB1); PG8_STAGE(PG8_SA(0, 0), cA, cv00, cv01); PG8_STAGE(PG8_SA(0, 1), cA, cv10, cv11);
        if (wr == 1) PG8_BAR;
        PG8_WAIT_V(2); PG8_BAR;
        PG8_STAGE(PG8_SB(1, 0), cB + kstep, voffB0, voffB1); PG8_STAGE(PG8_SA(1, 0), cA + kstep, cv00, cv01); PG8_STAGE(PG8_SB(1, 1), cB + hstepB + kstep, voffB0, voffB1);
        PG8_WAIT_V(6); PG8_BAR;
    } else {
        PG8_STAGE(PG8_SB(0, 0), cB, voffB0, voffB1); PG8_STAGE(PG8_SA(0, 0), cA, cv00, cv01); PG8_STAGE(PG8_SB(0, 1), cB + hstepB, voffB0, voffB1); PG8_STAGE(PG8_SA(0, 1), cA, cv10, cv11);
        if (wr == 1) PG8_BAR;
        PG8_WAIT_V(4); PG8_BAR;
        PG8_STAGE(PG8_SB(1, 0), cB + kstep, voffB0, voffB1); PG8_STAGE(PG8_SA(1, 0), cA + kstep, cv00, cv01); PG8_STAGE(PG8_SB(1, 1), cB + hstepB + kstep, voffB0, voffB1);
        PG8_WAIT_V(6); PG8_BAR;
    }
    for (;;) {
        const bool has_next = S.next(ui + 1, nxt);
        const char* nA = has_next ? nxt.A : cA; const char* nB = has_next ? nxt.B : cB;
#pragma unroll 1
        for (int t = 0; t < nt; t += 2) {
            const bool last = (t == nt - 2);
            const char* a1 = cA + (size_t)(t + 1) * kstep;
            const char* a2 = last ? nA : cA + (size_t)(t + 2) * kstep; const char* b2 = last ? nB : cB + (size_t)(t + 2) * kstep;
            const char* a3 = a2 + kstep; const char* b3 = b2 + kstep;
            if constexpr (SP2) {
            PG8_LDB(B0, 0, 0); PG8_LDB(B1, 0, 1); PG8_SCHED; PG8_LDA(At, 0, 0); PG8_STAGE(PG8_SA(1, 1), a1, cv10, cv11);
            PG8_WAIT_V(8); PG8_WAIT_L(0); PG8_BAR; PG8_MMA(0, 0, At, B0); PG8_MMA(0, 1, At, B1); PG8_BAR; PG8_SCHED;
            if constexpr (GATHER) { if (last && has_next) { PG8_SETV(cv00, cv01, cv10, cv11, nxt); } }
            PG8_LDA(At, 0, 1); PG8_STAGE(PG8_SB(0, 0), b2, voffB0, voffB1); PG8_STAGE(PG8_SB(0, 1), b2 + hstepB, voffB0, voffB1); PG8_STAGE(PG8_SA(0, 0), a2, cv00, cv01);
            PG8_WAIT_V(8); PG8_WAIT_L(0); PG8_BAR; PG8_MMA(1, 0, At, B0); PG8_MMA(1, 1, At, B1); PG8_BAR; PG8_SCHED;
            PG8_LDB(B0, 1, 0); PG8_LDB(B1, 1, 1); PG8_SCHED; PG8_LDA(At, 1, 0); PG8_STAGE(PG8_SA(0, 1), a2, cv10, cv11);
            PG8_WAIT_V(8); PG8_WAIT_L(0); PG8_BAR; PG8_MMA(0, 0, At, B0); PG8_MMA(0, 1, At, B1); PG8_BAR; PG8_SCHED;
            PG8_LDA(At, 1, 1); PG8_STAGE(PG8_SB(1, 0), b3, voffB0, voffB1); PG8_STAGE(PG8_SB(1, 1), b3 + hstepB, voffB0, voffB1); PG8_STAGE(PG8_SA(1, 0), a3, cv00, cv01);
            PG8_WAIT_V(8); PG8_WAIT_L(0); PG8_BAR; PG8_MMA(1, 0, At, B0); PG8_MMA(1, 1, At, B1); PG8_BAR; PG8_SCHED;
            } else {
            PG8_LDB(B0, 0, 0); PG8_SCHED; PG8_LDA(At, 0, 0); PG8_STAGE(PG8_SA(1, 1), a1, cv10, cv11);
            PG8_WAIT_L(8); PG8_BAR; PG8_WAIT_L(0); PG8_MMA(0, 0, At, B0); PG8_BAR; PG8_SCHED;
            if constexpr (GATHER) { if (last && has_next) { PG8_SETV(cv00, cv01, cv10, cv11, nxt); } }
            PG8_LDB(B1, 0, 1); PG8_STAGE(PG8_SB(0, 0), b2, voffB0, voffB1);
            PG8_BAR; PG8_WAIT_L(0); PG8_MMA(0, 1, At, B1); PG8_BAR;
            PG8_LDA(At, 0, 1); PG8_STAGE(PG8_SA(0, 0), a2, cv00, cv01);
            PG8_BAR; PG8_WAIT_L(0); PG8_MMA(1, 0, At, B0); PG8_BAR; PG8_SCHED;
            PG8_STAGE(PG8_SB(0, 1), b2 + hstepB, voffB0, voffB1);
            PG8_WAIT_V(6); PG8_BAR; PG8_MMA(1, 1, At, B1); PG8_BAR;
            PG8_LDB(B0, 1, 0); PG8_SCHED; PG8_LDA(At, 1, 0); PG8_STAGE(PG8_SA(0, 1), a2, cv10, cv11);
            PG8_WAIT_L(8); PG8_BAR; PG8_WAIT_L(0); PG8_MMA(0, 0, At, B0); PG8_BAR; PG8_SCHED;
            PG8_LDB(B1, 1, 1); PG8_STAGE(PG8_SB(1, 0), b3, voffB0, voffB1);
            PG8_BAR; PG8_WAIT_L(0); PG8_MMA(0, 1, At, B1); PG8_BAR;
            PG8_LDA(At, 1, 1); PG8_STAGE(PG8_SA(1, 0), a3, cv00, cv01);
            PG8_BAR; PG8_WAIT_L(0); PG8_MMA(1, 0, At, B0); PG8_BAR; PG8_SCHED;
            PG8_STAGE(PG8_SB(1, 1), b3 + hstepB, voffB0, voffB1);
            PG8_WAIT_V(6); PG8_BAR; PG8_MMA(1, 1, At, B1); PG8_BAR;
            }
        }
        if constexpr (ALIGN_EPI) { if (wr == 0) PG8_BAR; }
        { int t2 = tid; asm volatile("" : "+v"(t2));
          E(acc, cur, wr, wc, t2 & 15, (t2 & 63) >> 4); }
        if (!has_next) break;
#pragma unroll
        for (int a = 0; a < 2; ++a)
#pragma unroll
            for (int b = 0; b < 2; ++b)
#pragma unroll
                for (int m = 0; m < 4; ++m)
#pragma unroll
                    for (int n = 0; n < 2; ++n) acc[a][b][m][n] = (f32x4){0.f, 0.f, 0.f, 0.f};
        cur = nxt; cA = nA; cB = nB; ++ui;
        if constexpr (ALIGN_EPI) { if (wr == 1) PG8_BAR; }
    }
    PG8_WAIT_V(0);
    if constexpr (!ALIGN_EPI) { if (wr == 0) PG8_BAR; }
    PG8_BAR;
#undef PG8_SA
#undef PG8_SB
#undef PG8_STAGE
#undef PG8_LDA
#undef PG8_LDB
#undef PG8_MMA
#undef PG8_WAIT_V
#undef PG8_WAIT_L
#undef PG8_BAR
#undef PG8_SCHED
#undef PG8_SETV
}

struct DenseSched {
    const char* A; const char* B; unsigned lda, ldb, a_pn; int nM, nN, nwg, G, c; const unsigned* ident = nullptr;
    __device__ __forceinline__ bool next(int i, Unit& u) const {
        const long L = (long)i * G + c; if (L >= nwg) return false;
        int wgid = (int)L; { const int q = nwg / NXCD, r = nwg % NXCD, xcd = wgid % NXCD, off = wgid / NXCD; wgid = (xcd < r ? xcd * (q + 1) : r * (q + 1) + (xcd - r) * q) + off; }
        const int nig = WGM * nN, gid = wgid / nig, fm = gid * WGM, gsz = (nM - fm) < WGM ? (nM - fm) : WGM;
        const int pm = fm + ((wgid % nig) % gsz), pn = (wgid % nig) / gsz;
        u.A = ident ? A : A + (size_t)pm * BM * lda + (size_t)pn * a_pn; u.B = B + (size_t)pn * BM * ldb; u.gat = ident ? ident + pm * BM : nullptr; u.nvalid = BM; u.i0 = pm; u.i1 = pn; u.i2 = 0; return true;
    }
};
struct MoeInfo { const LAS unsigned* cnt; const LAS unsigned* tstart; const LAS unsigned* ystart; const LAS unsigned char* tile_e; int ntiles; };
struct G1Sched {
    MoeInfo mi; const char* XB; const char* Wgu; const unsigned* rowtok; const unsigned* ident; int G, vcu;
    __device__ __forceinline__ bool next(int i, Unit& u) const {
        const int L = i * G + vcu; if (L >= 2 * mi.ntiles) return false;
        const int tile = L >> 1, uu = L & 1; int e;
        if (tile < 64) { e = 64; u.gat = ident + tile * 256; u.nvalid = 256; }
        else { e = __builtin_amdgcn_readfirstlane((int)mi.tile_e[tile]); const int pos0 = (tile - __builtin_amdgcn_readfirstlane((int)mi.tstart[e])) * 256; u.gat = rowtok + (size_t)e * CAP + pos0; const int rem = __builtin_amdgcn_readfirstlane((int)mi.cnt[e]) - pos0; u.nvalid = rem < 256 ? rem : 256; }
        u.A = XB; u.B = Wgu + ((size_t)e * 512 + (size_t)uu * 256) * 1024; u.i0 = tile; u.i1 = uu; u.i2 = 0; return true;
    }
};
struct G2Sched {
    MoeInfo mi; const char* H; const char* Wd; int G, vcu, L0;
    __device__ __forceinline__ bool next(int i, Unit& u) const {
        const int L = i * G + vcu + L0; if (L >= 4 * mi.ntiles) return false;
        const int tile = L >> 2, pn = L & 3; int e;
        if (tile < 64) { e = 64; u.i0 = 131072 + tile * 256; u.i2 = 0; u.nvalid = 256; }
        else { e = __builtin_amdgcn_readfirstlane((int)mi.tile_e[tile]); const int pos0 = (tile - __builtin_amdgcn_readfirstlane((int)mi.tstart[e])) * 256; u.i0 = __builtin_amdgcn_readfirstlane((int)mi.ystart[e]) + pos0; u.i2 = 0; const int rem = __builtin_amdgcn_readfirstlane((int)mi.cnt[e]) - pos0; u.nvalid = rem < 256 ? rem : 256; }
        u.A = H + (size_t)tile * 256 * 256; u.B = Wd + ((size_t)e * 1024 + (size_t)pn * 256) * 256; u.gat = nullptr; u.i1 = pn; return true;
    }
};

template <int ACT, bool BIAS, bool SCALE, bool W32 = false, bool VSTAT = false> struct EpiBf16 {
    bf16* O; int ldo; const float* bias; const float* scale; float* vstat;
    __device__ __forceinline__ void operator()(const f32x4 (&acc)[2][2][4][2], const Unit& u, int wr, int wc, int fr, int fq) const {
        const int row0 = u.i0 * BM + wr * 64 + fr, col0 = u.i1 * BM + wc * 32 + 8 * fq;
        const bool dostat = VSTAT && u.i1 >= 8;
        f32x4 bv[2][2], sv[2][2];
#pragma unroll
        for (int bj = 0; bj < 2; ++bj)
#pragma unroll
            for (int n = 0; n < 2; ++n) { bv[bj][n] = BIAS ? *(const f32x4*)(bias + col0 + bj * HALF + 4 * n) : (f32x4){0.f, 0.f, 0.f, 0.f}; sv[bj][n] = SCALE ? *(const f32x4*)(scale + col0 + bj * HALF + 4 * n) : (f32x4){1.f, 1.f, 1.f, 1.f}; }
#pragma unroll
        for (int ai = 0; ai < 2; ++ai)
#pragma unroll
            for (int m = 0; m < 4; ++m) { bf16* rowp = O + (size_t)(row0 + ai * HALF + m * 16) * ldo + col0; float ssum = 0.f, ssq = 0.f;
#pragma unroll
                for (int bj = 0; bj < 2; ++bj) { f32x4 v0 = acc[ai][bj][m][0] * (W32 ? 0.03125f : 1.0f) + bv[bj][0], v1 = acc[ai][bj][m][1] * (W32 ? 0.03125f : 1.0f) + bv[bj][1];
                    if (ACT == 1) { const f32x2 a0 = gelu_tanh2((f32x2){v0[0], v0[1]}), a1 = gelu_tanh2((f32x2){v0[2], v0[3]}), a2 = gelu_tanh2((f32x2){v1[0], v1[1]}), a3 = gelu_tanh2((f32x2){v1[2], v1[3]});
                        v0 = (f32x4){a0.x, a0.y, a1.x, a1.y}; v1 = (f32x4){a2.x, a2.y, a3.x, a3.y}; }
                    if (SCALE) { v0 = v0 * sv[bj][0]; v1 = v1 * sv[bj][1]; }
                    v4u w; w.x = cvt_pk_bf16(v0[0], v0[1]); w.y = cvt_pk_bf16(v0[2], v0[3]); w.z = cvt_pk_bf16(v1[0], v1[1]); w.w = cvt_pk_bf16(v1[2], v1[3]);
                    *(v4u*)(rowp + bj * HALF) = w;
                    if constexpr (VSTAT) {
#pragma unroll
                        for (int j = 0; j < 4; ++j) { ssum += v0[j] + v1[j]; ssq += v0[j] * v0[j] + v1[j] * v1[j]; } } }
                if constexpr (VSTAT) { if (dostat) {
                    ssum += __shfl_xor(ssum, 16); ssq += __shfl_xor(ssq, 16); ssum += __shfl_xor(ssum, 32); ssq += __shfl_xor(ssq, 32);
                    if (fq == 0) *(f32x2*)(vstat + ((size_t)(row0 + ai * HALF + m * 16) * 32 + (size_t)(u.i1 - 8) * 4 + wc) * 2) = (f32x2){ssum, ssq}; } } }
    }
};
template <bool BASE_BF16> struct EpiResidB {
    const void* base; bf16* outb;
    __device__ __forceinline__ void operator()(const f32x4 (&acc)[2][2][4][2], const Unit& u, int wr, int wc, int fr, int fq) const {
        const int row0 = u.i0 * BM + wr * 64 + fr, col0 = u.i1 * BM + wc * 32 + 8 * fq;
#pragma unroll
        for (int ai = 0; ai < 2; ++ai)
#pragma unroll
            for (int m = 0; m < 4; ++m) { const size_t off = (size_t)(row0 + ai * HALF + m * 16) * DM + col0;
#pragma unroll
                for (int bj = 0; bj < 2; ++bj) { f32x4 b0, b1;
                    if constexpr (BASE_BF16) { const v4u w = *(const v4u*)((const bf16*)base + off + bj * HALF); b0 = (f32x4){bf_lo(w.x), bf_hi(w.x), bf_lo(w.y), bf_hi(w.y)}; b1 = (f32x4){bf_lo(w.z), bf_hi(w.z), bf_lo(w.w), bf_hi(w.w)}; }
                    else { b0 = *(const f32x4*)((const float*)base + off + bj * HALF); b1 = *(const f32x4*)((const float*)base + off + bj * HALF + 4); }
                    const f32x4 o0 = b0 * ALPHA + acc[ai][bj][m][0], o1 = b1 * ALPHA + acc[ai][bj][m][1];
                    v4u o; o.x = cvt_pk_bf16(o0[0], o0[1]); o.y = cvt_pk_bf16(o0[2], o0[3]); o.z = cvt_pk_bf16(o1[0], o1[1]); o.w = cvt_pk_bf16(o1[2], o1[3]);
                    *(v4u*)(outb + off + bj * HALF) = o; }
                asm volatile("" ::: "memory"); }
    }
};
struct EpiResid {
    const float* base; float* out;
    __device__ __forceinline__ void operator()(const f32x4 (&acc)[2][2][4][2], const Unit& u, int wr, int wc, int fr, int fq) const {
        const int row0 = u.i0 * BM + wr * 64 + fr, col0 = u.i1 * BM + wc * 32 + 8 * fq;
#pragma unroll
        for (int ai = 0; ai < 2; ++ai)
#pragma unroll
            for (int m = 0; m < 4; ++m) { const size_t off = (size_t)(row0 + ai * HALF + m * 16) * DM + col0;
#pragma unroll
                for (int bj = 0; bj < 2; ++bj) { const f32x4 b0 = *(const f32x4*)(base + off + bj * HALF), b1 = *(const f32x4*)(base + off + bj * HALF + 4);
                    *(f32x4*)(out + off + bj * HALF) = b0 * ALPHA + acc[ai][bj][m][0]; *(f32x4*)(out + off + bj * HALF + 4) = b1 * ALPHA + acc[ai][bj][m][1]; }
                asm volatile("" ::: "memory"); }
    }
};
struct EpiSwiglu {
    unsigned char* H8;
    __device__ __forceinline__ void operator()(const f32x4 (&acc)[2][2][4][2], const Unit& u, int wr, int wc, int fr, int fq) const {
        const int row0 = u.i0 * BM + wr * 64 + fr, col0 = u.i1 * HALF + wc * 32 + 8 * fq;
#pragma unroll
        for (int ai = 0; ai < 2; ++ai)
#pragma unroll
            for (int m = 0; m < 4; ++m) { unsigned char* rowp = H8 + (size_t)(row0 + ai * HALF + m * 16) * EDIM + col0; float h[8];
#pragma unroll
                for (int n = 0; n < 2; ++n)
#pragma unroll
                    for (int j = 0; j < 4; j += 2) { const f32x2 g = (f32x2){acc[ai][0][m][n][j], acc[ai][0][m][n][j + 1]} * 0.03125f, up = (f32x2){acc[ai][1][m][n][j], acc[ai][1][m][n][j + 1]} * 0.25f;
                        const f32x2 t = g * (-1.4426950408889634f); f32x2 e; e.x = __builtin_amdgcn_exp2f(t.x); e.y = __builtin_amdgcn_exp2f(t.y); const f32x2 d = e + 1.0f; f32x2 r; r.x = __builtin_amdgcn_rcpf(d.x); r.y = __builtin_amdgcn_rcpf(d.y);
                        const f32x2 hh = (g * r) * up; h[4 * n + j] = hh.x; h[4 * n + j + 1] = hh.y; }
                int t0 = 0, t1 = 0; t0 = __builtin_amdgcn_cvt_pk_fp8_f32(h[0], h[1], t0, false); t0 = __builtin_amdgcn_cvt_pk_fp8_f32(h[2], h[3], t0, true); t1 = __builtin_amdgcn_cvt_pk_fp8_f32(h[4], h[5], t1, false); t1 = __builtin_amdgcn_cvt_pk_fp8_f32(h[6], h[7], t1, true);
                *(v2u*)rowp = (v2u){(unsigned)t0, (unsigned)t1}; }
    }
};
struct EpiDown {
    unsigned char* Y8;
    __device__ __forceinline__ void operator()(const f32x4 (&acc)[2][2][4][2], const Unit& u, int wr, int wc, int fr, int fq) const {
        const int r0 = wr * 64 + fr, col0 = u.i1 * BM + wc * 64 + 16 * fq;
#pragma unroll
        for (int ai = 0; ai < 2; ++ai)
#pragma unroll
            for (int m = 0; m < 4; ++m) { const int r = r0 + ai * HALF + m * 16;
                if (r < u.nvalid) { v4u w;
#pragma unroll
                    for (int q = 0; q < 4; ++q) { const f32x4 v = acc[ai][q >> 1][m][q & 1] * 0.0625f;     int t = 0; t = __builtin_amdgcn_cvt_pk_fp8_f32(v[0], v[1], t, false); t = __builtin_amdgcn_cvt_pk_fp8_f32(v[2], v[3], t, true); w[q] = (unsigned)t; }
                    *(v4u*)(Y8 + (size_t)(u.i0 + r) * DM + col0) = w; } }
    }
};
}

struct Args { const float* in[24]; float* out; unsigned char* ws; int ph_lo, ph_hi; };
enum { I_X = 0, I_PWIN, I_PWGRP, I_PSCALE, I_PWOUT, I_SWIN, I_SBIN, I_SLNG, I_SLNB, I_SWS, I_SBS, I_SWOUT, I_LNMG, I_LNMB, I_WR, I_RB, I_WG, I_WU, I_WD, I_SHG, I_SHU, I_SHD, I_LNFG, I_LNFB };

__device__ __forceinline__ void tr_item(const float* W, int N, int k0, int n0, bf16* dst  , int dpitch, LAS float* scr, int lane) {
#pragma unroll 8
    for (int i = 0; i < 32; ++i) { const int kk = 2 * i + (lane >> 5); scr[kk * 33 + (lane & 31)] = W[(size_t)(k0 + kk) * N + n0 + (lane & 31)]; }
    LDS_WAIT(); asm volatile("" ::: "memory");
    const int c = lane & 7;
#pragma unroll
    for (int j = 0; j < 4; ++j) { const int n = (lane >> 3) + 8 * j; const LAS float* s = scr + (8 * c) * 33 + n;
        v4u o; o.x = cvt_pk_bf16(s[0 * 33], s[1 * 33]); o.y = cvt_pk_bf16(s[2 * 33], s[3 * 33]); o.z = cvt_pk_bf16(s[4 * 33], s[5 * 33]); o.w = cvt_pk_bf16(s[6 * 33], s[7 * 33]);
        *(v4u*)(dst + (size_t)n * dpitch + 8 * c) = o; }
    LDS_WAIT(); asm volatile("" ::: "memory");
}
__device__ __forceinline__ void tr_item_f8(const float* W, int N, int k0, int n0, unsigned char* dst, int dpitch, float scale, LAS float* scr, int lane) {
#pragma unroll 8
    for (int i = 0; i < 32; ++i) { const int kk = 2 * i + (lane >> 5); scr[kk * 33 + (lane & 31)] = W[(size_t)(k0 + kk) * N + n0 + (lane & 31)]; }
    LDS_WAIT(); asm volatile("" ::: "memory");
    const int c = lane & 7;
#pragma unroll
    for (int j = 0; j < 4; ++j) { const int n = (lane >> 3) + 8 * j; const LAS float* s = scr + (8 * c) * 33 + n;
        int t0 = 0, t1 = 0;
        t0 = __builtin_amdgcn_cvt_pk_fp8_f32(s[0 * 33] * scale, s[1 * 33] * scale, t0, false); t0 = __builtin_amdgcn_cvt_pk_fp8_f32(s[2 * 33] * scale, s[3 * 33] * scale, t0, true);
        t1 = __builtin_amdgcn_cvt_pk_fp8_f32(s[4 * 33] * scale, s[5 * 33] * scale, t1, false); t1 = __builtin_amdgcn_cvt_pk_fp8_f32(s[6 * 33] * scale, s[7 * 33] * scale, t1, true);
        *(v2u*)(dst + (size_t)n * dpitch + 8 * c) = (v2u){(unsigned)t0, (unsigned)t1}; }
    LDS_WAIT(); asm volatile("" ::: "memory");
}
__device__ __forceinline__ void tr_tall_f8(const float* W, int N, int k0, int n0, unsigned char* dst, int dpitch, float scale, LAS float* scr, int lane) {
    f32x4 q[16]; const int r8 = lane >> 3, c4 = 4 * (lane & 7);
#pragma unroll
    for (int i = 0; i < 16; ++i) q[i] = *(const f32x4*)(W + (size_t)(k0 + 8 * i + r8) * N + n0 + c4);
#pragma unroll
    for (int i = 0; i < 16; ++i) { const int kk = 8 * i + r8; *(LAS f32x4*)(scr + kk * 32 + ((c4 + 4 * (kk >> 4)) & 31)) = q[i]; }
    LDS_WAIT(); asm volatile("" ::: "memory");
    const int c = lane & 7;
#pragma unroll
    for (int j = 0; j < 4; ++j) { const int n = r8 + 8 * j; const int col = (n + 4 * c) & 31; v4u o;
#pragma unroll
        for (int z = 0; z < 4; ++z) { const LAS float* sp = scr + (16 * c + 4 * z) * 32 + col; int t = 0;
            t = __builtin_amdgcn_cvt_pk_fp8_f32(sp[0] * scale, sp[32] * scale, t, false); t = __builtin_amdgcn_cvt_pk_fp8_f32(sp[64] * scale, sp[96] * scale, t, true); o[z] = (unsigned)t; }
        *(v4u*)(dst + (size_t)n * dpitch + 16 * c) = o; }
    LDS_WAIT(); asm volatile("" ::: "memory");
}
template <bool SPLIT> __device__ __forceinline__ void tr_block_f8(const float* W, int N, int k0, int n0, unsigned char* dst, int dpitch, float scale, LAS float* tile, int wave, int lane) {
    f32x4 q[16];
#pragma unroll
    for (int i = 0; i < 16; ++i) q[i] = *(const f32x4*)(W + (size_t)(k0 + 16 * wave + i) * N + n0 + 4 * lane);
#pragma unroll
    for (int i = 0; i < 16; ++i) { const int kk = 16 * wave + i; *(LAS f32x4*)(tile + kk * 256 + ((4 * lane + 4 * (kk >> 4)) & 255)) = q[i]; }
    LDS_WAIT(); __syncthreads();
    const int c = lane & 7, r8 = lane >> 3;
#pragma unroll
    for (int j = 0; j < 4; ++j) { const int n = 32 * wave + r8 + 8 * j; const int col = (n + 4 * c) & 255; v4u o;
#pragma unroll
        for (int z = 0; z < 4; ++z) { const LAS float* sp = tile + (16 * c + 4 * z) * 256 + col; int t = 0;
            t = __builtin_amdgcn_cvt_pk_fp8_f32(sp[0] * scale, sp[256] * scale, t, false); t = __builtin_amdgcn_cvt_pk_fp8_f32(sp[512] * scale, sp[768] * scale, t, true); o[z] = (unsigned)t; }
        *(v4u*)(dst + (size_t)(SPLIT ? ((n >> 7) * 256 + (n & 127)) : n) * dpitch + 16 * c) = o; }
    LDS_WAIT(); __syncthreads();
}
__device__ __forceinline__ void tr_item_hilo(const float* W, int N, int k0, int n0, bf16* dh, bf16* dl, int dpitch, LAS float* scr, int lane) {
#pragma unroll 8
    for (int i = 0; i < 32; ++i) { const int kk = 2 * i + (lane >> 5); scr[kk * 33 + (lane & 31)] = W[(size_t)(k0 + kk) * N + n0 + (lane & 31)]; }
    LDS_WAIT(); asm volatile("" ::: "memory");
    const int c = lane & 7;
#pragma unroll
    for (int j = 0; j < 4; ++j) { const int n = (lane >> 3) + 8 * j; const LAS float* s = scr + (8 * c) * 33 + n; float w[8];
#pragma unroll
        for (int z = 0; z < 8; ++z) w[z] = s[z * 33];
        v4u o; o.x = cvt_pk_bf16(w[0], w[1]); o.y = cvt_pk_bf16(w[2], w[3]); o.z = cvt_pk_bf16(w[4], w[5]); o.w = cvt_pk_bf16(w[6], w[7]);
        v4u l; l.x = cvt_pk_bf16(w[0] - bf_lo(o.x), w[1] - bf_hi(o.x)); l.y = cvt_pk_bf16(w[2] - bf_lo(o.y), w[3] - bf_hi(o.y)); l.z = cvt_pk_bf16(w[4] - bf_lo(o.z), w[5] - bf_hi(o.z)); l.w = cvt_pk_bf16(w[6] - bf_lo(o.w), w[7] - bf_hi(o.w));
        *(v4u*)(dh + (size_t)n * dpitch + 8 * c) = o; *(v4u*)(dl + (size_t)n * dpitch + 8 * c) = l; }
    LDS_WAIT(); asm volatile("" ::: "memory");
}
constexpr int MOE_ITEMS = 65 * 192;
__device__ __forceinline__ void convert_moe_item(const Args& a, int layer, int it, LAS float* scr, int lane) {
    unsigned char* WGU = a.ws + WS_WGU + (size_t)layer * WS_MOE_LSTRIDE; unsigned char* WDN = a.ws + WS_WDN + (size_t)layer * WS_MOE_LSTRIDE;
    const int e = it / 192, r = it % 192;
    if (r < 128) { const int isup = r >> 6, rr = r & 63, kb = rr >> 3, nb = rr & 7, n0 = 32 * nb, k0 = 128 * kb;
        const float* src = (e < 64) ? a.in[isup ? I_WU : I_WG] + ((size_t)layer * 64 + e) * 262144 : a.in[isup ? I_SHU : I_SHG] + (size_t)layer * 262144;
        const int drow = e * 512 + (n0 >> 7) * 256 + isup * 128 + (n0 & 127);
        tr_tall_f8(src, 256, k0, n0, WGU + (size_t)drow * 1024 + k0, 1024, 32.0f, scr, lane);
    } else { const int rr = r - 128, kb = rr >> 5, nb = rr & 31, n0 = 32 * nb, k0 = 128 * kb;
        const float* src = (e < 64) ? a.in[I_WD] + ((size_t)layer * 64 + e) * 262144 : a.in[I_SHD] + (size_t)layer * 262144;
        tr_tall_f8(src, 1024, k0, n0, WDN + ((size_t)e * 1024 + n0) * 256 + k0, 256, 32.0f, scr, lane);
    }
}
constexpr int Q_SHARDS = 8, Q_PER_SHARD = MOE_ITEMS / Q_SHARDS;
static_assert(Q_PER_SHARD * Q_SHARDS == MOE_ITEMS, "queue shards");
template <int CHUNK> __device__ __forceinline__ bool convert_steal_n(const Args& a, int layer, LAS unsigned char* lds, int wave, int lane) {
    unsigned* q = (unsigned*)(a.ws + WS_CTL) + CW_QNEXT + 512 * layer;
    const int s0 = (int)(blockIdx.x & 7);
    for (int s = 0; s < Q_SHARDS; ++s) { const int sh = (s0 + s) & 7;
        unsigned it = 0; if (lane == 0) it = __hip_atomic_fetch_add(q + 64 * sh, (unsigned)CHUNK, RLX_AGENT);
        it = (unsigned)__builtin_amdgcn_readfirstlane((int)it);
        if (it < (unsigned)Q_PER_SHARD) {
            for (int c = 0; c < CHUNK; ++c) if (it + c < (unsigned)Q_PER_SHARD) convert_moe_item(a, layer, sh * Q_PER_SHARD + (int)it + c, (LAS float*)(lds + wave * 16384), lane);
            return true; } }
    return false;
}
__device__ __forceinline__ bool convert_steal(const Args& a, int layer, LAS unsigned char* lds, int wave, int lane) { return convert_steal_n<1>(a, layer, lds, wave, lane); }
constexpr int MOE_WG_ITEMS = 65 * 24;
__device__ __forceinline__ void convert_static(const Args& a, int layer, LAS unsigned char* lds, int vcu, int G) {
    const int lane = threadIdx.x & 63, wave = __builtin_amdgcn_readfirstlane(threadIdx.x >> 6);
    unsigned char* WGU = a.ws + WS_WGU + (size_t)layer * WS_MOE_LSTRIDE; unsigned char* WDN = a.ws + WS_WDN + (size_t)layer * WS_MOE_LSTRIDE;
    __syncthreads();
#pragma unroll 1
    for (int it = vcu; it < MOE_WG_ITEMS; it += G) { const int e = it / 24, r = it % 24;
        if (r < 16) { const int isup = r >> 3, k0 = 128 * (r & 7);
            const float* src = (e < 64) ? a.in[isup ? I_WU : I_WG] + ((size_t)layer * 64 + e) * 262144 : a.in[isup ? I_SHU : I_SHG] + (size_t)layer * 262144;
            tr_block_f8<true>(src, 256, k0, 0, WGU + ((size_t)e * 512 + isup * 128) * 1024 + k0, 1024, 32.0f, (LAS float*)lds, wave, lane);
        } else { const int rr = r - 16, k0 = 128 * (rr >> 2), n0 = 256 * (rr & 3);
            const float* src = (e < 64) ? a.in[I_WD] + ((size_t)layer * 64 + e) * 262144 : a.in[I_SHD] + (size_t)layer * 262144;
            tr_block_f8<false>(src, 1024, k0, n0, WDN + ((size_t)e * 1024 + n0) * 256 + k0, 256, 32.0f, (LAS float*)lds, wave, lane);
        } }
}
__device__ __forceinline__ void convert_drain(const Args& a, int layer, LAS unsigned char* lds) {
    const int lane = threadIdx.x & 63, wave = __builtin_amdgcn_readfirstlane(threadIdx.x >> 6);
    while (convert_steal_n<4>(a, layer, lds, wave, lane)) {}
    __syncthreads();
}
__device__ __forceinline__ void phase_p0(const Args& a, LAS unsigned char* lds, int vcu, int G) {
    const int tid = threadIdx.x, lane = tid & 63, wave = __builtin_amdgcn_readfirstlane(tid >> 6);
    const int gw = vcu * NWAVES + wave, NGW = G * NWAVES;
    LAS float* scr = (LAS float*)(lds + wave * 16384);
    constexpr int I_IN = 16 * 32, I_GRP = 4 * 4 * 8, I_OUT = 16 * 32, I_SIN = 16 * 128, I_SOUT = 32 * 32, NIT = I_IN + I_GRP + I_OUT + I_SIN + I_SOUT;
    for (int it = gw; it < NIT; it += NGW) {
        int r = it;
        if (r < I_IN) { const int kb = r >> 5, nb = r & 31; tr_item(a.in[I_PWIN], 1024, 64 * kb, 32 * nb, (bf16*)(a.ws + WS_WIN) + (size_t)(32 * nb) * 1024 + 64 * kb, 1024, scr, lane); continue; } r -= I_IN;
        if (r < I_GRP) { const int g = r >> 5, rr = r & 31, kb = rr >> 3, nb = rr & 7; tr_item(a.in[I_PWGRP] + (size_t)g * 65536, 256, 64 * kb, 32 * nb, (bf16*)(a.ws + WS_WGRP) + (size_t)(g * 256 + 32 * nb) * 256 + 64 * kb, 256, scr, lane); continue; } r -= I_GRP;
        if (r < I_OUT) { const int kb = r >> 5, nb = r & 31; tr_item(a.in[I_PWOUT], 1024, 64 * kb, 32 * nb, (bf16*)(a.ws + WS_WOUT) + (size_t)(32 * nb) * 1024 + 64 * kb, 1024, scr, lane); continue; } r -= I_OUT;
        if (r < I_SIN) { const int kb = r >> 7, nb = r & 127; tr_item_f8(a.in[I_SWIN], 4096, 64 * kb, 32 * nb, a.ws + WS_WSIN + (size_t)(32 * nb) * 1024 + 64 * kb, 1024, 32.0f, scr, lane); continue; } r -= I_SIN;
        { const int kb = r >> 5, nb = r & 31; tr_item(a.in[I_SWOUT], 1024, 64 * kb, 32 * nb, (bf16*)(a.ws + WS_WSOUT) + (size_t)(32 * nb) * 2048 + 64 * kb, 2048, scr, lane); }
    }
    for (int it = gw; it < 64; it += NGW) { const int layer = it >> 5, rr = it & 31, kb = rr >> 1, nb = rr & 1; bf16* base = (bf16*)(a.ws + WS_WRT) + (size_t)layer * 2 * 65536 + (size_t)(32 * nb) * 1024 + 64 * kb;
        tr_item_hilo(a.in[I_WR] + (size_t)layer * DM * NE, 64, 64 * kb, 32 * nb, base, base + 65536, 1024, scr, lane); }
    const float* x = a.in[I_X]; bf16* xb = (bf16*)(a.ws + WS_XB);
    const size_t gt = (size_t)vcu * NTHR + tid, NT = (size_t)G * NTHR;
#pragma unroll 1
    for (size_t i0 = gt; i0 < (size_t)T_TOK * DM / 8; i0 += 8 * NT) { f32x4 p[8], q[8];
#pragma unroll
        for (int u = 0; u < 8; ++u) { const size_t i = i0 + (size_t)u * NT; p[u] = *(const f32x4*)(x + i * 8); q[u] = *(const f32x4*)(x + i * 8 + 4); }
#pragma unroll
        for (int u = 0; u < 8; ++u) { const size_t i = i0 + (size_t)u * NT; v4u w; w.x = cvt_pk_bf16(p[u][0], p[u][1]); w.y = cvt_pk_bf16(p[u][2], p[u][3]); w.z = cvt_pk_bf16(q[u][0], q[u][1]); w.w = cvt_pk_bf16(q[u][2], q[u][3]); *(v4u*)(xb + i * 8) = w; } }
    unsigned* ident = (unsigned*)(a.ws + WS_IDENT);
    for (size_t i = gt; i < (size_t)T_TOK; i += NT) ident[i] = (unsigned)i;
}

template <int W> __device__ __forceinline__ void pool_item(const bf16* zp  , bf16* op  , int p0  ) {
    v4u q[W + 3];
#pragma unroll
    for (int i = 0; i < W + 3; ++i) { const int ii = i < p0 + 3 ? i : p0 + 3; q[i] = *(const v4u*)(zp - (size_t)ii * DM); }
#pragma unroll
    for (int o = 0; o < 4; ++o) {
        float s[8];
#pragma unroll
        for (int j = 0; j < 8; ++j) s[j] = 0.f;
#pragma unroll
        for (int i = 3 - o; i < 3 - o + W; ++i) { const float m = (i <= p0 + 3) ? 1.0f : 0.0f;
#pragma unroll
            for (int j = 0; j < 4; ++j) { s[2 * j] += m * bf_lo(q[i][j]); s[2 * j + 1] += m * bf_hi(q[i][j]); } }
        const int p = p0 + o, nw = (p + 1) < W ? (p + 1) : W; const float inv = 1.0f / (float)nw; v4u ov;
#pragma unroll
        for (int j = 0; j < 4; ++j) ov[j] = cvt_pk_bf16(s[2 * j] * inv - bf_lo(q[3 - o][j]), s[2 * j + 1] * inv - bf_hi(q[3 - o][j]));
        *(v4u*)(op + (size_t)o * DM) = ov; }
}
__device__ __forceinline__ void pool_block(const Args& a, int pm, int g) {
    const bf16* Z = (const bf16*)(a.ws + WS_Z); bf16* P = (bf16*)(a.ws + WS_POOLED);
    const int tid = threadIdx.x;
#pragma unroll 1
    for (int q = tid; q < 64 * 32; q += NTHR) { const int c8 = q & 31, tg = q >> 5, t0 = pm * 256 + tg * 4, p0 = t0 & (SEQ - 1);
        const bf16* zp = Z + (size_t)(t0 + 3) * DM + g * 256 + c8 * 8; bf16* op = P + (size_t)t0 * DM + g * 256 + c8 * 8;
        if (g == 0) pool_item<2>(zp, op, p0); else if (g == 1) pool_item<4>(zp, op, p0); else if (g == 2) pool_item<8>(zp, op, p0); else pool_item<16>(zp, op, p0); }
    VM_WAIT(); __syncthreads();
}
__device__ __forceinline__ void phase_pool(const Args& a, int vcu, int G) {
    const bf16* Z = (const bf16*)(a.ws + WS_Z); bf16* P = (bf16*)(a.ws + WS_POOLED);
    const int tid = threadIdx.x, wave = tid >> 6, lane = tid & 63;
    const int gw = vcu * NWAVES + wave, NGW = G * NWAVES;
    for (int it = gw; it < (T_TOK / 4) * 2; it += NGW) {
        const int t0 = (it >> 1) * 4, c8 = (it & 1) * 64 + lane, g = c8 >> 5, p0 = t0 & (SEQ - 1);
        const bf16* zp = Z + (size_t)(t0 + 3) * DM + c8 * 8; bf16* op = P + (size_t)t0 * DM + c8 * 8;
        if (g == 0) pool_item<2>(zp, op, p0); else if (g == 1) pool_item<4>(zp, op, p0); else if (g == 2) pool_item<8>(zp, op, p0); else pool_item<16>(zp, op, p0);
    }
}

template <int R, int MODE> __device__ __forceinline__ void ln_rows_store(float (&v)[R][16], const float* g, const float* b, float* const (&of)[R], bf16* const (&obf)[R], unsigned char* const (&o8)[R], int lane) {
    float s[R], s2[R];
#pragma unroll
    for (int r = 0; r < R; ++r) { s[r] = 0.f;
#pragma unroll
        for (int i = 0; i < 16; ++i) s[r] += v[r][i]; }
#pragma unroll
    for (int o = 1; o < 64; o <<= 1)
#pragma unroll
        for (int r = 0; r < R; ++r) s[r] += __shfl_xor(s[r], o);
#pragma unroll
    for (int r = 0; r < R; ++r) { const float mean = s[r] * (1.0f / DM); s2[r] = 0.f;
#pragma unroll
        for (int i = 0; i < 16; ++i) { v[r][i] -= mean; s2[r] += v[r][i] * v[r][i]; } }
#pragma unroll
    for (int o = 1; o < 64; o <<= 1)
#pragma unroll
        for (int r = 0; r < R; ++r) s2[r] += __shfl_xor(s2[r], o);
#pragma unroll
    for (int j = 0; j < 2; ++j) { const int c = 8 * lane + 512 * j;
        const f32x4 g0 = *(const f32x4*)(g + c), g1 = *(const f32x4*)(g + c + 4), b0 = *(const f32x4*)(b + c), b1 = *(const f32x4*)(b + c + 4);
#pragma unroll
        for (int r = 0; r < R; ++r) { const float rstd = 1.0f / sqrtf(s2[r] * (1.0f / DM) + LN_EPS); f32x4 y0, y1;
#pragma unroll
            for (int q = 0; q < 4; ++q) { y0[q] = v[r][8 * j + q] * rstd * g0[q] + b0[q]; y1[q] = v[r][8 * j + 4 + q] * rstd * g1[q] + b1[q]; }
            if constexpr (MODE & 1) { *(f32x4*)(of[r] + c) = y0; *(f32x4*)(of[r] + c + 4) = y1; }
            if constexpr (MODE & 2) { v4u w; w.x = cvt_pk_bf16(y0[0], y0[1]); w.y = cvt_pk_bf16(y0[2], y0[3]); w.z = cvt_pk_bf16(y1[0], y1[1]); w.w = cvt_pk_bf16(y1[2], y1[3]); *(v4u*)(obf[r] + c) = w; }
            if constexpr (MODE & 4) { int t0 = 0, t1 = 0; t0 = __builtin_amdgcn_cvt_pk_fp8_f32(y0[0], y0[1], t0, false); t0 = __builtin_amdgcn_cvt_pk_fp8_f32(y0[2], y0[3], t0, true); t1 = __builtin_amdgcn_cvt_pk_fp8_f32(y1[0], y1[1], t1, false); t1 = __builtin_amdgcn_cvt_pk_fp8_f32(y1[2], y1[3], t1, true);
                *(v2u*)(o8[r] + c) = (v2u){(unsigned)t0, (unsigned)t1}; } } }
}

__device__ __forceinline__ void phase_lnr(const Args& a, int layer, LAS unsigned char* lds, int vcu, int G, bool dry) {
    const int tid = threadIdx.x, lane = tid & 63, wave = __builtin_amdgcn_readfirstlane(tid >> 6);
    const bf16* xin = (const bf16*)(a.ws + WS_XR); float* xf = dry ? (float*)(a.ws + WS_Y) : a.out; bf16* xb = dry ? (bf16*)(a.ws + WS_Y + 72 * MiB) : (bf16*)(a.ws + WS_XB);
    const float* lng = a.in[I_LNMG] + layer * DM; const float* lnb = a.in[I_LNMB] + layer * DM;
    const float* Wr = a.in[I_WR] + (size_t)layer * DM * NE; const float* rbias = a.in[I_RB] + layer * NE;
    unsigned* gcount = (unsigned*)(a.ws + WS_CTL) + CW_CNT + layer * 64 + (dry ? 128 : 0);
    unsigned* rowtok = dry ? (unsigned*)(a.ws + WS_Y + 64 * MiB) : (unsigned*)(a.ws + WS_ROWTOK); unsigned* dest = dry ? (unsigned*)(a.ws + WS_Y + 68 * MiB) : (unsigned*)(a.ws + WS_DEST); float* gatev = dry ? (float*)(a.ws + WS_Y + 69 * MiB) : (float*)(a.ws + WS_GATE);
    LAS float* part = (LAS float*)lds;
    LAS unsigned* hist = (LAS unsigned*)(lds + 65536);
    LAS unsigned* basep = (LAS unsigned*)(lds + 65536 + 256);
    { const int blk = vcu;
        const int row0 = blk * 64;
        if (tid < 64) hist[tid] = 0u;
        { float v[8][16]; float* of[8]; bf16* obf[8]; unsigned char* o8[8];
#pragma unroll
            for (int r = 0; r < 8; ++r) { const int rr = wave * 8 + r; const bf16* xr = xin + (size_t)(row0 + rr) * DM; of[r] = xf + (size_t)(row0 + rr) * DM; obf[r] = nullptr; o8[r] = (unsigned char*)xb + (size_t)(row0 + rr) * DM;
#pragma unroll
                for (int j = 0; j < 2; ++j) { const v4u p = *(const v4u*)(xr + 8 * lane + 512 * j);
#pragma unroll
                    for (int i = 0; i < 4; ++i) { v[r][8 * j + 2 * i] = bf_lo(p[i]); v[r][8 * j + 2 * i + 1] = bf_hi(p[i]); } } }
            ln_rows_store<8, 5>(v, lng, lnb, of, obf, o8, lane); }
        VM_WAIT(); __syncthreads();
#ifndef DRY_PARTS
#define DRY_PARTS 7
#endif
        if (!dry || (DRY_PARTS & 2)) { const int kq = wave & 3, mh = wave >> 2, r = lane & 15, g = lane >> 4;
          f32x4 acc[2][4];
#pragma unroll
          for (int m = 0; m < 2; ++m)
#pragma unroll
              for (int n = 0; n < 4; ++n) acc[m][n] = (f32x4){0.f, 0.f, 0.f, 0.f};
          const float* arow = xf + (size_t)(row0 + 32 * mh + r) * DM + kq * 256 + 8 * g;
          const bf16* bh = (const bf16*)(a.ws + WS_WRT) + (size_t)layer * 2 * 65536 + (size_t)r * 1024 + kq * 256 + 8 * g; const bf16* bl = bh + 65536;
          f32x4 a0[2], a1[2]; bf16x8 wh[4], wl[4];
#pragma unroll
          for (int m = 0; m < 2; ++m) { a0[m] = *(const f32x4*)(arow + (size_t)m * 16 * DM); a1[m] = *(const f32x4*)(arow + (size_t)m * 16 * DM + 4); }
#pragma unroll
          for (int n = 0; n < 4; ++n) { wh[n] = *(const bf16x8*)(bh + (size_t)n * 16384); wl[n] = *(const bf16x8*)(bl + (size_t)n * 16384); }
#pragma unroll 1
          for (int s = 0; s < 8; ++s) { const int sn = s < 7 ? s + 1 : s;
              f32x4 n0[2], n1[2]; bf16x8 nh[4], nl[4];
#pragma unroll
              for (int m = 0; m < 2; ++m) { n0[m] = *(const f32x4*)(arow + (size_t)m * 16 * DM + 32 * sn); n1[m] = *(const f32x4*)(arow + (size_t)m * 16 * DM + 32 * sn + 4); }
#pragma unroll
              for (int n = 0; n < 4; ++n) { nh[n] = *(const bf16x8*)(bh + (size_t)n * 16384 + 32 * sn); nl[n] = *(const bf16x8*)(bl + (size_t)n * 16384 + 32 * sn); }
#pragma unroll
              for (int m = 0; m < 2; ++m) {
                  v4u hi, lo; hi.x = cvt_pk_bf16(a0[m][0], a0[m][1]); hi.y = cvt_pk_bf16(a0[m][2], a0[m][3]); hi.z = cvt_pk_bf16(a1[m][0], a1[m][1]); hi.w = cvt_pk_bf16(a1[m][2], a1[m][3]);
                  lo.x = cvt_pk_bf16(a0[m][0] - bf_lo(hi.x), a0[m][1] - bf_hi(hi.x)); lo.y = cvt_pk_bf16(a0[m][2] - bf_lo(hi.y), a0[m][3] - bf_hi(hi.y));
                  lo.z = cvt_pk_bf16(a1[m][0] - bf_lo(hi.z), a1[m][1] - bf_hi(hi.z)); lo.w = cvt_pk_bf16(a1[m][2] - bf_lo(hi.w), a1[m][3] - bf_hi(hi.w));
                  const bf16x8 ah = __builtin_bit_cast(bf16x8, hi), al = __builtin_bit_cast(bf16x8, lo);
#pragma unroll
                  for (int n = 0; n < 4; ++n) { acc[m][n] = __builtin_amdgcn_mfma_f32_16x16x32_bf16(ah, wh[n], acc[m][n], 0, 0, 0); acc[m][n] = __builtin_amdgcn_mfma_f32_16x16x32_bf16(al, wh[n], acc[m][n], 0, 0, 0); acc[m][n] = __builtin_amdgcn_mfma_f32_16x16x32_bf16(ah, wl[n], acc[m][n], 0, 0, 0); } }
#pragma unroll
              for (int m = 0; m < 2; ++m) { a0[m] = n0[m]; a1[m] = n1[m]; }
#pragma unroll
              for (int n = 0; n < 4; ++n) { wh[n] = nh[n]; wl[n] = nl[n]; } }
#pragma unroll
          for (int m = 0; m < 2; ++m)
#pragma unroll
              for (int n = 0; n < 4; ++n)
#pragma unroll
                  for (int q = 0; q < 4; ++q) part[(kq * 64 + 32 * mh + 16 * m + 4 * g + q) * 64 + 16 * n + r] = acc[m][n][q]; }
        __syncthreads();
        if (!dry || (DRY_PARTS & 4)) { const int row = tid >> 3, grp = tid & 7; float sc[8], bsd[8];
#pragma unroll
          for (int i = 0; i < 8; ++i) { const int e = 8 * grp + i; const float lg = (part[row * 64 + e] + part[(64 + row) * 64 + e]) + (part[(128 + row) * 64 + e] + part[(192 + row) * 64 + e]); sc[i] = 1.0f / (1.0f + __expf(-lg)); bsd[i] = sc[i] + rbias[e]; }
          float m1 = -INFINITY, m2 = -INFINITY;
#pragma unroll
          for (int i = 0; i < 8; ++i) { const float v = bsd[i]; if (v > m1) { m2 = m1; m1 = v; } else if (v > m2) m2 = v; }
          const float myg = m1 + m2;
          int grank = 0;
#pragma unroll
          for (int d = 1; d < 8; ++d) { const float o = __shfl(myg, (lane & ~7) | ((grp + d) & 7)); const int g2 = (grp + d) & 7; grank += (o > myg || (o == myg && g2 < grp)) ? 1 : 0; }
          const bool gsel = grank < 4;
          float cand[8]; int rk[8]; bool sel[8];
#pragma unroll
          for (int i = 0; i < 8; ++i) { cand[i] = gsel ? bsd[i] : -INFINITY; rk[i] = 0; sel[i] = false; }
#pragma unroll 1
          for (int k = 0; k < TOPK; ++k) {
              float best = cand[0]; int bi = 0;
#pragma unroll
              for (int i = 1; i < 8; ++i) if (cand[i] > best) { best = cand[i]; bi = i; }
              int gi = 8 * grp + bi;
#define LNR_RED(CTRL) { const float ov = __builtin_bit_cast(float, __builtin_amdgcn_update_dpp(0, __builtin_bit_cast(int, best), CTRL, 0xF, 0xF, false)); const int oi = __builtin_amdgcn_update_dpp(0, gi, CTRL, 0xF, 0xF, false); if (ov > best || (ov == best && oi < gi)) { best = ov; gi = oi; } }
              LNR_RED(0xB1) LNR_RED(0x4E) LNR_RED(0x141)
#undef LNR_RED
#pragma unroll
              for (int i = 0; i < 8; ++i) if (gi == 8 * grp + i) { cand[i] = -INFINITY; rk[i] = k; sel[i] = true; }
          }
          float psum = 0.f;
#pragma unroll
          for (int i = 0; i < 8; ++i) psum += sel[i] ? sc[i] : 0.f;
          psum += __shfl_xor(psum, 1); psum += __shfl_xor(psum, 2); psum += __shfl_xor(psum, 4);
          const float inv = ROUTED_SCALE / psum;
          unsigned loc[8];
#pragma unroll
          for (int i = 0; i < 8; ++i) { loc[i] = 0u; if (sel[i]) loc[i] = __hip_atomic_fetch_add(hist + 8 * grp + i, 1u, __ATOMIC_RELAXED, __HIP_MEMORY_SCOPE_WORKGROUP); }
          __syncthreads();
          if (tid < 64) { const unsigned h = hist[tid]; basep[tid] = h ? __hip_atomic_fetch_add(gcount + tid, h, RLX_AGENT) : 0u; }
          __syncthreads();
          const int tok = row0 + row;
#pragma unroll
          for (int i = 0; i < 8; ++i) if (sel[i]) { const int e = 8 * grp + i; const unsigned pos = basep[e] + loc[i];
              rowtok[(size_t)e * CAP + pos] = (unsigned)tok; dest[tok * 8 + rk[i]] = ((unsigned)e << 16) | pos; gatev[tok * 8 + rk[i]] = sc[i] * inv; }
        }
        __syncthreads();
    }
}

#define LCV_BAR() do { asm volatile("s_waitcnt vmcnt(0) lgkmcnt(0)" ::: "memory"); __builtin_amdgcn_s_barrier(); asm volatile("" ::: "memory"); } while (0)
__device__ __forceinline__ void phase_lnr_cv(const Args& a, int layer, LAS unsigned char* lds, int blk, int vcu, int G) {
    const int tid = threadIdx.x, lane = tid & 63, wave = __builtin_amdgcn_readfirstlane(tid >> 6);
    if (wave >= 4) {
        LAS float* scr = (LAS float*)(lds + 34816 + (wave - 4) * 16384);
        const int ncw = G * 4; int it = vcu * 4 + (wave - 4);
#define LCV_ITEMS(n) do { for (int q = 0; q < (n) && it < MOE_ITEMS; ++q, it += ncw) convert_moe_item(a, layer, it, scr, lane); } while (0)
        LCV_ITEMS(3); LCV_BAR(); LCV_ITEMS(3); LCV_BAR(); LCV_ITEMS(2); LCV_BAR(); LCV_ITEMS(2); LCV_BAR(); LCV_ITEMS(1); LCV_BAR(); LCV_ITEMS(1000);
#undef LCV_ITEMS
        return;
    }
    const bf16* xin = (const bf16*)(a.ws + WS_XR); float* xf = a.out; unsigned char* xb8 = a.ws + WS_XB;
    const float* lng = a.in[I_LNMG] + layer * DM; const float* lnb = a.in[I_LNMB] + layer * DM; const float* rbias = a.in[I_RB] + layer * NE;
    unsigned* gcount = (unsigned*)(a.ws + WS_CTL) + CW_CNT + layer * 64;
    unsigned* rowtok = (unsigned*)(a.ws + WS_ROWTOK); unsigned* dest = (unsigned*)(a.ws + WS_DEST); float* gatev = (float*)(a.ws + WS_GATE);
    LAS float* part = (LAS float*)lds;
    LAS unsigned* hist = (LAS unsigned*)(lds + 32768); LAS unsigned* basep = (LAS unsigned*)(lds + 33024);
    const int row0 = blk * 64;
    if (tid < 64) hist[tid] = 0u;
#pragma unroll 1
    for (int h8 = 0; h8 < 2; ++h8) { float v[8][16]; float* of[8]; bf16* obf[8]; unsigned char* o8[8];
#pragma unroll
        for (int r = 0; r < 8; ++r) { const int rr = wave * 16 + h8 * 8 + r; const bf16* xr = xin + (size_t)(row0 + rr) * DM; of[r] = xf + (size_t)(row0 + rr) * DM; obf[r] = nullptr; o8[r] = xb8 + (size_t)(row0 + rr) * DM;
#pragma unroll
            for (int j = 0; j < 2; ++j) { const v4u p = *(const v4u*)(xr + 8 * lane + 512 * j);
#pragma unroll
                for (int i = 0; i < 4; ++i) { v[r][8 * j + 2 * i] = bf_lo(p[i]); v[r][8 * j + 2 * i + 1] = bf_hi(p[i]); } } }
        ln_rows_store<8, 5>(v, lng, lnb, of, obf, o8, lane); }
    LCV_BAR();
    { const int mh = wave & 1, kh = wave >> 1, r = lane & 15, g = lane >> 4;
      f32x4 acc[2][4];
#pragma unroll
      for (int m = 0; m < 2; ++m)
#pragma unroll
          for (int n = 0; n < 4; ++n) acc[m][n] = (f32x4){0.f, 0.f, 0.f, 0.f};
      const float* arow = xf + (size_t)(row0 + 32 * mh + r) * DM + kh * 512 + 8 * g;
      const bf16* bh = (const bf16*)(a.ws + WS_WRT) + (size_t)layer * 2 * 65536 + (size_t)r * 1024 + kh * 512 + 8 * g; const bf16* bl = bh + 65536;
      f32x4 a0[2], a1[2]; bf16x8 wh[4], wl[4];
#pragma unroll
      for (int m = 0; m < 2; ++m) { a0[m] = *(const f32x4*)(arow + (size_t)m * 16 * DM); a1[m] = *(const f32x4*)(arow + (size_t)m * 16 * DM + 4); }
#pragma unroll
      for (int n = 0; n < 4; ++n) { wh[n] = *(const bf16x8*)(bh + (size_t)n * 16384); wl[n] = *(const bf16x8*)(bl + (size_t)n * 16384); }
#pragma unroll 1
      for (int s = 0; s < 16; ++s) { const int sn = s < 15 ? s + 1 : s;
          f32x4 n0[2], n1[2]; bf16x8 nh[4], nl[4];
#pragma unroll
          for (int m = 0; m < 2; ++m) { n0[m] = *(const f32x4*)(arow + (size_t)m * 16 * DM + 32 * sn); n1[m] = *(const f32x4*)(arow + (size_t)m * 16 * DM + 32 * sn + 4); }
#pragma unroll
          for (int n = 0; n < 4; ++n) { nh[n] = *(const bf16x8*)(bh + (size_t)n * 16384 + 32 * sn); nl[n] = *(const bf16x8*)(bl + (size_t)n * 16384 + 32 * sn); }
#pragma unroll
          for (int m = 0; m < 2; ++m) {
              v4u hi, lo; hi.x = cvt_pk_bf16(a0[m][0], a0[m][1]); hi.y = cvt_pk_bf16(a0[m][2], a0[m][3]); hi.z = cvt_pk_bf16(a1[m][0], a1[m][1]); hi.w = cvt_pk_bf16(a1[m][2], a1[m][3]);
              lo.x = cvt_pk_bf16(a0[m][0] - bf_lo(hi.x), a0[m][1] - bf_hi(hi.x)); lo.y = cvt_pk_bf16(a0[m][2] - bf_lo(hi.y), a0[m][3] - bf_hi(hi.y));
              lo.z = cvt_pk_bf16(a1[m][0] - bf_lo(hi.z), a1[m][1] - bf_hi(hi.z)); lo.w = cvt_pk_bf16(a1[m][2] - bf_lo(hi.w), a1[m][3] - bf_hi(hi.w));
              const bf16x8 ah = __builtin_bit_cast(bf16x8, hi), al = __builtin_bit_cast(bf16x8, lo);
#pragma unroll
              for (int n = 0; n < 4; ++n) { acc[m][n] = __builtin_amdgcn_mfma_f32_16x16x32_bf16(ah, wh[n], acc[m][n], 0, 0, 0); acc[m][n] = __builtin_amdgcn_mfma_f32_16x16x32_bf16(al, wh[n], acc[m][n], 0, 0, 0); acc[m][n] = __builtin_amdgcn_mfma_f32_16x16x32_bf16(ah, wl[n], acc[m][n], 0, 0, 0); } }
#pragma unroll
          for (int m = 0; m < 2; ++m) { a0[m] = n0[m]; a1[m] = n1[m]; }
#pragma unroll
          for (int n = 0; n < 4; ++n) { wh[n] = nh[n]; wl[n] = nl[n]; } }
#pragma unroll
      for (int m = 0; m < 2; ++m)
#pragma unroll
          for (int n = 0; n < 4; ++n)
#pragma unroll
              for (int q = 0; q < 4; ++q) part[(kh * 64 + 32 * mh + 16 * m + 4 * g + q) * 64 + 16 * n + r] = acc[m][n][q]; }
    LCV_BAR();
    const int grp = tid & 7; int rkk[2][8]; unsigned loc[2][8]; float gte[2][8]; unsigned selm[2];
#pragma unroll
    for (int ps = 0; ps < 2; ++ps) { const int row = 32 * ps + (tid >> 3); float sc[8], bsd[8];
#pragma unroll
        for (int i = 0; i < 8; ++i) { const int e = 8 * grp + i; const float lg = part[row * 64 + e] + part[(64 + row) * 64 + e]; sc[i] = 1.0f / (1.0f + __expf(-lg)); bsd[i] = sc[i] + rbias[e]; }
        float m1 = -INFINITY, m2 = -INFINITY;
#pragma unroll
        for (int i = 0; i < 8; ++i) { const float v = bsd[i]; if (v > m1) { m2 = m1; m1 = v; } else if (v > m2) m2 = v; }
        const float myg = m1 + m2; int grank = 0;
#pragma unroll
        for (int d = 1; d < 8; ++d) { const float o = __shfl(myg, (lane & ~7) | ((grp + d) & 7)); const int g2 = (grp + d) & 7; grank += (o > myg || (o == myg && g2 < grp)) ? 1 : 0; }
        const bool gsel = grank < 4;
        float cand[8]; unsigned sm = 0u;
#pragma unroll
        for (int i = 0; i < 8; ++i) { cand[i] = gsel ? bsd[i] : -INFINITY; rkk[ps][i] = 0; }
#pragma unroll 1
        for (int k = 0; k < TOPK; ++k) {
            float best = cand[0]; int bi = 0;
#pragma unroll
            for (int i = 1; i < 8; ++i) if (cand[i] > best) { best = cand[i]; bi = i; }
            int gi = 8 * grp + bi;
#define LNR_RED(CTRL) { const float ov = __builtin_bit_cast(float, __builtin_amdgcn_update_dpp(0, __builtin_bit_cast(int, best), CTRL, 0xF, 0xF, false)); const int oi = __builtin_amdgcn_update_dpp(0, gi, CTRL, 0xF, 0xF, false); if (ov > best || (ov == best && oi < gi)) { best = ov; gi = oi; } }
            LNR_RED(0xB1) LNR_RED(0x4E) LNR_RED(0x141)
#undef LNR_RED
#pragma unroll
            for (int i = 0; i < 8; ++i) if (gi == 8 * grp + i) { cand[i] = -INFINITY; rkk[ps][i] = k; sm |= 1u << i; }
        }
        float psum = 0.f;
#pragma unroll
        for (int i = 0; i < 8; ++i) psum += ((sm >> i) & 1u) ? sc[i] : 0.f;
        psum += __builtin_bit_cast(float, __builtin_amdgcn_update_dpp(0, __builtin_bit_cast(int, psum), 0xB1, 0xF, 0xF, false));
        psum += __builtin_bit_cast(float, __builtin_amdgcn_update_dpp(0, __builtin_bit_cast(int, psum), 0x4E, 0xF, 0xF, false));
        psum += __builtin_bit_cast(float, __builtin_amdgcn_update_dpp(0, __builtin_bit_cast(int, psum), 0x141, 0xF, 0xF, false));
        const float inv = ROUTED_SCALE / psum; selm[ps] = sm;
#pragma unroll
        for (int i = 0; i < 8; ++i) { gte[ps][i] = sc[i] * inv; loc[ps][i] = 0u; if ((sm >> i) & 1u) loc[ps][i] = __hip_atomic_fetch_add(hist + 8 * grp + i, 1u, __ATOMIC_RELAXED, __HIP_MEMORY_SCOPE_WORKGROUP); }
    }
    LCV_BAR();
    if (tid < 64) { const unsigned h = hist[tid]; basep[tid] = h ? __hip_atomic_fetch_add(gcount + tid, h, RLX_AGENT) : 0u; }
    LCV_BAR();
#pragma unroll
    for (int ps = 0; ps < 2; ++ps) { const int tok = row0 + 32 * ps + (tid >> 3);
#pragma unroll
        for (int i = 0; i < 8; ++i) if ((selm[ps] >> i) & 1u) { const int e = 8 * grp + i; const unsigned pos = basep[e] + loc[ps][i];
            rowtok[(size_t)e * CAP + pos] = (unsigned)tok; dest[tok * 8 + rkk[ps][i]] = ((unsigned)e << 16) | pos; gatev[tok * 8 + rkk[ps][i]] = gte[ps][i]; } }
    LCV_BAR();
}

__device__ __forceinline__ pg8::MoeInfo moe_setup(const Args& a, int layer, LAS unsigned char* misc) {
    const int tid = threadIdx.x;
    unsigned* gcount = (unsigned*)(a.ws + WS_CTL) + CW_CNT + layer * 64;
    LAS unsigned* cnt = (LAS unsigned*)(misc + MI_CNT); LAS unsigned* tstart = (LAS unsigned*)(misc + MI_TSTART); LAS unsigned* ystart = (LAS unsigned*)(misc + MI_YSTART);
    LAS unsigned* ntl = (LAS unsigned*)(misc + MI_NTILES); LAS unsigned char* tile_e = (LAS unsigned char*)(misc + MI_TILE_E);
    __syncthreads();
    if (tid < 64) { unsigned c = __hip_atomic_load(gcount + tid, RLX_AGENT); if (c > (unsigned)CAP) c = CAP; cnt[tid] = c; }
    __syncthreads();
    if (tid < 64) { unsigned ts = 64u, ys = 0u; for (int e = 0; e < tid; ++e) { const unsigned c = cnt[e]; ts += (c + 255u) >> 8; ys += c; }
        tstart[tid] = ts; ystart[tid] = ys; const unsigned mynt = (cnt[tid] + 255u) >> 8;
        for (unsigned i = 0; i < mynt; ++i) if (ts + i < 640u) tile_e[ts + i] = (unsigned char)tid;
        if (tid == 63) ntl[0] = ts + mynt; }
    __syncthreads();
    pg8::MoeInfo mi; mi.cnt = cnt; mi.tstart = tstart; mi.ystart = ystart; mi.tile_e = tile_e; mi.ntiles = __builtin_amdgcn_readfirstlane((int)ntl[0]);
    if (mi.ntiles > 640) mi.ntiles = 640;
    return mi;
}

__device__ __forceinline__ void phase_combine(const Args& a, int layer, LAS unsigned char* misc, int vcu, int G, bool dry) {
    const int tid = threadIdx.x, lane = tid & 63, wave = __builtin_amdgcn_readfirstlane(tid >> 6);
    const pg8::MoeInfo mi = moe_setup(a, layer, misc);
    float* xf = a.out; bf16* xb = (bf16*)(a.ws + WS_XB); const unsigned char* Y8 = (const unsigned char*)(a.ws + WS_Y);
    const unsigned* dest = (const unsigned*)(a.ws + WS_DEST); const float* gatev = (const float*)(a.ws + WS_GATE);
    const float* lng = a.in[I_LNFG] + layer * DM; const float* lnb = a.in[I_LNFB] + layer * DM;
    const int gw = vcu * NWAVES + wave, NGW = G * NWAVES;
#pragma unroll 1
    for (int rowa = gw; rowa < T_TOK; rowa += 2 * NGW) {
        float v[2][16]; float* of[2]; bf16* obf[2]; unsigned char* o8[2]; unsigned d[2][TOPK]; float gk[2][TOPK];
#pragma unroll
        for (int r = 0; r < 2; ++r) { const int row = rowa + r * NGW;
#pragma unroll
            for (int k = 0; k < TOPK; ++k) { d[r][k] = dest[row * 8 + k]; gk[r][k] = gatev[row * 8 + k]; } }
#pragma unroll
        for (int r = 0; r < 2; ++r) { const int row = rowa + r * NGW; float* xr = xf + (size_t)row * DM; of[r] = dry ? (float*)(a.ws + WS_H) + (size_t)row * DM : xr; obf[r] = (bf16*)(a.ws + WS_XR) + (size_t)row * DM; o8[r] = (unsigned char*)xb + (size_t)row * DM;
#pragma unroll
            for (int j = 0; j < 2; ++j) { const f32x4 p = *(const f32x4*)(xr + 8 * lane + 512 * j), q = *(const f32x4*)(xr + 8 * lane + 512 * j + 4);
#pragma unroll
                for (int i = 0; i < 4; ++i) { v[r][8 * j + i] = p[i] * ALPHA; v[r][8 * j + 4 + i] = q[i] * ALPHA; } } }
#pragma unroll
        for (int r = 0; r < 2; ++r) { const unsigned char* yr = Y8 + (size_t)(131072 + rowa + r * NGW) * DM;
#pragma unroll
            for (int j = 0; j < 2; ++j) { const v2u w = *(const v2u*)(yr + 8 * lane + 512 * j);
#pragma unroll
                for (int q = 0; q < 2; ++q) { const f32x2 lo2 = __builtin_amdgcn_cvt_pk_f32_fp8((int)w[q], false), hi2 = __builtin_amdgcn_cvt_pk_f32_fp8((int)w[q], true);
                    v[r][8 * j + 4 * q] += 0.0625f * lo2.x; v[r][8 * j + 4 * q + 1] += 0.0625f * lo2.y; v[r][8 * j + 4 * q + 2] += 0.0625f * hi2.x; v[r][8 * j + 4 * q + 3] += 0.0625f * hi2.y; } } }
#pragma unroll
        for (int r = 0; r < 2; ++r)
#pragma unroll
            for (int k = 0; k < TOPK; ++k) { const unsigned dd = (unsigned)__builtin_amdgcn_readfirstlane((int)d[r][k]); const float g = __uint_as_float((unsigned)__builtin_amdgcn_readfirstlane((int)__float_as_uint(gk[r][k])));
                const unsigned e = (dd >> 16) & 63u, pos = dd & 0xffffu; const unsigned char* yr = Y8 + (size_t)(mi.ystart[e] + pos) * DM; const float g16 = g * 0.0625f;
#pragma unroll
                for (int j = 0; j < 2; ++j) { const v2u w = *(const v2u*)(yr + 8 * lane + 512 * j);
#pragma unroll
                    for (int q = 0; q < 2; ++q) { const f32x2 lo2 = __builtin_amdgcn_cvt_pk_f32_fp8((int)w[q], false), hi2 = __builtin_amdgcn_cvt_pk_f32_fp8((int)w[q], true);
                        v[r][8 * j + 4 * q] += g16 * lo2.x; v[r][8 * j + 4 * q + 1] += g16 * lo2.y; v[r][8 * j + 4 * q + 2] += g16 * hi2.x; v[r][8 * j + 4 * q + 3] += g16 * hi2.y; } } }
        if (layer == 0 && !dry) ln_rows_store<2, 6>(v, lng, lnb, of, obf, o8, lane);
        else ln_rows_store<2, 1>(v, lng, lnb, of, obf, o8, lane);
    }
}

__device__ __forceinline__ int swz16(int row) { return (row ^ (row >> 4)) & 15; }
__device__ __forceinline__ void phase_sgu_spatial(const Args& a, LAS unsigned char* lds, int vcu, int G) {
    const int tid = threadIdx.x, lane = tid & 63, wave = __builtin_amdgcn_readfirstlane(tid >> 6), fr = lane & 15, fq = lane >> 4;
    const bf16* HS = (const bf16*)(a.ws + WS_HS); bf16* GT = (bf16*)(a.ws + WS_GATED);
    const float* lng = a.in[I_SLNG]; const float* lnb = a.in[I_SLNB]; const float* WS = a.in[I_SWS]; const float* BS = a.in[I_SBS];
    LAS unsigned char* Bs = lds;
    LAS unsigned char* As = lds + 65536;
    LAS float* stm = (LAS float*)(lds + 98304);
    LAS float* str = (LAS float*)(lds + 98304 + 512);
    for (int item = vcu; item < 512; item += G) {
        const int chunk = item >> 2, h = item & 3, t0 = chunk * 128;
        __syncthreads();
        if (tid < 128) { const f32x4* vs = (const f32x4*)((const float*)(a.ws + WS_VSTAT) + (size_t)(t0 + tid) * 64); float S = 0.f, Q = 0.f;
#pragma unroll
            for (int i = 0; i < 16; ++i) { const f32x4 p = vs[i]; S += p[0] + p[2]; Q += p[1] + p[3]; }
            const float mean = S * (1.0f / SGU_W); const float var = Q * (1.0f / SGU_W) - mean * mean;
            stm[tid] = mean; str[tid] = 1.0f / sqrtf((var > 0.f ? var : 0.f) + LN_EPS); }
        for (int q = tid; q < 128 * 16; q += NTHR) { const int i = q >> 4, jc = q & 15; const float* wp = WS + ((size_t)h * 128 + i) * 128 + 8 * jc;
            const f32x4 p0 = *(const f32x4*)wp, p1 = *(const f32x4*)(wp + 4); float w8[8];
#pragma unroll
            for (int z = 0; z < 4; ++z) { w8[z] = (8 * jc + z <= i) ? p0[z] : 0.f; w8[4 + z] = (8 * jc + 4 + z <= i) ? p1[z] : 0.f; }
            v4u o; o.x = cvt_pk_bf16(w8[0], w8[1]); o.y = cvt_pk_bf16(w8[2], w8[3]); o.z = cvt_pk_bf16(w8[4], w8[5]); o.w = cvt_pk_bf16(w8[6], w8[7]);
            *(LAS v4u*)(As + i * 256 + ((jc ^ swz16(i)) << 4)) = o; }
        __syncthreads();
        for (int hh = 0; hh < 2; ++hh) {
            const int cb = h * SGU_HD + hh * 256;
#pragma unroll 2
            for (int q = tid; q < 64 * 32; q += NTHR) { const int c8 = q & 31, jp = q >> 5, j0 = 2 * jp;
                const v4u w0 = *(const v4u*)(HS + (size_t)(t0 + j0) * 4096 + SGU_W + cb + 8 * c8), w1 = *(const v4u*)(HS + (size_t)(t0 + j0 + 1) * 4096 + SGU_W + cb + 8 * c8);
                const f32x4 g0 = *(const f32x4*)(lng + cb + 8 * c8), g1 = *(const f32x4*)(lng + cb + 8 * c8 + 4), b0 = *(const f32x4*)(lnb + cb + 8 * c8), b1 = *(const f32x4*)(lnb + cb + 8 * c8 + 4);
                const float m0 = stm[j0], r0 = str[j0], m1 = stm[j0 + 1], r1 = str[j0 + 1];
#pragma unroll
                for (int z = 0; z < 8; ++z) { const float gz = z < 4 ? g0[z & 3] : g1[z & 3], bz = z < 4 ? b0[z & 3] : b1[z & 3];
                    const float xa = (z & 1) ? bf_hi(w0[z >> 1]) : bf_lo(w0[z >> 1]), xc = (z & 1) ? bf_hi(w1[z >> 1]) : bf_lo(w1[z >> 1]);
                    const float ya = (xa - m0) * r0 * gz + bz, yc = (xc - m1) * r1 * gz + bz;
                    const int cc = 8 * c8 + z, slot = (cc & ~31) | (((cc >> 2) & 1) << 4) | (((cc >> 3) & 3) << 2) | (cc & 3);
                    *(LAS unsigned*)(Bs + slot * 256 + (((j0 >> 3) ^ swz16(slot)) << 4) + (j0 & 7) * 2) = cvt_pk_bf16(ya, yc); } }
            __syncthreads();
            f32x4 acc[8][2]; bf16x8 Bf[2][4];
#pragma unroll
            for (int n = 0; n < 2; ++n)
#pragma unroll
                for (int s = 0; s < 4; ++s) { const int slot = 32 * wave + 16 * n + fr; Bf[n][s] = *(const LAS bf16x8*)(Bs + slot * 256 + (((4 * s + fq) ^ swz16(slot)) << 4)); }
#pragma unroll
            for (int m = 0; m < 8; ++m) { acc[m][0] = (f32x4){0.f, 0.f, 0.f, 0.f}; acc[m][1] = (f32x4){0.f, 0.f, 0.f, 0.f};
#pragma unroll
                for (int s = 0; s < 4; ++s) if (s <= (m >> 1)) { const int i = 16 * m + fr; const bf16x8 af = *(const LAS bf16x8*)(As + i * 256 + (((4 * s + fq) ^ swz16(i)) << 4));
                    acc[m][0] = __builtin_amdgcn_mfma_f32_16x16x32_bf16(Bf[0][s], af, acc[m][0], 0, 0, 0); acc[m][1] = __builtin_amdgcn_mfma_f32_16x16x32_bf16(Bf[1][s], af, acc[m][1], 0, 0, 0); } }
#pragma unroll
            for (int m = 0; m < 8; ++m) { const int i = 16 * m + fr; const float bsv = BS[h * 128 + i]; const size_t t = (size_t)(t0 + i);
                const v4u uw = *(const v4u*)(HS + t * 4096 + cb + 32 * wave + 8 * fq); float o[8];
#pragma unroll
                for (int n = 0; n < 2; ++n)
#pragma unroll
                    for (int z = 0; z < 4; ++z) { const int c = 4 * n + z; const float uu = (c & 1) ? bf_hi(uw[c >> 1]) : bf_lo(uw[c >> 1]); o[c] = uu * (acc[m][n][z] + bsv); }
                v4u w; w.x = cvt_pk_bf16(o[0], o[1]); w.y = cvt_pk_bf16(o[2], o[3]); w.z = cvt_pk_bf16(o[4], o[5]); w.w = cvt_pk_bf16(o[6], o[7]);
                *(v4u*)(GT + t * SGU_W + cb + 32 * wave + 8 * fq) = w; }
            __syncthreads();
        }
    }
}

__device__ __forceinline__ void phase_flush(const Args& a, int vcu, int G) {
    const size_t gt = (size_t)vcu * NTHR + threadIdx.x, NT = (size_t)G * NTHR; f32x4 acc = (f32x4){0.f, 0.f, 0.f, 0.f};
    const f32x4* p0 = (const f32x4*)a.in[I_WG]; const f32x4* p1 = (const f32x4*)a.in[I_WU];
    for (size_t i = gt; i < (size_t)33554432 / 4; i += 4 * NT) { const f32x4 x0 = p0[i], x1 = p0[i + NT], x2 = p0[i + 2 * NT], x3 = p0[i + 3 * NT], y0 = p1[i], y1 = p1[i + NT], y2 = p1[i + 2 * NT], y3 = p1[i + 3 * NT]; acc += x0 + x1 + x2 + x3 + y0 + y1 + y2 + y3; }
    if (acc[0] + acc[1] + acc[2] + acc[3] == 1.2345e-30f) ((float*)(a.ws + WS_CTL))[16000] = acc[0];
}
constexpr int N_PHASES = 16;
__global__ void __launch_bounds__(NTHR, 2) mk_fwd(Args args) {
    extern __shared__ __attribute__((aligned(16))) unsigned char lds_raw[];
    LAS unsigned char* lds = (LAS unsigned char*)lds_raw;
    LAS unsigned char* misc = lds + MISC_OFF;
    const int tid = threadIdx.x;
    const int G = gridDim.x; const int bx = blockIdx.x; const int vcu = (G % 8 == 0) ? (bx % 8) * (G / 8) + bx / 8 : bx;
    unsigned char* ws = args.ws;
    unsigned* ctl = (unsigned*)(ws + WS_CTL);
    if (tid < 16) ((LAS unsigned*)(misc + MI_BARW))[tid] = 0u;
    __syncthreads();
    const int lo = args.ph_lo, hi = args.ph_hi;
    XcdBarrier bar; bar.bar = ctl + CW_BAR; bar.x = 0; bar.st = nullptr;
    if (hi - lo > 1) bar = xcd_barrier_post(ctl + CW_BAR, (volatile LAS unsigned*)(misc + MI_BARW));
#ifndef PH_MASK
#define PH_MASK 0xFFFF
#endif
#define IN(k) (((PH_MASK >> (k)) & 1) && lo <= (k) && (k) < hi)
#ifndef TS_A0
#define TS_A0 -1
#define TS_A1 -1
#define TS_M 1
#endif
    unsigned long long* tsbuf = (unsigned long long*)(ws + 32768);
#define TS_REC(k) do { if (TS_A0 >= 0 && bx == 0 && tid == 0) __hip_atomic_store(tsbuf + (k), (unsigned long long)__builtin_amdgcn_s_memrealtime(), RLX_AGENT); } while (0)
    TS_REC(0);
#ifndef REP_PH
#define REP_PH -1
#define REP_N 1
#endif
#define NREP(k) ((k) == REP_PH ? REP_N : 1)
#ifndef FLUSH_PH
#define FLUSH_PH -2
#endif
#define RUN(k) if (IN(k)) for (int rep = 0; rep < NREP(k); ++rep) if ((((k) == FLUSH_PH && rep == NREP(k) - 1) ? (xcd_barrier(bar), phase_flush(args, vcu, G), xcd_barrier(bar), true) : true))
#define DRY(k) (rep + 1 < NREP(k))
#define BG_LAYER(k) (-1)
#define SEAM(k) do { if (IN(k) && IN((k) + 1)) xcd_barrier(bar, &args, BG_LAYER(k), lds); TS_REC((k) + 1); } while (0)
    using namespace pg8;
    RUN(0) { phase_p0(args, lds, vcu, G); } SEAM(0);
    RUN(1) { DenseSched S{(const char*)(ws + WS_XB), (const char*)(ws + WS_WIN), 2048u, 2048u, 0u, 64, 4, 256, G, bx};
        EpiBf16<0, false, false> E{(bf16*)(ws + WS_Z), DM, nullptr, nullptr, nullptr};
        gemm_phase<EpiBf16<0, false, false>, DenseSched, false, true, true>(lds, 2048u, 2048u, 16, S, E); } SEAM(1);
    if (REP_PH == 100 && hi - lo > 1) for (int i = 0; i < REP_N; ++i) xcd_barrier(bar);
    RUN(3) { DenseSched S{(const char*)(ws + WS_POOLED), (const char*)(ws + WS_WGRP), 2048u, 512u, 512u, 64, 4, 256, G, bx};
        { Unit u0; if (S.next(0, u0)) pool_block(args, u0.i0, u0.i1); }
        EpiBf16<0, false, true> E{(bf16*)(ws + WS_YP), DM, nullptr, args.in[I_PSCALE], nullptr};
        gemm_phase<EpiBf16<0, false, true>, DenseSched, false, true, true>(lds, 2048u, 512u, 4, S, E); } SEAM(3);
    RUN(4) { DenseSched S{(const char*)(ws + WS_YP), (const char*)(ws + WS_WOUT), 2048u, 2048u, 0u, 64, 4, 256, G, bx};
        EpiResidB<false> E{args.in[I_X], (bf16*)(ws + WS_XR)};
        gemm_phase<EpiResidB<false>, DenseSched, false, true, true>(lds, 2048u, 2048u, 16, S, E); } SEAM(4);
#define MOE_PHASES(layer, pb) do { \
        RUN(pb) { phase_lnr_cv(args, layer, lds, vcu, vcu, G); __syncthreads(); } SEAM(pb); \
        RUN((pb) + 1) { const MoeInfo mi = moe_setup(args, layer, misc); \
            G1Sched S{mi, (const char*)(ws + WS_XB), (const char*)(ws + WS_WGU + (size_t)layer * WS_MOE_LSTRIDE), (const unsigned*)(ws + WS_ROWTOK), (const unsigned*)(ws + WS_IDENT), G, vcu}; \
            EpiSwiglu E{(unsigned char*)(ws + WS_H)}; \
            gemm_phase<EpiSwiglu, G1Sched, true, true, false, 0, 1>(lds, 1024u, 1024u, 8, S, E); } SEAM((pb) + 1); \
        if (IN((pb) + 2) && REP_PH == (pb) + 2) { const MoeInfo mi = moe_setup(args, layer, misc); \
            G2Sched S{mi, (const char*)(ws + WS_H), (const char*)(ws + WS_WDN + (size_t)layer * WS_MOE_LSTRIDE), G, vcu, 256}; \
            EpiDown E{(unsigned char*)(ws + WS_Y)}; \
            gemm_phase<EpiDown, G2Sched, false, true, true, 1, 1>(lds, 256u, 256u, 2, S, E); } \
        if (IN((pb) + 2)) { const MoeInfo mi = moe_setup(args, layer, misc); \
            G2Sched S{mi, (const char*)(ws + WS_H), (const char*)(ws + WS_WDN + (size_t)layer * WS_MOE_LSTRIDE), G, vcu, 0}; \
            EpiDown E{(unsigned char*)(ws + WS_Y)}; \
            gemm_phase<EpiDown, G2Sched, false, true, true, 1, 1>(lds, 256u, 256u, 2, S, E); } SEAM((pb) + 2); \
        RUN((pb) + 3) { phase_combine(args, layer, misc, vcu, G, DRY((pb) + 3)); } \
    } while (0)
    MOE_PHASES(0, 5); SEAM(8);
    RUN(9) { DenseSched S{(const char*)(ws + WS_XB), (const char*)(ws + WS_WSIN), 1024u, 1024u, 0u, 64, 16, 1024, G, bx, (const unsigned*)(ws + WS_IDENT)};
        EpiBf16<1, true, false, true, true> E{(bf16*)(ws + WS_HS), 4096, args.in[I_SBIN], nullptr, (float*)(ws + WS_VSTAT)};
        gemm_phase<EpiBf16<1, true, false, true, true>, DenseSched, true, true, false, 0, 1>(lds, 1024u, 1024u, 8, S, E); } SEAM(9);
    RUN(10) { phase_sgu_spatial(args, lds, vcu, G); } SEAM(10);
    RUN(11) { DenseSched S{(const char*)(ws + WS_GATED), (const char*)(ws + WS_WSOUT), 4096u, 4096u, 0u, 64, 4, 256, G, bx};
        EpiResidB<true> E{ws + WS_XR, (bf16*)(ws + WS_XR)};
        gemm_phase<EpiResidB<true>, DenseSched, false, true, true>(lds, 4096u, 4096u, 32, S, E); } SEAM(11);
    MOE_PHASES(1, 12);
#undef MOE_PHASES
    if (TS_A0 >= 0 && bx == 0 && tid == 0) {
        const unsigned long long tend = __builtin_amdgcn_s_memrealtime();
        const unsigned long long t0 = __hip_atomic_load(tsbuf + TS_A0, RLX_AGENT), t1 = (TS_A1 + 1 >= N_PHASES) ? tend : __hip_atomic_load(tsbuf + TS_A1 + 1, RLX_AGENT);
        const unsigned long long wait = (t1 - t0) * TS_M;
        while (__builtin_amdgcn_s_memrealtime() - tend < wait) __builtin_amdgcn_s_sleep(8);
    }
#undef IN
#undef SEAM
}

extern "C" void kernel_launch(void* const* d_in, const int* in_sizes, int n_in, void* d_out, int out_size, void* d_ws, size_t ws_size, hipStream_t stream) {
    static int grid = 0;
    if (grid == 0) {
        if (n_in != 24 || out_size != T_TOK * DM || ws_size < WS_END) { fprintf(stderr, "kernel_launch: unexpected shapes (n_in %d out %d ws %zu)\n", n_in, out_size, ws_size); grid = -1; return; }
        int dev = 0, cus = 0;
        if (hipGetDevice(&dev) != hipSuccess || hipDeviceGetAttribute(&cus, hipDeviceAttributeMultiprocessorCount, dev) != hipSuccess) { grid = -1; return; }
        if (hipFuncSetAttribute((const void*)mk_fwd, hipFuncAttributeMaxDynamicSharedMemorySize, LDS_BYTES) != hipSuccess) { fprintf(stderr, "kernel_launch: hipFuncSetAttribute failed\n"); grid = -1; return; }
        int per_cu = 0;
        if (hipOccupancyMaxActiveBlocksPerMultiprocessor(&per_cu, (const void*)mk_fwd, NTHR, LDS_BYTES) != hipSuccess || per_cu < 1) fprintf(stderr, "kernel_launch: occupancy query says %d\n", per_cu);
        (void)hipGetLastError();
        grid = cus;
        if (grid != 256) { fprintf(stderr, "kernel_launch: built for a 256-CU device (got %d)\n", cus); grid = -1; return; }
    }
    if (grid < 0) return;
    (void)hipMemsetAsync((char*)d_ws + WS_CTL, 0, CTL_ZERO_BYTES, stream);
    Args a{};
    for (int i = 0; i < 24; ++i) a.in[i] = (const float*)d_in[i];
    a.out = (float*)d_out; a.ws = (unsigned char*)d_ws;
#if MK_PER_PHASE
    for (int p = 0; p < N_PHASES; ++p) { a.ph_lo = p; a.ph_hi = p + 1; hipLaunchKernelGGL(mk_fwd, dim3(grid), dim3(NTHR), LDS_BYTES, stream, a); }
#else
    a.ph_lo = 0; a.ph_hi = N_PHASES; hipLaunchKernelGGL(mk_fwd, dim3(grid), dim3(NTHR), LDS_BYTES, stream, a);
#endif
}
```

```cpp
#include <hip/hip_runtime.h>
#include <cstdio>
#include <cstdint>

#ifndef MK_PER_PHASE
#define MK_PER_PHASE 0
#endif

#define GAS __attribute__((address_space(1)))
#define LAS __attribute__((address_space(3)))
typedef unsigned short bf16;
typedef unsigned v4u __attribute__((ext_vector_type(4)));
typedef unsigned v2u __attribute__((ext_vector_type(2)));
typedef float f32x4 __attribute__((ext_vector_type(4)));
typedef float f32x2 __attribute__((ext_vector_type(2)));
typedef short bf16x8 __attribute__((ext_vector_type(8)));
#define RLX_AGENT __ATOMIC_RELAXED, __HIP_MEMORY_SCOPE_AGENT
#define LDS_WAIT() asm volatile("s_waitcnt lgkmcnt(0)" ::: "memory")
#define VM_WAIT() asm volatile("s_waitcnt vmcnt(0)" ::: "memory")

constexpr int T_TOK = 16384, DM = 1024, SEQ = 4096, NE = 64, TOPK = 8, EDIM = 256;
constexpr int SGU_W = 2048, SGU_HD = 512;
constexpr float ALPHA = 1.41421356237309515f;
constexpr float LN_EPS = 1e-5f, ROUTED_SCALE = 2.5f;
constexpr int CAP = 16384;
constexpr int NWAVES = 8, NTHR = 512;

constexpr size_t MiB = 1u << 20;
constexpr size_t WS_CTL = 0, CTL_ZERO_BYTES = 65536;
constexpr size_t WS_IDENT = 256 * 1024;
constexpr size_t WS_DEST = 1 * MiB;
constexpr size_t WS_GATE = WS_DEST + 512 * 1024;
constexpr size_t WS_ROWTOK = 2 * MiB;
constexpr size_t WS_VSTAT = WS_ROWTOK;
constexpr size_t WS_WIN = 6 * MiB;
constexpr size_t WS_WGRP = 8 * MiB;
constexpr size_t WS_WOUT = WS_WGRP + 512 * 1024;
constexpr size_t WS_WSIN = WS_WOUT + 2 * MiB;
constexpr size_t WS_WSOUT = WS_WSIN + 8 * MiB;
constexpr size_t WS_WRT = WS_WSOUT + 4 * MiB;
constexpr size_t WS_WGU = 23 * MiB;
constexpr size_t WS_WDN = WS_WGU + 65 * MiB;
constexpr size_t WS_XB = 121 * MiB;
constexpr size_t WS_H = 153 * MiB;
constexpr size_t WS_Y = 233 * MiB;
constexpr size_t WS_WGU1 = 378 * MiB, WS_WDN1 = WS_WGU1 + 65 * MiB;
constexpr size_t WS_MOE_LSTRIDE = WS_WGU1 - WS_WGU;
constexpr size_t WS_XR = 476 * MiB;
constexpr size_t WS_END = 508 * MiB;
constexpr size_t WS_Z = 153 * MiB, WS_POOLED = 185 * MiB, WS_YP = 217 * MiB;
constexpr size_t WS_HS = 153 * MiB;
constexpr size_t WS_GATED = 281 * MiB;
static_assert(WS_WRT + 512 * 1024 <= WS_WGU && WS_WDN + 33 * MiB <= WS_XB && WS_XB + 32 * MiB <= WS_H && WS_H + 80 * MiB <= WS_Y && WS_Y + 145 * MiB <= WS_WGU1 && WS_WDN1 + 33 * MiB <= WS_END && WS_GATED + 64 * MiB <= WS_WGU1, "ws map");
constexpr int CW_TMO = 0, CW_BAR = 64, CW_CNT = 4096, CW_QNEXT = 4608;

constexpr int RING_BYTES = 131072;
constexpr int MISC_OFF = RING_BYTES;
constexpr int LDS_BYTES = 147456;
constexpr int MI_BARW = 0, MI_CNT = 64, MI_TSTART = 320, MI_YSTART = 576, MI_NTILES = 832, MI_TILE_E = 1024;

__device__ __forceinline__ unsigned cvt_pk_bf16(float lo, float hi) { unsigned r; asm volatile("v_cvt_pk_bf16_f32 %0, %1, %2" : "=v"(r) : "v"(lo), "v"(hi)); return r; }
__device__ __forceinline__ float bf_lo(unsigned w) { return __uint_as_float(w << 16); }
__device__ __forceinline__ float bf_hi(unsigned w) { return __uint_as_float(w & 0xffff0000u); }
__device__ __forceinline__ float wave_sum(float v) {
#pragma unroll
    for (int o = 1; o < 64; o <<= 1) v += __shfl_xor(v, o);
    return v;
}
__device__ __forceinline__ float sigmoidf_(float x) { return __builtin_amdgcn_rcpf(1.0f + __builtin_amdgcn_exp2f(-1.4426950408889634f * x)); }
__device__ __forceinline__ f32x2 gelu_tanh2(f32x2 v) { const f32x2 v2 = v * v; const f32x2 y = v * (v2 * 0.044715f + 1.0f); const f32x2 t = y * (-2.3022081983f);
    f32x2 e; e.x = __builtin_amdgcn_exp2f(t.x); e.y = __builtin_amdgcn_exp2f(t.y); const f32x2 d = e + 1.0f; f32x2 r; r.x = __builtin_amdgcn_rcpf(d.x); r.y = __builtin_amdgcn_rcpf(d.y); return v * r; }
__device__ __forceinline__ float gelu_tanh(float v) { const float y = v + 0.044715f * v * v * v; return v * __builtin_amdgcn_rcpf(1.0f + __builtin_amdgcn_exp2f(-2.3022081983f * y)); }

#define XB_TMO      128
#define XB_XCNT(j)  (256  + 64 * (j))
#define XB_XSUB(j)  (1280 + 64 * (j))
#define XB_XGEN(j)  (2304 + 64 * (j))
#define XB_TOP      3328
#define XB_TOPGEN   3392
#define XCD_BAR_WORDS 3456
#define XB_SPIN_CAP (1u << 20)
__device__ __forceinline__ unsigned xb_ld(unsigned* p)              { return __hip_atomic_load(p, __ATOMIC_RELAXED, __HIP_MEMORY_SCOPE_AGENT); }
__device__ __forceinline__ unsigned xb_add(unsigned* p, unsigned v) { return __hip_atomic_fetch_add(p, v, __ATOMIC_RELAXED, __HIP_MEMORY_SCOPE_AGENT); }
__device__ __forceinline__ unsigned xb_xcc_id() { return (unsigned)__builtin_amdgcn_s_getreg((3 << 11) | 20) & 0xFu; }
#define XB_SPIN(cond, bar) do { unsigned _sp = 0; while (cond) { __builtin_amdgcn_s_sleep(1); \
    if ((++_sp & 255u) == 0u) { if (xb_ld(&(bar)[XB_TMO])) break; if (_sp > XB_SPIN_CAP) { atomicAdd(&(bar)[XB_TMO], 1u); break; } } } } while (0)
struct XcdBarrier { unsigned* bar; unsigned x; volatile LAS unsigned* st; };
__device__ __forceinline__ XcdBarrier xcd_barrier_post(unsigned* bar, volatile LAS unsigned* st) {
    XcdBarrier b; b.bar = bar; b.x = xb_xcc_id(); b.st = st;
    if (threadIdx.x == 0) (void)xb_add(&bar[XB_XCNT(b.x)], 1u);
    return b;
}
__device__ __forceinline__ void xcd_barrier_complete(unsigned* bar, unsigned x, unsigned& nloc, unsigned& nx) {
    const unsigned G = gridDim.x * gridDim.y * gridDim.z;
    unsigned sum, cnt, mine, sp = 0u;
    for (;;) {
        sum = 0u; cnt = 0u; mine = 0u;
#pragma unroll
        for (unsigned j = 0; j < 16; ++j) { const unsigned c = xb_ld(&bar[XB_XCNT(j)]); sum += c; cnt += (c > 0u) ? 1u : 0u; mine = (j == x) ? c : mine; }
        if (sum == G) break;
        __builtin_amdgcn_s_sleep(1);
        if ((++sp & 255u) == 0u) { if (xb_ld(&bar[XB_TMO])) break; if (sp > XB_SPIN_CAP) { atomicAdd(&bar[XB_TMO], 1u); break; } }
    }
    nloc = mine > 0u ? mine : 1u; nx = cnt > 0u ? cnt : 1u;
}
struct Args;
__device__ __forceinline__ bool convert_steal(const Args& a, int layer, LAS unsigned char* lds, int wave, int lane);
__device__ __forceinline__ void xcd_barrier(const XcdBarrier& b, const Args* bga = nullptr, int bg_layer = -1, LAS unsigned char* lds = nullptr) {
    asm volatile("s_waitcnt vmcnt(0)" ::: "memory");
    __syncthreads();
    if (threadIdx.x == 0) {
        unsigned* bar = b.bar;
        __builtin_amdgcn_s_waitcnt(0);
        unsigned nloc = b.st[0], nx = b.st[1];
        if (nloc == 0u) { xcd_barrier_complete(bar, b.x, nloc, nx); b.st[0] = nloc; b.st[1] = nx; }
        const unsigned old = xb_add(&bar[XB_XSUB(b.x)], 1u);
        const unsigned gen = old / nloc;
        if (old + 1u == (gen + 1u) * nloc) {
            __builtin_amdgcn_fence(__ATOMIC_RELEASE, "agent");
            asm volatile("s_waitcnt vmcnt(0)" ::: "memory");
            const unsigned og = xb_add(&bar[XB_TOP], 1u);
            const unsigned tg = og / nx;
            if (og + 1u == (tg + 1u) * nx) xb_add(&bar[XB_TOPGEN], 1u);
            else XB_SPIN(xb_ld(&bar[XB_TOPGEN]) == tg, bar);
            __builtin_amdgcn_fence(__ATOMIC_ACQUIRE, "agent");
            xb_add(&bar[XB_XGEN(b.x)], 1u);
            asm volatile("s_waitcnt vmcnt(0)" ::: "memory");
            b.st[2] = 0xFFFFFFFFu;
        } else if (bg_layer < 0) {
            XB_SPIN(xb_ld(&bar[XB_XGEN(b.x)]) == gen, bar);
            __builtin_amdgcn_fence(__ATOMIC_ACQUIRE, "agent");
            asm volatile("s_waitcnt vmcnt(0)" ::: "memory");
            b.st[2] = 0xFFFFFFFFu;
        } else b.st[2] = gen;
    }
    __syncthreads();
    if (bg_layer >= 0) {
        const unsigned gen = b.st[2];
        if (gen != 0xFFFFFFFFu) {
            const int lane = threadIdx.x & 63, wave = __builtin_amdgcn_readfirstlane(threadIdx.x >> 6);
            bool more = true;
            while (more && (unsigned)__builtin_amdgcn_readfirstlane((int)xb_ld(&b.bar[XB_XGEN(b.x)])) == gen) more = convert_steal(*bga, bg_layer, lds, wave, lane);
            asm volatile("s_waitcnt vmcnt(0)" ::: "memory");
            __syncthreads();
            if (threadIdx.x == 0) { XB_SPIN(xb_ld(&b.bar[XB_XGEN(b.x)]) == gen, b.bar); __builtin_amdgcn_fence(__ATOMIC_ACQUIRE, "agent"); asm volatile("s_waitcnt vmcnt(0)" ::: "memory"); }
        } else __syncthreads();
        __syncthreads();
    }
}

namespace pg8 {
constexpr int BM = 256, BK = 64, HALF = 128, HTB = HALF * BK * 2, STAGE_BYTES = 8 * HTB, NXCD = 8, WGM = 8;
__host__ __device__ __forceinline__ int lds_byte(int r, int c) { const int st = (r >> 4) * 2 + (c >> 5), rr = r & 15, cc = c & 31, ob = rr * 64 + cc * 2; return st * 1024 + (ob ^ (((ob >> 9) & 1) << 5)); }
__host__ __device__ __forceinline__ void stage_rc(int b, int& R, int& C) { const int st = b / 1024, sb = b % 1024, swz = sb ^ (((sb >> 9) & 1) << 5); R = (st >> 1) * 16 + swz / 64; C = (st & 1) * 32 + (swz % 64) / 2; }
__host__ __device__ __forceinline__ int perm32(int rho) { const int n = rho >> 4, i = rho & 15; return 8 * (i >> 2) + 4 * n + (i & 3); }

typedef int v8i __attribute__((ext_vector_type(8)));
typedef int v4i __attribute__((ext_vector_type(4)));
__device__ __forceinline__ v8i cat8(bf16x8 lo, bf16x8 hi) { const v4i a = __builtin_bit_cast(v4i, lo), b = __builtin_bit_cast(v4i, hi); return __builtin_shufflevector(a, b, 0, 1, 2, 3, 4, 5, 6, 7); }
struct Unit { const char* A; const char* B; const unsigned* gat; int nvalid; int i0, i1, i2; };

template <class Epi, class Sched, bool GATHER, bool ALIGN_EPI, bool SP2, int BMODE = 0, int F8 = 0>
__device__ __forceinline__ void gemm_phase(LAS unsigned char* lds, const unsigned lda, const unsigned ldb, const int nt, const Sched& S, const Epi& E) {
    const int tid = threadIdx.x, wid = __builtin_amdgcn_readfirstlane(tid >> 6), lane = tid & 63, wr = wid >> 2, wc = wid & 3, fr = lane & 15, fq = lane >> 4;
    int R0, C0, R1, C1; stage_rc(tid * 16, R0, C0); stage_rc(tid * 16 + 8192, R1, C1);
    const int Rb0 = BMODE == 0 ? (R0 & ~31) + perm32(R0 & 31) : 64 * (R0 >> 5) + 16 * ((R0 & 15) >> 2) + 4 * ((R0 >> 4) & 1) + (R0 & 3);
    const int Rb1 = BMODE == 0 ? (R1 & ~31) + perm32(R1 & 31) : 64 * (R1 >> 5) + 16 * ((R1 & 15) >> 2) + 4 * ((R1 >> 4) & 1) + (R1 & 3);
    const unsigned voffB0 = (unsigned)Rb0 * ldb + (unsigned)C0 * 2u, voffB1 = (unsigned)Rb1 * ldb + (unsigned)C1 * 2u;
    const size_t hstepB = (size_t)(BMODE == 0 ? HALF : 8) * ldb;
    const size_t kstep = (size_t)(BK * 2);
    const unsigned ldsw = (unsigned)wid * 1024u;
    const int aoff = lds_byte(wr * 64 + fr, F8 ? fq * 16 : fq * 8), boff = lds_byte(wc * 32 + fr, F8 ? fq * 16 : fq * 8);
    const int aoff2 = F8 ? lds_byte(wr * 64 + fr, fq * 16 + 8) : aoff + 1024, boff2 = F8 ? lds_byte(wc * 32 + fr, fq * 16 + 8) : boff + 1024;
#define PG8_SA(b, h) (((b) * 2 + (h)) * HTB)
#define PG8_SB(b, h) ((4 + (b) * 2 + (h)) * HTB)
#define PG8_STAGE(bufoff, gbase, v0, v1) do { unsigned _v0 = (v0), _v1 = (v1); asm volatile("" : "+v"(_v0), "+v"(_v1)); \
        __builtin_amdgcn_global_load_lds((const unsigned*)((const char*)(gbase) + _v0), (LAS unsigned*)(lds + (bufoff) + ldsw), 16, 0, 0); \
        __builtin_amdgcn_global_load_lds((const unsigned*)((const char*)(gbase) + _v1), (LAS unsigned*)(lds + (bufoff) + ldsw + 8192), 16, 0, 0); } while (0)
#define PG8_LDA(dst, b, h) do { _Pragma("unroll") for (int m = 0; m < 4; ++m) { dst[m][0] = *(const LAS bf16x8*)(lds + PG8_SA(b, h) + aoff + m * 2048); dst[m][1] = *(const LAS bf16x8*)(lds + PG8_SA(b, h) + aoff2 + m * 2048); } } while (0)
#define PG8_LDB(dst, b, h) do { _Pragma("unroll") for (int n = 0; n < 2; ++n) { dst[n][0] = *(const LAS bf16x8*)(lds + PG8_SB(b, h) + boff + n * 2048); dst[n][1] = *(const LAS bf16x8*)(lds + PG8_SB(b, h) + boff2 + n * 2048); } } while (0)
#define PG8_MMA(ai, bj, At, Bt) do { __builtin_amdgcn_s_setprio(1); _Pragma("unroll") for (int m = 0; m < 4; ++m) _Pragma("unroll") for (int n = 0; n < 2; ++n) { \
        if constexpr (F8) acc[ai][bj][m][n] = __builtin_amdgcn_mfma_scale_f32_16x16x128_f8f6f4(cat8(Bt[n][0], Bt[n][1]), cat8(At[m][0], At[m][1]), acc[ai][bj][m][n], 0, 0, 0, 0x7F7F7F7F, 0, 0x7F7F7F7F); \
        else { _Pragma("unroll") for (int k = 0; k < 2; ++k) acc[ai][bj][m][n] = __builtin_amdgcn_mfma_f32_16x16x32_bf16(Bt[n][k], At[m][k], acc[ai][bj][m][n], 0, 0, 0); } } __builtin_amdgcn_s_setprio(0); } while (0)
#define PG8_WAIT_V(n) asm volatile("s_waitcnt vmcnt(" #n ")" ::: "memory")
#define PG8_WAIT_L(n) asm volatile("s_waitcnt lgkmcnt(" #n ")" ::: "memory")
#define PG8_BAR __builtin_amdgcn_s_barrier()
#define PG8_SCHED __builtin_amdgcn_sched_barrier(0)
#define PG8_SETV(v00, v01, v10, v11, u) do { \
        if (GATHER) { int _t = tid; asm volatile("" : "+v"(_t)); int r0, c0, r1, c1; stage_rc(_t * 16, r0, c0); stage_rc(_t * 16 + 8192, r1, c1);     \
            const unsigned ta = r0 < (u).nvalid ? (u).gat[r0] : 0u, tb = r1 < (u).nvalid ? (u).gat[r1] : 0u, \
                                     tc = (HALF + r0) < (u).nvalid ? (u).gat[HALF + r0] : 0u, td = (HALF + r1) < (u).nvalid ? (u).gat[HALF + r1] : 0u; \
            v00 = ta * lda + (unsigned)c0 * 2u; v01 = tb * lda + (unsigned)c1 * 2u; v10 = tc * lda + (unsigned)c0 * 2u; v11 = td * lda + (unsigned)c1 * 2u; } \
        else { v00 = (unsigned)R0 * lda + (unsigned)C0 * 2u; v01 = (unsigned)R1 * lda + (unsigned)C1 * 2u; v10 = (unsigned)(HALF + R0) * lda + (unsigned)C0 * 2u; v11 = (unsigned)(HALF + R1) * lda + (unsigned)C1 * 2u; } } while (0)
    Unit cur, nxt; int ui = 0;
    if (!S.next(0, cur)) return;
    f32x4 acc[2][2][4][2];
#pragma unroll
    for (int a = 0; a < 2; ++a)
#pragma unroll
        for (int b = 0; b < 2; ++b)
#pragma unroll
            for (int m = 0; m < 4; ++m)
#pragma unroll
                for (int n = 0; n < 2; ++n) acc[a][b][m][n] = (f32x4){0.f, 0.f, 0.f, 0.f};
    bf16x8 At[4][2], B0[2][2], B1[2][2];
    const char* cA = cur.A; const char* cB = cur.B;
    unsigned cv00, cv01, cv10, cv11;
    PG8_SETV(cv00, cv01, cv10, cv11, cur);
    if constexpr (SP2) {
        PG8_STAGE(PG8_SB(0, 0), cB, voffB0, voffB1); PG8_STAGE(PG8_SB(0, 1), cB + hstepB, voffB0, voffB1); PG8_STAGE(PG8_SA(0, 0), cA, cv00, cv01); PG8_STAGE(PG8_SA(0, 1), cA, cv10, cv11);
        if (wr == 1) PG8_BAR;
        PG8_WAIT_V(2); PG8_BAR;
        PG8_STAGE(PG8_SB(1, 0), cB + kstep, voffB0, voffB1); PG8_STAGE(PG8_SA(1, 0), cA + kstep, cv00, cv01); PG8_STAGE(PG8_SB(1, 1), cB + hstepB + kstep, voffB0, voffB1);
        PG8_WAIT_V(6); PG8_BAR;
    } else {
        PG8_STAGE(PG8_SB(0, 0), cB, voffB0, voffB1); PG8_STAGE(PG8_SA(0, 0), cA, cv00, cv01); PG8_STAGE(PG8_SB(0, 1), cB + hstepB, voffB0, voffB1); PG8_STAGE(PG8_SA(0, 1), cA, cv10, cv11);
        if (wr == 1) PG8_BAR;
        PG8_WAIT_V(4); PG8_BAR;
        PG8_STAGE(PG8_SB(1, 0), cB + kstep, voffB0, voffB1); PG8_STAGE(PG8_SA(1, 0), cA + kstep, cv00, cv01); PG8_STAGE(PG8_SB(1, 1), cB + hstepB + kstep, voffB0, voffB1);
        PG8_WAIT_V(6); PG8_BAR;
    }
    for (;;) {
        const bool has_next = S.next(ui + 1, nxt);
        const char* nA = has_next ? nxt.A : cA; const char* nB = has_next ? nxt.B : cB;
#pragma unroll 1
        for (int t = 0; t < nt; t += 2) {
            const bool last = (t == nt - 2);
            const char* a1 = cA + (size_t)(t + 1) * kstep;
            const char* a2 = last ? nA : cA + (size_t)(t + 2) * kstep; const char* b2 = last ? nB : cB + (size_t)(t + 2) * kstep;
            const char* a3 = a2 + kstep; const char* b3 = b2 + kstep;
            if constexpr (SP2) {
            PG8_LDB(B0, 0, 0); PG8_LDB(B1, 0, 1); PG8_SCHED; PG8_LDA(At, 0, 0); PG8_STAGE(PG8_SA(1, 1), a1, cv10, cv11);
            PG8_WAIT_V(8); PG8_WAIT_L(0); PG8_BAR; PG8_MMA(0, 0, At, B0); PG8_MMA(0, 1, At, B1); PG8_BAR; PG8_SCHED;
            if constexpr (GATHER) { if (last && has_next) { PG8_SETV(cv00, cv01, cv10, cv11, nxt); } }
            PG8_LDA(At, 0, 1); PG8_STAGE(PG8_SB(0, 0), b2, voffB0, voffB1); PG8_STAGE(PG8_SB(0, 1), b2 + hstepB, voffB0, voffB1); PG8_STAGE(PG8_SA(0, 0), a2, cv00, cv01);
            PG8_WAIT_V(8); PG8_WAIT_L(0); PG8_BAR; PG8_MMA(1, 0, At, B0); PG8_MMA(1, 1, At, B1); PG8_BAR; PG8_SCHED;
            PG8_LDB(B0, 1, 0); PG8_LDB(B1, 1, 1); PG8_SCHED; PG8_LDA(At, 1, 0); PG8_STAGE(PG8_SA(0, 1), a2, cv10, cv11);
            PG8_WAIT_V(8); PG8_WAIT_L(0); PG8_BAR; PG8_MMA(0, 0, At, B0); PG8_MMA(0, 1, At, B1); PG8_BAR; PG8_SCHED;
            PG8_LDA(At, 1, 1); PG8_STAGE(PG8_SB(1, 0), b3, voffB0, voffB1); PG8_STAGE(PG8_SB(1, 1), b3 + hstepB, voffB0, voffB1); PG8_STAGE(PG8_SA(1, 0), a3, cv00, cv01);
            PG8_WAIT_V(8); PG8_WAIT_L(0); PG8_BAR; PG8_MMA(1, 0, At, B0); PG8_MMA(1, 1, At, B1); PG8_BAR; PG8_SCHED;
            } else {
            PG8_LDB(B0, 0, 0); PG8_SCHED; PG8_LDA(At, 0, 0); PG8_STAGE(PG8_SA(1, 1), a1, cv10, cv11);
            PG8_WAIT_L(8); PG8_BAR; PG8_WAIT_L(0); PG8_MMA(0, 0, At, B0); PG8_BAR; PG8_SCHED;
            if constexpr (GATHER) { if (last && has_next) { PG8_SETV(cv00, cv01, cv10, cv11, nxt); } }
            PG8_LDB(B1, 0, 1); PG8_STAGE(PG8_SB(0, 0), b2, voffB0, voffB1);
            PG8_BAR; PG8_WAIT_L(0); PG8_MMA(0, 1, At, B1); PG8_BAR;
            PG8_LDA(At, 0, 1); PG8_STAGE(PG8_SA(0, 0), a2, cv00, cv01);
            PG8_BAR; PG8_WAIT_L(0); PG8_MMA(1, 0, At, B0); PG8_BAR; PG8_SCHED;
            PG8_STAGE(PG8_SB(0, 1), b2 + hstepB, voffB0, voffB1);
            PG8_WAIT_V(6); PG8_BAR; PG8_MMA(1, 1, At, B1); PG8_BAR;
            PG8_LDB(B0, 1, 0); PG8_SCHED; PG8_LDA(At, 1, 0); PG8_STAGE(PG8_SA(0, 1), a2, cv10, cv11);
            PG8_WAIT_L(8); PG8_BAR; PG8_WAIT_L(0); PG8_MMA(0, 0, At, B0); PG8_BAR; PG8_SCHED;
            PG8_LDB(B1, 1, 1); PG8_STAGE(PG8_SB(1, 0), b3, voffB0, voffB1);
            PG8_BAR; PG8_WAIT_L(0); PG8_MMA(0, 1, At, B1); PG8_BAR;
            PG8_LDA(At, 1, 1); PG8_STAGE(PG8_SA(1, 0), a3, cv00, cv01);
            PG8_BAR; PG8_WAIT_L(0); PG8_MMA(1, 0, At, B0); PG8_BAR; PG8_SCHED;
            PG8_STAGE(PG8_SB(1, 1), b3 + hstepB, voffB0, voffB1);
            PG8_WAIT_V(6); PG8_BAR; PG8_MMA(1, 1, At, B1); PG8_BAR;
            }
        }
        if constexpr (ALIGN_EPI) { if (wr == 0) PG8_BAR; }
        { int t2 = tid; asm volatile("" : "+v"(t2));
          E(acc, cur, wr, wc, t2 & 15, (t2 & 63) >> 4); }
        if (!has_next) break;
#pragma unroll
        for (int a = 0; a < 2; ++a)
#pragma unroll
            for (int b = 0; b < 2; ++b)
#pragma unroll
                for (int m = 0; m < 4; ++m)
#pragma unroll
                    for (int n = 0; n < 2; ++n) acc[a][b][m][n] = (f32x4){0.f, 0.f, 0.f, 0.f};
        cur = nxt; cA = nA; cB = nB; ++ui;
        if constexpr (ALIGN_EPI) { if (wr == 1) PG8_BAR; }
    }
    PG8_WAIT_V(0);
    if constexpr (!ALIGN_EPI) { if (wr == 0) PG8_BAR; }
    PG8_BAR;
#undef PG8_SA
#undef PG8_SB
#undef PG8_STAGE
#undef PG8_LDA
#undef PG8_LDB
#undef PG8_MMA
#undef PG8_WAIT_V
#undef PG8_WAIT_L
#undef PG8_BAR
#undef PG8_SCHED
#undef PG8_SETV
}

struct DenseSched {
    const char* A; const char* B; unsigned lda, ldb, a_pn; int nM, nN, nwg, G, c; const unsigned* ident = nullptr;
    __device__ __forceinline__ bool next(int i, Unit& u) const {
        const long L = (long)i * G + c; if (L >= nwg) return false;
        int wgid = (int)L; { const int q = nwg / NXCD, r = nwg % NXCD, xcd = wgid % NXCD, off = wgid / NXCD; wgid = (xcd < r ? xcd * (q + 1) : r * (q + 1) + (xcd - r) * q) + off; }
        const int nig = WGM * nN, gid = wgid / nig, fm = gid * WGM, gsz = (nM - fm) < WGM ? (nM - fm) : WGM;
        const int pm = fm + ((wgid % nig) % gsz), pn = (wgid % nig) / gsz;
        u.A = ident ? A : A + (size_t)pm * BM * lda + (size_t)pn * a_pn; u.B = B + (size_t)pn * BM * ldb; u.gat = ident ? ident + pm * BM : nullptr; u.nvalid = BM; u.i0 = pm; u.i1 = pn; u.i2 = 0; return true;
    }
};
struct MoeInfo { const LAS unsigned* cnt; const LAS unsigned* tstart; const LAS unsigned* ystart; const LAS unsigned char* tile_e; int ntiles; };
struct G1Sched {
    MoeInfo mi; const char* XB; const char* Wgu; const unsigned* rowtok; const unsigned* ident; int G, vcu;
    __device__ __forceinline__ bool next(int i, Unit& u) const {
        const int L = i * G + vcu; if (L >= 2 * mi.ntiles) return false;
        const int tile = L >> 1, uu = L & 1; int e;
        if (tile < 64) { e = 64; u.gat = ident + tile * 256; u.nvalid = 256; }
        else { e = __builtin_amdgcn_readfirstlane((int)mi.tile_e[tile]); const int pos0 = (tile - __builtin_amdgcn_readfirstlane((int)mi.tstart[e])) * 256; u.gat = rowtok + (size_t)e * CAP + pos0; const int rem = __builtin_amdgcn_readfirstlane((int)mi.cnt[e]) - pos0; u.nvalid = rem < 256 ? rem : 256; }
        u.A = XB; u.B = Wgu + ((size_t)e * 512 + (size_t)uu * 256) * 1024; u.i0 = tile; u.i1 = uu; u.i2 = 0; return true;
    }
};
struct G2Sched {
    MoeInfo mi; const char* H; const char* Wd; int G, vcu, L0;
    __device__ __forceinline__ bool next(int i, Unit& u) const {
        const int L = i * G + vcu + L0; if (L >= 4 * mi.ntiles) return false;
        const int tile = L >> 2, pn = L & 3; int e;
        if (tile < 64) { e = 64; u.i0 = 131072 + tile * 256; u.i2 = 0; u.nvalid = 256; }
        else { e = __builtin_amdgcn_readfirstlane((int)mi.tile_e[tile]); const int pos0 = (tile - __builtin_amdgcn_readfirstlane((int)mi.tstart[e])) * 256; u.i0 = __builtin_amdgcn_readfirstlane((int)mi.ystart[e]) + pos0; u.i2 = 0; const int rem = __builtin_amdgcn_readfirstlane((int)mi.cnt[e]) - pos0; u.nvalid = rem < 256 ? rem : 256; }
        u.A = H + (size_t)tile * 256 * 256; u.B = Wd + ((size_t)e * 1024 + (size_t)pn * 256) * 256; u.gat = nullptr; u.i1 = pn; return true;
    }
};

template <int ACT, bool BIAS, bool SCALE, bool W32 = false, bool VSTAT = false> struct EpiBf16 {
    bf16* O; int ldo; const float* bias; const float* scale; float* vstat;
    __device__ __forceinline__ void operator()(const f32x4 (&acc)[2][2][4][2], const Unit& u, int wr, int wc, int fr, int fq) const {
        const int row0 = u.i0 * BM + wr * 64 + fr, col0 = u.i1 * BM + wc * 32 + 8 * fq;
        const bool dostat = VSTAT && u.i1 >= 8;
        f32x4 bv[2][2], sv[2][2];
#pragma unroll
        for (int bj = 0; bj < 2; ++bj)
#pragma unroll
            for (int n = 0; n < 2; ++n) { bv[bj][n] = BIAS ? *(const f32x4*)(bias + col0 + bj * HALF + 4 * n) : (f32x4){0.f, 0.f, 0.f, 0.f}; sv[bj][n] = SCALE ? *(const f32x4*)(scale + col0 + bj * HALF + 4 * n) : (f32x4){1.f, 1.f, 1.f, 1.f}; }
#pragma unroll
        for (int ai = 0; ai < 2; ++ai)
#pragma unroll
            for (int m = 0; m < 4; ++m) { bf16* rowp = O + (size_t)(row0 + ai * HALF + m * 16) * ldo + col0; float ssum = 0.f, ssq = 0.f;
#pragma unroll
                for (int bj = 0; bj < 2; ++bj) { f32x4 v0 = acc[ai][bj][m][0] * (W32 ? 0.03125f : 1.0f) + bv[bj][0], v1 = acc[ai][bj][m][1] * (W32 ? 0.03125f : 1.0f) + bv[bj][1];
                    if (ACT == 1) { const f32x2 a0 = gelu_tanh2((f32x2){v0[0], v0[1]}), a1 = gelu_tanh2((f32x2){v0[2], v0[3]}), a2 = gelu_tanh2((f32x2){v1[0], v1[1]}), a3 = gelu_tanh2((f32x2){v1[2], v1[3]});
                        v0 = (f32x4){a0.x, a0.y, a1.x, a1.y}; v1 = (f32x4){a2.x, a2.y, a3.x, a3.y}; }
                    if (SCALE) { v0 = v0 * sv[bj][0]; v1 = v1 * sv[bj][1]; }
                    v4u w; w.x = cvt_pk_bf16(v0[0], v0[1]); w.y = cvt_pk_bf16(v0[2], v0[3]); w.z = cvt_pk_bf16(v1[0], v1[1]); w.w = cvt_pk_bf16(v1[2], v1[3]);
                    *(v4u*)(rowp + bj * HALF) = w;
                    if constexpr (VSTAT) {
#pragma unroll
                        for (int j = 0; j < 4; ++j) { ssum += v0[j] + v1[j]; ssq += v0[j] * v0[j] + v1[j] * v1[j]; } } }
                if constexpr (VSTAT) { if (dostat) {
                    ssum += __shfl_xor(ssum, 16); ssq += __shfl_xor(ssq, 16); ssum += __shfl_xor(ssum, 32); ssq += __shfl_xor(ssq, 32);
                    if (fq == 0) *(f32x2*)(vstat + ((size_t)(row0 + ai * HALF + m * 16) * 32 + (size_t)(u.i1 - 8) * 4 + wc) * 2) = (f32x2){ssum, ssq}; } } }
    }
};
template <bool BASE_BF16> struct EpiResidB {
    const void* base; bf16* outb;
    __device__ __forceinline__ void operator()(const f32x4 (&acc)[2][2][4][2], const Unit& u, int wr, int wc, int fr, int fq) const {
        const int row0 = u.i0 * BM + wr * 64 + fr, col0 = u.i1 * BM + wc * 32 + 8 * fq;
#pragma unroll
        for (int ai = 0; ai < 2; ++ai)
#pragma unroll
            for (int m = 0; m < 4; ++m) { const size_t off = (size_t)(row0 + ai * HALF + m * 16) * DM + col0;
#pragma unroll
                for (int bj = 0; bj < 2; ++bj) { f32x4 b0, b1;
                    if constexpr (BASE_BF16) { const v4u w = *(const v4u*)((const bf16*)base + off + bj * HALF); b0 = (f32x4){bf_lo(w.x), bf_hi(w.x), bf_lo(w.y), bf_hi(w.y)}; b1 = (f32x4){bf_lo(w.z), bf_hi(w.z), bf_lo(w.w), bf_hi(w.w)}; }
                    else { b0 = *(const f32x4*)((const float*)base + off + bj * HALF); b1 = *(const f32x4*)((const float*)base + off + bj * HALF + 4); }
                    const f32x4 o0 = b0 * ALPHA + acc[ai][bj][m][0], o1 = b1 * ALPHA + acc[ai][bj][m][1];
                    v4u o; o.x = cvt_pk_bf16(o0[0], o0[1]); o.y = cvt_pk_bf16(o0[2], o0[3]); o.z = cvt_pk_bf16(o1[0], o1[1]); o.w = cvt_pk_bf16(o1[2], o1[3]);
                    *(v4u*)(outb + off + bj * HALF) = o; }
                asm volatile("" ::: "memory"); }
    }
};
struct EpiResid {
    const float* base; float* out;
    __device__ __forceinline__ void operator()(const f32x4 (&acc)[2][2][4][2], const Unit& u, int wr, int wc, int fr, int fq) const {
        const int row0 = u.i0 * BM + wr * 64 + fr, col0 = u.i1 * BM + wc * 32 + 8 * fq;
#pragma unroll
        for (int ai = 0; ai < 2; ++ai)
#pragma unroll
            for (int m = 0; m < 4; ++m) { const size_t off = (size_t)(row0 + ai * HALF + m * 16) * DM + col0;
#pragma unroll
                for (int bj = 0; bj < 2; ++bj) { const f32x4 b0 = *(const f32x4*)(base + off + bj * HALF), b1 = *(const f32x4*)(base + off + bj * HALF + 4);
                    *(f32x4*)(out + off + bj * HALF) = b0 * ALPHA + acc[ai][bj][m][0]; *(f32x4*)(out + off + bj * HALF + 4) = b1 * ALPHA + acc[ai][bj][m][1]; }
                asm volatile("" ::: "memory"); }
    }
};
struct EpiSwiglu {
    unsigned char* H8;
    __device__ __forceinline__ void operator()(const f32x4 (&acc)[2][2][4][2], const Unit& u, int wr, int wc, int fr, int fq) const {
        const int row0 = u.i0 * BM + wr * 64 + fr, col0 = u.i1 * HALF + wc * 32 + 8 * fq;
#pragma unroll
        for (int ai = 0; ai < 2; ++ai)
#pragma unroll
            for (int m = 0; m < 4; ++m) { unsigned char* rowp = H8 + (size_t)(row0 + ai * HALF + m * 16) * EDIM + col0; float h[8];
#pragma unroll
                for (int n = 0; n < 2; ++n)
#pragma unroll
                    for (int j = 0; j < 4; j += 2) { const f32x2 g = (f32x2){acc[ai][0][m][n][j], acc[ai][0][m][n][j + 1]} * 0.03125f, up = (f32x2){acc[ai][1][m][n][j], acc[ai][1][m][n][j + 1]} * 0.25f;
                        const f32x2 t = g * (-1.4426950408889634f); f32x2 e; e.x = __builtin_amdgcn_exp2f(t.x); e.y = __builtin_amdgcn_exp2f(t.y); const f32x2 d = e + 1.0f; f32x2 r; r.x = __builtin_amdgcn_rcpf(d.x); r.y = __builtin_amdgcn_rcpf(d.y);
                        const f32x2 hh = (g * r) * up; h[4 * n + j] = hh.x; h[4 * n + j + 1] = hh.y; }
                int t0 = 0, t1 = 0; t0 = __builtin_amdgcn_cvt_pk_fp8_f32(h[0], h[1], t0, false); t0 = __builtin_amdgcn_cvt_pk_fp8_f32(h[2], h[3], t0, true); t1 = __builtin_amdgcn_cvt_pk_fp8_f32(h[4], h[5], t1, false); t1 = __builtin_amdgcn_cvt_pk_fp8_f32(h[6], h[7], t1, true);
                *(v2u*)rowp = (v2u){(unsigned)t0, (unsigned)t1}; }
    }
};
struct EpiDown {
    unsigned char* Y8;
    __device__ __forceinline__ void operator()(const f32x4 (&acc)[2][2][4][2], const Unit& u, int wr, int wc, int fr, int fq) const {
        const int r0 = wr * 64 + fr, col0 = u.i1 * BM + wc * 64 + 16 * fq;
#pragma unroll
        for (int ai = 0; ai < 2; ++ai)
#pragma unroll
            for (int m = 0; m < 4; ++m) { const int r = r0 + ai * HALF + m * 16;
                if (r < u.nvalid) { v4u w;
#pragma unroll
                    for (int q = 0; q < 4; ++q) { const f32x4 v = acc[ai][q >> 1][m][q & 1] * 0.0625f;     int t = 0; t = __builtin_amdgcn_cvt_pk_fp8_f32(v[0], v[1], t, false); t = __builtin_amdgcn_cvt_pk_fp8_f32(v[2], v[3], t, true); w[q] = (unsigned)t; }
                    *(v4u*)(Y8 + (size_t)(u.i0 + r) * DM + col0) = w; } }
    }
};
}

struct Args { const float* in[24]; float* out; unsigned char* ws; int ph_lo, ph_hi; };
enum { I_X = 0, I_PWIN, I_PWGRP, I_PSCALE, I_PWOUT, I_SWIN, I_SBIN, I_SLNG, I_SLNB, I_SWS, I_SBS, I_SWOUT, I_LNMG, I_LNMB, I_WR, I_RB, I_WG, I_WU, I_WD, I_SHG, I_SHU, I_SHD, I_LNFG, I_LNFB };

__device__ __forceinline__ void tr_item(const float* W, int N, int k0, int n0, bf16* dst  , int dpitch, LAS float* scr, int lane) {
#pragma unroll 8
    for (int i = 0; i < 32; ++i) { const int kk = 2 * i + (lane >> 5); scr[kk * 33 + (lane & 31)] = W[(size_t)(k0 + kk) * N + n0 + (lane & 31)]; }
    LDS_WAIT(); asm volatile("" ::: "memory");
    const int c = lane & 7;
#pragma unroll
    for (int j = 0; j < 4; ++j) { const int n = (lane >> 3) + 8 * j; const LAS float* s = scr + (8 * c) * 33 + n;
        v4u o; o.x = cvt_pk_bf16(s[0 * 33], s[1 * 33]); o.y = cvt_pk_bf16(s[2 * 33], s[3 * 33]); o.z = cvt_pk_bf16(s[4 * 33], s[5 * 33]); o.w = cvt_pk_bf16(s[6 * 33], s[7 * 33]);
        *(v4u*)(dst + (size_t)n * dpitch + 8 * c) = o; }
    LDS_WAIT(); asm volatile("" ::: "memory");
}
__device__ __forceinline__ void tr_item_f8(const float* W, int N, int k0, int n0, unsigned char* dst, int dpitch, float scale, LAS float* scr, int lane) {
#pragma unroll 8
    for (int i = 0; i < 32; ++i) { const int kk = 2 * i + (lane >> 5); scr[kk * 33 + (lane & 31)] = W[(size_t)(k0 + kk) * N + n0 + (lane & 31)]; }
    LDS_WAIT(); asm volatile("" ::: "memory");
    const int c = lane & 7;
#pragma unroll
    for (int j = 0; j < 4; ++j) { const int n = (lane >> 3) + 8 * j; const LAS float* s = scr + (8 * c) * 33 + n;
        int t0 = 0, t1 = 0;
        t0 = __builtin_amdgcn_cvt_pk_fp8_f32(s[0 * 33] * scale, s[1 * 33] * scale, t0, false); t0 = __builtin_amdgcn_cvt_pk_fp8_f32(s[2 * 33] * scale, s[3 * 33] * scale, t0, true);
        t1 = __builtin_amdgcn_cvt_pk_fp8_f32(s[4 * 33] * scale, s[5 * 33] * scale, t1, false); t1 = __builtin_amdgcn_cvt_pk_fp8_f32(s[6 * 33] * scale, s[7 * 33] * scale, t1, true);
        *(v2u*)(dst + (size_t)n * dpitch + 8 * c) = (v2u){(unsigned)t0, (unsigned)t1}; }
    LDS_WAIT(); asm volatile("" ::: "memory");
}
__device__ __forceinline__ void tr_tall_f8(const float* W, int N, int k0, int n0, unsigned char* dst, int dpitch, float scale, LAS float* scr, int lane) {
    f32x4 q[16]; const int r8 = lane >> 3, c4 = 4 * (lane & 7);
#pragma unroll
    for (int i = 0; i < 16; ++i) q[i] = *(const f32x4*)(W + (size_t)(k0 + 8 * i + r8) * N + n0 + c4);
#pragma unroll
    for (int i = 0; i < 16; ++i) { const int kk = 8 * i + r8; *(LAS f32x4*)(scr + kk * 32 + ((c4 + 4 * (kk >> 4)) & 31)) = q[i]; }
    LDS_WAIT(); asm volatile("" ::: "memory");
    const int c = lane & 7;
#pragma unroll
    for (int j = 0; j < 4; ++j) { const int n = r8 + 8 * j; const int col = (n + 4 * c) & 31; v4u o;
#pragma unroll
        for (int z = 0; z < 4; ++z) { const LAS float* sp = scr + (16 * c + 4 * z) * 32 + col; int t = 0;
            t = __builtin_amdgcn_cvt_pk_fp8_f32(sp[0] * scale, sp[32] * scale, t, false); t = __builtin_amdgcn_cvt_pk_fp8_f32(sp[64] * scale, sp[96] * scale, t, true); o[z] = (unsigned)t; }
        *(v4u*)(dst + (size_t)n * dpitch + 16 * c) = o; }
    LDS_WAIT(); asm volatile("" ::: "memory");
}
template <bool SPLIT> __device__ __forceinline__ void tr_block_f8(const float* W, int N, int k0, int n0, unsigned char* dst, int dpitch, float scale, LAS float* tile, int wave, int lane) {
    f32x4 q[16];
#pragma unroll
    for (int i = 0; i < 16; ++i) q[i] = *(const f32x4*)(W + (size_t)(k0 + 16 * wave + i) * N + n0 + 4 * lane);
#pragma unroll
    for (int i = 0; i < 16; ++i) { const int kk = 16 * wave + i; *(LAS f32x4*)(tile + kk * 256 + ((4 * lane + 4 * (kk >> 4)) & 255)) = q[i]; }
    LDS_WAIT(); __syncthreads();
    const int c = lane & 7, r8 = lane >> 3;
#pragma unroll
    for (int j = 0; j < 4; ++j) { const int n = 32 * wave + r8 + 8 * j; const int col = (n + 4 * c) & 255; v4u o;
#pragma unroll
        for (int z = 0; z < 4; ++z) { const LAS float* sp = tile + (16 * c + 4 * z) * 256 + col; int t = 0;
            t = __builtin_amdgcn_cvt_pk_fp8_f32(sp[0] * scale, sp[256] * scale, t, false); t = __builtin_amdgcn_cvt_pk_fp8_f32(sp[512] * scale, sp[768] * scale, t, true); o[z] = (unsigned)t; }
        *(v4u*)(dst + (size_t)(SPLIT ? ((n >> 7) * 256 + (n & 127)) : n) * dpitch + 16 * c) = o; }
    LDS_WAIT(); __syncthreads();
}
__device__ __forceinline__ void tr_tall_load(const float* W, int N, int k0, int n0, f32x4 (&q)[16], int lane) {
    const int r8 = lane >> 3, c4 = 4 * (lane & 7);
#pragma unroll
    for (int i = 0; i < 16; ++i) q[i] = *(const f32x4*)(W + (size_t)(k0 + 8 * i + r8) * N + n0 + c4);
}
__device__ __forceinline__ void tr_tall_store(const f32x4 (&q)[16], unsigned char* dst, int dpitch, float scale, LAS float* scr, int lane) {
    const int r8 = lane >> 3, c4 = 4 * (lane & 7);
#pragma unroll
    for (int i = 0; i < 16; ++i) { const int kk = 8 * i + r8; *(LAS f32x4*)(scr + kk * 32 + ((c4 + 4 * (kk >> 4)) & 31)) = q[i]; }
    LDS_WAIT(); asm volatile("" ::: "memory");
    const int c = lane & 7;
#pragma unroll
    for (int j = 0; j < 4; ++j) { const int n = r8 + 8 * j; const int col = (n + 4 * c) & 31; v4u o;
#pragma unroll
        for (int z = 0; z < 4; ++z) { const LAS float* sp = scr + (16 * c + 4 * z) * 32 + col; int t = 0;
            t = __builtin_amdgcn_cvt_pk_fp8_f32(sp[0] * scale, sp[32] * scale, t, false); t = __builtin_amdgcn_cvt_pk_fp8_f32(sp[64] * scale, sp[96] * scale, t, true); o[z] = (unsigned)t; }
        *(v4u*)(dst + (size_t)n * dpitch + 16 * c) = o; }
    LDS_WAIT(); asm volatile("" ::: "memory");
}
struct MoeItem { const float* src; unsigned char* dst; int N, k0, n0, dpitch; };
__device__ __forceinline__ void tr_item_hilo(const float* W, int N, int k0, int n0, bf16* dh, bf16* dl, int dpitch, LAS float* scr, int lane) {
#pragma unroll 8
    for (int i = 0; i < 32; ++i) { const int kk = 2 * i + (lane >> 5); scr[kk * 33 + (lane & 31)] = W[(size_t)(k0 + kk) * N + n0 + (lane & 31)]; }
    LDS_WAIT(); asm volatile("" ::: "memory");
    const int c = lane & 7;
#pragma unroll
    for (int j = 0; j < 4; ++j) { const int n = (lane >> 3) + 8 * j; const LAS float* s = scr + (8 * c) * 33 + n; float w[8];
#pragma unroll
        for (int z = 0; z < 8; ++z) w[z] = s[z * 33];
        v4u o; o.x = cvt_pk_bf16(w[0], w[1]); o.y = cvt_pk_bf16(w[2], w[3]); o.z = cvt_pk_bf16(w[4], w[5]); o.w = cvt_pk_bf16(w[6], w[7]);
        v4u l; l.x = cvt_pk_bf16(w[0] - bf_lo(o.x), w[1] - bf_hi(o.x)); l.y = cvt_pk_bf16(w[2] - bf_lo(o.y), w[3] - bf_hi(o.y)); l.z = cvt_pk_bf16(w[4] - bf_lo(o.z), w[5] - bf_hi(o.z)); l.w = cvt_pk_bf16(w[6] - bf_lo(o.w), w[7] - bf_hi(o.w));
        *(v4u*)(dh + (size_t)n * dpitch + 8 * c) = o; *(v4u*)(dl + (size_t)n * dpitch + 8 * c) = l; }
    LDS_WAIT(); asm volatile("" ::: "memory");
}
constexpr int MOE_ITEMS = 65 * 192;
__device__ __forceinline__ void convert_moe_item(const Args& a, int layer, int it, LAS float* scr, int lane) {
    unsigned char* WGU = a.ws + WS_WGU + (size_t)layer * WS_MOE_LSTRIDE; unsigned char* WDN = a.ws + WS_WDN + (size_t)layer * WS_MOE_LSTRIDE;
    const int e = it / 192, r = it % 192;
    if (r < 128) { const int isup = r >> 6, rr = r & 63, kb = rr >> 3, nb = rr & 7, n0 = 32 * nb, k0 = 128 * kb;
        const float* src = (e < 64) ? a.in[isup ? I_WU : I_WG] + ((size_t)layer * 64 + e) * 262144 : a.in[isup ? I_SHU : I_SHG] + (size_t)layer * 262144;
        const int drow = e * 512 + (n0 >> 7) * 256 + isup * 128 + (n0 & 127);
        tr_tall_f8(src, 256, k0, n0, WGU + (size_t)drow * 1024 + k0, 1024, 32.0f, scr, lane);
    } else { const int rr = r - 128, kb = rr >> 5, nb = rr & 31, n0 = 32 * nb, k0 = 128 * kb;
        const float* src = (e < 64) ? a.in[I_WD] + ((size_t)layer * 64 + e) * 262144 : a.in[I_SHD] + (size_t)layer * 262144;
        tr_tall_f8(src, 1024, k0, n0, WDN + ((size_t)e * 1024 + n0) * 256 + k0, 256, 32.0f, scr, lane);
    }
}
__device__ __forceinline__ MoeItem moe_item_desc(const Args& a, int layer, int it) {
    unsigned char* WGU = a.ws + WS_WGU + (size_t)layer * WS_MOE_LSTRIDE; unsigned char* WDN = a.ws + WS_WDN + (size_t)layer * WS_MOE_LSTRIDE;
    const int e = it / 192, r = it % 192; MoeItem d;
    if (r < 128) { const int isup = r >> 6, rr = r & 63, kb = rr >> 3, nb = rr & 7; d.n0 = 32 * nb; d.k0 = 128 * kb; d.N = 256; d.dpitch = 1024;
        d.src = (e < 64) ? a.in[isup ? I_WU : I_WG] + ((size_t)layer * 64 + e) * 262144 : a.in[isup ? I_SHU : I_SHG] + (size_t)layer * 262144;
        d.dst = WGU + (size_t)(e * 512 + (d.n0 >> 7) * 256 + isup * 128 + (d.n0 & 127)) * 1024 + d.k0;
    } else { const int rr = r - 128, kb = rr >> 5, nb = rr & 31; d.n0 = 32 * nb; d.k0 = 128 * kb; d.N = 1024; d.dpitch = 256;
        d.src = (e < 64) ? a.in[I_WD] + ((size_t)layer * 64 + e) * 262144 : a.in[I_SHD] + (size_t)layer * 262144;
        d.dst = WDN + ((size_t)e * 1024 + d.n0) * 256 + d.k0; }
    return d;
}
constexpr int Q_SHARDS = 8, Q_PER_SHARD = MOE_ITEMS / Q_SHARDS;
static_assert(Q_PER_SHARD * Q_SHARDS == MOE_ITEMS, "queue shards");
template <int CHUNK> __device__ __forceinline__ bool convert_steal_n(const Args& a, int layer, LAS unsigned char* lds, int wave, int lane) {
    unsigned* q = (unsigned*)(a.ws + WS_CTL) + CW_QNEXT + 512 * layer;
    const int s0 = (int)(blockIdx.x & 7);
    for (int s = 0; s < Q_SHARDS; ++s) { const int sh = (s0 + s) & 7;
        unsigned it = 0; if (lane == 0) it = __hip_atomic_fetch_add(q + 64 * sh, (unsigned)CHUNK, RLX_AGENT);
        it = (unsigned)__builtin_amdgcn_readfirstlane((int)it);
        if (it < (unsigned)Q_PER_SHARD) {
            for (int c = 0; c < CHUNK; ++c) if (it + c < (unsigned)Q_PER_SHARD) convert_moe_item(a, layer, sh * Q_PER_SHARD + (int)it + c, (LAS float*)(lds + wave * 16384), lane);
            return true; } }
    return false;
}
__device__ __forceinline__ bool convert_steal(const Args& a, int layer, LAS unsigned char* lds, int wave, int lane) { return convert_steal_n<1>(a, layer, lds, wave, lane); }
constexpr int MOE_WG_ITEMS = 65 * 24;
__device__ __forceinline__ void convert_static(const Args& a, int layer, LAS unsigned char* lds, int vcu, int G) {
    const int lane = threadIdx.x & 63, wave = __builtin_amdgcn_readfirstlane(threadIdx.x >> 6);
    unsigned char* WGU = a.ws + WS_WGU + (size_t)layer * WS_MOE_LSTRIDE; unsigned char* WDN = a.ws + WS_WDN + (size_t)layer * WS_MOE_LSTRIDE;
    __syncthreads();
#pragma unroll 1
    for (int it = vcu; it < MOE_WG_ITEMS; it += G) { const int e = it / 24, r = it % 24;
        if (r < 16) { const int isup = r >> 3, k0 = 128 * (r & 7);
            const float* src = (e < 64) ? a.in[isup ? I_WU : I_WG] + ((size_t)layer * 64 + e) * 262144 : a.in[isup ? I_SHU : I_SHG] + (size_t)layer * 262144;
            tr_block_f8<true>(src, 256, k0, 0, WGU + ((size_t)e * 512 + isup * 128) * 1024 + k0, 1024, 32.0f, (LAS float*)lds, wave, lane);
        } else { const int rr = r - 16, k0 = 128 * (rr >> 2), n0 = 256 * (rr & 3);
            const float* src = (e < 64) ? a.in[I_WD] + ((size_t)layer * 64 + e) * 262144 : a.in[I_SHD] + (size_t)layer * 262144;
            tr_block_f8<false>(src, 1024, k0, n0, WDN + ((size_t)e * 1024 + n0) * 256 + k0, 256, 32.0f, (LAS float*)lds, wave, lane);
        } }
}
__device__ __forceinline__ void convert_drain(const Args& a, int layer, LAS unsigned char* lds) {
    const int lane = threadIdx.x & 63, wave = __builtin_amdgcn_readfirstlane(threadIdx.x >> 6);
    while (convert_steal_n<4>(a, layer, lds, wave, lane)) {}
    __syncthreads();
}
__device__ __forceinline__ void phase_p0(const Args& a, LAS unsigned char* lds, int vcu, int G) {
    const int tid = threadIdx.x, lane = tid & 63, wave = __builtin_amdgcn_readfirstlane(tid >> 6);
    const int gw = vcu * NWAVES + wave, NGW = G * NWAVES;
    LAS float* scr = (LAS float*)(lds + wave * 16384);
    constexpr int I_IN = 16 * 32, I_GRP = 4 * 4 * 8, I_OUT = 16 * 32, I_SIN = 16 * 128, I_SOUT = 32 * 32, NIT = I_IN + I_GRP + I_OUT + I_SIN + I_SOUT;
    for (int it = gw; it < NIT; it += NGW) {
        int r = it;
        if (r < I_IN) { const int kb = r >> 5, nb = r & 31; tr_item(a.in[I_PWIN], 1024, 64 * kb, 32 * nb, (bf16*)(a.ws + WS_WIN) + (size_t)(32 * nb) * 1024 + 64 * kb, 1024, scr, lane); continue; } r -= I_IN;
        if (r < I_GRP) { const int g = r >> 5, rr = r & 31, kb = rr >> 3, nb = rr & 7; tr_item(a.in[I_PWGRP] + (size_t)g * 65536, 256, 64 * kb, 32 * nb, (bf16*)(a.ws + WS_WGRP) + (size_t)(g * 256 + 32 * nb) * 256 + 64 * kb, 256, scr, lane); continue; } r -= I_GRP;
        if (r < I_OUT) { const int kb = r >> 5, nb = r & 31; tr_item(a.in[I_PWOUT], 1024, 64 * kb, 32 * nb, (bf16*)(a.ws + WS_WOUT) + (size_t)(32 * nb) * 1024 + 64 * kb, 1024, scr, lane); continue; } r -= I_OUT;
        if (r < I_SIN) { const int kb = r >> 7, nb = r & 127; tr_item_f8(a.in[I_SWIN], 4096, 64 * kb, 32 * nb, a.ws + WS_WSIN + (size_t)(32 * nb) * 1024 + 64 * kb, 1024, 32.0f, scr, lane); continue; } r -= I_SIN;
        { const int kb = r >> 5, nb = r & 31; tr_item(a.in[I_SWOUT], 1024, 64 * kb, 32 * nb, (bf16*)(a.ws + WS_WSOUT) + (size_t)(32 * nb) * 2048 + 64 * kb, 2048, scr, lane); }
    }
    for (int it = gw; it < 64; it += NGW) { const int layer = it >> 5, rr = it & 31, kb = rr >> 1, nb = rr & 1; bf16* base = (bf16*)(a.ws + WS_WRT) + (size_t)layer * 2 * 65536 + (size_t)(32 * nb) * 1024 + 64 * kb;
        tr_item_hilo(a.in[I_WR] + (size_t)layer * DM * NE, 64, 64 * kb, 32 * nb, base, base + 65536, 1024, scr, lane); }
    const float* x = a.in[I_X]; bf16* xb = (bf16*)(a.ws + WS_XB);
    const size_t gt = (size_t)vcu * NTHR + tid, NT = (size_t)G * NTHR;
#pragma unroll 1
    for (size_t i0 = gt; i0 < (size_t)T_TOK * DM / 8; i0 += 8 * NT) { f32x4 p[8], q[8];
#pragma unroll
        for (int u = 0; u < 8; ++u) { const size_t i = i0 + (size_t)u * NT; p[u] = *(const f32x4*)(x + i * 8); q[u] = *(const f32x4*)(x + i * 8 + 4); }
#pragma unroll
        for (int u = 0; u < 8; ++u) { const size_t i = i0 + (size_t)u * NT; v4u w; w.x = cvt_pk_bf16(p[u][0], p[u][1]); w.y = cvt_pk_bf16(p[u][2], p[u][3]); w.z = cvt_pk_bf16(q[u][0], q[u][1]); w.w = cvt_pk_bf16(q[u][2], q[u][3]); *(v4u*)(xb + i * 8) = w; } }
    unsigned* ident = (unsigned*)(a.ws + WS_IDENT);
    for (size_t i = gt; i < (size_t)T_TOK; i += NT) ident[i] = (unsigned)i;
}

template <int W> __device__ __forceinline__ void pool_item(const bf16* zp  , bf16* op  , int p0  ) {
    v4u q[W + 3];
#pragma unroll
    for (int i = 0; i < W + 3; ++i) { const int ii = i < p0 + 3 ? i : p0 + 3; q[i] = *(const v4u*)(zp - (size_t)ii * DM); }
#pragma unroll
    for (int o = 0; o < 4; ++o) {
        float s[8];
#pragma unroll
        for (int j = 0; j < 8; ++j) s[j] = 0.f;
#pragma unroll
        for (int i = 3 - o; i < 3 - o + W; ++i) { const float m = (i <= p0 + 3) ? 1.0f : 0.0f;
#pragma unroll
            for (int j = 0; j < 4; ++j) { s[2 * j] += m * bf_lo(q[i][j]); s[2 * j + 1] += m * bf_hi(q[i][j]); } }
        const int p = p0 + o, nw = (p + 1) < W ? (p + 1) : W; const float inv = 1.0f / (float)nw; v4u ov;
#pragma unroll
        for (int j = 0; j < 4; ++j) ov[j] = cvt_pk_bf16(s[2 * j] * inv - bf_lo(q[3 - o][j]), s[2 * j + 1] * inv - bf_hi(q[3 - o][j]));
        *(v4u*)(op + (size_t)o * DM) = ov; }
}
__device__ __forceinline__ void pool_block(const Args& a, int pm, int g) {
    const bf16* Z = (const bf16*)(a.ws + WS_Z); bf16* P = (bf16*)(a.ws + WS_POOLED);
    const int tid = threadIdx.x;
#pragma unroll 1
    for (int q = tid; q < 64 * 32; q += NTHR) { const int c8 = q & 31, tg = q >> 5, t0 = pm * 256 + tg * 4, p0 = t0 & (SEQ - 1);
        const bf16* zp = Z + (size_t)(t0 + 3) * DM + g * 256 + c8 * 8; bf16* op = P + (size_t)t0 * DM + g * 256 + c8 * 8;
        if (g == 0) pool_item<2>(zp, op, p0); else if (g == 1) pool_item<4>(zp, op, p0); else if (g == 2) pool_item<8>(zp, op, p0); else pool_item<16>(zp, op, p0); }
    VM_WAIT(); __syncthreads();
}
__device__ __forceinline__ void phase_pool(const Args& a, int vcu, int G) {
    const bf16* Z = (const bf16*)(a.ws + WS_Z); bf16* P = (bf16*)(a.ws + WS_POOLED);
    const int tid = threadIdx.x, wave = tid >> 6, lane = tid & 63;
    const int gw = vcu * NWAVES + wave, NGW = G * NWAVES;
    for (int it = gw; it < (T_TOK / 4) * 2; it += NGW) {
        const int t0 = (it >> 1) * 4, c8 = (it & 1) * 64 + lane, g = c8 >> 5, p0 = t0 & (SEQ - 1);
        const bf16* zp = Z + (size_t)(t0 + 3) * DM + c8 * 8; bf16* op = P + (size_t)t0 * DM + c8 * 8;
        if (g == 0) pool_item<2>(zp, op, p0); else if (g == 1) pool_item<4>(zp, op, p0); else if (g == 2) pool_item<8>(zp, op, p0); else pool_item<16>(zp, op, p0);
    }
}

template <int R, int MODE> __device__ __forceinline__ void ln_rows_store(float (&v)[R][16], const float* g, const float* b, float* const (&of)[R], bf16* const (&obf)[R], unsigned char* const (&o8)[R], int lane) {
    float s[R], s2[R];
#pragma unroll
    for (int r = 0; r < R; ++r) { s[r] = 0.f;
#pragma unroll
        for (int i = 0; i < 16; ++i) s[r] += v[r][i]; }
#pragma unroll
    for (int o = 1; o < 64; o <<= 1)
#pragma unroll
        for (int r = 0; r < R; ++r) s[r] += __shfl_xor(s[r], o);
#pragma unroll
    for (int r = 0; r < R; ++r) { const float mean = s[r] * (1.0f / DM); s2[r] = 0.f;
#pragma unroll
        for (int i = 0; i < 16; ++i) { v[r][i] -= mean; s2[r] += v[r][i] * v[r][i]; } }
#pragma unroll
    for (int o = 1; o < 64; o <<= 1)
#pragma unroll
        for (int r = 0; r < R; ++r) s2[r] += __shfl_xor(s2[r], o);
#pragma unroll
    for (int j = 0; j < 2; ++j) { const int c = 8 * lane + 512 * j;
        const f32x4 g0 = *(const f32x4*)(g + c), g1 = *(const f32x4*)(g + c + 4), b0 = *(const f32x4*)(b + c), b1 = *(const f32x4*)(b + c + 4);
#pragma unroll
        for (int r = 0; r < R; ++r) { const float rstd = 1.0f / sqrtf(s2[r] * (1.0f / DM) + LN_EPS); f32x4 y0, y1;
#pragma unroll
            for (int q = 0; q < 4; ++q) { y0[q] = v[r][8 * j + q] * rstd * g0[q] + b0[q]; y1[q] = v[r][8 * j + 4 + q] * rstd * g1[q] + b1[q]; }
            if constexpr (MODE & 1) { *(f32x4*)(of[r] + c) = y0; *(f32x4*)(of[r] + c + 4) = y1; }
            if constexpr (MODE & 2) { v4u w; w.x = cvt_pk_bf16(y0[0], y0[1]); w.y = cvt_pk_bf16(y0[2], y0[3]); w.z = cvt_pk_bf16(y1[0], y1[1]); w.w = cvt_pk_bf16(y1[2], y1[3]); *(v4u*)(obf[r] + c) = w; }
            if constexpr (MODE & 4) { int t0 = 0, t1 = 0; t0 = __builtin_amdgcn_cvt_pk_fp8_f32(y0[0], y0[1], t0, false); t0 = __builtin_amdgcn_cvt_pk_fp8_f32(y0[2], y0[3], t0, true); t1 = __builtin_amdgcn_cvt_pk_fp8_f32(y1[0], y1[1], t1, false); t1 = __builtin_amdgcn_cvt_pk_fp8_f32(y1[2], y1[3], t1, true);
                *(v2u*)(o8[r] + c) = (v2u){(unsigned)t0, (unsigned)t1}; } } }
}

__device__ __forceinline__ void phase_lnr(const Args& a, int layer, LAS unsigned char* lds, int vcu, int G, bool dry) {
    const int tid = threadIdx.x, lane = tid & 63, wave = __builtin_amdgcn_readfirstlane(tid >> 6);
    const bf16* xin = (const bf16*)(a.ws + WS_XR); float* xf = dry ? (float*)(a.ws + WS_Y) : a.out; bf16* xb = dry ? (bf16*)(a.ws + WS_Y + 72 * MiB) : (bf16*)(a.ws + WS_XB);
    const float* lng = a.in[I_LNMG] + layer * DM; const float* lnb = a.in[I_LNMB] + layer * DM;
    const float* Wr = a.in[I_WR] + (size_t)layer * DM * NE; const float* rbias = a.in[I_RB] + layer * NE;
    unsigned* gcount = (unsigned*)(a.ws + WS_CTL) + CW_CNT + layer * 64 + (dry ? 128 : 0);
    unsigned* rowtok = dry ? (unsigned*)(a.ws + WS_Y + 64 * MiB) : (unsigned*)(a.ws + WS_ROWTOK); unsigned* dest = dry ? (unsigned*)(a.ws + WS_Y + 68 * MiB) : (unsigned*)(a.ws + WS_DEST); float* gatev = dry ? (float*)(a.ws + WS_Y + 69 * MiB) : (float*)(a.ws + WS_GATE);
    LAS float* part = (LAS float*)lds;
    LAS unsigned* hist = (LAS unsigned*)(lds + 65536);
    LAS unsigned* basep = (LAS unsigned*)(lds + 65536 + 256);
    { const int blk = vcu;
        const int row0 = blk * 64;
        if (tid < 64) hist[tid] = 0u;
        { float v[8][16]; float* of[8]; bf16* obf[8]; unsigned char* o8[8];
#pragma unroll
            for (int r = 0; r < 8; ++r) { const int rr = wave * 8 + r; const bf16* xr = xin + (size_t)(row0 + rr) * DM; of[r] = xf + (size_t)(row0 + rr) * DM; obf[r] = nullptr; o8[r] = (unsigned char*)xb + (size_t)(row0 + rr) * DM;
#pragma unroll
                for (int j = 0; j < 2; ++j) { const v4u p = *(const v4u*)(xr + 8 * lane + 512 * j);
#pragma unroll
                    for (int i = 0; i < 4; ++i) { v[r][8 * j + 2 * i] = bf_lo(p[i]); v[r][8 * j + 2 * i + 1] = bf_hi(p[i]); } } }
            ln_rows_store<8, 5>(v, lng, lnb, of, obf, o8, lane); }
        VM_WAIT(); __syncthreads();
#ifndef DRY_PARTS
#define DRY_PARTS 7
#endif
        if (!dry || (DRY_PARTS & 2)) { const int kq = wave & 3, mh = wave >> 2, r = lane & 15, g = lane >> 4;
          f32x4 acc[2][4];
#pragma unroll
          for (int m = 0; m < 2; ++m)
#pragma unroll
              for (int n = 0; n < 4; ++n) acc[m][n] = (f32x4){0.f, 0.f, 0.f, 0.f};
          const float* arow = xf + (size_t)(row0 + 32 * mh + r) * DM + kq * 256 + 8 * g;
          const bf16* bh = (const bf16*)(a.ws + WS_WRT) + (size_t)layer * 2 * 65536 + (size_t)r * 1024 + kq * 256 + 8 * g; const bf16* bl = bh + 65536;
          f32x4 a0[2], a1[2]; bf16x8 wh[4], wl[4];
#pragma unroll
          for (int m = 0; m < 2; ++m) { a0[m] = *(const f32x4*)(arow + (size_t)m * 16 * DM); a1[m] = *(const f32x4*)(arow + (size_t)m * 16 * DM + 4); }
#pragma unroll
          for (int n = 0; n < 4; ++n) { wh[n] = *(const bf16x8*)(bh + (size_t)n * 16384); wl[n] = *(const bf16x8*)(bl + (size_t)n * 16384); }
#pragma unroll 1
          for (int s = 0; s < 8; ++s) { const int sn = s < 7 ? s + 1 : s;
              f32x4 n0[2], n1[2]; bf16x8 nh[4], nl[4];
#pragma unroll
              for (int m = 0; m < 2; ++m) { n0[m] = *(const f32x4*)(arow + (size_t)m * 16 * DM + 32 * sn); n1[m] = *(const f32x4*)(arow + (size_t)m * 16 * DM + 32 * sn + 4); }
#pragma unroll
              for (int n = 0; n < 4; ++n) { nh[n] = *(const bf16x8*)(bh + (size_t)n * 16384 + 32 * sn); nl[n] = *(const bf16x8*)(bl + (size_t)n * 16384 + 32 * sn); }
#pragma unroll
              for (int m = 0; m < 2; ++m) {
                  v4u hi, lo; hi.x = cvt_pk_bf16(a0[m][0], a0[m][1]); hi.y = cvt_pk_bf16(a0[m][2], a0[m][3]); hi.z = cvt_pk_bf16(a1[m][0], a1[m][1]); hi.w = cvt_pk_bf16(a1[m][2], a1[m][3]);
                  lo.x = cvt_pk_bf16(a0[m][0] - bf_lo(hi.x), a0[m][1] - bf_hi(hi.x)); lo.y = cvt_pk_bf16(a0[m][2] - bf_lo(hi.y), a0[m][3] - bf_hi(hi.y));
                  lo.z = cvt_pk_bf16(a1[m][0] - bf_lo(hi.z), a1[m][1] - bf_hi(hi.z)); lo.w = cvt_pk_bf16(a1[m][2] - bf_lo(hi.w), a1[m][3] - bf_hi(hi.w));
                  const bf16x8 ah = __builtin_bit_cast(bf16x8, hi), al = __builtin_bit_cast(bf16x8, lo);
#pragma unroll
                  for (int n = 0; n < 4; ++n) { acc[m][n] = __builtin_amdgcn_mfma_f32_16x16x32_bf16(ah, wh[n], acc[m][n], 0, 0, 0); acc[m][n] = __builtin_amdgcn_mfma_f32_16x16x32_bf16(al, wh[n], acc[m][n], 0, 0, 0); acc[m][n] = __builtin_amdgcn_mfma_f32_16x16x32_bf16(ah, wl[n], acc[m][n], 0, 0, 0); } }
#pragma unroll
              for (int m = 0; m < 2; ++m) { a0[m] = n0[m]; a1[m] = n1[m]; }
#pragma unroll
              for (int n = 0; n < 4; ++n) { wh[n] = nh[n]; wl[n] = nl[n]; } }
#pragma unroll
          for (int m = 0; m < 2; ++m)
#pragma unroll
              for (int n = 0; n < 4; ++n)
#pragma unroll
                  for (int q = 0; q < 4; ++q) part[(kq * 64 + 32 * mh + 16 * m + 4 * g + q) * 64 + 16 * n + r] = acc[m][n][q]; }
        __syncthreads();
        if (!dry || (DRY_PARTS & 4)) { const int row = tid >> 3, grp = tid & 7; float sc[8], bsd[8];
#pragma unroll
          for (int i = 0; i < 8; ++i) { const int e = 8 * grp + i; const float lg = (part[row * 64 + e] + part[(64 + row) * 64 + e]) + (part[(128 + row) * 64 + e] + part[(192 + row) * 64 + e]); sc[i] = 1.0f / (1.0f + __expf(-lg)); bsd[i] = sc[i] + rbias[e]; }
          float m1 = -INFINITY, m2 = -INFINITY;
#pragma unroll
          for (int i = 0; i < 8; ++i) { const float v = bsd[i]; if (v > m1) { m2 = m1; m1 = v; } else if (v > m2) m2 = v; }
          const float myg = m1 + m2;
          int grank = 0;
#pragma unroll
          for (int d = 1; d < 8; ++d) { const float o = __shfl(myg, (lane & ~7) | ((grp + d) & 7)); const int g2 = (grp + d) & 7; grank += (o > myg || (o == myg && g2 < grp)) ? 1 : 0; }
          const bool gsel = grank < 4;
          float cand[8]; int rk[8]; bool sel[8];
#pragma unroll
          for (int i = 0; i < 8; ++i) { cand[i] = gsel ? bsd[i] : -INFINITY; rk[i] = 0; sel[i] = false; }
#pragma unroll 1
          for (int k = 0; k < TOPK; ++k) {
              float best = cand[0]; int bi = 0;
#pragma unroll
              for (int i = 1; i < 8; ++i) if (cand[i] > best) { best = cand[i]; bi = i; }
              int gi = 8 * grp + bi;
#define LNR_RED(CTRL) { const float ov = __builtin_bit_cast(float, __builtin_amdgcn_update_dpp(0, __builtin_bit_cast(int, best), CTRL, 0xF, 0xF, false)); const int oi = __builtin_amdgcn_update_dpp(0, gi, CTRL, 0xF, 0xF, false); if (ov > best || (ov == best && oi < gi)) { best = ov; gi = oi; } }
              LNR_RED(0xB1) LNR_RED(0x4E) LNR_RED(0x141)
#undef LNR_RED
#pragma unroll
              for (int i = 0; i < 8; ++i) if (gi == 8 * grp + i) { cand[i] = -INFINITY; rk[i] = k; sel[i] = true; }
          }
          float psum = 0.f;
#pragma unroll
          for (int i = 0; i < 8; ++i) psum += sel[i] ? sc[i] : 0.f;
          psum += __shfl_xor(psum, 1); psum += __shfl_xor(psum, 2); psum += __shfl_xor(psum, 4);
          const float inv = ROUTED_SCALE / psum;
          unsigned loc[8];
#pragma unroll
          for (int i = 0; i < 8; ++i) { loc[i] = 0u; if (sel[i]) loc[i] = __hip_atomic_fetch_add(hist + 8 * grp + i, 1u, __ATOMIC_RELAXED, __HIP_MEMORY_SCOPE_WORKGROUP); }
          __syncthreads();
          if (tid < 64) { const unsigned h = hist[tid]; basep[tid] = h ? __hip_atomic_fetch_add(gcount + tid, h, RLX_AGENT) : 0u; }
          __syncthreads();
          const int tok = row0 + row;
#pragma unroll
          for (int i = 0; i < 8; ++i) if (sel[i]) { const int e = 8 * grp + i; const unsigned pos = basep[e] + loc[i];
              rowtok[(size_t)e * CAP + pos] = (unsigned)tok; dest[tok * 8 + rk[i]] = ((unsigned)e << 16) | pos; gatev[tok * 8 + rk[i]] = sc[i] * inv; }
        }
        __syncthreads();
    }
}

#define LCV_BAR() do { asm volatile("s_waitcnt vmcnt(0) lgkmcnt(0)" ::: "memory"); ++lcv_ep; \
        if (lane == 0) __hip_atomic_fetch_add(lcv_cnt, 1u, __ATOMIC_RELAXED, __HIP_MEMORY_SCOPE_WORKGROUP); \
        while (__hip_atomic_load(lcv_cnt, __ATOMIC_RELAXED, __HIP_MEMORY_SCOPE_WORKGROUP) < 4u * lcv_ep) __builtin_amdgcn_s_sleep(1); \
        asm volatile("" ::: "memory"); } while (0)
__device__ __forceinline__ void phase_lnr_cv(const Args& a, int layer, LAS unsigned char* lds, int blk, int vcu, int G) {
    const int tid = threadIdx.x, lane = tid & 63, wave = __builtin_amdgcn_readfirstlane(tid >> 6);
    LAS unsigned* lcv_cnt = (LAS unsigned*)(lds + 33280); unsigned lcv_ep = 0u;
    LAS unsigned* lcv_q = (LAS unsigned*)(lds + 33284);
    if (tid == 0) { *lcv_cnt = 0u; *lcv_q = 0u; }
    __syncthreads();
#define LCV_PULL(scr_) do { for (;;) { unsigned j = 0; if (lane == 0) j = __hip_atomic_fetch_add(lcv_q, 1u, __ATOMIC_RELAXED, __HIP_MEMORY_SCOPE_WORKGROUP); j = (unsigned)__builtin_amdgcn_readfirstlane((int)j); \
        const int it = vcu * 4 + (int)(j & 3u) + 4 * G * (int)(j >> 2); if (it >= MOE_ITEMS) break; convert_moe_item(a, layer, it, (scr_), lane); } } while (0)
    if (wave >= 4) {
        LAS float* scr = (LAS float*)(lds + 34816 + (wave - 4) * 16384);
#define LCV_NEXT(itv) do { unsigned j = 0; if (lane == 0) j = __hip_atomic_fetch_add(lcv_q, 1u, __ATOMIC_RELAXED, __HIP_MEMORY_SCOPE_WORKGROUP); j = (unsigned)__builtin_amdgcn_readfirstlane((int)j); itv = vcu * 4 + (int)(j & 3u) + 4 * G * (int)(j >> 2); } while (0)
        int itA; LCV_NEXT(itA);
        if (itA < MOE_ITEMS) { MoeItem dA = moe_item_desc(a, layer, itA); f32x4 qA[16], qB[16]; tr_tall_load(dA.src, dA.N, dA.k0, dA.n0, qA, lane);
            for (;;) { int itB; LCV_NEXT(itB); const bool hb = itB < MOE_ITEMS; MoeItem dB = dA;
                if (hb) { dB = moe_item_desc(a, layer, itB); tr_tall_load(dB.src, dB.N, dB.k0, dB.n0, qB, lane); }
                tr_tall_store(qA, dA.dst, dA.dpitch, 32.0f, scr, lane);
                if (!hb) break;
                dA = dB;
#pragma unroll
                for (int i = 0; i < 16; ++i) qA[i] = qB[i]; } }
#undef LCV_NEXT
        return;
    }
    const bf16* xin = (const bf16*)(a.ws + WS_XR); float* xf = a.out; unsigned char* xb8 = a.ws + WS_XB;
    const float* lng = a.in[I_LNMG] + layer * DM; const float* lnb = a.in[I_LNMB] + layer * DM; const float* rbias = a.in[I_RB] + layer * NE;
    unsigned* gcount = (unsigned*)(a.ws + WS_CTL) + CW_CNT + layer * 64;
    unsigned* rowtok = (unsigned*)(a.ws + WS_ROWTOK); unsigned* dest = (unsigned*)(a.ws + WS_DEST); float* gatev = (float*)(a.ws + WS_GATE);
    LAS float* part = (LAS float*)lds;
    LAS unsigned* hist = (LAS unsigned*)(lds + 32768); LAS unsigned* basep = (LAS unsigned*)(lds + 33024);
    const int row0 = blk * 64;
    if (tid < 64) hist[tid] = 0u;
#pragma unroll 1
    for (int h8 = 0; h8 < 2; ++h8) { float v[8][16]; float* of[8]; bf16* obf[8]; unsigned char* o8[8];
#pragma unroll
        for (int r = 0; r < 8; ++r) { const int rr = wave * 16 + h8 * 8 + r; const bf16* xr = xin + (size_t)(row0 + rr) * DM; of[r] = xf + (size_t)(row0 + rr) * DM; obf[r] = nullptr; o8[r] = xb8 + (size_t)(row0 + rr) * DM;
#pragma unroll
            for (int j = 0; j < 2; ++j) { const v4u p = *(const v4u*)(xr + 8 * lane + 512 * j);
#pragma unroll
                for (int i = 0; i < 4; ++i) { v[r][8 * j + 2 * i] = bf_lo(p[i]); v[r][8 * j + 2 * i + 1] = bf_hi(p[i]); } } }
        ln_rows_store<8, 5>(v, lng, lnb, of, obf, o8, lane); }
    LCV_BAR();
    { const int mh = wave & 1, kh = wave >> 1, r = lane & 15, g = lane >> 4;
      f32x4 acc[2][4];
#pragma unroll
      for (int m = 0; m < 2; ++m)
#pragma unroll
          for (int n = 0; n < 4; ++n) acc[m][n] = (f32x4){0.f, 0.f, 0.f, 0.f};
      const float* arow = xf + (size_t)(row0 + 32 * mh + r) * DM + kh * 512 + 8 * g;
      const bf16* bh = (const bf16*)(a.ws + WS_WRT) + (size_t)layer * 2 * 65536 + (size_t)r * 1024 + kh * 512 + 8 * g; const bf16* bl = bh + 65536;
      f32x4 a0[2], a1[2]; bf16x8 wh[4], wl[4];
#pragma unroll
      for (int m = 0; m < 2; ++m) { a0[m] = *(const f32x4*)(arow + (size_t)m * 16 * DM); a1[m] = *(const f32x4*)(arow + (size_t)m * 16 * DM + 4); }
#pragma unroll
      for (int n = 0; n < 4; ++n) { wh[n] = *(const bf16x8*)(bh + (size_t)n * 16384); wl[n] = *(const bf16x8*)(bl + (size_t)n * 16384); }
#pragma unroll 1
      for (int s = 0; s < 16; ++s) { const int sn = s < 15 ? s + 1 : s;
          f32x4 n0[2], n1[2]; bf16x8 nh[4], nl[4];
#pragma unroll
          for (int m = 0; m < 2; ++m) { n0[m] = *(const f32x4*)(arow + (size_t)m * 16 * DM + 32 * sn); n1[m] = *(const f32x4*)(arow + (size_t)m * 16 * DM + 32 * sn + 4); }
#pragma unroll
          for (int n = 0; n < 4; ++n) { nh[n] = *(const bf16x8*)(bh + (size_t)n * 16384 + 32 * sn); nl[n] = *(const bf16x8*)(bl + (size_t)n * 16384 + 32 * sn); }
#pragma unroll
          for (int m = 0; m < 2; ++m) {
              v4u hi, lo; hi.x = cvt_pk_bf16(a0[m][0], a0[m][1]); hi.y = cvt_pk_bf16(a0[m][2], a0[m][3]); hi.z = cvt_pk_bf16(a1[m][0], a1[m][1]); hi.w = cvt_pk_bf16(a1[m][2], a1[m][3]);
              lo.x = cvt_pk_bf16(a0[m][0] - bf_lo(hi.x), a0[m][1] - bf_hi(hi.x)); lo.y = cvt_pk_bf16(a0[m][2] - bf_lo(hi.y), a0[m][3] - bf_hi(hi.y));
              lo.z = cvt_pk_bf16(a1[m][0] - bf_lo(hi.z), a1[m][1] - bf_hi(hi.z)); lo.w = cvt_pk_bf16(a1[m][2] - bf_lo(hi.w), a1[m][3] - bf_hi(hi.w));
              const bf16x8 ah = __builtin_bit_cast(bf16x8, hi), al = __builtin_bit_cast(bf16x8, lo);
#pragma unroll
              for (int n = 0; n < 4; ++n) { acc[m][n] = __builtin_amdgcn_mfma_f32_16x16x32_bf16(ah, wh[n], acc[m][n], 0, 0, 0); acc[m][n] = __builtin_amdgcn_mfma_f32_16x16x32_bf16(al, wh[n], acc[m][n], 0, 0, 0); acc[m][n] = __builtin_amdgcn_mfma_f32_16x16x32_bf16(ah, wl[n], acc[m][n], 0, 0, 0); } }
#pragma unroll
          for (int m = 0; m < 2; ++m) { a0[m] = n0[m]; a1[m] = n1[m]; }
#pragma unroll
          for (int n = 0; n < 4; ++n) { wh[n] = nh[n]; wl[n] = nl[n]; } }
#pragma unroll
      for (int m = 0; m < 2; ++m)
#pragma unroll
          for (int n = 0; n < 4; ++n)
#pragma unroll
              for (int q = 0; q < 4; ++q) part[(kh * 64 + 32 * mh + 16 * m + 4 * g + q) * 64 + 16 * n + r] = acc[m][n][q]; }
    LCV_BAR();
    const int grp = tid & 7; int rkk[2][8]; unsigned loc[2][8]; float gte[2][8]; unsigned selm[2];
#pragma unroll
    for (int ps = 0; ps < 2; ++ps) { const int row = 32 * ps + (tid >> 3); float sc[8], bsd[8];
#pragma unroll
        for (int i = 0; i < 8; ++i) { const int e = 8 * grp + i; const float lg = part[row * 64 + e] + part[(64 + row) * 64 + e]; sc[i] = 1.0f / (1.0f + __expf(-lg)); bsd[i] = sc[i] + rbias[e]; }
        float m1 = -INFINITY, m2 = -INFINITY;
#pragma unroll
        for (int i = 0; i < 8; ++i) { const float v = bsd[i]; if (v > m1) { m2 = m1; m1 = v; } else if (v > m2) m2 = v; }
        const float myg = m1 + m2; int grank = 0;
#pragma unroll
        for (int d = 1; d < 8; ++d) { const float o = __shfl(myg, (lane & ~7) | ((grp + d) & 7)); const int g2 = (grp + d) & 7; grank += (o > myg || (o == myg && g2 < grp)) ? 1 : 0; }
        const bool gsel = grank < 4;
        float cand[8]; unsigned sm = 0u;
#pragma unroll
        for (int i = 0; i < 8; ++i) { cand[i] = gsel ? bsd[i] : -INFINITY; rkk[ps][i] = 0; }
#pragma unroll 1
        for (int k = 0; k < TOPK; ++k) {
            float best = cand[0]; int bi = 0;
#pragma unroll
            for (int i = 1; i < 8; ++i) if (cand[i] > best) { best = cand[i]; bi = i; }
            int gi = 8 * grp + bi;
#define LNR_RED(CTRL) { const float ov = __builtin_bit_cast(float, __builtin_amdgcn_update_dpp(0, __builtin_bit_cast(int, best), CTRL, 0xF, 0xF, false)); const int oi = __builtin_amdgcn_update_dpp(0, gi, CTRL, 0xF, 0xF, false); if (ov > best || (ov == best && oi < gi)) { best = ov; gi = oi; } }
            LNR_RED(0xB1) LNR_RED(0x4E) LNR_RED(0x141)
#undef LNR_RED
#pragma unroll
            for (int i = 0; i < 8; ++i) if (gi == 8 * grp + i) { cand[i] = -INFINITY; rkk[ps][i] = k; sm |= 1u << i; }
        }
        float psum = 0.f;
#pragma unroll
        for (int i = 0; i < 8; ++i) psum += ((sm >> i) & 1u) ? sc[i] : 0.f;
        psum += __builtin_bit_cast(float, __builtin_amdgcn_update_dpp(0, __builtin_bit_cast(int, psum), 0xB1, 0xF, 0xF, false));
        psum += __builtin_bit_cast(float, __builtin_amdgcn_update_dpp(0, __builtin_bit_cast(int, psum), 0x4E, 0xF, 0xF, false));
        psum += __builtin_bit_cast(float, __builtin_amdgcn_update_dpp(0, __builtin_bit_cast(int, psum), 0x141, 0xF, 0xF, false));
        const float inv = ROUTED_SCALE / psum; selm[ps] = sm;
#pragma unroll
        for (int i = 0; i < 8; ++i) { gte[ps][i] = sc[i] * inv; loc[ps][i] = 0u; if ((sm >> i) & 1u) loc[ps][i] = __hip_atomic_fetch_add(hist + 8 * grp + i, 1u, __ATOMIC_RELAXED, __HIP_MEMORY_SCOPE_WORKGROUP); }
    }
    LCV_BAR();
    if (tid < 64) { const unsigned h = hist[tid]; basep[tid] = h ? __hip_atomic_fetch_add(gcount + tid, h, RLX_AGENT) : 0u; }
    LCV_BAR();
#pragma unroll
    for (int ps = 0; ps < 2; ++ps) { const int tok = row0 + 32 * ps + (tid >> 3);
#pragma unroll
        for (int i = 0; i < 8; ++i) if ((selm[ps] >> i) & 1u) { const int e = 8 * grp + i; const unsigned pos = basep[e] + loc[ps][i];
            rowtok[(size_t)e * CAP + pos] = (unsigned)tok; dest[tok * 8 + rkk[ps][i]] = ((unsigned)e << 16) | pos; gatev[tok * 8 + rkk[ps][i]] = gte[ps][i]; } }
    LCV_BAR();
    if (wave < 3) { LAS float* scr = (LAS float*)(lds + (wave == 2 ? 100352 : wave * 16384)); LCV_PULL(scr); }
#undef LCV_PULL
}

__device__ __forceinline__ pg8::MoeInfo moe_setup(const Args& a, int layer, LAS unsigned char* misc) {
    const int tid = threadIdx.x;
    unsigned* gcount = (unsigned*)(a.ws + WS_CTL) + CW_CNT + layer * 64;
    LAS unsigned* cnt = (LAS unsigned*)(misc + MI_CNT); LAS unsigned* tstart = (LAS unsigned*)(misc + MI_TSTART); LAS unsigned* ystart = (LAS unsigned*)(misc + MI_YSTART);
    LAS unsigned* ntl = (LAS unsigned*)(misc + MI_NTILES); LAS unsigned char* tile_e = (LAS unsigned char*)(misc + MI_TILE_E);
    __syncthreads();
    if (tid < 64) { unsigned c = __hip_atomic_load(gcount + tid, RLX_AGENT); if (c > (unsigned)CAP) c = CAP; cnt[tid] = c; }
    __syncthreads();
    if (tid < 64) { unsigned ts = 64u, ys = 0u; for (int e = 0; e < tid; ++e) { const unsigned c = cnt[e]; ts += (c + 255u) >> 8; ys += c; }
        tstart[tid] = ts; ystart[tid] = ys; const unsigned mynt = (cnt[tid] + 255u) >> 8;
        for (unsigned i = 0; i < mynt; ++i) if (ts + i < 640u) tile_e[ts + i] = (unsigned char)tid;
        if (tid == 63) ntl[0] = ts + mynt; }
    __syncthreads();
    pg8::MoeInfo mi; mi.cnt = cnt; mi.tstart = tstart; mi.ystart = ystart; mi.tile_e = tile_e; mi.ntiles = __builtin_amdgcn_readfirstlane((int)ntl[0]);
    if (mi.ntiles > 640) mi.ntiles = 640;
    return mi;
}

__device__ __forceinline__ void phase_combine(const Args& a, int layer, LAS unsigned char* misc, int vcu, int G, bool dry) {
    const int tid = threadIdx.x, lane = tid & 63, wave = __builtin_amdgcn_readfirstlane(tid >> 6);
    const pg8::MoeInfo mi = moe_setup(a, layer, misc);
    float* xf = a.out; bf16* xb = (bf16*)(a.ws + WS_XB); const unsigned char* Y8 = (const unsigned char*)(a.ws + WS_Y);
    const unsigned* dest = (const unsigned*)(a.ws + WS_DEST); const float* gatev = (const float*)(a.ws + WS_GATE);
    const float* lng = a.in[I_LNFG] + layer * DM; const float* lnb = a.in[I_LNFB] + layer * DM;
    const int gw = vcu * NWAVES + wave, NGW = G * NWAVES;
#pragma unroll 1
    for (int rowa = gw; rowa < T_TOK; rowa += 2 * NGW) {
        float v[2][16]; float* of[2]; bf16* obf[2]; unsigned char* o8[2]; unsigned d[2][TOPK]; float gk[2][TOPK];
#pragma unroll
        for (int r = 0; r < 2; ++r) { const int row = rowa + r * NGW;
#pragma unroll
            for (int k = 0; k < TOPK; ++k) { d[r][k] = dest[row * 8 + k]; gk[r][k] = gatev[row * 8 + k]; } }
#pragma unroll
        for (int r = 0; r < 2; ++r) { const int row = rowa + r * NGW; float* xr = xf + (size_t)row * DM; of[r] = dry ? (float*)(a.ws + WS_H) + (size_t)row * DM : xr; obf[r] = (bf16*)(a.ws + WS_XR) + (size_t)row * DM; o8[r] = (unsigned char*)xb + (size_t)row * DM;
#pragma unroll
            for (int j = 0; j < 2; ++j) { const f32x4 p = *(const f32x4*)(xr + 8 * lane + 512 * j), q = *(const f32x4*)(xr + 8 * lane + 512 * j + 4);
#pragma unroll
                for (int i = 0; i < 4; ++i) { v[r][8 * j + i] = p[i] * ALPHA; v[r][8 * j + 4 + i] = q[i] * ALPHA; } } }
#pragma unroll
        for (int r = 0; r < 2; ++r) { const unsigned char* yr = Y8 + (size_t)(131072 + rowa + r * NGW) * DM;
#pragma unroll
            for (int j = 0; j < 2; ++j) { const v2u w = *(const v2u*)(yr + 8 * lane + 512 * j);
#pragma unroll
                for (int q = 0; q < 2; ++q) { const f32x2 lo2 = __builtin_amdgcn_cvt_pk_f32_fp8((int)w[q], false), hi2 = __builtin_amdgcn_cvt_pk_f32_fp8((int)w[q], true);
                    v[r][8 * j + 4 * q] += 0.0625f * lo2.x; v[r][8 * j + 4 * q + 1] += 0.0625f * lo2.y; v[r][8 * j + 4 * q + 2] += 0.0625f * hi2.x; v[r][8 * j + 4 * q + 3] += 0.0625f * hi2.y; } } }
#pragma unroll
        for (int r = 0; r < 2; ++r)
#pragma unroll
            for (int k = 0; k < TOPK; ++k) { const unsigned dd = (unsigned)__builtin_amdgcn_readfirstlane((int)d[r][k]); const float g = __uint_as_float((unsigned)__builtin_amdgcn_readfirstlane((int)__float_as_uint(gk[r][k])));
                const unsigned e = (dd >> 16) & 63u, pos = dd & 0xffffu; const unsigned char* yr = Y8 + (size_t)(mi.ystart[e] + pos) * DM; const float g16 = g * 0.0625f;
#pragma unroll
                for (int j = 0; j < 2; ++j) { const v2u w = *(const v2u*)(yr + 8 * lane + 512 * j);
#pragma unroll
                    for (int q = 0; q < 2; ++q) { const f32x2 lo2 = __builtin_amdgcn_cvt_pk_f32_fp8((int)w[q], false), hi2 = __builtin_amdgcn_cvt_pk_f32_fp8((int)w[q], true);
                        v[r][8 * j + 4 * q] += g16 * lo2.x; v[r][8 * j + 4 * q + 1] += g16 * lo2.y; v[r][8 * j + 4 * q + 2] += g16 * hi2.x; v[r][8 * j + 4 * q + 3] += g16 * hi2.y; } } }
        if (layer == 0 && !dry) ln_rows_store<2, 6>(v, lng, lnb, of, obf, o8, lane);
        else ln_rows_store<2, 1>(v, lng, lnb, of, obf, o8, lane);
    }
}

__device__ __forceinline__ int swz16(int row) { return (row ^ (row >> 4)) & 15; }
__device__ __forceinline__ void phase_sgu_spatial(const Args& a, LAS unsigned char* lds, int vcu, int G) {
    const int tid = threadIdx.x, lane = tid & 63, wave = __builtin_amdgcn_readfirstlane(tid >> 6), fr = lane & 15, fq = lane >> 4;
    const bf16* HS = (const bf16*)(a.ws + WS_HS); bf16* GT = (bf16*)(a.ws + WS_GATED);
    const float* lng = a.in[I_SLNG]; const float* lnb = a.in[I_SLNB]; const float* WS = a.in[I_SWS]; const float* BS = a.in[I_SBS];
    LAS unsigned char* Bs = lds;
    LAS unsigned char* As = lds + 65536;
    LAS float* stm = (LAS float*)(lds + 98304);
    LAS float* str = (LAS float*)(lds + 98304 + 512);
    for (int item = vcu; item < 512; item += G) {
        const int chunk = item >> 2, h = item & 3, t0 = chunk * 128;
        __syncthreads();
        if (tid < 128) { const f32x4* vs = (const f32x4*)((const float*)(a.ws + WS_VSTAT) + (size_t)(t0 + tid) * 64); float S = 0.f, Q = 0.f;
#pragma unroll
            for (int i = 0; i < 16; ++i) { const f32x4 p = vs[i]; S += p[0] + p[2]; Q += p[1] + p[3]; }
            const float mean = S * (1.0f / SGU_W); const float var = Q * (1.0f / SGU_W) - mean * mean;
            stm[tid] = mean; str[tid] = 1.0f / sqrtf((var > 0.f ? var : 0.f) + LN_EPS); }
        for (int q = tid; q < 128 * 16; q += NTHR) { const int i = q >> 4, jc = q & 15; const float* wp = WS + ((size_t)h * 128 + i) * 128 + 8 * jc;
            const f32x4 p0 = *(const f32x4*)wp, p1 = *(const f32x4*)(wp + 4); float w8[8];
#pragma unroll
            for (int z = 0; z < 4; ++z) { w8[z] = (8 * jc + z <= i) ? p0[z] : 0.f; w8[4 + z] = (8 * jc + 4 + z <= i) ? p1[z] : 0.f; }
            v4u o; o.x = cvt_pk_bf16(w8[0], w8[1]); o.y = cvt_pk_bf16(w8[2], w8[3]); o.z = cvt_pk_bf16(w8[4], w8[5]); o.w = cvt_pk_bf16(w8[6], w8[7]);
            *(LAS v4u*)(As + i * 256 + ((jc ^ swz16(i)) << 4)) = o; }
        __syncthreads();
        for (int hh = 0; hh < 2; ++hh) {
            const int cb = h * SGU_HD + hh * 256;
#pragma unroll 2
            for (int q = tid; q < 64 * 32; q += NTHR) { const int c8 = q & 31, jp = q >> 5, j0 = 2 * jp;
                const v4u w0 = *(const v4u*)(HS + (size_t)(t0 + j0) * 4096 + SGU_W + cb + 8 * c8), w1 = *(const v4u*)(HS + (size_t)(t0 + j0 + 1) * 4096 + SGU_W + cb + 8 * c8);
                const f32x4 g0 = *(const f32x4*)(lng + cb + 8 * c8), g1 = *(const f32x4*)(lng + cb + 8 * c8 + 4), b0 = *(const f32x4*)(lnb + cb + 8 * c8), b1 = *(const f32x4*)(lnb + cb + 8 * c8 + 4);
                const float m0 = stm[j0], r0 = str[j0], m1 = stm[j0 + 1], r1 = str[j0 + 1];
#pragma unroll
                for (int z = 0; z < 8; ++z) { const float gz = z < 4 ? g0[z & 3] : g1[z & 3], bz = z < 4 ? b0[z & 3] : b1[z & 3];
                    const float xa = (z & 1) ? bf_hi(w0[z >> 1]) : bf_lo(w0[z >> 1]), xc = (z & 1) ? bf_hi(w1[z >> 1]) : bf_lo(w1[z >> 1]);
                    const float ya = (xa - m0) * r0 * gz + bz, yc = (xc - m1) * r1 * gz + bz;
                    const int cc = 8 * c8 + z, slot = (cc & ~31) | (((cc >> 2) & 1) << 4) | (((cc >> 3) & 3) << 2) | (cc & 3);
                    *(LAS unsigned*)(Bs + slot * 256 + (((j0 >> 3) ^ swz16(slot)) << 4) + (j0 & 7) * 2) = cvt_pk_bf16(ya, yc); } }
            __syncthreads();
            f32x4 acc[8][2]; bf16x8 Bf[2][4];
#pragma unroll
            for (int n = 0; n < 2; ++n)
#pragma unroll
                for (int s = 0; s < 4; ++s) { const int slot = 32 * wave + 16 * n + fr; Bf[n][s] = *(const LAS bf16x8*)(Bs + slot * 256 + (((4 * s + fq) ^ swz16(slot)) << 4)); }
#pragma unroll
            for (int m = 0; m < 8; ++m) { acc[m][0] = (f32x4){0.f, 0.f, 0.f, 0.f}; acc[m][1] = (f32x4){0.f, 0.f, 0.f, 0.f};
#pragma unroll
                for (int s = 0; s < 4; ++s) if (s <= (m >> 1)) { const int i = 16 * m + fr; const bf16x8 af = *(const LAS bf16x8*)(As + i * 256 + (((4 * s + fq) ^ swz16(i)) << 4));
                    acc[m][0] = __builtin_amdgcn_mfma_f32_16x16x32_bf16(Bf[0][s], af, acc[m][0], 0, 0, 0); acc[m][1] = __builtin_amdgcn_mfma_f32_16x16x32_bf16(Bf[1][s], af, acc[m][1], 0, 0, 0); } }
#pragma unroll
            for (int m = 0; m < 8; ++m) { const int i = 16 * m + fr; const float bsv = BS[h * 128 + i]; const size_t t = (size_t)(t0 + i);
                const v4u uw = *(const v4u*)(HS + t * 4096 + cb + 32 * wave + 8 * fq); float o[8];
#pragma unroll
                for (int n = 0; n < 2; ++n)
#pragma unroll
                    for (int z = 0; z < 4; ++z) { const int c = 4 * n + z; const float uu = (c & 1) ? bf_hi(uw[c >> 1]) : bf_lo(uw[c >> 1]); o[c] = uu * (acc[m][n][z] + bsv); }
                v4u w; w.x = cvt_pk_bf16(o[0], o[1]); w.y = cvt_pk_bf16(o[2], o[3]); w.z = cvt_pk_bf16(o[4], o[5]); w.w = cvt_pk_bf16(o[6], o[7]);
                *(v4u*)(GT + t * SGU_W + cb + 32 * wave + 8 * fq) = w; }
            __syncthreads();
        }
    }
}

__device__ __forceinline__ void phase_flush(const Args& a, int vcu, int G) {
    const size_t gt = (size_t)vcu * NTHR + threadIdx.x, NT = (size_t)G * NTHR; f32x4 acc = (f32x4){0.f, 0.f, 0.f, 0.f};
    const f32x4* p0 = (const f32x4*)a.in[I_WG]; const f32x4* p1 = (const f32x4*)a.in[I_WU];
    for (size_t i = gt; i < (size_t)33554432 / 4; i += 4 * NT) { const f32x4 x0 = p0[i], x1 = p0[i + NT], x2 = p0[i + 2 * NT], x3 = p0[i + 3 * NT], y0 = p1[i], y1 = p1[i + NT], y2 = p1[i + 2 * NT], y3 = p1[i + 3 * NT]; acc += x0 + x1 + x2 + x3 + y0 + y1 + y2 + y3; }
    if (acc[0] + acc[1] + acc[2] + acc[3] == 1.2345e-30f) ((float*)(a.ws + WS_CTL))[16000] = acc[0];
}
constexpr int N_PHASES = 16;
__global__ void __launch_bounds__(NTHR, 2) mk_fwd(Args args) {
    extern __shared__ __attribute__((aligned(16))) unsigned char lds_raw[];
    LAS unsigned char* lds = (LAS unsigned char*)lds_raw;
    LAS unsigned char* misc = lds + MISC_OFF;
    const int tid = threadIdx.x;
    const int G = gridDim.x; const int bx = blockIdx.x; const int vcu = (G % 8 == 0) ? (bx % 8) * (G / 8) + bx / 8 : bx;
    unsigned char* ws = args.ws;
    unsigned* ctl = (unsigned*)(ws + WS_CTL);
    if (tid < 16) ((LAS unsigned*)(misc + MI_BARW))[tid] = 0u;
    __syncthreads();
    const int lo = args.ph_lo, hi = args.ph_hi;
    XcdBarrier bar; bar.bar = ctl + CW_BAR; bar.x = 0; bar.st = nullptr;
    if (hi - lo > 1) bar = xcd_barrier_post(ctl + CW_BAR, (volatile LAS unsigned*)(misc + MI_BARW));
#ifndef PH_MASK
#define PH_MASK 0xFFFF
#endif
#define IN(k) (((PH_MASK >> (k)) & 1) && lo <= (k) && (k) < hi)
#ifndef TS_A0
#define TS_A0 -1
#define TS_A1 -1
#define TS_M 1
#endif
    unsigned long long* tsbuf = (unsigned long long*)(ws + 32768);
#define TS_REC(k) do { if (TS_A0 >= 0 && bx == 0 && tid == 0) __hip_atomic_store(tsbuf + (k), (unsigned long long)__builtin_amdgcn_s_memrealtime(), RLX_AGENT); } while (0)
    TS_REC(0);
#ifndef REP_PH
#define REP_PH -1
#define REP_N 1
#endif
#define NREP(k) ((k) == REP_PH ? REP_N : 1)
#ifndef FLUSH_PH
#define FLUSH_PH -2
#endif
#define RUN(k) if (IN(k)) for (int rep = 0; rep < NREP(k); ++rep) if ((((k) == FLUSH_PH && rep == NREP(k) - 1) ? (xcd_barrier(bar), phase_flush(args, vcu, G), xcd_barrier(bar), true) : true))
#define DRY(k) (rep + 1 < NREP(k))
#define BG_LAYER(k) (-1)
#define SEAM(k) do { if (IN(k) && IN((k) + 1)) xcd_barrier(bar, &args, BG_LAYER(k), lds); TS_REC((k) + 1); } while (0)
    using namespace pg8;
    RUN(0) { phase_p0(args, lds, vcu, G); } SEAM(0);
    RUN(1) { DenseSched S{(const char*)(ws + WS_XB), (const char*)(ws + WS_WIN), 2048u, 2048u, 0u, 64, 4, 256, G, bx};
        EpiBf16<0, false, false> E{(bf16*)(ws + WS_Z), DM, nullptr, nullptr, nullptr};
        gemm_phase<EpiBf16<0, false, false>, DenseSched, false, true, true>(lds, 2048u, 2048u, 16, S, E); } SEAM(1);
    if (REP_PH == 100 && hi - lo > 1) for (int i = 0; i < REP_N; ++i) xcd_barrier(bar);
    RUN(3) { DenseSched S{(const char*)(ws + WS_POOLED), (const char*)(ws + WS_WGRP), 2048u, 512u, 512u, 64, 4, 256, G, bx};
        { Unit u0; if (S.next(0, u0)) pool_block(args, u0.i0, u0.i1); }
        EpiBf16<0, false, true> E{(bf16*)(ws + WS_YP), DM, nullptr, args.in[I_PSCALE], nullptr};
        gemm_phase<EpiBf16<0, false, true>, DenseSched, false, true, true>(lds, 2048u, 512u, 4, S, E); } SEAM(3);
    RUN(4) { DenseSched S{(const char*)(ws + WS_YP), (const char*)(ws + WS_WOUT), 2048u, 2048u, 0u, 64, 4, 256, G, bx};
        EpiResidB<false> E{args.in[I_X], (bf16*)(ws + WS_XR)};
        gemm_phase<EpiResidB<false>, DenseSched, false, true, true>(lds, 2048u, 2048u, 16, S, E); } SEAM(4);
#define MOE_PHASES(layer, pb) do { \
        RUN(pb) { phase_lnr_cv(args, layer, lds, vcu, vcu, G); __syncthreads(); } SEAM(pb); \
        RUN((pb) + 1) { const MoeInfo mi = moe_setup(args, layer, misc); \
            G1Sched S{mi, (const char*)(ws + WS_XB), (const char*)(ws + WS_WGU + (size_t)layer * WS_MOE_LSTRIDE), (const unsigned*)(ws + WS_ROWTOK), (const unsigned*)(ws + WS_IDENT), G, vcu}; \
            EpiSwiglu E{(unsigned char*)(ws + WS_H)}; \
            gemm_phase<EpiSwiglu, G1Sched, true, true, false, 0, 1>(lds, 1024u, 1024u, 8, S, E); } SEAM((pb) + 1); \
        if (IN((pb) + 2) && REP_PH == (pb) + 2) { const MoeInfo mi = moe_setup(args, layer, misc); \
            G2Sched S{mi, (const char*)(ws + WS_H), (const char*)(ws + WS_WDN + (size_t)layer * WS_MOE_LSTRIDE), G, vcu, 256}; \
            EpiDown E{(unsigned char*)(ws + WS_Y)}; \
            gemm_phase<EpiDown, G2Sched, false, true, true, 1, 1>(lds, 256u, 256u, 2, S, E); } \
        if (IN((pb) + 2)) { const MoeInfo mi = moe_setup(args, layer, misc); \
            G2Sched S{mi, (const char*)(ws + WS_H), (const char*)(ws + WS_WDN + (size_t)layer * WS_MOE_LSTRIDE), G, vcu, 0}; \
            EpiDown E{(unsigned char*)(ws + WS_Y)}; \
            gemm_phase<EpiDown, G2Sched, false, true, true, 1, 1>(lds, 256u, 256u, 2, S, E); } SEAM((pb) + 2); \
        RUN((pb) + 3) { phase_combine(args, layer, misc, vcu, G, DRY((pb) + 3)); } \
    } while (0)
    MOE_PHASES(0, 5); SEAM(8);
    RUN(9) { DenseSched S{(const char*)(ws + WS_XB), (const char*)(ws + WS_WSIN), 1024u, 1024u, 0u, 64, 16, 1024, G, bx, (const unsigned*)(ws + WS_IDENT)};
        EpiBf16<1, true, false, true, true> E{(bf16*)(ws + WS_HS), 4096, args.in[I_SBIN], nullptr, (float*)(ws + WS_VSTAT)};
        gemm_phase<EpiBf16<1, true, false, true, true>, DenseSched, true, true, false, 0, 1>(lds, 1024u, 1024u, 8, S, E); } SEAM(9);
    RUN(10) { phase_sgu_spatial(args, lds, vcu, G); } SEAM(10);
    RUN(11) { DenseSched S{(const char*)(ws + WS_GATED), (const char*)(ws + WS_WSOUT), 4096u, 4096u, 0u, 64, 4, 256, G, bx};
        EpiResidB<true> E{ws + WS_XR, (bf16*)(ws + WS_XR)};
        gemm_phase<EpiResidB<true>, DenseSched, false, true, true>(lds, 4096u, 4096u, 32, S, E); } SEAM(11);
    MOE_PHASES(1, 12);
#undef MOE_PHASES
    if (TS_A0 >= 0 && bx == 0 && tid == 0) {
        const unsigned long long tend = __builtin_amdgcn_s_memrealtime();
        const unsigned long long t0 = __hip_atomic_load(tsbuf + TS_A0, RLX_AGENT), t1 = (TS_A1 + 1 >= N_PHASES) ? tend : __hip_atomic_load(tsbuf + TS_A1 + 1, RLX_AGENT);
        const unsigned long long wait = (t1 - t0) * TS_M;
        while (__builtin_amdgcn_s_memrealtime() - tend < wait) __builtin_amdgcn_s_sleep(8);
    }
#undef IN
#undef SEAM
}

extern "C" void kernel_launch(void* const* d_in, const int* in_sizes, int n_in, void* d_out, int out_size, void* d_ws, size_t ws_size, hipStream_t stream) {
    static int grid = 0;
    if (grid == 0) {
        if (n_in != 24 || out_size != T_TOK * DM || ws_size < WS_END) { fprintf(stderr, "kernel_launch: unexpected shapes (n_in %d out %d ws %zu)\n", n_in, out_size, ws_size); grid = -1; return; }
        int dev = 0, cus = 0;
        if (hipGetDevice(&dev) != hipSuccess || hipDeviceGetAttribute(&cus, hipDeviceAttributeMultiprocessorCount, dev) != hipSuccess) { grid = -1; return; }
        if (hipFuncSetAttribute((const void*)mk_fwd, hipFuncAttributeMaxDynamicSharedMemorySize, LDS_BYTES) != hipSuccess) { fprintf(stderr, "kernel_launch: hipFuncSetAttribute failed\n"); grid = -1; return; }
        int per_cu = 0;
        if (hipOccupancyMaxActiveBlocksPerMultiprocessor(&per_cu, (const void*)mk_fwd, NTHR, LDS_BYTES) != hipSuccess || per_cu < 1) fprintf(stderr, "kernel_launch: occupancy query says %d\n", per_cu);
        (void)hipGetLastError();
        grid = cus;
        if (grid != 256) { fprintf(stderr, "kernel_launch: built for a 256-CU device (got %d)\n", cus); grid = -1; return; }
    }
    if (grid < 0) return;
    (void)hipMemsetAsync((char*)d_ws + WS_CTL, 0, CTL_ZERO_BYTES, stream);
    Args a{};
    for (int i = 0; i < 24; ++i) a.in[i] = (const float*)d_in[i];
    a.out = (float*)d_out; a.ws = (unsigned char*)d_ws;
#if MK_PER_PHASE
    for (int p = 0; p < N_PHASES; ++p) { a.ph_lo = p; a.ph_hi = p + 1; hipLaunchKernelGGL(mk_fwd, dim3(grid), dim3(NTHR), LDS_BYTES, stream, a); }
#else
    a.ph_lo = 0; a.ph_hi = N_PHASES; hipLaunchKernelGGL(mk_fwd, dim3(grid), dim3(NTHR), LDS_BYTES, stream, a);
#endif
}
```

```cpp
#include <hip/hip_runtime.h>
#include <cstdio>
#include <cstdint>

#ifndef MK_PER_PHASE
#define MK_PER_PHASE 0
#endif

#define GAS __attribute__((address_space(1)))
#define LAS __attribute__((address_space(3)))
typedef unsigned short bf16;
typedef unsigned v4u __attribute__((ext_vector_type(4)));
typedef unsigned v2u __attribute__((ext_vector_type(2)));
typedef float f32x4 __attribute__((ext_vector_type(4)));
typedef float f32x2 __attribute__((ext_vector_type(2)));
typedef short bf16x8 __attribute__((ext_vector_type(8)));
#define RLX_AGENT __ATOMIC_RELAXED, __HIP_MEMORY_SCOPE_AGENT
#define LDS_WAIT() asm volatile("s_waitcnt lgkmcnt(0)" ::: "memory")
#define VM_WAIT() asm volatile("s_waitcnt vmcnt(0)" ::: "memory")

constexpr int T_TOK = 16384, DM = 1024, SEQ = 4096, NE = 64, TOPK = 8, EDIM = 256;
constexpr int SGU_W = 2048, SGU_HD = 512;
constexpr float ALPHA = 1.41421356237309515f;
constexpr float LN_EPS = 1e-5f, ROUTED_SCALE = 2.5f;
constexpr int CAP = 16384;
constexpr int NWAVES = 8, NTHR = 512;

constexpr size_t MiB = 1u << 20;
constexpr size_t WS_CTL = 0, CTL_ZERO_BYTES = 65536;
constexpr size_t WS_IDENT = 256 * 1024;
constexpr size_t WS_DEST = 1 * MiB;
constexpr size_t WS_GATE = WS_DEST + 512 * 1024;
constexpr size_t WS_ROWTOK = 2 * MiB;
constexpr size_t WS_VSTAT = WS_ROWTOK;
constexpr size_t WS_WIN = 6 * MiB;
constexpr size_t WS_WGRP = 8 * MiB;
constexpr size_t WS_WOUT = WS_WGRP + 512 * 1024;
constexpr size_t WS_WSIN = WS_WOUT + 2 * MiB;
constexpr size_t WS_WSOUT = WS_WSIN + 8 * MiB;
constexpr size_t WS_WRT = WS_WSOUT + 4 * MiB;
constexpr size_t WS_WGU = 23 * MiB;
constexpr size_t WS_WDN = WS_WGU + 65 * MiB;
constexpr size_t WS_XB = 121 * MiB;
constexpr size_t WS_H = 153 * MiB;
constexpr size_t WS_Y = 233 * MiB;
constexpr size_t WS_WGU1 = 378 * MiB, WS_WDN1 = WS_WGU1 + 65 * MiB;
constexpr size_t WS_MOE_LSTRIDE = WS_WGU1 - WS_WGU;
constexpr size_t WS_XR = 476 * MiB;
constexpr size_t WS_END = 508 * MiB;
constexpr size_t WS_Z = 153 * MiB, WS_POOLED = 185 * MiB, WS_YP = 217 * MiB;
constexpr size_t WS_HS = 153 * MiB;
constexpr size_t WS_GATED = 281 * MiB;
static_assert(WS_WRT + 512 * 1024 <= WS_WGU && WS_WDN + 33 * MiB <= WS_XB && WS_XB + 32 * MiB <= WS_H && WS_H + 80 * MiB <= WS_Y && WS_Y + 145 * MiB <= WS_WGU1 && WS_WDN1 + 33 * MiB <= WS_END && WS_GATED + 64 * MiB <= WS_WGU1, "ws map");
constexpr int CW_TMO = 0, CW_BAR = 64, CW_CNT = 4096, CW_QNEXT = 4608;

constexpr int RING_BYTES = 131072;
constexpr int MISC_OFF = RING_BYTES;
constexpr int LDS_BYTES = 147456;
constexpr int MI_BARW = 0, MI_CNT = 64, MI_TSTART = 320, MI_YSTART = 576, MI_NTILES = 832, MI_TILE_E = 1024;

__device__ __forceinline__ unsigned cvt_pk_bf16(float lo, float hi) { unsigned r; asm volatile("v_cvt_pk_bf16_f32 %0, %1, %2" : "=v"(r) : "v"(lo), "v"(hi)); return r; }
__device__ __forceinline__ float bf_lo(unsigned w) { return __uint_as_float(w << 16); }
__device__ __forceinline__ float bf_hi(unsigned w) { return __uint_as_float(w & 0xffff0000u); }
__device__ __forceinline__ float wave_sum(float v) {
#pragma unroll
    for (int o = 1; o < 64; o <<= 1) v += __shfl_xor(v, o);
    return v;
}
__device__ __forceinline__ float sigmoidf_(float x) { return __builtin_amdgcn_rcpf(1.0f + __builtin_amdgcn_exp2f(-1.4426950408889634f * x)); }
__device__ __forceinline__ f32x2 gelu_tanh2(f32x2 v) { const f32x2 v2 = v * v; const f32x2 y = v * (v2 * 0.044715f + 1.0f); const f32x2 t = y * (-2.3022081983f);
    f32x2 e; e.x = __builtin_amdgcn_exp2f(t.x); e.y = __builtin_amdgcn_exp2f(t.y); const f32x2 d = e + 1.0f; f32x2 r; r.x = __builtin_amdgcn_rcpf(d.x); r.y = __builtin_amdgcn_rcpf(d.y); return v * r; }
__device__ __forceinline__ float gelu_tanh(float v) { const float y = v + 0.044715f * v * v * v; return v * __builtin_amdgcn_rcpf(1.0f + __builtin_amdgcn_exp2f(-2.3022081983f * y)); }

#define XB_TMO      128
#define XB_XCNT(j)  (256  + 64 * (j))
#define XB_XSUB(j)  (1280 + 64 * (j))
#define XB_XGEN(j)  (2304 + 64 * (j))
#define XB_TOP      3328
#define XB_TOPGEN   3392
#define XCD_BAR_WORDS 3456
#define XB_SPIN_CAP (1u << 20)
__device__ __forceinline__ unsigned xb_ld(unsigned* p)              { return __hip_atomic_load(p, __ATOMIC_RELAXED, __HIP_MEMORY_SCOPE_AGENT); }
__device__ __forceinline__ unsigned xb_add(unsigned* p, unsigned v) { return __hip_atomic_fetch_add(p, v, __ATOMIC_RELAXED, __HIP_MEMORY_SCOPE_AGENT); }
__device__ __forceinline__ unsigned xb_xcc_id() { return (unsigned)__builtin_amdgcn_s_getreg((3 << 11) | 20) & 0xFu; }
#define XB_SPIN(cond, bar) do { unsigned _sp = 0; while (cond) { __builtin_amdgcn_s_sleep(1); \
    if ((++_sp & 255u) == 0u) { if (xb_ld(&(bar)[XB_TMO])) break; if (_sp > XB_SPIN_CAP) { atomicAdd(&(bar)[XB_TMO], 1u); break; } } } } while (0)
struct XcdBarrier { unsigned* bar; unsigned x; volatile LAS unsigned* st; };
__device__ __forceinline__ XcdBarrier xcd_barrier_post(unsigned* bar, volatile LAS unsigned* st) {
    XcdBarrier b; b.bar = bar; b.x = xb_xcc_id(); b.st = st;
    if (threadIdx.x == 0) (void)xb_add(&bar[XB_XCNT(b.x)], 1u);
    return b;
}
__device__ __forceinline__ void xcd_barrier_complete(unsigned* bar, unsigned x, unsigned& nloc, unsigned& nx) {
    const unsigned G = gridDim.x * gridDim.y * gridDim.z;
    unsigned sum, cnt, mine, sp = 0u;
    for (;;) {
        sum = 0u; cnt = 0u; mine = 0u;
#pragma unroll
        for (unsigned j = 0; j < 16; ++j) { const unsigned c = xb_ld(&bar[XB_XCNT(j)]); sum += c; cnt += (c > 0u) ? 1u : 0u; mine = (j == x) ? c : mine; }
        if (sum == G) break;
        __builtin_amdgcn_s_sleep(1);
        if ((++sp & 255u) == 0u) { if (xb_ld(&bar[XB_TMO])) break; if (sp > XB_SPIN_CAP) { atomicAdd(&bar[XB_TMO], 1u); break; } }
    }
    nloc = mine > 0u ? mine : 1u; nx = cnt > 0u ? cnt : 1u;
}
__device__ __forceinline__ void xcd_barrier(const XcdBarrier& b) {
    asm volatile("s_waitcnt vmcnt(0)" ::: "memory");
    __syncthreads();
    if (threadIdx.x == 0) {
        unsigned* bar = b.bar;
        __builtin_amdgcn_s_waitcnt(0);
        unsigned nloc = b.st[0], nx = b.st[1];
        if (nloc == 0u) { xcd_barrier_complete(bar, b.x, nloc, nx); b.st[0] = nloc; b.st[1] = nx; }
        const unsigned old = xb_add(&bar[XB_XSUB(b.x)], 1u);
        const unsigned gen = old / nloc;
        if (old + 1u == (gen + 1u) * nloc) {
            __builtin_amdgcn_fence(__ATOMIC_RELEASE, "agent");
            asm volatile("s_waitcnt vmcnt(0)" ::: "memory");
            const unsigned og = xb_add(&bar[XB_TOP], 1u);
            const unsigned tg = og / nx;
            if (og + 1u == (tg + 1u) * nx) xb_add(&bar[XB_TOPGEN], 1u);
            else XB_SPIN(xb_ld(&bar[XB_TOPGEN]) == tg, bar);
            __builtin_amdgcn_fence(__ATOMIC_ACQUIRE, "agent");
            xb_add(&bar[XB_XGEN(b.x)], 1u);
            asm volatile("s_waitcnt vmcnt(0)" ::: "memory");
        } else {
            XB_SPIN(xb_ld(&bar[XB_XGEN(b.x)]) == gen, bar);
            __builtin_amdgcn_fence(__ATOMIC_ACQUIRE, "agent");
            asm volatile("s_waitcnt vmcnt(0)" ::: "memory");
        }
    }
    __syncthreads();
}

constexpr size_t XPAN = (size_t)16384 * 128, GUPAN = (size_t)512 * 128, SINPAN = (size_t)4096 * 128, WINPAN = (size_t)1024 * 128;
namespace pg8 {
constexpr int BM = 256, BK = 64, HALF = 128, HTB = HALF * BK * 2, STAGE_BYTES = 8 * HTB, NXCD = 8, WGM = 8;
__host__ __device__ __forceinline__ int lds_byte(int r, int c) { const int st = (r >> 4) * 2 + (c >> 5), rr = r & 15, cc = c & 31, ob = rr * 64 + cc * 2; return st * 1024 + (ob ^ (((ob >> 9) & 1) << 5)); }
__host__ __device__ __forceinline__ void stage_rc(int b, int& R, int& C) { const int st = b / 1024, sb = b % 1024, swz = sb ^ (((sb >> 9) & 1) << 5); R = (st >> 1) * 16 + swz / 64; C = (st & 1) * 32 + (swz % 64) / 2; }
__host__ __device__ __forceinline__ int perm32(int rho) { const int n = rho >> 4, i = rho & 15; return 8 * (i >> 2) + 4 * n + (i & 3); }

typedef int v8i __attribute__((ext_vector_type(8)));
typedef int v4i __attribute__((ext_vector_type(4)));
__device__ __forceinline__ v8i cat8(bf16x8 lo, bf16x8 hi) { const v4i a = __builtin_bit_cast(v4i, lo), b = __builtin_bit_cast(v4i, hi); return __builtin_shufflevector(a, b, 0, 1, 2, 3, 4, 5, 6, 7); }
struct Unit { const char* A; const char* B; const unsigned* gat; int nvalid; int i0, i1, i2; };

template <class Epi, class Sched, bool GATHER, bool ALIGN_EPI, bool SP2, int BMODE = 0, int F8 = 0, int SC0 = 0x7F, int SC1 = 0x7F>
__device__ __forceinline__ void gemm_phase(LAS unsigned char* lds, const unsigned lda, const unsigned ldb, const int nt, const Sched& S, const Epi& E, const size_t kstepA = 128, const size_t kstepB = 128) {
    const int tid = threadIdx.x, wid = __builtin_amdgcn_readfirstlane(tid >> 6), lane = tid & 63, wr = wid >> 2, wc = wid & 3, fr = lane & 15, fq = lane >> 4;
    int R0, C0, R1, C1; stage_rc(tid * 16, R0, C0); stage_rc(tid * 16 + 8192, R1, C1);
    const int Rb0 = BMODE == 0 ? (R0 & ~31) + perm32(R0 & 31) : 64 * (R0 >> 5) + 16 * ((R0 & 15) >> 2) + 4 * ((R0 >> 4) & 1) + (R0 & 3);
    const int Rb1 = BMODE == 0 ? (R1 & ~31) + perm32(R1 & 31) : 64 * (R1 >> 5) + 16 * ((R1 & 15) >> 2) + 4 * ((R1 >> 4) & 1) + (R1 & 3);
    const unsigned voffB0 = (unsigned)Rb0 * ldb + (unsigned)C0 * 2u, voffB1 = (unsigned)Rb1 * ldb + (unsigned)C1 * 2u;
    const size_t hstepB = (size_t)(BMODE == 0 ? HALF : 8) * ldb;
    const unsigned ldsw = (unsigned)wid * 1024u;
    const int aoff = lds_byte(wr * 64 + fr, fq * 8), boff = lds_byte(wc * 32 + fr, fq * 8);
    const int aoff2 = aoff + 1024, boff2 = boff + 1024;
#define PG8_SA(b, h) (((b) * 2 + (h)) * HTB)
#define PG8_SB(b, h) ((4 + (b) * 2 + (h)) * HTB)
#define PG8_STAGE(bufoff, gbase, v0, v1) do { unsigned _v0 = (v0), _v1 = (v1); asm volatile("" : "+v"(_v0), "+v"(_v1)); \
        __builtin_amdgcn_global_load_lds((const unsigned*)((const char*)(gbase) + _v0), (LAS unsigned*)(lds + (bufoff) + ldsw), 16, 0, 0); \
        __builtin_amdgcn_global_load_lds((const unsigned*)((const char*)(gbase) + _v1), (LAS unsigned*)(lds + (bufoff) + ldsw + 8192), 16, 0, 0); } while (0)
#define PG8_LDA(dst, b, h) do { _Pragma("unroll") for (int m = 0; m < 4; ++m) { dst[m][0] = *(const LAS bf16x8*)(lds + PG8_SA(b, h) + aoff + m * 2048); dst[m][1] = *(const LAS bf16x8*)(lds + PG8_SA(b, h) + aoff2 + m * 2048); } } while (0)
#define PG8_LDB(dst, b, h) do { _Pragma("unroll") for (int n = 0; n < 2; ++n) { dst[n][0] = *(const LAS bf16x8*)(lds + PG8_SB(b, h) + boff + n * 2048); dst[n][1] = *(const LAS bf16x8*)(lds + PG8_SB(b, h) + boff2 + n * 2048); } } while (0)
#define PG8_MMA(ai, bj, At, Bt) do { __builtin_amdgcn_s_setprio(1); _Pragma("unroll") for (int m = 0; m < 4; ++m) _Pragma("unroll") for (int n = 0; n < 2; ++n) { \
        if constexpr (F8) acc[ai][bj][m][n] = __builtin_amdgcn_mfma_scale_f32_16x16x128_f8f6f4(cat8(Bt[n][0], Bt[n][1]), cat8(At[m][0], At[m][1]), acc[ai][bj][m][n], 0, 0, 0, 0, 0, 0);     \
        else { _Pragma("unroll") for (int k = 0; k < 2; ++k) acc[ai][bj][m][n] = __builtin_amdgcn_mfma_f32_16x16x32_bf16(Bt[n][k], At[m][k], acc[ai][bj][m][n], 0, 0, 0); } } __builtin_amdgcn_s_setprio(0); } while (0)
#define PG8_WAIT_V(n) asm volatile("s_waitcnt vmcnt(" #n ")" ::: "memory")
#define PG8_WAIT_L(n) asm volatile("s_waitcnt lgkmcnt(" #n ")" ::: "memory")
#define PG8_BAR __builtin_amdgcn_s_barrier()
#define PG8_SCHED __builtin_amdgcn_sched_barrier(0)
#define PG8_SETV(v00, v01, v10, v11, u) do { \
        if (GATHER) { int _t = tid; asm volatile("" : "+v"(_t)); int r0, c0, r1, c1; stage_rc(_t * 16, r0, c0); stage_rc(_t * 16 + 8192, r1, c1);     \
            const unsigned ta = r0 < (u).nvalid ? (u).gat[r0] : 0u, tb = r1 < (u).nvalid ? (u).gat[r1] : 0u, \
                                     tc = (HALF + r0) < (u).nvalid ? (u).gat[HALF + r0] : 0u, td = (HALF + r1) < (u).nvalid ? (u).gat[HALF + r1] : 0u; \
            v00 = ta * lda + (unsigned)c0 * 2u; v01 = tb * lda + (unsigned)c1 * 2u; v10 = tc * lda + (unsigned)c0 * 2u; v11 = td * lda + (unsigned)c1 * 2u; } \
        else { v00 = (unsigned)R0 * lda + (unsigned)C0 * 2u; v01 = (unsigned)R1 * lda + (unsigned)C1 * 2u; v10 = (unsigned)(HALF + R0) * lda + (unsigned)C0 * 2u; v11 = (unsigned)(HALF + R1) * lda + (unsigned)C1 * 2u; } } while (0)
#define PG8_PREF(u) do { int _t = tid; asm volatile("" : "+v"(_t)); int r0, c0, r1, c1; stage_rc(_t * 16, r0, c0); stage_rc(_t * 16 + 8192, r1, c1); \
        const unsigned* g0 = (u).gat + r0; const unsigned* g1 = (u).gat + r1; \
        asm volatile("global_load_dword %0, %4, off\n\tglobal_load_dword %1, %5, off\n\tglobal_load_dword %2, %4, off offset:512\n\tglobal_load_dword %3, %5, off offset:512" \
                     : "=&v"(tk0), "=&v"(tk1), "=&v"(tk2), "=&v"(tk3) : "v"(g0), "v"(g1) : "memory"); } while (0)
#define PG8_SETV_PREF(v00, v01, v10, v11, u) do { asm volatile("" : "+v"(tk0), "+v"(tk1), "+v"(tk2), "+v"(tk3)); \
        int _t = tid; asm volatile("" : "+v"(_t)); int r0, c0, r1, c1; stage_rc(_t * 16, r0, c0); stage_rc(_t * 16 + 8192, r1, c1); \
        const unsigned ta = r0 < (u).nvalid ? tk0 : 0u, tb = r1 < (u).nvalid ? tk1 : 0u, tc = (HALF + r0) < (u).nvalid ? tk2 : 0u, td = (HALF + r1) < (u).nvalid ? tk3 : 0u; \
        v00 = ta * lda + (unsigned)c0 * 2u; v01 = tb * lda + (unsigned)c1 * 2u; v10 = tc * lda + (unsigned)c0 * 2u; v11 = td * lda + (unsigned)c1 * 2u; } while (0)
    unsigned tk0 = 0u, tk1 = 0u, tk2 = 0u, tk3 = 0u;
    Unit cur, nxt; int ui = 0;
    if (!S.next(0, cur)) return;
    f32x4 acc[2][2][4][2];
#pragma unroll
    for (int a = 0; a < 2; ++a)
#pragma unroll
        for (int b = 0; b < 2; ++b)
#pragma unroll
            for (int m = 0; m < 4; ++m)
#pragma unroll
                for (int n = 0; n < 2; ++n) acc[a][b][m][n] = (f32x4){0.f, 0.f, 0.f, 0.f};
    bf16x8 At[4][2], B0[2][2], B1[2][2];
    const char* cA = cur.A; const char* cB = cur.B;
    unsigned cv00, cv01, cv10, cv11;
    PG8_SETV(cv00, cv01, cv10, cv11, cur);
    if constexpr (SP2) {
        PG8_STAGE(PG8_SB(0, 0), cB, voffB0, voffB1); PG8_STAGE(PG8_SB(0, 1), cB + hstepB, voffB0, voffB1); PG8_STAGE(PG8_SA(0, 0), cA, cv00, cv01); PG8_STAGE(PG8_SA(0, 1), cA, cv10, cv11);
        if (wr == 1) PG8_BAR;
        PG8_WAIT_V(2); PG8_BAR;
        PG8_STAGE(PG8_SB(1, 0), cB + kstepB, voffB0, voffB1); PG8_STAGE(PG8_SA(1, 0), cA + kstepA, cv00, cv01); PG8_STAGE(PG8_SB(1, 1), cB + hstepB + kstepB, voffB0, voffB1);
        PG8_WAIT_V(6); PG8_BAR;
    } else {
        PG8_STAGE(PG8_SB(0, 0), cB, voffB0, voffB1); PG8_STAGE(PG8_SA(0, 0), cA, cv00, cv01); PG8_STAGE(PG8_SB(0, 1), cB + hstepB, voffB0, voffB1); PG8_STAGE(PG8_SA(0, 1), cA, cv10, cv11);
        if (wr == 1) PG8_BAR;
        PG8_WAIT_V(4); PG8_BAR;
        PG8_STAGE(PG8_SB(1, 0), cB + kstepB, voffB0, voffB1); PG8_STAGE(PG8_SA(1, 0), cA + kstepA, cv00, cv01); PG8_STAGE(PG8_SB(1, 1), cB + hstepB + kstepB, voffB0, voffB1);
        PG8_WAIT_V(6); PG8_BAR;
    }
    for (;;) {
        const bool has_next = S.next(ui + 1, nxt);
        const char* nA = has_next ? nxt.A : cA; const char* nB = has_next ? nxt.B : cB;
        if constexpr (GATHER) { if (has_next) PG8_PREF(nxt); }
#pragma unroll 1
        for (int t = 0; t < nt; t += 2) {
            const bool last = (t == nt - 2);
            const char* a1 = cA + (size_t)(t + 1) * kstepA;
            const char* a2 = last ? nA : cA + (size_t)(t + 2) * kstepA; const char* b2 = last ? nB : cB + (size_t)(t + 2) * kstepB;
            const char* a3 = a2 + kstepA; const char* b3 = b2 + kstepB;
            if constexpr (SP2) {
            PG8_LDB(B0, 0, 0); PG8_LDB(B1, 0, 1); PG8_SCHED; PG8_LDA(At, 0, 0); PG8_STAGE(PG8_SA(1, 1), a1, cv10, cv11);
            PG8_WAIT_V(8); PG8_WAIT_L(0); PG8_BAR; PG8_MMA(0, 0, At, B0); PG8_MMA(0, 1, At, B1); PG8_BAR; PG8_SCHED;
            if constexpr (GATHER) { if (last && has_next) { PG8_SETV_PREF(cv00, cv01, cv10, cv11, nxt); } }
            PG8_LDA(At, 0, 1); PG8_STAGE(PG8_SB(0, 0), b2, voffB0, voffB1); PG8_STAGE(PG8_SB(0, 1), b2 + hstepB, voffB0, voffB1); PG8_STAGE(PG8_SA(0, 0), a2, cv00, cv01);
            PG8_WAIT_V(8); PG8_WAIT_L(0); PG8_BAR; PG8_MMA(1, 0, At, B0); PG8_MMA(1, 1, At, B1); PG8_BAR; PG8_SCHED;
            PG8_LDB(B0, 1, 0); PG8_LDB(B1, 1, 1); PG8_SCHED; PG8_LDA(At, 1, 0); PG8_STAGE(PG8_SA(0, 1), a2, cv10, cv11);
            PG8_WAIT_V(8); PG8_WAIT_L(0); PG8_BAR; PG8_MMA(0, 0, At, B0); PG8_MMA(0, 1, At, B1); PG8_BAR; PG8_SCHED;
            PG8_LDA(At, 1, 1); PG8_STAGE(PG8_SB(1, 0), b3, voffB0, voffB1); PG8_STAGE(PG8_SB(1, 1), b3 + hstepB, voffB0, voffB1); PG8_STAGE(PG8_SA(1, 0), a3, cv00, cv01);
            PG8_WAIT_V(8); PG8_WAIT_L(0); PG8_BAR; PG8_MMA(1, 0, At, B0); PG8_MMA(1, 1, At, B1); PG8_BAR; PG8_SCHED;
            } else {
            PG8_LDB(B0, 0, 0); PG8_SCHED; PG8_LDA(At, 0, 0); PG8_STAGE(PG8_SA(1, 1), a1, cv10, cv11);
            PG8_WAIT_L(8); PG8_BAR; PG8_WAIT_L(0); PG8_MMA(0, 0, At, B0); PG8_BAR; PG8_SCHED;
            if constexpr (GATHER) { if (last && has_next) { PG8_SETV_PREF(cv00, cv01, cv10, cv11, nxt); } }
            PG8_LDB(B1, 0, 1); PG8_STAGE(PG8_SB(0, 0), b2, voffB0, voffB1);
            PG8_BAR; PG8_WAIT_L(0); PG8_MMA(0, 1, At, B1); PG8_BAR;
            PG8_LDA(At, 0, 1); PG8_STAGE(PG8_SA(0, 0), a2, cv00, cv01);
            PG8_BAR; PG8_WAIT_L(0); PG8_MMA(1, 0, At, B0); PG8_BAR; PG8_SCHED;
            PG8_STAGE(PG8_SB(0, 1), b2 + hstepB, voffB0, voffB1);
            PG8_WAIT_V(6); PG8_BAR; PG8_MMA(1, 1, At, B1); PG8_BAR;
            PG8_LDB(B0, 1, 0); PG8_SCHED; PG8_LDA(At, 1, 0); PG8_STAGE(PG8_SA(0, 1), a2, cv10, cv11);
            PG8_WAIT_L(8); PG8_BAR; PG8_WAIT_L(0); PG8_MMA(0, 0, At, B0); PG8_BAR; PG8_SCHED;
            PG8_LDB(B1, 1, 1); PG8_STAGE(PG8_SB(1, 0), b3, voffB0, voffB1);
            PG8_BAR; PG8_WAIT_L(0); PG8_MMA(0, 1, At, B1); PG8_BAR;
            PG8_LDA(At, 1, 1); PG8_STAGE(PG8_SA(1, 0), a3, cv00, cv01);
            PG8_BAR; PG8_WAIT_L(0); PG8_MMA(1, 0, At, B0); PG8_BAR; PG8_SCHED;
            PG8_STAGE(PG8_SB(1, 1), b3 + hstepB, voffB0, voffB1);
            PG8_WAIT_V(6); PG8_BAR; PG8_MMA(1, 1, At, B1); PG8_BAR;
            }
        }
        if constexpr (ALIGN_EPI) { if (wr == 0) PG8_BAR; }
        if constexpr (F8 && (SC0 != 0x7F || SC1 != 0x7F)) {
            const float s0 = __builtin_ldexpf(1.0f, SC0 - 127), s1 = __builtin_ldexpf(1.0f, SC1 - 127);
#pragma unroll
            for (int a = 0; a < 2; ++a)
#pragma unroll
                for (int m = 0; m < 4; ++m)
#pragma unroll
                    for (int n = 0; n < 2; ++n) { acc[a][0][m][n] = acc[a][0][m][n] * s0; acc[a][1][m][n] = acc[a][1][m][n] * s1; } }
        { int t2 = tid; asm volatile("" : "+v"(t2));
          E(acc, cur, wr, wc, t2 & 15, (t2 & 63) >> 4); }
        if (!has_next) break;
#pragma unroll
        for (int a = 0; a < 2; ++a)
#pragma unroll
            for (int b = 0; b < 2; ++b)
#pragma unroll
                for (int m = 0; m < 4; ++m)
#pragma unroll
                    for (int n = 0; n < 2; ++n) acc[a][b][m][n] = (f32x4){0.f, 0.f, 0.f, 0.f};
        cur = nxt; cA = nA; cB = nB; ++ui;
        if constexpr (ALIGN_EPI) { if (wr == 1) PG8_BAR; }
    }
    PG8_WAIT_V(0);
    if constexpr (!ALIGN_EPI) { if (wr == 0) PG8_BAR; }
    PG8_BAR;
#undef PG8_SA
#undef PG8_SB
#undef PG8_STAGE
#undef PG8_LDA
#undef PG8_LDB
#undef PG8_MMA
#undef PG8_WAIT_V
#undef PG8_WAIT_L
#undef PG8_BAR
#undef PG8_SCHED
#undef PG8_SETV
#undef PG8_PREF
#undef PG8_SETV_PREF
}

struct DenseSched {
    const char* A; const char* B; unsigned lda, ldb, a_pn; int nM, nN, nwg, G, c; const unsigned* ident = nullptr;
    __device__ __forceinline__ bool next(int i, Unit& u) const {
        const long L = (long)i * G + c; if (L >= nwg) return false;
        int wgid = (int)L; { const int q = nwg / NXCD, r = nwg % NXCD, xcd = wgid % NXCD, off = wgid / NXCD; wgid = (xcd < r ? xcd * (q + 1) : r * (q + 1) + (xcd - r) * q) + off; }
        const int nig = WGM * nN, gid = wgid / nig, fm = gid * WGM, gsz = (nM - fm) < WGM ? (nM - fm) : WGM;
        const int pm = fm + ((wgid % nig) % gsz), pn = (wgid % nig) / gsz;
        u.A = ident ? A : A + (size_t)pm * BM * lda + (size_t)pn * a_pn; u.B = B + (size_t)pn * BM * ldb; u.gat = ident ? ident + pm * BM : nullptr; u.nvalid = BM; u.i0 = pm; u.i1 = pn; u.i2 = 0; return true;
    }
};
struct MoeInfo { const LAS unsigned* cnt; const LAS unsigned* tstart; const LAS unsigned* ystart; const LAS unsigned char* tile_e; int ntiles; };
struct G1Sched {
    MoeInfo mi; const char* XB; const char* Wgu; const unsigned* rowtok; const unsigned* ident; int G, vcu;
    __device__ __forceinline__ bool next(int i, Unit& u) const {
        const int L = i * G + vcu; if (L >= 2 * mi.ntiles) return false;
        const int tile = L >> 1, uu = L & 1; int e;
        if (tile < 64) { e = 64; u.gat = ident + tile * 256; u.nvalid = 256; }
        else { e = __builtin_amdgcn_readfirstlane((int)mi.tile_e[tile]); const int pos0 = (tile - __builtin_amdgcn_readfirstlane((int)mi.tstart[e])) * 256; u.gat = rowtok + (size_t)e * CAP + pos0; const int rem = __builtin_amdgcn_readfirstlane((int)mi.cnt[e]) - pos0; u.nvalid = rem < 256 ? rem : 256; }
        u.A = XB; u.B = Wgu + (size_t)e * 524288 + (size_t)uu * 256 * 128; u.i0 = tile; u.i1 = uu; u.i2 = 0; return true;
    }
};
struct G2Sched {
    MoeInfo mi; const char* H; const char* Wd; int G, vcu;
    __device__ __forceinline__ bool next(int i, Unit& u) const {
        const int L = i * G + vcu; if (L >= 4 * mi.ntiles) return false;
        const int tile = L >> 2, pn = L & 3; int e;
        if (tile < 64) { e = 64; u.i0 = 131072 + tile * 256; u.i2 = 0; u.nvalid = 256; }
        else { e = __builtin_amdgcn_readfirstlane((int)mi.tile_e[tile]); const int pos0 = (tile - __builtin_amdgcn_readfirstlane((int)mi.tstart[e])) * 256; u.i0 = __builtin_amdgcn_readfirstlane((int)mi.ystart[e]) + pos0; u.i2 = 0; const int rem = __builtin_amdgcn_readfirstlane((int)mi.cnt[e]) - pos0; u.nvalid = rem < 256 ? rem : 256; }
        u.A = H + (size_t)tile * 256 * 256; u.B = Wd + ((size_t)e * 1024 + (size_t)pn * 256) * 256; u.gat = nullptr; u.i1 = pn; return true;
    }
};

template <int ACT, bool BIAS, bool SCALE, bool W32 = false, bool VSTAT = false, bool OUT8 = false> struct EpiBf16 {
    bf16* O; int ldo; const float* bias; const float* scale; float* vstat;
    __device__ __forceinline__ void operator()(const f32x4 (&acc)[2][2][4][2], const Unit& u, int wr, int wc, int fr, int fq) const {
        const int row0 = u.i0 * BM + wr * 64 + fr, col0 = u.i1 * BM + wc * 32 + 8 * fq;
        const bool dostat = VSTAT && u.i1 >= 8;
        f32x4 bv[2][2], sv[2][2];
#pragma unroll
        for (int bj = 0; bj < 2; ++bj)
#pragma unroll
            for (int n = 0; n < 2; ++n) { bv[bj][n] = BIAS ? *(const f32x4*)(bias + col0 + bj * HALF + 4 * n) : (f32x4){0.f, 0.f, 0.f, 0.f}; sv[bj][n] = SCALE ? *(const f32x4*)(scale + col0 + bj * HALF + 4 * n) : (f32x4){1.f, 1.f, 1.f, 1.f}; }
#pragma unroll
        for (int ai = 0; ai < 2; ++ai)
#pragma unroll
            for (int m = 0; m < 4; ++m) { bf16* rowp = O + (size_t)(row0 + ai * HALF + m * 16) * ldo + col0; unsigned char* rowp8 = (unsigned char*)O + (size_t)(row0 + ai * HALF + m * 16) * ldo + col0; float ssum = 0.f, ssq = 0.f;
#pragma unroll
                for (int bj = 0; bj < 2; ++bj) { f32x4 v0 = acc[ai][bj][m][0] * (W32 ? 0.03125f : 1.0f) + bv[bj][0], v1 = acc[ai][bj][m][1] * (W32 ? 0.03125f : 1.0f) + bv[bj][1];
                    if (ACT == 1) { const f32x2 a0 = gelu_tanh2((f32x2){v0[0], v0[1]}), a1 = gelu_tanh2((f32x2){v0[2], v0[3]}), a2 = gelu_tanh2((f32x2){v1[0], v1[1]}), a3 = gelu_tanh2((f32x2){v1[2], v1[3]});
                        v0 = (f32x4){a0.x, a0.y, a1.x, a1.y}; v1 = (f32x4){a2.x, a2.y, a3.x, a3.y}; }
                    if (SCALE) { v0 = v0 * sv[bj][0]; v1 = v1 * sv[bj][1]; }
                    if constexpr (OUT8) { int t0 = 0, t1 = 0; t0 = __builtin_amdgcn_cvt_pk_fp8_f32(v0[0], v0[1], t0, false); t0 = __builtin_amdgcn_cvt_pk_fp8_f32(v0[2], v0[3], t0, true); t1 = __builtin_amdgcn_cvt_pk_fp8_f32(v1[0], v1[1], t1, false); t1 = __builtin_amdgcn_cvt_pk_fp8_f32(v1[2], v1[3], t1, true);
                        *(v2u*)(rowp8 + bj * HALF) = (v2u){(unsigned)t0, (unsigned)t1}; }
                    else { v4u w; w.x = cvt_pk_bf16(v0[0], v0[1]); w.y = cvt_pk_bf16(v0[2], v0[3]); w.z = cvt_pk_bf16(v1[0], v1[1]); w.w = cvt_pk_bf16(v1[2], v1[3]);
                    *(v4u*)(rowp + bj * HALF) = w; }
                    if constexpr (VSTAT) {
#pragma unroll
                        for (int j = 0; j < 4; ++j) { ssum += v0[j] + v1[j]; ssq += v0[j] * v0[j] + v1[j] * v1[j]; } } }
                if constexpr (VSTAT) { if (dostat) {
                    ssum += __shfl_xor(ssum, 16); ssq += __shfl_xor(ssq, 16); ssum += __shfl_xor(ssum, 32); ssq += __shfl_xor(ssq, 32);
                    if (fq == 0) *(f32x2*)(vstat + ((size_t)(row0 + ai * HALF + m * 16) * 32 + (size_t)(u.i1 - 8) * 4 + wc) * 2) = (f32x2){ssum, ssq}; } } }
    }
};
template <bool BASE_BF16> struct EpiResidB {
    const void* base; bf16* outb;
    __device__ __forceinline__ void operator()(const f32x4 (&acc)[2][2][4][2], const Unit& u, int wr, int wc, int fr, int fq) const {
        const int row0 = u.i0 * BM + wr * 64 + fr, col0 = u.i1 * BM + wc * 32 + 8 * fq;
#pragma unroll
        for (int ai = 0; ai < 2; ++ai)
#pragma unroll
            for (int m = 0; m < 4; ++m) { const size_t off = (size_t)(row0 + ai * HALF + m * 16) * DM + col0;
#pragma unroll
                for (int bj = 0; bj < 2; ++bj) { f32x4 b0, b1;
                    if constexpr (BASE_BF16) { const v4u w = *(const v4u*)((const bf16*)base + off + bj * HALF); b0 = (f32x4){bf_lo(w.x), bf_hi(w.x), bf_lo(w.y), bf_hi(w.y)}; b1 = (f32x4){bf_lo(w.z), bf_hi(w.z), bf_lo(w.w), bf_hi(w.w)}; }
                    else { b0 = *(const f32x4*)((const float*)base + off + bj * HALF); b1 = *(const f32x4*)((const float*)base + off + bj * HALF + 4); }
                    const f32x4 o0 = b0 * ALPHA + acc[ai][bj][m][0], o1 = b1 * ALPHA + acc[ai][bj][m][1];
                    v4u o; o.x = cvt_pk_bf16(o0[0], o0[1]); o.y = cvt_pk_bf16(o0[2], o0[3]); o.z = cvt_pk_bf16(o1[0], o1[1]); o.w = cvt_pk_bf16(o1[2], o1[3]);
                    *(v4u*)(outb + off + bj * HALF) = o; }
                asm volatile("" ::: "memory"); }
    }
};
struct EpiSwiglu {
    unsigned char* H8;
    __device__ __forceinline__ void operator()(const f32x4 (&acc)[2][2][4][2], const Unit& u, int wr, int wc, int fr, int fq) const {
        const int row0 = u.i0 * BM + wr * 64 + fr, col0 = u.i1 * HALF + wc * 32 + 8 * fq;
#pragma unroll
        for (int ai = 0; ai < 2; ++ai)
#pragma unroll
            for (int m = 0; m < 4; ++m) { unsigned char* rowp = H8 + (size_t)(row0 + ai * HALF + m * 16) * EDIM + col0; float h[8];
#pragma unroll
                for (int n = 0; n < 2; ++n)
#pragma unroll
                    for (int j = 0; j < 4; j += 2) { const f32x2 g = (f32x2){acc[ai][0][m][n][j], acc[ai][0][m][n][j + 1]}, up = (f32x2){acc[ai][1][m][n][j], acc[ai][1][m][n][j + 1]};
                        const f32x2 t = g * (-1.4426950408889634f); f32x2 e; e.x = __builtin_amdgcn_exp2f(t.x); e.y = __builtin_amdgcn_exp2f(t.y); const f32x2 d = e + 1.0f; f32x2 r; r.x = __builtin_amdgcn_rcpf(d.x); r.y = __builtin_amdgcn_rcpf(d.y);
                        const f32x2 hh = (g * r) * up; h[4 * n + j] = __builtin_amdgcn_fmed3f(hh.x, -448.f, 448.f); h[4 * n + j + 1] = __builtin_amdgcn_fmed3f(hh.y, -448.f, 448.f); }
                int t0 = 0, t1 = 0; t0 = __builtin_amdgcn_cvt_pk_fp8_f32(h[0], h[1], t0, false); t0 = __builtin_amdgcn_cvt_pk_fp8_f32(h[2], h[3], t0, true); t1 = __builtin_amdgcn_cvt_pk_fp8_f32(h[4], h[5], t1, false); t1 = __builtin_amdgcn_cvt_pk_fp8_f32(h[6], h[7], t1, true);
                *(v2u*)rowp = (v2u){(unsigned)t0, (unsigned)t1}; }
    }
};
struct EpiDown {
    unsigned char* Y8;
    __device__ __forceinline__ void operator()(const f32x4 (&acc)[2][2][4][2], const Unit& u, int wr, int wc, int fr, int fq) const {
        const int r0 = wr * 64 + fr, col0 = u.i1 * BM + wc * 64 + 16 * fq;
#pragma unroll
        for (int ai = 0; ai < 2; ++ai)
#pragma unroll
            for (int m = 0; m < 4; ++m) { const int r = r0 + ai * HALF + m * 16;
                if (r < u.nvalid) { v4u w;
#pragma unroll
                    for (int q = 0; q < 4; ++q) { f32x4 v = acc[ai][q >> 1][m][q & 1];
#pragma unroll
                        for (int z = 0; z < 4; ++z) v[z] = __builtin_amdgcn_fmed3f(v[z], -448.f, 448.f);
                        int t = 0; t = __builtin_amdgcn_cvt_pk_fp8_f32(v[0], v[1], t, false); t = __builtin_amdgcn_cvt_pk_fp8_f32(v[2], v[3], t, true); w[q] = (unsigned)t; }
                    *(v4u*)(Y8 + (size_t)(u.i0 + r) * DM + col0) = w; } }
    }
};
}

struct Args { const float* in[24]; float* out; unsigned char* ws; int ph_lo, ph_hi; };
enum { I_X = 0, I_PWIN, I_PWGRP, I_PSCALE, I_PWOUT, I_SWIN, I_SBIN, I_SLNG, I_SLNB, I_SWS, I_SBS, I_SWOUT, I_LNMG, I_LNMB, I_WR, I_RB, I_WG, I_WU, I_WD, I_SHG, I_SHU, I_SHD, I_LNFG, I_LNFB };

__device__ __forceinline__ void tr_tall_f8(const float* W, int N, int k0, int n0, unsigned char* dst, int dpitch, float scale, LAS float* scr, int lane) {
    f32x4 q[16]; const int r8 = lane >> 3, c4 = 4 * (lane & 7);
#pragma unroll
    for (int i = 0; i < 16; ++i) q[i] = __builtin_nontemporal_load((const f32x4*)(W + (size_t)(k0 + 8 * i + r8) * N + n0 + c4));
#pragma unroll
    for (int i = 0; i < 16; ++i) { const int kk = 8 * i + r8; *(LAS f32x4*)(scr + kk * 32 + ((c4 + 4 * (kk >> 4)) & 31)) = q[i]; }
    LDS_WAIT(); asm volatile("" ::: "memory");
    const int c = lane & 7;
#pragma unroll
    for (int j = 0; j < 4; ++j) { const int n = r8 + 8 * j; const int col = (n + 4 * c) & 31; v4u o;
#pragma unroll
        for (int z = 0; z < 4; ++z) { const LAS float* sp = scr + (16 * c + 4 * z) * 32 + col; int t = 0;
            t = __builtin_amdgcn_cvt_pk_fp8_f32(sp[0] * scale, sp[32] * scale, t, false); t = __builtin_amdgcn_cvt_pk_fp8_f32(sp[64] * scale, sp[96] * scale, t, true); o[z] = (unsigned)t; }
        *(v4u*)(dst + (size_t)n * dpitch + 16 * c) = o; }
    LDS_WAIT(); asm volatile("" ::: "memory");
}
__device__ __forceinline__ void tr_tall_load(const float* W, int N, int k0, int n0, f32x4 (&q)[16], int lane) {
    const int r8 = lane >> 3, c4 = 4 * (lane & 7);
#pragma unroll
    for (int i = 0; i < 16; ++i) q[i] = __builtin_nontemporal_load((const f32x4*)(W + (size_t)(k0 + 8 * i + r8) * N + n0 + c4));
}
__device__ __forceinline__ void tr_tall_store(const f32x4 (&q)[16], unsigned char* dst, int dpitch, float scale, LAS float* scr, int lane) {
    const int r8 = lane >> 3, c4 = 4 * (lane & 7);
#pragma unroll
    for (int i = 0; i < 16; ++i) { const int kk = 8 * i + r8; *(LAS f32x4*)(scr + kk * 32 + ((c4 + 4 * (kk >> 4)) & 31)) = q[i]; }
    LDS_WAIT(); asm volatile("" ::: "memory");
    const int c = lane & 7;
#pragma unroll
    for (int j = 0; j < 4; ++j) { const int n = r8 + 8 * j; const int col = (n + 4 * c) & 31; v4u o;
#pragma unroll
        for (int z = 0; z < 4; ++z) { const LAS float* sp = scr + (16 * c + 4 * z) * 32 + col; int t = 0;
            t = __builtin_amdgcn_cvt_pk_fp8_f32(sp[0] * scale, sp[32] * scale, t, false); t = __builtin_amdgcn_cvt_pk_fp8_f32(sp[64] * scale, sp[96] * scale, t, true); o[z] = (unsigned)t; }
        *(v4u*)(dst + (size_t)n * dpitch + 16 * c) = o; }
    LDS_WAIT(); asm volatile("" ::: "memory");
}
__device__ __forceinline__ void tr_tall_bf16(const float* W, int N, int k0, int n0, unsigned char* dst, int dpitch, LAS float* scr, int lane) {
    f32x4 q[16]; tr_tall_load(W, N, k0, n0, q, lane);
    const int r8 = lane >> 3, c4 = 4 * (lane & 7);
#pragma unroll
    for (int i = 0; i < 16; ++i) { const int kk = 8 * i + r8; *(LAS f32x4*)(scr + kk * 32 + ((c4 + 4 * (kk >> 4)) & 31)) = q[i]; }
    LDS_WAIT(); asm volatile("" ::: "memory");
    const int c = lane & 7;
#pragma unroll
    for (int j = 0; j < 4; ++j) { const int n = r8 + 8 * j; const int col = (n + 4 * c) & 31; v4u o0, o1;
#pragma unroll
        for (int z = 0; z < 4; ++z) { const LAS float* sp = scr + (16 * c + 2 * z) * 32 + col; o0[z] = cvt_pk_bf16(sp[0], sp[32]); o1[z] = cvt_pk_bf16(sp[8 * 32], sp[9 * 32]); }
        *(v4u*)(dst + (size_t)n * dpitch + 32 * c) = o0; *(v4u*)(dst + (size_t)n * dpitch + 32 * c + 16) = o1; }
    LDS_WAIT(); asm volatile("" ::: "memory");
}
struct MoeItem { const float* src; unsigned char* dst; int N, k0, n0, dpitch; };
__device__ __forceinline__ void tr_item_hilo(const float* W, int N, int k0, int n0, bf16* dh, bf16* dl, int dpitch, LAS float* scr, int lane) {
#pragma unroll 8
    for (int i = 0; i < 32; ++i) { const int kk = 2 * i + (lane >> 5); scr[kk * 33 + (lane & 31)] = W[(size_t)(k0 + kk) * N + n0 + (lane & 31)]; }
    LDS_WAIT(); asm volatile("" ::: "memory");
    const int c = lane & 7;
#pragma unroll
    for (int j = 0; j < 4; ++j) { const int n = (lane >> 3) + 8 * j; const LAS float* s = scr + (8 * c) * 33 + n; float w[8];
#pragma unroll
        for (int z = 0; z < 8; ++z) w[z] = s[z * 33];
        v4u o; o.x = cvt_pk_bf16(w[0], w[1]); o.y = cvt_pk_bf16(w[2], w[3]); o.z = cvt_pk_bf16(w[4], w[5]); o.w = cvt_pk_bf16(w[6], w[7]);
        v4u l; l.x = cvt_pk_bf16(w[0] - bf_lo(o.x), w[1] - bf_hi(o.x)); l.y = cvt_pk_bf16(w[2] - bf_lo(o.y), w[3] - bf_hi(o.y)); l.z = cvt_pk_bf16(w[4] - bf_lo(o.z), w[5] - bf_hi(o.z)); l.w = cvt_pk_bf16(w[6] - bf_lo(o.w), w[7] - bf_hi(o.w));
        *(v4u*)(dh + (size_t)n * dpitch + 8 * c) = o; *(v4u*)(dl + (size_t)n * dpitch + 8 * c) = l; }
    LDS_WAIT(); asm volatile("" ::: "memory");
}
constexpr int MOE_ITEMS = 65 * 192;
__device__ __forceinline__ MoeItem moe_item_desc(const Args& a, int layer, int it) {
    unsigned char* WGU = a.ws + WS_WGU + (size_t)layer * WS_MOE_LSTRIDE; unsigned char* WDN = a.ws + WS_WDN + (size_t)layer * WS_MOE_LSTRIDE;
    const int e = it / 192, r = it % 192; MoeItem d;
    if (r < 128) { const int isup = r >> 6, rr = r & 63, kb = rr >> 3, nb = rr & 7; d.n0 = 32 * nb; d.k0 = 128 * kb; d.N = 256; d.dpitch = 128;
        d.src = (e < 64) ? a.in[isup ? I_WU : I_WG] + ((size_t)layer * 64 + e) * 262144 : a.in[isup ? I_SHU : I_SHG] + (size_t)layer * 262144;
        d.dst = WGU + (size_t)e * 524288 + (size_t)kb * GUPAN + (size_t)((d.n0 >> 7) * 256 + isup * 128 + (d.n0 & 127)) * 128;
    } else { const int rr = r - 128, kb = rr >> 5, nb = rr & 31; d.n0 = 32 * nb; d.k0 = 128 * kb; d.N = 1024; d.dpitch = 256;
        d.src = (e < 64) ? a.in[I_WD] + ((size_t)layer * 64 + e) * 262144 : a.in[I_SHD] + (size_t)layer * 262144;
        d.dst = WDN + ((size_t)e * 1024 + d.n0) * 256 + d.k0; }
    return d;
}
__device__ __forceinline__ void phase_p0(const Args& a, LAS unsigned char* lds, int vcu, int G) {
    const int tid = threadIdx.x, lane = tid & 63, wave = __builtin_amdgcn_readfirstlane(tid >> 6);
    const int gw = vcu * NWAVES + wave, NGW = G * NWAVES;
    LAS float* scr = (LAS float*)(lds + wave * 16384);
    constexpr int I_IN = 8 * 32, I_GRP = 4 * 2 * 8, I_OUT = 8 * 32, I_SIN = 8 * 128, I_SOUT = 16 * 32, NIT = I_IN + I_GRP + I_OUT + I_SIN + I_SOUT;
    for (int it = gw; it < NIT; it += NGW) {
        int r = it;
        if (r < I_IN) { const int kb = r >> 5, nb = r & 31; tr_tall_f8(a.in[I_PWIN], 1024, 128 * kb, 32 * nb, a.ws + WS_WIN + (size_t)kb * WINPAN + (size_t)(32 * nb) * 128, 128, 32.0f, scr, lane); continue; } r -= I_IN;
        if (r < I_GRP) { const int g = r >> 4, rr = r & 15, kb = rr >> 3, nb = rr & 7; tr_tall_bf16(a.in[I_PWGRP] + (size_t)g * 65536, 256, 128 * kb, 32 * nb, a.ws + WS_WGRP + ((size_t)(g * 256 + 32 * nb) * 256 + 128 * kb) * 2, 512, scr, lane); continue; } r -= I_GRP;
        if (r < I_OUT) { const int kb = r >> 5, nb = r & 31; tr_tall_bf16(a.in[I_PWOUT], 1024, 128 * kb, 32 * nb, a.ws + WS_WOUT + ((size_t)(32 * nb) * 1024 + 128 * kb) * 2, 2048, scr, lane); continue; } r -= I_OUT;
        if (r < I_SIN) { const int kb = r >> 7, nb = r & 127; tr_tall_f8(a.in[I_SWIN], 4096, 128 * kb, 32 * nb, a.ws + WS_WSIN + (size_t)kb * SINPAN + (size_t)(32 * nb) * 128, 128, 32.0f, scr, lane); continue; } r -= I_SIN;
        { const int kb = r >> 5, nb = r & 31; tr_tall_f8(a.in[I_SWOUT], 1024, 128 * kb, 32 * nb, a.ws + WS_WSOUT + (size_t)(32 * nb) * 2048 + 128 * kb, 2048, 32.0f, scr, lane); }
    }
    for (int it = gw; it < 64; it += NGW) { const int layer = it >> 5, rr = it & 31, kb = rr >> 1, nb = rr & 1; bf16* base = (bf16*)(a.ws + WS_WRT) + (size_t)layer * 2 * 65536 + (size_t)(32 * nb) * 1024 + 64 * kb;
        tr_item_hilo(a.in[I_WR] + (size_t)layer * DM * NE, 64, 64 * kb, 32 * nb, base, base + 65536, 1024, scr, lane); }
    const float* x = a.in[I_X]; unsigned char* xb = a.ws + WS_XB;
    const size_t gt = (size_t)vcu * NTHR + tid, NT = (size_t)G * NTHR;
#pragma unroll 1
    for (size_t i0 = gt; i0 < (size_t)T_TOK * DM / 8; i0 += 8 * NT) { f32x4 p[8], q[8];
#pragma unroll
        for (int u = 0; u < 8; ++u) { const size_t i = i0 + (size_t)u * NT; p[u] = *(const f32x4*)(x + i * 8); q[u] = *(const f32x4*)(x + i * 8 + 4); }
#pragma unroll
        for (int u = 0; u < 8; ++u) { const size_t i = i0 + (size_t)u * NT; const size_t row = i >> 7; const int col = (int)(i & 127) * 8; int t0 = 0, t1 = 0; t0 = __builtin_amdgcn_cvt_pk_fp8_f32(p[u][0], p[u][1], t0, false); t0 = __builtin_amdgcn_cvt_pk_fp8_f32(p[u][2], p[u][3], t0, true); t1 = __builtin_amdgcn_cvt_pk_fp8_f32(q[u][0], q[u][1], t1, false); t1 = __builtin_amdgcn_cvt_pk_fp8_f32(q[u][2], q[u][3], t1, true); *(v2u*)(xb + (size_t)(col >> 7) * XPAN + row * 128 + (col & 127)) = (v2u){(unsigned)t0, (unsigned)t1}; } }
    unsigned* ident = (unsigned*)(a.ws + WS_IDENT);
    for (size_t i = gt; i < (size_t)T_TOK; i += NT) ident[i] = (unsigned)i;
}

template <int W> __device__ __forceinline__ void pool_item(const bf16* zp  , bf16* op  , int p0  ) {
    v4u q[W + 3];
#pragma unroll
    for (int i = 0; i < W + 3; ++i) { const int ii = i < p0 + 3 ? i : p0 + 3; q[i] = *(const v4u*)(zp - (size_t)ii * DM); }
#pragma unroll
    for (int o = 0; o < 4; ++o) {
        float s[8];
#pragma unroll
        for (int j = 0; j < 8; ++j) s[j] = 0.f;
#pragma unroll
        for (int i = 3 - o; i < 3 - o + W; ++i) { const float m = (i <= p0 + 3) ? 1.0f : 0.0f;
#pragma unroll
            for (int j = 0; j < 4; ++j) { s[2 * j] += m * bf_lo(q[i][j]); s[2 * j + 1] += m * bf_hi(q[i][j]); } }
        const int p = p0 + o, nw = (p + 1) < W ? (p + 1) : W; const float inv = __builtin_amdgcn_rcpf((float)nw); v4u ov;
#pragma unroll
        for (int j = 0; j < 4; ++j) ov[j] = cvt_pk_bf16(s[2 * j] * inv - bf_lo(q[3 - o][j]), s[2 * j + 1] * inv - bf_hi(q[3 - o][j]));
        *(v4u*)(op + (size_t)o * DM) = ov; }
}
__device__ __forceinline__ void pool_block(const Args& a, int pm, int g) {
    const bf16* Z = (const bf16*)(a.ws + WS_Z); bf16* P = (bf16*)(a.ws + WS_POOLED);
    const int tid = threadIdx.x;
#pragma unroll 1
    for (int q = tid; q < 64 * 32; q += NTHR) { const int c8 = q & 31, tg = q >> 5, t0 = pm * 256 + tg * 4, p0 = t0 & (SEQ - 1);
        const bf16* zp = Z + (size_t)(t0 + 3) * DM + g * 256 + c8 * 8; bf16* op = P + (size_t)t0 * DM + g * 256 + c8 * 8;
        if (g == 0) pool_item<2>(zp, op, p0); else if (g == 1) pool_item<4>(zp, op, p0); else if (g == 2) pool_item<8>(zp, op, p0); else pool_item<16>(zp, op, p0); }
    VM_WAIT(); __syncthreads();
}
template <int R, int MODE> __device__ __forceinline__ void ln_rows_store(float (&v)[R][16], const float* g, const float* b, float* const (&of)[R], bf16* const (&obf)[R], unsigned char* const (&o8)[R], int lane) {
    float s[R], s2[R];
#pragma unroll
    for (int r = 0; r < R; ++r) { s[r] = 0.f;
#pragma unroll
        for (int i = 0; i < 16; ++i) s[r] += v[r][i]; }
#pragma unroll
    for (int o = 1; o < 64; o <<= 1)
#pragma unroll
        for (int r = 0; r < R; ++r) s[r] += __shfl_xor(s[r], o);
#pragma unroll
    for (int r = 0; r < R; ++r) { const float mean = s[r] * (1.0f / DM); s2[r] = 0.f;
#pragma unroll
        for (int i = 0; i < 16; ++i) { v[r][i] -= mean; s2[r] += v[r][i] * v[r][i]; } }
#pragma unroll
    for (int o = 1; o < 64; o <<= 1)
#pragma unroll
        for (int r = 0; r < R; ++r) s2[r] += __shfl_xor(s2[r], o);
#pragma unroll
    for (int j = 0; j < 2; ++j) { const int c = 8 * lane + 512 * j;
        const f32x4 g0 = *(const f32x4*)(g + c), g1 = *(const f32x4*)(g + c + 4), b0 = *(const f32x4*)(b + c), b1 = *(const f32x4*)(b + c + 4);
#pragma unroll
        for (int r = 0; r < R; ++r) { const float rstd = __builtin_amdgcn_rsqf(s2[r] * (1.0f / DM) + LN_EPS); f32x4 y0, y1;
#pragma unroll
            for (int q = 0; q < 4; ++q) { y0[q] = v[r][8 * j + q] * rstd * g0[q] + b0[q]; y1[q] = v[r][8 * j + 4 + q] * rstd * g1[q] + b1[q]; }
            if constexpr (MODE & 1) { *(f32x4*)(of[r] + c) = y0; *(f32x4*)(of[r] + c + 4) = y1; }
            if constexpr (MODE & 2) { v4u w; w.x = cvt_pk_bf16(y0[0], y0[1]); w.y = cvt_pk_bf16(y0[2], y0[3]); w.z = cvt_pk_bf16(y1[0], y1[1]); w.w = cvt_pk_bf16(y1[2], y1[3]); *(v4u*)(obf[r] + c) = w; }
            if constexpr (MODE & 4) { int t0 = 0, t1 = 0; t0 = __builtin_amdgcn_cvt_pk_fp8_f32(y0[0], y0[1], t0, false); t0 = __builtin_amdgcn_cvt_pk_fp8_f32(y0[2], y0[3], t0, true); t1 = __builtin_amdgcn_cvt_pk_fp8_f32(y1[0], y1[1], t1, false); t1 = __builtin_amdgcn_cvt_pk_fp8_f32(y1[2], y1[3], t1, true);
                *(v2u*)(o8[r] + (size_t)(c >> 7) * XPAN + (c & 127)) = (v2u){(unsigned)t0, (unsigned)t1}; } } }
}

#define LCV_BAR() do { asm volatile("s_waitcnt vmcnt(0) lgkmcnt(0)" ::: "memory"); ++lcv_ep; \
        if (lane == 0) __hip_atomic_fetch_add(lcv_cnt, 1u, __ATOMIC_RELAXED, __HIP_MEMORY_SCOPE_WORKGROUP); \
        while (__hip_atomic_load(lcv_cnt, __ATOMIC_RELAXED, __HIP_MEMORY_SCOPE_WORKGROUP) < 4u * lcv_ep) __builtin_amdgcn_s_sleep(1); \
        asm volatile("" ::: "memory"); } while (0)
__device__ __forceinline__ void phase_lnr_cv(const Args& a, int layer, LAS unsigned char* lds, int blk, int vcu, int G) {
    const int tid = threadIdx.x, lane = tid & 63, wave = __builtin_amdgcn_readfirstlane(tid >> 6);
    LAS unsigned char* lctl = lds + MISC_OFF + 4096;
    LAS unsigned* lcv_cnt = (LAS unsigned*)(lctl + 512); unsigned lcv_ep = 0u;
    LAS unsigned* lcv_q = (LAS unsigned*)(lctl + 516);
    if (tid == 0) { *lcv_cnt = 0u; *lcv_q = 0u; }
    if (tid < 64) ((LAS unsigned*)lctl)[tid] = 0u;
    __syncthreads();
#define LCV_PULL(scr_) do { for (;;) { unsigned j = 0; if (lane == 0) j = __hip_atomic_fetch_add(lcv_q, 1u, __ATOMIC_RELAXED, __HIP_MEMORY_SCOPE_WORKGROUP); j = (unsigned)__builtin_amdgcn_readfirstlane((int)j); \
        const int it = vcu * 4 + (int)(j & 3u) + 4 * G * (int)(j >> 2); if (it >= MOE_ITEMS) break; const MoeItem d_ = moe_item_desc(a, layer, it); f32x4 q_[16]; tr_tall_load(d_.src, d_.N, d_.k0, d_.n0, q_, lane); tr_tall_store(q_, d_.dst, d_.dpitch, 32.0f, (scr_), lane); } } while (0)
#define LCV_NEXT(itv) do { unsigned j = 0; if (lane == 0) j = __hip_atomic_fetch_add(lcv_q, 1u, __ATOMIC_RELAXED, __HIP_MEMORY_SCOPE_WORKGROUP); j = (unsigned)__builtin_amdgcn_readfirstlane((int)j); itv = vcu * 4 + (int)(j & 3u) + 4 * G * (int)(j >> 2); } while (0)
#define LCV_CONVERT2(scr_) do { int itA; LCV_NEXT(itA); \
        if (itA < MOE_ITEMS) { MoeItem dA = moe_item_desc(a, layer, itA); f32x4 qA[16], qB[16]; tr_tall_load(dA.src, dA.N, dA.k0, dA.n0, qA, lane); \
            for (;;) { int itB; LCV_NEXT(itB); const bool hb = itB < MOE_ITEMS; MoeItem dB = dA; \
                if (hb) { dB = moe_item_desc(a, layer, itB); tr_tall_load(dB.src, dB.N, dB.k0, dB.n0, qB, lane); } \
                tr_tall_store(qA, dA.dst, dA.dpitch, 32.0f, (scr_), lane); \
                if (!hb) break; \
                dA = dB; \
                _Pragma("unroll") for (int i = 0; i < 16; ++i) qA[i] = qB[i]; } } } while (0)
    if (wave >= 4) {
        LAS float* scr = (LAS float*)(lds + 65536 + (wave - 4) * 16384);
        LCV_CONVERT2(scr);
        return;
    }
    const bf16* xin = (const bf16*)(a.ws + WS_XR); float* xf = a.out; unsigned char* xb8 = a.ws + WS_XB;
    const float* lng = a.in[I_LNMG] + layer * DM; const float* lnb = a.in[I_LNMB] + layer * DM; const float* rbias = a.in[I_RB] + layer * NE;
    unsigned* gcount = (unsigned*)(a.ws + WS_CTL) + CW_CNT + layer * 64;
    unsigned* rowtok = (unsigned*)(a.ws + WS_ROWTOK); unsigned* dest = (unsigned*)(a.ws + WS_DEST); float* gatev = (float*)(a.ws + WS_GATE);
    LAS float* part = (LAS float*)lds;
    LAS unsigned* hist = (LAS unsigned*)lctl; LAS unsigned* basep = (LAS unsigned*)(lctl + 256);
    const int row0 = blk * 64;
#pragma unroll 1
    for (int h8 = 0; h8 < 2; ++h8) { float v[8][16]; float* of[8]; bf16* obf[8]; unsigned char* o8[8];
#pragma unroll
        for (int r = 0; r < 8; ++r) { const int rr = wave * 16 + h8 * 8 + r; const bf16* xr = xin + (size_t)(row0 + rr) * DM; of[r] = xf + (size_t)(row0 + rr) * DM; obf[r] = nullptr; o8[r] = xb8 + (size_t)(row0 + rr) * 128;
#pragma unroll
            for (int j = 0; j < 2; ++j) { const v4u p = *(const v4u*)(xr + 8 * lane + 512 * j);
#pragma unroll
                for (int i = 0; i < 4; ++i) { v[r][8 * j + 2 * i] = bf_lo(p[i]); v[r][8 * j + 2 * i + 1] = bf_hi(p[i]); } } }
        ln_rows_store<8, 5>(v, lng, lnb, of, obf, o8, lane); }
    LCV_BAR();
    { const int kq = wave, r = lane & 15, g = lane >> 4;
      f32x4 acc[4][4];
#pragma unroll
      for (int m = 0; m < 4; ++m)
#pragma unroll
          for (int n = 0; n < 4; ++n) acc[m][n] = (f32x4){0.f, 0.f, 0.f, 0.f};
      const float* arow = xf + (size_t)(row0 + r) * DM + kq * 256 + 8 * g;
      const bf16* bh = (const bf16*)(a.ws + WS_WRT) + (size_t)layer * 2 * 65536 + (size_t)r * 1024 + kq * 256 + 8 * g; const bf16* bl = bh + 65536;
      f32x4 a0[4], a1[4]; bf16x8 wh[4], wl[4];
#pragma unroll
      for (int m = 0; m < 4; ++m) { a0[m] = *(const f32x4*)(arow + (size_t)m * 16 * DM); a1[m] = *(const f32x4*)(arow + (size_t)m * 16 * DM + 4); }
#pragma unroll
      for (int n = 0; n < 4; ++n) { wh[n] = *(const bf16x8*)(bh + (size_t)n * 16384); wl[n] = *(const bf16x8*)(bl + (size_t)n * 16384); }
#pragma unroll 1
      for (int s = 0; s < 8; ++s) { const int sn = s < 7 ? s + 1 : s;
          f32x4 n0[4], n1[4]; bf16x8 nh[4], nl[4];
#pragma unroll
          for (int m = 0; m < 4; ++m) { n0[m] = *(const f32x4*)(arow + (size_t)m * 16 * DM + 32 * sn); n1[m] = *(const f32x4*)(arow + (size_t)m * 16 * DM + 32 * sn + 4); }
#pragma unroll
          for (int n = 0; n < 4; ++n) { nh[n] = *(const bf16x8*)(bh + (size_t)n * 16384 + 32 * sn); nl[n] = *(const bf16x8*)(bl + (size_t)n * 16384 + 32 * sn); }
#pragma unroll
          for (int m = 0; m < 4; ++m) {
              v4u hi, lo; hi.x = cvt_pk_bf16(a0[m][0], a0[m][1]); hi.y = cvt_pk_bf16(a0[m][2], a0[m][3]); hi.z = cvt_pk_bf16(a1[m][0], a1[m][1]); hi.w = cvt_pk_bf16(a1[m][2], a1[m][3]);
              lo.x = cvt_pk_bf16(a0[m][0] - bf_lo(hi.x), a0[m][1] - bf_hi(hi.x)); lo.y = cvt_pk_bf16(a0[m][2] - bf_lo(hi.y), a0[m][3] - bf_hi(hi.y));
              lo.z = cvt_pk_bf16(a1[m][0] - bf_lo(hi.z), a1[m][1] - bf_hi(hi.z)); lo.w = cvt_pk_bf16(a1[m][2] - bf_lo(hi.w), a1[m][3] - bf_hi(hi.w));
              const bf16x8 ah = __builtin_bit_cast(bf16x8, hi), al = __builtin_bit_cast(bf16x8, lo);
#pragma unroll
              for (int n = 0; n < 4; ++n) { acc[m][n] = __builtin_amdgcn_mfma_f32_16x16x32_bf16(ah, wh[n], acc[m][n], 0, 0, 0); acc[m][n] = __builtin_amdgcn_mfma_f32_16x16x32_bf16(al, wh[n], acc[m][n], 0, 0, 0); acc[m][n] = __builtin_amdgcn_mfma_f32_16x16x32_bf16(ah, wl[n], acc[m][n], 0, 0, 0); } }
#pragma unroll
          for (int m = 0; m < 4; ++m) { a0[m] = n0[m]; a1[m] = n1[m]; }
#pragma unroll
          for (int n = 0; n < 4; ++n) { wh[n] = nh[n]; wl[n] = nl[n]; } }
#pragma unroll
      for (int m = 0; m < 4; ++m)
#pragma unroll
          for (int n = 0; n < 4; ++n)
#pragma unroll
              for (int q = 0; q < 4; ++q) part[(kq * 64 + 16 * m + 4 * g + q) * 64 + 16 * n + r] = acc[m][n][q]; }
    LCV_BAR();
    const int grp = tid & 7; int rkk[2][8]; unsigned loc[2][8]; float gte[2][8]; unsigned selm[2];
#pragma unroll
    for (int ps = 0; ps < 2; ++ps) { const int row = 32 * ps + (tid >> 3); float sc[8], bsd[8];
#pragma unroll
        for (int i = 0; i < 8; ++i) { const int e = 8 * grp + i; const float lg = (part[row * 64 + e] + part[(64 + row) * 64 + e]) + (part[(128 + row) * 64 + e] + part[(192 + row) * 64 + e]); sc[i] = __builtin_amdgcn_rcpf(1.0f + __expf(-lg)); bsd[i] = sc[i] + rbias[e]; }
        float m1 = -INFINITY, m2 = -INFINITY;
#pragma unroll
        for (int i = 0; i < 8; ++i) { const float v = bsd[i]; if (v > m1) { m2 = m1; m1 = v; } else if (v > m2) m2 = v; }
        const float myg = m1 + m2; int grank = 0;
#pragma unroll
        for (int d = 1; d < 8; ++d) { const float o = __shfl(myg, (lane & ~7) | ((grp + d) & 7)); const int g2 = (grp + d) & 7; grank += (o > myg || (o == myg && g2 < grp)) ? 1 : 0; }
        const bool gsel = grank < 4;
        float cand[8]; unsigned sm = 0u;
#pragma unroll
        for (int i = 0; i < 8; ++i) { cand[i] = gsel ? bsd[i] : -INFINITY; rkk[ps][i] = 0; }
#pragma unroll 1
        for (int k = 0; k < TOPK; ++k) {
            float best = cand[0]; int bi = 0;
#pragma unroll
            for (int i = 1; i < 8; ++i) if (cand[i] > best) { best = cand[i]; bi = i; }
            int gi = 8 * grp + bi;
#define LNR_RED(CTRL) { const float ov = __builtin_bit_cast(float, __builtin_amdgcn_update_dpp(0, __builtin_bit_cast(int, best), CTRL, 0xF, 0xF, false)); const int oi = __builtin_amdgcn_update_dpp(0, gi, CTRL, 0xF, 0xF, false); if (ov > best || (ov == best && oi < gi)) { best = ov; gi = oi; } }
            LNR_RED(0xB1) LNR_RED(0x4E) LNR_RED(0x141)
#undef LNR_RED
#pragma unroll
            for (int i = 0; i < 8; ++i) if (gi == 8 * grp + i) { cand[i] = -INFINITY; rkk[ps][i] = k; sm |= 1u << i; }
        }
        float psum = 0.f;
#pragma unroll
        for (int i = 0; i < 8; ++i) psum += ((sm >> i) & 1u) ? sc[i] : 0.f;
        psum += __builtin_bit_cast(float, __builtin_amdgcn_update_dpp(0, __builtin_bit_cast(int, psum), 0xB1, 0xF, 0xF, false));
        psum += __builtin_bit_cast(float, __builtin_amdgcn_update_dpp(0, __builtin_bit_cast(int, psum), 0x4E, 0xF, 0xF, false));
        psum += __builtin_bit_cast(float, __builtin_amdgcn_update_dpp(0, __builtin_bit_cast(int, psum), 0x141, 0xF, 0xF, false));
        const float inv = ROUTED_SCALE * __builtin_amdgcn_rcpf(psum); selm[ps] = sm;
#pragma unroll
        for (int i = 0; i < 8; ++i) { gte[ps][i] = sc[i] * inv; loc[ps][i] = 0u; if ((sm >> i) & 1u) loc[ps][i] = __hip_atomic_fetch_add(hist + 8 * grp + i, 1u, __ATOMIC_RELAXED, __HIP_MEMORY_SCOPE_WORKGROUP); }
    }
    LCV_BAR();
    if (tid < 64) { const unsigned h = hist[tid]; basep[tid] = h ? __hip_atomic_fetch_add(gcount + tid, h, RLX_AGENT) : 0u; }
    LCV_BAR();
#pragma unroll
    for (int ps = 0; ps < 2; ++ps) { const int tok = row0 + 32 * ps + (tid >> 3);
#pragma unroll
        for (int i = 0; i < 8; ++i) if ((selm[ps] >> i) & 1u) { const int e = 8 * grp + i; const unsigned pos = basep[e] + loc[ps][i];
            rowtok[(size_t)e * CAP + pos] = (unsigned)tok; dest[tok * 8 + rkk[ps][i]] = ((unsigned)e << 16) | pos; gatev[tok * 8 + rkk[ps][i]] = gte[ps][i]; } }
    LCV_BAR();
    if (wave < 3) { LAS float* scr = (LAS float*)(lds + wave * 16384); LCV_CONVERT2(scr); }
#undef LCV_PULL
#undef LCV_CONVERT2
#undef LCV_NEXT
}

__device__ __forceinline__ pg8::MoeInfo moe_cached(LAS unsigned char* misc) {
    pg8::MoeInfo mi; mi.cnt = (const LAS unsigned*)(misc + MI_CNT); mi.tstart = (const LAS unsigned*)(misc + MI_TSTART); mi.ystart = (const LAS unsigned*)(misc + MI_YSTART); mi.tile_e = (const LAS unsigned char*)(misc + MI_TILE_E);
    mi.ntiles = __builtin_amdgcn_readfirstlane((int)*(const LAS unsigned*)(misc + MI_NTILES)); if (mi.ntiles > 640) mi.ntiles = 640;
    return mi;
}
__device__ __forceinline__ pg8::MoeInfo moe_setup(const Args& a, int layer, LAS unsigned char* misc) {
    const int tid = threadIdx.x;
    unsigned* gcount = (unsigned*)(a.ws + WS_CTL) + CW_CNT + layer * 64;
    LAS unsigned* cnt = (LAS unsigned*)(misc + MI_CNT); LAS unsigned* tstart = (LAS unsigned*)(misc + MI_TSTART); LAS unsigned* ystart = (LAS unsigned*)(misc + MI_YSTART);
    LAS unsigned* ntl = (LAS unsigned*)(misc + MI_NTILES); LAS unsigned char* tile_e = (LAS unsigned char*)(misc + MI_TILE_E);
    __syncthreads();
    if (tid < 64) { unsigned c = __hip_atomic_load(gcount + tid, RLX_AGENT); if (c > (unsigned)CAP) c = CAP; cnt[tid] = c; }
    __syncthreads();
    if (tid < 64) { const unsigned myc = cnt[tid], mynt0 = (myc + 255u) >> 8; unsigned its = mynt0, iys = myc;
#pragma unroll
        for (int o = 1; o < 64; o <<= 1) { const unsigned t1 = __shfl_up(its, o), t2 = __shfl_up(iys, o); if (tid >= o) { its += t1; iys += t2; } }
        const unsigned ts = 64u + its - mynt0, ys = iys - myc;
        tstart[tid] = ts; ystart[tid] = ys; const unsigned mynt = mynt0;
        for (unsigned i = 0; i < mynt; ++i) if (ts + i < 640u) tile_e[ts + i] = (unsigned char)tid;
        if (tid == 63) ntl[0] = ts + mynt; }
    __syncthreads();
    pg8::MoeInfo mi; mi.cnt = cnt; mi.tstart = tstart; mi.ystart = ystart; mi.tile_e = tile_e; mi.ntiles = __builtin_amdgcn_readfirstlane((int)ntl[0]);
    if (mi.ntiles > 640) mi.ntiles = 640;
    return mi;
}

__device__ __forceinline__ void phase_combine(const Args& a, int layer, LAS unsigned char* misc, int vcu, int G, bool cached) {
    const int tid = threadIdx.x, lane = tid & 63, wave = __builtin_amdgcn_readfirstlane(tid >> 6);
    const pg8::MoeInfo mi = cached ? moe_cached(misc) : moe_setup(a, layer, misc);
    float* xf = a.out; bf16* xb = (bf16*)(a.ws + WS_XB); const unsigned char* Y8 = (const unsigned char*)(a.ws + WS_Y);
    const unsigned* dest = (const unsigned*)(a.ws + WS_DEST); const float* gatev = (const float*)(a.ws + WS_GATE);
    const float* lng = a.in[I_LNFG] + layer * DM; const float* lnb = a.in[I_LNFB] + layer * DM;
    const int gw = vcu * NWAVES + wave, NGW = G * NWAVES;
#pragma unroll 1
    for (int rowa = gw; rowa < T_TOK; rowa += 2 * NGW) {
        float v[2][16]; float* of[2]; bf16* obf[2]; unsigned char* o8[2]; unsigned d[2][TOPK]; float gk[2][TOPK];
#pragma unroll
        for (int r = 0; r < 2; ++r) { const int row = rowa + r * NGW;
#pragma unroll
            for (int k = 0; k < TOPK; ++k) { d[r][k] = dest[row * 8 + k]; gk[r][k] = gatev[row * 8 + k]; } }
#pragma unroll
        for (int r = 0; r < 2; ++r) { const int row = rowa + r * NGW; float* xr = xf + (size_t)row * DM; of[r] = xr; obf[r] = (bf16*)(a.ws + WS_XR) + (size_t)row * DM; o8[r] = (unsigned char*)xb + (size_t)row * 128;
#pragma unroll
            for (int j = 0; j < 2; ++j) { const f32x4 p = *(const f32x4*)(xr + 8 * lane + 512 * j), q = *(const f32x4*)(xr + 8 * lane + 512 * j + 4);
#pragma unroll
                for (int i = 0; i < 4; ++i) { v[r][8 * j + i] = p[i] * ALPHA; v[r][8 * j + 4 + i] = q[i] * ALPHA; } } }
#pragma unroll
        for (int r = 0; r < 2; ++r) { const unsigned char* yr = Y8 + (size_t)(131072 + rowa + r * NGW) * DM;
#pragma unroll
            for (int j = 0; j < 2; ++j) { const v2u w = *(const v2u*)(yr + 8 * lane + 512 * j);
#pragma unroll
                for (int q = 0; q < 2; ++q) { const f32x2 lo2 = __builtin_amdgcn_cvt_pk_f32_fp8((int)w[q], false), hi2 = __builtin_amdgcn_cvt_pk_f32_fp8((int)w[q], true);
                    v[r][8 * j + 4 * q] += 0.0625f * lo2.x; v[r][8 * j + 4 * q + 1] += 0.0625f * lo2.y; v[r][8 * j + 4 * q + 2] += 0.0625f * hi2.x; v[r][8 * j + 4 * q + 3] += 0.0625f * hi2.y; } } }
#pragma unroll
        for (int r = 0; r < 2; ++r)
#pragma unroll
            for (int k = 0; k < TOPK; ++k) { const unsigned dd = (unsigned)__builtin_amdgcn_readfirstlane((int)d[r][k]); const float g = __uint_as_float((unsigned)__builtin_amdgcn_readfirstlane((int)__float_as_uint(gk[r][k])));
                const unsigned e = (dd >> 16) & 63u, pos = dd & 0xffffu; const unsigned char* yr = Y8 + (size_t)(mi.ystart[e] + pos) * DM; const float g16 = g * 0.0625f;
#pragma unroll
                for (int j = 0; j < 2; ++j) { const v2u w = *(const v2u*)(yr + 8 * lane + 512 * j);
#pragma unroll
                    for (int q = 0; q < 2; ++q) { const f32x2 lo2 = __builtin_amdgcn_cvt_pk_f32_fp8((int)w[q], false), hi2 = __builtin_amdgcn_cvt_pk_f32_fp8((int)w[q], true);
                        v[r][8 * j + 4 * q] += g16 * lo2.x; v[r][8 * j + 4 * q + 1] += g16 * lo2.y; v[r][8 * j + 4 * q + 2] += g16 * hi2.x; v[r][8 * j + 4 * q + 3] += g16 * hi2.y; } } }
        if (layer == 0) ln_rows_store<2, 6>(v, lng, lnb, of, obf, o8, lane);
        else ln_rows_store<2, 1>(v, lng, lnb, of, obf, o8, lane);
    }
}

__device__ __forceinline__ int swz16(int row) { return (row ^ (row >> 4)) & 15; }
__device__ __forceinline__ void phase_sgu_spatial(const Args& a, LAS unsigned char* lds, int vcu, int G) {
    const int tid = threadIdx.x, lane = tid & 63, wave = __builtin_amdgcn_readfirstlane(tid >> 6), fr = lane & 15, fq = lane >> 4;
    const unsigned char* HS = (const unsigned char*)(a.ws + WS_HS); unsigned char* GT = (unsigned char*)(a.ws + WS_GATED);
    const float* lng = a.in[I_SLNG]; const float* lnb = a.in[I_SLNB]; const float* WS = a.in[I_SWS]; const float* BS = a.in[I_SBS];
    LAS unsigned char* Bs = lds;
    LAS unsigned char* As = lds + 65536;
    LAS float* stm = (LAS float*)(lds + 98304);
    LAS float* str = (LAS float*)(lds + 98304 + 512);
    int hprev = -1;
    for (int item = vcu; item < 512; item += G) {
        const int chunk = item >> 2, h = item & 3, t0 = chunk * 128;
        __syncthreads();
        if (tid < 128) { const f32x4* vs = (const f32x4*)((const float*)(a.ws + WS_VSTAT) + (size_t)(t0 + tid) * 64); float S = 0.f, Q = 0.f;
#pragma unroll
            for (int i = 0; i < 16; ++i) { const f32x4 p = vs[i]; S += p[0] + p[2]; Q += p[1] + p[3]; }
            const float mean = S * (1.0f / SGU_W); const float var = Q * (1.0f / SGU_W) - mean * mean;
            stm[tid] = mean; str[tid] = __builtin_amdgcn_rsqf((var > 0.f ? var : 0.f) + LN_EPS); }
        if (h != hprev) for (int q = tid; q < 128 * 16; q += NTHR) { const int i = q >> 4, jc = q & 15; const float* wp = WS + ((size_t)h * 128 + i) * 128 + 8 * jc;
            const f32x4 p0 = *(const f32x4*)wp, p1 = *(const f32x4*)(wp + 4); float w8[8];
#pragma unroll
            for (int z = 0; z < 4; ++z) { w8[z] = (8 * jc + z <= i) ? p0[z] : 0.f; w8[4 + z] = (8 * jc + 4 + z <= i) ? p1[z] : 0.f; }
            v4u o; o.x = cvt_pk_bf16(w8[0], w8[1]); o.y = cvt_pk_bf16(w8[2], w8[3]); o.z = cvt_pk_bf16(w8[4], w8[5]); o.w = cvt_pk_bf16(w8[6], w8[7]);
            *(LAS v4u*)(As + i * 256 + ((jc ^ swz16(i)) << 4)) = o; }
        hprev = h;
        __syncthreads();
        for (int hh = 0; hh < 2; ++hh) {
            const int cb = h * SGU_HD + hh * 256;
            const int c8 = tid & 31;
            const f32x4 g0 = *(const f32x4*)(lng + cb + 8 * c8), g1 = *(const f32x4*)(lng + cb + 8 * c8 + 4), b0 = *(const f32x4*)(lnb + cb + 8 * c8), b1 = *(const f32x4*)(lnb + cb + 8 * c8 + 4);
#pragma unroll 2
            for (int q = tid; q < 64 * 32; q += NTHR) { const int jp = q >> 5, j0 = 2 * jp;
                const v2u w0 = *(const v2u*)(HS + (size_t)(t0 + j0) * 4096 + SGU_W + cb + 8 * c8), w1 = *(const v2u*)(HS + (size_t)(t0 + j0 + 1) * 4096 + SGU_W + cb + 8 * c8);
                float xa8[8], xc8[8];
#pragma unroll
                for (int q2 = 0; q2 < 2; ++q2) { const f32x2 al = __builtin_amdgcn_cvt_pk_f32_fp8((int)w0[q2], false), ah = __builtin_amdgcn_cvt_pk_f32_fp8((int)w0[q2], true), cl = __builtin_amdgcn_cvt_pk_f32_fp8((int)w1[q2], false), ch = __builtin_amdgcn_cvt_pk_f32_fp8((int)w1[q2], true);
                    xa8[4 * q2] = al.x; xa8[4 * q2 + 1] = al.y; xa8[4 * q2 + 2] = ah.x; xa8[4 * q2 + 3] = ah.y; xc8[4 * q2] = cl.x; xc8[4 * q2 + 1] = cl.y; xc8[4 * q2 + 2] = ch.x; xc8[4 * q2 + 3] = ch.y; }
                const float m0 = stm[j0], r0 = str[j0], m1 = stm[j0 + 1], r1 = str[j0 + 1];
#pragma unroll
                for (int z = 0; z < 8; ++z) { const float gz = z < 4 ? g0[z & 3] : g1[z & 3], bz = z < 4 ? b0[z & 3] : b1[z & 3];
                    const float xa = xa8[z], xc = xc8[z];
                    const float ya = (xa - m0) * r0 * gz + bz, yc = (xc - m1) * r1 * gz + bz;
                    const int cc = 8 * c8 + z, slot = (cc & ~31) | (((cc >> 2) & 1) << 4) | (((cc >> 3) & 3) << 2) | (cc & 3);
                    *(LAS unsigned*)(Bs + slot * 256 + (((j0 >> 3) ^ swz16(slot)) << 4) + (j0 & 7) * 2) = cvt_pk_bf16(ya, yc); } }
            __syncthreads();
            f32x4 acc[8][2]; bf16x8 Bf[2][4];
#pragma unroll
            for (int n = 0; n < 2; ++n)
#pragma unroll
                for (int s = 0; s < 4; ++s) { const int slot = 32 * wave + 16 * n + fr; Bf[n][s] = *(const LAS bf16x8*)(Bs + slot * 256 + (((4 * s + fq) ^ swz16(slot)) << 4)); }
#pragma unroll
            for (int m = 0; m < 8; ++m) { acc[m][0] = (f32x4){0.f, 0.f, 0.f, 0.f}; acc[m][1] = (f32x4){0.f, 0.f, 0.f, 0.f};
#pragma unroll
                for (int s = 0; s < 4; ++s) if (s <= (m >> 1)) { const int i = 16 * m + fr; const bf16x8 af = *(const LAS bf16x8*)(As + i * 256 + (((4 * s + fq) ^ swz16(i)) << 4));
                    acc[m][0] = __builtin_amdgcn_mfma_f32_16x16x32_bf16(Bf[0][s], af, acc[m][0], 0, 0, 0); acc[m][1] = __builtin_amdgcn_mfma_f32_16x16x32_bf16(Bf[1][s], af, acc[m][1], 0, 0, 0); } }
#pragma unroll
            for (int m = 0; m < 8; ++m) { const int i = 16 * m + fr; const float bsv = BS[h * 128 + i]; const size_t t = (size_t)(t0 + i);
                const v2u uw = *(const v2u*)(HS + t * 4096 + cb + 32 * wave + 8 * fq); float o[8], u8[8];
#pragma unroll
                for (int q2 = 0; q2 < 2; ++q2) { const f32x2 ul = __builtin_amdgcn_cvt_pk_f32_fp8((int)uw[q2], false), uh = __builtin_amdgcn_cvt_pk_f32_fp8((int)uw[q2], true); u8[4 * q2] = ul.x; u8[4 * q2 + 1] = ul.y; u8[4 * q2 + 2] = uh.x; u8[4 * q2 + 3] = uh.y; }
#pragma unroll
                for (int n = 0; n < 2; ++n)
#pragma unroll
                    for (int z = 0; z < 4; ++z) { const int c = 4 * n + z; o[c] = __builtin_amdgcn_fmed3f(u8[c] * (acc[m][n][z] + bsv), -448.f, 448.f); }
                int g0 = 0, g1 = 0; g0 = __builtin_amdgcn_cvt_pk_fp8_f32(o[0], o[1], g0, false); g0 = __builtin_amdgcn_cvt_pk_fp8_f32(o[2], o[3], g0, true); g1 = __builtin_amdgcn_cvt_pk_fp8_f32(o[4], o[5], g1, false); g1 = __builtin_amdgcn_cvt_pk_fp8_f32(o[6], o[7], g1, true);
                *(v2u*)(GT + t * SGU_W + cb + 32 * wave + 8 * fq) = (v2u){(unsigned)g0, (unsigned)g1}; }
            __syncthreads();
        }
    }
}

constexpr int N_PHASES = 16;
__global__ void __launch_bounds__(NTHR, 2) mk_fwd(Args args) {
    extern __shared__ __attribute__((aligned(16))) unsigned char lds_raw[];
    LAS unsigned char* lds = (LAS unsigned char*)lds_raw;
    LAS unsigned char* misc = lds + MISC_OFF;
    const int tid = threadIdx.x;
    const int G = gridDim.x; const int bx = blockIdx.x; const int vcu = (G % 8 == 0) ? (bx % 8) * (G / 8) + bx / 8 : bx;
    unsigned char* ws = args.ws;
    unsigned* ctl = (unsigned*)(ws + WS_CTL);
    if (tid < 16) ((LAS unsigned*)(misc + MI_BARW))[tid] = 0u;
    __syncthreads();
    const int lo = args.ph_lo, hi = args.ph_hi;
    XcdBarrier bar; bar.bar = ctl + CW_BAR; bar.x = 0; bar.st = nullptr;
    if (hi - lo > 1) bar = xcd_barrier_post(ctl + CW_BAR, (volatile LAS unsigned*)(misc + MI_BARW));
#define IN(k) (lo <= (k) && (k) < hi)
#ifndef TS_A0
#define TS_A0 -1
#define TS_A1 -1
#define TS_M 1
#endif
    unsigned long long* tsbuf = (unsigned long long*)(ws + 32768);
#define TS_REC(k) do { if (TS_A0 >= 0 && bx == 0 && tid == 0) __hip_atomic_store(tsbuf + (k), (unsigned long long)__builtin_amdgcn_s_memrealtime(), RLX_AGENT); } while (0)
    TS_REC(0);
#define SEAM(k) do { if (IN(k) && IN((k) + 1)) xcd_barrier(bar); TS_REC((k) + 1); } while (0)
#define RUN(k) if (IN(k)) for (int rep = 0; rep < 1; ++rep)
    using namespace pg8;
    RUN(0) { phase_p0(args, lds, vcu, G); } SEAM(0);
    RUN(1) { DenseSched S{(const char*)(ws + WS_XB), (const char*)(ws + WS_WIN), 128u, 128u, 0u, 64, 4, 256, G, bx, (const unsigned*)(ws + WS_IDENT)};
        EpiBf16<0, false, false> E{(bf16*)(ws + WS_Z), DM, nullptr, nullptr, nullptr};
        gemm_phase<EpiBf16<0, false, false>, DenseSched, true, true, false, 0, 1, 0x7A, 0x7A>(lds, 128u, 128u, 8, S, E, XPAN, WINPAN); } SEAM(1);
    RUN(3) { DenseSched S{(const char*)(ws + WS_POOLED), (const char*)(ws + WS_WGRP), 2048u, 512u, 512u, 64, 4, 256, G, bx};
        { Unit u0; if (S.next(0, u0)) pool_block(args, u0.i0, u0.i1); }
        EpiBf16<0, false, true> E{(bf16*)(ws + WS_YP), DM, nullptr, args.in[I_PSCALE], nullptr};
        gemm_phase<EpiBf16<0, false, true>, DenseSched, false, true, true>(lds, 2048u, 512u, 4, S, E); } SEAM(3);
    RUN(4) { DenseSched S{(const char*)(ws + WS_YP), (const char*)(ws + WS_WOUT), 2048u, 2048u, 0u, 64, 4, 256, G, bx};
        EpiResidB<false> E{args.in[I_X], (bf16*)(ws + WS_XR)};
        gemm_phase<EpiResidB<false>, DenseSched, false, true, true>(lds, 2048u, 2048u, 16, S, E); } SEAM(4);
#define MOE_PHASES(layer, pb) do { \
        RUN(pb) { phase_lnr_cv(args, layer, lds, vcu, vcu, G); __syncthreads(); } SEAM(pb); \
        RUN((pb) + 1) { const MoeInfo mi = moe_setup(args, layer, misc); \
            G1Sched S{mi, (const char*)(ws + WS_XB), (const char*)(ws + WS_WGU + (size_t)layer * WS_MOE_LSTRIDE), (const unsigned*)(ws + WS_ROWTOK), (const unsigned*)(ws + WS_IDENT), G, vcu}; \
            EpiSwiglu E{(unsigned char*)(ws + WS_H)}; \
            gemm_phase<EpiSwiglu, G1Sched, true, true, false, 0, 1, 0x7A, 0x7D>(lds, 128u, 128u, 8, S, E, XPAN, GUPAN); } SEAM((pb) + 1); \
        if (IN((pb) + 2)) { const MoeInfo mi = IN((pb) + 1) ? moe_cached(misc) : moe_setup(args, layer, misc); \
            G2Sched S{mi, (const char*)(ws + WS_H), (const char*)(ws + WS_WDN + (size_t)layer * WS_MOE_LSTRIDE), G, vcu}; \
            EpiDown E{(unsigned char*)(ws + WS_Y)}; \
            gemm_phase<EpiDown, G2Sched, false, true, true, 1, 1, 0x7B, 0x7B>(lds, 256u, 256u, 2, S, E); } SEAM((pb) + 2); \
        RUN((pb) + 3) { phase_combine(args, layer, misc, vcu, G, IN((pb) + 1)); } \
    } while (0)
    MOE_PHASES(0, 5); SEAM(8);
    RUN(9) { DenseSched S{(const char*)(ws + WS_XB), (const char*)(ws + WS_WSIN), 128u, 128u, 0u, 64, 16, 1024, G, bx, (const unsigned*)(ws + WS_IDENT)};
        EpiBf16<1, true, false, false, true, true> E{(bf16*)(ws + WS_HS), 4096, args.in[I_SBIN], nullptr, (float*)(ws + WS_VSTAT)};
        gemm_phase<EpiBf16<1, true, false, false, true, true>, DenseSched, true, true, false, 0, 1, 0x7A, 0x7A>(lds, 128u, 128u, 8, S, E, XPAN, SINPAN); } SEAM(9);
    RUN(10) { phase_sgu_spatial(args, lds, vcu, G); } SEAM(10);
    RUN(11) { DenseSched S{(const char*)(ws + WS_GATED), (const char*)(ws + WS_WSOUT), 2048u, 2048u, 0u, 64, 4, 256, G, bx, (const unsigned*)(ws + WS_IDENT)};
        EpiResidB<true> E{ws + WS_XR, (bf16*)(ws + WS_XR)};
        gemm_phase<EpiResidB<true>, DenseSched, true, true, false, 0, 1, 0x7A, 0x7A>(lds, 2048u, 2048u, 16, S, E); } SEAM(11);
    MOE_PHASES(1, 12);
#undef MOE_PHASES
    if (TS_A0 >= 0 && bx == 0 && tid == 0) {
        const unsigned long long tend = __builtin_amdgcn_s_memrealtime();
        const unsigned long long t0 = __hip_atomic_load(tsbuf + TS_A0, RLX_AGENT), t1 = (TS_A1 + 1 >= N_PHASES) ? tend : __hip_atomic_load(tsbuf + TS_A1 + 1, RLX_AGENT);
        const unsigned long long wait = (t1 - t0) * TS_M;
        while (__builtin_amdgcn_s_memrealtime() - tend < wait) __builtin_amdgcn_s_sleep(8);
    }
#undef IN
#undef SEAM
}

extern "C" void kernel_launch(void* const* d_in, const int* in_sizes, int n_in, void* d_out, int out_size, void* d_ws, size_t ws_size, hipStream_t stream) {
    static int grid = 0;
    if (grid == 0) {
        if (n_in != 24 || out_size != T_TOK * DM || ws_size < WS_END) { fprintf(stderr, "kernel_launch: unexpected shapes (n_in %d out %d ws %zu)\n", n_in, out_size, ws_size); grid = -1; return; }
        int dev = 0, cus = 0;
        if (hipGetDevice(&dev) != hipSuccess || hipDeviceGetAttribute(&cus, hipDeviceAttributeMultiprocessorCount, dev) != hipSuccess) { grid = -1; return; }
        if (hipFuncSetAttribute((const void*)mk_fwd, hipFuncAttributeMaxDynamicSharedMemorySize, LDS_BYTES) != hipSuccess) { fprintf(stderr, "kernel_launch: hipFuncSetAttribute failed\n"); grid = -1; return; }
        int per_cu = 0;
        if (hipOccupancyMaxActiveBlocksPerMultiprocessor(&per_cu, (const void*)mk_fwd, NTHR, LDS_BYTES) != hipSuccess || per_cu < 1) fprintf(stderr, "kernel_launch: occupancy query says %d\n", per_cu);
        (void)hipGetLastError();
        grid = cus;
        if (grid != 256) { fprintf(stderr, "kernel_launch: built for a 256-CU device (got %d)\n", cus); grid = -1; return; }
    }
    if (grid < 0) return;
    (void)hipMemsetAsync((char*)d_ws + WS_CTL, 0, CTL_ZERO_BYTES, stream);
    Args a{};
    for (int i = 0; i < 24; ++i) a.in[i] = (const float*)d_in[i];
    a.out = (float*)d_out; a.ws = (unsigned char*)d_ws;
#if MK_PER_PHASE
    for (int p = 0; p < N_PHASES; ++p) { a.ph_lo = p; a.ph_hi = p + 1; hipLaunchKernelGGL(mk_fwd, dim3(grid), dim3(NTHR), LDS_BYTES, stream, a); }
#else
    a.ph_lo = 0; a.ph_hi = N_PHASES; hipLaunchKernelGGL(mk_fwd, dim3(grid), dim3(NTHR), LDS_BYTES, stream, a);
#endif
}
```
